# Optimizing an MI355X kernel written in HIP

```python
import jax
import jax.numpy as jnp
from jax import lax
import numpy as np

D_MODEL = 1024
BATCH = 8
SEQ = 8192
DEPTH = 4

HEAD_DIM = 64
HEADS_PER_MIXER = 4
MIX_WIDTH = HEADS_PER_MIXER * HEAD_DIM
N_MIXERS = 4
Q_BLOCK = 128
SUPER_Q = 512
SUFFIX_CHUNK = 128
ROPE_THETA = 500000.0
ROPE_DIMS = HEAD_DIM // 4
CMP_LEN = 32
CMP_STRIDE = 16
SEL_BLOCK = 64
SEL_TOPN = 16
WINDOW = 512
FORCE_BONUS = 1.0e6
IDX_HEADS = 4
IDX_DIM = 64
DSA_TOPK_MAX = 256
N_EXPERTS = 64
TOP_K = 8
N_GROUPS = 8
TOPK_GROUPS = 4
D_EXPERT = 256
ROUTE_SCALE = 2.5
MOE_BLOCK = 512
DEEPNORM_ALPHA = (2 * DEPTH) ** 0.25
DEEPNORM_BETA = (8 * DEPTH) ** -0.25
LN_EPS = 1e-5
NEG_INF = -1e30
TINY = 1e-30

IN_LAYOUT = (
    ('a_q', MIX_WIDTH), ('a_k_cmp', HEAD_DIM), ('a_v_cmp', HEAD_DIM), ('a_k_sel', HEAD_DIM),
    ('a_v_sel', HEAD_DIM), ('a_k_win', HEAD_DIM), ('a_v_win', HEAD_DIM), ('a_gate', 3 * HEADS_PER_MIXER),
    ('b_q', MIX_WIDTH), ('b_k', MIX_WIDTH), ('b_v', MIX_WIDTH),
    ('c_q', MIX_WIDTH), ('c_k', MIX_WIDTH), ('c_v', MIX_WIDTH), ('c_f', HEADS_PER_MIXER),
    ('d_q', MIX_WIDTH), ('d_k', HEAD_DIM), ('d_v', HEAD_DIM),
    ('d_iq', IDX_HEADS * IDX_DIM), ('d_ik', IDX_DIM), ('d_iw', IDX_HEADS),
)
IN_NAMES = tuple(n for n, _ in IN_LAYOUT)
IN_SIZES = tuple(c for _, c in IN_LAYOUT)
IN_WIDTH = sum(IN_SIZES)
IN_SPLITS = tuple(sum(IN_SIZES[:i + 1]) for i in range(len(IN_SIZES) - 1))

kernel_name = 'hybrid_nsa_stickbreak_fox_dsa_moe'


def _layer_norm(x, g, b):
    xf = x.astype(jnp.float32)
    mu = jnp.mean(xf, axis=-1, keepdims=True)
    var = jnp.mean(jnp.square(xf - mu), axis=-1, keepdims=True)
    return ((xf - mu) * lax.rsqrt(var + LN_EPS)).astype(x.dtype) * g + b


def _rope(x, positions):
    half = ROPE_DIMS // 2
    inv_freq = jnp.float32(ROPE_THETA) ** (-jnp.arange(half, dtype=jnp.float32) / half)
    ang = positions.astype(jnp.float32)[..., None] * inv_freq
    shape = ang.shape[:2] + (1,) * (x.ndim - 3) + (half,)
    cos = jnp.cos(ang).reshape(shape).astype(x.dtype)
    sin = jnp.sin(ang).reshape(shape).astype(x.dtype)
    x1, x2, rest = x[..., :half], x[..., half:ROPE_DIMS], x[..., ROPE_DIMS:]
    return jnp.concatenate([x1 * cos - x2 * sin, x1 * sin + x2 * cos, rest], axis=-1)


def _q_slice(t, q0):
    return lax.dynamic_slice_in_dim(t, q0, Q_BLOCK, axis=1)


def _unblock(out):
    nq, b, q = out.shape[:3]
    return jnp.moveaxis(out, 0, 1).reshape((b, nq * q) + out.shape[3:])


def _causal_sweep(block_fn, seq):
    outs = []
    for s0 in range(0, seq, SUPER_Q):
        n_b = min(SUPER_Q, seq - s0) // Q_BLOCK
        kl = s0 + n_b * Q_BLOCK
        outs.append(_unblock(lax.map(lambda i, s0=s0, kl=kl: block_fn(s0 + i * Q_BLOCK, kl),
                                     jnp.arange(n_b))))
    return jnp.concatenate(outs, axis=1)


def _suffix_sum(t):
    n_c = t.shape[-1] // SUFFIX_CHUNK
    tc = t.reshape(t.shape[:-1] + (n_c, SUFFIX_CHUNK))
    tri = jnp.asarray(np.tril(np.ones((SUFFIX_CHUNK, SUFFIX_CHUNK), np.float32)), dtype=t.dtype)
    within = jnp.einsum('...cj,ji->...ci', tc, tri)
    later_m = jnp.asarray(np.tril(np.ones((n_c, n_c), np.float32), -1), dtype=t.dtype)
    later = jnp.einsum('...c,cd->...d', within[..., 0], later_m)
    return (within + later[..., None]).reshape(t.shape)


def _masked_probs(s, mask):
    s = jnp.where(mask, s, NEG_INF)
    p = jnp.where(mask, jnp.exp(s - jnp.max(s, axis=-1, keepdims=True)), 0.0)
    return p / jnp.maximum(jnp.sum(p, axis=-1, keepdims=True), TINY)


_gather_rows = jax.vmap(lambda t, idx: t[idx])


def _nsa_attention(q, k_cmp_raw, v_cmp_raw, k_sel, v_sel, k_win, v_win, gates, pe_cmp, w_cmp1, w_cmp2):
    b_, s_, h_, d_ = q.shape
    scale = d_ ** -0.5
    n_cmp = (s_ - CMP_LEN) // CMP_STRIDE + 1
    n_sel = s_ // SEL_BLOCK
    top_n = min(SEL_TOPN, n_sel)
    cidx = np.arange(n_cmp)[:, None] * CMP_STRIDE + np.arange(CMP_LEN)[None, :]
    cmp_end = jnp.asarray(cidx[:, -1])
    sel_start = np.arange(n_sel) * SEL_BLOCK
    overlap = jnp.asarray(((cidx[:, :1] < sel_start[None, :] + SEL_BLOCK)
                           & (cidx[:, -1:] >= sel_start[None, :])).astype(np.float32))
    sel_ids = jnp.arange(n_sel)

    def compress(t, j):
        blocks = t[:, cidx] + pe_cmp[j]
        hid = jax.nn.gelu(blocks.reshape(b_, n_cmp, CMP_LEN * d_) @ w_cmp1[j])
        return hid @ w_cmp2[j]

    k_cmp = compress(k_cmp_raw, 0)
    v_cmp = compress(v_cmp_raw, 1)
    k_blk = k_sel.reshape(b_, n_sel, SEL_BLOCK, d_)
    v_blk = v_sel.reshape(b_, n_sel, SEL_BLOCK, d_)
    pad = ((0, 0), (WINDOW, 0), (0, 0))
    k_pad = jnp.pad(k_win, pad)
    v_pad = jnp.pad(v_win, pad)

    def block(i):
        q0 = i * Q_BLOCK
        qpos = q0 + jnp.arange(Q_BLOCK)
        qb = _q_slice(q, q0)
        gb = _q_slice(gates, q0)
        s_c = jnp.einsum('bqhd,bnd->bhqn', qb, k_cmp).astype(jnp.float32) * scale
        p_c = _masked_probs(s_c, cmp_end[None, :] <= qpos[:, None])
        o_c = jnp.einsum('bhqn,bnd->bqhd', p_c.astype(v_cmp.dtype), v_cmp)
        imp = jnp.einsum('bhqn,ns->bqs', p_c, overlap)
        q_blk = qpos[:, None] // SEL_BLOCK
        forced = (sel_ids[None, :] == 0) | (sel_ids[None, :] == q_blk) | (sel_ids[None, :] == q_blk - 1)
        imp = jnp.where(sel_ids[None, :] <= q_blk, imp + jnp.where(forced, FORCE_BONUS, 0.0), NEG_INF)
        _, top = lax.top_k(imp, top_n)
        kg = _gather_rows(k_blk, top).reshape(b_, Q_BLOCK, top_n * SEL_BLOCK, d_)
        vg = _gather_rows(v_blk, top).reshape(b_, Q_BLOCK, top_n * SEL_BLOCK, d_)
        tok = (top[..., None] * SEL_BLOCK + jnp.arange(SEL_BLOCK)).reshape(b_, Q_BLOCK, top_n * SEL_BLOCK)
        s_s = jnp.einsum('bqhd,bqkd->bhqk', qb, kg).astype(jnp.float32) * scale
        p_s = _masked_probs(s_s, (tok <= qpos[None, :, None])[:, None])
        o_s = jnp.einsum('bhqk,bqkd->bqhd', p_s.astype(vg.dtype), vg)
        kw = lax.dynamic_slice_in_dim(k_pad, q0, Q_BLOCK + WINDOW, axis=1)
        vw = lax.dynamic_slice_in_dim(v_pad, q0, Q_BLOCK + WINDOW, axis=1)
        wpos = q0 - WINDOW + jnp.arange(Q_BLOCK + WINDOW)
        m_w = (wpos[None, :] >= 0) & (wpos[None, :] <= qpos[:, None]) & (wpos[None, :] > qpos[:, None] - WINDOW)
        s_w = jnp.einsum('bqhd,bkd->bhqk', qb, kw).astype(jnp.float32) * scale
        p_w = _masked_probs(s_w, m_w)
        o_w = jnp.einsum('bhqk,bkd->bqhd', p_w.astype(vw.dtype), vw)
        return gb[..., 0:1] * o_c + gb[..., 1:2] * o_s + gb[..., 2:3] * o_w

    return _unblock(lax.map(block, jnp.arange(s_ // Q_BLOCK)))


def _stick_breaking_attention(q, k, v):
    scale = q.shape[-1] ** -0.5

    def block(q0, kl):
        qpos = q0 + jnp.arange(Q_BLOCK)
        mask = jnp.arange(kl)[None, :] < qpos[:, None]
        z = jnp.einsum('bqhd,bkhd->bhqk', _q_slice(q, q0), k[:, :kl]).astype(jnp.float32) * scale
        log_fail = jnp.where(mask, jax.nn.log_sigmoid(-z), 0.0)
        a = jnp.where(mask, jnp.exp(z + _suffix_sum(log_fail)), 0.0)
        return jnp.einsum('bhqk,bkhd->bqhd', a.astype(v.dtype), v[:, :kl])

    return _causal_sweep(block, q.shape[1])


def _forgetting_attention(q, k, v, log_f):
    scale = q.shape[-1] ** -0.5
    cum = jnp.moveaxis(jnp.cumsum(log_f, axis=1), 1, 2)

    def block(q0, kl):
        qpos = q0 + jnp.arange(Q_BLOCK)
        mask = jnp.arange(kl)[None, :] <= qpos[:, None]
        cq = lax.dynamic_slice_in_dim(cum, q0, Q_BLOCK, axis=2)
        s = (jnp.einsum('bqhd,bkhd->bhqk', _q_slice(q, q0), k[:, :kl]).astype(jnp.float32) * scale
             + (cq[:, :, :, None] - cum[:, :, None, :kl]))
        s = jnp.where(mask, s, NEG_INF)
        p = jnp.exp(s - jnp.max(s, axis=-1, keepdims=True))
        o = jnp.einsum('bhqk,bkhd->bqhd', p.astype(v.dtype), v[:, :kl])
        denom = jnp.moveaxis(jnp.sum(p, axis=-1), 1, 2)[..., None]
        return o / denom.astype(o.dtype)

    return _causal_sweep(block, q.shape[1])


def _dsa_attention(q, k, v, iq, ik, iw):
    s_ = q.shape[1]
    scale = q.shape[-1] ** -0.5
    idx_scale = (IDX_DIM ** -0.5) * (IDX_HEADS ** -0.5)
    topk = min(DSA_TOPK_MAX, s_ // 4)

    def block(q0, kl):
        qpos = q0 + jnp.arange(Q_BLOCK)
        rel = jax.nn.relu(jnp.einsum('bqhd,bkd->bqhk', _q_slice(iq, q0), ik[:, :kl])).astype(jnp.float32)
        score = jnp.einsum('bqh,bqhk->bqk', _q_slice(iw, q0).astype(jnp.float32), rel) * idx_scale
        score = jnp.where(jnp.arange(kl)[None, :] <= qpos[:, None], score, NEG_INF)
        _, sel = lax.top_k(score, topk)
        kg = _gather_rows(k, sel)
        vg = _gather_rows(v, sel)
        s = jnp.einsum('bqhd,bqkd->bhqk', _q_slice(q, q0), kg).astype(jnp.float32) * scale
        p = _masked_probs(s, (sel <= qpos[None, :, None])[:, None])
        return jnp.einsum('bhqk,bqkd->bqhd', p.astype(vg.dtype), vg)

    return _causal_sweep(block, s_)


def _token_mixer(x, positions, w_in, b_f, pe_cmp, w_cmp1, w_cmp2, w_gate, w_br, w_o):
    b_, s_, _ = x.shape
    p = dict(zip(IN_NAMES, jnp.split(x @ w_in, IN_SPLITS, axis=-1)))
    hd = lambda t: t.reshape(b_, s_, -1, HEAD_DIM)
    o_a = _nsa_attention(
        _rope(hd(p['a_q']), positions), p['a_k_cmp'], p['a_v_cmp'],
        _rope(p['a_k_sel'], positions), p['a_v_sel'], _rope(p['a_k_win'], positions), p['a_v_win'],
        jax.nn.sigmoid(p['a_gate'].reshape(b_, s_, HEADS_PER_MIXER, 3)), pe_cmp, w_cmp1, w_cmp2)
    o_b = _stick_breaking_attention(hd(p['b_q']), hd(p['b_k']), hd(p['b_v']))
    log_f = jax.nn.log_sigmoid((p['c_f'] + b_f).astype(jnp.float32))
    o_c = _forgetting_attention(hd(p['c_q']), hd(p['c_k']), hd(p['c_v']), log_f)
    o_d = _dsa_attention(
        _rope(hd(p['d_q']), positions), _rope(p['d_k'], positions), p['d_v'],
        _rope(p['d_iq'].reshape(b_, s_, IDX_HEADS, IDX_DIM), positions), _rope(p['d_ik'], positions), p['d_iw'])
    merged = sum(jax.nn.sigmoid(x @ w_gate[m]) * (o.reshape(b_, s_, MIX_WIDTH) @ w_br[m])
                 for m, o in enumerate((o_a, o_b, o_c, o_d)))
    return merged @ w_o


def _moe(x, w_router, router_bias, w_exp_gate, w_exp_up, w_exp_down, w_sh_gate, w_sh_up, w_sh_down):
    b_, s_, d_ = x.shape
    n_tok = b_ * s_
    xt = x.reshape(n_tok, d_)
    scores = jax.nn.sigmoid((xt @ w_router).astype(jnp.float32))
    biased = scores + router_bias.astype(jnp.float32)
    grp = biased.reshape(n_tok, N_GROUPS, N_EXPERTS // N_GROUPS)
    grp_score = jnp.sum(lax.top_k(grp, 2)[0], axis=-1)
    _, top_g = lax.top_k(grp_score, TOPK_GROUPS)
    gmask = jnp.any(top_g[..., :, None] == jnp.arange(N_GROUPS), axis=-2)
    emask = jnp.repeat(gmask, N_EXPERTS // N_GROUPS, axis=-1)
    _, eidx = lax.top_k(jnp.where(emask, biased, NEG_INF), TOP_K)
    w = jnp.take_along_axis(scores, eidx, axis=-1)
    w = w / jnp.sum(w, axis=-1, keepdims=True) * ROUTE_SCALE
    n_assign = n_tok * TOP_K
    flat_e = eidx.reshape(n_assign)
    flat_tok = jnp.repeat(jnp.arange(n_tok, dtype=jnp.int32), TOP_K)
    order = jnp.argsort(flat_e)
    sorted_e = flat_e[order]
    counts = jnp.bincount(flat_e, length=N_EXPERTS)
    padded = (counts + MOE_BLOCK - 1) // MOE_BLOCK * MOE_BLOCK
    pad_end = jnp.cumsum(padded)
    start = jnp.cumsum(counts) - counts
    dest = ((pad_end - padded)[sorted_e] + (jnp.arange(n_assign) - start[sorted_e])).astype(jnp.int32)
    n_slots = n_assign + N_EXPERTS * MOE_BLOCK
    n_blk = n_slots // MOE_BLOCK
    slot_tok = jnp.full((n_slots,), n_tok, jnp.int32).at[dest].set(flat_tok[order])
    blk_expert = jnp.minimum(jnp.searchsorted(pad_end, jnp.arange(n_blk) * MOE_BLOCK, side='right'),
                             N_EXPERTS - 1)
    x_pad = jnp.concatenate([xt, jnp.zeros((1, d_), xt.dtype)], axis=0)
    xs = x_pad[slot_tok].reshape(n_blk, MOE_BLOCK, d_)

    def expert_block(args):
        xb, e = args
        hb = jax.nn.silu(xb @ w_exp_gate[e]) * (xb @ w_exp_up[e])
        return hb @ w_exp_down[e]

    y_slots = lax.map(expert_block, (xs, blk_expert)).reshape(n_slots, d_)
    slot_of = jnp.zeros((n_assign,), jnp.int32).at[order].set(dest)
    routed = jnp.einsum('tk,tkd->td', w.astype(x.dtype), y_slots[slot_of].reshape(n_tok, TOP_K, d_))
    shared = (jax.nn.silu(xt @ w_sh_gate) * (xt @ w_sh_up)) @ w_sh_down
    return (routed + shared).reshape(b_, s_, d_)


def setup_inputs(seed: int = 0) -> dict:
    key = jax.random.key(seed)
    ks = jax.random.split(key, 24)
    nrm = lambda k, shape, scale: jax.random.normal(k, shape, jnp.float32) * scale
    x = nrm(ks[0], (BATCH, SEQ, D_MODEL), 1.0)
    offset = jax.random.randint(ks[1], (BATCH, 1), 0, 1024, dtype=jnp.int32)
    positions = offset + jnp.arange(SEQ, dtype=jnp.int32)[None, :]
    return {
        'x': x,
        'positions': positions,
        'w_in': nrm(ks[2], (DEPTH, D_MODEL, IN_WIDTH), D_MODEL ** -0.5),
        'b_f': 3.0 + nrm(ks[3], (DEPTH, HEADS_PER_MIXER), 0.5),
        'pe_cmp': nrm(ks[4], (DEPTH, 2, CMP_LEN, HEAD_DIM), 0.02),
        'w_cmp1': nrm(ks[5], (DEPTH, 2, CMP_LEN * HEAD_DIM, HEAD_DIM), (CMP_LEN * HEAD_DIM) ** -0.5),
        'w_cmp2': nrm(ks[6], (DEPTH, 2, HEAD_DIM, HEAD_DIM), HEAD_DIM ** -0.5),
        'w_gate': nrm(ks[7], (DEPTH, N_MIXERS, D_MODEL, D_MODEL), D_MODEL ** -0.5),
        'w_br': nrm(ks[8], (DEPTH, N_MIXERS, MIX_WIDTH, D_MODEL), MIX_WIDTH ** -0.5),
        'w_o': nrm(ks[9], (DEPTH, D_MODEL, D_MODEL), D_MODEL ** -0.5 * DEEPNORM_BETA),
        'ln1_g': 1.0 + nrm(ks[10], (DEPTH, D_MODEL), 0.01),
        'ln1_b': nrm(ks[11], (DEPTH, D_MODEL), 0.01),
        'w_router': nrm(ks[12], (DEPTH, D_MODEL, N_EXPERTS), D_MODEL ** -0.5),
        'router_bias': nrm(ks[13], (DEPTH, N_EXPERTS), 0.01),
        'w_exp_gate': nrm(ks[14], (DEPTH, N_EXPERTS, D_MODEL, D_EXPERT), D_MODEL ** -0.5),
        'w_exp_up': nrm(ks[15], (DEPTH, N_EXPERTS, D_MODEL, D_EXPERT), D_MODEL ** -0.5),
        'w_exp_down': nrm(ks[16], (DEPTH, N_EXPERTS, D_EXPERT, D_MODEL), D_EXPERT ** -0.5 * DEEPNORM_BETA),
        'w_sh_gate': nrm(ks[17], (DEPTH, D_MODEL, D_EXPERT), D_MODEL ** -0.5),
        'w_sh_up': nrm(ks[18], (DEPTH, D_MODEL, D_EXPERT), D_MODEL ** -0.5),
        'w_sh_down': nrm(ks[19], (DEPTH, D_EXPERT, D_MODEL), D_EXPERT ** -0.5 * DEEPNORM_BETA),
        'ln2_g': 1.0 + nrm(ks[20], (DEPTH, D_MODEL), 0.01),
        'ln2_b': nrm(ks[21], (DEPTH, D_MODEL), 0.01),
    }


def reference(x, positions, w_in, b_f, pe_cmp, w_cmp1, w_cmp2, w_gate, w_br, w_o, ln1_g, ln1_b,
              w_router, router_bias, w_exp_gate, w_exp_up, w_exp_down, w_sh_gate, w_sh_up, w_sh_down,
              ln2_g, ln2_b):
    for l in range(DEPTH):
        mix = _token_mixer(x, positions, w_in[l], b_f[l], pe_cmp[l], w_cmp1[l], w_cmp2[l],
                           w_gate[l], w_br[l], w_o[l])
        x = _layer_norm(DEEPNORM_ALPHA * x + mix, ln1_g[l], ln1_b[l])
        ffn = _moe(x, w_router[l], router_bias[l], w_exp_gate[l], w_exp_up[l], w_exp_down[l],
                   w_sh_gate[l], w_sh_up[l], w_sh_down[l])
        x = _layer_norm(DEEPNORM_ALPHA * x + ffn, ln2_g[l], ln2_b[l])
    return x
```

```cpp
#include <hip/hip_runtime.h>
#include <cstdio>
#include <cstdint>

#define GAS __attribute__((address_space(1)))
#define LAS __attribute__((address_space(3)))
typedef unsigned short bf16;
typedef short bf16x8 __attribute__((ext_vector_type(8)));
typedef float f32x4 __attribute__((ext_vector_type(4)));
typedef float f32x2 __attribute__((ext_vector_type(2)));
typedef float f32x16 __attribute__((ext_vector_type(16)));
typedef unsigned u32x4 __attribute__((ext_vector_type(4)));
typedef unsigned u32x2 __attribute__((ext_vector_type(2)));
typedef __bf16 bf16x2_t __attribute__((ext_vector_type(2)));
typedef GAS unsigned gu32;

#define DI __device__ __forceinline__
#define LDS_WAIT() asm volatile("s_waitcnt lgkmcnt(0)" ::: "memory")
#define VM_WAIT() asm volatile("s_waitcnt vmcnt(0)" ::: "memory")
#define RLX_AGENT __ATOMIC_RELAXED, __HIP_MEMORY_SCOPE_AGENT

constexpr int NBATCH = 8, SEQ = 8192, NTOK = NBATCH * SEQ, DM = 1024, DEPTH = 4;
constexpr int PW = 3136;
constexpr int C_AQ = 0, C_BQ = 256, C_BK = 512, C_BV = 768, C_CQ = 1024, C_CK = 1280, C_CV = 1536, C_DQ = 1792, C_DIQ = 2048,
              C_AKC = 2304, C_AVC = 2368, C_AKS = 2432, C_AVS = 2496, C_AKW = 2560, C_AVW = 2624, C_DK = 2688, C_DV = 2752, C_DIK = 2816, C_SM = 2880;
constexpr int IN_W = 2900;
constexpr float QS = 0.18033688011112042f;
constexpr float LOG2E = 1.4426950408889634f;
constexpr float ALPHA = 1.681792830507429f;
constexpr float LN_EPS = 1e-5f;
constexpr int NEXP = 64, NCH = 2, CHTOK = NTOK / NCH;
constexpr int NPL = 12 + 2 * NCH;
constexpr int NPHASE = 1 + DEPTH * NPL;
constexpr int NWAVES = 8;

constexpr size_t MiB = 1u << 20;
constexpr size_t WS_CTL = 0, CTL_ZERO_BYTES = 1 * MiB;
constexpr size_t WS_ROPE = 1 * MiB;
constexpr size_t WS_SM32 = 5 * MiB;
constexpr size_t WS_GATE = 13 * MiB;
constexpr size_t WS_LOGF = 16 * MiB;
constexpr size_t WS_CUM  = 17 * MiB;
constexpr size_t WS_IW   = 18 * MiB;
constexpr size_t WS_HID  = 19 * MiB;
constexpr size_t WS_KCMP = 21 * MiB;
constexpr size_t WS_VTCMP = 21 * MiB + 512 * 1024;
constexpr size_t WS_CBIAS = 22 * MiB;
constexpr size_t WS_KCR  = 23 * MiB;
constexpr size_t WS_VCR  = 32 * MiB;
constexpr size_t WS_VT   = 41 * MiB;
constexpr size_t WS_VTB = WS_VT, WS_VTC = WS_VT + 32 * MiB, WS_VTAS = WS_VT + 64 * MiB, WS_VTAW = WS_VT + 72 * MiB;
constexpr size_t WS_LOGIT = WS_VT;
constexpr size_t WS_TOKINFO = WS_VT + 16 * MiB;
constexpr size_t WS_LIST = WS_VT + 20 * MiB;
constexpr size_t WS_W    = 121 * MiB;
constexpr size_t W_IN = WS_W, W_G = WS_W + 6 * MiB, W_BR = WS_W + 14 * MiB, W_O = WS_W + 16 * MiB, W_C1 = WS_W + 18 * MiB,
                 W_RH = WS_W + 20 * MiB, W_RL = WS_W + 20 * MiB + 512 * 1024, W_1 = WS_W + 21 * MiB, W_2 = WS_W + 86 * MiB;
constexpr size_t WS_XB   = 243 * MiB;
constexpr size_t WS_A    = 371 * MiB;
constexpr size_t WS_B    = 763 * MiB;
constexpr size_t WS_C    = 891 * MiB;
constexpr size_t WS_END  = 1019 * MiB;
constexpr size_t WS_KTS = WS_C, WS_KTW = WS_C + 8 * MiB, WS_IKT = WS_C + 16 * MiB, WS_KTB = WS_C + 32 * MiB, WS_KTC = WS_C + 64 * MiB;
constexpr size_t WS_XL = WS_A, WS_HB = WS_A, WS_Y = WS_A + 320 * MiB;
static_assert(WS_Y + (size_t)(CHTOK * 8 / 256 + 64 + CHTOK / 256) * 256 * DM <= WS_END, "tile-padded fp8 y chunk fits");
constexpr int HB_TILES = NTOK * 8 / 256 + NCH * 64 + NTOK / 256;
static_assert((size_t)HB_TILES * 256 * 512 <= 320 * MiB, "hbuf fits");

constexpr int CW_BAR = 4096;
constexpr int CW_CNT = 16384;
constexpr int CW_KMAX = 32768;

constexpr int RING_BYTES = 131072;
constexpr int MISC_OFF = 162816;
constexpr int LDS_BYTES = 163840;

DI unsigned cvtpk(float lo, float hi) { f32x2 v = {lo, hi}; bf16x2_t b = __builtin_convertvector(v, bf16x2_t); return __builtin_bit_cast(unsigned, b); }
DI u32x4 pack8(const f32x4& v0, const f32x4& v1) { u32x4 w; w.x = cvtpk(v0[0], v0[1]); w.y = cvtpk(v0[2], v0[3]); w.z = cvtpk(v1[0], v1[1]); w.w = cvtpk(v1[2], v1[3]); return w; }
DI float bf2f(unsigned short h) { return __uint_as_float(((unsigned)h) << 16); }
DI float bflo(unsigned w) { return __uint_as_float(w << 16); }
DI float bfhi(unsigned w) { return __uint_as_float(w & 0xffff0000u); }
DI float fexp2(float x) { return __builtin_amdgcn_exp2f(x); }
DI float flog2(float x) { return __builtin_amdgcn_logf(x); }
DI float frcp(float x) { return __builtin_amdgcn_rcpf(x); }
DI float sigmoidf_(float x) { return frcp(1.f + fexp2(-x * LOG2E)); }
#define DPPF(v, ctrl, rm, bc) __int_as_float(__builtin_amdgcn_update_dpp(0, __float_as_int(v), (ctrl), (rm), 0xF, (bc)))
#define DPPI(v, ctrl, rm, bc) __builtin_amdgcn_update_dpp(0, (v), (ctrl), (rm), 0xF, (bc))
DI float dpp_xor1(float v) { return DPPF(v, 0xB1, 0xF, true); }
DI float dpp_xor2(float v) { return DPPF(v, 0x4E, 0xF, true); }
DI float red16_sum(float v) { const auto r = __builtin_amdgcn_permlane16_swap(__float_as_uint(v), __float_as_uint(v), false, false); return __uint_as_float(r[0]) + __uint_as_float(r[1]); }
DI float red16_max(float v) { const auto r = __builtin_amdgcn_permlane16_swap(__float_as_uint(v), __float_as_uint(v), false, false); return fmaxf(__uint_as_float(r[0]), __uint_as_float(r[1])); }
DI float red32_sum(float v) { const auto r = __builtin_amdgcn_permlane32_swap(__float_as_uint(v), __float_as_uint(v), false, false); return __uint_as_float(r[0]) + __uint_as_float(r[1]); }
DI float red32_max(float v) { const auto r = __builtin_amdgcn_permlane32_swap(__float_as_uint(v), __float_as_uint(v), false, false); return fmaxf(__uint_as_float(r[0]), __uint_as_float(r[1])); }
DI float wave_sum(float v) {
    v += dpp_xor1(v); v += dpp_xor2(v); v += DPPF(v, 0x124, 0xF, true); v += DPPF(v, 0x128, 0xF, true);
    v = red16_sum(v); return red32_sum(v);
}
DI float wave_max(float v) {
    v = fmaxf(v, dpp_xor1(v)); v = fmaxf(v, dpp_xor2(v)); v = fmaxf(v, DPPF(v, 0x124, 0xF, true)); v = fmaxf(v, DPPF(v, 0x128, 0xF, true));
    v = red16_max(v); return red32_max(v);
}
DI int wave_incl_scan(int v) {
    v += DPPI(v, 0x111, 0xF, true); v += DPPI(v, 0x112, 0xF, true); v += DPPI(v, 0x114, 0xF, true); v += DPPI(v, 0x118, 0xF, true);
    v += DPPI(v, 0x142, 0xA, false);
    v += DPPI(v, 0x143, 0xC, false);
    return v;
}
DI float wave_incl_scan_f(float v) {
    v += DPPF(v, 0x111, 0xF, true); v += DPPF(v, 0x112, 0xF, true); v += DPPF(v, 0x114, 0xF, true); v += DPPF(v, 0x118, 0xF, true);
    v += DPPF(v, 0x142, 0xA, false); v += DPPF(v, 0x143, 0xC, false);
    return v;
}
DI int ltid() { int t = threadIdx.x; asm volatile("" : "+v"(t)); return t; }
DI int lbid() { int b = blockIdx.x; asm volatile("" : "+s"(b)); return b; }
DI int lgrid() { int g = gridDim.x; asm volatile("" : "+s"(g)); return g; }
DI f32x16 mfma32(bf16x8 a, bf16x8 b, f32x16 c) { return __builtin_amdgcn_mfma_f32_32x32x16_bf16(a, b, c, 0, 0, 0); }
DI f32x4 mfma16(bf16x8 a, bf16x8 b, f32x4 c) { return __builtin_amdgcn_mfma_f32_16x16x32_bf16(a, b, c, 0, 0, 0); }

#define XB_TMO      128
#define XB_XCNT(j)  (256  + 64 * (j))
#define XB_XSUB(j)  (1280 + 64 * (j))
#define XB_XGEN(j)  (2304 + 64 * (j))
#define XB_TOP      3328
#define XB_TOPGEN   3392
#define XCD_BAR_WORDS 3456
#define XB_SPIN_CAP (1u << 22)
DI unsigned xb_ld(unsigned* p)              { return __hip_atomic_load(p, __ATOMIC_RELAXED, __HIP_MEMORY_SCOPE_AGENT); }
DI unsigned xb_add(unsigned* p, unsigned v) { return __hip_atomic_fetch_add(p, v, __ATOMIC_RELAXED, __HIP_MEMORY_SCOPE_AGENT); }
DI unsigned xb_xcc_id() { return (unsigned)__builtin_amdgcn_s_getreg((3 << 11) | 20) & 0xFu; }
#define XB_SPIN(cond, bar) do { unsigned _sp = 0; while (cond) { __builtin_amdgcn_s_sleep(1); \
    if ((++_sp & 255u) == 0u) { if (xb_ld(&(bar)[XB_TMO])) break; if (_sp > XB_SPIN_CAP) { atomicAdd(&(bar)[XB_TMO], 1u); break; } } } } while (0)
struct XcdBarrier { unsigned* bar; unsigned x; volatile LAS unsigned* st; };
DI XcdBarrier xcd_barrier_post(unsigned* bar, volatile LAS unsigned* st) {
    XcdBarrier b; b.bar = bar; b.x = xb_xcc_id(); b.st = st;
    if (threadIdx.x == 0) (void)xb_add(&bar[XB_XCNT(b.x)], 1u);
    return b;
}
DI void xcd_barrier_complete(unsigned* bar, unsigned x, unsigned& nloc, unsigned& nx) {
    const unsigned G = gridDim.x * gridDim.y * gridDim.z;
    unsigned sum, cnt, mine, sp = 0u;
    for (;;) {
        sum = 0u; cnt = 0u; mine = 0u;
#pragma unroll
        for (unsigned j = 0; j < 16; ++j) { const unsigned c = xb_ld(&bar[XB_XCNT(j)]); sum += c; cnt += (c > 0u) ? 1u : 0u; mine = (j == x) ? c : mine; }
        if (sum == G) break;
        __builtin_amdgcn_s_sleep(1);
        if ((++sp & 255u) == 0u) { if (xb_ld(&bar[XB_TMO])) break; if (sp > XB_SPIN_CAP) { atomicAdd(&bar[XB_TMO], 1u); break; } }
    }
    nloc = mine > 0u ? mine : 1u; nx = cnt > 0u ? cnt : 1u;
}
DI void xcd_barrier(const XcdBarrier& b) {
    asm volatile("s_waitcnt vmcnt(0)" ::: "memory");
    __syncthreads();
    if (threadIdx.x == 0) {
        unsigned* bar = b.bar;
        __builtin_amdgcn_s_waitcnt(0);
        unsigned nloc = b.st[0], nx = b.st[1];
        if (nloc == 0u) { xcd_barrier_complete(bar, b.x, nloc, nx); b.st[0] = nloc; b.st[1] = nx; }
        const unsigned old = xb_add(&bar[XB_XSUB(b.x)], 1u);
        const unsigned gen = old / nloc;
        if (old + 1u == (gen + 1u) * nloc) {
            __builtin_amdgcn_fence(__ATOMIC_RELEASE, "agent");
            asm volatile("s_waitcnt vmcnt(0)" ::: "memory");
            const unsigned og = xb_add(&bar[XB_TOP], 1u);
            const unsigned tg = og / nx;
            if (og + 1u == (tg + 1u) * nx) xb_add(&bar[XB_TOPGEN], 1u);
            else XB_SPIN(xb_ld(&bar[XB_TOPGEN]) == tg, bar);
            __builtin_amdgcn_fence(__ATOMIC_ACQUIRE, "agent");
            xb_add(&bar[XB_XGEN(b.x)], 1u);
            asm volatile("s_waitcnt vmcnt(0)" ::: "memory");
        } else {
            XB_SPIN(xb_ld(&bar[XB_XGEN(b.x)]) == gen, bar);
            __builtin_amdgcn_fence(__ATOMIC_ACQUIRE, "agent");
            asm volatile("s_waitcnt vmcnt(0)" ::: "memory");
        }
    }
    __syncthreads();
}

namespace gs {
constexpr int BM = 256, BK = 64, HALF = 128, HTB = HALF * BK * 2, NXCD = 8, WGM = 8;
__host__ __device__ __forceinline__ int lds_byte(int r, int c) { const int st = (r >> 4) * 2 + (c >> 5), rr = r & 15, cc = c & 31, ob = rr * 64 + cc * 2; return st * 1024 + (ob ^ (((ob >> 9) & 1) << 5)); }
__host__ __device__ __forceinline__ void stage_rc(int b, int& R, int& C) { const int st = b / 1024, sb = b % 1024, swz = sb ^ (((sb >> 9) & 1) << 5); R = (st >> 1) * 16 + swz / 64; C = (st & 1) * 32 + (swz % 64) / 2; }
__host__ __device__ __forceinline__ int perm32(int rho) { const int n = rho >> 4, i = rho & 15; return 8 * (i >> 2) + 4 * n + (i & 3); }
__host__ __device__ __forceinline__ int bh8row(int R) { return (R >> 5) * 64 + 16 * ((R & 15) >> 2) + 4 * ((R >> 4) & 1) + (R & 3); }

struct GU {
    unsigned A, B; const int* idx;
    unsigned lda, ldb;
    int nt;
    int flags;
    int nvalid;
    int a0, a1, a2, a3;
};
struct Unit { int pm, pn; };
struct StaticOrder {
    int nM, nN, nwg, G, c;
    DI void init(int M, int N, int G_, int c_) { nM = M / BM; nN = N / BM; nwg = nM * nN; G = G_; c = c_; }
    DI bool next(int i, Unit& u) const {
        const long L = (long)i * G + c; if (L >= nwg) return false;
        int wgid = (int)L; { const int q = nwg / NXCD, r = nwg % NXCD, xcd = wgid % NXCD, off = wgid / NXCD; wgid = (xcd < r ? xcd * (q + 1) : r * (q + 1) + (xcd - r) * q) + off; }
        const int nig = WGM * nN, gid = wgid / nig, fm = gid * WGM, gsz = (nM - fm) < WGM ? (nM - fm) : WGM;
        u.pm = fm + ((wgid % nig) % gsz); u.pn = (wgid % nig) / gsz; return true;
    }
};

template <class Sched, class Epi, int NBH>
DI void gemm_stream(LAS unsigned char* lds, const char* wsb, Sched& S, Epi& E) {
    constexpr bool GATH = Sched::GATHER, FIXED = Sched::FIXED;
    const int tid = ltid(), wid = __builtin_amdgcn_readfirstlane(tid >> 6), lane = tid & 63, wr = wid >> 2, wc = wid & 3, fr = lane & 15, fq = lane >> 4;
    int R0, C0, R1, C1; stage_rc(tid * 16, R0, C0); stage_rc(tid * 16 + 8192, R1, C1);
    const unsigned Rb0 = Epi::BH8 ? (unsigned)bh8row(R0) : Epi::PERM ? ((R0 & ~31) + perm32(R0 & 31)) : R0, Rb1 = Epi::BH8 ? (unsigned)bh8row(R1) : Epi::PERM ? ((R1 & ~31) + perm32(R1 & 31)) : R1;
    constexpr unsigned BHS = Epi::BH8 ? 8u : (unsigned)HALF;
    const unsigned C0b = (unsigned)C0 * 2u, C1b = (unsigned)C1 * 2u;
    const unsigned ldsw = (unsigned)wid * 1024u;
    const int aoff = lds_byte(wr * 64 + fr, fq * 8), boff = lds_byte(wc * 32 + fr, fq * 8);
#define GS_SA(b, h) (((b) * 2 + (h)) * HTB)
#define GS_SB(b, h) ((4 + (b) * 2 + (h)) * HTB)
#define GS_STG_O(bufoff, gbase, o0, o1) do { \
        unsigned _q0 = (gbase) + (o0), _q1 = (gbase) + (o1); asm volatile("" : "+v"(_q0), "+v"(_q1)); \
        __builtin_amdgcn_global_load_lds((const unsigned*)(wsb + (size_t)_q0), (LAS unsigned*)(lds + (bufoff) + ldsw), 16, 0, 0); \
        __builtin_amdgcn_global_load_lds((const unsigned*)(wsb + (size_t)_q1), (LAS unsigned*)(lds + (bufoff) + ldsw + 8192), 16, 0, 0); } while (0)
#define GS_STGA(bufoff, gbase, h, r0, r1, ld) do { if constexpr (FIXED) GS_STG_O(bufoff, (gbase) + (unsigned)(h) * HALF * (ld), fa0, fa1); \
        else GS_STG_O(bufoff, gbase, (unsigned)(r0) * (ld) + C0b, (unsigned)(r1) * (ld) + C1b); } while (0)
#define GS_STGB(bufoff, gbase, h, ld) do { if constexpr (FIXED) GS_STG_O(bufoff, (gbase) + (unsigned)(h) * BHS * (ld), fb0, fb1); \
        else GS_STG_O(bufoff, (gbase) + (unsigned)(h) * BHS * (ld), Rb0 * (ld) + C0b, Rb1 * (ld) + C1b); } while (0)
#define GS_LDA(dst, b, h) do { _Pragma("unroll") for (int m = 0; m < 4; ++m) _Pragma("unroll") for (int k = 0; k < 2; ++k) dst[m][k] = *(const LAS bf16x8*)(lds + GS_SA(b, h) + aoff + m * 2048 + k * 1024); } while (0)
#define GS_LDB(dst, b, h) do { _Pragma("unroll") for (int n = 0; n < 2; ++n) _Pragma("unroll") for (int k = 0; k < 2; ++k) dst[n][k] = *(const LAS bf16x8*)(lds + GS_SB(b, h) + boff + n * 2048 + k * 1024); } while (0)
#define GS_MMA(ai, bj, At, Bt) do { __builtin_amdgcn_s_setprio(1); _Pragma("unroll") for (int m = 0; m < 4; ++m) _Pragma("unroll") for (int n = 0; n < 2; ++n) _Pragma("unroll") for (int k = 0; k < 2; ++k) \
        acc[ai][bj][m][n] = __builtin_amdgcn_mfma_f32_16x16x32_bf16(Bt[n][k], At[m][k], acc[ai][bj][m][n], 0, 0, 0); __builtin_amdgcn_s_setprio(0); } while (0)
#define GS_WAIT_V(n) asm volatile("s_waitcnt vmcnt(" #n ")" ::: "memory")
#define GS_WAIT_L(n) asm volatile("s_waitcnt lgkmcnt(" #n ")" ::: "memory")
#define GS_BAR __builtin_amdgcn_s_barrier()
#define GS_SCHED __builtin_amdgcn_sched_barrier(0)
#define GS_ROWS(u, ia) do { if (GATH) { if ((u).idx) { \
            ia[0] = R0 < (u).nvalid ? (unsigned)(u).idx[R0] : 0u; ia[1] = R1 < (u).nvalid ? (unsigned)(u).idx[R1] : 0u; \
            ia[2] = HALF + R0 < (u).nvalid ? (unsigned)(u).idx[HALF + R0] : 0u; ia[3] = HALF + R1 < (u).nvalid ? (unsigned)(u).idx[HALF + R1] : 0u; } \
        else { ia[0] = R0; ia[1] = R1; ia[2] = HALF + R0; ia[3] = HALF + R1; } } } while (0)
    GU cur, nxt; int ui = 0;
    if (!S.next(0, cur)) return;
    f32x4 acc[2][NBH][4][2];
#pragma unroll
    for (int a = 0; a < 2; ++a)
#pragma unroll
        for (int b = 0; b < NBH; ++b)
#pragma unroll
            for (int m = 0; m < 4; ++m)
#pragma unroll
                for (int n = 0; n < 2; ++n) acc[a][b][m][n] = (f32x4){0.f, 0.f, 0.f, 0.f};
    bf16x8 At[4][2], B0[2][2], B1[2][2];
    unsigned ia[4] = {(unsigned)R0, (unsigned)R1, (unsigned)(HALF + R0), (unsigned)(HALF + R1)}, na[4] = {(unsigned)R0, (unsigned)R1, (unsigned)(HALF + R0), (unsigned)(HALF + R1)};
    GS_ROWS(cur, ia);
    unsigned cA = cur.A, cB = cur.B;
    unsigned lda = cur.lda, ldb = cur.ldb;
    const unsigned fa0 = (unsigned)R0 * lda + C0b, fa1 = (unsigned)R1 * lda + C1b, fb0 = Rb0 * ldb + C0b, fb1 = Rb1 * ldb + C1b;
    if constexpr (NBH == 2) {
        GS_STGB(GS_SB(0, 0), cB, 0, ldb); GS_STGB(GS_SB(0, 1), cB, 1, ldb); GS_STGA(GS_SA(0, 0), cA, 0, ia[0], ia[1], lda); GS_STGA(GS_SA(0, 1), cA, 1, ia[2], ia[3], lda);
        if (wr == 1) GS_BAR;
        GS_WAIT_V(2); GS_BAR;
        GS_STGB(GS_SB(1, 0), cB + 128, 0, ldb); GS_STGA(GS_SA(1, 0), cA + 128, 0, ia[0], ia[1], lda); GS_STGB(GS_SB(1, 1), cB + 128, 1, ldb);
        GS_WAIT_V(6); GS_BAR;
    } else {
        GS_STGB(GS_SB(0, 0), cB, 0, ldb); GS_STGA(GS_SA(0, 0), cA, 0, ia[0], ia[1], lda); GS_STGA(GS_SA(0, 1), cA, 1, ia[2], ia[3], lda);
        if (wr == 1) GS_BAR;
        GS_WAIT_V(2); GS_BAR;
        GS_STGB(GS_SB(1, 0), cB + 128, 0, ldb); GS_STGA(GS_SA(1, 0), cA + 128, 0, ia[0], ia[1], lda);
        GS_WAIT_V(4); GS_BAR;
    }
    for (;;) {
        const bool has_next = S.next(ui + 1, nxt);
        unsigned nA = cA, nB = cB, nlda = lda, nldb = ldb;
        if (has_next) { GS_ROWS(nxt, na); nA = nxt.A; nB = nxt.B; nlda = nxt.lda; nldb = nxt.ldb; }
        else if (GATH) { na[0] = ia[0]; na[1] = ia[1]; na[2] = ia[2]; na[3] = ia[3]; }
        const int nt = cur.nt;
        for (int t = 0; t < nt; t += 2) {
            const bool last = (t == nt - 2);
            const unsigned a1 = cA + (unsigned)(t + 1) * 128u;
            const unsigned a2 = last ? nA : cA + (unsigned)(t + 2) * 128u, b2 = last ? nB : cB + (unsigned)(t + 2) * 128u;
            const unsigned a3 = a2 + 128u, b3 = b2 + 128u;
            const unsigned xlda = last ? nlda : lda, xldb = last ? nldb : ldb;
            unsigned x0, x1, x2, x3;
            if (GATH) { x0 = last ? na[0] : ia[0]; x1 = last ? na[1] : ia[1]; x2 = last ? na[2] : ia[2]; x3 = last ? na[3] : ia[3]; }
            else { x0 = R0; x1 = R1; x2 = HALF + R0; x3 = HALF + R1; }
            if constexpr (NBH == 2) {
                GS_LDB(B0, 0, 0); GS_LDB(B1, 0, 1); GS_SCHED; GS_LDA(At, 0, 0); GS_STGA(GS_SA(1, 1), a1, 1, ia[2], ia[3], lda);
                GS_WAIT_V(8); GS_WAIT_L(0); GS_BAR; GS_MMA(0, 0, At, B0); GS_MMA(0, 1, At, B1); GS_BAR; GS_SCHED;
                GS_LDA(At, 0, 1); GS_STGB(GS_SB(0, 0), b2, 0, xldb); GS_STGB(GS_SB(0, 1), b2, 1, xldb); GS_STGA(GS_SA(0, 0), a2, 0, x0, x1, xlda);
                GS_WAIT_V(8); GS_WAIT_L(0); GS_BAR; GS_MMA(1, 0, At, B0); GS_MMA(1, 1, At, B1); GS_BAR; GS_SCHED;
                GS_LDB(B0, 1, 0); GS_LDB(B1, 1, 1); GS_SCHED; GS_LDA(At, 1, 0); GS_STGA(GS_SA(0, 1), a2, 1, x2, x3, xlda);
                GS_WAIT_V(8); GS_WAIT_L(0); GS_BAR; GS_MMA(0, 0, At, B0); GS_MMA(0, 1, At, B1); GS_BAR; GS_SCHED;
                GS_LDA(At, 1, 1); GS_STGB(GS_SB(1, 0), b3, 0, xldb); GS_STGB(GS_SB(1, 1), b3, 1, xldb); GS_STGA(GS_SA(1, 0), a3, 0, x0, x1, xlda);
                GS_WAIT_V(8); GS_WAIT_L(0); GS_BAR; GS_MMA(1, 0, At, B0); GS_MMA(1, 1, At, B1); GS_BAR; GS_SCHED;
            } else {
                GS_LDB(B0, 0, 0); GS_SCHED; GS_LDA(At, 0, 0); GS_STGA(GS_SA(1, 1), a1, 1, ia[2], ia[3], lda);
                GS_WAIT_V(6); GS_WAIT_L(0); GS_BAR; GS_MMA(0, 0, At, B0); GS_BAR; GS_SCHED;
                GS_LDA(At, 0, 1); GS_STGB(GS_SB(0, 0), b2, 0, xldb); GS_STGA(GS_SA(0, 0), a2, 0, x0, x1, xlda);
                GS_WAIT_V(6); GS_WAIT_L(0); GS_BAR; GS_MMA(1, 0, At, B0); GS_BAR; GS_SCHED;
                GS_LDB(B0, 1, 0); GS_SCHED; GS_LDA(At, 1, 0); GS_STGA(GS_SA(0, 1), a2, 1, x2, x3, xlda);
                GS_WAIT_V(6); GS_WAIT_L(0); GS_BAR; GS_MMA(0, 0, At, B0); GS_BAR; GS_SCHED;
                GS_LDA(At, 1, 1); GS_STGB(GS_SB(1, 0), b3, 0, xldb); GS_STGA(GS_SA(1, 0), a3, 0, x0, x1, xlda);
                GS_WAIT_V(6); GS_WAIT_L(0); GS_BAR; GS_MMA(1, 0, At, B0); GS_BAR; GS_SCHED;
            }
        }
        if (cur.flags & 2) {
            if (wr == 0) GS_BAR;
            E(acc, cur, wr, wc, fr, fq);
        }
        if (!has_next) break;
        if (nxt.flags & 1) {
#pragma unroll
            for (int a = 0; a < 2; ++a)
#pragma unroll
                for (int b = 0; b < NBH; ++b)
#pragma unroll
                    for (int m = 0; m < 4; ++m)
#pragma unroll
                        for (int n = 0; n < 2; ++n) acc[a][b][m][n] = (f32x4){0.f, 0.f, 0.f, 0.f};
        }
        const bool did_epi = (cur.flags & 2) != 0;
        cur = nxt; cA = nA; cB = nB; lda = nlda; ldb = nldb; ++ui;
        if (GATH) { ia[0] = na[0]; ia[1] = na[1]; ia[2] = na[2]; ia[3] = na[3]; }
        if (did_epi) { if (wr == 1) GS_BAR; }
    }
    GS_WAIT_V(0);
    if (!(cur.flags & 2)) { if (wr == 0) GS_BAR; }
    GS_BAR;
#undef GS_SA
#undef GS_SB
#undef GS_STG_O
#undef GS_STGA
#undef GS_STGB
#undef GS_LDA
#undef GS_LDB
#undef GS_MMA
#undef GS_WAIT_V
#undef GS_WAIT_L
#undef GS_BAR
#undef GS_SCHED
#undef GS_ROWS
}
}

struct Args {
    const float* x; const int* pos; const float* w_in; const float* b_f; const float* pe_cmp; const float* w_cmp1; const float* w_cmp2;
    const float* w_gate; const float* w_br; const float* w_o; const float* ln1_g; const float* ln1_b; const float* w_router; const float* router_bias;
    const float* w_eg; const float* w_eu; const float* w_ed; const float* w_sg; const float* w_su; const float* w_sd; const float* ln2_g; const float* ln2_b;
    float* out; unsigned char* ws; int ph_lo, ph_hi;
};

DI void ph_prologue(const Args& a, int gw, int NGW, int lane) {
    bf16* xb = (bf16*)(a.ws + WS_XB);
    for (int row = gw; row < NTOK; row += NGW) {
        const f32x4* xr = (const f32x4*)(a.x + (size_t)row * DM) + lane;
        u32x2* o = (u32x2*)(xb + (size_t)row * DM) + lane;
#pragma unroll
        for (int j = 0; j < 4; ++j) { const f32x4 v = xr[64 * j]; u32x2 w; w.x = cvtpk(v.x, v.y); w.y = cvtpk(v.z, v.w); o[64 * j] = w; }
    }
    float* rope = (float*)(a.ws + WS_ROPE);
    constexpr float INVF[8] = {1.0f, 0.1939227432012558f, 0.03760603070259094f, 0.007292664609849453f, 0.0014142135623842478f, 0.00027424818836152554f, 5.318296098266728e-05f, 1.0313386155758053e-05f};
    for (int i = gw * 64 + lane; i < NTOK; i += NGW * 64) {
        const float p = (float)a.pos[i];
#pragma unroll
        for (int j = 0; j < 8; ++j) {
            const float ang = p * INVF[j];
            const double rev = (double)ang * 0.15915494309189535;
            const float fr = (float)(rev - __builtin_rint(rev));
            rope[(size_t)i * 16 + j] = __builtin_amdgcn_cosf(fr);
            rope[(size_t)i * 16 + 8 + j] = __builtin_amdgcn_sinf(fr);
        }
    }
}

constexpr float Y_SCALE = 16.f;
struct CvtItem { const float* W; bf16* WT; int N, n0, nv, k0, dK, drow0, mode; float scale; };
__device__ const int SEG_SRC[21] = {0, 652, 908, 1164, 1420, 1676, 1932, 2192, 2576, 256, 320, 384, 448, 512, 576, 2448, 2512, 2832, 640, 2188, 2896};
__device__ const int SEG_DST[21] = {C_AQ, C_BQ, C_BK, C_BV, C_CQ, C_CK, C_CV, C_DQ, C_DIQ, C_AKC, C_AVC, C_AKS, C_AVS, C_AKW, C_AVW, C_DK, C_DV, C_DIK, 2880, 2892, 2896};
constexpr int CVT_I_IN = 93 * 16, CVT_I_G = 2048, CVT_I_BR = 512, CVT_I_O = 512, CVT_I_C1 = 128, CVT_I_R = 64, CVT_I_E = 65 * 384, CVT_I_CB = 2;
constexpr int CVT_NIT = CVT_I_IN + CVT_I_G + CVT_I_BR + CVT_I_O + CVT_I_C1 + CVT_I_R + CVT_I_E + CVT_I_CB;
DI CvtItem cvt_decode(const Args& a, int l, int it) {
    unsigned char* ws = a.ws; CvtItem c; c.mode = 0; c.nv = 32; c.scale = 1.f;
    int r = it;
    if (r < CVT_I_IN) {
        const int kb = r / 93, ci = r % 93; int seg, off;
        if (ci < 72) { seg = ci >> 3; off = (ci & 7) * 32; } else if (ci < 90) { seg = 9 + ((ci - 72) >> 1); off = ((ci - 72) & 1) * 32; }
        else { seg = 18 + (ci - 90); off = 0; c.nv = (seg == 18) ? 12 : 4; }
        if (seg == 0 || seg == 1 || seg == 4 || seg == 7) c.scale = QS;
        c.W = a.w_in + (size_t)l * DM * IN_W; c.N = IN_W; c.n0 = SEG_SRC[seg] + off; c.k0 = kb * 64; c.WT = (bf16*)(ws + W_IN); c.dK = DM; c.drow0 = SEG_DST[seg] + off; return c; }
    r -= CVT_I_IN;
    if (r < CVT_I_G) { const int m = r >> 9, q = r & 511, kb = q >> 5, nb = q & 31;
        c.W = a.w_gate + (size_t)(l * 4 + m) * DM * DM; c.N = DM; c.n0 = nb * 32; c.k0 = kb * 64; c.WT = (bf16*)(ws + W_G) + (size_t)m * DM * DM; c.dK = DM; c.drow0 = nb * 32; c.scale = -LOG2E; return c; }
    r -= CVT_I_G;
    if (r < CVT_I_BR) { const int m = r >> 7, q = r & 127, kb = q >> 5, nb = q & 31;
        c.W = a.w_br + (size_t)(l * 4 + m) * 256 * DM; c.N = DM; c.n0 = nb * 32; c.k0 = kb * 64; c.WT = (bf16*)(ws + W_BR) + (size_t)m * DM * 256; c.dK = 256; c.drow0 = nb * 32; return c; }
    r -= CVT_I_BR;
    if (r < CVT_I_O) { const int kb = r >> 5, nb = r & 31;
        c.W = a.w_o + (size_t)l * DM * DM; c.N = DM; c.n0 = nb * 32; c.k0 = kb * 64; c.WT = (bf16*)(ws + W_O); c.dK = DM; c.drow0 = nb * 32; return c; }
    r -= CVT_I_O;
    if (r < CVT_I_C1) { const int j = r >> 6, q = r & 63, kb = q >> 1, nb = q & 1;
        c.W = a.w_cmp1 + (size_t)(l * 2 + j) * 2048 * 64; c.N = 64; c.n0 = nb * 32; c.k0 = kb * 64; c.WT = (bf16*)(ws + W_C1) + (size_t)j * 256 * 2048; c.dK = 2048; c.drow0 = nb * 32; return c; }
    r -= CVT_I_C1;
    if (r < CVT_I_R) { const int mode = r >> 5, q = r & 31, kb = q >> 1, nb = q & 1;
        c.W = a.w_router + (size_t)l * DM * 64; c.N = 64; c.n0 = nb * 32; c.k0 = kb * 64; c.WT = (bf16*)(ws + (mode ? W_RL : W_RH)); c.dK = DM; c.drow0 = nb * 32; c.mode = mode; return c; }
    r -= CVT_I_R;
    if (r < CVT_I_E) {
        const int e = r / 384, q = r % 384, which = q >> 7, qq = q & 127;
        if (which < 2) { const int kb = qq >> 3, nb = qq & 7, n0 = nb * 32, pn = n0 >> 7, i0 = n0 & 127;
            c.W = (which == 0) ? (e < 64 ? a.w_eg + (size_t)(l * 64 + e) * DM * 256 : a.w_sg + (size_t)l * DM * 256) : (e < 64 ? a.w_eu + (size_t)(l * 64 + e) * DM * 256 : a.w_su + (size_t)l * DM * 256);
            c.N = 256; c.n0 = n0; c.k0 = kb * 64; c.WT = (bf16*)(ws + W_1) + (size_t)e * 512 * DM; c.dK = DM; c.drow0 = pn * 256 + which * 128 + i0;
        } else { const int kb = qq >> 5, nb = qq & 31;
            c.W = e < 64 ? a.w_ed + (size_t)(l * 64 + e) * 256 * DM : a.w_sd + (size_t)l * 256 * DM; c.N = DM; c.n0 = nb * 32; c.k0 = kb * 64; c.WT = (bf16*)(ws + W_2) + (size_t)e * DM * 256; c.dK = 256; c.drow0 = nb * 32; c.scale = Y_SCALE; }
        return c; }
    r -= CVT_I_E;
    c.mode = 2; c.n0 = r; c.W = nullptr; c.WT = nullptr; c.N = 0; c.k0 = 0; c.dK = 0; c.drow0 = 0; return c;
}
DI void cvt_load(const CvtItem& c, f32x4 (&v)[8], int lane) {
    if (c.mode == 2) return;
    if (c.nv == 32 && ((c.N | c.n0) & 3) == 0) {
#pragma unroll
        for (int i = 0; i < 8; ++i) v[i] = *(const f32x4*)(c.W + (size_t)(c.k0 + 8 * i + (lane >> 3)) * c.N + c.n0 + (lane & 7) * 4);
    } else {
#pragma unroll
        for (int i = 0; i < 8; ++i) { const float* p = c.W + (size_t)(c.k0 + 8 * i + (lane >> 3)) * c.N + c.n0 + (lane & 7) * 4; const int c4 = (lane & 7) * 4;
            v[i][0] = (c4 + 0 < c.nv) ? p[0] : 0.f; v[i][1] = (c4 + 1 < c.nv) ? p[1] : 0.f; v[i][2] = (c4 + 2 < c.nv) ? p[2] : 0.f; v[i][3] = (c4 + 3 < c.nv) ? p[3] : 0.f; }
    }
}
DI void cvt_finish(const Args& a, int l, const CvtItem& c, const f32x4 (&v)[8], LAS float* scr, int lane) {
    if (c.mode == 2) {
        const int j = c.n0; const float* pe = a.pe_cmp + (size_t)(l * 2 + j) * 2048; const float* w1 = a.w_cmp1 + (size_t)(l * 2 + j) * 2048 * 64;
        float s = 0.f;
        for (int k = 0; k < 2048; ++k) s += pe[k] * w1[(size_t)k * 64 + lane];
        ((float*)(a.ws + WS_CBIAS))[j * 64 + lane] = s; return; }
#pragma unroll
    for (int i = 0; i < 8; ++i) { const int kk = 8 * i + (lane >> 3), c4 = (lane & 7) * 4; scr[kk * 33 + c4] = v[i][0]; scr[kk * 33 + c4 + 1] = v[i][1]; scr[kk * 33 + c4 + 2] = v[i][2]; scr[kk * 33 + c4 + 3] = v[i][3]; }
    LDS_WAIT(); asm volatile("" ::: "memory");
    const int cc = lane & 7;
#pragma unroll
    for (int j = 0; j < 4; ++j) {
        const int n = (lane >> 3) + 8 * j; const LAS float* s = scr + (8 * cc) * 33 + n;
        float w[8];
#pragma unroll
        for (int q = 0; q < 8; ++q) { w[q] = s[q * 33] * c.scale; if (c.mode == 1) { const float h = __uint_as_float(cvtpk(w[q], 0.f) << 16); w[q] = w[q] - h; } }
        u32x4 o; o.x = cvtpk(w[0], w[1]); o.y = cvtpk(w[2], w[3]); o.z = cvtpk(w[4], w[5]); o.w = cvtpk(w[6], w[7]);
        if (n < c.nv) *(u32x4*)(c.WT + (size_t)(c.drow0 + n) * c.dK + c.k0 + 8 * cc) = o;
    }
    LDS_WAIT(); asm volatile("" ::: "memory");
}
DI void ph_cvt(const Args& a, int l, LAS unsigned char* lds, int gw, int NGW, int wave, int lane) {
    LAS float* scr = (LAS float*)(lds + wave * 8704);
    f32x4 va[8], vb[8];
    CvtItem ca, cb; ca.mode = 2; ca.n0 = 0;
    int it = gw;
    if (it < CVT_NIT) { ca = cvt_decode(a, l, it); cvt_load(ca, va, lane); }
    for (; it < CVT_NIT; it += 2 * NGW) {
        const bool hasb = it + NGW < CVT_NIT;
        if (hasb) { cb = cvt_decode(a, l, it + NGW); cvt_load(cb, vb, lane); }
        cvt_finish(a, l, ca, va, scr, lane);
        const bool hasa = it + 2 * NGW < CVT_NIT;
        if (hasa) { ca = cvt_decode(a, l, it + 2 * NGW); cvt_load(ca, va, lane); }
        if (hasb) cvt_finish(a, l, cb, vb, scr, lane);
    }
}

DI void rope4(float (&v)[4], int a, const float* rp, float scale) {
    float pv[4];
#pragma unroll
    for (int i = 0; i < 4; ++i) pv[i] = dpp_xor2(v[i]);
    const f32x4 c4 = *(const f32x4*)(rp + 4 * (a & 1)), s4 = *(const f32x4*)(rp + 8 + 4 * (a & 1));
    if (a < 4) {
#pragma unroll
        for (int i = 0; i < 4; ++i) v[i] = (a < 2) ? (v[i] * c4[i] - pv[i] * s4[i]) : (pv[i] * s4[i] + v[i] * c4[i]);
    }
#pragma unroll
    for (int i = 0; i < 4; ++i) v[i] *= scale;
}
DI void ld4bf(const bf16* p, float (&v)[4]) { const u32x2 w = *(const u32x2*)p; v[0] = bflo(w.x); v[1] = bfhi(w.x); v[2] = bflo(w.y); v[3] = bfhi(w.y); }
DI void st4bf(bf16* p, const float (&v)[4]) { u32x2 w; w.x = cvtpk(v[0], v[1]); w.y = cvtpk(v[2], v[3]); *(u32x2*)p = w; }

DI void ph_post(const Args& a, int l, LAS unsigned char* lds, int wave, int lane) {
    unsigned char* ws = a.ws;
    bf16* proj = (bf16*)(ws + WS_A);
    const float* rope = (const float*)(ws + WS_ROPE);
    const float* sm32 = (const float*)(ws + WS_SM32);
    LAS bf16* T = (LAS bf16*)(lds + wave * 9216);
    for (int tile = lbid(); tile < NTOK / 64; tile += lgrid()) {
        const int tok0 = tile * 64;
        float kmx = 0.f;
        for (int tt = wave; tt < 64; tt += NWAVES) {
            const int tok = tok0 + tt; bf16* row = proj + (size_t)tok * PW;
            const float* cs = rope + (size_t)tok * 16;
            const int ah = lane & 15;
            float v[4];
            ld4bf(row + C_AQ + 4 * lane, v); rope4(v, ah, cs, 1.0f); st4bf(row + C_AQ + 4 * lane, v);
            ld4bf(row + C_DQ + 4 * lane, v); rope4(v, ah, cs, 1.0f); st4bf(row + C_DQ + 4 * lane, v);
            ld4bf(row + C_DIQ + 4 * lane, v); rope4(v, ah, cs, 1.0f); st4bf(row + C_DIQ + 4 * lane, v);
            {
                const int tl = tok % SEQ, kin = tl & 31, slot = (kin & ~12) | ((kin & 4) << 1) | ((kin & 8) >> 1), hq = lane >> 4;
                const size_t toff = (((size_t)(tok / SEQ) * 4 + hq) * (SEQ / 32) + (tl >> 5)) * 2048 + ((ah >> 1) * 32 + slot) * 8 + (ah & 1) * 4;
                *(u32x2*)((bf16*)(ws + WS_KTB) + toff) = *(const u32x2*)(row + C_BK + 4 * lane);
                const u32x2 ckw = *(const u32x2*)(row + C_CK + 4 * lane);
                *(u32x2*)((bf16*)(ws + WS_KTC) + toff) = ckw;
                float sq = bflo(ckw.x) * bflo(ckw.x) + bfhi(ckw.x) * bfhi(ckw.x) + bflo(ckw.y) * bflo(ckw.y) + bfhi(ckw.y) * bfhi(ckw.y);
                sq += dpp_xor1(sq); sq += dpp_xor2(sq); sq += DPPF(sq, 0x124, 0xF, true); sq += DPPF(sq, 0x128, 0xF, true);
                kmx = fmaxf(kmx, sq);
            }
            { const int hk = lane >> 4; const int cb = (hk == 0) ? C_AKS : (hk == 1) ? C_AKW : (hk == 2) ? C_DK : C_DIK;
              ld4bf(row + cb + 4 * ah, v); rope4(v, ah, cs, 1.0f); st4bf(row + cb + 4 * ah, v);
              if (hk < 2) {
                  const int tl = tok % SEQ, kin = tl & 31, slot = (kin & ~12) | ((kin & 4) << 1) | ((kin & 8) >> 1);
                  bf16* kt = (bf16*)(ws + (hk == 0 ? WS_KTS : WS_KTW)) + ((size_t)(tok / SEQ) * (SEQ / 32) + (tl >> 5)) * 2048 + ((ah >> 1) * 32 + slot) * 8 + (ah & 1) * 4;
                  st4bf(kt, v); }
              if (hk == 3) {
                  const int tl = tok % SEQ;
                  bf16* it = (bf16*)(ws + WS_IKT) + ((size_t)(tok / SEQ) * (SEQ / 32) + (tl >> 5)) * 2048 + ((ah >> 1) * 32 + (tl & 31)) * 8 + (ah & 1) * 4;
                  st4bf(it, v); } }
            if (lane < 32) { const int j = lane >> 4; const u32x2 w = *(const u32x2*)(row + (j ? C_AVC : C_AKC) + 4 * ah);
                *(u32x2*)((bf16*)(ws + (j ? WS_VCR : WS_KCR)) + (size_t)tok * 64 + 4 * ah) = w; }
            if (lane < 20) {
                const float s = sm32[(size_t)tok * 32 + lane];
                if (lane < 12) ((float*)(ws + WS_GATE))[(size_t)tok * 12 + lane] = sigmoidf_(s);
                else if (lane < 16) { const float z = s + a.b_f[l * 4 + (lane - 12)];
                    ((float*)(ws + WS_LOGF))[(size_t)tok * 4 + (lane - 12)] = fminf(z, 0.f) * LOG2E - flog2(1.f + fexp2(-fabsf(z) * LOG2E)); }
                else ((float*)(ws + WS_IW))[(size_t)tok * 4 + (lane - 16)] = s;
            }
        }
        if ((lane & 15) == 0) atomicMax((unsigned*)(ws + WS_CTL) + CW_KMAX + l * 32 + (tok0 / SEQ) * 4 + (lane >> 4), __float_as_uint(kmx * 1.02f));
        const int bidx = tok0 / SEQ, tl0 = tok0 % SEQ;
        for (int hv = wave; hv < 10; hv += NWAVES) {
            int cb; bf16* dst;
            if (hv < 4) { cb = C_BV + 64 * hv; dst = (bf16*)(ws + WS_VTB) + (size_t)(bidx * 4 + hv) * 64 * SEQ; }
            else if (hv < 8) { cb = C_CV + 64 * (hv - 4); dst = (bf16*)(ws + WS_VTC) + (size_t)(bidx * 4 + hv - 4) * 64 * SEQ; }
            else if (hv == 8) { cb = C_AVS; dst = (bf16*)(ws + WS_VTAS) + (size_t)bidx * 64 * SEQ; }
            else { cb = C_AVW; dst = (bf16*)(ws + WS_VTAW) + (size_t)bidx * 64 * SEQ; }
            const bf16* src = proj + (size_t)(tok0 + lane) * PW + cb;
#pragma unroll
            for (int i = 0; i < 8; ++i) { const u32x4 w = *(const u32x4*)(src + 8 * i);
                T[(8 * i + 0) * 72 + lane] = (bf16)(w.x & 0xffff); T[(8 * i + 1) * 72 + lane] = (bf16)(w.x >> 16);
                T[(8 * i + 2) * 72 + lane] = (bf16)(w.y & 0xffff); T[(8 * i + 3) * 72 + lane] = (bf16)(w.y >> 16);
                T[(8 * i + 4) * 72 + lane] = (bf16)(w.z & 0xffff); T[(8 * i + 5) * 72 + lane] = (bf16)(w.z >> 16);
                T[(8 * i + 6) * 72 + lane] = (bf16)(w.w & 0xffff); T[(8 * i + 7) * 72 + lane] = (bf16)(w.w >> 16); }
            LDS_WAIT(); asm volatile("" ::: "memory");
            {
                const int dt = lane >> 5, cc = lane & 31;
#pragma unroll
                for (int i = 0; i < 8; ++i) { const int tile = i >> 2, sh = i & 3;
                    bf16* d = dst + ((size_t)(tl0 >> 5) + tile) * 2048 + ((dt * 2 + (sh >> 1)) * 64 + (sh & 1) * 32 + cc) * 8;
                    *(u32x4*)d = *(const LAS u32x4*)(T + lane * 72 + 8 * i); }
            }
            LDS_WAIT(); asm volatile("" ::: "memory");
        }
    }
}

DI void cumsum_seq(const Args& a, int bh, int lane) {
    const float* lf = (const float*)(a.ws + WS_LOGF); float* cum = (float*)(a.ws + WS_CUM);
    const int b = bh >> 2, h = bh & 3;
    const float* src = lf + ((size_t)b * SEQ + lane * 128) * 4 + h;
    float s = 0.f;
    for (int i = 0; i < 128; ++i) s += src[(size_t)i * 4];
    const float incl = wave_incl_scan_f(s);
    float run = incl - s;
    float* dst = cum + (size_t)bh * SEQ + lane * 128;
    for (int i = 0; i < 128; ++i) { run += src[(size_t)i * 4]; dst[i] = run; }
}

DI void ph_cmp2(const Args& a, int l, int gw, int NGW, int lane) {
    const float* hid = (const float*)(a.ws + WS_HID);
    bf16* kc = (bf16*)(a.ws + WS_KCMP); bf16* vtc = (bf16*)(a.ws + WS_VTCMP);
    for (int it = gw; it < 2 * 4096; it += NGW) {
        const int j = it >> 12, row = it & 4095, b = row >> 9, n = row & 511;
        const float* h = hid + ((size_t)j * 4096 + row) * 64; const float* w2 = a.w_cmp2 + (size_t)(l * 2 + j) * 64 * 64;
        float s = 0.f;
#pragma unroll 8
        for (int k = 0; k < 64; ++k) s += h[k] * w2[k * 64 + lane];
        if (n == 511) s = 0.f;
        const bf16 o = (bf16)(cvtpk(s, 0.f) & 0xffff);
        const int tile = n >> 5, kin = n & 31;
        if (j == 0) { const int slot = (kin & ~12) | ((kin & 4) << 1) | ((kin & 8) >> 1); kc[((size_t)b * 16 + tile) * 2048 + ((lane >> 3) * 32 + slot) * 8 + (lane & 7)] = o; }
        else { const int sI = kin >> 4, hI = (kin >> 3) & 1, e = kin & 7; vtc[((size_t)b * 16 + tile) * 2048 + (((lane >> 5) * 2 + sI) * 64 + hI * 32 + (lane & 31)) * 8 + e] = o; }
    }
}

DI void ph_ln1(const Args& a, int l, int gw, int NGW, int lane) {
    bf16* xb = (bf16*)(a.ws + WS_XB); bf16* xl = (bf16*)(a.ws + WS_XL);
    const float* g = a.ln1_g + l * DM; const float* be = a.ln1_b + l * DM;
    u32x4 nq0 = {0u,0u,0u,0u}, nq1 = {0u,0u,0u,0u};
    if (gw < NTOK) { const u32x4* x0 = (const u32x4*)(xb + (size_t)gw * DM) + lane; nq0 = x0[0]; nq1 = x0[64]; }
    for (int row = gw; row < NTOK; row += NGW) {
        u32x4* xr = (u32x4*)(xb + (size_t)row * DM) + lane; u32x4* lr = (u32x4*)(xl + (size_t)row * DM) + lane;
        const u32x4 qq[2] = {nq0, nq1};
        if (row + NGW < NTOK) { const u32x4* xn = (const u32x4*)(xb + (size_t)(row + NGW) * DM) + lane; nq0 = xn[0]; nq1 = xn[64]; }
        f32x4 v[4]; float s = 0.f;
#pragma unroll
        for (int j = 0; j < 2; ++j) { const u32x4 q = qq[j];
            v[2 * j] = (f32x4){bflo(q.x), bfhi(q.x), bflo(q.y), bfhi(q.y)}; v[2 * j + 1] = (f32x4){bflo(q.z), bfhi(q.z), bflo(q.w), bfhi(q.w)}; }
#pragma unroll
        for (int j = 0; j < 4; ++j) s += (v[j].x + v[j].y) + (v[j].z + v[j].w);
        const float mean = wave_sum(s) * (1.f / DM); float s2 = 0.f;
#pragma unroll
        for (int j = 0; j < 4; ++j) { v[j] = v[j] - mean; s2 += (v[j].x * v[j].x + v[j].y * v[j].y) + (v[j].z * v[j].z + v[j].w * v[j].w); }
        const float rstd = 1.f / sqrtf(wave_sum(s2) * (1.f / DM) + LN_EPS);
#pragma unroll
        for (int j = 0; j < 2; ++j) {
            const int cb = 8 * lane + 512 * j;
            const f32x4 g0 = *(const f32x4*)(g + cb), g1 = *(const f32x4*)(g + cb + 4), b0 = *(const f32x4*)(be + cb), b1 = *(const f32x4*)(be + cb + 4);
            const f32x4 y0 = v[2 * j] * rstd * g0 + b0, y1 = v[2 * j + 1] * rstd * g1 + b1;
            const u32x4 hi = pack8(y0, y1);
            const f32x4 r0 = {y0[0] - bflo(hi.x), y0[1] - bfhi(hi.x), y0[2] - bflo(hi.y), y0[3] - bfhi(hi.y)}, r1 = {y1[0] - bflo(hi.z), y1[1] - bfhi(hi.z), y1[2] - bflo(hi.w), y1[3] - bfhi(hi.w)};
            xr[64 * j] = hi; lr[64 * j] = pack8(r0, r1);
        }
    }
}

DI void ph_route(const Args& a, int l, LAS unsigned char* lds, int wave, int lane) {
    const float* logit = (const float*)(a.ws + WS_LOGIT);
    u32x2* tokinfo = (u32x2*)(a.ws + WS_TOKINFO);
    unsigned* lists = (unsigned*)(a.ws + WS_LIST);
    unsigned* gcnt = (unsigned*)(a.ws + WS_CTL) + CW_CNT + l * NCH * 64;
    LAS unsigned* lcnt = (LAS unsigned*)lds;
    LAS unsigned* lbase = lcnt + 64;
    LAS unsigned* stash = lbase + 64;
    const float rb = a.router_bias[l * 64 + lane];
    for (int blk = lbid(); blk < NTOK / 256; blk += lgrid()) {
        const int tok0 = blk * 256, c = tok0 / CHTOK;
        if (ltid() < 64) lcnt[ltid()] = 0u;
        __syncthreads();
        for (int tt = wave; tt < 256; tt += NWAVES) {
            const int tok = tok0 + tt;
            const float sc = sigmoidf_(logit[(size_t)tok * 64 + lane]);
            const float bi = sc + rb;
            float m1 = bi;
            m1 = fmaxf(m1, __shfl_xor(m1, 1)); m1 = fmaxf(m1, __shfl_xor(m1, 2)); m1 = fmaxf(m1, __shfl_xor(m1, 4));
            const unsigned long long eqm = __ballot(bi == m1);
            const int gsh = lane & ~7; const unsigned gm = (unsigned)((eqm >> gsh) & 0xffu);
            const int first = __builtin_ctz(gm);
            float v2 = ((lane & 7) == first) ? -3.0e38f : bi;
            v2 = fmaxf(v2, __shfl_xor(v2, 1)); v2 = fmaxf(v2, __shfl_xor(v2, 2)); v2 = fmaxf(v2, __shfl_xor(v2, 4));
            const float gs = m1 + v2;
            const int g = lane >> 3; int grank = 0;
#pragma unroll
            for (int gg = 0; gg < 8; ++gg) { const float o = __int_as_float(__builtin_amdgcn_readlane(__float_as_int(gs), gg * 8)); grank += (o > gs || (o == gs && gg < g)) ? 1 : 0; }
            const float mb = (grank < 4) ? bi : -1.0e30f;
            int rank = 0;
#pragma unroll 4
            for (int e = 0; e < 64; ++e) { const float o = __int_as_float(__builtin_amdgcn_readlane(__float_as_int(mb), e)); rank += (o > mb || (o == mb && e < lane)) ? 1 : 0; }
            const bool sel = rank < 8;
            const float wsum = wave_sum(sel ? sc : 0.f);
            const float w = sc / wsum * 2.5f;
            const unsigned long long sm = __ballot(sel);
            const int k = __popcll(sm & ((1ull << lane) - 1ull));
            if (sel) {
                const unsigned lp = atomicAdd((unsigned*)&lcnt[lane], 1u);
                stash[tt * 8 + k] = ((unsigned)lane << 16) | lp;
                ((float*)tokinfo)[((size_t)tok * 8 + k) * 2 + 1] = w;
            }
        }
        __syncthreads();
        if (ltid() < 64) lbase[ltid()] = atomicAdd(&gcnt[c * 64 + ltid()], lcnt[ltid()]);
        __syncthreads();
        for (int i = ltid(); i < 256 * 8; i += NWAVES * 64) {
            const unsigned s = stash[i]; const unsigned e = s >> 16, lp = s & 0xffffu; const int tok = tok0 + (i >> 3);
            const unsigned pos = lbase[e] + lp;
            lists[((size_t)c * 64 + e) * CHTOK + pos] = (unsigned)tok;
            ((unsigned*)tokinfo)[((size_t)tok * 8 + (i & 7)) * 2] = (e << 16) | pos;
        }
        __syncthreads();
    }
}

typedef f32x4 Acc2[2][2][4][2];
typedef f32x4 Acc1[2][1][4][2];

struct SchedProj {
    static constexpr bool GATHER = false, FIXED = true;
    gs::StaticOrder so; unsigned A, B;
    DI bool next(int i, gs::GU& u) const { gs::Unit t; if (!so.next(i, t)) return false;
        u.A = A + (unsigned)t.pm * 256u * 2048u; u.B = B + (unsigned)t.pn * 256u * 2048u; u.idx = nullptr; u.lda = 2048; u.ldb = 2048; u.nt = 16; u.flags = 3; u.nvalid = 256;
        u.a0 = t.pm; u.a1 = t.pn; u.a2 = 0; u.a3 = 0; return true; }
};
struct EpiProj {
    static constexpr bool PERM = true; static constexpr bool BH8 = false; bf16* proj; float* sm32;
    DI void operator()(const Acc2& acc, const gs::GU& u, int wr, int wc, int fr, int fq) const {
        const int row0 = u.a0 * 256 + wr * 64 + fr, col0 = u.a1 * 256 + wc * 32 + 8 * fq;
#pragma unroll
        for (int ai = 0; ai < 2; ++ai)
#pragma unroll
            for (int m = 0; m < 4; ++m) { const int row = row0 + ai * 128 + m * 16;
#pragma unroll
                for (int bj = 0; bj < 2; ++bj) *(u32x4*)(proj + (size_t)row * PW + col0 + bj * 128) = pack8(acc[ai][bj][m][0], acc[ai][bj][m][1]);
                if (u.a1 == 11 && wc == 2) { *(f32x4*)(sm32 + (size_t)row * 32 + 8 * fq) = acc[ai][0][m][0]; *(f32x4*)(sm32 + (size_t)row * 32 + 8 * fq + 4) = acc[ai][0][m][1]; } }
    }
};

struct SchedCmp {
    static constexpr bool GATHER = false, FIXED = true;
    unsigned kcr, vcr, w;
    DI bool next(int i, gs::GU& u) const { if (i > 0 || lbid() >= 32) return false; const int j = lbid() >> 4, pm = lbid() & 15;
        u.A = (j ? vcr : kcr) + (unsigned)pm * 256u * 2048u; u.B = w + (unsigned)j * 256u * 4096u; u.idx = nullptr; u.lda = 2048; u.ldb = 4096; u.nt = 32; u.flags = 3; u.nvalid = 256;
        u.a0 = pm; u.a1 = j; u.a2 = 0; u.a3 = 0; return true; }
};
struct EpiCmp {
    static constexpr bool PERM = true; static constexpr bool BH8 = false; float* hid; const float* cbias;
    DI void operator()(const Acc2& acc, const gs::GU& u, int wr, int wc, int fr, int fq) const {
        if (wc >= 2) return;
        const int row0 = u.a0 * 256 + wr * 64 + fr, col0 = wc * 32 + 8 * fq, j = u.a1;
        float cb[8];
#pragma unroll
        for (int q = 0; q < 8; ++q) cb[q] = cbias[j * 64 + col0 + q];
#pragma unroll
        for (int ai = 0; ai < 2; ++ai)
#pragma unroll
            for (int m = 0; m < 4; ++m) { const int row = row0 + ai * 128 + m * 16; float o[8];
#pragma unroll
                for (int q = 0; q < 8; ++q) { const float x = acc[ai][0][m][q >> 2][q & 3] + cb[q];
                    const float y2 = 1.5957691216f * (x + 0.044715f * x * x * x);
                    o[q] = x * frcp(1.f + fexp2(-y2 * LOG2E)); }
                float* d = hid + ((size_t)j * 4096 + row) * 64 + col0;
                *(f32x4*)d = (f32x4){o[0], o[1], o[2], o[3]}; *(f32x4*)(d + 4) = (f32x4){o[4], o[5], o[6], o[7]}; }
    }
};

struct SchedMerge {
    static constexpr bool GATHER = false, FIXED = false;
    unsigned xb, om, wg, wbr; int G;
    DI bool next(int i, gs::GU& u) const { const int ti = i >> 3, k = i & 7; const int bid_ = lbid(); const long L = (long)ti * G + bid_; if (L >= 2048) return false;
        int pm = (int)(L >> 3), pc = (int)(L & 7); const int m = k >> 1, kind = k & 1;
        if (G == 256) { const int x = bid_ & 7, idx = bid_ >> 3; pm = ti * 32 + x * 4 + (idx >> 3); pc = idx & 7; }
        if (kind == 0) { u.A = om + (unsigned)pm * 256u * 2048u + (unsigned)m * 512u; u.B = wbr + (unsigned)m * 1024u * 512u + (unsigned)pc * 128u * 512u; u.lda = 2048; u.ldb = 512; u.nt = 4; }
        else           { u.A = xb + (unsigned)pm * 256u * 2048u;           u.B = wg + (unsigned)m * 1024u * 2048u + (unsigned)pc * 128u * 2048u; u.lda = 2048; u.ldb = 2048; u.nt = 16; }
        u.idx = nullptr; u.flags = 3; u.nvalid = 256; u.a0 = pm; u.a1 = pc; u.a2 = kind; u.a3 = m; return true; }
};
struct EpiMerge {
    static constexpr bool PERM = true; static constexpr bool BH8 = false; bf16* merged; u32x4* stash;
    f32x4 M[2][4][2];
    DI void operator()(const Acc1& acc, const gs::GU& u, int wr, int wc, int fr, int fq) {
        const int tid = ltid();
        if (u.a2 == 0) {
#pragma unroll
            for (int ai = 0; ai < 2; ++ai)
#pragma unroll
                for (int m = 0; m < 4; ++m) stash[(ai * 4 + m) * 512 + tid] = pack8(acc[ai][0][m][0], acc[ai][0][m][1]);
        } else {
            const bool first = (u.a3 == 0), lastm = (u.a3 == 3);
            const int row0 = u.a0 * 256 + wr * 64 + fr, col0 = u.a1 * 128 + wc * 32 + 8 * fq;
            if (first) {
#pragma unroll
                for (int ai = 0; ai < 2; ++ai)
#pragma unroll
                    for (int m = 0; m < 4; ++m) { M[ai][m][0] = (f32x4){0.f, 0.f, 0.f, 0.f}; M[ai][m][1] = (f32x4){0.f, 0.f, 0.f, 0.f}; }
            }
#pragma unroll
            for (int ai = 0; ai < 2; ++ai)
#pragma unroll
                for (int m = 0; m < 4; ++m) {
                    const u32x4 p = stash[(ai * 4 + m) * 512 + tid];
                    const f32x4 g0 = acc[ai][0][m][0], g1 = acc[ai][0][m][1];
                    f32x4 m0 = M[ai][m][0], m1 = M[ai][m][1];
                    m0[0] = __builtin_fmaf(frcp(1.f + fexp2(g0[0])), bflo(p.x), m0[0]); m0[1] = __builtin_fmaf(frcp(1.f + fexp2(g0[1])), bfhi(p.x), m0[1]);
                    m0[2] = __builtin_fmaf(frcp(1.f + fexp2(g0[2])), bflo(p.y), m0[2]); m0[3] = __builtin_fmaf(frcp(1.f + fexp2(g0[3])), bfhi(p.y), m0[3]);
                    m1[0] = __builtin_fmaf(frcp(1.f + fexp2(g1[0])), bflo(p.z), m1[0]); m1[1] = __builtin_fmaf(frcp(1.f + fexp2(g1[1])), bfhi(p.z), m1[1]);
                    m1[2] = __builtin_fmaf(frcp(1.f + fexp2(g1[2])), bflo(p.w), m1[2]); m1[3] = __builtin_fmaf(frcp(1.f + fexp2(g1[3])), bfhi(p.w), m1[3]);
                    M[ai][m][0] = m0; M[ai][m][1] = m1;
                    asm volatile("" : "+v"(M[ai][m][0]), "+v"(M[ai][m][1]));
                    if (lastm) *(u32x4*)(merged + (size_t)(row0 + ai * 128 + m * 16) * DM + col0) = pack8(M[ai][m][0], M[ai][m][1]);
                    asm volatile("" ::: "memory");
                }
        }
    }
};

struct SchedWo {
    static constexpr bool GATHER = false, FIXED = true;
    gs::StaticOrder so; unsigned A, B;
    DI bool next(int i, gs::GU& u) const { gs::Unit t; if (!so.next(i, t)) return false;
        u.A = A + (unsigned)t.pm * 256u * 2048u; u.B = B + (unsigned)t.pn * 256u * 2048u; u.idx = nullptr; u.lda = 2048; u.ldb = 2048; u.nt = 16; u.flags = 3; u.nvalid = 256;
        u.a0 = t.pm; u.a1 = t.pn; u.a2 = 0; u.a3 = 0; return true; }
};
struct EpiWo {
    static constexpr bool PERM = true; static constexpr bool BH8 = false; bf16* xb;
    DI void operator()(const Acc2& acc, const gs::GU& u, int wr, int wc, int fr, int fq) const {
        const int row0 = u.a0 * 256 + wr * 64 + fr, col0 = u.a1 * 256 + wc * 32 + 8 * fq;
#pragma unroll
        for (int ai = 0; ai < 2; ++ai)
#pragma unroll
            for (int m = 0; m < 4; ++m) {
#pragma unroll
                for (int bj = 0; bj < 2; ++bj) { bf16* p = xb + (size_t)(row0 + ai * 128 + m * 16) * DM + col0 + bj * 128; const u32x4 xv = *(const u32x4*)p;
                    f32x4 v0 = acc[ai][bj][m][0], v1 = acc[ai][bj][m][1];
                    v0[0] += ALPHA * bflo(xv.x); v0[1] += ALPHA * bfhi(xv.x); v0[2] += ALPHA * bflo(xv.y); v0[3] += ALPHA * bfhi(xv.y);
                    v1[0] += ALPHA * bflo(xv.z); v1[1] += ALPHA * bfhi(xv.z); v1[2] += ALPHA * bflo(xv.w); v1[3] += ALPHA * bfhi(xv.w);
                    *(u32x4*)p = pack8(v0, v1); } }
    }
};

struct SchedRouter {
    static constexpr bool GATHER = false, FIXED = true;
    unsigned xh, xl, wh, wl; int G;
    DI bool next(int i, gs::GU& u) const { const int ti = i / 3, k = i % 3; const int pm = ti * G + lbid(); if (pm >= 256) return false;
        u.A = ((k == 1) ? xl : xh) + (unsigned)pm * 256u * 2048u; u.B = (k == 2) ? wl : wh; u.idx = nullptr; u.lda = 2048; u.ldb = 2048; u.nt = 16;
        u.flags = (k == 0 ? 1 : 0) | (k == 2 ? 2 : 0); u.nvalid = 256; u.a0 = pm; u.a1 = 0; u.a2 = 0; u.a3 = 0; return true; }
};
struct EpiRouter {
    static constexpr bool PERM = false; static constexpr bool BH8 = false; float* logit;
    DI void operator()(const Acc1& acc, const gs::GU& u, int wr, int wc, int fr, int fq) const {
        if (wc >= 2) return;
        const int row0 = u.a0 * 256 + wr * 64 + fr, col0 = wc * 32 + 4 * fq;
#pragma unroll
        for (int ai = 0; ai < 2; ++ai)
#pragma unroll
            for (int m = 0; m < 4; ++m)
#pragma unroll
                for (int n = 0; n < 2; ++n) *(f32x4*)(logit + (size_t)(row0 + ai * 128 + m * 16) * 64 + col0 + n * 16) = acc[ai][0][m][n];
    }
};

constexpr int TBL_OFF = 131072, NPAIR = NCH * 65, TBLN = 528;
static_assert(NPAIR + 1 <= TBLN && TBL_OFF + 3 * TBLN * 4 <= MISC_OFF, "MoE tables");
DI void moe_tables(const Args& a, int l, LAS unsigned char* lds) {
    LAS int* ptile = (LAS int*)(lds + TBL_OFF); LAS int* ypre = ptile + TBLN; LAS int* cntv = ypre + TBLN;
    __syncthreads();
    const int tid_ = ltid();
    if (tid_ < 64) {
        const unsigned* gcnt = (const unsigned*)(a.ws + WS_CTL) + CW_CNT + l * NCH * 64;
        int pt = 0;
        for (int c = 0; c < NCH; ++c) {
            const int n = (int)__hip_atomic_load(gcnt + c * 64 + tid_, __ATOMIC_RELAXED, __HIP_MEMORY_SCOPE_AGENT);
            const int tl = (n + 255) >> 8;
            const int tinc = wave_incl_scan(tl), yinc = wave_incl_scan(n);
            const int p = c * 65 + tid_;
            cntv[p] = n; ptile[p] = pt + tinc - tl; ypre[p] = yinc - n;
            const int ttot = __builtin_amdgcn_readlane(tinc, 63), ytot = __builtin_amdgcn_readlane(yinc, 63);
            if (tid_ == 0) { cntv[c * 65 + 64] = CHTOK; ptile[c * 65 + 64] = pt + ttot; ypre[c * 65 + 64] = ytot; }
            pt += ttot + CHTOK / 256;
        }
        if (tid_ == 0) ptile[NPAIR] = pt;
    }
    __syncthreads();
}
DI int find_pair(const LAS int* ptile, int tile) {
    int lo = 0, hi = NPAIR;
    while (hi - lo > 1) { const int mid = (lo + hi) >> 1; if (ptile[mid] <= tile) lo = mid; else hi = mid; }
    return lo;
}
struct SchedE1 {
    static constexpr bool GATHER = true, FIXED = false;
    const LAS int* ptile; const LAS int* cntv; unsigned xb; const unsigned* lists; unsigned w1; int G;
    DI bool next(int i, gs::GU& u) const { const int bid_ = lbid(); int un = i * G + bid_;
        if (G == 256) { const int x = bid_ & 7, idx = bid_ >> 3; un = (i * 128 + x * 16 + (idx >> 1)) * 2 + (idx & 1); }
        const int tile = un >> 1, pn = un & 1; if (tile >= ptile[NPAIR]) return false;
        const int p = find_pair(ptile, tile), c = p / 65, e = p % 65, t = tile - ptile[p];
        if (e < 64) { u.A = xb; u.idx = (const int*)(lists + ((size_t)c * 64 + e) * CHTOK + (size_t)t * 256); u.nvalid = cntv[p] - t * 256; }
        else { u.A = xb + ((unsigned)c * CHTOK + (unsigned)t * 256u) * 2048u; u.idx = nullptr; u.nvalid = 256; }
        u.B = w1 + (unsigned)e * 512u * 2048u + (unsigned)pn * 256u * 2048u; u.lda = 2048; u.ldb = 2048; u.nt = 16; u.flags = 3; u.a0 = tile; u.a1 = pn; u.a2 = 0; u.a3 = 0; return true; }
};
struct EpiE1 {
    static constexpr bool PERM = true; static constexpr bool BH8 = false; bf16* hb;
    DI void operator()(const Acc2& acc, const gs::GU& u, int wr, int wc, int fr, int fq) const {
        const int row0 = u.a0 * 256 + wr * 64 + fr, col0 = u.a1 * 128 + wc * 32 + 8 * fq;
#pragma unroll
        for (int ai = 0; ai < 2; ++ai)
#pragma unroll
            for (int m = 0; m < 4; ++m) { f32x4 h[2];
#pragma unroll
                for (int n = 0; n < 2; ++n)
#pragma unroll
                    for (int q = 0; q < 4; ++q) { const float g = acc[ai][0][m][n][q], up = acc[ai][1][m][n][q]; h[n][q] = g * sigmoidf_(g) * up; }
                *(u32x4*)(hb + (size_t)(row0 + ai * 128 + m * 16) * 256 + col0) = pack8(h[0], h[1]); }
    }
};
struct SchedE2 {
    static constexpr bool GATHER = false, FIXED = true;
    const LAS int* ptile; const LAS int* cntv; const LAS int* ypre; unsigned hb, w2; int c; int G;
    DI bool next(int i, gs::GU& u) const { const int bid_ = lbid(); int un = i * G + bid_;
        if (G == 256) { const int x = bid_ & 7, idx = bid_ >> 3; un = (i * 64 + x * 8 + (idx >> 2)) * 4 + (idx & 3); }
        const int tile = ptile[c * 65] + (un >> 2), pn = un & 3; if (tile >= ptile[(c + 1) * 65]) return false;
        const int p = find_pair(ptile, tile), e = p % 65, t = tile - ptile[p];
        u.A = hb + (unsigned)tile * 256u * 512u; u.B = w2 + (unsigned)e * 1024u * 512u + (unsigned)pn * 256u * 512u; u.idx = nullptr; u.lda = 512; u.ldb = 512; u.nt = 4; u.flags = 3;
        u.nvalid = 256; u.a0 = (tile - ptile[c * 65]) * 256; u.a1 = pn; u.a2 = 0; u.a3 = 0; return true; }
};
DI unsigned pk4_fp8(float a, float b, float c, float d) { int w = __builtin_amdgcn_cvt_pk_fp8_f32(a, b, 0, false); w = __builtin_amdgcn_cvt_pk_fp8_f32(c, d, w, true); return (unsigned)w; }
struct EpiE2 {
    static constexpr bool PERM = true; static constexpr bool BH8 = true; unsigned char* y;
    DI void operator()(const Acc2& acc, const gs::GU& u, int wr, int wc, int fr, int fq) const {
        const int row0 = u.a0 + wr * 64 + fr, col0 = u.a1 * 256 + wc * 64 + 16 * fq;
#pragma unroll
        for (int ai = 0; ai < 2; ++ai)
#pragma unroll
            for (int m = 0; m < 4; ++m) {
                u32x4 w;
                { const f32x4 v0 = acc[ai][0][m][0], v1 = acc[ai][0][m][1]; w.x = pk4_fp8(v0[0], v0[1], v0[2], v0[3]); w.y = pk4_fp8(v1[0], v1[1], v1[2], v1[3]); }
                { const f32x4 v0 = acc[ai][1][m][0], v1 = acc[ai][1][m][1]; w.z = pk4_fp8(v0[0], v0[1], v0[2], v0[3]); w.w = pk4_fp8(v1[0], v1[1], v1[2], v1[3]); }
                *(u32x4*)(y + (size_t)(row0 + ai * 128 + m * 16) * DM + col0) = w; }
    }
};

DI void ph_ln2(const Args& a, int l, int c, LAS unsigned char* lds, int gw, int NGW, int lane) {
    const LAS int* ptile = (const LAS int*)(lds + TBL_OFF);
    bf16* xb = (bf16*)(a.ws + WS_XB); const unsigned char* y = (const unsigned char*)(a.ws + WS_Y);
    const u32x2* tokinfo = (const u32x2*)(a.ws + WS_TOKINFO);
    const float* g = a.ln2_g + l * DM; const float* be = a.ln2_b + l * DM;
    u32x4 nx0 = {0u,0u,0u,0u}, nx1 = {0u,0u,0u,0u}; u32x2 nti = {0u, 0u};
    if (gw < CHTOK) { const int row0 = c * CHTOK + gw; const u32x4* xr0 = (const u32x4*)(xb + (size_t)row0 * DM) + lane; nx0 = xr0[0]; nx1 = xr0[64]; if (lane < 8) nti = tokinfo[(size_t)row0 * 8 + lane]; }
    for (int tt = gw; tt < CHTOK; tt += NGW) {
        const int row = c * CHTOK + tt;
        const u32x4 cx0 = nx0, cx1 = nx1; const u32x2 cti = nti;
        if (tt + NGW < CHTOK) { const int rown = row + NGW; const u32x4* xrn = (const u32x4*)(xb + (size_t)rown * DM) + lane; nx0 = xrn[0]; nx1 = xrn[64]; if (lane < 8) nti = tokinfo[(size_t)rown * 8 + lane]; }
        u32x4* xr = (u32x4*)(xb + (size_t)row * DM) + lane;
        f32x4 v[4];
        v[0] = (f32x4){bflo(cx0.x), bfhi(cx0.x), bflo(cx0.y), bfhi(cx0.y)} * ALPHA; v[1] = (f32x4){bflo(cx0.z), bfhi(cx0.z), bflo(cx0.w), bfhi(cx0.w)} * ALPHA;
        v[2] = (f32x4){bflo(cx1.x), bfhi(cx1.x), bflo(cx1.y), bfhi(cx1.y)} * ALPHA; v[3] = (f32x4){bflo(cx1.z), bfhi(cx1.z), bflo(cx1.w), bfhi(cx1.w)} * ALPHA;
        int yrv = 0; float wv = 1.f;
        if (lane < 8) { const u32x2 ti = cti; yrv = (ptile[c * 65 + (int)(ti.x >> 16)] - ptile[c * 65]) * 256 + (int)(ti.x & 0xffffu); wv = __uint_as_float(ti.y); }
        else if (lane == 8) yrv = (ptile[c * 65 + 64] - ptile[c * 65]) * 256 + tt;
        u32x2 q[9][2]; float wk[9];
#pragma unroll
        for (int k = 0; k < 9; ++k) { const int yrow = __builtin_amdgcn_readlane(yrv, k); wk[k] = __int_as_float(__builtin_amdgcn_readlane(__float_as_int(wv), k)) * (1.f / Y_SCALE);
            const u32x2* yr = (const u32x2*)(y + (size_t)yrow * DM) + lane; q[k][0] = yr[0]; q[k][1] = yr[64]; }
#pragma unroll
        for (int k = 0; k < 9; ++k) {
#pragma unroll
            for (int j = 0; j < 2; ++j) { const float ws_ = wk[k]; const u32x2 qq = q[k][j];
                v[2 * j][0] += ws_ * __builtin_amdgcn_cvt_f32_fp8((int)qq.x, 0); v[2 * j][1] += ws_ * __builtin_amdgcn_cvt_f32_fp8((int)qq.x, 1); v[2 * j][2] += ws_ * __builtin_amdgcn_cvt_f32_fp8((int)qq.x, 2); v[2 * j][3] += ws_ * __builtin_amdgcn_cvt_f32_fp8((int)qq.x, 3);
                v[2 * j + 1][0] += ws_ * __builtin_amdgcn_cvt_f32_fp8((int)qq.y, 0); v[2 * j + 1][1] += ws_ * __builtin_amdgcn_cvt_f32_fp8((int)qq.y, 1); v[2 * j + 1][2] += ws_ * __builtin_amdgcn_cvt_f32_fp8((int)qq.y, 2); v[2 * j + 1][3] += ws_ * __builtin_amdgcn_cvt_f32_fp8((int)qq.y, 3); }
        }
        float s = 0.f;
#pragma unroll
        for (int j = 0; j < 4; ++j) s += (v[j].x + v[j].y) + (v[j].z + v[j].w);
        const float mean = wave_sum(s) * (1.f / DM); float s2 = 0.f;
#pragma unroll
        for (int j = 0; j < 4; ++j) { v[j] = v[j] - mean; s2 += (v[j].x * v[j].x + v[j].y * v[j].y) + (v[j].z * v[j].z + v[j].w * v[j].w); }
        const float rstd = 1.f / sqrtf(wave_sum(s2) * (1.f / DM) + LN_EPS);
#pragma unroll
        for (int j = 0; j < 2; ++j) {
            const int cb = 8 * lane + 512 * j;
            const f32x4 g0 = *(const f32x4*)(g + cb), g1 = *(const f32x4*)(g + cb + 4), b0 = *(const f32x4*)(be + cb), b1 = *(const f32x4*)(be + cb + 4);
            const f32x4 y0 = v[2 * j] * rstd * g0 + b0, y1 = v[2 * j + 1] * rstd * g1 + b1;
            xr[64 * j] = pack8(y0, y1);
            if (l == DEPTH - 1) { float* o = a.out + (size_t)row * DM + cb; *(f32x4*)o = y0; *(f32x4*)(o + 4) = y1; }
        }
    }
}

DI int pi32(int r) { return (r & ~12) | ((r & 4) << 1) | ((r & 8) >> 1); }
DI int kofs(int i, int hh) { return 16 * (i >> 3) + 8 * hh + (i & 7); }
DI bf16x8 pack_p(const float (&p)[16], int s) {
    u32x4 w; w.x = cvtpk(p[8 * s], p[8 * s + 1]); w.y = cvtpk(p[8 * s + 2], p[8 * s + 3]); w.z = cvtpk(p[8 * s + 4], p[8 * s + 5]); w.w = cvtpk(p[8 * s + 6], p[8 * s + 7]);
    return __builtin_bit_cast(bf16x8, w);
}
DI f32x16 zero16() { f32x16 z;
#pragma unroll
    for (int i = 0; i < 16; ++i) z[i] = 0.f; return z; }
DI void store_ot(bf16* dst, const f32x16& o0, const f32x16& o1, float sc, int hh) {
#pragma unroll
    for (int g = 0; g < 4; ++g) {
        float v[4];
#pragma unroll
        for (int q = 0; q < 4; ++q) v[q] = o0[4 * g + q] * sc;
        st4bf(dst + 8 * g + 4 * hh, v);
#pragma unroll
        for (int q = 0; q < 4; ++q) v[q] = o1[4 * g + q] * sc;
        st4bf(dst + 32 + 8 * g + 4 * hh, v);
    }
}

DI void load_kv(bf16x8 (&kf)[4], bf16x8 (&vf)[2][2], const bf16* kp, const bf16* vp) {
#pragma unroll
    for (int s = 0; s < 4; ++s) kf[s] = *(const bf16x8*)(kp + 16 * s);
#pragma unroll
    for (int dt = 0; dt < 2; ++dt)
#pragma unroll
        for (int s = 0; s < 2; ++s) vf[dt][s] = *(const bf16x8*)(vp + (size_t)dt * 32 * SEQ + 16 * s);
}
DI void copy_kv(bf16x8 (&kf)[4], bf16x8 (&vf)[2][2], const bf16x8 (&nkf)[4], const bf16x8 (&nvf)[2][2]) {
#pragma unroll
    for (int s = 0; s < 4; ++s) kf[s] = nkf[s];
#pragma unroll
    for (int dt = 0; dt < 2; ++dt)
#pragma unroll
        for (int s = 0; s < 2; ++s) vf[dt][s] = nvf[dt][s];
}

DI void sb_unit(const Args& a, int b, int h, int qb, int lane) {
    const bf16* proj = (const bf16*)(a.ws + WS_A);
    const int c = lane & 31, hh = lane >> 5, pr = pi32(c);
    const size_t tokq = (size_t)b * SEQ + qb * 32 + c;
    const bf16* qp = proj + tokq * PW + C_BQ + h * 64 + 8 * hh;
    bf16x8 qf[4];
#pragma unroll
    for (int s = 0; s < 4; ++s) qf[s] = *(const bf16x8*)(qp + 16 * s);
    f32x16 o0 = zero16(), o1 = zero16(); float R = 1.f;
    const bool slot0lo = (__builtin_amdgcn_permlane32_swap((unsigned)hh, (unsigned)hh, false, false)[0] == 0u);
    const bf16* kbase = proj + (size_t)b * SEQ * PW + C_BK + h * 64 + 8 * hh;
    const bf16* vb0 = (const bf16*)(a.ws + WS_VTB) + ((size_t)(b * 4 + h) * 64 + c) * SEQ + 8 * hh;
    bf16x8 kf[4], vf[2][2];
    load_kv(kf, vf, kbase + (size_t)(qb * 32 + pr) * PW, vb0 + qb * 32);
    for (int kt = qb; kt >= 0; --kt) {
        bf16x8 nkf[4], nvf[2][2];
        { const int kn = (kt > 0) ? kt - 1 : 0; load_kv(nkf, nvf, kbase + (size_t)(kn * 32 + pr) * PW, vb0 + kn * 32); }
        f32x16 x = zero16();
#pragma unroll
        for (int s = 0; s < 4; ++s) x = mfma32(kf[s], qf[s], x);
        const bool diag = (kt == qb);
        float rr[16], ex[16], T[2];
#pragma unroll
        for (int i = 0; i < 16; ++i) { float rv = frcp(1.f + fexp2(x[i])); if (diag && kofs(i, hh) >= c) rv = 1.f; rr[i] = rv; }
#pragma unroll
        for (int s = 0; s < 2; ++s) { ex[8 * s + 7] = 1.f;
#pragma unroll
            for (int j = 6; j >= 0; --j) ex[8 * s + j] = ex[8 * s + j + 1] * rr[8 * s + j + 1];
            T[s] = ex[8 * s] * rr[8 * s]; }
        const auto r0_ = __builtin_amdgcn_permlane32_swap(__float_as_uint(T[0]), __float_as_uint(T[0]), false, false), r1_ = __builtin_amdgcn_permlane32_swap(__float_as_uint(T[1]), __float_as_uint(T[1]), false, false);
        const float PT0 = __uint_as_float((hh != 0) == slot0lo ? r0_[0] : r0_[1]), PT1 = __uint_as_float((hh != 0) == slot0lo ? r1_[0] : r1_[1]);
        float suf0, suf1;
        if (hh == 0) { suf1 = R * PT1; suf0 = suf1 * T[1] * PT0; } else { suf1 = R; suf0 = R * T[1] * PT1; }
        R = R * (T[0] * T[1]) * (PT0 * PT1);
        float p[16];
#pragma unroll
        for (int i = 0; i < 16; ++i) p[i] = (1.f - rr[i]) * ex[i] * (i < 8 ? suf0 : suf1);
        const bf16x8 pb0 = pack_p(p, 0), pb1 = pack_p(p, 1);
        o0 = mfma32(vf[0][0], pb0, o0); o0 = mfma32(vf[0][1], pb1, o0);
        o1 = mfma32(vf[1][0], pb0, o1); o1 = mfma32(vf[1][1], pb1, o1);
        copy_kv(kf, vf, nkf, nvf);
    }
    store_ot((bf16*)(a.ws + WS_B) + tokq * DM + 256 + h * 64, o0, o1, 1.f, hh);
}

DI void fg_unit(const Args& a, int b, int h, int qb, int lane) {
    const bf16* proj = (const bf16*)(a.ws + WS_A);
    const int c = lane & 31, hh = lane >> 5, pr = pi32(c);
    const size_t tokq = (size_t)b * SEQ + qb * 32 + c;
    const bf16* qp = proj + tokq * PW + C_CQ + h * 64 + 8 * hh;
    bf16x8 qf[4];
#pragma unroll
    for (int s = 0; s < 4; ++s) qf[s] = *(const bf16x8*)(qp + 16 * s);
    const float* cum = (const float*)(a.ws + WS_CUM) + (size_t)(b * 4 + h) * SEQ;
    const float cq = cum[qb * 32 + c];
    f32x16 o0 = zero16(), o1 = zero16(); float m = -1.0e30f, l = 0.f;
    const bf16* kbase = proj + (size_t)b * SEQ * PW + C_CK + h * 64 + 8 * hh;
    const bf16* vb0 = (const bf16*)(a.ws + WS_VTC) + ((size_t)(b * 4 + h) * 64 + c) * SEQ + 8 * hh;
    bf16x8 kf[4], vf[2][2];
    load_kv(kf, vf, kbase + (size_t)pr * PW, vb0);
    for (int kt = 0; kt <= qb; ++kt) {
        const int k0 = kt * 32;
        bf16x8 nkf[4], nvf[2][2];
        { const int kn = (kt < qb) ? kt + 1 : kt; load_kv(nkf, nvf, kbase + (size_t)(kn * 32 + pr) * PW, vb0 + kn * 32); }
        float ck[16];
#pragma unroll
        for (int s = 0; s < 2; ++s) { const f32x4 c0 = *(const f32x4*)(cum + k0 + 16 * s + 8 * hh), c1 = *(const f32x4*)(cum + k0 + 16 * s + 8 * hh + 4);
            ck[8 * s] = c0.x; ck[8 * s + 1] = c0.y; ck[8 * s + 2] = c0.z; ck[8 * s + 3] = c0.w; ck[8 * s + 4] = c1.x; ck[8 * s + 5] = c1.y; ck[8 * s + 6] = c1.z; ck[8 * s + 7] = c1.w; }
        f32x16 x = zero16();
#pragma unroll
        for (int s = 0; s < 4; ++s) x = mfma32(kf[s], qf[s], x);
        const bool diag = (kt == qb);
        float sv[16]; float tmax = -1.0e30f;
#pragma unroll
        for (int i = 0; i < 16; ++i) { const bool ok = !(diag && kofs(i, hh) > c); sv[i] = ok ? (x[i] + (cq - ck[i])) : -1.0e30f; tmax = fmaxf(tmax, sv[i]); }
        tmax = red32_max(tmax);
        const float mn = fmaxf(m, tmax), al = fexp2(m - mn);
        float p[16]; float ls = 0.f;
#pragma unroll
        for (int i = 0; i < 16; ++i) { p[i] = (sv[i] > -1.0e29f) ? fexp2(sv[i] - mn) : 0.f; ls += p[i]; }
        l = l * al + ls; m = mn;
#pragma unroll
        for (int i = 0; i < 16; ++i) { o0[i] *= al; o1[i] *= al; }
        const bf16x8 pb0 = pack_p(p, 0), pb1 = pack_p(p, 1);
        o0 = mfma32(vf[0][0], pb0, o0); o0 = mfma32(vf[0][1], pb1, o0);
        o1 = mfma32(vf[1][0], pb0, o1); o1 = mfma32(vf[1][1], pb1, o1);
        copy_kv(kf, vf, nkf, nvf);
    }
    const float lt = red32_sum(l);
    store_ot((bf16*)(a.ws + WS_B) + tokq * DM + 512 + h * 64, o0, o1, 1.f / lt, hh);
}


DI void atile_load(u32x4& reg, const bf16* kt0, const bf16* vt0, int kt, int tid) {
    reg = (tid < 256) ? *(const u32x4*)(kt0 + (size_t)kt * 2048 + tid * 8) : *(const u32x4*)(vt0 + (size_t)kt * 2048 + (tid - 256) * 8);
}
DI void atile_store(LAS unsigned char* buf, const u32x4& reg, int tid) { *(LAS u32x4*)(buf + tid * 16) = reg; }
DI void atile_frags(bf16x8 (&kf)[4], bf16x8 (&vf)[2][2], const LAS unsigned char* buf, int c, int hh, int prow) {
    (void)prow;
#pragma unroll
    for (int s = 0; s < 4; ++s) kf[s] = *(const LAS bf16x8*)(buf + ((2 * s + hh) * 32 + c) * 16);
#pragma unroll
    for (int dt = 0; dt < 2; ++dt)
#pragma unroll
        for (int s = 0; s < 2; ++s) vf[dt][s] = *(const LAS bf16x8*)(buf + 4096 + ((dt * 2 + s) * 64 + hh * 32 + c) * 16);
}
template <int MIXER>
DI void sbfg_block(const Args& a, int l, int b, int h, int QB, LAS unsigned char* lds, int tid, int wave, int lane) {
    const bf16* proj = (const bf16*)(a.ws + WS_A);
    const int c = lane & 31, hh = lane >> 5, pr = pi32(c);
    const int ntile = 8 * QB + 8, qb = 8 * QB + wave;
    const size_t tokq = (size_t)b * SEQ + qb * 32 + c;
    const bf16* qp = proj + tokq * PW + (MIXER == 0 ? C_BQ : C_CQ) + h * 64 + 8 * hh;
    bf16x8 qf[4];
#pragma unroll
    for (int s = 0; s < 4; ++s) qf[s] = *(const bf16x8*)(qp + 16 * s);
    const bf16* krow0 = (const bf16*)(a.ws + (MIXER == 0 ? WS_KTB : WS_KTC)) + (size_t)(b * 4 + h) * (SEQ / 32) * 2048;
    const bf16* vt0 = (const bf16*)(a.ws + (MIXER == 0 ? WS_VTB : WS_VTC)) + (size_t)(b * 4 + h) * (SEQ / 32) * 2048;
    const float* cum = (const float*)(a.ws + WS_CUM) + (size_t)(b * 4 + h) * SEQ;
    const float cq = (MIXER == 1) ? cum[qb * 32 + c] : 0.f;
    float Bq = 0.f;
    if (MIXER == 1) { float qs = 0.f;
#pragma unroll
        for (int s = 0; s < 4; ++s) { const u32x4 w = __builtin_bit_cast(u32x4, qf[s]);
            qs += bflo(w.x) * bflo(w.x) + bfhi(w.x) * bfhi(w.x) + bflo(w.y) * bflo(w.y) + bfhi(w.y) * bfhi(w.y) + bflo(w.z) * bflo(w.z) + bfhi(w.z) * bfhi(w.z) + bflo(w.w) * bflo(w.w) + bfhi(w.w) * bfhi(w.w); }
        qs = red32_sum(qs);
        const float k2 = __uint_as_float(((const unsigned*)(a.ws + WS_CTL))[CW_KMAX + l * 32 + b * 4 + h]);
        Bq = sqrtf(qs * k2) * 1.01f + 0.5f; }
    f32x16 o0 = zero16(), o1 = zero16(); float R = 1.f, m = -1.0e30f, l_ = 0.f;
    const bool slot0lo = (__builtin_amdgcn_permlane32_swap((unsigned)hh, (unsigned)hh, false, false)[0] == 0u);
    u32x4 reg;
    atile_load(reg, krow0, vt0, ntile - 1, tid); atile_store(lds, reg, tid);
    if (ntile > 1) { atile_load(reg, krow0, vt0, ntile - 2, tid); atile_store(lds + 8192, reg, tid); }
    __syncthreads();
    bf16x8 kfA[4], vfA[2][2], kfB[4], vfB[2][2];
    atile_frags(kfA, vfA, lds, c, hh, pr);
    int st = 0;
#define SBFG_STEP(JJ, KF, VF, NKF, NVF) { \
        const int kt = ntile - 1 - (JJ); \
        const int st1 = (st == 2) ? 0 : st + 1, st2 = (st1 == 2) ? 0 : st1 + 1; \
        if ((JJ) + 2 < ntile) atile_load(reg, krow0, vt0, kt - 2, tid); \
        if ((JJ) + 1 < ntile) atile_frags(NKF, NVF, lds + st1 * 8192, c, hh, pr); \
        if (kt <= qb) { \
            f32x16 x = zero16(); \
_Pragma("unroll") \
            for (int s = 0; s < 4; ++s) x = mfma32(KF[s], qf[s], x); \
            const bool diag = (kt == qb); \
            float p[16]; \
            if (MIXER == 0) { \
                float rr[16], ex[16], T[2]; \
_Pragma("unroll") \
                for (int i = 0; i < 16; ++i) rr[i] = frcp(1.f + fexp2(x[i])); \
                if (diag) { \
_Pragma("unroll") \
                    for (int i = 0; i < 16; ++i) if (kofs(i, hh) >= c) rr[i] = 1.f; \
                } \
_Pragma("unroll") \
                for (int s = 0; s < 2; ++s) { ex[8 * s + 7] = 1.f; \
_Pragma("unroll") \
                    for (int q = 6; q >= 0; --q) ex[8 * s + q] = ex[8 * s + q + 1] * rr[8 * s + q + 1]; \
                    T[s] = ex[8 * s] * rr[8 * s]; } \
                const auto r0_ = __builtin_amdgcn_permlane32_swap(__float_as_uint(T[0]), __float_as_uint(T[0]), false, false), r1_ = __builtin_amdgcn_permlane32_swap(__float_as_uint(T[1]), __float_as_uint(T[1]), false, false); \
                const float PT0 = __uint_as_float((hh != 0) == slot0lo ? r0_[0] : r0_[1]), PT1 = __uint_as_float((hh != 0) == slot0lo ? r1_[0] : r1_[1]); \
                float suf0, suf1; \
                if (hh == 0) { suf1 = R * PT1; suf0 = suf1 * T[1] * PT0; } else { suf1 = R; suf0 = R * T[1] * PT1; } \
                R = R * (T[0] * T[1]) * (PT0 * PT1); \
_Pragma("unroll") \
                for (int i = 0; i < 16; ++i) p[i] = (ex[i] - ex[i] * rr[i]) * (i < 8 ? suf0 : suf1); \
            } else { \
                const int k0 = kt * 32; \
                float ck[16]; \
_Pragma("unroll") \
                for (int s = 0; s < 2; ++s) { const f32x4 c0 = *(const f32x4*)(cum + k0 + 16 * s + 8 * hh), c1 = *(const f32x4*)(cum + k0 + 16 * s + 8 * hh + 4); \
                    ck[8 * s] = c0.x; ck[8 * s + 1] = c0.y; ck[8 * s + 2] = c0.z; ck[8 * s + 3] = c0.w; ck[8 * s + 4] = c1.x; ck[8 * s + 5] = c1.y; ck[8 * s + 6] = c1.z; ck[8 * s + 7] = c1.w; } \
                float sv[16]; float tmax = -1.0e30f; \
_Pragma("unroll") \
                for (int i = 0; i < 16; ++i) sv[i] = x[i] + (cq - ck[i]); \
                if (diag) { \
_Pragma("unroll") \
                    for (int i = 0; i < 16; ++i) if (kofs(i, hh) > c) sv[i] = -1.0e30f; \
                } \
_Pragma("unroll") \
                for (int i = 0; i < 16; ++i) tmax = fmaxf(tmax, sv[i]); \
                tmax = red32_max(tmax); \
                if (__any(tmax > m)) { \
                    const float mn = fmaxf(m, tmax), al = fexp2(m - mn); m = mn; l_ *= al; \
_Pragma("unroll") \
                    for (int i = 0; i < 16; ++i) { o0[i] *= al; o1[i] *= al; } \
                } \
                float ls = 0.f; \
_Pragma("unroll") \
                for (int i = 0; i < 16; ++i) { p[i] = fexp2(sv[i] - m); ls += p[i]; } \
                l_ += ls; \
            } \
            const bf16x8 pb0 = pack_p(p, 0), pb1 = pack_p(p, 1); \
            o0 = mfma32(VF[0][0], pb0, o0); o0 = mfma32(VF[0][1], pb1, o0); \
            o1 = mfma32(VF[1][0], pb0, o1); o1 = mfma32(VF[1][1], pb1, o1); \
        } \
        if ((JJ) + 2 < ntile) atile_store(lds + st2 * 8192, reg, tid); \
        __syncthreads(); \
        st = st1; \
    }
    LAS unsigned* dflag = (LAS unsigned*)(lds + 24576);
    for (int j = 0; j < ntile; j += 2) {
        SBFG_STEP(j, kfA, vfA, kfB, vfB)
        {
            const int ktj = ntile - 1 - j; const bool started = ktj <= qb;
            bool fin;
            if (MIXER == 0) fin = started && __all(R < 1.0e-12f);
            else { const float cn = (ktj >= 1) ? cum[32 * ktj - 1] : 0.f; fin = started && (ktj >= 1) && __all(Bq + (cq - cn) < m - 40.f); }
            if (lane == 0) dflag[((j >> 1) & 1) * 8 + wave] = fin ? 1u : 0u;
        }
        SBFG_STEP(j + 1, kfB, vfB, kfA, vfA)
        {
            const u32x4 f0 = *(const LAS u32x4*)(dflag + ((j >> 1) & 1) * 8), f1 = *(const LAS u32x4*)(dflag + ((j >> 1) & 1) * 8 + 4);
            if ((f0.x & f0.y & f0.z & f0.w & f1.x & f1.y & f1.z & f1.w) != 0u) break;
        }
    }
#undef SBFG_STEP
    if (MIXER == 0) store_ot((bf16*)(a.ws + WS_B) + tokq * DM + 256 + h * 64, o0, o1, 1.f, hh);
    else { const float lt = red32_sum(l_); store_ot((bf16*)(a.ws + WS_B) + tokq * DM + 512 + h * 64, o0, o1, 1.f / lt, hh); }
}

DI void osm_step(const f32x16& x, int lo, int hi, int hh, float& m, float& l, f32x16& o0, f32x16& o1, const bf16x8 (&vf)[2][2]) {
    float sv[16]; float tmax = -3.0e38f;
#pragma unroll
    for (int i = 0; i < 16; ++i) { const int ko = kofs(i, hh); sv[i] = (ko <= hi && ko >= lo) ? x[i] : -3.0e38f; tmax = fmaxf(tmax, sv[i]); }
    tmax = red32_max(tmax);
    if (__any(tmax > m)) { const float mn = fmaxf(m, tmax), al = fexp2(m - mn); m = mn; l *= al;
#pragma unroll
        for (int i = 0; i < 16; ++i) { o0[i] *= al; o1[i] *= al; } }
    float p[16]; float ls = 0.f;
#pragma unroll
    for (int i = 0; i < 16; ++i) { p[i] = fexp2(sv[i] - m); ls += p[i]; }
    l += ls;
    const bf16x8 pb0 = pack_p(p, 0), pb1 = pack_p(p, 1);
    o0 = mfma32(vf[0][0], pb0, o0); o0 = mfma32(vf[0][1], pb1, o0);
    o1 = mfma32(vf[1][0], pb0, o1); o1 = mfma32(vf[1][1], pb1, o1);
}

DI void ld_k4(bf16x8 (&kf)[4], const bf16* kp) {
#pragma unroll
    for (int s = 0; s < 4; ++s) kf[s] = *(const bf16x8*)(kp + 16 * s);
}
DI void ld_v4(bf16x8 (&vf)[2][2], const bf16* vp, int vpitch) {
#pragma unroll
    for (int dt = 0; dt < 2; ++dt)
#pragma unroll
        for (int s = 0; s < 2; ++s) vf[dt][s] = *(const bf16x8*)(vp + (size_t)dt * 32 * vpitch + 16 * s);
}
DI void ld_kt(bf16x8 (&kf)[4], const bf16* tile, int c, int hh) {
#pragma unroll
    for (int s = 0; s < 4; ++s) kf[s] = *(const bf16x8*)(tile + ((2 * s + hh) * 32 + c) * 8);
}
DI void ld_vt(bf16x8 (&vf)[2][2], const bf16* tile, int c, int hh) {
#pragma unroll
    for (int dt = 0; dt < 2; ++dt)
#pragma unroll
        for (int s = 0; s < 2; ++s) vf[dt][s] = *(const bf16x8*)(tile + ((dt * 2 + s) * 64 + hh * 32 + c) * 8);
}
DI void nsa_unit(const Args& a, int unit, LAS unsigned char* wl, int lane) {
    const bf16* proj = (const bf16*)(a.ws + WS_A);
    const int tok0 = unit * 8, b = tok0 / SEQ, t0 = tok0 % SEQ;
    const int c = lane & 31, hh = lane >> 5, ql = c >> 2, hd = c & 3, pr = pi32(c);
    const int tq = t0 + ql; const size_t tokq = (size_t)tok0 + ql;
    const bf16* qp = proj + tokq * PW + C_AQ + hd * 64 + 8 * hh;
    bf16x8 qf[4];
#pragma unroll
    for (int s = 0; s < 4; ++s) qf[s] = *(const bf16x8*)(qp + 16 * s);
    LAS float* imp = (LAS float*)wl; LAS unsigned* selm = (LAS unsigned*)(wl + 4096); LAS unsigned char* blist = (LAS unsigned char*)(wl + 4096 + 128);
    for (int i = lane; i < 1024; i += 64) imp[i] = 0.f;
    const float* gate = (const float*)(a.ws + WS_GATE) + tokq * 12 + hd * 3;
    const float g0 = gate[0], g1 = gate[1], g2 = gate[2];
    f32x16 of0 = zero16(), of1 = zero16();
    {
        const bf16* kc = (const bf16*)(a.ws + WS_KCMP) + (size_t)b * 16 * 2048;
        const bf16* vt = (const bf16*)(a.ws + WS_VTCMP) + (size_t)b * 16 * 2048;
        const int nmaxq = (tq >= 31) ? ((tq - 31) >> 4) : -1;
        const int nmaxu = (t0 + 7 >= 31) ? ((t0 + 7 - 31) >> 4) : -1;
        const int ntile = (nmaxu >> 5) + 1;
        float m = -1.0e30f, l = 0.f;
        bf16x8 kf[4], nkf[4];
        if (ntile > 0) ld_kt(kf, kc, c, hh);
        for (int kt = 0; kt < ntile; ++kt) {
            ld_kt(nkf, kc + (size_t)(kt + 1 < ntile ? kt + 1 : kt) * 2048, c, hh);
            f32x16 x = zero16();
#pragma unroll
            for (int s = 0; s < 4; ++s) x = mfma32(kf[s], qf[s], x);
            const int lim = nmaxq - kt * 32; float sv[16]; float tmax = -3.0e38f;
#pragma unroll
            for (int i = 0; i < 16; ++i) { sv[i] = (kofs(i, hh) <= lim) ? x[i] : -3.0e38f; tmax = fmaxf(tmax, sv[i]); }
            tmax = red32_max(tmax);
            const float mn = fmaxf(m, tmax); float ls = 0.f;
#pragma unroll
            for (int i = 0; i < 16; ++i) ls += fexp2(sv[i] - mn);
            l = l * fexp2(m - mn) + ls; m = mn;
#pragma unroll
            for (int s = 0; s < 4; ++s) kf[s] = nkf[s];
        }
        const float lt = red32_sum(l);
        const float inv = 1.f / fmaxf(lt, 1.0e-30f);
        f32x16 o0 = zero16(), o1 = zero16();
        LDS_WAIT();
        bf16x8 vf[2][2], nvf[2][2];
        if (ntile > 0) { ld_kt(kf, kc, c, hh); ld_vt(vf, vt, c, hh); }
        for (int kt = 0; kt < ntile; ++kt) {
            { const int kn = (kt + 1 < ntile ? kt + 1 : kt); ld_kt(nkf, kc + (size_t)kn * 2048, c, hh); ld_vt(nvf, vt + (size_t)kn * 2048, c, hh); }
            f32x16 x = zero16();
#pragma unroll
            for (int s = 0; s < 4; ++s) x = mfma32(kf[s], qf[s], x);
            float p[16], ps[16];
#pragma unroll
            for (int i = 0; i < 16; ++i) { p[i] = (kofs(i, hh) <= nmaxq - kt * 32) ? fexp2(x[i] - m) * inv : 0.f;
                float t = p[i]; t += dpp_xor1(t); t += dpp_xor2(t); ps[i] = t; }
            if (hd == 0) {
#pragma unroll
                for (int s = 0; s < 2; ++s) { const int gb = (kt * 32 + 16 * s + 8 * hh) >> 2; LAS float* ip = imp + ql * 128 + gb;
                    __hip_atomic_fetch_add(ip, (ps[8 * s] + ps[8 * s + 1]) + (ps[8 * s + 2] + ps[8 * s + 3]), __ATOMIC_RELAXED, __HIP_MEMORY_SCOPE_WORKGROUP);
                    __hip_atomic_fetch_add(ip + 1, ps[8 * s + 3] + (ps[8 * s + 4] + ps[8 * s + 5]) + (ps[8 * s + 6] + ps[8 * s + 7]), __ATOMIC_RELAXED, __HIP_MEMORY_SCOPE_WORKGROUP);
                    if (gb + 2 < 128) __hip_atomic_fetch_add(ip + 2, ps[8 * s + 7], __ATOMIC_RELAXED, __HIP_MEMORY_SCOPE_WORKGROUP); }
            }
            const bf16x8 pb0 = pack_p(p, 0), pb1 = pack_p(p, 1);
            o0 = mfma32(vf[0][0], pb0, o0); o0 = mfma32(vf[0][1], pb1, o0);
            o1 = mfma32(vf[1][0], pb0, o1); o1 = mfma32(vf[1][1], pb1, o1);
            copy_kv(kf, vf, nkf, nvf);
        }
#pragma unroll
        for (int i = 0; i < 16; ++i) { of0[i] = g0 * o0[i]; of1[i] = g0 * o1[i]; }
    }
    LDS_WAIT();
    for (int qi = 0; qi < 8; ++qi) {
        const int qblk = (t0 + qi) >> 6;
        const LAS float* iq = imp + qi * 128;
        const int b0 = lane, b1 = lane + 64;
        const bool ad0 = b0 <= qblk, ad1 = b1 <= qblk;
        const bool f0 = (b0 == 0) || (b0 == qblk) || (b0 == qblk - 1), f1 = (b1 == qblk) || (b1 == qblk - 1);
        float v0 = ad0 ? (f0 ? iq[b0] + 1.0e6f : iq[b0]) : -1.0e30f, v1 = ad1 ? (f1 ? iq[b1] + 1.0e6f : iq[b1]) : -1.0e30f;
        unsigned long long m0 = 0ull, m1 = 0ull;
        const int nsel = (qblk + 1 < 16) ? qblk + 1 : 16;
        for (int r = 0; r < nsel; ++r) {
            const float mx = wave_max(fmaxf(v0, v1));
            const unsigned long long e0 = __ballot(v0 == mx);
            if (e0) { const int idx = __builtin_ctzll(e0); m0 |= 1ull << idx; if (lane == idx) v0 = -1.0e30f; }
            else { const unsigned long long e1 = __ballot(v1 == mx); const int idx = __builtin_ctzll(e1); m1 |= 1ull << idx; if (lane == idx) v1 = -1.0e30f; }
        }
        if (lane == 0) { selm[qi * 4] = (unsigned)m0; selm[qi * 4 + 1] = (unsigned)(m0 >> 32); selm[qi * 4 + 2] = (unsigned)m1; selm[qi * 4 + 3] = (unsigned)(m1 >> 32); }
    }
    LDS_WAIT();
    {
        unsigned mk[4], um[4]; int nb = 0;
#pragma unroll
        for (int w = 0; w < 4; ++w) { mk[w] = selm[ql * 4 + w]; unsigned u = 0;
#pragma unroll
            for (int q = 0; q < 8; ++q) u |= selm[q * 4 + w];
            um[w] = (unsigned)__builtin_amdgcn_readfirstlane((int)u); }
#pragma unroll
        for (int w = 0; w < 4; ++w) { const unsigned u = um[w]; const int l32 = lane & 31;
            if (lane < 32 && ((u >> l32) & 1u)) blist[nb + __builtin_popcount(u & ((1u << l32) - 1u))] = (unsigned char)(32 * w + l32);
            nb += __builtin_popcount(u); }
        LDS_WAIT();
        const bf16* kbase = (const bf16*)(a.ws + WS_KTS) + (size_t)b * (SEQ / 32) * 2048;
        const bf16* vb0 = (const bf16*)(a.ws + WS_VTAS) + (size_t)b * (SEQ / 32) * 2048;
        f32x16 o0 = zero16(), o1 = zero16(); float m = -1.0e30f, l = 0.f;
        const int nt = 2 * nb;
        bf16x8 kf[4], vf[2][2], nkf[4], nvf[2][2];
        int blk = blist[0];
        { const int t0i = blk * 2; ld_kt(kf, kbase + (size_t)t0i * 2048, c, hh); ld_vt(vf, vb0 + (size_t)t0i * 2048, c, hh); }
#define NSA_SEL_STEP(TT, KF, VF, NKF, NVF) { \
            const int k0 = blk * 64 + 32 * ((TT) & 1); \
            const int tn = ((TT) + 1 < nt) ? (TT) + 1 : (TT); const int blkn = blist[tn >> 1]; \
            { const int tni = blkn * 2 + (tn & 1); ld_kt(NKF, kbase + (size_t)tni * 2048, c, hh); ld_vt(NVF, vb0 + (size_t)tni * 2048, c, hh); } \
            const bool mysel = ((((blk >> 5) == 0 ? mk[0] : (blk >> 5) == 1 ? mk[1] : (blk >> 5) == 2 ? mk[2] : mk[3]) >> (blk & 31)) & 1u) != 0u; \
            f32x16 x = zero16(); \
            _Pragma("unroll") for (int s = 0; s < 4; ++s) x = mfma32(KF[s], qf[s], x); \
            osm_step(x, 0, mysel ? tq - k0 : -1, hh, m, l, o0, o1, VF); \
            blk = blkn; }
        for (int t = 0; t < nt; t += 2) {
            NSA_SEL_STEP(t, kf, vf, nkf, nvf)
            NSA_SEL_STEP(t + 1, nkf, nvf, kf, vf)
        }
#undef NSA_SEL_STEP
        const float lt = red32_sum(l); const float sc = g1 / fmaxf(lt, 1.0e-30f);
#pragma unroll
        for (int i = 0; i < 16; ++i) { of0[i] += sc * o0[i]; of1[i] += sc * o1[i]; }
    }
    {
        const bf16* kbase = (const bf16*)(a.ws + WS_KTW) + (size_t)b * (SEQ / 32) * 2048;
        const bf16* vb0 = (const bf16*)(a.ws + WS_VTAW) + (size_t)b * (SEQ / 32) * 2048;
        f32x16 o0 = zero16(), o1 = zero16(); float m = -1.0e30f, l = 0.f;
        const int klo = (t0 >= 511) ? ((t0 - 511) >> 5) : 0, khi = (t0 + 7) >> 5;
        bf16x8 kf[4], vf[2][2], nkf[4], nvf[2][2];
        ld_kt(kf, kbase + (size_t)klo * 2048, c, hh); ld_vt(vf, vb0 + (size_t)klo * 2048, c, hh);
        for (int kt = klo; kt <= khi; ++kt) {
            const int k0 = kt * 32;
            { const int kn = (kt < khi ? kt + 1 : kt); ld_kt(nkf, kbase + (size_t)kn * 2048, c, hh); ld_vt(nvf, vb0 + (size_t)kn * 2048, c, hh); }
            f32x16 x = zero16();
#pragma unroll
            for (int s = 0; s < 4; ++s) x = mfma32(kf[s], qf[s], x);
            osm_step(x, tq - 511 - k0, tq - k0, hh, m, l, o0, o1, vf);
            copy_kv(kf, vf, nkf, nvf);
        }
        const float lt = red32_sum(l); const float sc = g2 / fmaxf(lt, 1.0e-30f);
#pragma unroll
        for (int i = 0; i < 16; ++i) { of0[i] += sc * o0[i]; of1[i] += sc * o1[i]; }
    }
    store_ot((bf16*)(a.ws + WS_B) + tokq * DM + hd * 64, of0, of1, 1.f, hh);
}

#ifndef DSA_REP_S
#define DSA_REP_S 1
#define DSA_REP_L 1
#define DSA_REP_A 1
#endif
#ifndef DSA_REP_1
#define DSA_REP_1 1
#define DSA_REP_2 1
#define DSA_REP_3 1
#endif
constexpr int DSA_CIDX = 132096, DSA_LIST = DSA_CIDX + 16384, DSA_DUMMY = DSA_LIST + 8192;  static_assert(DSA_DUMMY + 8 * 128 <= MISC_OFF, "DSA LDS map");
static_assert(DSA_LIST + 8192 <= MISC_OFF, "DSA LDS map");
typedef short v4i16_t __attribute__((ext_vector_type(4)));
DI unsigned f2key(float f) { const unsigned u = __float_as_uint(f); return u ^ ((u >> 31) ? 0xffffffffu : 0x80000000u); }
DI int wave_excl_scan(int v, int lane) { (void)lane; return wave_incl_scan(v) - v; }
DI int wave_sum_i(int v) {
    v += DPPI(v, 0xB1, 0xF, true); v += DPPI(v, 0x4E, 0xF, true); v += DPPI(v, 0x124, 0xF, true); v += DPPI(v, 0x128, 0xF, true);
    const auto r = __builtin_amdgcn_permlane16_swap((unsigned)v, (unsigned)v, false, false); v = (int)(r[0] + r[1]);
    const auto q = __builtin_amdgcn_permlane32_swap((unsigned)v, (unsigned)v, false, false); return (int)(q[0] + q[1]);
}
DI unsigned kth_reg16(const unsigned (&k)[16], int K) {
    unsigned hi = 0u, lo = 0xffffffffu;
#pragma unroll
    for (int j = 0; j < 16; ++j) { hi = (k[j] > hi) ? k[j] : hi; const unsigned kk = k[j] ? k[j] : 0xffffffffu; lo = (kk < lo) ? kk : lo; }
    hi = max(hi, (unsigned)DPPI((int)hi, 0xB1, 0xF, true)); hi = max(hi, (unsigned)DPPI((int)hi, 0x4E, 0xF, true));
    lo = min(lo, (unsigned)__builtin_amdgcn_update_dpp((int)0xffffffff, (int)lo, 0xB1, 0xF, 0xF, false)); lo = min(lo, (unsigned)__builtin_amdgcn_update_dpp((int)0xffffffff, (int)lo, 0x4E, 0xF, 0xF, false));
    hi = max(hi, (unsigned)DPPI((int)hi, 0x124, 0xF, true)); hi = max(hi, (unsigned)DPPI((int)hi, 0x128, 0xF, true));
    lo = min(lo, (unsigned)__builtin_amdgcn_update_dpp((int)0xffffffff, (int)lo, 0x124, 0xF, 0xF, false)); lo = min(lo, (unsigned)__builtin_amdgcn_update_dpp((int)0xffffffff, (int)lo, 0x128, 0xF, 0xF, false));
    { const auto r = __builtin_amdgcn_permlane16_swap(hi, hi, false, false); hi = max(r[0], r[1]); const auto q = __builtin_amdgcn_permlane32_swap(hi, hi, false, false); hi = max(q[0], q[1]); }
    { const auto r = __builtin_amdgcn_permlane16_swap(lo, lo, false, false); lo = min(r[0], r[1]); const auto q = __builtin_amdgcn_permlane32_swap(lo, lo, false, false); lo = min(q[0], q[1]); }
    const unsigned diff = (unsigned)__builtin_amdgcn_readfirstlane((int)(hi ^ lo));
    if (diff == 0u) return (unsigned)__builtin_amdgcn_readfirstlane((int)hi);
    const int top = 31 - __builtin_clz(diff);
    unsigned prefix = (unsigned)__builtin_amdgcn_readfirstlane((int)hi) & ~((2u << top) - 1u);
#pragma unroll 1
    for (int bit = top; bit >= 0; --bit) {
        const unsigned cand = prefix | (1u << bit); int c = 0;
#pragma unroll
        for (int j = 0; j < 16; ++j) c += __builtin_popcountll(__ballot(k[j] >= cand));
        if (c >= K) prefix = cand;
    }
    return prefix;
}
DI void dsa_attend(const Args& a, const bf16* proj, int b, size_t tokq, const LAS unsigned short* list, int cnt, LAS unsigned char* stg, int lane) {
        const int col = lane & 15, quad = lane >> 4, hd = col & 3;
        const bf16* qp = proj + tokq * PW + C_DQ + hd * 64 + 8 * quad;
        const bf16x8 qb0 = *(const bf16x8*)qp, qb1 = *(const bf16x8*)(qp + 32);
        const bf16* krow0 = proj + (size_t)b * SEQ * PW + C_DK; const bf16* vrow0 = proj + (size_t)b * SEQ * PW + C_DV;
        const int grow_ = lane >> 3, piece_ = lane & 7;
        f32x4 o[4];
#pragma unroll
        for (int dt = 0; dt < 4; ++dt) o[dt] = (f32x4){0.f, 0.f, 0.f, 0.f};
        float mrun = -1.0e30f, ls = 0.f;
#pragma unroll 1
        for (int ch = 0; ch < 2; ++ch) {
            if (ch * 128 >= cnt) break;
            int grow = grow_, piece = piece_; asm volatile("" : "+v"(grow), "+v"(piece));
            u32x4 wk[16], wv[16];
#pragma unroll
            for (int it = 0; it < 16; ++it) { const int j = ch * 128 + it * 8 + grow; const unsigned kidx = (j < cnt) ? (unsigned)list[j] : 0u;
                wk[it] = *(const u32x4*)(krow0 + (size_t)kidx * PW + 8 * piece); wv[it] = *(const u32x4*)(vrow0 + (size_t)kidx * PW + 8 * piece); }
#pragma unroll
            for (int it = 0; it < 16; ++it) { const int row = it * 8 + grow; *(LAS u32x4*)(stg + row * 128 + ((piece ^ (row & 7)) * 16)) = wk[it]; }
            LDS_WAIT();
            float sr[8][4];
            {
                int colq = col, quadq = quad; asm volatile("" : "+v"(colq), "+v"(quadq));
#pragma unroll
                for (int kt = 0; kt < 8; ++kt) {
                    const int row = kt * 16 + colq;
                    const bf16x8 a0 = *(const LAS bf16x8*)(stg + row * 128 + ((quadq ^ (row & 7)) * 16)), a1 = *(const LAS bf16x8*)(stg + row * 128 + (((quadq + 4) ^ (row & 7)) * 16));
                    f32x4 d = (f32x4){0.f, 0.f, 0.f, 0.f};
                    d = mfma16(a0, qb0, d); d = mfma16(a1, qb1, d);
#pragma unroll
                    for (int i = 0; i < 4; ++i) sr[kt][i] = (ch * 128 + kt * 16 + 4 * quadq + i < cnt) ? d[i] : -1.0e30f;
                }
            }
            float mx = -1.0e30f;
#pragma unroll
            for (int kt = 0; kt < 8; ++kt)
#pragma unroll
                for (int i = 0; i < 4; ++i) mx = fmaxf(mx, sr[kt][i]);
            mx = red16_max(mx); mx = red32_max(mx);
            const float mn = fmaxf(mrun, mx), al = fexp2(mrun - mn); mrun = mn;
            float lc = 0.f;
#pragma unroll
            for (int kt = 0; kt < 8; ++kt)
#pragma unroll
                for (int i = 0; i < 4; ++i) { const float p = (sr[kt][i] > -1.0e29f) ? fexp2(sr[kt][i] - mn) : 0.f; sr[kt][i] = p; lc += p; }
            lc = red16_sum(lc); lc = red32_sum(lc);
            ls = ls * al + lc;
#pragma unroll
            for (int dt = 0; dt < 4; ++dt) o[dt] = o[dt] * al;
            LDS_WAIT();
#pragma unroll
            for (int it = 0; it < 16; ++it) { const int row = it * 8 + grow; *(LAS u32x4*)(stg + row * 128 + ((piece ^ (row & 7)) * 16)) = wv[it]; }
            LDS_WAIT();
            {
                int colp = col, quadp = quad; asm volatile("" : "+v"(colp), "+v"(quadp));
#pragma unroll
                for (int g = 0; g < 4; ++g) {
                    u32x4 pw; pw.x = cvtpk(sr[2 * g][0], sr[2 * g][1]); pw.y = cvtpk(sr[2 * g][2], sr[2 * g][3]); pw.z = cvtpk(sr[2 * g + 1][0], sr[2 * g + 1][1]); pw.w = cvtpk(sr[2 * g + 1][2], sr[2 * g + 1][3]);
                    const bf16x8 pb = __builtin_bit_cast(bf16x8, pw);
                    const int klo = 32 * g + 4 * quadp + (colp >> 2), khi = klo + 16;
#pragma unroll
                    for (int dt = 0; dt < 4; ++dt) { const int pc = 2 * dt + ((colp & 3) >> 1), bo = (colp & 1) * 8;
                        const v4i16_t lo = __builtin_amdgcn_ds_read_tr16_b64_v4i16((LAS v4i16_t*)(stg + klo * 128 + ((pc ^ (klo & 7)) * 16) + bo));
                        const v4i16_t hi = __builtin_amdgcn_ds_read_tr16_b64_v4i16((LAS v4i16_t*)(stg + khi * 128 + ((pc ^ (khi & 7)) * 16) + bo));
                        const bf16x8 av = (bf16x8){lo[0], lo[1], lo[2], lo[3], hi[0], hi[1], hi[2], hi[3]};
                        o[dt] = mfma16(av, pb, o[dt]); }
                }
            }
            LDS_WAIT();
        }
        if (col < 4) { const float inv = 1.f / ls; bf16* om = (bf16*)(a.ws + WS_B) + tokq * DM + 768 + hd * 64 + 4 * quad;
#pragma unroll
            for (int dt = 0; dt < 4; ++dt) { float v[4] = {o[dt][0] * inv, o[dt][1] * inv, o[dt][2] * inv, o[dt][3] * inv}; st4bf(om + 16 * dt, v); } }
    }

DI void dsa_attend2(const Args& a, const bf16* proj, int b, size_t tokA, const LAS unsigned short* listA, int cntA, size_t tokB, const LAS unsigned short* listB, int cntB, LAS unsigned char* stg, int lane) {
    const int col = lane & 15, quad = lane >> 4, hd = col & 3;
    const bf16* krow0 = proj + (size_t)b * SEQ * PW + C_DK; const bf16* vrow0 = proj + (size_t)b * SEQ * PW + C_DV;
    const int grow_ = lane >> 3, piece_ = lane & 7;
    const int ncA = (cntA + 63) >> 6, nc = ncA + ((cntB + 63) >> 6);
    bf16x8 qb0, qb1; f32x4 o[4]; float mrun = -1.0e30f, ls = 0.f;
    u32x4 wk0[8], wv0[8], wk1[8], wv1[8];
#define DSA_GATHER(WK, WV, CI) { const bool isb_ = (CI) >= ncA; const int ch_ = isb_ ? (CI) - ncA : (CI); const int cnt_ = isb_ ? cntB : cntA; const LAS unsigned short* li_ = isb_ ? listB : listA; \
        int grow = grow_, piece = piece_; asm volatile("" : "+v"(grow), "+v"(piece)); \
        _Pragma("unroll") for (int it = 0; it < 8; ++it) { const int j = ch_ * 64 + it * 8 + grow; const unsigned kidx = (j < cnt_) ? (unsigned)li_[j] : 0u; \
            WK[it] = *(const u32x4*)(krow0 + (size_t)kidx * PW + 8 * piece); WV[it] = *(const u32x4*)(vrow0 + (size_t)kidx * PW + 8 * piece); } }
#define DSA_CHUNK(WK, WV, CI) { const bool isb_ = (CI) >= ncA; const int ch_ = isb_ ? (CI) - ncA : (CI); const int cnt_ = isb_ ? cntB : cntA; \
        if (ch_ == 0) { const bf16* qp = proj + (isb_ ? tokB : tokA) * PW + C_DQ + hd * 64 + 8 * quad; qb0 = *(const bf16x8*)qp; qb1 = *(const bf16x8*)(qp + 32); mrun = -1.0e30f; ls = 0.f; \
            _Pragma("unroll") for (int dt = 0; dt < 4; ++dt) o[dt] = (f32x4){0.f, 0.f, 0.f, 0.f}; } \
        int grow = grow_, piece = piece_; asm volatile("" : "+v"(grow), "+v"(piece)); \
        _Pragma("unroll") for (int it = 0; it < 8; ++it) { const int row = it * 8 + grow; *(LAS u32x4*)(stg + row * 128 + ((piece ^ (row & 7)) * 16)) = WK[it]; } \
        LDS_WAIT(); \
        float sr[4][4]; \
        { int colq = col, quadq = quad; asm volatile("" : "+v"(colq), "+v"(quadq)); \
          _Pragma("unroll") for (int kt = 0; kt < 4; ++kt) { const int row = kt * 16 + colq; \
            const bf16x8 a0 = *(const LAS bf16x8*)(stg + row * 128 + ((quadq ^ (row & 7)) * 16)), a1 = *(const LAS bf16x8*)(stg + row * 128 + (((quadq + 4) ^ (row & 7)) * 16)); \
            f32x4 d = (f32x4){0.f, 0.f, 0.f, 0.f}; d = mfma16(a0, qb0, d); d = mfma16(a1, qb1, d); \
            _Pragma("unroll") for (int i = 0; i < 4; ++i) sr[kt][i] = (ch_ * 64 + kt * 16 + 4 * quadq + i < cnt_) ? d[i] : -3.0e38f; } } \
        float mx = -3.0e38f; \
        _Pragma("unroll") for (int kt = 0; kt < 4; ++kt) _Pragma("unroll") for (int i = 0; i < 4; ++i) mx = fmaxf(mx, sr[kt][i]); \
        mx = red16_max(mx); mx = red32_max(mx); \
        const float mn = fmaxf(mrun, mx), al = fexp2(mrun - mn); mrun = mn; \
        float lc = 0.f; \
        _Pragma("unroll") for (int kt = 0; kt < 4; ++kt) _Pragma("unroll") for (int i = 0; i < 4; ++i) { const float p = fexp2(sr[kt][i] - mn); sr[kt][i] = p; lc += p; } \
        lc = red16_sum(lc); lc = red32_sum(lc); ls = ls * al + lc; \
        _Pragma("unroll") for (int dt = 0; dt < 4; ++dt) o[dt] = o[dt] * al; \
        LDS_WAIT(); \
        _Pragma("unroll") for (int it = 0; it < 8; ++it) { const int row = it * 8 + grow; *(LAS u32x4*)(stg + row * 128 + ((piece ^ (row & 7)) * 16)) = WV[it]; } \
        LDS_WAIT(); \
        { int colp = col, quadp = quad; asm volatile("" : "+v"(colp), "+v"(quadp)); \
          _Pragma("unroll") for (int g = 0; g < 2; ++g) { \
            u32x4 pw; pw.x = cvtpk(sr[2 * g][0], sr[2 * g][1]); pw.y = cvtpk(sr[2 * g][2], sr[2 * g][3]); pw.z = cvtpk(sr[2 * g + 1][0], sr[2 * g + 1][1]); pw.w = cvtpk(sr[2 * g + 1][2], sr[2 * g + 1][3]); \
            const bf16x8 pb = __builtin_bit_cast(bf16x8, pw); \
            const int klo = 32 * g + 4 * quadp + (colp >> 2), khi = klo + 16; \
            _Pragma("unroll") for (int dt = 0; dt < 4; ++dt) { const int pc = 2 * dt + ((colp & 3) >> 1), bo = (colp & 1) * 8; \
                const v4i16_t lo = __builtin_amdgcn_ds_read_tr16_b64_v4i16((LAS v4i16_t*)(stg + klo * 128 + ((pc ^ (klo & 7)) * 16) + bo)); \
                const v4i16_t hi = __builtin_amdgcn_ds_read_tr16_b64_v4i16((LAS v4i16_t*)(stg + khi * 128 + ((pc ^ (khi & 7)) * 16) + bo)); \
                const bf16x8 av = (bf16x8){lo[0], lo[1], lo[2], lo[3], hi[0], hi[1], hi[2], hi[3]}; \
                o[dt] = mfma16(av, pb, o[dt]); } } } \
        LDS_WAIT(); \
        const int nch_ = isb_ ? nc - ncA : ncA; \
        if (ch_ == nch_ - 1 && col < 4) { const float inv = 1.f / ls; bf16* om = (bf16*)(a.ws + WS_B) + (isb_ ? tokB : tokA) * DM + 768 + hd * 64 + 4 * quad; \
            _Pragma("unroll") for (int dt = 0; dt < 4; ++dt) { float v[4] = {o[dt][0] * inv, o[dt][1] * inv, o[dt][2] * inv, o[dt][3] * inv}; st4bf(om + 16 * dt, v); } } }
    if (nc > 0) DSA_GATHER(wk0, wv0, 0)
    for (int ci = 0; ci < nc; ci += 2) {
        if (ci + 1 < nc) DSA_GATHER(wk1, wv1, ci + 1)
        DSA_CHUNK(wk0, wv0, ci)
        if (ci + 1 < nc) {
            if (ci + 2 < nc) DSA_GATHER(wk0, wv0, ci + 2)
            DSA_CHUNK(wk1, wv1, ci + 1)
        }
    }
#undef DSA_GATHER
#undef DSA_CHUNK
}

typedef unsigned short u16x2_t __attribute__((ext_vector_type(2)));
DI unsigned pkmax16(unsigned x, unsigned y) { return __builtin_bit_cast(unsigned, __builtin_elementwise_max(__builtin_bit_cast(u16x2_t, x), __builtin_bit_cast(u16x2_t, y))); }
DI unsigned f2key16s(float f) { const unsigned h = (unsigned)__builtin_bit_cast(unsigned short, (_Float16)f); return h ^ ((unsigned)((int)__float_as_uint(f) >> 31) | 0x8000u); }
DI unsigned f2key16(float f) { const unsigned h = (unsigned)__builtin_bit_cast(unsigned short, (_Float16)f); return (h & 0x8000u) ? (~h & 0xffffu) : (h | 0x8000u); }
DI void dsa_unit16(const Args& a, int pu, LAS unsigned char* lds, int wave, int lane) {
    const bf16* proj = (const bf16*)(a.ws + WS_A);
    const int b = pu >> 9, p = pu & 511;
    const int tA0 = 8 * p, tB0 = 8184 - 8 * p, nA = tA0 + 8, nB = tB0 + 8;
    const int na32 = (nA + 31) & ~31, nb32 = (nB + 31) & ~31;
    LAS unsigned short* sc = (LAS unsigned short*)lds;
    {
        const int c = lane & 31, hh = lane >> 5, qr = c >> 2, hr = c & 3;
        const size_t tokA = (size_t)b * SEQ + tA0, tokB = (size_t)b * SEQ + tB0;
        bf16x8 iqA[4], iqB[4];
#pragma unroll
        for (int s = 0; s < 4; ++s) { iqA[s] = *(const bf16x8*)(proj + (tokA + qr) * PW + C_DIQ + hr * 64 + 16 * s + 8 * hh); iqB[s] = *(const bf16x8*)(proj + (tokB + qr) * PW + C_DIQ + hr * 64 + 16 * s + 8 * hh); }
        f32x4 iwA[4], iwB[4];
#pragma unroll
        for (int g = 0; g < 4; ++g) { iwA[g] = *(const f32x4*)((const float*)(a.ws + WS_IW) + (tokA + 2 * g + hh) * 4); iwB[g] = *(const f32x4*)((const float*)(a.ws + WS_IW) + (tokB + 2 * g + hh) * 4); }
        const bf16* kb = (const bf16*)(a.ws + WS_IKT) + (size_t)b * (SEQ / 32) * 2048;
        const int ntA = na32 >> 5, ntB = nb32 >> 5;
        LAS unsigned short* dA = sc + hh * na32 + c; LAS unsigned short* dB = sc + 8 * na32 + hh * nb32 + c;
#define DSA_EPI(X, IW, T0, DST, PITCH, K0, MASK) { _Pragma("unroll") for (int g = 0; g < 4; ++g) { \
            const float r0 = __builtin_amdgcn_fmed3f(X[4 * g], 0.f, 3.0e38f), r1 = __builtin_amdgcn_fmed3f(X[4 * g + 1], 0.f, 3.0e38f); \
            const float r2 = __builtin_amdgcn_fmed3f(X[4 * g + 2], 0.f, 3.0e38f), r3 = __builtin_amdgcn_fmed3f(X[4 * g + 3], 0.f, 3.0e38f); \
            float a0 = __builtin_fmaf(IW[g].x, r0, 0.f), a1 = __builtin_fmaf(IW[g].y, r1, 0.f); a0 = __builtin_fmaf(IW[g].z, r2, a0); a1 = __builtin_fmaf(IW[g].w, r3, a1); \
            unsigned key = f2key16s(a0 + a1); if (MASK) key = ((K0) + c <= (T0) + 2 * g + hh) ? key : 0u; \
            (DST)[2 * g * (PITCH) + (K0)] = (unsigned short)key; } }
        bf16x8 kf[4], nkf[4];
        if (wave < ntB) ld_kt(kf, kb + (size_t)wave * 2048, c, hh);
        for (int kt = wave; kt < ntB; kt += NWAVES) {
            { const int kn = (kt + NWAVES < ntB) ? kt + NWAVES : kt; ld_kt(nkf, kb + (size_t)kn * 2048, c, hh); }
            const int k0 = kt * 32; const bool hasA = kt < ntA;
            f32x16 x = zero16(), y = zero16();
#pragma unroll
            for (int s = 0; s < 4; ++s) x = mfma32(iqB[s], kf[s], x);
            if (hasA) {
#pragma unroll
                for (int s = 0; s < 4; ++s) y = mfma32(iqA[s], kf[s], y);
            }
            if (k0 + 31 > tB0) DSA_EPI(x, iwB, tB0, dB, nb32, k0, true) else DSA_EPI(x, iwB, tB0, dB, nb32, k0, false)
            if (hasA) { if (k0 + 31 > tA0) DSA_EPI(y, iwA, tA0, dA, na32, k0, true) else DSA_EPI(y, iwA, tA0, dA, na32, k0, false) }
#pragma unroll
            for (int s = 0; s < 4; ++s) kf[s] = nkf[s];
        }
#undef DSA_EPI
    }
    __syncthreads();
    LAS unsigned short* cidx = (LAS unsigned short*)(lds + DSA_CIDX + wave * 2048);
    LAS unsigned short* dummy = (LAS unsigned short*)(lds + DSA_DUMMY + wave * 128) + lane;
    const unsigned long long ltm = (1ull << lane) - 1ull;
    int cntA = 0, cntB = 0;
#pragma unroll 1
    for (int blk = 0; blk < 2; ++blk) {
        const int tq = (blk ? tB0 : tA0) + wave, n = tq + 1, n32 = (blk ? nb32 : na32);
        const LAS unsigned short* s16 = sc + (blk ? 8 * na32 + wave * nb32 : wave * na32);
        LAS unsigned short* list = (LAS unsigned short*)(lds + DSA_LIST + (blk * 8 + wave) * 512);
        int cnt;
        if (n <= 256) { for (int i = lane; i < n; i += 64) list[i] = (unsigned short)i; cnt = n; }
        else {
            int c = 0;
            if (n <= 1024) { for (int i = lane; i < n; i += 64) cidx[i] = (unsigned short)i; c = n; }
            else {
                const bool cs4 = n <= 2048; unsigned M[16];
#pragma unroll
                for (int it = 0; it < 16; ++it) {
                    const int i8 = (cs4 ? (it >> 1) : it) * 512 + lane * 8; unsigned mx = 0u;
                    if (i8 < n32) { const u32x4 v = *(const LAS u32x4*)(s16 + i8);
                        if (cs4) { const unsigned m2 = (it & 1) ? pkmax16(v.z, v.w) : pkmax16(v.x, v.y); mx = max(m2 & 0xffffu, m2 >> 16); }
                        else { const unsigned m4 = pkmax16(pkmax16(v.x, v.y), pkmax16(v.z, v.w)); mx = max(m4 & 0xffffu, m4 >> 16); } }
                    if (cs4 && it >= 8) mx = 0u;
                    M[it] = mx;
                }
                const unsigned beta = kth_reg16(M, 256);
                for (int i0 = 0; i0 < n32; i0 += 512) {
                    const int i8 = i0 + lane * 8;
                    u32x4 v = (u32x4){0u, 0u, 0u, 0u}; if (i8 < n32) v = *(const LAS u32x4*)(s16 + i8);
                    const unsigned kk[8] = {v.x & 0xffffu, v.x >> 16, v.y & 0xffffu, v.y >> 16, v.z & 0xffffu, v.z >> 16, v.w & 0xffffu, v.w >> 16};
                    int fc = 0;
#pragma unroll
                    for (int k = 0; k < 8; ++k) fc += (kk[k] >= beta) ? 1 : 0;
                    const int inc = wave_incl_scan(fc); int pos = c + inc - fc;
#pragma unroll
                    for (int k = 0; k < 8; ++k) { const bool cd = kk[k] >= beta;
                        LAS unsigned short* d = (cd && pos < 1024) ? (cidx + pos) : dummy; *d = (unsigned short)(i8 + k); pos += cd ? 1 : 0; }
                    c += __builtin_amdgcn_readlane(inc, 63);
                }
                LDS_WAIT();
            }
            unsigned tau; bool fromc = (c <= 1024);
            if (fromc) {
                unsigned ck[16], ixs[16];
#pragma unroll
                for (int j = 0; j < 16; ++j) ixs[j] = (unsigned)cidx[j * 64 + lane];
#pragma unroll
                for (int j = 0; j < 16; ++j) ixs[j] = (j * 64 + lane < c) ? ixs[j] : 0u;
#pragma unroll
                for (int j = 0; j < 16; ++j) ck[j] = (unsigned)s16[ixs[j]];
#pragma unroll
                for (int j = 0; j < 16; ++j) ck[j] = (j * 64 + lane < c) ? ck[j] : 0u;
                tau = kth_reg16(ck, 256);
                int cg = 0;
#pragma unroll
                for (int j = 0; j < 16; ++j) cg += (ck[j] > tau) ? 1 : 0;
                const int krem = 256 - wave_sum_i(cg);
                int total = 0, eqt = 0;
#pragma unroll
                for (int j = 0; j < 16; ++j) {
                    if (j * 64 < c) {
                        const bool gt = ck[j] > tau, eq = ck[j] == tau;
                        const unsigned long long eqm = __ballot(eq); const int eqp = __popcll(eqm & ltm);
                        const bool take = gt || (eq && (eqt + eqp < krem));
                        const unsigned long long tm = __ballot(take); const int pos = total + __popcll(tm & ltm);
                        if (take) list[pos] = (unsigned short)ixs[j];
                        total += __popcll(tm); eqt += __popcll(eqm);
                    }
                }
                cnt = total;
            } else {
                tau = 0u;
                for (int bit = 15; bit >= 0; --bit) {
                    const unsigned cand = tau | (1u << bit); int cc = 0;
                    for (int i = lane; i < n; i += 64) cc += ((unsigned)s16[i] >= cand) ? 1 : 0;
                    if (wave_sum_i(cc) >= 256) tau = cand;
                }
                int cg = 0;
                for (int i = lane; i < n; i += 64) cg += ((unsigned)s16[i] > tau) ? 1 : 0;
                const int krem = 256 - wave_sum_i(cg);
                int total = 0, eqt = 0;
                for (int i0 = 0; i0 < n; i0 += 64) {
                    const int i = i0 + lane; const unsigned key = (i < n) ? (unsigned)s16[i] : 0u;
                    const bool gt = key > tau, eq = (i < n) && key == tau;
                    const unsigned long long eqm = __ballot(eq); const int eqp = __popcll(eqm & ltm);
                    const bool take = gt || (eq && (eqt + eqp < krem));
                    const unsigned long long tm = __ballot(take); const int pos = total + __popcll(tm & ltm);
                    if (take) list[pos] = (unsigned short)i;
                    total += __popcll(tm); eqt += __popcll(eqm);
                }
                cnt = total;
            }
        }
        if (blk) cntB = cnt; else cntA = cnt;
    }
    __syncthreads();
    dsa_attend2(a, proj, b, (size_t)b * SEQ + tA0 + wave, (const LAS unsigned short*)(lds + DSA_LIST + wave * 512), cntA, (size_t)b * SEQ + tB0 + wave, (const LAS unsigned short*)(lds + DSA_LIST + (8 + wave) * 512), cntB, lds + wave * 16384, lane);
    __syncthreads();
}

#ifndef HOSTDUP
#define HOSTDUP 0
#endif
#ifndef MK_SINGLE
#define MK_SINGLE 1
#endif
constexpr int PRM_OFF = MISC_OFF + 256;
DI void store_args(LAS unsigned char* lds, const Args& k) {
    LAS unsigned long long* q = (LAS unsigned long long*)(lds + PRM_OFF);
    q[0] = (unsigned long long)k.x; q[1] = (unsigned long long)k.pos; q[2] = (unsigned long long)k.w_in; q[3] = (unsigned long long)k.b_f; q[4] = (unsigned long long)k.pe_cmp;
    q[5] = (unsigned long long)k.w_cmp1; q[6] = (unsigned long long)k.w_cmp2; q[7] = (unsigned long long)k.w_gate; q[8] = (unsigned long long)k.w_br; q[9] = (unsigned long long)k.w_o;
    q[10] = (unsigned long long)k.ln1_g; q[11] = (unsigned long long)k.ln1_b; q[12] = (unsigned long long)k.w_router; q[13] = (unsigned long long)k.router_bias;
    q[14] = (unsigned long long)k.w_eg; q[15] = (unsigned long long)k.w_eu; q[16] = (unsigned long long)k.w_ed; q[17] = (unsigned long long)k.w_sg; q[18] = (unsigned long long)k.w_su; q[19] = (unsigned long long)k.w_sd;
    q[20] = (unsigned long long)k.ln2_g; q[21] = (unsigned long long)k.ln2_b; q[22] = (unsigned long long)k.out; q[23] = (unsigned long long)k.ws;
}
DI unsigned long long ldprm(LAS unsigned char* lds, int i) {
    const u32x2 v = *(const LAS u32x2*)(lds + PRM_OFF + 8 * i);
    return ((unsigned long long)(unsigned)__builtin_amdgcn_readfirstlane((int)v.y) << 32) | (unsigned long long)(unsigned)__builtin_amdgcn_readfirstlane((int)v.x);
}
DI Args lds_args(LAS unsigned char* lds) {
    Args a;
    a.x = (const float*)(const GAS float*)ldprm(lds, 0); a.pos = (const int*)(const GAS int*)ldprm(lds, 1); a.w_in = (const float*)(const GAS float*)ldprm(lds, 2); a.b_f = (const float*)(const GAS float*)ldprm(lds, 3); a.pe_cmp = (const float*)(const GAS float*)ldprm(lds, 4);
    a.w_cmp1 = (const float*)(const GAS float*)ldprm(lds, 5); a.w_cmp2 = (const float*)(const GAS float*)ldprm(lds, 6); a.w_gate = (const float*)(const GAS float*)ldprm(lds, 7); a.w_br = (const float*)(const GAS float*)ldprm(lds, 8); a.w_o = (const float*)(const GAS float*)ldprm(lds, 9);
    a.ln1_g = (const float*)(const GAS float*)ldprm(lds, 10); a.ln1_b = (const float*)(const GAS float*)ldprm(lds, 11); a.w_router = (const float*)(const GAS float*)ldprm(lds, 12); a.router_bias = (const float*)(const GAS float*)ldprm(lds, 13);
    a.w_eg = (const float*)(const GAS float*)ldprm(lds, 14); a.w_eu = (const float*)(const GAS float*)ldprm(lds, 15); a.w_ed = (const float*)(const GAS float*)ldprm(lds, 16); a.w_sg = (const float*)(const GAS float*)ldprm(lds, 17); a.w_su = (const float*)(const GAS float*)ldprm(lds, 18); a.w_sd = (const float*)(const GAS float*)ldprm(lds, 19);
    a.ln2_g = (const float*)(const GAS float*)ldprm(lds, 20); a.ln2_b = (const float*)(const GAS float*)ldprm(lds, 21); a.out = (float*)(GAS float*)ldprm(lds, 22); a.ws = (unsigned char*)(GAS unsigned char*)ldprm(lds, 23); a.ph_lo = 0; a.ph_hi = 0;
    return a;
}
#ifndef PHMASK
#define PHMASK 0xffffffffu
#endif
#define PHON(j) (((PHMASK) >> (j)) & 1u)
#define PH_BEGIN const Args a = lds_args(lds); unsigned char* ws = a.ws; (void)ws; \
    const int tid = ltid(), lane = tid & 63, wave = __builtin_amdgcn_readfirstlane(tid >> 6); \
    const int G = lgrid(), bid = lbid(), gw = bid * NWAVES + wave, NGW = G * NWAVES; (void)bid; (void)lane; (void)wave; (void)gw; (void)NGW; (void)G;
#ifndef PH_NOINLINE
#define PHFN DI void
#else
#define PHFN __attribute__((noinline)) __device__ void
#endif

PHFN f_prologue(LAS unsigned char* lds) { PH_BEGIN ph_prologue(a, gw, NGW, lane); }
PHFN f_cvt(LAS unsigned char* lds, int l) { PH_BEGIN ph_cvt(a, l, lds, gw, NGW, wave, lane); }
PHFN f_proj(LAS unsigned char* lds) { PH_BEGIN
    SchedProj S; S.so.init(NTOK, PW, G, bid); S.A = (unsigned)WS_XB; S.B = (unsigned)W_IN;
    EpiProj E; E.proj = (bf16*)(ws + WS_A); E.sm32 = (float*)(ws + WS_SM32);
    gs::gemm_stream<SchedProj, EpiProj, 2>(lds, (const char*)ws, S, E); }
PHFN f_post(LAS unsigned char* lds, int l) { PH_BEGIN ph_post(a, l, lds, wave, lane); }
PHFN f_cmp(LAS unsigned char* lds) { PH_BEGIN
    SchedCmp S; S.kcr = (unsigned)WS_KCR; S.vcr = (unsigned)WS_VCR; S.w = (unsigned)W_C1;
    EpiCmp E; E.hid = (float*)(ws + WS_HID); E.cbias = (const float*)(ws + WS_CBIAS);
    gs::gemm_stream<SchedCmp, EpiCmp, 2>(lds, (const char*)ws, S, E);
    if (bid >= 32 && bid < 64 && wave == 0) cumsum_seq(a, bid - 32, lane);
    if (G < 64 && bid == 0 && wave == 1) for (int q = (G > 32 ? G - 32 : 0); q < 32; ++q) cumsum_seq(a, q, lane); }
PHFN f_cmp2(LAS unsigned char* lds, int l) { PH_BEGIN ph_cmp2(a, l, gw, NGW, lane); }
PHFN f_dsa(LAS unsigned char* lds) { PH_BEGIN for (int pu = bid; pu < NTOK / 16; pu += G) dsa_unit16(a, pu, lds, wave, lane); }
PHFN f_nsa(LAS unsigned char* lds) { PH_BEGIN
    for (int u = gw, r = 0; u < NTOK / 8; u += NGW, ++r) {
        int unit = u;
        if (NGW == 2048) { const int bsel = u >> 10, pos = ((u & 1023) + 256 * r) & 1023; unit = bsel * 1024 + pos; }
        nsa_unit(a, unit, lds + wave * 5120, lane);
    } }
PHFN f_sbfg(LAS unsigned char* lds, int l) { PH_BEGIN
    for (int u = bid; u < 2048; u += G) {
        const int r = u >> 8, blk = u & 255, bh = blk & 31, f = blk >> 5, mixer = r >> 2, rr = r & 3;
        const int QB = (rr == 0) ? f : (rr == 1) ? 31 - f : (rr == 2) ? 8 + f : 23 - f;
        if (mixer == 0) sbfg_block<0>(a, l, bh >> 2, bh & 3, QB, lds, tid, wave, lane); else sbfg_block<1>(a, l, bh >> 2, bh & 3, QB, lds, tid, wave, lane);
        __syncthreads();
    } }
PHFN f_merge(LAS unsigned char* lds) { PH_BEGIN
    SchedMerge S; S.xb = (unsigned)WS_XB; S.om = (unsigned)WS_B; S.wg = (unsigned)W_G; S.wbr = (unsigned)W_BR; S.G = G;
    EpiMerge E; E.merged = (bf16*)(ws + WS_C); E.stash = (u32x4*)(ws + WS_A + (size_t)bid * 65536);
    gs::gemm_stream<SchedMerge, EpiMerge, 1>(lds, (const char*)ws, S, E); }
PHFN f_wo(LAS unsigned char* lds, int l) { PH_BEGIN
    SchedWo S; S.so.init(NTOK, DM, G, bid); S.A = (unsigned)WS_C; S.B = (unsigned)W_O;
    EpiWo E; E.xb = (bf16*)(ws + WS_XB); (void)l;
    gs::gemm_stream<SchedWo, EpiWo, 2>(lds, (const char*)ws, S, E); }
PHFN f_ln1(LAS unsigned char* lds, int l) { PH_BEGIN ph_ln1(a, l, gw, NGW, lane); }
PHFN f_router(LAS unsigned char* lds) { PH_BEGIN
    SchedRouter S; S.xh = (unsigned)WS_XB; S.xl = (unsigned)WS_XL; S.wh = (unsigned)W_RH; S.wl = (unsigned)W_RL; S.G = G;
    EpiRouter E; E.logit = (float*)(ws + WS_LOGIT);
    gs::gemm_stream<SchedRouter, EpiRouter, 1>(lds, (const char*)ws, S, E); }
PHFN f_route(LAS unsigned char* lds, int l) { PH_BEGIN ph_route(a, l, lds, wave, lane); }
PHFN f_e1(LAS unsigned char* lds, int l) { PH_BEGIN
    moe_tables(a, l, lds);
    SchedE1 S; S.ptile = (const LAS int*)(lds + TBL_OFF); S.cntv = S.ptile + 2 * TBLN; S.xb = (unsigned)WS_XB; S.lists = (const unsigned*)(ws + WS_LIST); S.w1 = (unsigned)W_1; S.G = G;
    EpiE1 E; E.hb = (bf16*)(ws + WS_HB);
    gs::gemm_stream<SchedE1, EpiE1, 2>(lds, (const char*)ws, S, E); }
PHFN f_e2(LAS unsigned char* lds, int l, int c) { PH_BEGIN
    moe_tables(a, l, lds);
    SchedE2 S; S.ptile = (const LAS int*)(lds + TBL_OFF); S.ypre = S.ptile + TBLN; S.cntv = S.ptile + 2 * TBLN; S.hb = (unsigned)WS_HB; S.w2 = (unsigned)W_2; S.c = c; S.G = G;
    EpiE2 E; E.y = (unsigned char*)(ws + WS_Y);
    gs::gemm_stream<SchedE2, EpiE2, 2>(lds, (const char*)ws, S, E); }
PHFN f_ln2(LAS unsigned char* lds, int l, int c) { PH_BEGIN moe_tables(a, l, lds); ph_ln2(a, l, c, lds, gw, NGW, lane); }
PHFN f_seam(LAS unsigned char* lds) {
    XcdBarrier bar; bar.bar = (unsigned*)((unsigned char*)(GAS unsigned char*)ldprm(lds, 23) + WS_CTL) + CW_BAR; bar.x = xb_xcc_id(); bar.st = (volatile LAS unsigned*)(lds + MISC_OFF) + 8; xcd_barrier(bar); }

#define IN(k) (lo <= (k) && (k) < hi)
#define SEAM(k) do { if ((k) + 1 < hi) f_seam(lds); } while (0)
DI void run_layer(LAS unsigned char* lds, const int l, const int lo, const int hi) {
        const int pb = 1 + l * NPL;
        if (PHON(0) && IN(pb + 0)) { f_cvt(lds, l); SEAM(pb + 0); }
        if (PHON(1) && IN(pb + 1)) { f_proj(lds); SEAM(pb + 1); }
        if (PHON(2) && IN(pb + 2)) { f_post(lds, l); SEAM(pb + 2); }
        if (PHON(3) && IN(pb + 3)) { f_cmp(lds); __syncthreads(); f_dsa(lds); SEAM(pb + 3); }
        if (PHON(4) && IN(pb + 4)) { f_cmp2(lds, l); __syncthreads(); f_sbfg(lds, l); SEAM(pb + 4); }
        if (PHON(21) && IN(pb + 5)) { f_nsa(lds); SEAM(pb + 5); }
        if (PHON(6) && IN(pb + 6)) { f_merge(lds); SEAM(pb + 6); }
        if (PHON(7) && IN(pb + 7)) { f_wo(lds, l); SEAM(pb + 7); }
        if (PHON(8) && IN(pb + 8)) { f_ln1(lds, l); SEAM(pb + 8); }
        if (PHON(9) && IN(pb + 9)) { f_router(lds); SEAM(pb + 9); }
        if (PHON(10) && IN(pb + 10)) { f_route(lds, l); SEAM(pb + 10); }
        if (PHON(11) && IN(pb + 11)) { f_e1(lds, l); SEAM(pb + 11); }
        for (int c = 0; c < NCH; ++c) {
            if (PHON(12) && IN(pb + 12 + 2 * c)) { f_e2(lds, l, c); SEAM(pb + 12 + 2 * c); }
            if (PHON(13) && IN(pb + 13 + 2 * c)) { f_ln2(lds, l, c); SEAM(pb + 13 + 2 * c); }
        }
}
#undef IN
#undef SEAM
#ifndef DUPMASK
#define DUPMASK 0
#endif
#define DUP(j) (((DUPMASK) >> (j)) & 1)
__global__ void __launch_bounds__(NWAVES * 64, 2) fwd(Args ka) {
    extern __shared__ __attribute__((aligned(16))) unsigned char lds_[];
    LAS unsigned char* lds = (LAS unsigned char*)lds_;
    const int tid = threadIdx.x;
    volatile LAS unsigned* MISC = (volatile LAS unsigned*)(lds + MISC_OFF);
    if (tid < 64) MISC[tid] = 0u;
    if (tid == 64) store_args(lds, ka);
    const int lo = ka.ph_lo, hi = ka.ph_hi;
    __syncthreads();
    if (hi - lo > 1 && tid == 0) (void)xb_add(&((unsigned*)(ka.ws + WS_CTL) + CW_BAR)[XB_XCNT(xb_xcc_id())], 1u);
#define IN(k) (lo <= (k) && (k) < hi)
#define SEAM(k) do { if ((k) + 1 < hi) f_seam(lds); } while (0)
    if (PHON(31) && IN(0)) { f_prologue(lds); SEAM(0); }
    run_layer(lds, 0, lo, hi); run_layer(lds, 1, lo, hi); run_layer(lds, 2, lo, hi); run_layer(lds, 3, lo, hi);
#undef IN
#undef SEAM
}

extern "C" void kernel_launch(void* const* d_in, const int* in_sizes, int n_in, void* d_out, int out_size, void* d_ws, size_t ws_size, hipStream_t stream) {
    static int grid = 0;
    if (grid == 0) {
        if (n_in != 22 || in_sizes[0] != NTOK * DM || out_size != NTOK * DM || ws_size < WS_END) {
            fprintf(stderr, "kernel_launch: unexpected shapes/workspace: n_in %d in0 %d out %d ws %zu (need %zu)\n", n_in, n_in > 0 ? in_sizes[0] : -1, out_size, ws_size, (size_t)WS_END); grid = -1; return; }
        int dev = 0, cus = 0, per_cu = 0;
        if (hipGetDevice(&dev) != hipSuccess || hipDeviceGetAttribute(&cus, hipDeviceAttributeMultiprocessorCount, dev) != hipSuccess) { grid = -1; return; }
        if (hipFuncSetAttribute((const void*)fwd, hipFuncAttributeMaxDynamicSharedMemorySize, LDS_BYTES) != hipSuccess) { fprintf(stderr, "kernel_launch: hipFuncSetAttribute failed\n"); grid = -1; return; }
        if (hipOccupancyMaxActiveBlocksPerMultiprocessor(&per_cu, (const void*)fwd, NWAVES * 64, LDS_BYTES) != hipSuccess || per_cu < 1)
            fprintf(stderr, "kernel_launch: occupancy query reports %d blocks per CU\n", per_cu);
        (void)hipGetLastError();
        grid = cus;
    }
    if (grid < 0) return;
    (void)hipMemsetAsync((char*)d_ws + WS_CTL, 0, CTL_ZERO_BYTES, stream);
    Args a{};
    a.x = (const float*)d_in[0]; a.pos = (const int*)d_in[1]; a.w_in = (const float*)d_in[2]; a.b_f = (const float*)d_in[3]; a.pe_cmp = (const float*)d_in[4];
    a.w_cmp1 = (const float*)d_in[5]; a.w_cmp2 = (const float*)d_in[6]; a.w_gate = (const float*)d_in[7]; a.w_br = (const float*)d_in[8]; a.w_o = (const float*)d_in[9];
    a.ln1_g = (const float*)d_in[10]; a.ln1_b = (const float*)d_in[11]; a.w_router = (const float*)d_in[12]; a.router_bias = (const float*)d_in[13];
    a.w_eg = (const float*)d_in[14]; a.w_eu = (const float*)d_in[15]; a.w_ed = (const float*)d_in[16]; a.w_sg = (const float*)d_in[17]; a.w_su = (const float*)d_in[18]; a.w_sd = (const float*)d_in[19];
    a.ln2_g = (const float*)d_in[20]; a.ln2_b = (const float*)d_in[21];
    a.out = (float*)d_out; a.ws = (unsigned char*)d_ws;
#if MK_SINGLE
    a.ph_lo = 0; a.ph_hi = NPHASE;
    hipLaunchKernelGGL(fwd, dim3(grid), dim3(NWAVES * 64), LDS_BYTES, stream, a);
#else
    for (int p = 0; p < NPHASE; ++p) { a.ph_lo = p; a.ph_hi = p + 1; hipLaunchKernelGGL(fwd, dim3(grid), dim3(NWAVES * 64), LDS_BYTES, stream, a);
        if (p > 0 && ((HOSTDUP >> ((p - 1) % NPL)) & 1)) hipLaunchKernelGGL(fwd, dim3(grid), dim3(NWAVES * 64), LDS_BYTES, stream, a); }
#endif
}
```

```cpp
#include <hip/hip_runtime.h>
#include <cstdio>
#include <cstdint>

#define GAS __attribute__((address_space(1)))
#define LAS __attribute__((address_space(3)))
typedef unsigned short bf16;
typedef short bf16x8 __attribute__((ext_vector_type(8)));
typedef float f32x4 __attribute__((ext_vector_type(4)));
typedef float f32x2 __attribute__((ext_vector_type(2)));
typedef float f32x16 __attribute__((ext_vector_type(16)));
typedef unsigned u32x4 __attribute__((ext_vector_type(4)));
typedef unsigned u32x2 __attribute__((ext_vector_type(2)));
typedef __bf16 bf16x2_t __attribute__((ext_vector_type(2)));
typedef GAS unsigned gu32;

#define DI __device__ __forceinline__
#define LDS_WAIT() asm volatile("s_waitcnt lgkmcnt(0)" ::: "memory")
#define VM_WAIT() asm volatile("s_waitcnt vmcnt(0)" ::: "memory")
#define RLX_AGENT __ATOMIC_RELAXED, __HIP_MEMORY_SCOPE_AGENT

constexpr int NBATCH = 8, SEQ = 8192, NTOK = NBATCH * SEQ, DM = 1024, DEPTH = 4;
constexpr int PW = 3136;
constexpr int C_AQ = 0, C_BQ = 256, C_BK = 512, C_BV = 768, C_CQ = 1024, C_CK = 1280, C_CV = 1536, C_DQ = 1792, C_DIQ = 2048,
              C_AKC = 2304, C_AVC = 2368, C_AKS = 2432, C_AVS = 2496, C_AKW = 2560, C_AVW = 2624, C_DK = 2688, C_DV = 2752, C_DIK = 2816, C_SM = 2880;
constexpr int IN_W = 2900;
constexpr float QS = 0.18033688011112042f;
constexpr float LOG2E = 1.4426950408889634f;
constexpr float ALPHA = 1.681792830507429f;
constexpr float LN_EPS = 1e-5f;
constexpr int NEXP = 64, NCH = 2, CHTOK = NTOK / NCH;
constexpr int NPL = 12 + 2 * NCH;
constexpr int NPHASE = 1 + DEPTH * NPL;
constexpr int NWAVES = 8;

constexpr size_t MiB = 1u << 20;
constexpr size_t WS_CTL = 0, CTL_ZERO_BYTES = 1 * MiB;
constexpr size_t WS_ROPE = 1 * MiB;
constexpr size_t WS_SM32 = 5 * MiB;
constexpr size_t WS_GATE = 13 * MiB;
constexpr size_t WS_LOGF = 16 * MiB;
constexpr size_t WS_CUM  = 17 * MiB;
constexpr size_t WS_IW   = 18 * MiB;
constexpr size_t WS_HID  = 19 * MiB;
constexpr size_t WS_KCMP = 21 * MiB;
constexpr size_t WS_VTCMP = 21 * MiB + 512 * 1024;
constexpr size_t WS_CBIAS = 22 * MiB;
constexpr size_t WS_KCR  = 23 * MiB;
constexpr size_t WS_VCR  = 32 * MiB;
constexpr size_t WS_VT   = 41 * MiB;
constexpr size_t WS_VTB = WS_VT, WS_VTC = WS_VT + 32 * MiB, WS_VTAS = WS_VT + 64 * MiB, WS_VTAW = WS_VT + 72 * MiB;
constexpr size_t WS_LOGIT = WS_VT;
constexpr size_t WS_TOKINFO = WS_VT + 16 * MiB;
constexpr size_t WS_LIST = WS_VT + 20 * MiB;
constexpr size_t WS_W    = 121 * MiB;
constexpr size_t W_IN = WS_W, W_G = WS_W + 6 * MiB, W_BR = WS_W + 14 * MiB, W_O = WS_W + 16 * MiB, W_C1 = WS_W + 18 * MiB,
                 W_RH = WS_W + 20 * MiB, W_RL = WS_W + 20 * MiB + 512 * 1024, W_1 = WS_W + 21 * MiB, W_2 = WS_W + 86 * MiB;
constexpr size_t WS_XB   = 243 * MiB;
constexpr size_t WS_A    = 371 * MiB;
constexpr size_t WS_B    = 763 * MiB;
constexpr size_t WS_C    = 891 * MiB;
constexpr size_t WS_END  = 1019 * MiB;
constexpr size_t WS_KTS = WS_C, WS_KTW = WS_C + 8 * MiB, WS_IKT = WS_C + 16 * MiB, WS_KTB = WS_C + 32 * MiB, WS_KTC = WS_C + 64 * MiB;
constexpr size_t WS_XL = WS_A, WS_HB = WS_A, WS_Y = WS_A + 320 * MiB;
static_assert(WS_Y + (size_t)(CHTOK * 8 / 256 + 64 + CHTOK / 256) * 256 * DM <= WS_END, "tile-padded fp8 y chunk fits");
constexpr int HB_TILES = NTOK * 8 / 256 + NCH * 64 + NTOK / 256;
static_assert((size_t)HB_TILES * 256 * 512 <= 320 * MiB, "hbuf fits");

constexpr int CW_BAR = 4096;
constexpr int CW_CNT = 16384;
constexpr int CW_KMAX = 32768;

constexpr int RING_BYTES = 131072;
constexpr int MISC_OFF = 162816;
constexpr int LDS_BYTES = 163840;

DI unsigned cvtpk(float lo, float hi) { f32x2 v = {lo, hi}; bf16x2_t b = __builtin_convertvector(v, bf16x2_t); return __builtin_bit_cast(unsigned, b); }
DI u32x4 pack8(const f32x4& v0, const f32x4& v1) { u32x4 w; w.x = cvtpk(v0[0], v0[1]); w.y = cvtpk(v0[2], v0[3]); w.z = cvtpk(v1[0], v1[1]); w.w = cvtpk(v1[2], v1[3]); return w; }
DI float bf2f(unsigned short h) { return __uint_as_float(((unsigned)h) << 16); }
DI float bflo(unsigned w) { return __uint_as_float(w << 16); }
DI float bfhi(unsigned w) { return __uint_as_float(w & 0xffff0000u); }
DI float fexp2(float x) { return __builtin_amdgcn_exp2f(x); }
DI float flog2(float x) { return __builtin_amdgcn_logf(x); }
DI float frcp(float x) { return __builtin_amdgcn_rcpf(x); }
DI float sigmoidf_(float x) { return frcp(1.f + fexp2(-x * LOG2E)); }
#define DPPF(v, ctrl, rm, bc) __int_as_float(__builtin_amdgcn_update_dpp(0, __float_as_int(v), (ctrl), (rm), 0xF, (bc)))
#define DPPI(v, ctrl, rm, bc) __builtin_amdgcn_update_dpp(0, (v), (ctrl), (rm), 0xF, (bc))
DI float dpp_xor1(float v) { return DPPF(v, 0xB1, 0xF, true); }
DI float dpp_xor2(float v) { return DPPF(v, 0x4E, 0xF, true); }
DI float red16_sum(float v) { const auto r = __builtin_amdgcn_permlane16_swap(__float_as_uint(v), __float_as_uint(v), false, false); return __uint_as_float(r[0]) + __uint_as_float(r[1]); }
DI float red16_max(float v) { const auto r = __builtin_amdgcn_permlane16_swap(__float_as_uint(v), __float_as_uint(v), false, false); return fmaxf(__uint_as_float(r[0]), __uint_as_float(r[1])); }
DI float red32_sum(float v) { const auto r = __builtin_amdgcn_permlane32_swap(__float_as_uint(v), __float_as_uint(v), false, false); return __uint_as_float(r[0]) + __uint_as_float(r[1]); }
DI float red32_max(float v) { const auto r = __builtin_amdgcn_permlane32_swap(__float_as_uint(v), __float_as_uint(v), false, false); return fmaxf(__uint_as_float(r[0]), __uint_as_float(r[1])); }
DI float wave_sum(float v) {
    v += dpp_xor1(v); v += dpp_xor2(v); v += DPPF(v, 0x124, 0xF, true); v += DPPF(v, 0x128, 0xF, true);
    v = red16_sum(v); return red32_sum(v);
}
DI float wave_max(float v) {
    v = fmaxf(v, dpp_xor1(v)); v = fmaxf(v, dpp_xor2(v)); v = fmaxf(v, DPPF(v, 0x124, 0xF, true)); v = fmaxf(v, DPPF(v, 0x128, 0xF, true));
    v = red16_max(v); return red32_max(v);
}
DI int wave_incl_scan(int v) {
    v += DPPI(v, 0x111, 0xF, true); v += DPPI(v, 0x112, 0xF, true); v += DPPI(v, 0x114, 0xF, true); v += DPPI(v, 0x118, 0xF, true);
    v += DPPI(v, 0x142, 0xA, false);
    v += DPPI(v, 0x143, 0xC, false);
    return v;
}
DI float wave_incl_scan_f(float v) {
    v += DPPF(v, 0x111, 0xF, true); v += DPPF(v, 0x112, 0xF, true); v += DPPF(v, 0x114, 0xF, true); v += DPPF(v, 0x118, 0xF, true);
    v += DPPF(v, 0x142, 0xA, false); v += DPPF(v, 0x143, 0xC, false);
    return v;
}
DI int ltid() { int t = threadIdx.x; asm volatile("" : "+v"(t)); return t; }
DI int lbid() { int b = blockIdx.x; asm volatile("" : "+s"(b)); return b; }
DI int lgrid() { int g = gridDim.x; asm volatile("" : "+s"(g)); return g; }
DI f32x16 mfma32(bf16x8 a, bf16x8 b, f32x16 c) { return __builtin_amdgcn_mfma_f32_32x32x16_bf16(a, b, c, 0, 0, 0); }
DI f32x4 mfma16(bf16x8 a, bf16x8 b, f32x4 c) { return __builtin_amdgcn_mfma_f32_16x16x32_bf16(a, b, c, 0, 0, 0); }

#define XB_TMO      128
#define XB_XCNT(j)  (256  + 64 * (j))
#define XB_XSUB(j)  (1280 + 64 * (j))
#define XB_XGEN(j)  (2304 + 64 * (j))
#define XB_TOP      3328
#define XB_TOPGEN   3392
#define XCD_BAR_WORDS 3456
#define XB_SPIN_CAP (1u << 22)
DI unsigned xb_ld(unsigned* p)              { return __hip_atomic_load(p, __ATOMIC_RELAXED, __HIP_MEMORY_SCOPE_AGENT); }
DI unsigned xb_add(unsigned* p, unsigned v) { return __hip_atomic_fetch_add(p, v, __ATOMIC_RELAXED, __HIP_MEMORY_SCOPE_AGENT); }
DI unsigned xb_xcc_id() { return (unsigned)__builtin_amdgcn_s_getreg((3 << 11) | 20) & 0xFu; }
#define XB_SPIN(cond, bar) do { unsigned _sp = 0; while (cond) { __builtin_amdgcn_s_sleep(1); \
    if ((++_sp & 255u) == 0u) { if (xb_ld(&(bar)[XB_TMO])) break; if (_sp > XB_SPIN_CAP) { atomicAdd(&(bar)[XB_TMO], 1u); break; } } } } while (0)
struct XcdBarrier { unsigned* bar; unsigned x; volatile LAS unsigned* st; };
DI XcdBarrier xcd_barrier_post(unsigned* bar, volatile LAS unsigned* st) {
    XcdBarrier b; b.bar = bar; b.x = xb_xcc_id(); b.st = st;
    if (threadIdx.x == 0) (void)xb_add(&bar[XB_XCNT(b.x)], 1u);
    return b;
}
DI void xcd_barrier_complete(unsigned* bar, unsigned x, unsigned& nloc, unsigned& nx) {
    const unsigned G = gridDim.x * gridDim.y * gridDim.z;
    unsigned sum, cnt, mine, sp = 0u;
    for (;;) {
        sum = 0u; cnt = 0u; mine = 0u;
#pragma unroll
        for (unsigned j = 0; j < 16; ++j) { const unsigned c = xb_ld(&bar[XB_XCNT(j)]); sum += c; cnt += (c > 0u) ? 1u : 0u; mine = (j == x) ? c : mine; }
        if (sum == G) break;
        __builtin_amdgcn_s_sleep(1);
        if ((++sp & 255u) == 0u) { if (xb_ld(&bar[XB_TMO])) break; if (sp > XB_SPIN_CAP) { atomicAdd(&bar[XB_TMO], 1u); break; } }
    }
    nloc = mine > 0u ? mine : 1u; nx = cnt > 0u ? cnt : 1u;
}
DI void xcd_barrier(const XcdBarrier& b) {
    asm volatile("s_waitcnt vmcnt(0)" ::: "memory");
    __syncthreads();
    if (threadIdx.x == 0) {
        unsigned* bar = b.bar;
        __builtin_amdgcn_s_waitcnt(0);
        unsigned nloc = b.st[0], nx = b.st[1];
        if (nloc == 0u) { xcd_barrier_complete(bar, b.x, nloc, nx); b.st[0] = nloc; b.st[1] = nx; }
        const unsigned old = xb_add(&bar[XB_XSUB(b.x)], 1u);
        const unsigned gen = old / nloc;
        if (old + 1u == (gen + 1u) * nloc) {
            __builtin_amdgcn_fence(__ATOMIC_RELEASE, "agent");
            asm volatile("s_waitcnt vmcnt(0)" ::: "memory");
            const unsigned og = xb_add(&bar[XB_TOP], 1u);
            const unsigned tg = og / nx;
            if (og + 1u == (tg + 1u) * nx) xb_add(&bar[XB_TOPGEN], 1u);
            else XB_SPIN(xb_ld(&bar[XB_TOPGEN]) == tg, bar);
            __builtin_amdgcn_fence(__ATOMIC_ACQUIRE, "agent");
            xb_add(&bar[XB_XGEN(b.x)], 1u);
            asm volatile("s_waitcnt vmcnt(0)" ::: "memory");
        } else {
            XB_SPIN(xb_ld(&bar[XB_XGEN(b.x)]) == gen, bar);
            __builtin_amdgcn_fence(__ATOMIC_ACQUIRE, "agent");
            asm volatile("s_waitcnt vmcnt(0)" ::: "memory");
        }
    }
    __syncthreads();
}

namespace gs {
constexpr int BM = 256, BK = 64, HALF = 128, HTB = HALF * BK * 2, NXCD = 8, WGM = 8;
__host__ __device__ __forceinline__ int lds_byte(int r, int c) { const int st = (r >> 4) * 2 + (c >> 5), rr = r & 15, cc = c & 31, ob = rr * 64 + cc * 2; return st * 1024 + (ob ^ (((ob >> 9) & 1) << 5)); }
__host__ __device__ __forceinline__ void stage_rc(int b, int& R, int& C) { const int st = b / 1024, sb = b % 1024, swz = sb ^ (((sb >> 9) & 1) << 5); R = (st >> 1) * 16 + swz / 64; C = (st & 1) * 32 + (swz % 64) / 2; }
__host__ __device__ __forceinline__ int perm32(int rho) { const int n = rho >> 4, i = rho & 15; return 8 * (i >> 2) + 4 * n + (i & 3); }
__host__ __device__ __forceinline__ int bh8row(int R) { return (R >> 5) * 64 + 16 * ((R & 15) >> 2) + 4 * ((R >> 4) & 1) + (R & 3); }

struct GU {
    unsigned A, B; const int* idx;
    unsigned lda, ldb;
    int nt;
    int flags;
    int nvalid;
    int a0, a1, a2, a3;
};
struct Unit { int pm, pn; };
struct StaticOrder {
    int nM, nN, nwg, G, c;
    DI void init(int M, int N, int G_, int c_) { nM = M / BM; nN = N / BM; nwg = nM * nN; G = G_; c = c_; }
    DI bool next(int i, Unit& u) const {
        const long L = (long)i * G + c; if (L >= nwg) return false;
        int wgid = (int)L; { const int q = nwg / NXCD, r = nwg % NXCD, xcd = wgid % NXCD, off = wgid / NXCD; wgid = (xcd < r ? xcd * (q + 1) : r * (q + 1) + (xcd - r) * q) + off; }
        const int nig = WGM * nN, gid = wgid / nig, fm = gid * WGM, gsz = (nM - fm) < WGM ? (nM - fm) : WGM;
        u.pm = fm + ((wgid % nig) % gsz); u.pn = (wgid % nig) / gsz; return true;
    }
};

template <class Sched, class Epi, int NBH>
DI void gemm_stream(LAS unsigned char* lds, const char* wsb, Sched& S, Epi& E) {
    constexpr bool GATH = Sched::GATHER, FIXED = Sched::FIXED;
    const int tid = ltid(), wid = __builtin_amdgcn_readfirstlane(tid >> 6), lane = tid & 63, wr = wid >> 2, wc = wid & 3, fr = lane & 15, fq = lane >> 4;
    int R0, C0, R1, C1; stage_rc(tid * 16, R0, C0); stage_rc(tid * 16 + 8192, R1, C1);
    const unsigned Rb0 = Epi::BH8 ? (unsigned)bh8row(R0) : Epi::PERM ? ((R0 & ~31) + perm32(R0 & 31)) : R0, Rb1 = Epi::BH8 ? (unsigned)bh8row(R1) : Epi::PERM ? ((R1 & ~31) + perm32(R1 & 31)) : R1;
    constexpr unsigned BHS = Epi::BH8 ? 8u : (unsigned)HALF;
    const unsigned C0b = (unsigned)C0 * 2u, C1b = (unsigned)C1 * 2u;
    const unsigned ldsw = (unsigned)wid * 1024u;
    const int aoff = lds_byte(wr * 64 + fr, fq * 8), boff = lds_byte(wc * 32 + fr, fq * 8);
#define GS_SA(b, h) (((b) * 2 + (h)) * HTB)
#define GS_SB(b, h) ((4 + (b) * 2 + (h)) * HTB)
#define GS_STG_O(bufoff, gbase, o0, o1) do { \
        unsigned _q0 = (gbase) + (o0), _q1 = (gbase) + (o1); asm volatile("" : "+v"(_q0), "+v"(_q1)); \
        __builtin_amdgcn_global_load_lds((const unsigned*)(wsb + (size_t)_q0), (LAS unsigned*)(lds + (bufoff) + ldsw), 16, 0, 0); \
        __builtin_amdgcn_global_load_lds((const unsigned*)(wsb + (size_t)_q1), (LAS unsigned*)(lds + (bufoff) + ldsw + 8192), 16, 0, 0); } while (0)
#define GS_STGA(bufoff, gbase, h, r0, r1, ld) do { if constexpr (FIXED) GS_STG_O(bufoff, (gbase) + (unsigned)(h) * HALF * (ld), fa0, fa1); \
        else GS_STG_O(bufoff, gbase, (unsigned)(r0) * (ld) + C0b, (unsigned)(r1) * (ld) + C1b); } while (0)
#define GS_STGB(bufoff, gbase, h, ld) do { if constexpr (FIXED) GS_STG_O(bufoff, (gbase) + (unsigned)(h) * BHS * (ld), fb0, fb1); \
        else GS_STG_O(bufoff, (gbase) + (unsigned)(h) * BHS * (ld), Rb0 * (ld) + C0b, Rb1 * (ld) + C1b); } while (0)
#define GS_LDA(dst, b, h) do { _Pragma("unroll") for (int m = 0; m < 4; ++m) _Pragma("unroll") for (int k = 0; k < 2; ++k) dst[m][k] = *(const LAS bf16x8*)(lds + GS_SA(b, h) + aoff + m * 2048 + k * 1024); } while (0)
#define GS_LDB(dst, b, h) do { _Pragma("unroll") for (int n = 0; n < 2; ++n) _Pragma("unroll") for (int k = 0; k < 2; ++k) dst[n][k] = *(const LAS bf16x8*)(lds + GS_SB(b, h) + boff + n * 2048 + k * 1024); } while (0)
#define GS_MMA(ai, bj, At, Bt) do { __builtin_amdgcn_s_setprio(1); _Pragma("unroll") for (int m = 0; m < 4; ++m) _Pragma("unroll") for (int n = 0; n < 2; ++n) _Pragma("unroll") for (int k = 0; k < 2; ++k) \
        acc[ai][bj][m][n] = __builtin_amdgcn_mfma_f32_16x16x32_bf16(Bt[n][k], At[m][k], acc[ai][bj][m][n], 0, 0, 0); __builtin_amdgcn_s_setprio(0); } while (0)
#define GS_WAIT_V(n) asm volatile("s_waitcnt vmcnt(" #n ")" ::: "memory")
#define GS_WAIT_L(n) asm volatile("s_waitcnt lgkmcnt(" #n ")" ::: "memory")
#define GS_BAR __builtin_amdgcn_s_barrier()
#define GS_SCHED __builtin_amdgcn_sched_barrier(0)
#define GS_ROWS(u, ia) do { if (GATH) { if ((u).idx) { \
            ia[0] = R0 < (u).nvalid ? (unsigned)(u).idx[R0] : 0u; ia[1] = R1 < (u).nvalid ? (unsigned)(u).idx[R1] : 0u; \
            ia[2] = HALF + R0 < (u).nvalid ? (unsigned)(u).idx[HALF + R0] : 0u; ia[3] = HALF + R1 < (u).nvalid ? (unsigned)(u).idx[HALF + R1] : 0u; } \
        else { ia[0] = R0; ia[1] = R1; ia[2] = HALF + R0; ia[3] = HALF + R1; } } } while (0)
    GU cur, nxt; int ui = 0;
    if (!S.next(0, cur)) return;
    f32x4 acc[2][NBH][4][2];
#pragma unroll
    for (int a = 0; a < 2; ++a)
#pragma unroll
        for (int b = 0; b < NBH; ++b)
#pragma unroll
            for (int m = 0; m < 4; ++m)
#pragma unroll
                for (int n = 0; n < 2; ++n) acc[a][b][m][n] = (f32x4){0.f, 0.f, 0.f, 0.f};
    bf16x8 At[4][2], B0[2][2], B1[2][2];
    unsigned ia[4] = {(unsigned)R0, (unsigned)R1, (unsigned)(HALF + R0), (unsigned)(HALF + R1)}, na[4] = {(unsigned)R0, (unsigned)R1, (unsigned)(HALF + R0), (unsigned)(HALF + R1)};
    GS_ROWS(cur, ia);
    unsigned cA = cur.A, cB = cur.B;
    unsigned lda = cur.lda, ldb = cur.ldb;
    const unsigned fa0 = (unsigned)R0 * lda + C0b, fa1 = (unsigned)R1 * lda + C1b, fb0 = Rb0 * ldb + C0b, fb1 = Rb1 * ldb + C1b;
    if constexpr (NBH == 2) {
        GS_STGB(GS_SB(0, 0), cB, 0, ldb); GS_STGB(GS_SB(0, 1), cB, 1, ldb); GS_STGA(GS_SA(0, 0), cA, 0, ia[0], ia[1], lda); GS_STGA(GS_SA(0, 1), cA, 1, ia[2], ia[3], lda);
        if (wr == 1) GS_BAR;
        GS_WAIT_V(2); GS_BAR;
        GS_STGB(GS_SB(1, 0), cB + 128, 0, ldb); GS_STGA(GS_SA(1, 0), cA + 128, 0, ia[0], ia[1], lda); GS_STGB(GS_SB(1, 1), cB + 128, 1, ldb);
        GS_WAIT_V(6); GS_BAR;
    } else {
        GS_STGB(GS_SB(0, 0), cB, 0, ldb); GS_STGA(GS_SA(0, 0), cA, 0, ia[0], ia[1], lda); GS_STGA(GS_SA(0, 1), cA, 1, ia[2], ia[3], lda);
        if (wr == 1) GS_BAR;
        GS_WAIT_V(2); GS_BAR;
        GS_STGB(GS_SB(1, 0), cB + 128, 0, ldb); GS_STGA(GS_SA(1, 0), cA + 128, 0, ia[0], ia[1], lda);
        GS_WAIT_V(4); GS_BAR;
    }
    for (;;) {
        const bool has_next = S.next(ui + 1, nxt);
        unsigned nA = cA, nB = cB, nlda = lda, nldb = ldb;
        if (has_next) { GS_ROWS(nxt, na); nA = nxt.A; nB = nxt.B; nlda = nxt.lda; nldb = nxt.ldb; }
        else if (GATH) { na[0] = ia[0]; na[1] = ia[1]; na[2] = ia[2]; na[3] = ia[3]; }
        const int nt = cur.nt;
        for (int t = 0; t < nt; t += 2) {
            const bool last = (t == nt - 2);
            const unsigned a1 = cA + (unsigned)(t + 1) * 128u;
            const unsigned a2 = last ? nA : cA + (unsigned)(t + 2) * 128u, b2 = last ? nB : cB + (unsigned)(t + 2) * 128u;
            const unsigned a3 = a2 + 128u, b3 = b2 + 128u;
            const unsigned xlda = last ? nlda : lda, xldb = last ? nldb : ldb;
            unsigned x0, x1, x2, x3;
            if (GATH) { x0 = last ? na[0] : ia[0]; x1 = last ? na[1] : ia[1]; x2 = last ? na[2] : ia[2]; x3 = last ? na[3] : ia[3]; }
            else { x0 = R0; x1 = R1; x2 = HALF + R0; x3 = HALF + R1; }
            if constexpr (NBH == 2) {
                GS_LDB(B0, 0, 0); GS_LDB(B1, 0, 1); GS_SCHED; GS_LDA(At, 0, 0); GS_STGA(GS_SA(1, 1), a1, 1, ia[2], ia[3], lda);
                GS_WAIT_V(8); GS_WAIT_L(0); GS_BAR; GS_MMA(0, 0, At, B0); GS_MMA(0, 1, At, B1); GS_BAR; GS_SCHED;
                GS_LDA(At, 0, 1); GS_STGB(GS_SB(0, 0), b2, 0, xldb); GS_STGB(GS_SB(0, 1), b2, 1, xldb); GS_STGA(GS_SA(0, 0), a2, 0, x0, x1, xlda);
                GS_WAIT_V(8); GS_WAIT_L(0); GS_BAR; GS_MMA(1, 0, At, B0); GS_MMA(1, 1, At, B1); GS_BAR; GS_SCHED;
                GS_LDB(B0, 1, 0); GS_LDB(B1, 1, 1); GS_SCHED; GS_LDA(At, 1, 0); GS_STGA(GS_SA(0, 1), a2, 1, x2, x3, xlda);
                GS_WAIT_V(8); GS_WAIT_L(0); GS_BAR; GS_MMA(0, 0, At, B0); GS_MMA(0, 1, At, B1); GS_BAR; GS_SCHED;
                GS_LDA(At, 1, 1); GS_STGB(GS_SB(1, 0), b3, 0, xldb); GS_STGB(GS_SB(1, 1), b3, 1, xldb); GS_STGA(GS_SA(1, 0), a3, 0, x0, x1, xlda);
                GS_WAIT_V(8); GS_WAIT_L(0); GS_BAR; GS_MMA(1, 0, At, B0); GS_MMA(1, 1, At, B1); GS_BAR; GS_SCHED;
            } else {
                GS_LDB(B0, 0, 0); GS_SCHED; GS_LDA(At, 0, 0); GS_STGA(GS_SA(1, 1), a1, 1, ia[2], ia[3], lda);
                GS_WAIT_V(6); GS_WAIT_L(0); GS_BAR; GS_MMA(0, 0, At, B0); GS_BAR; GS_SCHED;
                GS_LDA(At, 0, 1); GS_STGB(GS_SB(0, 0), b2, 0, xldb); GS_STGA(GS_SA(0, 0), a2, 0, x0, x1, xlda);
                GS_WAIT_V(6); GS_WAIT_L(0); GS_BAR; GS_MMA(1, 0, At, B0); GS_BAR; GS_SCHED;
                GS_LDB(B0, 1, 0); GS_SCHED; GS_LDA(At, 1, 0); GS_STGA(GS_SA(0, 1), a2, 1, x2, x3, xlda);
                GS_WAIT_V(6); GS_WAIT_L(0); GS_BAR; GS_MMA(0, 0, At, B0); GS_BAR; GS_SCHED;
                GS_LDA(At, 1, 1); GS_STGB(GS_SB(1, 0), b3, 0, xldb); GS_STGA(GS_SA(1, 0), a3, 0, x0, x1, xlda);
                GS_WAIT_V(6); GS_WAIT_L(0); GS_BAR; GS_MMA(1, 0, At, B0); GS_BAR; GS_SCHED;
            }
        }
        if (cur.flags & 2) {
            if (wr == 0) GS_BAR;
            E(acc, cur, wr, wc, fr, fq);
        }
        if (!has_next) break;
        if (nxt.flags & 1) {
#pragma unroll
            for (int a = 0; a < 2; ++a)
#pragma unroll
                for (int b = 0; b < NBH; ++b)
#pragma unroll
                    for (int m = 0; m < 4; ++m)
#pragma unroll
                        for (int n = 0; n < 2; ++n) acc[a][b][m][n] = (f32x4){0.f, 0.f, 0.f, 0.f};
        }
        const bool did_epi = (cur.flags & 2) != 0;
        cur = nxt; cA = nA; cB = nB; lda = nlda; ldb = nldb; ++ui;
        if (GATH) { ia[0] = na[0]; ia[1] = na[1]; ia[2] = na[2]; ia[3] = na[3]; }
        if (did_epi) { if (wr == 1) GS_BAR; }
    }
    GS_WAIT_V(0);
    if (!(cur.flags & 2)) { if (wr == 0) GS_BAR; }
    GS_BAR;
#undef GS_SA
#undef GS_SB
#undef GS_STG_O
#undef GS_STGA
#undef GS_STGB
#undef GS_LDA
#undef GS_LDB
#undef GS_MMA
#undef GS_WAIT_V
#undef GS_WAIT_L
#undef GS_BAR
#undef GS_SCHED
#undef GS_ROWS
}
}

struct Args {
    const float* x; const int* pos; const float* w_in; const float* b_f; const float* pe_cmp; const float* w_cmp1; const float* w_cmp2;
    const float* w_gate; const float* w_br; const float* w_o; const float* ln1_g; const float* ln1_b; const float* w_router; const float* router_bias;
    const float* w_eg; const float* w_eu; const float* w_ed; const float* w_sg; const float* w_su; const float* w_sd; const float* ln2_g; const float* ln2_b;
    float* out; unsigned char* ws; int ph_lo, ph_hi;
};

DI void ph_prologue(const Args& a, int gw, int NGW, int lane) {
    bf16* xb = (bf16*)(a.ws + WS_XB);
    for (int row = gw; row < NTOK; row += NGW) {
        const f32x4* xr = (const f32x4*)(a.x + (size_t)row * DM) + lane;
        u32x2* o = (u32x2*)(xb + (size_t)row * DM) + lane;
#pragma unroll
        for (int j = 0; j < 4; ++j) { const f32x4 v = xr[64 * j]; u32x2 w; w.x = cvtpk(v.x, v.y); w.y = cvtpk(v.z, v.w); o[64 * j] = w; }
    }
    float* rope = (float*)(a.ws + WS_ROPE);
    constexpr float INVF[8] = {1.0f, 0.1939227432012558f, 0.03760603070259094f, 0.007292664609849453f, 0.0014142135623842478f, 0.00027424818836152554f, 5.318296098266728e-05f, 1.0313386155758053e-05f};
    for (int i = gw * 64 + lane; i < NTOK; i += NGW * 64) {
        const float p = (float)a.pos[i];
#pragma unroll
        for (int j = 0; j < 8; ++j) {
            const float ang = p * INVF[j];
            const double rev = (double)ang * 0.15915494309189535;
            const float fr = (float)(rev - __builtin_rint(rev));
            rope[(size_t)i * 16 + j] = __builtin_amdgcn_cosf(fr);
            rope[(size_t)i * 16 + 8 + j] = __builtin_amdgcn_sinf(fr);
        }
    }
}

constexpr float Y_SCALE = 16.f;
struct CvtItem { const float* W; bf16* WT; int N, n0, nv, k0, dK, drow0, mode; float scale; };
__device__ const int SEG_SRC[21] = {0, 652, 908, 1164, 1420, 1676, 1932, 2192, 2576, 256, 320, 384, 448, 512, 576, 2448, 2512, 2832, 640, 2188, 2896};
__device__ const int SEG_DST[21] = {C_AQ, C_BQ, C_BK, C_BV, C_CQ, C_CK, C_CV, C_DQ, C_DIQ, C_AKC, C_AVC, C_AKS, C_AVS, C_AKW, C_AVW, C_DK, C_DV, C_DIK, 2880, 2892, 2896};
constexpr int CVT_I_IN = 93 * 16, CVT_I_G = 2048, CVT_I_BR = 512, CVT_I_O = 512, CVT_I_C1 = 128, CVT_I_R = 64, CVT_I_E = 65 * 384, CVT_I_CB = 2;
constexpr int CVT_NIT = CVT_I_IN + CVT_I_G + CVT_I_BR + CVT_I_O + CVT_I_C1 + CVT_I_R + CVT_I_E + CVT_I_CB;
DI CvtItem cvt_decode(const Args& a, int l, int it) {
    unsigned char* ws = a.ws; CvtItem c; c.mode = 0; c.nv = 32; c.scale = 1.f;
    int r = it;
    if (r < CVT_I_IN) {
        const int kb = r / 93, ci = r % 93; int seg, off;
        if (ci < 72) { seg = ci >> 3; off = (ci & 7) * 32; } else if (ci < 90) { seg = 9 + ((ci - 72) >> 1); off = ((ci - 72) & 1) * 32; }
        else { seg = 18 + (ci - 90); off = 0; c.nv = (seg == 18) ? 12 : 4; }
        if (seg == 0 || seg == 1 || seg == 4 || seg == 7) c.scale = QS;
        c.W = a.w_in + (size_t)l * DM * IN_W; c.N = IN_W; c.n0 = SEG_SRC[seg] + off; c.k0 = kb * 64; c.WT = (bf16*)(ws + W_IN); c.dK = DM; c.drow0 = SEG_DST[seg] + off; return c; }
    r -= CVT_I_IN;
    if (r < CVT_I_G) { const int m = r >> 9, q = r & 511, kb = q >> 5, nb = q & 31;
        c.W = a.w_gate + (size_t)(l * 4 + m) * DM * DM; c.N = DM; c.n0 = nb * 32; c.k0 = kb * 64; c.WT = (bf16*)(ws + W_G) + (size_t)m * DM * DM; c.dK = DM; c.drow0 = nb * 32; c.scale = -LOG2E; return c; }
    r -= CVT_I_G;
    if (r < CVT_I_BR) { const int m = r >> 7, q = r & 127, kb = q >> 5, nb = q & 31;
        c.W = a.w_br + (size_t)(l * 4 + m) * 256 * DM; c.N = DM; c.n0 = nb * 32; c.k0 = kb * 64; c.WT = (bf16*)(ws + W_BR) + (size_t)m * DM * 256; c.dK = 256; c.drow0 = nb * 32; return c; }
    r -= CVT_I_BR;
    if (r < CVT_I_O) { const int kb = r >> 5, nb = r & 31;
        c.W = a.w_o + (size_t)l * DM * DM; c.N = DM; c.n0 = nb * 32; c.k0 = kb * 64; c.WT = (bf16*)(ws + W_O); c.dK = DM; c.drow0 = nb * 32; return c; }
    r -= CVT_I_O;
    if (r < CVT_I_C1) { const int j = r >> 6, q = r & 63, kb = q >> 1, nb = q & 1;
        c.W = a.w_cmp1 + (size_t)(l * 2 + j) * 2048 * 64; c.N = 64; c.n0 = nb * 32; c.k0 = kb * 64; c.WT = (bf16*)(ws + W_C1) + (size_t)j * 256 * 2048; c.dK = 2048; c.drow0 = nb * 32; return c; }
    r -= CVT_I_C1;
    if (r < CVT_I_R) { const int mode = r >> 5, q = r & 31, kb = q >> 1, nb = q & 1;
        c.W = a.w_router + (size_t)l * DM * 64; c.N = 64; c.n0 = nb * 32; c.k0 = kb * 64; c.WT = (bf16*)(ws + (mode ? W_RL : W_RH)); c.dK = DM; c.drow0 = nb * 32; c.mode = mode; return c; }
    r -= CVT_I_R;
    if (r < CVT_I_E) {
        const int e = r / 384, q = r % 384, which = q >> 7, qq = q & 127;
        if (which < 2) { const int kb = qq >> 3, nb = qq & 7, n0 = nb * 32, pn = n0 >> 7, i0 = n0 & 127;
            c.W = (which == 0) ? (e < 64 ? a.w_eg + (size_t)(l * 64 + e) * DM * 256 : a.w_sg + (size_t)l * DM * 256) : (e < 64 ? a.w_eu + (size_t)(l * 64 + e) * DM * 256 : a.w_su + (size_t)l * DM * 256);
            c.N = 256; c.n0 = n0; c.k0 = kb * 64; c.WT = (bf16*)(ws + W_1) + (size_t)e * 512 * DM; c.dK = DM; c.drow0 = pn * 256 + which * 128 + i0;
        } else { const int kb = qq >> 5, nb = qq & 31;
            c.W = e < 64 ? a.w_ed + (size_t)(l * 64 + e) * 256 * DM : a.w_sd + (size_t)l * 256 * DM; c.N = DM; c.n0 = nb * 32; c.k0 = kb * 64; c.WT = (bf16*)(ws + W_2) + (size_t)e * DM * 256; c.dK = 256; c.drow0 = nb * 32; c.scale = Y_SCALE; }
        return c; }
    r -= CVT_I_E;
    c.mode = 2; c.n0 = r; c.W = nullptr; c.WT = nullptr; c.N = 0; c.k0 = 0; c.dK = 0; c.drow0 = 0; return c;
}
DI void cvt_load(const CvtItem& c, f32x4 (&v)[8], int lane) {
    if (c.mode == 2) return;
    if (c.nv == 32 && ((c.N | c.n0) & 3) == 0) {
#pragma unroll
        for (int i = 0; i < 8; ++i) v[i] = *(const f32x4*)(c.W + (size_t)(c.k0 + 8 * i + (lane >> 3)) * c.N + c.n0 + (lane & 7) * 4);
    } else {
#pragma unroll
        for (int i = 0; i < 8; ++i) { const float* p = c.W + (size_t)(c.k0 + 8 * i + (lane >> 3)) * c.N + c.n0 + (lane & 7) * 4; const int c4 = (lane & 7) * 4;
            v[i][0] = (c4 + 0 < c.nv) ? p[0] : 0.f; v[i][1] = (c4 + 1 < c.nv) ? p[1] : 0.f; v[i][2] = (c4 + 2 < c.nv) ? p[2] : 0.f; v[i][3] = (c4 + 3 < c.nv) ? p[3] : 0.f; }
    }
}
DI void cvt_finish(const Args& a, int l, const CvtItem& c, const f32x4 (&v)[8], LAS float* scr, int lane) {
    if (c.mode == 2) {
        const int j = c.n0; const float* pe = a.pe_cmp + (size_t)(l * 2 + j) * 2048; const float* w1 = a.w_cmp1 + (size_t)(l * 2 + j) * 2048 * 64;
        float s = 0.f;
        for (int k = 0; k < 2048; ++k) s += pe[k] * w1[(size_t)k * 64 + lane];
        ((float*)(a.ws + WS_CBIAS))[j * 64 + lane] = s; return; }
#pragma unroll
    for (int i = 0; i < 8; ++i) { const int kk = 8 * i + (lane >> 3), c4 = (lane & 7) * 4; scr[kk * 33 + c4] = v[i][0]; scr[kk * 33 + c4 + 1] = v[i][1]; scr[kk * 33 + c4 + 2] = v[i][2]; scr[kk * 33 + c4 + 3] = v[i][3]; }
    LDS_WAIT(); asm volatile("" ::: "memory");
    const int cc = lane & 7;
#pragma unroll
    for (int j = 0; j < 4; ++j) {
        const int n = (lane >> 3) + 8 * j; const LAS float* s = scr + (8 * cc) * 33 + n;
        float w[8];
#pragma unroll
        for (int q = 0; q < 8; ++q) { w[q] = s[q * 33] * c.scale; if (c.mode == 1) { const float h = __uint_as_float(cvtpk(w[q], 0.f) << 16); w[q] = w[q] - h; } }
        u32x4 o; o.x = cvtpk(w[0], w[1]); o.y = cvtpk(w[2], w[3]); o.z = cvtpk(w[4], w[5]); o.w = cvtpk(w[6], w[7]);
        if (n < c.nv) *(u32x4*)(c.WT + (size_t)(c.drow0 + n) * c.dK + c.k0 + 8 * cc) = o;
    }
    LDS_WAIT(); asm volatile("" ::: "memory");
}
DI void ph_cvt(const Args& a, int l, LAS unsigned char* lds, int gw, int NGW, int wave, int lane) {
    LAS float* scr = (LAS float*)(lds + wave * 8704);
    f32x4 va[8], vb[8];
    CvtItem ca, cb; ca.mode = 2; ca.n0 = 0;
    int it = gw;
    if (it < CVT_NIT) { ca = cvt_decode(a, l, it); cvt_load(ca, va, lane); }
    for (; it < CVT_NIT; it += 2 * NGW) {
        const bool hasb = it + NGW < CVT_NIT;
        if (hasb) { cb = cvt_decode(a, l, it + NGW); cvt_load(cb, vb, lane); }
        cvt_finish(a, l, ca, va, scr, lane);
        const bool hasa = it + 2 * NGW < CVT_NIT;
        if (hasa) { ca = cvt_decode(a, l, it + 2 * NGW); cvt_load(ca, va, lane); }
        if (hasb) cvt_finish(a, l, cb, vb, scr, lane);
    }
}

DI void rope4(float (&v)[4], int a, const float* rp, float scale) {
    float pv[4];
#pragma unroll
    for (int i = 0; i < 4; ++i) pv[i] = dpp_xor2(v[i]);
    const f32x4 c4 = *(const f32x4*)(rp + 4 * (a & 1)), s4 = *(const f32x4*)(rp + 8 + 4 * (a & 1));
    if (a < 4) {
#pragma unroll
        for (int i = 0; i < 4; ++i) v[i] = (a < 2) ? (v[i] * c4[i] - pv[i] * s4[i]) : (pv[i] * s4[i] + v[i] * c4[i]);
    }
#pragma unroll
    for (int i = 0; i < 4; ++i) v[i] *= scale;
}
DI void ld4bf(const bf16* p, float (&v)[4]) { const u32x2 w = *(const u32x2*)p; v[0] = bflo(w.x); v[1] = bfhi(w.x); v[2] = bflo(w.y); v[3] = bfhi(w.y); }
DI void st4bf(bf16* p, const float (&v)[4]) { u32x2 w; w.x = cvtpk(v[0], v[1]); w.y = cvtpk(v[2], v[3]); *(u32x2*)p = w; }

DI void ph_post(const Args& a, int l, LAS unsigned char* lds, int wave, int lane) {
    unsigned char* ws = a.ws;
    bf16* proj = (bf16*)(ws + WS_A);
    const float* rope = (const float*)(ws + WS_ROPE);
    const float* sm32 = (const float*)(ws + WS_SM32);
    LAS bf16* T = (LAS bf16*)(lds + wave * 9216);
    for (int tile = lbid(); tile < NTOK / 64; tile += lgrid()) {
        const int tok0 = tile * 64;
        float kmx = 0.f;
        for (int tt = wave; tt < 64; tt += NWAVES) {
            const int tok = tok0 + tt; bf16* row = proj + (size_t)tok * PW;
            const float* cs = rope + (size_t)tok * 16;
            const int ah = lane & 15;
            float v[4];
            ld4bf(row + C_AQ + 4 * lane, v); rope4(v, ah, cs, 1.0f); st4bf(row + C_AQ + 4 * lane, v);
            ld4bf(row + C_DQ + 4 * lane, v); rope4(v, ah, cs, 1.0f); st4bf(row + C_DQ + 4 * lane, v);
            ld4bf(row + C_DIQ + 4 * lane, v); rope4(v, ah, cs, 1.0f); st4bf(row + C_DIQ + 4 * lane, v);
            {
                const int tl = tok % SEQ, kin = tl & 31, slot = (kin & ~12) | ((kin & 4) << 1) | ((kin & 8) >> 1), hq = lane >> 4;
                const size_t toff = (((size_t)(tok / SEQ) * 4 + hq) * (SEQ / 32) + (tl >> 5)) * 2048 + ((ah >> 1) * 32 + slot) * 8 + (ah & 1) * 4;
                *(u32x2*)((bf16*)(ws + WS_KTB) + toff) = *(const u32x2*)(row + C_BK + 4 * lane);
                const u32x2 ckw = *(const u32x2*)(row + C_CK + 4 * lane);
                *(u32x2*)((bf16*)(ws + WS_KTC) + toff) = ckw;
                float sq = bflo(ckw.x) * bflo(ckw.x) + bfhi(ckw.x) * bfhi(ckw.x) + bflo(ckw.y) * bflo(ckw.y) + bfhi(ckw.y) * bfhi(ckw.y);
                sq += dpp_xor1(sq); sq += dpp_xor2(sq); sq += DPPF(sq, 0x124, 0xF, true); sq += DPPF(sq, 0x128, 0xF, true);
                kmx = fmaxf(kmx, sq);
            }
            { const int hk = lane >> 4; const int cb = (hk == 0) ? C_AKS : (hk == 1) ? C_AKW : (hk == 2) ? C_DK : C_DIK;
              ld4bf(row + cb + 4 * ah, v); rope4(v, ah, cs, 1.0f); st4bf(row + cb + 4 * ah, v);
              if (hk < 2) {
                  const int tl = tok % SEQ, kin = tl & 31, slot = (kin & ~12) | ((kin & 4) << 1) | ((kin & 8) >> 1);
                  bf16* kt = (bf16*)(ws + (hk == 0 ? WS_KTS : WS_KTW)) + ((size_t)(tok / SEQ) * (SEQ / 32) + (tl >> 5)) * 2048 + ((ah >> 1) * 32 + slot) * 8 + (ah & 1) * 4;
                  st4bf(kt, v); }
              if (hk == 3) {
                  const int tl = tok % SEQ;
                  bf16* it = (bf16*)(ws + WS_IKT) + ((size_t)(tok / SEQ) * (SEQ / 32) + (tl >> 5)) * 2048 + ((ah >> 1) * 32 + (tl & 31)) * 8 + (ah & 1) * 4;
                  st4bf(it, v); } }
            if (lane < 32) { const int j = lane >> 4; const u32x2 w = *(const u32x2*)(row + (j ? C_AVC : C_AKC) + 4 * ah);
                *(u32x2*)((bf16*)(ws + (j ? WS_VCR : WS_KCR)) + (size_t)tok * 64 + 4 * ah) = w; }
            if (lane < 20) {
                const float s = sm32[(size_t)tok * 32 + lane];
                if (lane < 12) ((float*)(ws + WS_GATE))[(size_t)tok * 12 + lane] = sigmoidf_(s);
                else if (lane < 16) { const float z = s + a.b_f[l * 4 + (lane - 12)];
                    ((float*)(ws + WS_LOGF))[(size_t)tok * 4 + (lane - 12)] = fminf(z, 0.f) * LOG2E - flog2(1.f + fexp2(-fabsf(z) * LOG2E)); }
                else ((float*)(ws + WS_IW))[(size_t)tok * 4 + (lane - 16)] = s;
            }
        }
        if ((lane & 15) == 0) atomicMax((unsigned*)(ws + WS_CTL) + CW_KMAX + l * 32 + (tok0 / SEQ) * 4 + (lane >> 4), __float_as_uint(kmx * 1.02f));
        const int bidx = tok0 / SEQ, tl0 = tok0 % SEQ;
        for (int hv = wave; hv < 10; hv += NWAVES) {
            int cb; bf16* dst;
            if (hv < 4) { cb = C_BV + 64 * hv; dst = (bf16*)(ws + WS_VTB) + (size_t)(bidx * 4 + hv) * 64 * SEQ; }
            else if (hv < 8) { cb = C_CV + 64 * (hv - 4); dst = (bf16*)(ws + WS_VTC) + (size_t)(bidx * 4 + hv - 4) * 64 * SEQ; }
            else if (hv == 8) { cb = C_AVS; dst = (bf16*)(ws + WS_VTAS) + (size_t)bidx * 64 * SEQ; }
            else { cb = C_AVW; dst = (bf16*)(ws + WS_VTAW) + (size_t)bidx * 64 * SEQ; }
            const bf16* src = proj + (size_t)(tok0 + lane) * PW + cb;
#pragma unroll
            for (int i = 0; i < 8; ++i) { const u32x4 w = *(const u32x4*)(src + 8 * i);
                T[(8 * i + 0) * 72 + lane] = (bf16)(w.x & 0xffff); T[(8 * i + 1) * 72 + lane] = (bf16)(w.x >> 16);
                T[(8 * i + 2) * 72 + lane] = (bf16)(w.y & 0xffff); T[(8 * i + 3) * 72 + lane] = (bf16)(w.y >> 16);
                T[(8 * i + 4) * 72 + lane] = (bf16)(w.z & 0xffff); T[(8 * i + 5) * 72 + lane] = (bf16)(w.z >> 16);
                T[(8 * i + 6) * 72 + lane] = (bf16)(w.w & 0xffff); T[(8 * i + 7) * 72 + lane] = (bf16)(w.w >> 16); }
            LDS_WAIT(); asm volatile("" ::: "memory");
            {
                const int dt = lane >> 5, cc = lane & 31;
#pragma unroll
                for (int i = 0; i < 8; ++i) { const int tile = i >> 2, sh = i & 3;
                    bf16* d = dst + ((size_t)(tl0 >> 5) + tile) * 2048 + ((dt * 2 + (sh >> 1)) * 64 + (sh & 1) * 32 + cc) * 8;
                    *(u32x4*)d = *(const LAS u32x4*)(T + lane * 72 + 8 * i); }
            }
            LDS_WAIT(); asm volatile("" ::: "memory");
        }
    }
}

DI void cumsum_seq(const Args& a, int bh, int lane) {
    const float* lf = (const float*)(a.ws + WS_LOGF); float* cum = (float*)(a.ws + WS_CUM);
    const int b = bh >> 2, h = bh & 3;
    const float* src = lf + ((size_t)b * SEQ + lane * 128) * 4 + h;
    float s = 0.f;
    for (int i = 0; i < 128; ++i) s += src[(size_t)i * 4];
    const float incl = wave_incl_scan_f(s);
    float run = incl - s;
    float* dst = cum + (size_t)bh * SEQ + lane * 128;
    for (int i = 0; i < 128; ++i) { run += src[(size_t)i * 4]; dst[i] = run; }
}

DI void ph_cmp2(const Args& a, int l, int gw, int NGW, int lane) {
    const float* hid = (const float*)(a.ws + WS_HID);
    bf16* kc = (bf16*)(a.ws + WS_KCMP); bf16* vtc = (bf16*)(a.ws + WS_VTCMP);
    for (int it = gw; it < 2 * 4096; it += NGW) {
        const int j = it >> 12, row = it & 4095, b = row >> 9, n = row & 511;
        const float* h = hid + ((size_t)j * 4096 + row) * 64; const float* w2 = a.w_cmp2 + (size_t)(l * 2 + j) * 64 * 64;
        float s = 0.f;
#pragma unroll 8
        for (int k = 0; k < 64; ++k) s += h[k] * w2[k * 64 + lane];
        if (n == 511) s = 0.f;
        const bf16 o = (bf16)(cvtpk(s, 0.f) & 0xffff);
        const int tile = n >> 5, kin = n & 31;
        if (j == 0) { const int slot = (kin & ~12) | ((kin & 4) << 1) | ((kin & 8) >> 1); kc[((size_t)b * 16 + tile) * 2048 + ((lane >> 3) * 32 + slot) * 8 + (lane & 7)] = o; }
        else { const int sI = kin >> 4, hI = (kin >> 3) & 1, e = kin & 7; vtc[((size_t)b * 16 + tile) * 2048 + (((lane >> 5) * 2 + sI) * 64 + hI * 32 + (lane & 31)) * 8 + e] = o; }
    }
}

DI void ph_ln1(const Args& a, int l, int gw, int NGW, int lane) {
    bf16* xb = (bf16*)(a.ws + WS_XB); bf16* xl = (bf16*)(a.ws + WS_XL);
    const float* g = a.ln1_g + l * DM; const float* be = a.ln1_b + l * DM;
    u32x4 nq0 = {0u,0u,0u,0u}, nq1 = {0u,0u,0u,0u};
    if (gw < NTOK) { const u32x4* x0 = (const u32x4*)(xb + (size_t)gw * DM) + lane; nq0 = x0[0]; nq1 = x0[64]; }
    for (int row = gw; row < NTOK; row += NGW) {
        u32x4* xr = (u32x4*)(xb + (size_t)row * DM) + lane; u32x4* lr = (u32x4*)(xl + (size_t)row * DM) + lane;
        const u32x4 qq[2] = {nq0, nq1};
        if (row + NGW < NTOK) { const u32x4* xn = (const u32x4*)(xb + (size_t)(row + NGW) * DM) + lane; nq0 = xn[0]; nq1 = xn[64]; }
        f32x4 v[4]; float s = 0.f;
#pragma unroll
        for (int j = 0; j < 2; ++j) { const u32x4 q = qq[j];
            v[2 * j] = (f32x4){bflo(q.x), bfhi(q.x), bflo(q.y), bfhi(q.y)}; v[2 * j + 1] = (f32x4){bflo(q.z), bfhi(q.z), bflo(q.w), bfhi(q.w)}; }
#pragma unroll
        for (int j = 0; j < 4; ++j) s += (v[j].x + v[j].y) + (v[j].z + v[j].w);
        const float mean = wave_sum(s) * (1.f / DM); float s2 = 0.f;
#pragma unroll
        for (int j = 0; j < 4; ++j) { v[j] = v[j] - mean; s2 += (v[j].x * v[j].x + v[j].y * v[j].y) + (v[j].z * v[j].z + v[j].w * v[j].w); }
        const float rstd = 1.f / sqrtf(wave_sum(s2) * (1.f / DM) + LN_EPS);
#pragma unroll
        for (int j = 0; j < 2; ++j) {
            const int cb = 8 * lane + 512 * j;
            const f32x4 g0 = *(const f32x4*)(g + cb), g1 = *(const f32x4*)(g + cb + 4), b0 = *(const f32x4*)(be + cb), b1 = *(const f32x4*)(be + cb + 4);
            const f32x4 y0 = v[2 * j] * rstd * g0 + b0, y1 = v[2 * j + 1] * rstd * g1 + b1;
            const u32x4 hi = pack8(y0, y1);
            const f32x4 r0 = {y0[0] - bflo(hi.x), y0[1] - bfhi(hi.x), y0[2] - bflo(hi.y), y0[3] - bfhi(hi.y)}, r1 = {y1[0] - bflo(hi.z), y1[1] - bfhi(hi.z), y1[2] - bflo(hi.w), y1[3] - bfhi(hi.w)};
            xr[64 * j] = hi; lr[64 * j] = pack8(r0, r1);
        }
    }
}

DI void ph_route(const Args& a, int l, LAS unsigned char* lds, int wave, int lane) {
    const float* logit = (const float*)(a.ws + WS_LOGIT);
    u32x2* tokinfo = (u32x2*)(a.ws + WS_TOKINFO);
    unsigned* lists = (unsigned*)(a.ws + WS_LIST);
    unsigned* gcnt = (unsigned*)(a.ws + WS_CTL) + CW_CNT + l * NCH * 64;
    LAS unsigned* lcnt = (LAS unsigned*)lds;
    LAS unsigned* lbase = lcnt + 64;
    LAS unsigned* stash = lbase + 64;
    const float rb = a.router_bias[l * 64 + lane];
    for (int blk = lbid(); blk < NTOK / 256; blk += lgrid()) {
        const int tok0 = blk * 256, c = tok0 / CHTOK;
        if (ltid() < 64) lcnt[ltid()] = 0u;
        __syncthreads();
        for (int tt = wave; tt < 256; tt += NWAVES) {
            const int tok = tok0 + tt;
            const float sc = sigmoidf_(logit[(size_t)tok * 64 + lane]);
            const float bi = sc + rb;
            float m1 = bi;
            m1 = fmaxf(m1, __shfl_xor(m1, 1)); m1 = fmaxf(m1, __shfl_xor(m1, 2)); m1 = fmaxf(m1, __shfl_xor(m1, 4));
            const unsigned long long eqm = __ballot(bi == m1);
            const int gsh = lane & ~7; const unsigned gm = (unsigned)((eqm >> gsh) & 0xffu);
            const int first = __builtin_ctz(gm);
            float v2 = ((lane & 7) == first) ? -3.0e38f : bi;
            v2 = fmaxf(v2, __shfl_xor(v2, 1)); v2 = fmaxf(v2, __shfl_xor(v2, 2)); v2 = fmaxf(v2, __shfl_xor(v2, 4));
            const float gs = m1 + v2;
            const int g = lane >> 3; int grank = 0;
#pragma unroll
            for (int gg = 0; gg < 8; ++gg) { const float o = __int_as_float(__builtin_amdgcn_readlane(__float_as_int(gs), gg * 8)); grank += (o > gs || (o == gs && gg < g)) ? 1 : 0; }
            const float mb = (grank < 4) ? bi : -1.0e30f;
            int rank = 0;
#pragma unroll 4
            for (int e = 0; e < 64; ++e) { const float o = __int_as_float(__builtin_amdgcn_readlane(__float_as_int(mb), e)); rank += (o > mb || (o == mb && e < lane)) ? 1 : 0; }
            const bool sel = rank < 8;
            const float wsum = wave_sum(sel ? sc : 0.f);
            const float w = sc / wsum * 2.5f;
            const unsigned long long sm = __ballot(sel);
            const int k = __popcll(sm & ((1ull << lane) - 1ull));
            if (sel) {
                const unsigned lp = atomicAdd((unsigned*)&lcnt[lane], 1u);
                stash[tt * 8 + k] = ((unsigned)lane << 16) | lp;
                ((float*)tokinfo)[((size_t)tok * 8 + k) * 2 + 1] = w;
            }
        }
        __syncthreads();
        if (ltid() < 64) lbase[ltid()] = atomicAdd(&gcnt[c * 64 + ltid()], lcnt[ltid()]);
        __syncthreads();
        for (int i = ltid(); i < 256 * 8; i += NWAVES * 64) {
            const unsigned s = stash[i]; const unsigned e = s >> 16, lp = s & 0xffffu; const int tok = tok0 + (i >> 3);
            const unsigned pos = lbase[e] + lp;
            lists[((size_t)c * 64 + e) * CHTOK + pos] = (unsigned)tok;
            ((unsigned*)tokinfo)[((size_t)tok * 8 + (i & 7)) * 2] = (e << 16) | pos;
        }
        __syncthreads();
    }
}

typedef f32x4 Acc2[2][2][4][2];
typedef f32x4 Acc1[2][1][4][2];

struct SchedProj {
    static constexpr bool GATHER = false, FIXED = true;
    gs::StaticOrder so; unsigned A, B;
    DI bool next(int i, gs::GU& u) const { gs::Unit t; if (!so.next(i, t)) return false;
        u.A = A + (unsigned)t.pm * 256u * 2048u; u.B = B + (unsigned)t.pn * 256u * 2048u; u.idx = nullptr; u.lda = 2048; u.ldb = 2048; u.nt = 16; u.flags = 3; u.nvalid = 256;
        u.a0 = t.pm; u.a1 = t.pn; u.a2 = 0; u.a3 = 0; return true; }
};
struct EpiProj {
    static constexpr bool PERM = true; static constexpr bool BH8 = false; bf16* proj; float* sm32;
    DI void operator()(const Acc2& acc, const gs::GU& u, int wr, int wc, int fr, int fq) const {
        const int row0 = u.a0 * 256 + wr * 64 + fr, col0 = u.a1 * 256 + wc * 32 + 8 * fq;
#pragma unroll
        for (int ai = 0; ai < 2; ++ai)
#pragma unroll
            for (int m = 0; m < 4; ++m) { const int row = row0 + ai * 128 + m * 16;
#pragma unroll
                for (int bj = 0; bj < 2; ++bj) *(u32x4*)(proj + (size_t)row * PW + col0 + bj * 128) = pack8(acc[ai][bj][m][0], acc[ai][bj][m][1]);
                if (u.a1 == 11 && wc == 2) { *(f32x4*)(sm32 + (size_t)row * 32 + 8 * fq) = acc[ai][0][m][0]; *(f32x4*)(sm32 + (size_t)row * 32 + 8 * fq + 4) = acc[ai][0][m][1]; } }
    }
};

struct SchedCmp {
    static constexpr bool GATHER = false, FIXED = true;
    unsigned kcr, vcr, w;
    DI bool next(int i, gs::GU& u) const { if (i > 0 || lbid() >= 32) return false; const int j = lbid() >> 4, pm = lbid() & 15;
        u.A = (j ? vcr : kcr) + (unsigned)pm * 256u * 2048u; u.B = w + (unsigned)j * 256u * 4096u; u.idx = nullptr; u.lda = 2048; u.ldb = 4096; u.nt = 32; u.flags = 3; u.nvalid = 256;
        u.a0 = pm; u.a1 = j; u.a2 = 0; u.a3 = 0; return true; }
};
struct EpiCmp {
    static constexpr bool PERM = true; static constexpr bool BH8 = false; float* hid; const float* cbias;
    DI void operator()(const Acc2& acc, const gs::GU& u, int wr, int wc, int fr, int fq) const {
        if (wc >= 2) return;
        const int row0 = u.a0 * 256 + wr * 64 + fr, col0 = wc * 32 + 8 * fq, j = u.a1;
        float cb[8];
#pragma unroll
        for (int q = 0; q < 8; ++q) cb[q] = cbias[j * 64 + col0 + q];
#pragma unroll
        for (int ai = 0; ai < 2; ++ai)
#pragma unroll
            for (int m = 0; m < 4; ++m) { const int row = row0 + ai * 128 + m * 16; float o[8];
#pragma unroll
                for (int q = 0; q < 8; ++q) { const float x = acc[ai][0][m][q >> 2][q & 3] + cb[q];
                    const float y2 = 1.5957691216f * (x + 0.044715f * x * x * x);
                    o[q] = x * frcp(1.f + fexp2(-y2 * LOG2E)); }
                float* d = hid + ((size_t)j * 4096 + row) * 64 + col0;
                *(f32x4*)d = (f32x4){o[0], o[1], o[2], o[3]}; *(f32x4*)(d + 4) = (f32x4){o[4], o[5], o[6], o[7]}; }
    }
};

struct SchedMerge {
    static constexpr bool GATHER = false, FIXED = false;
    unsigned xb, om, wg, wbr; int G;
    DI bool next(int i, gs::GU& u) const { const int ti = i >> 3, k = i & 7; const int bid_ = lbid(); const long L = (long)ti * G + bid_; if (L >= 2048) return false;
        int pm = (int)(L >> 3), pc = (int)(L & 7); const int m = k >> 1, kind = k & 1;
        if (G == 256) { const int x = bid_ & 7, idx = bid_ >> 3; pm = ti * 32 + x * 4 + (idx >> 3); pc = idx & 7; }
        if (kind == 0) { u.A = om + (unsigned)pm * 256u * 2048u + (unsigned)m * 512u; u.B = wbr + (unsigned)m * 1024u * 512u + (unsigned)pc * 128u * 512u; u.lda = 2048; u.ldb = 512; u.nt = 4; }
        else           { u.A = xb + (unsigned)pm * 256u * 2048u;           u.B = wg + (unsigned)m * 1024u * 2048u + (unsigned)pc * 128u * 2048u; u.lda = 2048; u.ldb = 2048; u.nt = 16; }
        u.idx = nullptr; u.flags = 3; u.nvalid = 256; u.a0 = pm; u.a1 = pc; u.a2 = kind; u.a3 = m; return true; }
};
struct EpiMerge {
    static constexpr bool PERM = true; static constexpr bool BH8 = false; bf16* merged; u32x4* stash;
    f32x4 M[2][4][2];
    DI void operator()(const Acc1& acc, const gs::GU& u, int wr, int wc, int fr, int fq) {
        const int tid = ltid();
        if (u.a2 == 0) {
#pragma unroll
            for (int ai = 0; ai < 2; ++ai)
#pragma unroll
                for (int m = 0; m < 4; ++m) stash[(ai * 4 + m) * 512 + tid] = pack8(acc[ai][0][m][0], acc[ai][0][m][1]);
        } else {
            const bool first = (u.a3 == 0), lastm = (u.a3 == 3);
            const int row0 = u.a0 * 256 + wr * 64 + fr, col0 = u.a1 * 128 + wc * 32 + 8 * fq;
            if (first) {
#pragma unroll
                for (int ai = 0; ai < 2; ++ai)
#pragma unroll
                    for (int m = 0; m < 4; ++m) { M[ai][m][0] = (f32x4){0.f, 0.f, 0.f, 0.f}; M[ai][m][1] = (f32x4){0.f, 0.f, 0.f, 0.f}; }
            }
#pragma unroll
            for (int ai = 0; ai < 2; ++ai)
#pragma unroll
                for (int m = 0; m < 4; ++m) {
                    const u32x4 p = stash[(ai * 4 + m) * 512 + tid];
                    const f32x4 g0 = acc[ai][0][m][0], g1 = acc[ai][0][m][1];
                    f32x4 m0 = M[ai][m][0], m1 = M[ai][m][1];
                    m0[0] = __builtin_fmaf(frcp(1.f + fexp2(g0[0])), bflo(p.x), m0[0]); m0[1] = __builtin_fmaf(frcp(1.f + fexp2(g0[1])), bfhi(p.x), m0[1]);
                    m0[2] = __builtin_fmaf(frcp(1.f + fexp2(g0[2])), bflo(p.y), m0[2]); m0[3] = __builtin_fmaf(frcp(1.f + fexp2(g0[3])), bfhi(p.y), m0[3]);
                    m1[0] = __builtin_fmaf(frcp(1.f + fexp2(g1[0])), bflo(p.z), m1[0]); m1[1] = __builtin_fmaf(frcp(1.f + fexp2(g1[1])), bfhi(p.z), m1[1]);
                    m1[2] = __builtin_fmaf(frcp(1.f + fexp2(g1[2])), bflo(p.w), m1[2]); m1[3] = __builtin_fmaf(frcp(1.f + fexp2(g1[3])), bfhi(p.w), m1[3]);
                    M[ai][m][0] = m0; M[ai][m][1] = m1;
                    asm volatile("" : "+v"(M[ai][m][0]), "+v"(M[ai][m][1]));
                    if (lastm) *(u32x4*)(merged + (size_t)(row0 + ai * 128 + m * 16) * DM + col0) = pack8(M[ai][m][0], M[ai][m][1]);
                    asm volatile("" ::: "memory");
                }
        }
    }
};

struct SchedWo {
    static constexpr bool GATHER = false, FIXED = true;
    gs::StaticOrder so; unsigned A, B;
    DI bool next(int i, gs::GU& u) const { gs::Unit t; if (!so.next(i, t)) return false;
        u.A = A + (unsigned)t.pm * 256u * 2048u; u.B = B + (unsigned)t.pn * 256u * 2048u; u.idx = nullptr; u.lda = 2048; u.ldb = 2048; u.nt = 16; u.flags = 3; u.nvalid = 256;
        u.a0 = t.pm; u.a1 = t.pn; u.a2 = 0; u.a3 = 0; return true; }
};
struct EpiWo {
    static constexpr bool PERM = true; static constexpr bool BH8 = false; bf16* xb;
    DI void operator()(const Acc2& acc, const gs::GU& u, int wr, int wc, int fr, int fq) const {
        const int row0 = u.a0 * 256 + wr * 64 + fr, col0 = u.a1 * 256 + wc * 32 + 8 * fq;
#pragma unroll
        for (int ai = 0; ai < 2; ++ai)
#pragma unroll
            for (int m = 0; m < 4; ++m) {
#pragma unroll
                for (int bj = 0; bj < 2; ++bj) { bf16* p = xb + (size_t)(row0 + ai * 128 + m * 16) * DM + col0 + bj * 128; const u32x4 xv = *(const u32x4*)p;
                    f32x4 v0 = acc[ai][bj][m][0], v1 = acc[ai][bj][m][1];
                    v0[0] += ALPHA * bflo(xv.x); v0[1] += ALPHA * bfhi(xv.x); v0[2] += ALPHA * bflo(xv.y); v0[3] += ALPHA * bfhi(xv.y);
                    v1[0] += ALPHA * bflo(xv.z); v1[1] += ALPHA * bfhi(xv.z); v1[2] += ALPHA * bflo(xv.w); v1[3] += ALPHA * bfhi(xv.w);
                    *(u32x4*)p = pack8(v0, v1); } }
    }
};

struct SchedRouter {
    static constexpr bool GATHER = false, FIXED = true;
    unsigned xh, xl, wh, wl; int G;
    DI bool next(int i, gs::GU& u) const { const int ti = i / 3, k = i % 3; const int pm = ti * G + lbid(); if (pm >= 256) return false;
        u.A = ((k == 1) ? xl : xh) + (unsigned)pm * 256u * 2048u; u.B = (k == 2) ? wl : wh; u.idx = nullptr; u.lda = 2048; u.ldb = 2048; u.nt = 16;
        u.flags = (k == 0 ? 1 : 0) | (k == 2 ? 2 : 0); u.nvalid = 256; u.a0 = pm; u.a1 = 0; u.a2 = 0; u.a3 = 0; return true; }
};
struct EpiRouter {
    static constexpr bool PERM = false; static constexpr bool BH8 = false; float* logit;
    DI void operator()(const Acc1& acc, const gs::GU& u, int wr, int wc, int fr, int fq) const {
        if (wc >= 2) return;
        const int row0 = u.a0 * 256 + wr * 64 + fr, col0 = wc * 32 + 4 * fq;
#pragma unroll
        for (int ai = 0; ai < 2; ++ai)
#pragma unroll
            for (int m = 0; m < 4; ++m)
#pragma unroll
                for (int n = 0; n < 2; ++n) *(f32x4*)(logit + (size_t)(row0 + ai * 128 + m * 16) * 64 + col0 + n * 16) = acc[ai][0][m][n];
    }
};

constexpr int TBL_OFF = 131072, NPAIR = NCH * 65, TBLN = 528;
static_assert(NPAIR + 1 <= TBLN && TBL_OFF + 3 * TBLN * 4 <= MISC_OFF, "MoE tables");
DI void moe_tables(const Args& a, int l, LAS unsigned char* lds) {
    LAS int* ptile = (LAS int*)(lds + TBL_OFF); LAS int* ypre = ptile + TBLN; LAS int* cntv = ypre + TBLN;
    __syncthreads();
    const int tid_ = ltid();
    if (tid_ < 64) {
        const unsigned* gcnt = (const unsigned*)(a.ws + WS_CTL) + CW_CNT + l * NCH * 64;
        int pt = 0;
        for (int c = 0; c < NCH; ++c) {
            const int n = (int)__hip_atomic_load(gcnt + c * 64 + tid_, __ATOMIC_RELAXED, __HIP_MEMORY_SCOPE_AGENT);
            const int tl = (n + 255) >> 8;
            const int tinc = wave_incl_scan(tl), yinc = wave_incl_scan(n);
            const int p = c * 65 + tid_;
            cntv[p] = n; ptile[p] = pt + tinc - tl; ypre[p] = yinc - n;
            const int ttot = __builtin_amdgcn_readlane(tinc, 63), ytot = __builtin_amdgcn_readlane(yinc, 63);
            if (tid_ == 0) { cntv[c * 65 + 64] = CHTOK; ptile[c * 65 + 64] = pt + ttot; ypre[c * 65 + 64] = ytot; }
            pt += ttot + CHTOK / 256;
        }
        if (tid_ == 0) ptile[NPAIR] = pt;
    }
    __syncthreads();
}
DI int find_pair(const LAS int* ptile, int tile) {
    int lo = 0, hi = NPAIR;
    while (hi - lo > 1) { const int mid = (lo + hi) >> 1; if (ptile[mid] <= tile) lo = mid; else hi = mid; }
    return lo;
}
struct SchedE1 {
    static constexpr bool GATHER = true, FIXED = false;
    const LAS int* ptile; const LAS int* cntv; unsigned xb; const unsigned* lists; unsigned w1; int G;
    DI bool next(int i, gs::GU& u) const { const int bid_ = lbid(); int un = i * G + bid_;
        if (G == 256) { const int x = bid_ & 7, idx = bid_ >> 3; un = (i * 128 + x * 16 + (idx >> 1)) * 2 + (idx & 1); }
        const int tile = un >> 1, pn = un & 1; if (tile >= ptile[NPAIR]) return false;
        const int p = find_pair(ptile, tile), c = p / 65, e = p % 65, t = tile - ptile[p];
        if (e < 64) { u.A = xb; u.idx = (const int*)(lists + ((size_t)c * 64 + e) * CHTOK + (size_t)t * 256); u.nvalid = cntv[p] - t * 256; }
        else { u.A = xb + ((unsigned)c * CHTOK + (unsigned)t * 256u) * 2048u; u.idx = nullptr; u.nvalid = 256; }
        u.B = w1 + (unsigned)e * 512u * 2048u + (unsigned)pn * 256u * 2048u; u.lda = 2048; u.ldb = 2048; u.nt = 16; u.flags = 3; u.a0 = tile; u.a1 = pn; u.a2 = 0; u.a3 = 0; return true; }
};
struct EpiE1 {
    static constexpr bool PERM = true; static constexpr bool BH8 = false; bf16* hb;
    DI void operator()(const Acc2& acc, const gs::GU& u, int wr, int wc, int fr, int fq) const {
        const int row0 = u.a0 * 256 + wr * 64 + fr, col0 = u.a1 * 128 + wc * 32 + 8 * fq;
#pragma unroll
        for (int ai = 0; ai < 2; ++ai)
#pragma unroll
            for (int m = 0; m < 4; ++m) { f32x4 h[2];
#pragma unroll
                for (int n = 0; n < 2; ++n)
#pragma unroll
                    for (int q = 0; q < 4; ++q) { const float g = acc[ai][0][m][n][q], up = acc[ai][1][m][n][q]; h[n][q] = g * sigmoidf_(g) * up; }
                *(u32x4*)(hb + (size_t)(row0 + ai * 128 + m * 16) * 256 + col0) = pack8(h[0], h[1]); }
    }
};
struct SchedE2 {
    static constexpr bool GATHER = false, FIXED = true;
    const LAS int* ptile; const LAS int* cntv; const LAS int* ypre; unsigned hb, w2; int c; int G;
    DI bool next(int i, gs::GU& u) const { const int bid_ = lbid(); int un = i * G + bid_;
        if (G == 256) { const int x = bid_ & 7, idx = bid_ >> 3; un = (i * 64 + x * 8 + (idx >> 2)) * 4 + (idx & 3); }
        const int tile = ptile[c * 65] + (un >> 2), pn = un & 3; if (tile >= ptile[(c + 1) * 65]) return false;
        const int p = find_pair(ptile, tile), e = p % 65, t = tile - ptile[p];
        u.A = hb + (unsigned)tile * 256u * 512u; u.B = w2 + (unsigned)e * 1024u * 512u + (unsigned)pn * 256u * 512u; u.idx = nullptr; u.lda = 512; u.ldb = 512; u.nt = 4; u.flags = 3;
        u.nvalid = 256; u.a0 = (tile - ptile[c * 65]) * 256; u.a1 = pn; u.a2 = 0; u.a3 = 0; return true; }
};
DI unsigned pk4_fp8(float a, float b, float c, float d) { int w = __builtin_amdgcn_cvt_pk_fp8_f32(a, b, 0, false); w = __builtin_amdgcn_cvt_pk_fp8_f32(c, d, w, true); return (unsigned)w; }
struct EpiE2 {
    static constexpr bool PERM = true; static constexpr bool BH8 = true; unsigned char* y;
    DI void operator()(const Acc2& acc, const gs::GU& u, int wr, int wc, int fr, int fq) const {
        const int row0 = u.a0 + wr * 64 + fr, col0 = u.a1 * 256 + wc * 64 + 16 * fq;
#pragma unroll
        for (int ai = 0; ai < 2; ++ai)
#pragma unroll
            for (int m = 0; m < 4; ++m) {
                u32x4 w;
                { const f32x4 v0 = acc[ai][0][m][0], v1 = acc[ai][0][m][1]; w.x = pk4_fp8(v0[0], v0[1], v0[2], v0[3]); w.y = pk4_fp8(v1[0], v1[1], v1[2], v1[3]); }
                { const f32x4 v0 = acc[ai][1][m][0], v1 = acc[ai][1][m][1]; w.z = pk4_fp8(v0[0], v0[1], v0[2], v0[3]); w.w = pk4_fp8(v1[0], v1[1], v1[2], v1[3]); }
                *(u32x4*)(y + (size_t)(row0 + ai * 128 + m * 16) * DM + col0) = w; }
    }
};

DI void ph_ln2(const Args& a, int l, int c, LAS unsigned char* lds, int gw, int NGW, int lane) {
    const LAS int* ptile = (const LAS int*)(lds + TBL_OFF);
    bf16* xb = (bf16*)(a.ws + WS_XB); const unsigned char* y = (const unsigned char*)(a.ws + WS_Y);
    const u32x2* tokinfo = (const u32x2*)(a.ws + WS_TOKINFO);
    const float* g = a.ln2_g + l * DM; const float* be = a.ln2_b + l * DM;
    u32x4 nx0 = {0u,0u,0u,0u}, nx1 = {0u,0u,0u,0u}; u32x2 nti = {0u, 0u};
    if (gw < CHTOK) { const int row0 = c * CHTOK + gw; const u32x4* xr0 = (const u32x4*)(xb + (size_t)row0 * DM) + lane; nx0 = xr0[0]; nx1 = xr0[64]; if (lane < 8) nti = tokinfo[(size_t)row0 * 8 + lane]; }
    for (int tt = gw; tt < CHTOK; tt += NGW) {
        const int row = c * CHTOK + tt;
        const u32x4 cx0 = nx0, cx1 = nx1; const u32x2 cti = nti;
        if (tt + NGW < CHTOK) { const int rown = row + NGW; const u32x4* xrn = (const u32x4*)(xb + (size_t)rown * DM) + lane; nx0 = xrn[0]; nx1 = xrn[64]; if (lane < 8) nti = tokinfo[(size_t)rown * 8 + lane]; }
        u32x4* xr = (u32x4*)(xb + (size_t)row * DM) + lane;
        f32x4 v[4];
        v[0] = (f32x4){bflo(cx0.x), bfhi(cx0.x), bflo(cx0.y), bfhi(cx0.y)} * ALPHA; v[1] = (f32x4){bflo(cx0.z), bfhi(cx0.z), bflo(cx0.w), bfhi(cx0.w)} * ALPHA;
        v[2] = (f32x4){bflo(cx1.x), bfhi(cx1.x), bflo(cx1.y), bfhi(cx1.y)} * ALPHA; v[3] = (f32x4){bflo(cx1.z), bfhi(cx1.z), bflo(cx1.w), bfhi(cx1.w)} * ALPHA;
        int yrv = 0; float wv = 1.f;
        if (lane < 8) { const u32x2 ti = cti; yrv = (ptile[c * 65 + (int)(ti.x >> 16)] - ptile[c * 65]) * 256 + (int)(ti.x & 0xffffu); wv = __uint_as_float(ti.y); }
        else if (lane == 8) yrv = (ptile[c * 65 + 64] - ptile[c * 65]) * 256 + tt;
        u32x2 q[9][2]; float wk[9];
#pragma unroll
        for (int k = 0; k < 9; ++k) { const int yrow = __builtin_amdgcn_readlane(yrv, k); wk[k] = __int_as_float(__builtin_amdgcn_readlane(__float_as_int(wv), k)) * (1.f / Y_SCALE);
            const u32x2* yr = (const u32x2*)(y + (size_t)yrow * DM) + lane; q[k][0] = yr[0]; q[k][1] = yr[64]; }
#pragma unroll
        for (int k = 0; k < 9; ++k) {
#pragma unroll
            for (int j = 0; j < 2; ++j) { const float ws_ = wk[k]; const u32x2 qq = q[k][j];
                v[2 * j][0] += ws_ * __builtin_amdgcn_cvt_f32_fp8((int)qq.x, 0); v[2 * j][1] += ws_ * __builtin_amdgcn_cvt_f32_fp8((int)qq.x, 1); v[2 * j][2] += ws_ * __builtin_amdgcn_cvt_f32_fp8((int)qq.x, 2); v[2 * j][3] += ws_ * __builtin_amdgcn_cvt_f32_fp8((int)qq.x, 3);
                v[2 * j + 1][0] += ws_ * __builtin_amdgcn_cvt_f32_fp8((int)qq.y, 0); v[2 * j + 1][1] += ws_ * __builtin_amdgcn_cvt_f32_fp8((int)qq.y, 1); v[2 * j + 1][2] += ws_ * __builtin_amdgcn_cvt_f32_fp8((int)qq.y, 2); v[2 * j + 1][3] += ws_ * __builtin_amdgcn_cvt_f32_fp8((int)qq.y, 3); }
        }
        float s = 0.f;
#pragma unroll
        for (int j = 0; j < 4; ++j) s += (v[j].x + v[j].y) + (v[j].z + v[j].w);
        const float mean = wave_sum(s) * (1.f / DM); float s2 = 0.f;
#pragma unroll
        for (int j = 0; j < 4; ++j) { v[j] = v[j] - mean; s2 += (v[j].x * v[j].x + v[j].y * v[j].y) + (v[j].z * v[j].z + v[j].w * v[j].w); }
        const float rstd = 1.f / sqrtf(wave_sum(s2) * (1.f / DM) + LN_EPS);
#pragma unroll
        for (int j = 0; j < 2; ++j) {
            const int cb = 8 * lane + 512 * j;
            const f32x4 g0 = *(const f32x4*)(g + cb), g1 = *(const f32x4*)(g + cb + 4), b0 = *(const f32x4*)(be + cb), b1 = *(const f32x4*)(be + cb + 4);
            const f32x4 y0 = v[2 * j] * rstd * g0 + b0, y1 = v[2 * j + 1] * rstd * g1 + b1;
            xr[64 * j] = pack8(y0, y1);
            if (l == DEPTH - 1) { float* o = a.out + (size_t)row * DM + cb; *(f32x4*)o = y0; *(f32x4*)(o + 4) = y1; }
        }
    }
}

DI int pi32(int r) { return (r & ~12) | ((r & 4) << 1) | ((r & 8) >> 1); }
DI int kofs(int i, int hh) { return 16 * (i >> 3) + 8 * hh + (i & 7); }
DI bf16x8 pack_p(const float (&p)[16], int s) {
    u32x4 w; w.x = cvtpk(p[8 * s], p[8 * s + 1]); w.y = cvtpk(p[8 * s + 2], p[8 * s + 3]); w.z = cvtpk(p[8 * s + 4], p[8 * s + 5]); w.w = cvtpk(p[8 * s + 6], p[8 * s + 7]);
    return __builtin_bit_cast(bf16x8, w);
}
DI f32x16 zero16() { f32x16 z;
#pragma unroll
    for (int i = 0; i < 16; ++i) z[i] = 0.f; return z; }
DI void store_ot(bf16* dst, const f32x16& o0, const f32x16& o1, float sc, int hh) {
#pragma unroll
    for (int g = 0; g < 4; ++g) {
        float v[4];
#pragma unroll
        for (int q = 0; q < 4; ++q) v[q] = o0[4 * g + q] * sc;
        st4bf(dst + 8 * g + 4 * hh, v);
#pragma unroll
        for (int q = 0; q < 4; ++q) v[q] = o1[4 * g + q] * sc;
        st4bf(dst + 32 + 8 * g + 4 * hh, v);
    }
}

DI void load_kv(bf16x8 (&kf)[4], bf16x8 (&vf)[2][2], const bf16* kp, const bf16* vp) {
#pragma unroll
    for (int s = 0; s < 4; ++s) kf[s] = *(const bf16x8*)(kp + 16 * s);
#pragma unroll
    for (int dt = 0; dt < 2; ++dt)
#pragma unroll
        for (int s = 0; s < 2; ++s) vf[dt][s] = *(const bf16x8*)(vp + (size_t)dt * 32 * SEQ + 16 * s);
}
DI void copy_kv(bf16x8 (&kf)[4], bf16x8 (&vf)[2][2], const bf16x8 (&nkf)[4], const bf16x8 (&nvf)[2][2]) {
#pragma unroll
    for (int s = 0; s < 4; ++s) kf[s] = nkf[s];
#pragma unroll
    for (int dt = 0; dt < 2; ++dt)
#pragma unroll
        for (int s = 0; s < 2; ++s) vf[dt][s] = nvf[dt][s];
}

DI void sb_unit(const Args& a, int b, int h, int qb, int lane) {
    const bf16* proj = (const bf16*)(a.ws + WS_A);
    const int c = lane & 31, hh = lane >> 5, pr = pi32(c);
    const size_t tokq = (size_t)b * SEQ + qb * 32 + c;
    const bf16* qp = proj + tokq * PW + C_BQ + h * 64 + 8 * hh;
    bf16x8 qf[4];
#pragma unroll
    for (int s = 0; s < 4; ++s) qf[s] = *(const bf16x8*)(qp + 16 * s);
    f32x16 o0 = zero16(), o1 = zero16(); float R = 1.f;
    const bool slot0lo = (__builtin_amdgcn_permlane32_swap((unsigned)hh, (unsigned)hh, false, false)[0] == 0u);
    const bf16* kbase = proj + (size_t)b * SEQ * PW + C_BK + h * 64 + 8 * hh;
    const bf16* vb0 = (const bf16*)(a.ws + WS_VTB) + ((size_t)(b * 4 + h) * 64 + c) * SEQ + 8 * hh;
    bf16x8 kf[4], vf[2][2];
    load_kv(kf, vf, kbase + (size_t)(qb * 32 + pr) * PW, vb0 + qb * 32);
    for (int kt = qb; kt >= 0; --kt) {
        bf16x8 nkf[4], nvf[2][2];
        { const int kn = (kt > 0) ? kt - 1 : 0; load_kv(nkf, nvf, kbase + (size_t)(kn * 32 + pr) * PW, vb0 + kn * 32); }
        f32x16 x = zero16();
#pragma unroll
        for (int s = 0; s < 4; ++s) x = mfma32(kf[s], qf[s], x);
        const bool diag = (kt == qb);
        float rr[16], ex[16], T[2];
#pragma unroll
        for (int i = 0; i < 16; ++i) { float rv = frcp(1.f + fexp2(x[i])); if (diag && kofs(i, hh) >= c) rv = 1.f; rr[i] = rv; }
#pragma unroll
        for (int s = 0; s < 2; ++s) { ex[8 * s + 7] = 1.f;
#pragma unroll
            for (int j = 6; j >= 0; --j) ex[8 * s + j] = ex[8 * s + j + 1] * rr[8 * s + j + 1];
            T[s] = ex[8 * s] * rr[8 * s]; }
        const auto r0_ = __builtin_amdgcn_permlane32_swap(__float_as_uint(T[0]), __float_as_uint(T[0]), false, false), r1_ = __builtin_amdgcn_permlane32_swap(__float_as_uint(T[1]), __float_as_uint(T[1]), false, false);
        const float PT0 = __uint_as_float((hh != 0) == slot0lo ? r0_[0] : r0_[1]), PT1 = __uint_as_float((hh != 0) == slot0lo ? r1_[0] : r1_[1]);
        float suf0, suf1;
        if (hh == 0) { suf1 = R * PT1; suf0 = suf1 * T[1] * PT0; } else { suf1 = R; suf0 = R * T[1] * PT1; }
        R = R * (T[0] * T[1]) * (PT0 * PT1);
        float p[16];
#pragma unroll
        for (int i = 0; i < 16; ++i) p[i] = (1.f - rr[i]) * ex[i] * (i < 8 ? suf0 : suf1);
        const bf16x8 pb0 = pack_p(p, 0), pb1 = pack_p(p, 1);
        o0 = mfma32(vf[0][0], pb0, o0); o0 = mfma32(vf[0][1], pb1, o0);
        o1 = mfma32(vf[1][0], pb0, o1); o1 = mfma32(vf[1][1], pb1, o1);
        copy_kv(kf, vf, nkf, nvf);
    }
    store_ot((bf16*)(a.ws + WS_B) + tokq * DM + 256 + h * 64, o0, o1, 1.f, hh);
}

DI void fg_unit(const Args& a, int b, int h, int qb, int lane) {
    const bf16* proj = (const bf16*)(a.ws + WS_A);
    const int c = lane & 31, hh = lane >> 5, pr = pi32(c);
    const size_t tokq = (size_t)b * SEQ + qb * 32 + c;
    const bf16* qp = proj + tokq * PW + C_CQ + h * 64 + 8 * hh;
    bf16x8 qf[4];
#pragma unroll
    for (int s = 0; s < 4; ++s) qf[s] = *(const bf16x8*)(qp + 16 * s);
    const float* cum = (const float*)(a.ws + WS_CUM) + (size_t)(b * 4 + h) * SEQ;
    const float cq = cum[qb * 32 + c];
    f32x16 o0 = zero16(), o1 = zero16(); float m = -1.0e30f, l = 0.f;
    const bf16* kbase = proj + (size_t)b * SEQ * PW + C_CK + h * 64 + 8 * hh;
    const bf16* vb0 = (const bf16*)(a.ws + WS_VTC) + ((size_t)(b * 4 + h) * 64 + c) * SEQ + 8 * hh;
    bf16x8 kf[4], vf[2][2];
    load_kv(kf, vf, kbase + (size_t)pr * PW, vb0);
    for (int kt = 0; kt <= qb; ++kt) {
        const int k0 = kt * 32;
        bf16x8 nkf[4], nvf[2][2];
        { const int kn = (kt < qb) ? kt + 1 : kt; load_kv(nkf, nvf, kbase + (size_t)(kn * 32 + pr) * PW, vb0 + kn * 32); }
        float ck[16];
#pragma unroll
        for (int s = 0; s < 2; ++s) { const f32x4 c0 = *(const f32x4*)(cum + k0 + 16 * s + 8 * hh), c1 = *(const f32x4*)(cum + k0 + 16 * s + 8 * hh + 4);
            ck[8 * s] = c0.x; ck[8 * s + 1] = c0.y; ck[8 * s + 2] = c0.z; ck[8 * s + 3] = c0.w; ck[8 * s + 4] = c1.x; ck[8 * s + 5] = c1.y; ck[8 * s + 6] = c1.z; ck[8 * s + 7] = c1.w; }
        f32x16 x = zero16();
#pragma unroll
        for (int s = 0; s < 4; ++s) x = mfma32(kf[s], qf[s], x);
        const bool diag = (kt == qb);
        float sv[16]; float tmax = -1.0e30f;
#pragma unroll
        for (int i = 0; i < 16; ++i) { const bool ok = !(diag && kofs(i, hh) > c); sv[i] = ok ? (x[i] + (cq - ck[i])) : -1.0e30f; tmax = fmaxf(tmax, sv[i]); }
        tmax = red32_max(tmax);
        const float mn = fmaxf(m, tmax), al = fexp2(m - mn);
        float p[16]; float ls = 0.f;
#pragma unroll
        for (int i = 0; i < 16; ++i) { p[i] = (sv[i] > -1.0e29f) ? fexp2(sv[i] - mn) : 0.f; ls += p[i]; }
        l = l * al + ls; m = mn;
#pragma unroll
        for (int i = 0; i < 16; ++i) { o0[i] *= al; o1[i] *= al; }
        const bf16x8 pb0 = pack_p(p, 0), pb1 = pack_p(p, 1);
        o0 = mfma32(vf[0][0], pb0, o0); o0 = mfma32(vf[0][1], pb1, o0);
        o1 = mfma32(vf[1][0], pb0, o1); o1 = mfma32(vf[1][1], pb1, o1);
        copy_kv(kf, vf, nkf, nvf);
    }
    const float lt = red32_sum(l);
    store_ot((bf16*)(a.ws + WS_B) + tokq * DM + 512 + h * 64, o0, o1, 1.f / lt, hh);
}


DI void atile_load(u32x4& reg, const bf16* kt0, const bf16* vt0, int kt, int tid) {
    reg = (tid < 256) ? *(const u32x4*)(kt0 + (size_t)kt * 2048 + tid * 8) : *(const u32x4*)(vt0 + (size_t)kt * 2048 + (tid - 256) * 8);
}
DI void atile_store(LAS unsigned char* buf, const u32x4& reg, int tid) { *(LAS u32x4*)(buf + tid * 16) = reg; }
DI void atile_frags(bf16x8 (&kf)[4], bf16x8 (&vf)[2][2], const LAS unsigned char* buf, int c, int hh, int prow) {
    (void)prow;
#pragma unroll
    for (int s = 0; s < 4; ++s) kf[s] = *(const LAS bf16x8*)(buf + ((2 * s + hh) * 32 + c) * 16);
#pragma unroll
    for (int dt = 0; dt < 2; ++dt)
#pragma unroll
        for (int s = 0; s < 2; ++s) vf[dt][s] = *(const LAS bf16x8*)(buf + 4096 + ((dt * 2 + s) * 64 + hh * 32 + c) * 16);
}
template <int MIXER>
DI void sbfg_block(const Args& a, int l, int b, int h, int QB, LAS unsigned char* lds, int tid, int wave, int lane) {
    const bf16* proj = (const bf16*)(a.ws + WS_A);
    const int c = lane & 31, hh = lane >> 5, pr = pi32(c);
    const int ntile = 8 * QB + 8, qb = 8 * QB + wave;
    const size_t tokq = (size_t)b * SEQ + qb * 32 + c;
    const bf16* qp = proj + tokq * PW + (MIXER == 0 ? C_BQ : C_CQ) + h * 64 + 8 * hh;
    bf16x8 qf[4];
#pragma unroll
    for (int s = 0; s < 4; ++s) qf[s] = *(const bf16x8*)(qp + 16 * s);
    const bf16* krow0 = (const bf16*)(a.ws + (MIXER == 0 ? WS_KTB : WS_KTC)) + (size_t)(b * 4 + h) * (SEQ / 32) * 2048;
    const bf16* vt0 = (const bf16*)(a.ws + (MIXER == 0 ? WS_VTB : WS_VTC)) + (size_t)(b * 4 + h) * (SEQ / 32) * 2048;
    const float* cum = (const float*)(a.ws + WS_CUM) + (size_t)(b * 4 + h) * SEQ;
    const float cq = (MIXER == 1) ? cum[qb * 32 + c] : 0.f;
    float Bq = 0.f;
    if (MIXER == 1) { float qs = 0.f;
#pragma unroll
        for (int s = 0; s < 4; ++s) { const u32x4 w = __builtin_bit_cast(u32x4, qf[s]);
            qs += bflo(w.x) * bflo(w.x) + bfhi(w.x) * bfhi(w.x) + bflo(w.y) * bflo(w.y) + bfhi(w.y) * bfhi(w.y) + bflo(w.z) * bflo(w.z) + bfhi(w.z) * bfhi(w.z) + bflo(w.w) * bflo(w.w) + bfhi(w.w) * bfhi(w.w); }
        qs = red32_sum(qs);
        const float k2 = __uint_as_float(((const unsigned*)(a.ws + WS_CTL))[CW_KMAX + l * 32 + b * 4 + h]);
        Bq = sqrtf(qs * k2) * 1.01f + 0.5f; }
    f32x16 o0 = zero16(), o1 = zero16(); float R = 1.f, m = -1.0e30f, l_ = 0.f;
    const bool slot0lo = (__builtin_amdgcn_permlane32_swap((unsigned)hh, (unsigned)hh, false, false)[0] == 0u);
    u32x4 reg;
    atile_load(reg, krow0, vt0, ntile - 1, tid); atile_store(lds, reg, tid);
    if (ntile > 1) { atile_load(reg, krow0, vt0, ntile - 2, tid); atile_store(lds + 8192, reg, tid); }
    __syncthreads();
    bf16x8 kfA[4], vfA[2][2], kfB[4], vfB[2][2];
    atile_frags(kfA, vfA, lds, c, hh, pr);
    int st = 0;
#define SBFG_STEP(JJ, KF, VF, NKF, NVF) { \
        const int kt = ntile - 1 - (JJ); \
        const int st1 = (st == 2) ? 0 : st + 1, st2 = (st1 == 2) ? 0 : st1 + 1; \
        if ((JJ) + 2 < ntile) atile_load(reg, krow0, vt0, kt - 2, tid); \
        if ((JJ) + 1 < ntile) atile_frags(NKF, NVF, lds + st1 * 8192, c, hh, pr); \
        if (kt <= qb) { \
            f32x16 x = zero16(); \
_Pragma("unroll") \
            for (int s = 0; s < 4; ++s) x = mfma32(KF[s], qf[s], x); \
            const bool diag = (kt == qb); \
            float p[16]; \
            if (MIXER == 0) { \
                float rr[16], ex[16], T[2]; \
_Pragma("unroll") \
                for (int i = 0; i < 16; ++i) rr[i] = frcp(1.f + fexp2(x[i])); \
                if (diag) { \
_Pragma("unroll") \
                    for (int i = 0; i < 16; ++i) if (kofs(i, hh) >= c) rr[i] = 1.f; \
                } \
_Pragma("unroll") \
                for (int s = 0; s < 2; ++s) { ex[8 * s + 7] = 1.f; \
_Pragma("unroll") \
                    for (int q = 6; q >= 0; --q) ex[8 * s + q] = ex[8 * s + q + 1] * rr[8 * s + q + 1]; \
                    T[s] = ex[8 * s] * rr[8 * s]; } \
                const auto r0_ = __builtin_amdgcn_permlane32_swap(__float_as_uint(T[0]), __float_as_uint(T[0]), false, false), r1_ = __builtin_amdgcn_permlane32_swap(__float_as_uint(T[1]), __float_as_uint(T[1]), false, false); \
                const float PT0 = __uint_as_float((hh != 0) == slot0lo ? r0_[0] : r0_[1]), PT1 = __uint_as_float((hh != 0) == slot0lo ? r1_[0] : r1_[1]); \
                float suf0, suf1; \
                if (hh == 0) { suf1 = R * PT1; suf0 = suf1 * T[1] * PT0; } else { suf1 = R; suf0 = R * T[1] * PT1; } \
                R = R * (T[0] * T[1]) * (PT0 * PT1); \
_Pragma("unroll") \
                for (int i = 0; i < 16; ++i) p[i] = (ex[i] - ex[i] * rr[i]) * (i < 8 ? suf0 : suf1); \
            } else { \
                const int k0 = kt * 32; \
                float ck[16]; \
_Pragma("unroll") \
                for (int s = 0; s < 2; ++s) { const f32x4 c0 = *(const f32x4*)(cum + k0 + 16 * s + 8 * hh), c1 = *(const f32x4*)(cum + k0 + 16 * s + 8 * hh + 4); \
                    ck[8 * s] = c0.x; ck[8 * s + 1] = c0.y; ck[8 * s + 2] = c0.z; ck[8 * s + 3] = c0.w; ck[8 * s + 4] = c1.x; ck[8 * s + 5] = c1.y; ck[8 * s + 6] = c1.z; ck[8 * s + 7] = c1.w; } \
                float sv[16]; float tmax = -1.0e30f; \
_Pragma("unroll") \
                for (int i = 0; i < 16; ++i) sv[i] = x[i] + (cq - ck[i]); \
                if (diag) { \
_Pragma("unroll") \
                    for (int i = 0; i < 16; ++i) if (kofs(i, hh) > c) sv[i] = -1.0e30f; \
                } \
_Pragma("unroll") \
                for (int i = 0; i < 16; ++i) tmax = fmaxf(tmax, sv[i]); \
                tmax = red32_max(tmax); \
                if (__any(tmax > m)) { \
                    const float mn = fmaxf(m, tmax), al = fexp2(m - mn); m = mn; l_ *= al; \
_Pragma("unroll") \
                    for (int i = 0; i < 16; ++i) { o0[i] *= al; o1[i] *= al; } \
                } \
                float ls = 0.f; \
_Pragma("unroll") \
                for (int i = 0; i < 16; ++i) { p[i] = fexp2(sv[i] - m); ls += p[i]; } \
                l_ += ls; \
            } \
            const bf16x8 pb0 = pack_p(p, 0), pb1 = pack_p(p, 1); \
            o0 = mfma32(VF[0][0], pb0, o0); o0 = mfma32(VF[0][1], pb1, o0); \
            o1 = mfma32(VF[1][0], pb0, o1); o1 = mfma32(VF[1][1], pb1, o1); \
        } \
        if ((JJ) + 2 < ntile) atile_store(lds + st2 * 8192, reg, tid); \
        __syncthreads(); \
        st = st1; \
    }
    LAS unsigned* dflag = (LAS unsigned*)(lds + 24576);
    for (int j = 0; j < ntile; j += 2) {
        SBFG_STEP(j, kfA, vfA, kfB, vfB)
        {
            const int ktj = ntile - 1 - j; const bool started = ktj <= qb;
            bool fin;
            if (MIXER == 0) fin = started && __all(R < 1.0e-12f);
            else { const float cn = (ktj >= 1) ? cum[32 * ktj - 1] : 0.f; fin = started && (ktj >= 1) && __all(Bq + (cq - cn) < m - 40.f); }
            if (lane == 0) dflag[((j >> 1) & 1) * 8 + wave] = fin ? 1u : 0u;
        }
        SBFG_STEP(j + 1, kfB, vfB, kfA, vfA)
        {
            const u32x4 f0 = *(const LAS u32x4*)(dflag + ((j >> 1) & 1) * 8), f1 = *(const LAS u32x4*)(dflag + ((j >> 1) & 1) * 8 + 4);
            if ((f0.x & f0.y & f0.z & f0.w & f1.x & f1.y & f1.z & f1.w) != 0u) break;
        }
    }
#undef SBFG_STEP
    if (MIXER == 0) store_ot((bf16*)(a.ws + WS_B) + tokq * DM + 256 + h * 64, o0, o1, 1.f, hh);
    else { const float lt = red32_sum(l_); store_ot((bf16*)(a.ws + WS_B) + tokq * DM + 512 + h * 64, o0, o1, 1.f / lt, hh); }
}

DI void osm_step(const f32x16& x, int lo, int hi, int hh, float& m, float& l, f32x16& o0, f32x16& o1, const bf16x8 (&vf)[2][2]) {
    float sv[16]; float tmax = -3.0e38f;
#pragma unroll
    for (int i = 0; i < 16; ++i) { const int ko = kofs(i, hh); sv[i] = (ko <= hi && ko >= lo) ? x[i] : -3.0e38f; tmax = fmaxf(tmax, sv[i]); }
    tmax = red32_max(tmax);
    if (__any(tmax > m)) { const float mn = fmaxf(m, tmax), al = fexp2(m - mn); m = mn; l *= al;
#pragma unroll
        for (int i = 0; i < 16; ++i) { o0[i] *= al; o1[i] *= al; } }
    float p[16]; float ls = 0.f;
#pragma unroll
    for (int i = 0; i < 16; ++i) { p[i] = fexp2(sv[i] - m); ls += p[i]; }
    l += ls;
    const bf16x8 pb0 = pack_p(p, 0), pb1 = pack_p(p, 1);
    o0 = mfma32(vf[0][0], pb0, o0); o0 = mfma32(vf[0][1], pb1, o0);
    o1 = mfma32(vf[1][0], pb0, o1); o1 = mfma32(vf[1][1], pb1, o1);
}

DI void ld_k4(bf16x8 (&kf)[4], const bf16* kp) {
#pragma unroll
    for (int s = 0; s < 4; ++s) kf[s] = *(const bf16x8*)(kp + 16 * s);
}
DI void ld_v4(bf16x8 (&vf)[2][2], const bf16* vp, int vpitch) {
#pragma unroll
    for (int dt = 0; dt < 2; ++dt)
#pragma unroll
        for (int s = 0; s < 2; ++s) vf[dt][s] = *(const bf16x8*)(vp + (size_t)dt * 32 * vpitch + 16 * s);
}
DI void ld_kt(bf16x8 (&kf)[4], const bf16* tile, int c, int hh) {
#pragma unroll
    for (int s = 0; s < 4; ++s) kf[s] = *(const bf16x8*)(tile + ((2 * s + hh) * 32 + c) * 8);
}
DI void ld_vt(bf16x8 (&vf)[2][2], const bf16* tile, int c, int hh) {
#pragma unroll
    for (int dt = 0; dt < 2; ++dt)
#pragma unroll
        for (int s = 0; s < 2; ++s) vf[dt][s] = *(const bf16x8*)(tile + ((dt * 2 + s) * 64 + hh * 32 + c) * 8);
}
DI unsigned wave_max_u(unsigned v) {
    v = max(v, (unsigned)DPPI((int)v, 0xB1, 0xF, true)); v = max(v, (unsigned)DPPI((int)v, 0x4E, 0xF, true));
    v = max(v, (unsigned)DPPI((int)v, 0x124, 0xF, true)); v = max(v, (unsigned)DPPI((int)v, 0x128, 0xF, true));
    { const auto r = __builtin_amdgcn_permlane16_swap(v, v, false, false); v = max(r[0], r[1]); const auto q = __builtin_amdgcn_permlane32_swap(v, v, false, false); v = max(q[0], q[1]); }
    return v;
}
DI void nsa_unit(const Args& a, int unit, LAS unsigned char* wl, int lane) {
    const bf16* proj = (const bf16*)(a.ws + WS_A);
    const int tok0 = unit * 8, b = tok0 / SEQ, t0 = tok0 % SEQ;
    const int c = lane & 31, hh = lane >> 5, ql = c >> 2, hd = c & 3, pr = pi32(c);
    const int tq = t0 + ql; const size_t tokq = (size_t)tok0 + ql;
    const bf16* qp = proj + tokq * PW + C_AQ + hd * 64 + 8 * hh;
    bf16x8 qf[4];
#pragma unroll
    for (int s = 0; s < 4; ++s) qf[s] = *(const bf16x8*)(qp + 16 * s);
    LAS float* imp = (LAS float*)wl; LAS unsigned* selm = (LAS unsigned*)(wl + 4096); LAS unsigned char* blist = (LAS unsigned char*)(wl + 4096 + 128);
    for (int i = lane; i < 1024; i += 64) imp[i] = 0.f;
    const float* gate = (const float*)(a.ws + WS_GATE) + tokq * 12 + hd * 3;
    const float g0 = gate[0], g1 = gate[1], g2 = gate[2];
    f32x16 of0 = zero16(), of1 = zero16();
    {
        const bf16* kc = (const bf16*)(a.ws + WS_KCMP) + (size_t)b * 16 * 2048;
        const bf16* vt = (const bf16*)(a.ws + WS_VTCMP) + (size_t)b * 16 * 2048;
        const int nmaxq = (tq >= 31) ? ((tq - 31) >> 4) : -1;
        const int nmaxu = (t0 + 7 >= 31) ? ((t0 + 7 - 31) >> 4) : -1;
        const int ntile = (nmaxu >> 5) + 1;
        float m = -1.0e30f, l = 0.f;
        bf16x8 kf[4], nkf[4];
        if (ntile > 0) ld_kt(kf, kc, c, hh);
        for (int kt = 0; kt < ntile; ++kt) {
            ld_kt(nkf, kc + (size_t)(kt + 1 < ntile ? kt + 1 : kt) * 2048, c, hh);
            f32x16 x = zero16();
#pragma unroll
            for (int s = 0; s < 4; ++s) x = mfma32(kf[s], qf[s], x);
            const int lim = nmaxq - kt * 32; float sv[16]; float tmax = -3.0e38f;
#pragma unroll
            for (int i = 0; i < 16; ++i) { sv[i] = (kofs(i, hh) <= lim) ? x[i] : -3.0e38f; tmax = fmaxf(tmax, sv[i]); }
            tmax = red32_max(tmax);
            const float mn = fmaxf(m, tmax); float ls = 0.f;
#pragma unroll
            for (int i = 0; i < 16; ++i) ls += fexp2(sv[i] - mn);
            l = l * fexp2(m - mn) + ls; m = mn;
#pragma unroll
            for (int s = 0; s < 4; ++s) kf[s] = nkf[s];
        }
        const float lt = red32_sum(l);
        const float inv = 1.f / fmaxf(lt, 1.0e-30f);
        f32x16 o0 = zero16(), o1 = zero16();
        LDS_WAIT();
        bf16x8 vf[2][2], nvf[2][2];
        if (ntile > 0) { ld_kt(kf, kc, c, hh); ld_vt(vf, vt, c, hh); }
        for (int kt = 0; kt < ntile; ++kt) {
            { const int kn = (kt + 1 < ntile ? kt + 1 : kt); ld_kt(nkf, kc + (size_t)kn * 2048, c, hh); ld_vt(nvf, vt + (size_t)kn * 2048, c, hh); }
            f32x16 x = zero16();
#pragma unroll
            for (int s = 0; s < 4; ++s) x = mfma32(kf[s], qf[s], x);
            float p[16], ps[16];
#pragma unroll
            for (int i = 0; i < 16; ++i) { p[i] = (kofs(i, hh) <= nmaxq - kt * 32) ? fexp2(x[i] - m) * inv : 0.f;
                float t = p[i]; t += dpp_xor1(t); t += dpp_xor2(t); ps[i] = t; }
            if (hd == 0) {
#pragma unroll
                for (int s = 0; s < 2; ++s) { const int gb = (kt * 32 + 16 * s + 8 * hh) >> 2; LAS float* ip = imp + ql * 128 + gb;
                    __hip_atomic_fetch_add(ip, (ps[8 * s] + ps[8 * s + 1]) + (ps[8 * s + 2] + ps[8 * s + 3]), __ATOMIC_RELAXED, __HIP_MEMORY_SCOPE_WORKGROUP);
                    __hip_atomic_fetch_add(ip + 1, ps[8 * s + 3] + (ps[8 * s + 4] + ps[8 * s + 5]) + (ps[8 * s + 6] + ps[8 * s + 7]), __ATOMIC_RELAXED, __HIP_MEMORY_SCOPE_WORKGROUP);
                    if (gb + 2 < 128) __hip_atomic_fetch_add(ip + 2, ps[8 * s + 7], __ATOMIC_RELAXED, __HIP_MEMORY_SCOPE_WORKGROUP); }
            }
            const bf16x8 pb0 = pack_p(p, 0), pb1 = pack_p(p, 1);
            o0 = mfma32(vf[0][0], pb0, o0); o0 = mfma32(vf[0][1], pb1, o0);
            o1 = mfma32(vf[1][0], pb0, o1); o1 = mfma32(vf[1][1], pb1, o1);
            copy_kv(kf, vf, nkf, nvf);
        }
#pragma unroll
        for (int i = 0; i < 16; ++i) { of0[i] = g0 * o0[i]; of1[i] = g0 * o1[i]; }
    }
    LDS_WAIT();
    for (int qi = 0; qi < 8; ++qi) {
        const int qblk = (t0 + qi) >> 6;
        const LAS float* iq = imp + qi * 128;
        const int b0 = lane, b1 = lane + 64;
        const bool ad0 = b0 <= qblk, ad1 = b1 <= qblk;
        const bool f0 = (b0 == 0) || (b0 == qblk) || (b0 == qblk - 1), f1 = (b1 == qblk) || (b1 == qblk - 1);
        unsigned v0 = ad0 ? __float_as_uint(f0 ? iq[b0] + 1.0e6f : iq[b0]) + 1u : 0u, v1 = ad1 ? __float_as_uint(f1 ? iq[b1] + 1.0e6f : iq[b1]) + 1u : 0u;
        unsigned long long m0 = 0ull, m1 = 0ull;
        const int nsel = (qblk + 1 < 16) ? qblk + 1 : 16;
        for (int r = 0; r < nsel; ++r) {
            const unsigned mx = wave_max_u(max(v0, v1));
            const unsigned long long e0 = __ballot(v0 == mx);
            if (e0) { const int idx = __builtin_ctzll(e0); m0 |= 1ull << idx; if (lane == idx) v0 = 0u; }
            else { const unsigned long long e1 = __ballot(v1 == mx); const int idx = __builtin_ctzll(e1); m1 |= 1ull << idx; if (lane == idx) v1 = 0u; }
        }
        if (lane == 0) { selm[qi * 4] = (unsigned)m0; selm[qi * 4 + 1] = (unsigned)(m0 >> 32); selm[qi * 4 + 2] = (unsigned)m1; selm[qi * 4 + 3] = (unsigned)(m1 >> 32); }
    }
    LDS_WAIT();
    {
        unsigned mk[4], um[4]; int nb = 0;
#pragma unroll
        for (int w = 0; w < 4; ++w) { mk[w] = selm[ql * 4 + w]; unsigned u = 0;
#pragma unroll
            for (int q = 0; q < 8; ++q) u |= selm[q * 4 + w];
            um[w] = (unsigned)__builtin_amdgcn_readfirstlane((int)u); }
#pragma unroll
        for (int w = 0; w < 4; ++w) { const unsigned u = um[w]; const int l32 = lane & 31;
            if (lane < 32 && ((u >> l32) & 1u)) blist[nb + __builtin_popcount(u & ((1u << l32) - 1u))] = (unsigned char)(32 * w + l32);
            nb += __builtin_popcount(u); }
        LDS_WAIT();
        const bf16* kbase = (const bf16*)(a.ws + WS_KTS) + (size_t)b * (SEQ / 32) * 2048;
        const bf16* vb0 = (const bf16*)(a.ws + WS_VTAS) + (size_t)b * (SEQ / 32) * 2048;
        f32x16 o0 = zero16(), o1 = zero16(); float m = -1.0e30f, l = 0.f;
        const int nt = 2 * nb;
        bf16x8 kf[4], vf[2][2], nkf[4], nvf[2][2];
        int blk = blist[0];
        { const int t0i = blk * 2; ld_kt(kf, kbase + (size_t)t0i * 2048, c, hh); ld_vt(vf, vb0 + (size_t)t0i * 2048, c, hh); }
#define NSA_SEL_STEP(TT, KF, VF, NKF, NVF) { \
            const int k0 = blk * 64 + 32 * ((TT) & 1); \
            const int tn = ((TT) + 1 < nt) ? (TT) + 1 : (TT); const int blkn = blist[tn >> 1]; \
            { const int tni = blkn * 2 + (tn & 1); ld_kt(NKF, kbase + (size_t)tni * 2048, c, hh); ld_vt(NVF, vb0 + (size_t)tni * 2048, c, hh); } \
            const bool mysel = ((((blk >> 5) == 0 ? mk[0] : (blk >> 5) == 1 ? mk[1] : (blk >> 5) == 2 ? mk[2] : mk[3]) >> (blk & 31)) & 1u) != 0u; \
            f32x16 x = zero16(); \
            _Pragma("unroll") for (int s = 0; s < 4; ++s) x = mfma32(KF[s], qf[s], x); \
            osm_step(x, 0, mysel ? tq - k0 : -1, hh, m, l, o0, o1, VF); \
            blk = blkn; }
        for (int t = 0; t < nt; t += 2) {
            NSA_SEL_STEP(t, kf, vf, nkf, nvf)
            NSA_SEL_STEP(t + 1, nkf, nvf, kf, vf)
        }
#undef NSA_SEL_STEP
        const float lt = red32_sum(l); const float sc = g1 / fmaxf(lt, 1.0e-30f);
#pragma unroll
        for (int i = 0; i < 16; ++i) { of0[i] += sc * o0[i]; of1[i] += sc * o1[i]; }
    }
    {
        const bf16* kbase = (const bf16*)(a.ws + WS_KTW) + (size_t)b * (SEQ / 32) * 2048;
        const bf16* vb0 = (const bf16*)(a.ws + WS_VTAW) + (size_t)b * (SEQ / 32) * 2048;
        f32x16 o0 = zero16(), o1 = zero16(); float m = -1.0e30f, l = 0.f;
        const int klo = (t0 >= 511) ? ((t0 - 511) >> 5) : 0, khi = (t0 + 7) >> 5;
        bf16x8 kf[4], vf[2][2], nkf[4], nvf[2][2];
        ld_kt(kf, kbase + (size_t)klo * 2048, c, hh); ld_vt(vf, vb0 + (size_t)klo * 2048, c, hh);
        for (int kt = klo; kt <= khi; ++kt) {
            const int k0 = kt * 32;
            { const int kn = (kt < khi ? kt + 1 : kt); ld_kt(nkf, kbase + (size_t)kn * 2048, c, hh); ld_vt(nvf, vb0 + (size_t)kn * 2048, c, hh); }
            f32x16 x = zero16();
#pragma unroll
            for (int s = 0; s < 4; ++s) x = mfma32(kf[s], qf[s], x);
            osm_step(x, tq - 511 - k0, tq - k0, hh, m, l, o0, o1, vf);
            copy_kv(kf, vf, nkf, nvf);
        }
        const float lt = red32_sum(l); const float sc = g2 / fmaxf(lt, 1.0e-30f);
#pragma unroll
        for (int i = 0; i < 16; ++i) { of0[i] += sc * o0[i]; of1[i] += sc * o1[i]; }
    }
    store_ot((bf16*)(a.ws + WS_B) + tokq * DM + hd * 64, of0, of1, 1.f, hh);
}

#ifndef DSA_REP_S
#define DSA_REP_S 1
#define DSA_REP_L 1
#define DSA_REP_A 1
#endif
#ifndef DSA_REP_1
#define DSA_REP_1 1
#define DSA_REP_2 1
#define DSA_REP_3 1
#endif
constexpr int DSA_CIDX = 132096, DSA_LIST = DSA_CIDX + 16384, DSA_DUMMY = DSA_LIST + 8192;  static_assert(DSA_DUMMY + 8 * 128 <= MISC_OFF, "DSA LDS map");
static_assert(DSA_LIST + 8192 <= MISC_OFF, "DSA LDS map");
typedef short v4i16_t __attribute__((ext_vector_type(4)));
DI unsigned f2key(float f) { const unsigned u = __float_as_uint(f); return u ^ ((u >> 31) ? 0xffffffffu : 0x80000000u); }
DI int wave_excl_scan(int v, int lane) { (void)lane; return wave_incl_scan(v) - v; }
DI int wave_sum_i(int v) {
    v += DPPI(v, 0xB1, 0xF, true); v += DPPI(v, 0x4E, 0xF, true); v += DPPI(v, 0x124, 0xF, true); v += DPPI(v, 0x128, 0xF, true);
    const auto r = __builtin_amdgcn_permlane16_swap((unsigned)v, (unsigned)v, false, false); v = (int)(r[0] + r[1]);
    const auto q = __builtin_amdgcn_permlane32_swap((unsigned)v, (unsigned)v, false, false); return (int)(q[0] + q[1]);
}
DI unsigned kth_reg16(const unsigned (&k)[16], int K) {
    unsigned hi = 0u, lo = 0xffffffffu;
#pragma unroll
    for (int j = 0; j < 16; ++j) { hi = (k[j] > hi) ? k[j] : hi; const unsigned kk = k[j] ? k[j] : 0xffffffffu; lo = (kk < lo) ? kk : lo; }
    hi = max(hi, (unsigned)DPPI((int)hi, 0xB1, 0xF, true)); hi = max(hi, (unsigned)DPPI((int)hi, 0x4E, 0xF, true));
    lo = min(lo, (unsigned)__builtin_amdgcn_update_dpp((int)0xffffffff, (int)lo, 0xB1, 0xF, 0xF, false)); lo = min(lo, (unsigned)__builtin_amdgcn_update_dpp((int)0xffffffff, (int)lo, 0x4E, 0xF, 0xF, false));
    hi = max(hi, (unsigned)DPPI((int)hi, 0x124, 0xF, true)); hi = max(hi, (unsigned)DPPI((int)hi, 0x128, 0xF, true));
    lo = min(lo, (unsigned)__builtin_amdgcn_update_dpp((int)0xffffffff, (int)lo, 0x124, 0xF, 0xF, false)); lo = min(lo, (unsigned)__builtin_amdgcn_update_dpp((int)0xffffffff, (int)lo, 0x128, 0xF, 0xF, false));
    { const auto r = __builtin_amdgcn_permlane16_swap(hi, hi, false, false); hi = max(r[0], r[1]); const auto q = __builtin_amdgcn_permlane32_swap(hi, hi, false, false); hi = max(q[0], q[1]); }
    { const auto r = __builtin_amdgcn_permlane16_swap(lo, lo, false, false); lo = min(r[0], r[1]); const auto q = __builtin_amdgcn_permlane32_swap(lo, lo, false, false); lo = min(q[0], q[1]); }
    const unsigned diff = (unsigned)__builtin_amdgcn_readfirstlane((int)(hi ^ lo));
    if (diff == 0u) return (unsigned)__builtin_amdgcn_readfirstlane((int)hi);
    const int top = 31 - __builtin_clz(diff);
    unsigned prefix = (unsigned)__builtin_amdgcn_readfirstlane((int)hi) & ~((2u << top) - 1u);
#pragma unroll 1
    for (int bit = top; bit >= 0; --bit) {
        const unsigned cand = prefix | (1u << bit); int c = 0;
#pragma unroll
        for (int j = 0; j < 16; ++j) c += __builtin_popcountll(__ballot(k[j] >= cand));
        if (c >= K) prefix = cand;
    }
    return prefix;
}
DI void dsa_attend(const Args& a, const bf16* proj, int b, size_t tokq, const LAS unsigned short* list, int cnt, LAS unsigned char* stg, int lane) {
        const int col = lane & 15, quad = lane >> 4, hd = col & 3;
        const bf16* qp = proj + tokq * PW + C_DQ + hd * 64 + 8 * quad;
        const bf16x8 qb0 = *(const bf16x8*)qp, qb1 = *(const bf16x8*)(qp + 32);
        const bf16* krow0 = proj + (size_t)b * SEQ * PW + C_DK; const bf16* vrow0 = proj + (size_t)b * SEQ * PW + C_DV;
        const int grow_ = lane >> 3, piece_ = lane & 7;
        f32x4 o[4];
#pragma unroll
        for (int dt = 0; dt < 4; ++dt) o[dt] = (f32x4){0.f, 0.f, 0.f, 0.f};
        float mrun = -1.0e30f, ls = 0.f;
#pragma unroll 1
        for (int ch = 0; ch < 2; ++ch) {
            if (ch * 128 >= cnt) break;
            int grow = grow_, piece = piece_; asm volatile("" : "+v"(grow), "+v"(piece));
            u32x4 wk[16], wv[16];
#pragma unroll
            for (int it = 0; it < 16; ++it) { const int j = ch * 128 + it * 8 + grow; const unsigned kidx = (j < cnt) ? (unsigned)list[j] : 0u;
                wk[it] = *(const u32x4*)(krow0 + (size_t)kidx * PW + 8 * piece); wv[it] = *(const u32x4*)(vrow0 + (size_t)kidx * PW + 8 * piece); }
#pragma unroll
            for (int it = 0; it < 16; ++it) { const int row = it * 8 + grow; *(LAS u32x4*)(stg + row * 128 + ((piece ^ (row & 7)) * 16)) = wk[it]; }
            LDS_WAIT();
            float sr[8][4];
            {
                int colq = col, quadq = quad; asm volatile("" : "+v"(colq), "+v"(quadq));
#pragma unroll
                for (int kt = 0; kt < 8; ++kt) {
                    const int row = kt * 16 + colq;
                    const bf16x8 a0 = *(const LAS bf16x8*)(stg + row * 128 + ((quadq ^ (row & 7)) * 16)), a1 = *(const LAS bf16x8*)(stg + row * 128 + (((quadq + 4) ^ (row & 7)) * 16));
                    f32x4 d = (f32x4){0.f, 0.f, 0.f, 0.f};
                    d = mfma16(a0, qb0, d); d = mfma16(a1, qb1, d);
#pragma unroll
                    for (int i = 0; i < 4; ++i) sr[kt][i] = (ch * 128 + kt * 16 + 4 * quadq + i < cnt) ? d[i] : -1.0e30f;
                }
            }
            float mx = -1.0e30f;
#pragma unroll
            for (int kt = 0; kt < 8; ++kt)
#pragma unroll
                for (int i = 0; i < 4; ++i) mx = fmaxf(mx, sr[kt][i]);
            mx = red16_max(mx); mx = red32_max(mx);
            const float mn = fmaxf(mrun, mx), al = fexp2(mrun - mn); mrun = mn;
            float lc = 0.f;
#pragma unroll
            for (int kt = 0; kt < 8; ++kt)
#pragma unroll
                for (int i = 0; i < 4; ++i) { const float p = (sr[kt][i] > -1.0e29f) ? fexp2(sr[kt][i] - mn) : 0.f; sr[kt][i] = p; lc += p; }
            lc = red16_sum(lc); lc = red32_sum(lc);
            ls = ls * al + lc;
#pragma unroll
            for (int dt = 0; dt < 4; ++dt) o[dt] = o[dt] * al;
            LDS_WAIT();
#pragma unroll
            for (int it = 0; it < 16; ++it) { const int row = it * 8 + grow; *(LAS u32x4*)(stg + row * 128 + ((piece ^ (row & 7)) * 16)) = wv[it]; }
            LDS_WAIT();
            {
                int colp = col, quadp = quad; asm volatile("" : "+v"(colp), "+v"(quadp));
#pragma unroll
                for (int g = 0; g < 4; ++g) {
                    u32x4 pw; pw.x = cvtpk(sr[2 * g][0], sr[2 * g][1]); pw.y = cvtpk(sr[2 * g][2], sr[2 * g][3]); pw.z = cvtpk(sr[2 * g + 1][0], sr[2 * g + 1][1]); pw.w = cvtpk(sr[2 * g + 1][2], sr[2 * g + 1][3]);
                    const bf16x8 pb = __builtin_bit_cast(bf16x8, pw);
                    const int klo = 32 * g + 4 * quadp + (colp >> 2), khi = klo + 16;
#pragma unroll
                    for (int dt = 0; dt < 4; ++dt) { const int pc = 2 * dt + ((colp & 3) >> 1), bo = (colp & 1) * 8;
                        const v4i16_t lo = __builtin_amdgcn_ds_read_tr16_b64_v4i16((LAS v4i16_t*)(stg + klo * 128 + ((pc ^ (klo & 7)) * 16) + bo));
                        const v4i16_t hi = __builtin_amdgcn_ds_read_tr16_b64_v4i16((LAS v4i16_t*)(stg + khi * 128 + ((pc ^ (khi & 7)) * 16) + bo));
                        const bf16x8 av = (bf16x8){lo[0], lo[1], lo[2], lo[3], hi[0], hi[1], hi[2], hi[3]};
                        o[dt] = mfma16(av, pb, o[dt]); }
                }
            }
            LDS_WAIT();
        }
        if (col < 4) { const float inv = 1.f / ls; bf16* om = (bf16*)(a.ws + WS_B) + tokq * DM + 768 + hd * 64 + 4 * quad;
#pragma unroll
            for (int dt = 0; dt < 4; ++dt) { float v[4] = {o[dt][0] * inv, o[dt][1] * inv, o[dt][2] * inv, o[dt][3] * inv}; st4bf(om + 16 * dt, v); } }
    }

DI void dsa_attend2(const Args& a, const bf16* proj, int b, size_t tokA, const LAS unsigned short* listA, int cntA, size_t tokB, const LAS unsigned short* listB, int cntB, LAS unsigned char* stg, int lane) {
    const int col = lane & 15, quad = lane >> 4, hd = col & 3;
    const bf16* krow0 = proj + (size_t)b * SEQ * PW + C_DK; const bf16* vrow0 = proj + (size_t)b * SEQ * PW + C_DV;
    const int grow_ = lane >> 3, piece_ = lane & 7;
    const int ncA = (cntA + 63) >> 6, nc = ncA + ((cntB + 63) >> 6);
    bf16x8 qb0, qb1; f32x4 o[4]; float mrun = -1.0e30f, ls = 0.f;
    u32x4 wk0[8], wv0[8], wk1[8], wv1[8];
#define DSA_GATHER(WK, WV, CI) { const bool isb_ = (CI) >= ncA; const int ch_ = isb_ ? (CI) - ncA : (CI); const int cnt_ = isb_ ? cntB : cntA; const LAS unsigned short* li_ = isb_ ? listB : listA; \
        int grow = grow_, piece = piece_; asm volatile("" : "+v"(grow), "+v"(piece)); \
        _Pragma("unroll") for (int it = 0; it < 8; ++it) { const int j = ch_ * 64 + it * 8 + grow; const unsigned kidx = (j < cnt_) ? (unsigned)li_[j] : 0u; \
            WK[it] = *(const u32x4*)(krow0 + (size_t)kidx * PW + 8 * piece); WV[it] = *(const u32x4*)(vrow0 + (size_t)kidx * PW + 8 * piece); } }
#define DSA_CHUNK(WK, WV, CI) { const bool isb_ = (CI) >= ncA; const int ch_ = isb_ ? (CI) - ncA : (CI); const int cnt_ = isb_ ? cntB : cntA; \
        if (ch_ == 0) { const bf16* qp = proj + (isb_ ? tokB : tokA) * PW + C_DQ + hd * 64 + 8 * quad; qb0 = *(const bf16x8*)qp; qb1 = *(const bf16x8*)(qp + 32); mrun = -1.0e30f; ls = 0.f; \
            _Pragma("unroll") for (int dt = 0; dt < 4; ++dt) o[dt] = (f32x4){0.f, 0.f, 0.f, 0.f}; } \
        int grow = grow_, piece = piece_; asm volatile("" : "+v"(grow), "+v"(piece)); \
        _Pragma("unroll") for (int it = 0; it < 8; ++it) { const int row = it * 8 + grow; *(LAS u32x4*)(stg + row * 128 + ((piece ^ (row & 7)) * 16)) = WK[it]; } \
        LDS_WAIT(); \
        float sr[4][4]; \
        { int colq = col, quadq = quad; asm volatile("" : "+v"(colq), "+v"(quadq)); \
          _Pragma("unroll") for (int kt = 0; kt < 4; ++kt) { const int row = kt * 16 + colq; \
            const bf16x8 a0 = *(const LAS bf16x8*)(stg + row * 128 + ((quadq ^ (row & 7)) * 16)), a1 = *(const LAS bf16x8*)(stg + row * 128 + (((quadq + 4) ^ (row & 7)) * 16)); \
            f32x4 d = (f32x4){0.f, 0.f, 0.f, 0.f}; d = mfma16(a0, qb0, d); d = mfma16(a1, qb1, d); \
            _Pragma("unroll") for (int i = 0; i < 4; ++i) sr[kt][i] = (ch_ * 64 + kt * 16 + 4 * quadq + i < cnt_) ? d[i] : -3.0e38f; } } \
        float mx = -3.0e38f; \
        _Pragma("unroll") for (int kt = 0; kt < 4; ++kt) _Pragma("unroll") for (int i = 0; i < 4; ++i) mx = fmaxf(mx, sr[kt][i]); \
        mx = red16_max(mx); mx = red32_max(mx); \
        const float mn = fmaxf(mrun, mx), al = fexp2(mrun - mn); mrun = mn; \
        float lc = 0.f; \
        _Pragma("unroll") for (int kt = 0; kt < 4; ++kt) _Pragma("unroll") for (int i = 0; i < 4; ++i) { const float p = fexp2(sr[kt][i] - mn); sr[kt][i] = p; lc += p; } \
        lc = red16_sum(lc); lc = red32_sum(lc); ls = ls * al + lc; \
        _Pragma("unroll") for (int dt = 0; dt < 4; ++dt) o[dt] = o[dt] * al; \
        LDS_WAIT(); \
        _Pragma("unroll") for (int it = 0; it < 8; ++it) { const int row = it * 8 + grow; *(LAS u32x4*)(stg + row * 128 + ((piece ^ (row & 7)) * 16)) = WV[it]; } \
        LDS_WAIT(); \
        { int colp = col, quadp = quad; asm volatile("" : "+v"(colp), "+v"(quadp)); \
          _Pragma("unroll") for (int g = 0; g < 2; ++g) { \
            u32x4 pw; pw.x = cvtpk(sr[2 * g][0], sr[2 * g][1]); pw.y = cvtpk(sr[2 * g][2], sr[2 * g][3]); pw.z = cvtpk(sr[2 * g + 1][0], sr[2 * g + 1][1]); pw.w = cvtpk(sr[2 * g + 1][2], sr[2 * g + 1][3]); \
            const bf16x8 pb = __builtin_bit_cast(bf16x8, pw); \
            const int klo = 32 * g + 4 * quadp + (colp >> 2), khi = klo + 16; \
            _Pragma("unroll") for (int dt = 0; dt < 4; ++dt) { const int pc = 2 * dt + ((colp & 3) >> 1), bo = (colp & 1) * 8; \
                const v4i16_t lo = __builtin_amdgcn_ds_read_tr16_b64_v4i16((LAS v4i16_t*)(stg + klo * 128 + ((pc ^ (klo & 7)) * 16) + bo)); \
                const v4i16_t hi = __builtin_amdgcn_ds_read_tr16_b64_v4i16((LAS v4i16_t*)(stg + khi * 128 + ((pc ^ (khi & 7)) * 16) + bo)); \
                const bf16x8 av = (bf16x8){lo[0], lo[1], lo[2], lo[3], hi[0], hi[1], hi[2], hi[3]}; \
                o[dt] = mfma16(av, pb, o[dt]); } } } \
        LDS_WAIT(); \
        const int nch_ = isb_ ? nc - ncA : ncA; \
        if (ch_ == nch_ - 1 && col < 4) { const float inv = 1.f / ls; bf16* om = (bf16*)(a.ws + WS_B) + (isb_ ? tokB : tokA) * DM + 768 + hd * 64 + 4 * quad; \
            _Pragma("unroll") for (int dt = 0; dt < 4; ++dt) { float v[4] = {o[dt][0] * inv, o[dt][1] * inv, o[dt][2] * inv, o[dt][3] * inv}; st4bf(om + 16 * dt, v); } } }
    if (nc > 0) DSA_GATHER(wk0, wv0, 0)
    for (int ci = 0; ci < nc; ci += 2) {
        if (ci + 1 < nc) DSA_GATHER(wk1, wv1, ci + 1)
        DSA_CHUNK(wk0, wv0, ci)
        if (ci + 1 < nc) {
            if (ci + 2 < nc) DSA_GATHER(wk0, wv0, ci + 2)
            DSA_CHUNK(wk1, wv1, ci + 1)
        }
    }
#undef DSA_GATHER
#undef DSA_CHUNK
}

typedef unsigned short u16x2_t __attribute__((ext_vector_type(2)));
DI unsigned pkmax16(unsigned x, unsigned y) { return __builtin_bit_cast(unsigned, __builtin_elementwise_max(__builtin_bit_cast(u16x2_t, x), __builtin_bit_cast(u16x2_t, y))); }
DI unsigned f2key16s(float f) { const unsigned h = (unsigned)__builtin_bit_cast(unsigned short, (_Float16)f); return h ^ ((unsigned)((int)__float_as_uint(f) >> 31) | 0x8000u); }
DI unsigned f2key16(float f) { const unsigned h = (unsigned)__builtin_bit_cast(unsigned short, (_Float16)f); return (h & 0x8000u) ? (~h & 0xffffu) : (h | 0x8000u); }
DI void dsa_unit16(const Args& a, int pu, LAS unsigned char* lds, int wave, int lane) {
    const bf16* proj = (const bf16*)(a.ws + WS_A);
    const int b = pu >> 9, p = pu & 511;
    const int tA0 = 8 * p, tB0 = 8184 - 8 * p, nA = tA0 + 8, nB = tB0 + 8;
    const int na32 = (nA + 31) & ~31, nb32 = (nB + 31) & ~31;
    LAS unsigned short* sc = (LAS unsigned short*)lds;
    {
        const int c = lane & 31, hh = lane >> 5, qr = c >> 2, hr = c & 3;
        const size_t tokA = (size_t)b * SEQ + tA0, tokB = (size_t)b * SEQ + tB0;
        bf16x8 iqA[4], iqB[4];
#pragma unroll
        for (int s = 0; s < 4; ++s) { iqA[s] = *(const bf16x8*)(proj + (tokA + qr) * PW + C_DIQ + hr * 64 + 16 * s + 8 * hh); iqB[s] = *(const bf16x8*)(proj + (tokB + qr) * PW + C_DIQ + hr * 64 + 16 * s + 8 * hh); }
        f32x4 iwA[4], iwB[4];
#pragma unroll
        for (int g = 0; g < 4; ++g) { iwA[g] = *(const f32x4*)((const float*)(a.ws + WS_IW) + (tokA + 2 * g + hh) * 4); iwB[g] = *(const f32x4*)((const float*)(a.ws + WS_IW) + (tokB + 2 * g + hh) * 4); }
        const bf16* kb = (const bf16*)(a.ws + WS_IKT) + (size_t)b * (SEQ / 32) * 2048;
        const int ntA = na32 >> 5, ntB = nb32 >> 5;
        LAS unsigned short* dA = sc + hh * na32 + c; LAS unsigned short* dB = sc + 8 * na32 + hh * nb32 + c;
#define DSA_EPI(X, IW, T0, DST, PITCH, K0, MASK) { _Pragma("unroll") for (int g = 0; g < 4; ++g) { \
            const float r0 = __builtin_amdgcn_fmed3f(X[4 * g], 0.f, 3.0e38f), r1 = __builtin_amdgcn_fmed3f(X[4 * g + 1], 0.f, 3.0e38f); \
            const float r2 = __builtin_amdgcn_fmed3f(X[4 * g + 2], 0.f, 3.0e38f), r3 = __builtin_amdgcn_fmed3f(X[4 * g + 3], 0.f, 3.0e38f); \
            float a0 = __builtin_fmaf(IW[g].x, r0, 0.f), a1 = __builtin_fmaf(IW[g].y, r1, 0.f); a0 = __builtin_fmaf(IW[g].z, r2, a0); a1 = __builtin_fmaf(IW[g].w, r3, a1); \
            unsigned key = f2key16s(a0 + a1); if (MASK) key = ((K0) + c <= (T0) + 2 * g + hh) ? key : 0u; \
            (DST)[2 * g * (PITCH) + (K0)] = (unsigned short)key; } }
        bf16x8 kf[4], nkf[4];
        if (wave < ntB) ld_kt(kf, kb + (size_t)wave * 2048, c, hh);
        for (int kt = wave; kt < ntB; kt += NWAVES) {
            { const int kn = (kt + NWAVES < ntB) ? kt + NWAVES : kt; ld_kt(nkf, kb + (size_t)kn * 2048, c, hh); }
            const int k0 = kt * 32; const bool hasA = kt < ntA;
            f32x16 x = zero16(), y = zero16();
#pragma unroll
            for (int s = 0; s < 4; ++s) x = mfma32(iqB[s], kf[s], x);
            if (hasA) {
#pragma unroll
                for (int s = 0; s < 4; ++s) y = mfma32(iqA[s], kf[s], y);
            }
            if (k0 + 31 > tB0) DSA_EPI(x, iwB, tB0, dB, nb32, k0, true) else DSA_EPI(x, iwB, tB0, dB, nb32, k0, false)
            if (hasA) { if (k0 + 31 > tA0) DSA_EPI(y, iwA, tA0, dA, na32, k0, true) else DSA_EPI(y, iwA, tA0, dA, na32, k0, false) }
#pragma unroll
            for (int s = 0; s < 4; ++s) kf[s] = nkf[s];
        }
#undef DSA_EPI
    }
    __syncthreads();
    LAS unsigned short* cidx = (LAS unsigned short*)(lds + DSA_CIDX + wave * 2048);
    LAS unsigned short* dummy = (LAS unsigned short*)(lds + DSA_DUMMY + wave * 128) + lane;
    const unsigned long long ltm = (1ull << lane) - 1ull;
    int cntA = 0, cntB = 0;
#pragma unroll 1
    for (int blk = 0; blk < 2; ++blk) {
        const int tq = (blk ? tB0 : tA0) + wave, n = tq + 1, n32 = (blk ? nb32 : na32);
        const LAS unsigned short* s16 = sc + (blk ? 8 * na32 + wave * nb32 : wave * na32);
        LAS unsigned short* list = (LAS unsigned short*)(lds + DSA_LIST + (blk * 8 + wave) * 512);
        int cnt;
        if (n <= 256) { for (int i = lane; i < n; i += 64) list[i] = (unsigned short)i; cnt = n; }
        else {
            int c = 0;
            if (n <= 1024) { for (int i = lane; i < n; i += 64) cidx[i] = (unsigned short)i; c = n; }
            else {
                const bool cs4 = n <= 2048; unsigned M[16];
#pragma unroll
                for (int it = 0; it < 16; ++it) {
                    const int i8 = (cs4 ? (it >> 1) : it) * 512 + lane * 8; unsigned mx = 0u;
                    if (i8 < n32) { const u32x4 v = *(const LAS u32x4*)(s16 + i8);
                        if (cs4) { const unsigned m2 = (it & 1) ? pkmax16(v.z, v.w) : pkmax16(v.x, v.y); mx = max(m2 & 0xffffu, m2 >> 16); }
                        else { const unsigned m4 = pkmax16(pkmax16(v.x, v.y), pkmax16(v.z, v.w)); mx = max(m4 & 0xffffu, m4 >> 16); } }
                    if (cs4 && it >= 8) mx = 0u;
                    M[it] = mx;
                }
                const unsigned beta = kth_reg16(M, 256);
                for (int i0 = 0; i0 < n32; i0 += 512) {
                    const int i8 = i0 + lane * 8;
                    u32x4 v = (u32x4){0u, 0u, 0u, 0u}; if (i8 < n32) v = *(const LAS u32x4*)(s16 + i8);
                    const unsigned kk[8] = {v.x & 0xffffu, v.x >> 16, v.y & 0xffffu, v.y >> 16, v.z & 0xffffu, v.z >> 16, v.w & 0xffffu, v.w >> 16};
                    int fc = 0;
#pragma unroll
                    for (int k = 0; k < 8; ++k) fc += (kk[k] >= beta) ? 1 : 0;
                    const int inc = wave_incl_scan(fc); int pos = c + inc - fc;
#pragma unroll
                    for (int k = 0; k < 8; ++k) { const bool cd = kk[k] >= beta;
                        LAS unsigned short* d = (cd && pos < 1024) ? (cidx + pos) : dummy; *d = (unsigned short)(i8 + k); pos += cd ? 1 : 0; }
                    c += __builtin_amdgcn_readlane(inc, 63);
                }
                LDS_WAIT();
            }
            unsigned tau; bool fromc = (c <= 1024);
            if (fromc) {
                unsigned ck[16], ixs[16];
#pragma unroll
                for (int j = 0; j < 16; ++j) ixs[j] = (unsigned)cidx[j * 64 + lane];
#pragma unroll
                for (int j = 0; j < 16; ++j) ixs[j] = (j * 64 + lane < c) ? ixs[j] : 0u;
#pragma unroll
                for (int j = 0; j < 16; ++j) ck[j] = (unsigned)s16[ixs[j]];
#pragma unroll
                for (int j = 0; j < 16; ++j) ck[j] = (j * 64 + lane < c) ? ck[j] : 0u;
                tau = kth_reg16(ck, 256);
                int cg = 0;
#pragma unroll
                for (int j = 0; j < 16; ++j) cg += (ck[j] > tau) ? 1 : 0;
                const int krem = 256 - wave_sum_i(cg);
                int total = 0, eqt = 0;
#pragma unroll
                for (int j = 0; j < 16; ++j) {
                    if (j * 64 < c) {
                        const bool gt = ck[j] > tau, eq = ck[j] == tau;
                        const unsigned long long eqm = __ballot(eq); const int eqp = __popcll(eqm & ltm);
                        const bool take = gt || (eq && (eqt + eqp < krem));
                        const unsigned long long tm = __ballot(take); const int pos = total + __popcll(tm & ltm);
                        if (take) list[pos] = (unsigned short)ixs[j];
                        total += __popcll(tm); eqt += __popcll(eqm);
                    }
                }
                cnt = total;
            } else {
                tau = 0u;
                for (int bit = 15; bit >= 0; --bit) {
                    const unsigned cand = tau | (1u << bit); int cc = 0;
                    for (int i = lane; i < n; i += 64) cc += ((unsigned)s16[i] >= cand) ? 1 : 0;
                    if (wave_sum_i(cc) >= 256) tau = cand;
                }
                int cg = 0;
                for (int i = lane; i < n; i += 64) cg += ((unsigned)s16[i] > tau) ? 1 : 0;
                const int krem = 256 - wave_sum_i(cg);
                int total = 0, eqt = 0;
                for (int i0 = 0; i0 < n; i0 += 64) {
                    const int i = i0 + lane; const unsigned key = (i < n) ? (unsigned)s16[i] : 0u;
                    const bool gt = key > tau, eq = (i < n) && key == tau;
                    const unsigned long long eqm = __ballot(eq); const int eqp = __popcll(eqm & ltm);
                    const bool take = gt || (eq && (eqt + eqp < krem));
                    const unsigned long long tm = __ballot(take); const int pos = total + __popcll(tm & ltm);
                    if (take) list[pos] = (unsigned short)i;
                    total += __popcll(tm); eqt += __popcll(eqm);
                }
                cnt = total;
            }
        }
        if (blk) cntB = cnt; else cntA = cnt;
    }
    __syncthreads();
    dsa_attend2(a, proj, b, (size_t)b * SEQ + tA0 + wave, (const LAS unsigned short*)(lds + DSA_LIST + wave * 512), cntA, (size_t)b * SEQ + tB0 + wave, (const LAS unsigned short*)(lds + DSA_LIST + (8 + wave) * 512), cntB, lds + wave * 16384, lane);
    __syncthreads();
}

#ifndef HOSTDUP
#define HOSTDUP 0
#endif
#ifndef MK_SINGLE
#define MK_SINGLE 1
#endif
constexpr int PRM_OFF = MISC_OFF + 256;
DI void store_args(LAS unsigned char* lds, const Args& k) {
    LAS unsigned long long* q = (LAS unsigned long long*)(lds + PRM_OFF);
    q[0] = (unsigned long long)k.x; q[1] = (unsigned long long)k.pos; q[2] = (unsigned long long)k.w_in; q[3] = (unsigned long long)k.b_f; q[4] = (unsigned long long)k.pe_cmp;
    q[5] = (unsigned long long)k.w_cmp1; q[6] = (unsigned long long)k.w_cmp2; q[7] = (unsigned long long)k.w_gate; q[8] = (unsigned long long)k.w_br; q[9] = (unsigned long long)k.w_o;
    q[10] = (unsigned long long)k.ln1_g; q[11] = (unsigned long long)k.ln1_b; q[12] = (unsigned long long)k.w_router; q[13] = (unsigned long long)k.router_bias;
    q[14] = (unsigned long long)k.w_eg; q[15] = (unsigned long long)k.w_eu; q[16] = (unsigned long long)k.w_ed; q[17] = (unsigned long long)k.w_sg; q[18] = (unsigned long long)k.w_su; q[19] = (unsigned long long)k.w_sd;
    q[20] = (unsigned long long)k.ln2_g; q[21] = (unsigned long long)k.ln2_b; q[22] = (unsigned long long)k.out; q[23] = (unsigned long long)k.ws;
}
DI unsigned long long ldprm(LAS unsigned char* lds, int i) {
    const u32x2 v = *(const LAS u32x2*)(lds + PRM_OFF + 8 * i);
    return ((unsigned long long)(unsigned)__builtin_amdgcn_readfirstlane((int)v.y) << 32) | (unsigned long long)(unsigned)__builtin_amdgcn_readfirstlane((int)v.x);
}
DI Args lds_args(LAS unsigned char* lds) {
    Args a;
    a.x = (const float*)(const GAS float*)ldprm(lds, 0); a.pos = (const int*)(const GAS int*)ldprm(lds, 1); a.w_in = (const float*)(const GAS float*)ldprm(lds, 2); a.b_f = (const float*)(const GAS float*)ldprm(lds, 3); a.pe_cmp = (const float*)(const GAS float*)ldprm(lds, 4);
    a.w_cmp1 = (const float*)(const GAS float*)ldprm(lds, 5); a.w_cmp2 = (const float*)(const GAS float*)ldprm(lds, 6); a.w_gate = (const float*)(const GAS float*)ldprm(lds, 7); a.w_br = (const float*)(const GAS float*)ldprm(lds, 8); a.w_o = (const float*)(const GAS float*)ldprm(lds, 9);
    a.ln1_g = (const float*)(const GAS float*)ldprm(lds, 10); a.ln1_b = (const float*)(const GAS float*)ldprm(lds, 11); a.w_router = (const float*)(const GAS float*)ldprm(lds, 12); a.router_bias = (const float*)(const GAS float*)ldprm(lds, 13);
    a.w_eg = (const float*)(const GAS float*)ldprm(lds, 14); a.w_eu = (const float*)(const GAS float*)ldprm(lds, 15); a.w_ed = (const float*)(const GAS float*)ldprm(lds, 16); a.w_sg = (const float*)(const GAS float*)ldprm(lds, 17); a.w_su = (const float*)(const GAS float*)ldprm(lds, 18); a.w_sd = (const float*)(const GAS float*)ldprm(lds, 19);
    a.ln2_g = (const float*)(const GAS float*)ldprm(lds, 20); a.ln2_b = (const float*)(const GAS float*)ldprm(lds, 21); a.out = (float*)(GAS float*)ldprm(lds, 22); a.ws = (unsigned char*)(GAS unsigned char*)ldprm(lds, 23); a.ph_lo = 0; a.ph_hi = 0;
    return a;
}
#ifndef PHMASK
#define PHMASK 0xffffffffu
#endif
#define PHON(j) (((PHMASK) >> (j)) & 1u)
#define PH_BEGIN const Args a = lds_args(lds); unsigned char* ws = a.ws; (void)ws; \
    const int tid = ltid(), lane = tid & 63, wave = __builtin_amdgcn_readfirstlane(tid >> 6); \
    const int G = lgrid(), bid = lbid(), gw = bid * NWAVES + wave, NGW = G * NWAVES; (void)bid; (void)lane; (void)wave; (void)gw; (void)NGW; (void)G;
#ifndef PH_NOINLINE
#define PHFN DI void
#else
#define PHFN __attribute__((noinline)) __device__ void
#endif

PHFN f_prologue(LAS unsigned char* lds) { PH_BEGIN ph_prologue(a, gw, NGW, lane); }
PHFN f_cvt(LAS unsigned char* lds, int l) { PH_BEGIN ph_cvt(a, l, lds, gw, NGW, wave, lane); }
PHFN f_proj(LAS unsigned char* lds) { PH_BEGIN
    SchedProj S; S.so.init(NTOK, PW, G, bid); S.A = (unsigned)WS_XB; S.B = (unsigned)W_IN;
    EpiProj E; E.proj = (bf16*)(ws + WS_A); E.sm32 = (float*)(ws + WS_SM32);
    gs::gemm_stream<SchedProj, EpiProj, 2>(lds, (const char*)ws, S, E); }
PHFN f_post(LAS unsigned char* lds, int l) { PH_BEGIN ph_post(a, l, lds, wave, lane); }
PHFN f_cmp(LAS unsigned char* lds) { PH_BEGIN
    SchedCmp S; S.kcr = (unsigned)WS_KCR; S.vcr = (unsigned)WS_VCR; S.w = (unsigned)W_C1;
    EpiCmp E; E.hid = (float*)(ws + WS_HID); E.cbias = (const float*)(ws + WS_CBIAS);
    gs::gemm_stream<SchedCmp, EpiCmp, 2>(lds, (const char*)ws, S, E);
    if (bid >= 32 && bid < 64 && wave == 0) cumsum_seq(a, bid - 32, lane);
    if (G < 64 && bid == 0 && wave == 1) for (int q = (G > 32 ? G - 32 : 0); q < 32; ++q) cumsum_seq(a, q, lane); }
PHFN f_cmp2(LAS unsigned char* lds, int l) { PH_BEGIN ph_cmp2(a, l, gw, NGW, lane); }
PHFN f_dsa(LAS unsigned char* lds) { PH_BEGIN for (int pu = bid; pu < NTOK / 16; pu += G) dsa_unit16(a, pu, lds, wave, lane); }
PHFN f_nsa(LAS unsigned char* lds) { PH_BEGIN
    for (int u = gw, r = 0; u < NTOK / 8; u += NGW, ++r) {
        int unit = u;
        if (NGW == 2048) { const int bsel = u >> 10, pos = ((u & 1023) + 256 * r) & 1023; unit = bsel * 1024 + pos; }
        nsa_unit(a, unit, lds + wave * 5120, lane);
    } }
PHFN f_sbfg(LAS unsigned char* lds, int l) { PH_BEGIN
    for (int u = bid; u < 2048; u += G) {
        const int r = u >> 8, blk = u & 255, bh = blk & 31, f = blk >> 5, mixer = r >> 2, rr = r & 3;
        const int QB = (rr == 0) ? f : (rr == 1) ? 31 - f : (rr == 2) ? 8 + f : 23 - f;
        if (mixer == 0) sbfg_block<0>(a, l, bh >> 2, bh & 3, QB, lds, tid, wave, lane); else sbfg_block<1>(a, l, bh >> 2, bh & 3, QB, lds, tid, wave, lane);
        __syncthreads();
    } }
PHFN f_merge(LAS unsigned char* lds) { PH_BEGIN
    SchedMerge S; S.xb = (unsigned)WS_XB; S.om = (unsigned)WS_B; S.wg = (unsigned)W_G; S.wbr = (unsigned)W_BR; S.G = G;
    EpiMerge E; E.merged = (bf16*)(ws + WS_C); E.stash = (u32x4*)(ws + WS_A + (size_t)bid * 65536);
    gs::gemm_stream<SchedMerge, EpiMerge, 1>(lds, (const char*)ws, S, E); }
PHFN f_wo(LAS unsigned char* lds, int l) { PH_BEGIN
    SchedWo S; S.so.init(NTOK, DM, G, bid); S.A = (unsigned)WS_C; S.B = (unsigned)W_O;
    EpiWo E; E.xb = (bf16*)(ws + WS_XB); (void)l;
    gs::gemm_stream<SchedWo, EpiWo, 2>(lds, (const char*)ws, S, E); }
PHFN f_ln1(LAS unsigned char* lds, int l) { PH_BEGIN ph_ln1(a, l, gw, NGW, lane); }
PHFN f_router(LAS unsigned char* lds) { PH_BEGIN
    SchedRouter S; S.xh = (unsigned)WS_XB; S.xl = (unsigned)WS_XL; S.wh = (unsigned)W_RH; S.wl = (unsigned)W_RL; S.G = G;
    EpiRouter E; E.logit = (float*)(ws + WS_LOGIT);
    gs::gemm_stream<SchedRouter, EpiRouter, 1>(lds, (const char*)ws, S, E); }
PHFN f_route(LAS unsigned char* lds, int l) { PH_BEGIN ph_route(a, l, lds, wave, lane); }
PHFN f_e1(LAS unsigned char* lds, int l) { PH_BEGIN
    moe_tables(a, l, lds);
    SchedE1 S; S.ptile = (const LAS int*)(lds + TBL_OFF); S.cntv = S.ptile + 2 * TBLN; S.xb = (unsigned)WS_XB; S.lists = (const unsigned*)(ws + WS_LIST); S.w1 = (unsigned)W_1; S.G = G;
    EpiE1 E; E.hb = (bf16*)(ws + WS_HB);
    gs::gemm_stream<SchedE1, EpiE1, 2>(lds, (const char*)ws, S, E); }
PHFN f_e2(LAS unsigned char* lds, int l, int c) { PH_BEGIN
    moe_tables(a, l, lds);
    SchedE2 S; S.ptile = (const LAS int*)(lds + TBL_OFF); S.ypre = S.ptile + TBLN; S.cntv = S.ptile + 2 * TBLN; S.hb = (unsigned)WS_HB; S.w2 = (unsigned)W_2; S.c = c; S.G = G;
    EpiE2 E; E.y = (unsigned char*)(ws + WS_Y);
    gs::gemm_stream<SchedE2, EpiE2, 2>(lds, (const char*)ws, S, E); }
PHFN f_ln2(LAS unsigned char* lds, int l, int c) { PH_BEGIN moe_tables(a, l, lds); ph_ln2(a, l, c, lds, gw, NGW, lane); }
PHFN f_seam(LAS unsigned char* lds) {
    XcdBarrier bar; bar.bar = (unsigned*)((unsigned char*)(GAS unsigned char*)ldprm(lds, 23) + WS_CTL) + CW_BAR; bar.x = xb_xcc_id(); bar.st = (volatile LAS unsigned*)(lds + MISC_OFF) + 8; xcd_barrier(bar); }

#define IN(k) (lo <= (k) && (k) < hi)
#define SEAM(k) do { if ((k) + 1 < hi) f_seam(lds); } while (0)
DI void run_layer(LAS unsigned char* lds, const int l, const int lo, const int hi) {
        const int pb = 1 + l * NPL;
        if (PHON(0) && IN(pb + 0)) { f_cvt(lds, l); SEAM(pb + 0); }
        if (PHON(1) && IN(pb + 1)) { f_proj(lds); SEAM(pb + 1); }
        if (PHON(2) && IN(pb + 2)) { f_post(lds, l); SEAM(pb + 2); }
        if (PHON(3) && IN(pb + 3)) { f_cmp(lds); __syncthreads(); f_dsa(lds); SEAM(pb + 3); }
        if (PHON(4) && IN(pb + 4)) { f_cmp2(lds, l); __syncthreads(); f_sbfg(lds, l); SEAM(pb + 4); }
        if (PHON(21) && IN(pb + 5)) { f_nsa(lds); SEAM(pb + 5); }
        if (PHON(6) && IN(pb + 6)) { f_merge(lds); SEAM(pb + 6); }
        if (PHON(7) && IN(pb + 7)) { f_wo(lds, l); SEAM(pb + 7); }
        if (PHON(8) && IN(pb + 8)) { f_ln1(lds, l); SEAM(pb + 8); }
        if (PHON(9) && IN(pb + 9)) { f_router(lds); SEAM(pb + 9); }
        if (PHON(10) && IN(pb + 10)) { f_route(lds, l); SEAM(pb + 10); }
        if (PHON(11) && IN(pb + 11)) { f_e1(lds, l); SEAM(pb + 11); }
        for (int c = 0; c < NCH; ++c) {
            if (PHON(12) && IN(pb + 12 + 2 * c)) { f_e2(lds, l, c); SEAM(pb + 12 + 2 * c); }
            if (PHON(13) && IN(pb + 13 + 2 * c)) { f_ln2(lds, l, c); SEAM(pb + 13 + 2 * c); }
        }
}
#undef IN
#undef SEAM
#ifndef DUPMASK
#define DUPMASK 0
#endif
#define DUP(j) (((DUPMASK) >> (j)) & 1)
__global__ void __launch_bounds__(NWAVES * 64, 2) fwd(Args ka) {
    extern __shared__ __attribute__((aligned(16))) unsigned char lds_[];
    LAS unsigned char* lds = (LAS unsigned char*)lds_;
    const int tid = threadIdx.x;
    volatile LAS unsigned* MISC = (volatile LAS unsigned*)(lds + MISC_OFF);
    if (tid < 64) MISC[tid] = 0u;
    if (tid == 64) store_args(lds, ka);
    const int lo = ka.ph_lo, hi = ka.ph_hi;
    __syncthreads();
    if (hi - lo > 1 && tid == 0) (void)xb_add(&((unsigned*)(ka.ws + WS_CTL) + CW_BAR)[XB_XCNT(xb_xcc_id())], 1u);
#define IN(k) (lo <= (k) && (k) < hi)
#define SEAM(k) do { if ((k) + 1 < hi) f_seam(lds); } while (0)
    if (PHON(31) && IN(0)) { f_prologue(lds); SEAM(0); }
    run_layer(lds, 0, lo, hi); run_layer(lds, 1, lo, hi); run_layer(lds, 2, lo, hi); run_layer(lds, 3, lo, hi);
#undef IN
#undef SEAM
}

extern "C" void kernel_launch(void* const* d_in, const int* in_sizes, int n_in, void* d_out, int out_size, void* d_ws, size_t ws_size, hipStream_t stream) {
    static int grid = 0;
    if (grid == 0) {
        if (n_in != 22 || in_sizes[0] != NTOK * DM || out_size != NTOK * DM || ws_size < WS_END) {
            fprintf(stderr, "kernel_launch: unexpected shapes/workspace: n_in %d in0 %d out %d ws %zu (need %zu)\n", n_in, n_in > 0 ? in_sizes[0] : -1, out_size, ws_size, (size_t)WS_END); grid = -1; return; }
        int dev = 0, cus = 0, per_cu = 0;
        if (hipGetDevice(&dev) != hipSuccess || hipDeviceGetAttribute(&cus, hipDeviceAttributeMultiprocessorCount, dev) != hipSuccess) { grid = -1; return; }
        if (hipFuncSetAttribute((const void*)fwd, hipFuncAttributeMaxDynamicSharedMemorySize, LDS_BYTES) != hipSuccess) { fprintf(stderr, "kernel_launch: hipFuncSetAttribute failed\n"); grid = -1; return; }
        if (hipOccupancyMaxActiveBlocksPerMultiprocessor(&per_cu, (const void*)fwd, NWAVES * 64, LDS_BYTES) != hipSuccess || per_cu < 1)
            fprintf(stderr, "kernel_launch: occupancy query reports %d blocks per CU\n", per_cu);
        (void)hipGetLastError();
        grid = cus;
    }
    if (grid < 0) return;
    (void)hipMemsetAsync((char*)d_ws + WS_CTL, 0, CTL_ZERO_BYTES, stream);
    Args a{};
    a.x = (const float*)d_in[0]; a.pos = (const int*)d_in[1]; a.w_in = (const float*)d_in[2]; a.b_f = (const float*)d_in[3]; a.pe_cmp = (const float*)d_in[4];
    a.w_cmp1 = (const float*)d_in[5]; a.w_cmp2 = (const float*)d_in[6]; a.w_gate = (const float*)d_in[7]; a.w_br = (const float*)d_in[8]; a.w_o = (const float*)d_in[9];
    a.ln1_g = (const float*)d_in[10]; a.ln1_b = (const float*)d_in[11]; a.w_router = (const float*)d_in[12]; a.router_bias = (const float*)d_in[13];
    a.w_eg = (const float*)d_in[14]; a.w_eu = (const float*)d_in[15]; a.w_ed = (const float*)d_in[16]; a.w_sg = (const float*)d_in[17]; a.w_su = (const float*)d_in[18]; a.w_sd = (const float*)d_in[19];
    a.ln2_g = (const float*)d_in[20]; a.ln2_b = (const float*)d_in[21];
    a.out = (float*)d_out; a.ws = (unsigned char*)d_ws;
#if MK_SINGLE
    a.ph_lo = 0; a.ph_hi = NPHASE;
    hipLaunchKernelGGL(fwd, dim3(grid), dim3(NWAVES * 64), LDS_BYTES, stream, a);
#else
    for (int p = 0; p < NPHASE; ++p) { a.ph_lo = p; a.ph_hi = p + 1; hipLaunchKernelGGL(fwd, dim3(grid), dim3(NWAVES * 64), LDS_BYTES, stream, a);
        if (p > 0 && ((HOSTDUP >> ((p - 1) % NPL)) & 1)) hipLaunchKernelGGL(fwd, dim3(grid), dim3(NWAVES * 64), LDS_BYTES, stream, a); }
#endif
}
```

```cpp
#include <hip/hip_runtime.h>
#include <cstdio>
#include <cstdint>

#define GAS __attribute__((address_space(1)))
#define LAS __attribute__((address_space(3)))
typedef unsigned short bf16;
typedef short bf16x8 __attribute__((ext_vector_type(8)));
typedef float f32x4 __attribute__((ext_vector_type(4)));
typedef float f32x2 __attribute__((ext_vector_type(2)));
typedef float f32x16 __attribute__((ext_vector_type(16)));
typedef unsigned u32x4 __attribute__((ext_vector_type(4)));
typedef unsigned u32x2 __attribute__((ext_vector_type(2)));
typedef __bf16 bf16x2_t __attribute__((ext_vector_type(2)));
typedef GAS unsigned gu32;

#define DI __device__ __forceinline__
#define LDS_WAIT() asm volatile("s_waitcnt lgkmcnt(0)" ::: "memory")
#define VM_WAIT() asm volatile("s_waitcnt vmcnt(0)" ::: "memory")
#define RLX_AGENT __ATOMIC_RELAXED, __HIP_MEMORY_SCOPE_AGENT

constexpr int NBATCH = 8, SEQ = 8192, NTOK = NBATCH * SEQ, DM = 1024, DEPTH = 4;
constexpr int PW = 3136;
constexpr int C_AQ = 0, C_BQ = 256, C_BK = 512, C_BV = 768, C_CQ = 1024, C_CK = 1280, C_CV = 1536, C_DQ = 1792, C_DIQ = 2048,
              C_AKC = 2304, C_AVC = 2368, C_AKS = 2432, C_AVS = 2496, C_AKW = 2560, C_AVW = 2624, C_DK = 2688, C_DV = 2752, C_DIK = 2816, C_SM = 2880;
constexpr int IN_W = 2900;
constexpr float QS = 0.18033688011112042f;
constexpr float LOG2E = 1.4426950408889634f;
constexpr float ALPHA = 1.681792830507429f;
constexpr float LN_EPS = 1e-5f;
constexpr int NEXP = 64, NCH = 2, CHTOK = NTOK / NCH;
constexpr int NPL = 12 + 2 * NCH;
constexpr int NPHASE = 1 + DEPTH * NPL;
constexpr int NWAVES = 8;

constexpr size_t MiB = 1u << 20;
constexpr size_t WS_CTL = 0, CTL_ZERO_BYTES = 1 * MiB;
constexpr size_t WS_ROPE = 1 * MiB;
constexpr size_t WS_SM32 = 5 * MiB;
constexpr size_t WS_GATE = 13 * MiB;
constexpr size_t WS_LOGF = 16 * MiB;
constexpr size_t WS_CUM  = 17 * MiB;
constexpr size_t WS_IW   = 18 * MiB;
constexpr size_t WS_HID  = 19 * MiB;
constexpr size_t WS_KCMP = 21 * MiB;
constexpr size_t WS_VTCMP = 21 * MiB + 512 * 1024;
constexpr size_t WS_CBIAS = 22 * MiB;
constexpr size_t WS_KCR  = 23 * MiB;
constexpr size_t WS_VCR  = 32 * MiB;
constexpr size_t WS_VT   = 41 * MiB;
constexpr size_t WS_VTB = WS_VT, WS_VTC = WS_VT + 32 * MiB, WS_VTAS = WS_VT + 64 * MiB, WS_VTAW = WS_VT + 72 * MiB;
constexpr size_t WS_LOGIT = WS_VT;
constexpr size_t WS_TOKINFO = WS_VT + 16 * MiB;
constexpr size_t WS_LIST = WS_VT + 20 * MiB;
constexpr size_t WS_W    = 121 * MiB;
constexpr size_t W_IN = WS_W, W_G = WS_W + 6 * MiB, W_BR = WS_W + 14 * MiB, W_O = WS_W + 16 * MiB, W_C1 = WS_W + 18 * MiB,
                 W_RH = WS_W + 20 * MiB, W_RL = WS_W + 20 * MiB + 512 * 1024, W_1 = WS_W + 21 * MiB, W_2 = WS_W + 86 * MiB;
constexpr size_t WS_XB   = 243 * MiB;
constexpr size_t WS_A    = 371 * MiB;
constexpr size_t WS_B    = 763 * MiB;
constexpr size_t WS_C    = 891 * MiB;
constexpr size_t WS_END  = 1019 * MiB;
constexpr size_t WS_KTS = WS_C, WS_KTW = WS_C + 8 * MiB, WS_IKT = WS_C + 16 * MiB, WS_KTB = WS_C + 32 * MiB, WS_KTC = WS_C + 64 * MiB;
constexpr size_t WS_XL = WS_A, WS_HB = WS_A, WS_Y = WS_A + 320 * MiB;
static_assert(WS_Y + (size_t)(CHTOK * 8 / 256 + 64 + CHTOK / 256) * 256 * DM <= WS_END, "tile-padded fp8 y chunk fits");
constexpr int HB_TILES = NTOK * 8 / 256 + NCH * 64 + NTOK / 256;
static_assert((size_t)HB_TILES * 256 * 512 <= 320 * MiB, "hbuf fits");

constexpr int CW_BAR = 4096;
constexpr int CW_CNT = 16384;
constexpr int CW_KMAX = 32768;

constexpr int RING_BYTES = 131072;
constexpr int MISC_OFF = 162816;
constexpr int LDS_BYTES = 163840;

DI unsigned cvtpk(float lo, float hi) { f32x2 v = {lo, hi}; bf16x2_t b = __builtin_convertvector(v, bf16x2_t); return __builtin_bit_cast(unsigned, b); }
DI u32x4 pack8(const f32x4& v0, const f32x4& v1) { u32x4 w; w.x = cvtpk(v0[0], v0[1]); w.y = cvtpk(v0[2], v0[3]); w.z = cvtpk(v1[0], v1[1]); w.w = cvtpk(v1[2], v1[3]); return w; }
DI float bf2f(unsigned short h) { return __uint_as_float(((unsigned)h) << 16); }
DI float bflo(unsigned w) { return __uint_as_float(w << 16); }
DI float bfhi(unsigned w) { return __uint_as_float(w & 0xffff0000u); }
DI float fexp2(float x) { return __builtin_amdgcn_exp2f(x); }
DI float flog2(float x) { return __builtin_amdgcn_logf(x); }
DI float frcp(float x) { return __builtin_amdgcn_rcpf(x); }
DI float sigmoidf_(float x) { return frcp(1.f + fexp2(-x * LOG2E)); }
#define DPPF(v, ctrl, rm, bc) __int_as_float(__builtin_amdgcn_update_dpp(0, __float_as_int(v), (ctrl), (rm), 0xF, (bc)))
#define DPPI(v, ctrl, rm, bc) __builtin_amdgcn_update_dpp(0, (v), (ctrl), (rm), 0xF, (bc))
DI float dpp_xor1(float v) { return DPPF(v, 0xB1, 0xF, true); }
DI float dpp_xor2(float v) { return DPPF(v, 0x4E, 0xF, true); }
DI float red16_sum(float v) { const auto r = __builtin_amdgcn_permlane16_swap(__float_as_uint(v), __float_as_uint(v), false, false); return __uint_as_float(r[0]) + __uint_as_float(r[1]); }
DI float red16_max(float v) { const auto r = __builtin_amdgcn_permlane16_swap(__float_as_uint(v), __float_as_uint(v), false, false); return fmaxf(__uint_as_float(r[0]), __uint_as_float(r[1])); }
DI float red32_sum(float v) { const auto r = __builtin_amdgcn_permlane32_swap(__float_as_uint(v), __float_as_uint(v), false, false); return __uint_as_float(r[0]) + __uint_as_float(r[1]); }
DI float red32_max(float v) { const auto r = __builtin_amdgcn_permlane32_swap(__float_as_uint(v), __float_as_uint(v), false, false); return fmaxf(__uint_as_float(r[0]), __uint_as_float(r[1])); }
DI float wave_sum(float v) {
    v += dpp_xor1(v); v += dpp_xor2(v); v += DPPF(v, 0x124, 0xF, true); v += DPPF(v, 0x128, 0xF, true);
    v = red16_sum(v); return red32_sum(v);
}
DI float wave_max(float v) {
    v = fmaxf(v, dpp_xor1(v)); v = fmaxf(v, dpp_xor2(v)); v = fmaxf(v, DPPF(v, 0x124, 0xF, true)); v = fmaxf(v, DPPF(v, 0x128, 0xF, true));
    v = red16_max(v); return red32_max(v);
}
DI int wave_incl_scan(int v) {
    v += DPPI(v, 0x111, 0xF, true); v += DPPI(v, 0x112, 0xF, true); v += DPPI(v, 0x114, 0xF, true); v += DPPI(v, 0x118, 0xF, true);
    v += DPPI(v, 0x142, 0xA, false);
    v += DPPI(v, 0x143, 0xC, false);
    return v;
}
DI float wave_incl_scan_f(float v) {
    v += DPPF(v, 0x111, 0xF, true); v += DPPF(v, 0x112, 0xF, true); v += DPPF(v, 0x114, 0xF, true); v += DPPF(v, 0x118, 0xF, true);
    v += DPPF(v, 0x142, 0xA, false); v += DPPF(v, 0x143, 0xC, false);
    return v;
}
DI int ltid() { int t = threadIdx.x; asm volatile("" : "+v"(t)); return t; }
DI int lbid() { int b = blockIdx.x; asm volatile("" : "+s"(b)); return b; }
DI int lgrid() { int g = gridDim.x; asm volatile("" : "+s"(g)); return g; }
DI f32x16 mfma32(bf16x8 a, bf16x8 b, f32x16 c) { return __builtin_amdgcn_mfma_f32_32x32x16_bf16(a, b, c, 0, 0, 0); }
DI f32x4 mfma16(bf16x8 a, bf16x8 b, f32x4 c) { return __builtin_amdgcn_mfma_f32_16x16x32_bf16(a, b, c, 0, 0, 0); }

#define XB_TMO      128
#define XB_XCNT(j)  (256  + 64 * (j))
#define XB_XSUB(j)  (1280 + 64 * (j))
#define XB_XGEN(j)  (2304 + 64 * (j))
#define XB_TOP      3328
#define XB_TOPGEN   3392
#define XCD_BAR_WORDS 3456
#define XB_SPIN_CAP (1u << 22)
DI unsigned xb_ld(unsigned* p)              { return __hip_atomic_load(p, __ATOMIC_RELAXED, __HIP_MEMORY_SCOPE_AGENT); }
DI unsigned xb_add(unsigned* p, unsigned v) { return __hip_atomic_fetch_add(p, v, __ATOMIC_RELAXED, __HIP_MEMORY_SCOPE_AGENT); }
DI unsigned xb_xcc_id() { return (unsigned)__builtin_amdgcn_s_getreg((3 << 11) | 20) & 0xFu; }
#define XB_SPIN(cond, bar) do { unsigned _sp = 0; while (cond) { __builtin_amdgcn_s_sleep(1); \
    if ((++_sp & 255u) == 0u) { if (xb_ld(&(bar)[XB_TMO])) break; if (_sp > XB_SPIN_CAP) { atomicAdd(&(bar)[XB_TMO], 1u); break; } } } } while (0)
struct XcdBarrier { unsigned* bar; unsigned x; volatile LAS unsigned* st; };
DI XcdBarrier xcd_barrier_post(unsigned* bar, volatile LAS unsigned* st) {
    XcdBarrier b; b.bar = bar; b.x = xb_xcc_id(); b.st = st;
    if (threadIdx.x == 0) (void)xb_add(&bar[XB_XCNT(b.x)], 1u);
    return b;
}
DI void xcd_barrier_complete(unsigned* bar, unsigned x, unsigned& nloc, unsigned& nx) {
    const unsigned G = gridDim.x * gridDim.y * gridDim.z;
    unsigned sum, cnt, mine, sp = 0u;
    for (;;) {
        sum = 0u; cnt = 0u; mine = 0u;
#pragma unroll
        for (unsigned j = 0; j < 16; ++j) { const unsigned c = xb_ld(&bar[XB_XCNT(j)]); sum += c; cnt += (c > 0u) ? 1u : 0u; mine = (j == x) ? c : mine; }
        if (sum == G) break;
        __builtin_amdgcn_s_sleep(1);
        if ((++sp & 255u) == 0u) { if (xb_ld(&bar[XB_TMO])) break; if (sp > XB_SPIN_CAP) { atomicAdd(&bar[XB_TMO], 1u); break; } }
    }
    nloc = mine > 0u ? mine : 1u; nx = cnt > 0u ? cnt : 1u;
}
DI void xcd_barrier(const XcdBarrier& b) {
    asm volatile("s_waitcnt vmcnt(0)" ::: "memory");
    __syncthreads();
    if (threadIdx.x == 0) {
        unsigned* bar = b.bar;
        __builtin_amdgcn_s_waitcnt(0);
        unsigned nloc = b.st[0], nx = b.st[1];
        if (nloc == 0u) { xcd_barrier_complete(bar, b.x, nloc, nx); b.st[0] = nloc; b.st[1] = nx; }
        const unsigned old = xb_add(&bar[XB_XSUB(b.x)], 1u);
        const unsigned gen = old / nloc;
        if (old + 1u == (gen + 1u) * nloc) {
            __builtin_amdgcn_fence(__ATOMIC_RELEASE, "agent");
            asm volatile("s_waitcnt vmcnt(0)" ::: "memory");
            const unsigned og = xb_add(&bar[XB_TOP], 1u);
            const unsigned tg = og / nx;
            if (og + 1u == (tg + 1u) * nx) xb_add(&bar[XB_TOPGEN], 1u);
            else XB_SPIN(xb_ld(&bar[XB_TOPGEN]) == tg, bar);
            __builtin_amdgcn_fence(__ATOMIC_ACQUIRE, "agent");
            xb_add(&bar[XB_XGEN(b.x)], 1u);
            asm volatile("s_waitcnt vmcnt(0)" ::: "memory");
        } else {
            XB_SPIN(xb_ld(&bar[XB_XGEN(b.x)]) == gen, bar);
            __builtin_amdgcn_fence(__ATOMIC_ACQUIRE, "agent");
            asm volatile("s_waitcnt vmcnt(0)" ::: "memory");
        }
    }
    __syncthreads();
}

namespace gs {
constexpr int BM = 256, BK = 64, HALF = 128, HTB = HALF * BK * 2, NXCD = 8, WGM = 8;
__host__ __device__ __forceinline__ int lds_byte(int r, int c) { const int st = (r >> 4) * 2 + (c >> 5), rr = r & 15, cc = c & 31, ob = rr * 64 + cc * 2; return st * 1024 + (ob ^ (((ob >> 9) & 1) << 5)); }
__host__ __device__ __forceinline__ void stage_rc(int b, int& R, int& C) { const int st = b / 1024, sb = b % 1024, swz = sb ^ (((sb >> 9) & 1) << 5); R = (st >> 1) * 16 + swz / 64; C = (st & 1) * 32 + (swz % 64) / 2; }
__host__ __device__ __forceinline__ int perm32(int rho) { const int n = rho >> 4, i = rho & 15; return 8 * (i >> 2) + 4 * n + (i & 3); }
__host__ __device__ __forceinline__ int bh8row(int R) { return (R >> 5) * 64 + 16 * ((R & 15) >> 2) + 4 * ((R >> 4) & 1) + (R & 3); }

struct GU {
    unsigned A, B; const int* idx;
    unsigned lda, ldb;
    int nt;
    int flags;
    int nvalid;
    int a0, a1, a2, a3;
};
struct Unit { int pm, pn; };
struct StaticOrder {
    int nM, nN, nwg, G, c;
    DI void init(int M, int N, int G_, int c_) { nM = M / BM; nN = N / BM; nwg = nM * nN; G = G_; c = c_; }
    DI bool next(int i, Unit& u) const {
        const long L = (long)i * G + c; if (L >= nwg) return false;
        int wgid = (int)L; { const int q = nwg / NXCD, r = nwg % NXCD, xcd = wgid % NXCD, off = wgid / NXCD; wgid = (xcd < r ? xcd * (q + 1) : r * (q + 1) + (xcd - r) * q) + off; }
        const int nig = WGM * nN, gid = wgid / nig, fm = gid * WGM, gsz = (nM - fm) < WGM ? (nM - fm) : WGM;
        u.pm = fm + ((wgid % nig) % gsz); u.pn = (wgid % nig) / gsz; return true;
    }
};

template <class Sched, class Epi, int NBH>
DI void gemm_stream(LAS unsigned char* lds, const char* wsb, Sched& S, Epi& E) {
    constexpr bool GATH = Sched::GATHER, FIXED = Sched::FIXED;
    const int tid = ltid(), wid = __builtin_amdgcn_readfirstlane(tid >> 6), lane = tid & 63, wr = wid >> 2, wc = wid & 3, fr = lane & 15, fq = lane >> 4;
    int R0, C0, R1, C1; stage_rc(tid * 16, R0, C0); stage_rc(tid * 16 + 8192, R1, C1);
    const unsigned Rb0 = Epi::BH8 ? (unsigned)bh8row(R0) : Epi::PERM ? ((R0 & ~31) + perm32(R0 & 31)) : R0, Rb1 = Epi::BH8 ? (unsigned)bh8row(R1) : Epi::PERM ? ((R1 & ~31) + perm32(R1 & 31)) : R1;
    constexpr unsigned BHS = Epi::BH8 ? 8u : (unsigned)HALF;
    const unsigned C0b = (unsigned)C0 * 2u, C1b = (unsigned)C1 * 2u;
    const unsigned ldsw = (unsigned)wid * 1024u;
    const int aoff = lds_byte(wr * 64 + fr, fq * 8), boff = lds_byte(wc * 32 + fr, fq * 8);
#define GS_SA(b, h) (((b) * 2 + (h)) * HTB)
#define GS_SB(b, h) ((4 + (b) * 2 + (h)) * HTB)
#define GS_STG_O(bufoff, gbase, o0, o1) do { \
        unsigned _q0 = (gbase) + (o0), _q1 = (gbase) + (o1); asm volatile("" : "+v"(_q0), "+v"(_q1)); \
        __builtin_amdgcn_global_load_lds((const unsigned*)(wsb + (size_t)_q0), (LAS unsigned*)(lds + (bufoff) + ldsw), 16, 0, 0); \
        __builtin_amdgcn_global_load_lds((const unsigned*)(wsb + (size_t)_q1), (LAS unsigned*)(lds + (bufoff) + ldsw + 8192), 16, 0, 0); } while (0)
#define GS_STGA(bufoff, gbase, h, r0, r1, ld) do { if constexpr (FIXED) GS_STG_O(bufoff, (gbase) + (unsigned)(h) * HALF * (ld), fa0, fa1); \
        else GS_STG_O(bufoff, gbase, (unsigned)(r0) * (ld) + C0b, (unsigned)(r1) * (ld) + C1b); } while (0)
#define GS_STGB(bufoff, gbase, h, ld) do { if constexpr (FIXED) GS_STG_O(bufoff, (gbase) + (unsigned)(h) * BHS * (ld), fb0, fb1); \
        else GS_STG_O(bufoff, (gbase) + (unsigned)(h) * BHS * (ld), Rb0 * (ld) + C0b, Rb1 * (ld) + C1b); } while (0)
#define GS_LDA(dst, b, h) do { _Pragma("unroll") for (int m = 0; m < 4; ++m) _Pragma("unroll") for (int k = 0; k < 2; ++k) dst[m][k] = *(const LAS bf16x8*)(lds + GS_SA(b, h) + aoff + m * 2048 + k * 1024); } while (0)
#define GS_LDB(dst, b, h) do { _Pragma("unroll") for (int n = 0; n < 2; ++n) _Pragma("unroll") for (int k = 0; k < 2; ++k) dst[n][k] = *(const LAS bf16x8*)(lds + GS_SB(b, h) + boff + n * 2048 + k * 1024); } while (0)
#define GS_MMA(ai, bj, At, Bt) do { __builtin_amdgcn_s_setprio(1); _Pragma("unroll") for (int m = 0; m < 4; ++m) _Pragma("unroll") for (int n = 0; n < 2; ++n) _Pragma("unroll") for (int k = 0; k < 2; ++k) \
        acc[ai][bj][m][n] = __builtin_amdgcn_mfma_f32_16x16x32_bf16(Bt[n][k], At[m][k], acc[ai][bj][m][n], 0, 0, 0); __builtin_amdgcn_s_setprio(0); } while (0)
#define GS_WAIT_V(n) asm volatile("s_waitcnt vmcnt(" #n ")" ::: "memory")
#define GS_WAIT_L(n) asm volatile("s_waitcnt lgkmcnt(" #n ")" ::: "memory")
#define GS_BAR __builtin_amdgcn_s_barrier()
#define GS_SCHED __builtin_amdgcn_sched_barrier(0)
#define GS_ROWS(u, ia) do { if (GATH) { if ((u).idx) { \
            ia[0] = R0 < (u).nvalid ? (unsigned)(u).idx[R0] : 0u; ia[1] = R1 < (u).nvalid ? (unsigned)(u).idx[R1] : 0u; \
            ia[2] = HALF + R0 < (u).nvalid ? (unsigned)(u).idx[HALF + R0] : 0u; ia[3] = HALF + R1 < (u).nvalid ? (unsigned)(u).idx[HALF + R1] : 0u; } \
        else { ia[0] = R0; ia[1] = R1; ia[2] = HALF + R0; ia[3] = HALF + R1; } } } while (0)
    GU cur, nxt; int ui = 0;
    if (!S.next(0, cur)) return;
    f32x4 acc[2][NBH][4][2];
#pragma unroll
    for (int a = 0; a < 2; ++a)
#pragma unroll
        for (int b = 0; b < NBH; ++b)
#pragma unroll
            for (int m = 0; m < 4; ++m)
#pragma unroll
                for (int n = 0; n < 2; ++n) acc[a][b][m][n] = (f32x4){0.f, 0.f, 0.f, 0.f};
    bf16x8 At[4][2], B0[2][2], B1[2][2];
    unsigned ia[4] = {(unsigned)R0, (unsigned)R1, (unsigned)(HALF + R0), (unsigned)(HALF + R1)}, na[4] = {(unsigned)R0, (unsigned)R1, (unsigned)(HALF + R0), (unsigned)(HALF + R1)};
    GS_ROWS(cur, ia);
    unsigned cA = cur.A, cB = cur.B;
    unsigned lda = cur.lda, ldb = cur.ldb;
    const unsigned fa0 = (unsigned)R0 * lda + C0b, fa1 = (unsigned)R1 * lda + C1b, fb0 = Rb0 * ldb + C0b, fb1 = Rb1 * ldb + C1b;
    if constexpr (NBH == 2) {
        GS_STGB(GS_SB(0, 0), cB, 0, ldb); GS_STGB(GS_SB(0, 1), cB, 1, ldb); GS_STGA(GS_SA(0, 0), cA, 0, ia[0], ia[1], lda); GS_STGA(GS_SA(0, 1), cA, 1, ia[2], ia[3], lda);
        if (wr == 1) GS_BAR;
        GS_WAIT_V(2); GS_BAR;
        GS_STGB(GS_SB(1, 0), cB + 128, 0, ldb); GS_STGA(GS_SA(1, 0), cA + 128, 0, ia[0], ia[1], lda); GS_STGB(GS_SB(1, 1), cB + 128, 1, ldb);
        GS_WAIT_V(6); GS_BAR;
    } else {
        GS_STGB(GS_SB(0, 0), cB, 0, ldb); GS_STGA(GS_SA(0, 0), cA, 0, ia[0], ia[1], lda); GS_STGA(GS_SA(0, 1), cA, 1, ia[2], ia[3], lda);
        if (wr == 1) GS_BAR;
        GS_WAIT_V(2); GS_BAR;
        GS_STGB(GS_SB(1, 0), cB + 128, 0, ldb); GS_STGA(GS_SA(1, 0), cA + 128, 0, ia[0], ia[1], lda);
        GS_WAIT_V(4); GS_BAR;
    }
    for (;;) {
        const bool has_next = S.next(ui + 1, nxt);
        unsigned nA = cA, nB = cB, nlda = lda, nldb = ldb;
        if (has_next) { GS_ROWS(nxt, na); nA = nxt.A; nB = nxt.B; nlda = nxt.lda; nldb = nxt.ldb; }
        else if (GATH) { na[0] = ia[0]; na[1] = ia[1]; na[2] = ia[2]; na[3] = ia[3]; }
        const int nt = cur.nt;
        for (int t = 0; t < nt; t += 2) {
            const bool last = (t == nt - 2);
            const unsigned a1 = cA + (unsigned)(t + 1) * 128u;
            const unsigned a2 = last ? nA : cA + (unsigned)(t + 2) * 128u, b2 = last ? nB : cB + (unsigned)(t + 2) * 128u;
            const unsigned a3 = a2 + 128u, b3 = b2 + 128u;
            const unsigned xlda = last ? nlda : lda, xldb = last ? nldb : ldb;
            unsigned x0, x1, x2, x3;
            if (GATH) { x0 = last ? na[0] : ia[0]; x1 = last ? na[1] : ia[1]; x2 = last ? na[2] : ia[2]; x3 = last ? na[3] : ia[3]; }
            else { x0 = R0; x1 = R1; x2 = HALF + R0; x3 = HALF + R1; }
            if constexpr (NBH == 2) {
                GS_LDB(B0, 0, 0); GS_LDB(B1, 0, 1); GS_SCHED; GS_LDA(At, 0, 0); GS_STGA(GS_SA(1, 1), a1, 1, ia[2], ia[3], lda);
                GS_WAIT_V(8); GS_WAIT_L(0); GS_BAR; GS_MMA(0, 0, At, B0); GS_MMA(0, 1, At, B1); GS_BAR; GS_SCHED;
                GS_LDA(At, 0, 1); GS_STGB(GS_SB(0, 0), b2, 0, xldb); GS_STGB(GS_SB(0, 1), b2, 1, xldb); GS_STGA(GS_SA(0, 0), a2, 0, x0, x1, xlda);
                GS_WAIT_V(8); GS_WAIT_L(0); GS_BAR; GS_MMA(1, 0, At, B0); GS_MMA(1, 1, At, B1); GS_BAR; GS_SCHED;
                GS_LDB(B0, 1, 0); GS_LDB(B1, 1, 1); GS_SCHED; GS_LDA(At, 1, 0); GS_STGA(GS_SA(0, 1), a2, 1, x2, x3, xlda);
                GS_WAIT_V(8); GS_WAIT_L(0); GS_BAR; GS_MMA(0, 0, At, B0); GS_MMA(0, 1, At, B1); GS_BAR; GS_SCHED;
                GS_LDA(At, 1, 1); GS_STGB(GS_SB(1, 0), b3, 0, xldb); GS_STGB(GS_SB(1, 1), b3, 1, xldb); GS_STGA(GS_SA(1, 0), a3, 0, x0, x1, xlda);
                GS_WAIT_V(8); GS_WAIT_L(0); GS_BAR; GS_MMA(1, 0, At, B0); GS_MMA(1, 1, At, B1); GS_BAR; GS_SCHED;
            } else {
                GS_LDB(B0, 0, 0); GS_SCHED; GS_LDA(At, 0, 0); GS_STGA(GS_SA(1, 1), a1, 1, ia[2], ia[3], lda);
                GS_WAIT_V(6); GS_WAIT_L(0); GS_BAR; GS_MMA(0, 0, At, B0); GS_BAR; GS_SCHED;
                GS_LDA(At, 0, 1); GS_STGB(GS_SB(0, 0), b2, 0, xldb); GS_STGA(GS_SA(0, 0), a2, 0, x0, x1, xlda);
                GS_WAIT_V(6); GS_WAIT_L(0); GS_BAR; GS_MMA(1, 0, At, B0); GS_BAR; GS_SCHED;
                GS_LDB(B0, 1, 0); GS_SCHED; GS_LDA(At, 1, 0); GS_STGA(GS_SA(0, 1), a2, 1, x2, x3, xlda);
                GS_WAIT_V(6); GS_WAIT_L(0); GS_BAR; GS_MMA(0, 0, At, B0); GS_BAR; GS_SCHED;
                GS_LDA(At, 1, 1); GS_STGB(GS_SB(1, 0), b3, 0, xldb); GS_STGA(GS_SA(1, 0), a3, 0, x0, x1, xlda);
                GS_WAIT_V(6); GS_WAIT_L(0); GS_BAR; GS_MMA(1, 0, At, B0); GS_BAR; GS_SCHED;
            }
        }
        if (cur.flags & 2) {
            if (wr == 0) GS_BAR;
            E(acc, cur, wr, wc, fr, fq);
        }
        if (!has_next) break;
        if (nxt.flags & 1) {
#pragma unroll
            for (int a = 0; a < 2; ++a)
#pragma unroll
                for (int b = 0; b < NBH; ++b)
#pragma unroll
                    for (int m = 0; m < 4; ++m)
#pragma unroll
                        for (int n = 0; n < 2; ++n) acc[a][b][m][n] = (f32x4){0.f, 0.f, 0.f, 0.f};
        }
        const bool did_epi = (cur.flags & 2) != 0;
        cur = nxt; cA = nA; cB = nB; lda = nlda; ldb = nldb; ++ui;
        if (GATH) { ia[0] = na[0]; ia[1] = na[1]; ia[2] = na[2]; ia[3] = na[3]; }
        if (did_epi) { if (wr == 1) GS_BAR; }
    }
    GS_WAIT_V(0);
    if (!(cur.flags & 2)) { if (wr == 0) GS_BAR; }
    GS_BAR;
#undef GS_SA
#undef GS_SB
#undef GS_STG_O
#undef GS_STGA
#undef GS_STGB
#undef GS_LDA
#undef GS_LDB
#undef GS_MMA
#undef GS_WAIT_V
#undef GS_WAIT_L
#undef GS_BAR
#undef GS_SCHED
#undef GS_ROWS
}
}

struct Args {
    const float* x; const int* pos; const float* w_in; const float* b_f; const float* pe_cmp; const float* w_cmp1; const float* w_cmp2;
    const float* w_gate; const float* w_br; const float* w_o; const float* ln1_g; const float* ln1_b; const float* w_router; const float* router_bias;
    const float* w_eg; const float* w_eu; const float* w_ed; const float* w_sg; const float* w_su; const float* w_sd; const float* ln2_g; const float* ln2_b;
    float* out; unsigned char* ws; int ph_lo, ph_hi;
};

DI void ph_prologue(const Args& a, int gw, int NGW, int lane) {
    bf16* xb = (bf16*)(a.ws + WS_XB);
    for (int row = gw; row < NTOK; row += NGW) {
        const f32x4* xr = (const f32x4*)(a.x + (size_t)row * DM) + lane;
        u32x2* o = (u32x2*)(xb + (size_t)row * DM) + lane;
#pragma unroll
        for (int j = 0; j < 4; ++j) { const f32x4 v = xr[64 * j]; u32x2 w; w.x = cvtpk(v.x, v.y); w.y = cvtpk(v.z, v.w); o[64 * j] = w; }
    }
    float* rope = (float*)(a.ws + WS_ROPE);
    constexpr float INVF[8] = {1.0f, 0.1939227432012558f, 0.03760603070259094f, 0.007292664609849453f, 0.0014142135623842478f, 0.00027424818836152554f, 5.318296098266728e-05f, 1.0313386155758053e-05f};
    for (int i = gw * 64 + lane; i < NTOK; i += NGW * 64) {
        const float p = (float)a.pos[i];
#pragma unroll
        for (int j = 0; j < 8; ++j) {
            const float ang = p * INVF[j];
            const double rev = (double)ang * 0.15915494309189535;
            const float fr = (float)(rev - __builtin_rint(rev));
            rope[(size_t)i * 16 + j] = __builtin_amdgcn_cosf(fr);
            rope[(size_t)i * 16 + 8 + j] = __builtin_amdgcn_sinf(fr);
        }
    }
}

constexpr float Y_SCALE = 16.f;
struct CvtItem { const float* W; bf16* WT; int N, n0, nv, k0, dK, drow0, mode; float scale; };
__device__ const int SEG_SRC[21] = {0, 652, 908, 1164, 1420, 1676, 1932, 2192, 2576, 256, 320, 384, 448, 512, 576, 2448, 2512, 2832, 640, 2188, 2896};
__device__ const int SEG_DST[21] = {C_AQ, C_BQ, C_BK, C_BV, C_CQ, C_CK, C_CV, C_DQ, C_DIQ, C_AKC, C_AVC, C_AKS, C_AVS, C_AKW, C_AVW, C_DK, C_DV, C_DIK, 2880, 2892, 2896};
constexpr int CVT_I_IN = 93 * 16, CVT_I_G = 2048, CVT_I_BR = 512, CVT_I_O = 512, CVT_I_C1 = 128, CVT_I_R = 64, CVT_I_E = 65 * 384, CVT_I_CB = 2;
constexpr int CVT_NIT = CVT_I_IN + CVT_I_G + CVT_I_BR + CVT_I_O + CVT_I_C1 + CVT_I_R + CVT_I_E + CVT_I_CB;
DI CvtItem cvt_decode(const Args& a, int l, int it) {
    unsigned char* ws = a.ws; CvtItem c; c.mode = 0; c.nv = 32; c.scale = 1.f;
    int r = it;
    if (r < CVT_I_IN) {
        const int kb = r / 93, ci = r % 93; int seg, off;
        if (ci < 72) { seg = ci >> 3; off = (ci & 7) * 32; } else if (ci < 90) { seg = 9 + ((ci - 72) >> 1); off = ((ci - 72) & 1) * 32; }
        else { seg = 18 + (ci - 90); off = 0; c.nv = (seg == 18) ? 12 : 4; }
        if (seg == 0 || seg == 1 || seg == 4 || seg == 7) c.scale = QS;
        c.W = a.w_in + (size_t)l * DM * IN_W; c.N = IN_W; c.n0 = SEG_SRC[seg] + off; c.k0 = kb * 64; c.WT = (bf16*)(ws + W_IN); c.dK = DM; c.drow0 = SEG_DST[seg] + off; return c; }
    r -= CVT_I_IN;
    if (r < CVT_I_G) { const int m = r >> 9, q = r & 511, kb = q >> 5, nb = q & 31;
        c.W = a.w_gate + (size_t)(l * 4 + m) * DM * DM; c.N = DM; c.n0 = nb * 32; c.k0 = kb * 64; c.WT = (bf16*)(ws + W_G) + (size_t)m * DM * DM; c.dK = DM; c.drow0 = nb * 32; c.scale = -LOG2E; return c; }
    r -= CVT_I_G;
    if (r < CVT_I_BR) { const int m = r >> 7, q = r & 127, kb = q >> 5, nb = q & 31;
        c.W = a.w_br + (size_t)(l * 4 + m) * 256 * DM; c.N = DM; c.n0 = nb * 32; c.k0 = kb * 64; c.WT = (bf16*)(ws + W_BR) + (size_t)m * DM * 256; c.dK = 256; c.drow0 = nb * 32; return c; }
    r -= CVT_I_BR;
    if (r < CVT_I_O) { const int kb = r >> 5, nb = r & 31;
        c.W = a.w_o + (size_t)l * DM * DM; c.N = DM; c.n0 = nb * 32; c.k0 = kb * 64; c.WT = (bf16*)(ws + W_O); c.dK = DM; c.drow0 = nb * 32; return c; }
    r -= CVT_I_O;
    if (r < CVT_I_C1) { const int j = r >> 6, q = r & 63, kb = q >> 1, nb = q & 1;
        c.W = a.w_cmp1 + (size_t)(l * 2 + j) * 2048 * 64; c.N = 64; c.n0 = nb * 32; c.k0 = kb * 64; c.WT = (bf16*)(ws + W_C1) + (size_t)j * 256 * 2048; c.dK = 2048; c.drow0 = nb * 32; return c; }
    r -= CVT_I_C1;
    if (r < CVT_I_R) { const int mode = r >> 5, q = r & 31, kb = q >> 1, nb = q & 1;
        c.W = a.w_router + (size_t)l * DM * 64; c.N = 64; c.n0 = nb * 32; c.k0 = kb * 64; c.WT = (bf16*)(ws + (mode ? W_RL : W_RH)); c.dK = DM; c.drow0 = nb * 32; c.mode = mode; return c; }
    r -= CVT_I_R;
    if (r < CVT_I_E) {
        const int e = r / 384, q = r % 384, which = q >> 7, qq = q & 127;
        if (which < 2) { const int kb = qq >> 3, nb = qq & 7, n0 = nb * 32, pn = n0 >> 7, i0 = n0 & 127;
            c.W = (which == 0) ? (e < 64 ? a.w_eg + (size_t)(l * 64 + e) * DM * 256 : a.w_sg + (size_t)l * DM * 256) : (e < 64 ? a.w_eu + (size_t)(l * 64 + e) * DM * 256 : a.w_su + (size_t)l * DM * 256);
            c.N = 256; c.n0 = n0; c.k0 = kb * 64; c.WT = (bf16*)(ws + W_1) + (size_t)e * 512 * DM; c.dK = DM; c.drow0 = pn * 256 + which * 128 + i0;
        } else { const int kb = qq >> 5, nb = qq & 31;
            c.W = e < 64 ? a.w_ed + (size_t)(l * 64 + e) * 256 * DM : a.w_sd + (size_t)l * 256 * DM; c.N = DM; c.n0 = nb * 32; c.k0 = kb * 64; c.WT = (bf16*)(ws + W_2) + (size_t)e * DM * 256; c.dK = 256; c.drow0 = nb * 32; c.scale = Y_SCALE; }
        return c; }
    r -= CVT_I_E;
    c.mode = 2; c.n0 = r; c.W = nullptr; c.WT = nullptr; c.N = 0; c.k0 = 0; c.dK = 0; c.drow0 = 0; return c;
}
DI void cvt_load(const CvtItem& c, f32x4 (&v)[8], int lane) {
    if (c.mode == 2) return;
    if (c.nv == 32 && ((c.N | c.n0) & 3) == 0) {
#pragma unroll
        for (int i = 0; i < 8; ++i) v[i] = *(const f32x4*)(c.W + (size_t)(c.k0 + 8 * i + (lane >> 3)) * c.N + c.n0 + (lane & 7) * 4);
    } else {
#pragma unroll
        for (int i = 0; i < 8; ++i) { const float* p = c.W + (size_t)(c.k0 + 8 * i + (lane >> 3)) * c.N + c.n0 + (lane & 7) * 4; const int c4 = (lane & 7) * 4;
            v[i][0] = (c4 + 0 < c.nv) ? p[0] : 0.f; v[i][1] = (c4 + 1 < c.nv) ? p[1] : 0.f; v[i][2] = (c4 + 2 < c.nv) ? p[2] : 0.f; v[i][3] = (c4 + 3 < c.nv) ? p[3] : 0.f; }
    }
}
DI void cvt_finish(const Args& a, int l, const CvtItem& c, const f32x4 (&v)[8], LAS float* scr, int lane) {
    if (c.mode == 2) {
        const int j = c.n0; const float* pe = a.pe_cmp + (size_t)(l * 2 + j) * 2048; const float* w1 = a.w_cmp1 + (size_t)(l * 2 + j) * 2048 * 64;
        float s = 0.f;
        for (int k = 0; k < 2048; ++k) s += pe[k] * w1[(size_t)k * 64 + lane];
        ((float*)(a.ws + WS_CBIAS))[j * 64 + lane] = s; return; }
#pragma unroll
    for (int i = 0; i < 8; ++i) { const int kk = 8 * i + (lane >> 3), c4 = (lane & 7) * 4; scr[kk * 33 + c4] = v[i][0]; scr[kk * 33 + c4 + 1] = v[i][1]; scr[kk * 33 + c4 + 2] = v[i][2]; scr[kk * 33 + c4 + 3] = v[i][3]; }
    LDS_WAIT(); asm volatile("" ::: "memory");
    const int cc = lane & 7;
#pragma unroll
    for (int j = 0; j < 4; ++j) {
        const int n = (lane >> 3) + 8 * j; const LAS float* s = scr + (8 * cc) * 33 + n;
        float w[8];
#pragma unroll
        for (int q = 0; q < 8; ++q) { w[q] = s[q * 33] * c.scale; if (c.mode == 1) { const float h = __uint_as_float(cvtpk(w[q], 0.f) << 16); w[q] = w[q] - h; } }
        u32x4 o; o.x = cvtpk(w[0], w[1]); o.y = cvtpk(w[2], w[3]); o.z = cvtpk(w[4], w[5]); o.w = cvtpk(w[6], w[7]);
        if (n < c.nv) *(u32x4*)(c.WT + (size_t)(c.drow0 + n) * c.dK + c.k0 + 8 * cc) = o;
    }
    LDS_WAIT(); asm volatile("" ::: "memory");
}
DI void ph_cvt(const Args& a, int l, LAS unsigned char* lds, int gw, int NGW, int wave, int lane) {
    LAS float* scr = (LAS float*)(lds + wave * 8704);
    f32x4 va[8], vb[8];
    CvtItem ca, cb; ca.mode = 2; ca.n0 = 0;
    int it = gw;
    if (it < CVT_NIT) { ca = cvt_decode(a, l, it); cvt_load(ca, va, lane); }
    for (; it < CVT_NIT; it += 2 * NGW) {
        const bool hasb = it + NGW < CVT_NIT;
        if (hasb) { cb = cvt_decode(a, l, it + NGW); cvt_load(cb, vb, lane); }
        cvt_finish(a, l, ca, va, scr, lane);
        const bool hasa = it + 2 * NGW < CVT_NIT;
        if (hasa) { ca = cvt_decode(a, l, it + 2 * NGW); cvt_load(ca, va, lane); }
        if (hasb) cvt_finish(a, l, cb, vb, scr, lane);
    }
}

DI void rope4(float (&v)[4], int a, const float* rp, float scale) {
    float pv[4];
#pragma unroll
    for (int i = 0; i < 4; ++i) pv[i] = dpp_xor2(v[i]);
    const f32x4 c4 = *(const f32x4*)(rp + 4 * (a & 1)), s4 = *(const f32x4*)(rp + 8 + 4 * (a & 1));
    if (a < 4) {
#pragma unroll
        for (int i = 0; i < 4; ++i) v[i] = (a < 2) ? (v[i] * c4[i] - pv[i] * s4[i]) : (pv[i] * s4[i] + v[i] * c4[i]);
    }
#pragma unroll
    for (int i = 0; i < 4; ++i) v[i] *= scale;
}
DI void ld4bf(const bf16* p, float (&v)[4]) { const u32x2 w = *(const u32x2*)p; v[0] = bflo(w.x); v[1] = bfhi(w.x); v[2] = bflo(w.y); v[3] = bfhi(w.y); }
DI void st4bf(bf16* p, const float (&v)[4]) { u32x2 w; w.x = cvtpk(v[0], v[1]); w.y = cvtpk(v[2], v[3]); *(u32x2*)p = w; }

DI void ph_post(const Args& a, int l, LAS unsigned char* lds, int wave, int lane) {
    unsigned char* ws = a.ws;
    bf16* proj = (bf16*)(ws + WS_A);
    const float* rope = (const float*)(ws + WS_ROPE);
    const float* sm32 = (const float*)(ws + WS_SM32);
    LAS bf16* T = (LAS bf16*)(lds + wave * 9216);
    for (int tile = lbid(); tile < NTOK / 64; tile += lgrid()) {
        const int tok0 = tile * 64;
        float kmx = 0.f;
        for (int tt = wave; tt < 64; tt += NWAVES) {
            const int tok = tok0 + tt; bf16* row = proj + (size_t)tok * PW;
            const float* cs = rope + (size_t)tok * 16;
            const int ah = lane & 15;
            float v[4];
            ld4bf(row + C_AQ + 4 * lane, v); rope4(v, ah, cs, 1.0f); st4bf(row + C_AQ + 4 * lane, v);
            ld4bf(row + C_DQ + 4 * lane, v); rope4(v, ah, cs, 1.0f); st4bf(row + C_DQ + 4 * lane, v);
            ld4bf(row + C_DIQ + 4 * lane, v); rope4(v, ah, cs, 1.0f); st4bf(row + C_DIQ + 4 * lane, v);
            {
                const int tl = tok % SEQ, kin = tl & 31, slot = (kin & ~12) | ((kin & 4) << 1) | ((kin & 8) >> 1), hq = lane >> 4;
                const size_t toff = (((size_t)(tok / SEQ) * 4 + hq) * (SEQ / 32) + (tl >> 5)) * 2048 + ((ah >> 1) * 32 + slot) * 8 + (ah & 1) * 4;
                *(u32x2*)((bf16*)(ws + WS_KTB) + toff) = *(const u32x2*)(row + C_BK + 4 * lane);
                const u32x2 ckw = *(const u32x2*)(row + C_CK + 4 * lane);
                *(u32x2*)((bf16*)(ws + WS_KTC) + toff) = ckw;
                float sq = bflo(ckw.x) * bflo(ckw.x) + bfhi(ckw.x) * bfhi(ckw.x) + bflo(ckw.y) * bflo(ckw.y) + bfhi(ckw.y) * bfhi(ckw.y);
                sq += dpp_xor1(sq); sq += dpp_xor2(sq); sq += DPPF(sq, 0x124, 0xF, true); sq += DPPF(sq, 0x128, 0xF, true);
                kmx = fmaxf(kmx, sq);
            }
            { const int hk = lane >> 4; const int cb = (hk == 0) ? C_AKS : (hk == 1) ? C_AKW : (hk == 2) ? C_DK : C_DIK;
              ld4bf(row + cb + 4 * ah, v); rope4(v, ah, cs, 1.0f); st4bf(row + cb + 4 * ah, v);
              if (hk < 2) {
                  const int tl = tok % SEQ, kin = tl & 31, slot = (kin & ~12) | ((kin & 4) << 1) | ((kin & 8) >> 1);
                  bf16* kt = (bf16*)(ws + (hk == 0 ? WS_KTS : WS_KTW)) + ((size_t)(tok / SEQ) * (SEQ / 32) + (tl >> 5)) * 2048 + ((ah >> 1) * 32 + slot) * 8 + (ah & 1) * 4;
                  st4bf(kt, v); }
              if (hk == 3) {
                  const int tl = tok % SEQ;
                  bf16* it = (bf16*)(ws + WS_IKT) + ((size_t)(tok / SEQ) * (SEQ / 32) + (tl >> 5)) * 2048 + ((ah >> 1) * 32 + (tl & 31)) * 8 + (ah & 1) * 4;
                  st4bf(it, v); } }
            if (lane < 32) { const int j = lane >> 4; const u32x2 w = *(const u32x2*)(row + (j ? C_AVC : C_AKC) + 4 * ah);
                *(u32x2*)((bf16*)(ws + (j ? WS_VCR : WS_KCR)) + (size_t)tok * 64 + 4 * ah) = w; }
            if (lane < 20) {
                const float s = sm32[(size_t)tok * 32 + lane];
                if (lane < 12) ((float*)(ws + WS_GATE))[(size_t)tok * 12 + lane] = sigmoidf_(s);
                else if (lane < 16) { const float z = s + a.b_f[l * 4 + (lane - 12)];
                    ((float*)(ws + WS_LOGF))[(size_t)tok * 4 + (lane - 12)] = fminf(z, 0.f) * LOG2E - flog2(1.f + fexp2(-fabsf(z) * LOG2E)); }
                else ((float*)(ws + WS_IW))[(size_t)tok * 4 + (lane - 16)] = s;
            }
        }
        if ((lane & 15) == 0) atomicMax((unsigned*)(ws + WS_CTL) + CW_KMAX + l * 32 + (tok0 / SEQ) * 4 + (lane >> 4), __float_as_uint(kmx * 1.02f));
        const int bidx = tok0 / SEQ, tl0 = tok0 % SEQ;
        for (int hv = wave; hv < 10; hv += NWAVES) {
            int cb; bf16* dst;
            if (hv < 4) { cb = C_BV + 64 * hv; dst = (bf16*)(ws + WS_VTB) + (size_t)(bidx * 4 + hv) * 64 * SEQ; }
            else if (hv < 8) { cb = C_CV + 64 * (hv - 4); dst = (bf16*)(ws + WS_VTC) + (size_t)(bidx * 4 + hv - 4) * 64 * SEQ; }
            else if (hv == 8) { cb = C_AVS; dst = (bf16*)(ws + WS_VTAS) + (size_t)bidx * 64 * SEQ; }
            else { cb = C_AVW; dst = (bf16*)(ws + WS_VTAW) + (size_t)bidx * 64 * SEQ; }
            const bf16* src = proj + (size_t)(tok0 + lane) * PW + cb;
#pragma unroll
            for (int i = 0; i < 8; ++i) { const u32x4 w = *(const u32x4*)(src + 8 * i);
                T[(8 * i + 0) * 72 + lane] = (bf16)(w.x & 0xffff); T[(8 * i + 1) * 72 + lane] = (bf16)(w.x >> 16);
                T[(8 * i + 2) * 72 + lane] = (bf16)(w.y & 0xffff); T[(8 * i + 3) * 72 + lane] = (bf16)(w.y >> 16);
                T[(8 * i + 4) * 72 + lane] = (bf16)(w.z & 0xffff); T[(8 * i + 5) * 72 + lane] = (bf16)(w.z >> 16);
                T[(8 * i + 6) * 72 + lane] = (bf16)(w.w & 0xffff); T[(8 * i + 7) * 72 + lane] = (bf16)(w.w >> 16); }
            LDS_WAIT(); asm volatile("" ::: "memory");
            {
                const int dt = lane >> 5, cc = lane & 31;
#pragma unroll
                for (int i = 0; i < 8; ++i) { const int tile = i >> 2, sh = i & 3;
                    bf16* d = dst + ((size_t)(tl0 >> 5) + tile) * 2048 + ((dt * 2 + (sh >> 1)) * 64 + (sh & 1) * 32 + cc) * 8;
                    *(u32x4*)d = *(const LAS u32x4*)(T + lane * 72 + 8 * i); }
            }
            LDS_WAIT(); asm volatile("" ::: "memory");
        }
    }
}

DI void cumsum_seq(const Args& a, int bh, int lane) {
    const float* lf = (const float*)(a.ws + WS_LOGF); float* cum = (float*)(a.ws + WS_CUM);
    const int b = bh >> 2, h = bh & 3;
    const float* src = lf + ((size_t)b * SEQ + lane * 128) * 4 + h;
    float s = 0.f;
    for (int i = 0; i < 128; ++i) s += src[(size_t)i * 4];
    const float incl = wave_incl_scan_f(s);
    float run = incl - s;
    float* dst = cum + (size_t)bh * SEQ + lane * 128;
    for (int i = 0; i < 128; ++i) { run += src[(size_t)i * 4]; dst[i] = run; }
}

DI void ph_cmp2(const Args& a, int l, int gw, int NGW, int lane) {
    const float* hid = (const float*)(a.ws + WS_HID);
    bf16* kc = (bf16*)(a.ws + WS_KCMP); bf16* vtc = (bf16*)(a.ws + WS_VTCMP);
    for (int it = gw; it < 2 * 4096; it += NGW) {
        const int j = it >> 12, row = it & 4095, b = row >> 9, n = row & 511;
        const float* h = hid + ((size_t)j * 4096 + row) * 64; const float* w2 = a.w_cmp2 + (size_t)(l * 2 + j) * 64 * 64;
        float s = 0.f;
#pragma unroll 8
        for (int k = 0; k < 64; ++k) s += h[k] * w2[k * 64 + lane];
        if (n == 511) s = 0.f;
        const bf16 o = (bf16)(cvtpk(s, 0.f) & 0xffff);
        const int tile = n >> 5, kin = n & 31;
        if (j == 0) { const int slot = (kin & ~12) | ((kin & 4) << 1) | ((kin & 8) >> 1); kc[((size_t)b * 16 + tile) * 2048 + ((lane >> 3) * 32 + slot) * 8 + (lane & 7)] = o; }
        else { const int sI = kin >> 4, hI = (kin >> 3) & 1, e = kin & 7; vtc[((size_t)b * 16 + tile) * 2048 + (((lane >> 5) * 2 + sI) * 64 + hI * 32 + (lane & 31)) * 8 + e] = o; }
    }
}

DI void ph_ln1(const Args& a, int l, int gw, int NGW, int lane) {
    bf16* xb = (bf16*)(a.ws + WS_XB); bf16* xl = (bf16*)(a.ws + WS_XL);
    const float* g = a.ln1_g + l * DM; const float* be = a.ln1_b + l * DM;
    u32x4 nq0 = {0u,0u,0u,0u}, nq1 = {0u,0u,0u,0u};
    if (gw < NTOK) { const u32x4* x0 = (const u32x4*)(xb + (size_t)gw * DM) + lane; nq0 = x0[0]; nq1 = x0[64]; }
    for (int row = gw; row < NTOK; row += NGW) {
        u32x4* xr = (u32x4*)(xb + (size_t)row * DM) + lane; u32x4* lr = (u32x4*)(xl + (size_t)row * DM) + lane;
        const u32x4 qq[2] = {nq0, nq1};
        if (row + NGW < NTOK) { const u32x4* xn = (const u32x4*)(xb + (size_t)(row + NGW) * DM) + lane; nq0 = xn[0]; nq1 = xn[64]; }
        f32x4 v[4]; float s = 0.f;
#pragma unroll
        for (int j = 0; j < 2; ++j) { const u32x4 q = qq[j];
            v[2 * j] = (f32x4){bflo(q.x), bfhi(q.x), bflo(q.y), bfhi(q.y)}; v[2 * j + 1] = (f32x4){bflo(q.z), bfhi(q.z), bflo(q.w), bfhi(q.w)}; }
#pragma unroll
        for (int j = 0; j < 4; ++j) s += (v[j].x + v[j].y) + (v[j].z + v[j].w);
        const float mean = wave_sum(s) * (1.f / DM); float s2 = 0.f;
#pragma unroll
        for (int j = 0; j < 4; ++j) { v[j] = v[j] - mean; s2 += (v[j].x * v[j].x + v[j].y * v[j].y) + (v[j].z * v[j].z + v[j].w * v[j].w); }
        const float rstd = 1.f / sqrtf(wave_sum(s2) * (1.f / DM) + LN_EPS);
#pragma unroll
        for (int j = 0; j < 2; ++j) {
            const int cb = 8 * lane + 512 * j;
            const f32x4 g0 = *(const f32x4*)(g + cb), g1 = *(const f32x4*)(g + cb + 4), b0 = *(const f32x4*)(be + cb), b1 = *(const f32x4*)(be + cb + 4);
            const f32x4 y0 = v[2 * j] * rstd * g0 + b0, y1 = v[2 * j + 1] * rstd * g1 + b1;
            const u32x4 hi = pack8(y0, y1);
            const f32x4 r0 = {y0[0] - bflo(hi.x), y0[1] - bfhi(hi.x), y0[2] - bflo(hi.y), y0[3] - bfhi(hi.y)}, r1 = {y1[0] - bflo(hi.z), y1[1] - bfhi(hi.z), y1[2] - bflo(hi.w), y1[3] - bfhi(hi.w)};
            xr[64 * j] = hi; lr[64 * j] = pack8(r0, r1);
        }
    }
}

DI void ph_route(const Args& a, int l, LAS unsigned char* lds, int wave, int lane) {
    const float* logit = (const float*)(a.ws + WS_LOGIT);
    u32x2* tokinfo = (u32x2*)(a.ws + WS_TOKINFO);
    unsigned* lists = (unsigned*)(a.ws + WS_LIST);
    unsigned* gcnt = (unsigned*)(a.ws + WS_CTL) + CW_CNT + l * NCH * 64;
    LAS unsigned* lcnt = (LAS unsigned*)lds;
    LAS unsigned* lbase = lcnt + 64;
    LAS unsigned* stash = lbase + 64;
    const float rb = a.router_bias[l * 64 + lane];
    for (int blk = lbid(); blk < NTOK / 256; blk += lgrid()) {
        const int tok0 = blk * 256, c = tok0 / CHTOK;
        if (ltid() < 64) lcnt[ltid()] = 0u;
        __syncthreads();
        for (int tt = wave; tt < 256; tt += NWAVES) {
            const int tok = tok0 + tt;
            const float sc = sigmoidf_(logit[(size_t)tok * 64 + lane]);
            const float bi = sc + rb;
            float m1 = bi;
            m1 = fmaxf(m1, __shfl_xor(m1, 1)); m1 = fmaxf(m1, __shfl_xor(m1, 2)); m1 = fmaxf(m1, __shfl_xor(m1, 4));
            const unsigned long long eqm = __ballot(bi == m1);
            const int gsh = lane & ~7; const unsigned gm = (unsigned)((eqm >> gsh) & 0xffu);
            const int first = __builtin_ctz(gm);
            float v2 = ((lane & 7) == first) ? -3.0e38f : bi;
            v2 = fmaxf(v2, __shfl_xor(v2, 1)); v2 = fmaxf(v2, __shfl_xor(v2, 2)); v2 = fmaxf(v2, __shfl_xor(v2, 4));
            const float gs = m1 + v2;
            const int g = lane >> 3; int grank = 0;
#pragma unroll
            for (int gg = 0; gg < 8; ++gg) { const float o = __int_as_float(__builtin_amdgcn_readlane(__float_as_int(gs), gg * 8)); grank += (o > gs || (o == gs && gg < g)) ? 1 : 0; }
            const float mb = (grank < 4) ? bi : -1.0e30f;
            int rank = 0;
#pragma unroll 4
            for (int e = 0; e < 64; ++e) { const float o = __int_as_float(__builtin_amdgcn_readlane(__float_as_int(mb), e)); rank += (o > mb || (o == mb && e < lane)) ? 1 : 0; }
            const bool sel = rank < 8;
            const float wsum = wave_sum(sel ? sc : 0.f);
            const float w = sc / wsum * 2.5f;
            const unsigned long long sm = __ballot(sel);
            const int k = __popcll(sm & ((1ull << lane) - 1ull));
            if (sel) {
                const unsigned lp = atomicAdd((unsigned*)&lcnt[lane], 1u);
                stash[tt * 8 + k] = ((unsigned)lane << 16) | lp;
                ((float*)tokinfo)[((size_t)tok * 8 + k) * 2 + 1] = w;
            }
        }
        __syncthreads();
        if (ltid() < 64) lbase[ltid()] = atomicAdd(&gcnt[c * 64 + ltid()], lcnt[ltid()]);
        __syncthreads();
        for (int i = ltid(); i < 256 * 8; i += NWAVES * 64) {
            const unsigned s = stash[i]; const unsigned e = s >> 16, lp = s & 0xffffu; const int tok = tok0 + (i >> 3);
            const unsigned pos = lbase[e] + lp;
            lists[((size_t)c * 64 + e) * CHTOK + pos] = (unsigned)tok;
            ((unsigned*)tokinfo)[((size_t)tok * 8 + (i & 7)) * 2] = (e << 16) | pos;
        }
        __syncthreads();
    }
}

typedef f32x4 Acc2[2][2][4][2];
typedef f32x4 Acc1[2][1][4][2];

struct SchedProj {
    static constexpr bool GATHER = false, FIXED = true;
    gs::StaticOrder so; unsigned A, B;
    DI bool next(int i, gs::GU& u) const { gs::Unit t; if (!so.next(i, t)) return false;
        u.A = A + (unsigned)t.pm * 256u * 2048u; u.B = B + (unsigned)t.pn * 256u * 2048u; u.idx = nullptr; u.lda = 2048; u.ldb = 2048; u.nt = 16; u.flags = 3; u.nvalid = 256;
        u.a0 = t.pm; u.a1 = t.pn; u.a2 = 0; u.a3 = 0; return true; }
};
struct EpiProj {
    static constexpr bool PERM = true; static constexpr bool BH8 = false; bf16* proj; float* sm32;
    DI void operator()(const Acc2& acc, const gs::GU& u, int wr, int wc, int fr, int fq) const {
        const int row0 = u.a0 * 256 + wr * 64 + fr, col0 = u.a1 * 256 + wc * 32 + 8 * fq;
#pragma unroll
        for (int ai = 0; ai < 2; ++ai)
#pragma unroll
            for (int m = 0; m < 4; ++m) { const int row = row0 + ai * 128 + m * 16;
#pragma unroll
                for (int bj = 0; bj < 2; ++bj) *(u32x4*)(proj + (size_t)row * PW + col0 + bj * 128) = pack8(acc[ai][bj][m][0], acc[ai][bj][m][1]);
                if (u.a1 == 11 && wc == 2) { *(f32x4*)(sm32 + (size_t)row * 32 + 8 * fq) = acc[ai][0][m][0]; *(f32x4*)(sm32 + (size_t)row * 32 + 8 * fq + 4) = acc[ai][0][m][1]; } }
    }
};

struct SchedCmp {
    static constexpr bool GATHER = false, FIXED = true;
    unsigned kcr, vcr, w;
    DI bool next(int i, gs::GU& u) const { if (i > 0 || lbid() >= 32) return false; const int j = lbid() >> 4, pm = lbid() & 15;
        u.A = (j ? vcr : kcr) + (unsigned)pm * 256u * 2048u; u.B = w + (unsigned)j * 256u * 4096u; u.idx = nullptr; u.lda = 2048; u.ldb = 4096; u.nt = 32; u.flags = 3; u.nvalid = 256;
        u.a0 = pm; u.a1 = j; u.a2 = 0; u.a3 = 0; return true; }
};
struct EpiCmp {
    static constexpr bool PERM = true; static constexpr bool BH8 = false; float* hid; const float* cbias;
    DI void operator()(const Acc2& acc, const gs::GU& u, int wr, int wc, int fr, int fq) const {
        if (wc >= 2) return;
        const int row0 = u.a0 * 256 + wr * 64 + fr, col0 = wc * 32 + 8 * fq, j = u.a1;
        float cb[8];
#pragma unroll
        for (int q = 0; q < 8; ++q) cb[q] = cbias[j * 64 + col0 + q];
#pragma unroll
        for (int ai = 0; ai < 2; ++ai)
#pragma unroll
            for (int m = 0; m < 4; ++m) { const int row = row0 + ai * 128 + m * 16; float o[8];
#pragma unroll
                for (int q = 0; q < 8; ++q) { const float x = acc[ai][0][m][q >> 2][q & 3] + cb[q];
                    const float y2 = 1.5957691216f * (x + 0.044715f * x * x * x);
                    o[q] = x * frcp(1.f + fexp2(-y2 * LOG2E)); }
                float* d = hid + ((size_t)j * 4096 + row) * 64 + col0;
                *(f32x4*)d = (f32x4){o[0], o[1], o[2], o[3]}; *(f32x4*)(d + 4) = (f32x4){o[4], o[5], o[6], o[7]}; }
    }
};

struct SchedMerge {
    static constexpr bool GATHER = false, FIXED = false;
    unsigned xb, om, wg, wbr; int G;
    DI bool next(int i, gs::GU& u) const { const int ti = i >> 3, k = i & 7; const int bid_ = lbid(); const long L = (long)ti * G + bid_; if (L >= 2048) return false;
        int pm = (int)(L >> 3), pc = (int)(L & 7); const int m = k >> 1, kind = k & 1;
        if (G == 256) { const int x = bid_ & 7, idx = bid_ >> 3; pm = ti * 32 + x * 4 + (idx >> 3); pc = idx & 7; }
        if (kind == 0) { u.A = om + (unsigned)pm * 256u * 2048u + (unsigned)m * 512u; u.B = wbr + (unsigned)m * 1024u * 512u + (unsigned)pc * 128u * 512u; u.lda = 2048; u.ldb = 512; u.nt = 4; }
        else           { u.A = xb + (unsigned)pm * 256u * 2048u;           u.B = wg + (unsigned)m * 1024u * 2048u + (unsigned)pc * 128u * 2048u; u.lda = 2048; u.ldb = 2048; u.nt = 16; }
        u.idx = nullptr; u.flags = 3; u.nvalid = 256; u.a0 = pm; u.a1 = pc; u.a2 = kind; u.a3 = m; return true; }
};
struct EpiMerge {
    static constexpr bool PERM = true; static constexpr bool BH8 = false; bf16* merged; u32x4* stash;
    f32x4 M[2][4][2];
    DI void operator()(const Acc1& acc, const gs::GU& u, int wr, int wc, int fr, int fq) {
        const int tid = ltid();
        if (u.a2 == 0) {
#pragma unroll
            for (int ai = 0; ai < 2; ++ai)
#pragma unroll
                for (int m = 0; m < 4; ++m) stash[(ai * 4 + m) * 512 + tid] = pack8(acc[ai][0][m][0], acc[ai][0][m][1]);
        } else {
            const bool first = (u.a3 == 0), lastm = (u.a3 == 3);
            const int row0 = u.a0 * 256 + wr * 64 + fr, col0 = u.a1 * 128 + wc * 32 + 8 * fq;
            if (first) {
#pragma unroll
                for (int ai = 0; ai < 2; ++ai)
#pragma unroll
                    for (int m = 0; m < 4; ++m) { M[ai][m][0] = (f32x4){0.f, 0.f, 0.f, 0.f}; M[ai][m][1] = (f32x4){0.f, 0.f, 0.f, 0.f}; }
            }
#pragma unroll
            for (int ai = 0; ai < 2; ++ai)
#pragma unroll
                for (int m = 0; m < 4; ++m) {
                    const u32x4 p = stash[(ai * 4 + m) * 512 + tid];
                    const f32x4 g0 = acc[ai][0][m][0], g1 = acc[ai][0][m][1];
                    f32x4 m0 = M[ai][m][0], m1 = M[ai][m][1];
                    m0[0] = __builtin_fmaf(frcp(1.f + fexp2(g0[0])), bflo(p.x), m0[0]); m0[1] = __builtin_fmaf(frcp(1.f + fexp2(g0[1])), bfhi(p.x), m0[1]);
                    m0[2] = __builtin_fmaf(frcp(1.f + fexp2(g0[2])), bflo(p.y), m0[2]); m0[3] = __builtin_fmaf(frcp(1.f + fexp2(g0[3])), bfhi(p.y), m0[3]);
                    m1[0] = __builtin_fmaf(frcp(1.f + fexp2(g1[0])), bflo(p.z), m1[0]); m1[1] = __builtin_fmaf(frcp(1.f + fexp2(g1[1])), bfhi(p.z), m1[1]);
                    m1[2] = __builtin_fmaf(frcp(1.f + fexp2(g1[2])), bflo(p.w), m1[2]); m1[3] = __builtin_fmaf(frcp(1.f + fexp2(g1[3])), bfhi(p.w), m1[3]);
                    M[ai][m][0] = m0; M[ai][m][1] = m1;
                    asm volatile("" : "+v"(M[ai][m][0]), "+v"(M[ai][m][1]));
                    if (lastm) *(u32x4*)(merged + (size_t)(row0 + ai * 128 + m * 16) * DM + col0) = pack8(M[ai][m][0], M[ai][m][1]);
                    asm volatile("" ::: "memory");
                }
        }
    }
};

struct SchedWo {
    static constexpr bool GATHER = false, FIXED = true;
    gs::StaticOrder so; unsigned A, B;
    DI bool next(int i, gs::GU& u) const { gs::Unit t; if (!so.next(i, t)) return false;
        u.A = A + (unsigned)t.pm * 256u * 2048u; u.B = B + (unsigned)t.pn * 256u * 2048u; u.idx = nullptr; u.lda = 2048; u.ldb = 2048; u.nt = 16; u.flags = 3; u.nvalid = 256;
        u.a0 = t.pm; u.a1 = t.pn; u.a2 = 0; u.a3 = 0; return true; }
};
struct EpiWo {
    static constexpr bool PERM = true; static constexpr bool BH8 = false; bf16* xb;
    DI void operator()(const Acc2& acc, const gs::GU& u, int wr, int wc, int fr, int fq) const {
        const int row0 = u.a0 * 256 + wr * 64 + fr, col0 = u.a1 * 256 + wc * 32 + 8 * fq;
#pragma unroll
        for (int ai = 0; ai < 2; ++ai)
#pragma unroll
            for (int m = 0; m < 4; ++m) {
#pragma unroll
                for (int bj = 0; bj < 2; ++bj) { bf16* p = xb + (size_t)(row0 + ai * 128 + m * 16) * DM + col0 + bj * 128; const u32x4 xv = *(const u32x4*)p;
                    f32x4 v0 = acc[ai][bj][m][0], v1 = acc[ai][bj][m][1];
                    v0[0] += ALPHA * bflo(xv.x); v0[1] += ALPHA * bfhi(xv.x); v0[2] += ALPHA * bflo(xv.y); v0[3] += ALPHA * bfhi(xv.y);
                    v1[0] += ALPHA * bflo(xv.z); v1[1] += ALPHA * bfhi(xv.z); v1[2] += ALPHA * bflo(xv.w); v1[3] += ALPHA * bfhi(xv.w);
                    *(u32x4*)p = pack8(v0, v1); } }
    }
};

struct SchedRouter {
    static constexpr bool GATHER = false, FIXED = true;
    unsigned xh, xl, wh, wl; int G;
    DI bool next(int i, gs::GU& u) const { const int ti = i / 3, k = i % 3; const int pm = ti * G + lbid(); if (pm >= 256) return false;
        u.A = ((k == 1) ? xl : xh) + (unsigned)pm * 256u * 2048u; u.B = (k == 2) ? wl : wh; u.idx = nullptr; u.lda = 2048; u.ldb = 2048; u.nt = 16;
        u.flags = (k == 0 ? 1 : 0) | (k == 2 ? 2 : 0); u.nvalid = 256; u.a0 = pm; u.a1 = 0; u.a2 = 0; u.a3 = 0; return true; }
};
struct EpiRouter {
    static constexpr bool PERM = false; static constexpr bool BH8 = false; float* logit;
    DI void operator()(const Acc1& acc, const gs::GU& u, int wr, int wc, int fr, int fq) const {
        if (wc >= 2) return;
        const int row0 = u.a0 * 256 + wr * 64 + fr, col0 = wc * 32 + 4 * fq;
#pragma unroll
        for (int ai = 0; ai < 2; ++ai)
#pragma unroll
            for (int m = 0; m < 4; ++m)
#pragma unroll
                for (int n = 0; n < 2; ++n) *(f32x4*)(logit + (size_t)(row0 + ai * 128 + m * 16) * 64 + col0 + n * 16) = acc[ai][0][m][n];
    }
};

constexpr int TBL_OFF = 131072, NPAIR = NCH * 65, TBLN = 528;
static_assert(NPAIR + 1 <= TBLN && TBL_OFF + 3 * TBLN * 4 <= MISC_OFF, "MoE tables");
DI void moe_tables(const Args& a, int l, LAS unsigned char* lds) {
    LAS int* ptile = (LAS int*)(lds + TBL_OFF); LAS int* ypre = ptile + TBLN; LAS int* cntv = ypre + TBLN;
    __syncthreads();
    const int tid_ = ltid();
    if (tid_ < 64) {
        const unsigned* gcnt = (const unsigned*)(a.ws + WS_CTL) + CW_CNT + l * NCH * 64;
        int pt = 0;
        for (int c = 0; c < NCH; ++c) {
            const int n = (int)__hip_atomic_load(gcnt + c * 64 + tid_, __ATOMIC_RELAXED, __HIP_MEMORY_SCOPE_AGENT);
            const int tl = (n + 255) >> 8;
            const int tinc = wave_incl_scan(tl), yinc = wave_incl_scan(n);
            const int p = c * 65 + tid_;
            cntv[p] = n; ptile[p] = pt + tinc - tl; ypre[p] = yinc - n;
            const int ttot = __builtin_amdgcn_readlane(tinc, 63), ytot = __builtin_amdgcn_readlane(yinc, 63);
            if (tid_ == 0) { cntv[c * 65 + 64] = CHTOK; ptile[c * 65 + 64] = pt + ttot; ypre[c * 65 + 64] = ytot; }
            pt += ttot + CHTOK / 256;
        }
        if (tid_ == 0) ptile[NPAIR] = pt;
    }
    __syncthreads();
}
DI int find_pair(const LAS int* ptile, int tile) {
    int lo = 0, hi = NPAIR;
    while (hi - lo > 1) { const int mid = (lo + hi) >> 1; if (ptile[mid] <= tile) lo = mid; else hi = mid; }
    return lo;
}
struct SchedE1 {
    static constexpr bool GATHER = true, FIXED = false;
    const LAS int* ptile; const LAS int* cntv; unsigned xb; const unsigned* lists; unsigned w1; int G;
    DI bool next(int i, gs::GU& u) const { const int bid_ = lbid(); int un = i * G + bid_;
        if (G == 256) { const int x = bid_ & 7, idx = bid_ >> 3; un = (i * 128 + x * 16 + (idx >> 1)) * 2 + (idx & 1); }
        const int tile = un >> 1, pn = un & 1; if (tile >= ptile[NPAIR]) return false;
        const int p = find_pair(ptile, tile), c = p / 65, e = p % 65, t = tile - ptile[p];
        if (e < 64) { u.A = xb; u.idx = (const int*)(lists + ((size_t)c * 64 + e) * CHTOK + (size_t)t * 256); u.nvalid = cntv[p] - t * 256; }
        else { u.A = xb + ((unsigned)c * CHTOK + (unsigned)t * 256u) * 2048u; u.idx = nullptr; u.nvalid = 256; }
        u.B = w1 + (unsigned)e * 512u * 2048u + (unsigned)pn * 256u * 2048u; u.lda = 2048; u.ldb = 2048; u.nt = 16; u.flags = 3; u.a0 = tile; u.a1 = pn; u.a2 = 0; u.a3 = 0; return true; }
};
struct EpiE1 {
    static constexpr bool PERM = true; static constexpr bool BH8 = false; bf16* hb;
    DI void operator()(const Acc2& acc, const gs::GU& u, int wr, int wc, int fr, int fq) const {
        const int row0 = u.a0 * 256 + wr * 64 + fr, col0 = u.a1 * 128 + wc * 32 + 8 * fq;
#pragma unroll
        for (int ai = 0; ai < 2; ++ai)
#pragma unroll
            for (int m = 0; m < 4; ++m) { f32x4 h[2];
#pragma unroll
                for (int n = 0; n < 2; ++n)
#pragma unroll
                    for (int q = 0; q < 4; ++q) { const float g = acc[ai][0][m][n][q], up = acc[ai][1][m][n][q]; h[n][q] = g * sigmoidf_(g) * up; }
                *(u32x4*)(hb + (size_t)(row0 + ai * 128 + m * 16) * 256 + col0) = pack8(h[0], h[1]); }
    }
};
struct SchedE2 {
    static constexpr bool GATHER = false, FIXED = true;
    const LAS int* ptile; const LAS int* cntv; const LAS int* ypre; unsigned hb, w2; int c; int G;
    DI bool next(int i, gs::GU& u) const { const int bid_ = lbid(); int un = i * G + bid_;
        if (G == 256) { const int x = bid_ & 7, idx = bid_ >> 3; un = (i * 64 + x * 8 + (idx >> 2)) * 4 + (idx & 3); }
        const int tile = ptile[c * 65] + (un >> 2), pn = un & 3; if (tile >= ptile[(c + 1) * 65]) return false;
        const int p = find_pair(ptile, tile), e = p % 65, t = tile - ptile[p];
        u.A = hb + (unsigned)tile * 256u * 512u; u.B = w2 + (unsigned)e * 1024u * 512u + (unsigned)pn * 256u * 512u; u.idx = nullptr; u.lda = 512; u.ldb = 512; u.nt = 4; u.flags = 3;
        u.nvalid = 256; u.a0 = (tile - ptile[c * 65]) * 256; u.a1 = pn; u.a2 = 0; u.a3 = 0; return true; }
};
DI unsigned pk4_fp8(float a, float b, float c, float d) { int w = __builtin_amdgcn_cvt_pk_fp8_f32(a, b, 0, false); w = __builtin_amdgcn_cvt_pk_fp8_f32(c, d, w, true); return (unsigned)w; }
struct EpiE2 {
    static constexpr bool PERM = true; static constexpr bool BH8 = true; unsigned char* y;
    DI void operator()(const Acc2& acc, const gs::GU& u, int wr, int wc, int fr, int fq) const {
        const int row0 = u.a0 + wr * 64 + fr, col0 = u.a1 * 256 + wc * 64 + 16 * fq;
#pragma unroll
        for (int ai = 0; ai < 2; ++ai)
#pragma unroll
            for (int m = 0; m < 4; ++m) {
                u32x4 w;
                { const f32x4 v0 = acc[ai][0][m][0], v1 = acc[ai][0][m][1]; w.x = pk4_fp8(v0[0], v0[1], v0[2], v0[3]); w.y = pk4_fp8(v1[0], v1[1], v1[2], v1[3]); }
                { const f32x4 v0 = acc[ai][1][m][0], v1 = acc[ai][1][m][1]; w.z = pk4_fp8(v0[0], v0[1], v0[2], v0[3]); w.w = pk4_fp8(v1[0], v1[1], v1[2], v1[3]); }
                *(u32x4*)(y + (size_t)(row0 + ai * 128 + m * 16) * DM + col0) = w; }
    }
};

DI void ph_ln2(const Args& a, int l, int c, LAS unsigned char* lds, int gw, int NGW, int lane) {
    const LAS int* ptile = (const LAS int*)(lds + TBL_OFF);
    bf16* xb = (bf16*)(a.ws + WS_XB); const unsigned char* y = (const unsigned char*)(a.ws + WS_Y);
    const u32x2* tokinfo = (const u32x2*)(a.ws + WS_TOKINFO);
    const float* g = a.ln2_g + l * DM; const float* be = a.ln2_b + l * DM;
    u32x4 nx0 = {0u,0u,0u,0u}, nx1 = {0u,0u,0u,0u}; u32x2 nti = {0u, 0u};
    if (gw < CHTOK) { const int row0 = c * CHTOK + gw; const u32x4* xr0 = (const u32x4*)(xb + (size_t)row0 * DM) + lane; nx0 = xr0[0]; nx1 = xr0[64]; if (lane < 8) nti = tokinfo[(size_t)row0 * 8 + lane]; }
    for (int tt = gw; tt < CHTOK; tt += NGW) {
        const int row = c * CHTOK + tt;
        const u32x4 cx0 = nx0, cx1 = nx1; const u32x2 cti = nti;
        if (tt + NGW < CHTOK) { const int rown = row + NGW; const u32x4* xrn = (const u32x4*)(xb + (size_t)rown * DM) + lane; nx0 = xrn[0]; nx1 = xrn[64]; if (lane < 8) nti = tokinfo[(size_t)rown * 8 + lane]; }
        u32x4* xr = (u32x4*)(xb + (size_t)row * DM) + lane;
        f32x4 v[4];
        v[0] = (f32x4){bflo(cx0.x), bfhi(cx0.x), bflo(cx0.y), bfhi(cx0.y)} * ALPHA; v[1] = (f32x4){bflo(cx0.z), bfhi(cx0.z), bflo(cx0.w), bfhi(cx0.w)} * ALPHA;
        v[2] = (f32x4){bflo(cx1.x), bfhi(cx1.x), bflo(cx1.y), bfhi(cx1.y)} * ALPHA; v[3] = (f32x4){bflo(cx1.z), bfhi(cx1.z), bflo(cx1.w), bfhi(cx1.w)} * ALPHA;
        int yrv = 0; float wv = 1.f;
        if (lane < 8) { const u32x2 ti = cti; yrv = (ptile[c * 65 + (int)(ti.x >> 16)] - ptile[c * 65]) * 256 + (int)(ti.x & 0xffffu); wv = __uint_as_float(ti.y); }
        else if (lane == 8) yrv = (ptile[c * 65 + 64] - ptile[c * 65]) * 256 + tt;
        u32x2 q[9][2]; float wk[9];
#pragma unroll
        for (int k = 0; k < 9; ++k) { const int yrow = __builtin_amdgcn_readlane(yrv, k); wk[k] = __int_as_float(__builtin_amdgcn_readlane(__float_as_int(wv), k)) * (1.f / Y_SCALE);
            const u32x2* yr = (const u32x2*)(y + (size_t)yrow * DM) + lane; q[k][0] = yr[0]; q[k][1] = yr[64]; }
#pragma unroll
        for (int k = 0; k < 9; ++k) {
#pragma unroll
            for (int j = 0; j < 2; ++j) { const float ws_ = wk[k]; const u32x2 qq = q[k][j];
                v[2 * j][0] += ws_ * __builtin_amdgcn_cvt_f32_fp8((int)qq.x, 0); v[2 * j][1] += ws_ * __builtin_amdgcn_cvt_f32_fp8((int)qq.x, 1); v[2 * j][2] += ws_ * __builtin_amdgcn_cvt_f32_fp8((int)qq.x, 2); v[2 * j][3] += ws_ * __builtin_amdgcn_cvt_f32_fp8((int)qq.x, 3);
                v[2 * j + 1][0] += ws_ * __builtin_amdgcn_cvt_f32_fp8((int)qq.y, 0); v[2 * j + 1][1] += ws_ * __builtin_amdgcn_cvt_f32_fp8((int)qq.y, 1); v[2 * j + 1][2] += ws_ * __builtin_amdgcn_cvt_f32_fp8((int)qq.y, 2); v[2 * j + 1][3] += ws_ * __builtin_amdgcn_cvt_f32_fp8((int)qq.y, 3); }
        }
        float s = 0.f;
#pragma unroll
        for (int j = 0; j < 4; ++j) s += (v[j].x + v[j].y) + (v[j].z + v[j].w);
        const float mean = wave_sum(s) * (1.f / DM); float s2 = 0.f;
#pragma unroll
        for (int j = 0; j < 4; ++j) { v[j] = v[j] - mean; s2 += (v[j].x * v[j].x + v[j].y * v[j].y) + (v[j].z * v[j].z + v[j].w * v[j].w); }
        const float rstd = 1.f / sqrtf(wave_sum(s2) * (1.f / DM) + LN_EPS);
#pragma unroll
        for (int j = 0; j < 2; ++j) {
            const int cb = 8 * lane + 512 * j;
            const f32x4 g0 = *(const f32x4*)(g + cb), g1 = *(const f32x4*)(g + cb + 4), b0 = *(const f32x4*)(be + cb), b1 = *(const f32x4*)(be + cb + 4);
            const f32x4 y0 = v[2 * j] * rstd * g0 + b0, y1 = v[2 * j + 1] * rstd * g1 + b1;
            xr[64 * j] = pack8(y0, y1);
            if (l == DEPTH - 1) { float* o = a.out + (size_t)row * DM + cb; *(f32x4*)o = y0; *(f32x4*)(o + 4) = y1; }
        }
    }
}

DI int pi32(int r) { return (r & ~12) | ((r & 4) << 1) | ((r & 8) >> 1); }
DI int kofs(int i, int hh) { return 16 * (i >> 3) + 8 * hh + (i & 7); }
DI bf16x8 pack_p(const float (&p)[16], int s) {
    u32x4 w; w.x = cvtpk(p[8 * s], p[8 * s + 1]); w.y = cvtpk(p[8 * s + 2], p[8 * s + 3]); w.z = cvtpk(p[8 * s + 4], p[8 * s + 5]); w.w = cvtpk(p[8 * s + 6], p[8 * s + 7]);
    return __builtin_bit_cast(bf16x8, w);
}
DI f32x16 zero16() { f32x16 z;
#pragma unroll
    for (int i = 0; i < 16; ++i) z[i] = 0.f; return z; }
DI void store_ot(bf16* dst, const f32x16& o0, const f32x16& o1, float sc, int hh) {
#pragma unroll
    for (int g = 0; g < 4; ++g) {
        float v[4];
#pragma unroll
        for (int q = 0; q < 4; ++q) v[q] = o0[4 * g + q] * sc;
        st4bf(dst + 8 * g + 4 * hh, v);
#pragma unroll
        for (int q = 0; q < 4; ++q) v[q] = o1[4 * g + q] * sc;
        st4bf(dst + 32 + 8 * g + 4 * hh, v);
    }
}

DI void load_kv(bf16x8 (&kf)[4], bf16x8 (&vf)[2][2], const bf16* kp, const bf16* vp) {
#pragma unroll
    for (int s = 0; s < 4; ++s) kf[s] = *(const bf16x8*)(kp + 16 * s);
#pragma unroll
    for (int dt = 0; dt < 2; ++dt)
#pragma unroll
        for (int s = 0; s < 2; ++s) vf[dt][s] = *(const bf16x8*)(vp + (size_t)dt * 32 * SEQ + 16 * s);
}
DI void copy_kv(bf16x8 (&kf)[4], bf16x8 (&vf)[2][2], const bf16x8 (&nkf)[4], const bf16x8 (&nvf)[2][2]) {
#pragma unroll
    for (int s = 0; s < 4; ++s) kf[s] = nkf[s];
#pragma unroll
    for (int dt = 0; dt < 2; ++dt)
#pragma unroll
        for (int s = 0; s < 2; ++s) vf[dt][s] = nvf[dt][s];
}

DI void sb_unit(const Args& a, int b, int h, int qb, int lane) {
    const bf16* proj = (const bf16*)(a.ws + WS_A);
    const int c = lane & 31, hh = lane >> 5, pr = pi32(c);
    const size_t tokq = (size_t)b * SEQ + qb * 32 + c;
    const bf16* qp = proj + tokq * PW + C_BQ + h * 64 + 8 * hh;
    bf16x8 qf[4];
#pragma unroll
    for (int s = 0; s < 4; ++s) qf[s] = *(const bf16x8*)(qp + 16 * s);
    f32x16 o0 = zero16(), o1 = zero16(); float R = 1.f;
    const bool slot0lo = (__builtin_amdgcn_permlane32_swap((unsigned)hh, (unsigned)hh, false, false)[0] == 0u);
    const bf16* kbase = proj + (size_t)b * SEQ * PW + C_BK + h * 64 + 8 * hh;
    const bf16* vb0 = (const bf16*)(a.ws + WS_VTB) + ((size_t)(b * 4 + h) * 64 + c) * SEQ + 8 * hh;
    bf16x8 kf[4], vf[2][2];
    load_kv(kf, vf, kbase + (size_t)(qb * 32 + pr) * PW, vb0 + qb * 32);
    for (int kt = qb; kt >= 0; --kt) {
        bf16x8 nkf[4], nvf[2][2];
        { const int kn = (kt > 0) ? kt - 1 : 0; load_kv(nkf, nvf, kbase + (size_t)(kn * 32 + pr) * PW, vb0 + kn * 32); }
        f32x16 x = zero16();
#pragma unroll
        for (int s = 0; s < 4; ++s) x = mfma32(kf[s], qf[s], x);
        const bool diag = (kt == qb);
        float rr[16], ex[16], T[2];
#pragma unroll
        for (int i = 0; i < 16; ++i) { float rv = frcp(1.f + fexp2(x[i])); if (diag && kofs(i, hh) >= c) rv = 1.f; rr[i] = rv; }
#pragma unroll
        for (int s = 0; s < 2; ++s) { ex[8 * s + 7] = 1.f;
#pragma unroll
            for (int j = 6; j >= 0; --j) ex[8 * s + j] = ex[8 * s + j + 1] * rr[8 * s + j + 1];
            T[s] = ex[8 * s] * rr[8 * s]; }
        const auto r0_ = __builtin_amdgcn_permlane32_swap(__float_as_uint(T[0]), __float_as_uint(T[0]), false, false), r1_ = __builtin_amdgcn_permlane32_swap(__float_as_uint(T[1]), __float_as_uint(T[1]), false, false);
        const float PT0 = __uint_as_float((hh != 0) == slot0lo ? r0_[0] : r0_[1]), PT1 = __uint_as_float((hh != 0) == slot0lo ? r1_[0] : r1_[1]);
        float suf0, suf1;
        if (hh == 0) { suf1 = R * PT1; suf0 = suf1 * T[1] * PT0; } else { suf1 = R; suf0 = R * T[1] * PT1; }
        R = R * (T[0] * T[1]) * (PT0 * PT1);
        float p[16];
#pragma unroll
        for (int i = 0; i < 16; ++i) p[i] = (1.f - rr[i]) * ex[i] * (i < 8 ? suf0 : suf1);
        const bf16x8 pb0 = pack_p(p, 0), pb1 = pack_p(p, 1);
        o0 = mfma32(vf[0][0], pb0, o0); o0 = mfma32(vf[0][1], pb1, o0);
        o1 = mfma32(vf[1][0], pb0, o1); o1 = mfma32(vf[1][1], pb1, o1);
        copy_kv(kf, vf, nkf, nvf);
    }
    store_ot((bf16*)(a.ws + WS_B) + tokq * DM + 256 + h * 64, o0, o1, 1.f, hh);
}

DI void fg_unit(const Args& a, int b, int h, int qb, int lane) {
    const bf16* proj = (const bf16*)(a.ws + WS_A);
    const int c = lane & 31, hh = lane >> 5, pr = pi32(c);
    const size_t tokq = (size_t)b * SEQ + qb * 32 + c;
    const bf16* qp = proj + tokq * PW + C_CQ + h * 64 + 8 * hh;
    bf16x8 qf[4];
#pragma unroll
    for (int s = 0; s < 4; ++s) qf[s] = *(const bf16x8*)(qp + 16 * s);
    const float* cum = (const float*)(a.ws + WS_CUM) + (size_t)(b * 4 + h) * SEQ;
    const float cq = cum[qb * 32 + c];
    f32x16 o0 = zero16(), o1 = zero16(); float m = -1.0e30f, l = 0.f;
    const bf16* kbase = proj + (size_t)b * SEQ * PW + C_CK + h * 64 + 8 * hh;
    const bf16* vb0 = (const bf16*)(a.ws + WS_VTC) + ((size_t)(b * 4 + h) * 64 + c) * SEQ + 8 * hh;
    bf16x8 kf[4], vf[2][2];
    load_kv(kf, vf, kbase + (size_t)pr * PW, vb0);
    for (int kt = 0; kt <= qb; ++kt) {
        const int k0 = kt * 32;
        bf16x8 nkf[4], nvf[2][2];
        { const int kn = (kt < qb) ? kt + 1 : kt; load_kv(nkf, nvf, kbase + (size_t)(kn * 32 + pr) * PW, vb0 + kn * 32); }
        float ck[16];
#pragma unroll
        for (int s = 0; s < 2; ++s) { const f32x4 c0 = *(const f32x4*)(cum + k0 + 16 * s + 8 * hh), c1 = *(const f32x4*)(cum + k0 + 16 * s + 8 * hh + 4);
            ck[8 * s] = c0.x; ck[8 * s + 1] = c0.y; ck[8 * s + 2] = c0.z; ck[8 * s + 3] = c0.w; ck[8 * s + 4] = c1.x; ck[8 * s + 5] = c1.y; ck[8 * s + 6] = c1.z; ck[8 * s + 7] = c1.w; }
        f32x16 x = zero16();
#pragma unroll
        for (int s = 0; s < 4; ++s) x = mfma32(kf[s], qf[s], x);
        const bool diag = (kt == qb);
        float sv[16]; float tmax = -1.0e30f;
#pragma unroll
        for (int i = 0; i < 16; ++i) { const bool ok = !(diag && kofs(i, hh) > c); sv[i] = ok ? (x[i] + (cq - ck[i])) : -1.0e30f; tmax = fmaxf(tmax, sv[i]); }
        tmax = red32_max(tmax);
        const float mn = fmaxf(m, tmax), al = fexp2(m - mn);
        float p[16]; float ls = 0.f;
#pragma unroll
        for (int i = 0; i < 16; ++i) { p[i] = (sv[i] > -1.0e29f) ? fexp2(sv[i] - mn) : 0.f; ls += p[i]; }
        l = l * al + ls; m = mn;
#pragma unroll
        for (int i = 0; i < 16; ++i) { o0[i] *= al; o1[i] *= al; }
        const bf16x8 pb0 = pack_p(p, 0), pb1 = pack_p(p, 1);
        o0 = mfma32(vf[0][0], pb0, o0); o0 = mfma32(vf[0][1], pb1, o0);
        o1 = mfma32(vf[1][0], pb0, o1); o1 = mfma32(vf[1][1], pb1, o1);
        copy_kv(kf, vf, nkf, nvf);
    }
    const float lt = red32_sum(l);
    store_ot((bf16*)(a.ws + WS_B) + tokq * DM + 512 + h * 64, o0, o1, 1.f / lt, hh);
}


DI void atile_load(u32x4& reg, const bf16* kt0, const bf16* vt0, int kt, int tid) {
    reg = (tid < 256) ? *(const u32x4*)(kt0 + (size_t)kt * 2048 + tid * 8) : *(const u32x4*)(vt0 + (size_t)kt * 2048 + (tid - 256) * 8);
}
DI void atile_store(LAS unsigned char* buf, const u32x4& reg, int tid) { *(LAS u32x4*)(buf + tid * 16) = reg; }
DI void atile_frags(bf16x8 (&kf)[4], bf16x8 (&vf)[2][2], const LAS unsigned char* buf, int c, int hh, int prow) {
    (void)prow;
#pragma unroll
    for (int s = 0; s < 4; ++s) kf[s] = *(const LAS bf16x8*)(buf + ((2 * s + hh) * 32 + c) * 16);
#pragma unroll
    for (int dt = 0; dt < 2; ++dt)
#pragma unroll
        for (int s = 0; s < 2; ++s) vf[dt][s] = *(const LAS bf16x8*)(buf + 4096 + ((dt * 2 + s) * 64 + hh * 32 + c) * 16);
}
template <int MIXER>
DI void sbfg_block(const Args& a, int l, int b, int h, int QB, LAS unsigned char* lds, int tid, int wave, int lane) {
    const bf16* proj = (const bf16*)(a.ws + WS_A);
    const int c = lane & 31, hh = lane >> 5, pr = pi32(c);
    const int ntile = 8 * QB + 8, qb = 8 * QB + wave;
    const size_t tokq = (size_t)b * SEQ + qb * 32 + c;
    const bf16* qp = proj + tokq * PW + (MIXER == 0 ? C_BQ : C_CQ) + h * 64 + 8 * hh;
    bf16x8 qf[4];
#pragma unroll
    for (int s = 0; s < 4; ++s) qf[s] = *(const bf16x8*)(qp + 16 * s);
    const bf16* krow0 = (const bf16*)(a.ws + (MIXER == 0 ? WS_KTB : WS_KTC)) + (size_t)(b * 4 + h) * (SEQ / 32) * 2048;
    const bf16* vt0 = (const bf16*)(a.ws + (MIXER == 0 ? WS_VTB : WS_VTC)) + (size_t)(b * 4 + h) * (SEQ / 32) * 2048;
    const float* cum = (const float*)(a.ws + WS_CUM) + (size_t)(b * 4 + h) * SEQ;
    const float cq = (MIXER == 1) ? cum[qb * 32 + c] : 0.f;
    float Bq = 0.f;
    if (MIXER == 1) { float qs = 0.f;
#pragma unroll
        for (int s = 0; s < 4; ++s) { const u32x4 w = __builtin_bit_cast(u32x4, qf[s]);
            qs += bflo(w.x) * bflo(w.x) + bfhi(w.x) * bfhi(w.x) + bflo(w.y) * bflo(w.y) + bfhi(w.y) * bfhi(w.y) + bflo(w.z) * bflo(w.z) + bfhi(w.z) * bfhi(w.z) + bflo(w.w) * bflo(w.w) + bfhi(w.w) * bfhi(w.w); }
        qs = red32_sum(qs);
        const float k2 = __uint_as_float(((const unsigned*)(a.ws + WS_CTL))[CW_KMAX + l * 32 + b * 4 + h]);
        Bq = sqrtf(qs * k2) * 1.01f + 0.5f; }
    f32x16 o0 = zero16(), o1 = zero16(); float R = 1.f, m = -1.0e30f, l_ = 0.f;
    const bool slot0lo = (__builtin_amdgcn_permlane32_swap((unsigned)hh, (unsigned)hh, false, false)[0] == 0u);
    u32x4 reg;
    atile_load(reg, krow0, vt0, ntile - 1, tid); atile_store(lds, reg, tid);
    if (ntile > 1) { atile_load(reg, krow0, vt0, ntile - 2, tid); atile_store(lds + 8192, reg, tid); }
    __syncthreads();
    bf16x8 kfA[4], vfA[2][2], kfB[4], vfB[2][2];
    atile_frags(kfA, vfA, lds, c, hh, pr);
    int st = 0;
#define SBFG_STEP(JJ, KF, VF, NKF, NVF) { \
        const int kt = ntile - 1 - (JJ); \
        const int st1 = (st == 2) ? 0 : st + 1, st2 = (st1 == 2) ? 0 : st1 + 1; \
        if ((JJ) + 2 < ntile) atile_load(reg, krow0, vt0, kt - 2, tid); \
        if ((JJ) + 1 < ntile) atile_frags(NKF, NVF, lds + st1 * 8192, c, hh, pr); \
        if (kt <= qb) { \
            f32x16 x = zero16(); \
_Pragma("unroll") \
            for (int s = 0; s < 4; ++s) x = mfma32(KF[s], qf[s], x); \
            const bool diag = (kt == qb); \
            float p[16]; \
            if (MIXER == 0) { \
                float rr[16], ex[16], T[2]; \
_Pragma("unroll") \
                for (int i = 0; i < 16; ++i) rr[i] = frcp(1.f + fexp2(x[i])); \
                if (diag) { \
_Pragma("unroll") \
                    for (int i = 0; i < 16; ++i) if (kofs(i, hh) >= c) rr[i] = 1.f; \
                } \
_Pragma("unroll") \
                for (int s = 0; s < 2; ++s) { ex[8 * s + 7] = 1.f; \
_Pragma("unroll") \
                    for (int q = 6; q >= 0; --q) ex[8 * s + q] = ex[8 * s + q + 1] * rr[8 * s + q + 1]; \
                    T[s] = ex[8 * s] * rr[8 * s]; } \
                const auto r0_ = __builtin_amdgcn_permlane32_swap(__float_as_uint(T[0]), __float_as_uint(T[0]), false, false), r1_ = __builtin_amdgcn_permlane32_swap(__float_as_uint(T[1]), __float_as_uint(T[1]), false, false); \
                const float PT0 = __uint_as_float((hh != 0) == slot0lo ? r0_[0] : r0_[1]), PT1 = __uint_as_float((hh != 0) == slot0lo ? r1_[0] : r1_[1]); \
                float suf0, suf1; \
                if (hh == 0) { suf1 = R * PT1; suf0 = suf1 * T[1] * PT0; } else { suf1 = R; suf0 = R * T[1] * PT1; } \
                R = R * (T[0] * T[1]) * (PT0 * PT1); \
_Pragma("unroll") \
                for (int i = 0; i < 16; ++i) p[i] = (ex[i] - ex[i] * rr[i]) * (i < 8 ? suf0 : suf1); \
            } else { \
                const int k0 = kt * 32; \
                float ck[16]; \
_Pragma("unroll") \
                for (int s = 0; s < 2; ++s) { const f32x4 c0 = *(const f32x4*)(cum + k0 + 16 * s + 8 * hh), c1 = *(const f32x4*)(cum + k0 + 16 * s + 8 * hh + 4); \
                    ck[8 * s] = c0.x; ck[8 * s + 1] = c0.y; ck[8 * s + 2] = c0.z; ck[8 * s + 3] = c0.w; ck[8 * s + 4] = c1.x; ck[8 * s + 5] = c1.y; ck[8 * s + 6] = c1.z; ck[8 * s + 7] = c1.w; } \
                float sv[16]; float tmax = -1.0e30f; \
_Pragma("unroll") \
                for (int i = 0; i < 16; ++i) sv[i] = x[i] + (cq - ck[i]); \
                if (diag) { \
_Pragma("unroll") \
                    for (int i = 0; i < 16; ++i) if (kofs(i, hh) > c) sv[i] = -1.0e30f; \
                } \
_Pragma("unroll") \
                for (int i = 0; i < 16; ++i) tmax = fmaxf(tmax, sv[i]); \
                tmax = red32_max(tmax); \
                if (__any(tmax > m)) { \
                    const float mn = fmaxf(m, tmax), al = fexp2(m - mn); m = mn; l_ *= al; \
_Pragma("unroll") \
                    for (int i = 0; i < 16; ++i) { o0[i] *= al; o1[i] *= al; } \
                } \
                float ls = 0.f; \
_Pragma("unroll") \
                for (int i = 0; i < 16; ++i) { p[i] = fexp2(sv[i] - m); ls += p[i]; } \
                l_ += ls; \
            } \
            const bf16x8 pb0 = pack_p(p, 0), pb1 = pack_p(p, 1); \
            o0 = mfma32(VF[0][0], pb0, o0); o0 = mfma32(VF[0][1], pb1, o0); \
            o1 = mfma32(VF[1][0], pb0, o1); o1 = mfma32(VF[1][1], pb1, o1); \
        } \
        if ((JJ) + 2 < ntile) atile_store(lds + st2 * 8192, reg, tid); \
        __syncthreads(); \
        st = st1; \
    }
    LAS unsigned* dflag = (LAS unsigned*)(lds + 24576);
    for (int j = 0; j < ntile; j += 2) {
        SBFG_STEP(j, kfA, vfA, kfB, vfB)
        {
            const int ktj = ntile - 1 - j; const bool started = ktj <= qb;
            bool fin;
            if (MIXER == 0) fin = started && __all(R < 1.0e-12f);
            else { const float cn = (ktj >= 1) ? cum[32 * ktj - 1] : 0.f; fin = started && (ktj >= 1) && __all(Bq + (cq - cn) < m - 40.f); }
            if (lane == 0) dflag[((j >> 1) & 1) * 8 + wave] = fin ? 1u : 0u;
        }
        SBFG_STEP(j + 1, kfB, vfB, kfA, vfA)
        {
            const u32x4 f0 = *(const LAS u32x4*)(dflag + ((j >> 1) & 1) * 8), f1 = *(const LAS u32x4*)(dflag + ((j >> 1) & 1) * 8 + 4);
            if ((f0.x & f0.y & f0.z & f0.w & f1.x & f1.y & f1.z & f1.w) != 0u) break;
        }
    }
#undef SBFG_STEP
    if (MIXER == 0) store_ot((bf16*)(a.ws + WS_B) + tokq * DM + 256 + h * 64, o0, o1, 1.f, hh);
    else { const float lt = red32_sum(l_); store_ot((bf16*)(a.ws + WS_B) + tokq * DM + 512 + h * 64, o0, o1, 1.f / lt, hh); }
}

DI void osm_step(const f32x16& x, int lo, int hi, int hh, float& m, float& l, f32x16& o0, f32x16& o1, const bf16x8 (&vf)[2][2]) {
    float sv[16]; float tmax = -3.0e38f;
#pragma unroll
    for (int i = 0; i < 16; ++i) { const int ko = kofs(i, hh); sv[i] = (ko <= hi && ko >= lo) ? x[i] : -3.0e38f; tmax = fmaxf(tmax, sv[i]); }
    tmax = red32_max(tmax);
    if (__any(tmax > m)) { const float mn = fmaxf(m, tmax), al = fexp2(m - mn); m = mn; l *= al;
#pragma unroll
        for (int i = 0; i < 16; ++i) { o0[i] *= al; o1[i] *= al; } }
    float p[16]; float ls = 0.f;
#pragma unroll
    for (int i = 0; i < 16; ++i) { p[i] = fexp2(sv[i] - m); ls += p[i]; }
    l += ls;
    const bf16x8 pb0 = pack_p(p, 0), pb1 = pack_p(p, 1);
    o0 = mfma32(vf[0][0], pb0, o0); o0 = mfma32(vf[0][1], pb1, o0);
    o1 = mfma32(vf[1][0], pb0, o1); o1 = mfma32(vf[1][1], pb1, o1);
}

DI void ld_k4(bf16x8 (&kf)[4], const bf16* kp) {
#pragma unroll
    for (int s = 0; s < 4; ++s) kf[s] = *(const bf16x8*)(kp + 16 * s);
}
DI void ld_v4(bf16x8 (&vf)[2][2], const bf16* vp, int vpitch) {
#pragma unroll
    for (int dt = 0; dt < 2; ++dt)
#pragma unroll
        for (int s = 0; s < 2; ++s) vf[dt][s] = *(const bf16x8*)(vp + (size_t)dt * 32 * vpitch + 16 * s);
}
DI void ld_kt(bf16x8 (&kf)[4], const bf16* tile, int c, int hh) {
#pragma unroll
    for (int s = 0; s < 4; ++s) kf[s] = *(const bf16x8*)(tile + ((2 * s + hh) * 32 + c) * 8);
}
DI void ld_vt(bf16x8 (&vf)[2][2], const bf16* tile, int c, int hh) {
#pragma unroll
    for (int dt = 0; dt < 2; ++dt)
#pragma unroll
        for (int s = 0; s < 2; ++s) vf[dt][s] = *(const bf16x8*)(tile + ((dt * 2 + s) * 64 + hh * 32 + c) * 8);
}
DI unsigned wave_max_u(unsigned v) {
    v = max(v, (unsigned)DPPI((int)v, 0xB1, 0xF, true)); v = max(v, (unsigned)DPPI((int)v, 0x4E, 0xF, true));
    v = max(v, (unsigned)DPPI((int)v, 0x124, 0xF, true)); v = max(v, (unsigned)DPPI((int)v, 0x128, 0xF, true));
    { const auto r = __builtin_amdgcn_permlane16_swap(v, v, false, false); v = max(r[0], r[1]); const auto q = __builtin_amdgcn_permlane32_swap(v, v, false, false); v = max(q[0], q[1]); }
    return v;
}
DI void nsa_unit(const Args& a, int unit, LAS unsigned char* wl, int lane) {
    const bf16* proj = (const bf16*)(a.ws + WS_A);
    const int tok0 = unit * 8, b = tok0 / SEQ, t0 = tok0 % SEQ;
    const int c = lane & 31, hh = lane >> 5, ql = c >> 2, hd = c & 3, pr = pi32(c);
    const int tq = t0 + ql; const size_t tokq = (size_t)tok0 + ql;
    const bf16* qp = proj + tokq * PW + C_AQ + hd * 64 + 8 * hh;
    bf16x8 qf[4];
#pragma unroll
    for (int s = 0; s < 4; ++s) qf[s] = *(const bf16x8*)(qp + 16 * s);
    LAS float* imp = (LAS float*)wl; LAS unsigned* selm = (LAS unsigned*)(wl + 4096); LAS unsigned char* blist = (LAS unsigned char*)(wl + 4096 + 128);
    for (int i = lane; i < 1024; i += 64) imp[i] = 0.f;
    const float* gate = (const float*)(a.ws + WS_GATE) + tokq * 12 + hd * 3;
    const float g0 = gate[0], g1 = gate[1], g2 = gate[2];
    f32x16 of0 = zero16(), of1 = zero16();
    {
        const bf16* kc = (const bf16*)(a.ws + WS_KCMP) + (size_t)b * 16 * 2048;
        const bf16* vt = (const bf16*)(a.ws + WS_VTCMP) + (size_t)b * 16 * 2048;
        const int nmaxq = (tq >= 31) ? ((tq - 31) >> 4) : -1;
        const int nmaxu = (t0 + 7 >= 31) ? ((t0 + 7 - 31) >> 4) : -1;
        const int ntile = (nmaxu >> 5) + 1;
        float m = -1.0e30f, l = 0.f;
        bf16x8 kf[4], nkf[4];
        if (ntile > 0) ld_kt(kf, kc, c, hh);
        for (int kt = 0; kt < ntile; ++kt) {
            ld_kt(nkf, kc + (size_t)(kt + 1 < ntile ? kt + 1 : kt) * 2048, c, hh);
            f32x16 x = zero16();
#pragma unroll
            for (int s = 0; s < 4; ++s) x = mfma32(kf[s], qf[s], x);
            const int lim = nmaxq - kt * 32; float sv[16]; float tmax = -3.0e38f;
#pragma unroll
            for (int i = 0; i < 16; ++i) { sv[i] = (kofs(i, hh) <= lim) ? x[i] : -3.0e38f; tmax = fmaxf(tmax, sv[i]); }
            tmax = red32_max(tmax);
            const float mn = fmaxf(m, tmax); float ls = 0.f;
#pragma unroll
            for (int i = 0; i < 16; ++i) ls += fexp2(sv[i] - mn);
            l = l * fexp2(m - mn) + ls; m = mn;
#pragma unroll
            for (int s = 0; s < 4; ++s) kf[s] = nkf[s];
        }
        const float lt = red32_sum(l);
        const float inv = 1.f / fmaxf(lt, 1.0e-30f);
        f32x16 o0 = zero16(), o1 = zero16();
        LDS_WAIT();
        bf16x8 vf[2][2], nvf[2][2];
        if (ntile > 0) { ld_kt(kf, kc, c, hh); ld_vt(vf, vt, c, hh); }
        for (int kt = 0; kt < ntile; ++kt) {
            { const int kn = (kt + 1 < ntile ? kt + 1 : kt); ld_kt(nkf, kc + (size_t)kn * 2048, c, hh); ld_vt(nvf, vt + (size_t)kn * 2048, c, hh); }
            f32x16 x = zero16();
#pragma unroll
            for (int s = 0; s < 4; ++s) x = mfma32(kf[s], qf[s], x);
            float p[16], ps[16];
#pragma unroll
            for (int i = 0; i < 16; ++i) { p[i] = (kofs(i, hh) <= nmaxq - kt * 32) ? fexp2(x[i] - m) * inv : 0.f;
                float t = p[i]; t += dpp_xor1(t); t += dpp_xor2(t); ps[i] = t; }
            if (hd == 0) {
#pragma unroll
                for (int s = 0; s < 2; ++s) { const int gb = (kt * 32 + 16 * s + 8 * hh) >> 2; LAS float* ip = imp + ql * 128 + gb;
                    __hip_atomic_fetch_add(ip, (ps[8 * s] + ps[8 * s + 1]) + (ps[8 * s + 2] + ps[8 * s + 3]), __ATOMIC_RELAXED, __HIP_MEMORY_SCOPE_WORKGROUP);
                    __hip_atomic_fetch_add(ip + 1, ps[8 * s + 3] + (ps[8 * s + 4] + ps[8 * s + 5]) + (ps[8 * s + 6] + ps[8 * s + 7]), __ATOMIC_RELAXED, __HIP_MEMORY_SCOPE_WORKGROUP);
                    if (gb + 2 < 128) __hip_atomic_fetch_add(ip + 2, ps[8 * s + 7], __ATOMIC_RELAXED, __HIP_MEMORY_SCOPE_WORKGROUP); }
            }
            const bf16x8 pb0 = pack_p(p, 0), pb1 = pack_p(p, 1);
            o0 = mfma32(vf[0][0], pb0, o0); o0 = mfma32(vf[0][1], pb1, o0);
            o1 = mfma32(vf[1][0], pb0, o1); o1 = mfma32(vf[1][1], pb1, o1);
            copy_kv(kf, vf, nkf, nvf);
        }
#pragma unroll
        for (int i = 0; i < 16; ++i) { of0[i] = g0 * o0[i]; of1[i] = g0 * o1[i]; }
    }
    LDS_WAIT();
    for (int qi = 0; qi < 8; ++qi) {
        const int qblk = (t0 + qi) >> 6;
        const LAS float* iq = imp + qi * 128;
        const int b0 = lane, b1 = lane + 64;
        const bool ad0 = b0 <= qblk, ad1 = b1 <= qblk;
        const bool f0 = (b0 == 0) || (b0 == qblk) || (b0 == qblk - 1), f1 = (b1 == qblk) || (b1 == qblk - 1);
        unsigned v0 = ad0 ? __float_as_uint(f0 ? iq[b0] + 1.0e6f : iq[b0]) + 1u : 0u, v1 = ad1 ? __float_as_uint(f1 ? iq[b1] + 1.0e6f : iq[b1]) + 1u : 0u;
        unsigned long long m0 = 0ull, m1 = 0ull;
        const int nsel = (qblk + 1 < 16) ? qblk + 1 : 16;
        for (int r = 0; r < nsel; ++r) {
            const unsigned mx = wave_max_u(max(v0, v1));
            const unsigned long long e0 = __ballot(v0 == mx);
            if (e0) { const int idx = __builtin_ctzll(e0); m0 |= 1ull << idx; if (lane == idx) v0 = 0u; }
            else { const unsigned long long e1 = __ballot(v1 == mx); const int idx = __builtin_ctzll(e1); m1 |= 1ull << idx; if (lane == idx) v1 = 0u; }
        }
        if (lane == 0) { selm[qi * 4] = (unsigned)m0; selm[qi * 4 + 1] = (unsigned)(m0 >> 32); selm[qi * 4 + 2] = (unsigned)m1; selm[qi * 4 + 3] = (unsigned)(m1 >> 32); }
    }
    LDS_WAIT();
    {
        unsigned mk[4], um[4]; int nb = 0;
#pragma unroll
        for (int w = 0; w < 4; ++w) { mk[w] = selm[ql * 4 + w]; unsigned u = 0;
#pragma unroll
            for (int q = 0; q < 8; ++q) u |= selm[q * 4 + w];
            um[w] = (unsigned)__builtin_amdgcn_readfirstlane((int)u); }
#pragma unroll
        for (int w = 0; w < 4; ++w) { const unsigned u = um[w]; const int l32 = lane & 31;
            if (lane < 32 && ((u >> l32) & 1u)) blist[nb + __builtin_popcount(u & ((1u << l32) - 1u))] = (unsigned char)(32 * w + l32);
            nb += __builtin_popcount(u); }
        LDS_WAIT();
        const bf16* kbase = (const bf16*)(a.ws + WS_KTS) + (size_t)b * (SEQ / 32) * 2048;
        const bf16* vb0 = (const bf16*)(a.ws + WS_VTAS) + (size_t)b * (SEQ / 32) * 2048;
        f32x16 o0 = zero16(), o1 = zero16(); float m = -1.0e30f, l = 0.f;
        const int nt = 2 * nb;
        bf16x8 kf[4], vf[2][2], nkf[4], nvf[2][2];
        int blk = blist[0];
        { const int t0i = blk * 2; ld_kt(kf, kbase + (size_t)t0i * 2048, c, hh); ld_vt(vf, vb0 + (size_t)t0i * 2048, c, hh); }
#define NSA_SEL_STEP(TT, KF, VF, NKF, NVF) { \
            const int k0 = blk * 64 + 32 * ((TT) & 1); \
            const int tn = ((TT) + 1 < nt) ? (TT) + 1 : (TT); const int blkn = blist[tn >> 1]; \
            { const int tni = blkn * 2 + (tn & 1); ld_kt(NKF, kbase + (size_t)tni * 2048, c, hh); ld_vt(NVF, vb0 + (size_t)tni * 2048, c, hh); } \
            const bool mysel = ((((blk >> 5) == 0 ? mk[0] : (blk >> 5) == 1 ? mk[1] : (blk >> 5) == 2 ? mk[2] : mk[3]) >> (blk & 31)) & 1u) != 0u; \
            f32x16 x = zero16(); \
            _Pragma("unroll") for (int s = 0; s < 4; ++s) x = mfma32(KF[s], qf[s], x); \
            osm_step(x, 0, mysel ? tq - k0 : -1, hh, m, l, o0, o1, VF); \
            blk = blkn; }
        for (int t = 0; t < nt; t += 2) {
            NSA_SEL_STEP(t, kf, vf, nkf, nvf)
            NSA_SEL_STEP(t + 1, nkf, nvf, kf, vf)
        }
#undef NSA_SEL_STEP
        const float lt = red32_sum(l); const float sc = g1 / fmaxf(lt, 1.0e-30f);
#pragma unroll
        for (int i = 0; i < 16; ++i) { of0[i] += sc * o0[i]; of1[i] += sc * o1[i]; }
    }
    {
        const bf16* kbase = (const bf16*)(a.ws + WS_KTW) + (size_t)b * (SEQ / 32) * 2048;
        const bf16* vb0 = (const bf16*)(a.ws + WS_VTAW) + (size_t)b * (SEQ / 32) * 2048;
        f32x16 o0 = zero16(), o1 = zero16(); float m = -1.0e30f, l = 0.f;
        const int klo = (t0 >= 511) ? ((t0 - 511) >> 5) : 0, khi = (t0 + 7) >> 5;
        bf16x8 kf[4], vf[2][2], nkf[4], nvf[2][2];
        ld_kt(kf, kbase + (size_t)klo * 2048, c, hh); ld_vt(vf, vb0 + (size_t)klo * 2048, c, hh);
        for (int kt = klo; kt <= khi; ++kt) {
            const int k0 = kt * 32;
            { const int kn = (kt < khi ? kt + 1 : kt); ld_kt(nkf, kbase + (size_t)kn * 2048, c, hh); ld_vt(nvf, vb0 + (size_t)kn * 2048, c, hh); }
            f32x16 x = zero16();
#pragma unroll
            for (int s = 0; s < 4; ++s) x = mfma32(kf[s], qf[s], x);
            osm_step(x, tq - 511 - k0, tq - k0, hh, m, l, o0, o1, vf);
            copy_kv(kf, vf, nkf, nvf);
        }
        const float lt = red32_sum(l); const float sc = g2 / fmaxf(lt, 1.0e-30f);
#pragma unroll
        for (int i = 0; i < 16; ++i) { of0[i] += sc * o0[i]; of1[i] += sc * o1[i]; }
    }
    store_ot((bf16*)(a.ws + WS_B) + tokq * DM + hd * 64, of0, of1, 1.f, hh);
}

#ifndef DSA_REP_S
#define DSA_REP_S 1
#define DSA_REP_L 1
#define DSA_REP_A 1
#endif
#ifndef DSA_REP_1
#define DSA_REP_1 1
#define DSA_REP_2 1
#define DSA_REP_3 1
#endif
constexpr int DSA_CIDX = 132096, DSA_LIST = DSA_CIDX + 16384, DSA_DUMMY = DSA_LIST + 8192;  static_assert(DSA_DUMMY + 8 * 128 <= MISC_OFF, "DSA LDS map");
static_assert(DSA_LIST + 8192 <= MISC_OFF, "DSA LDS map");
typedef short v4i16_t __attribute__((ext_vector_type(4)));
DI unsigned f2key(float f) { const unsigned u = __float_as_uint(f); return u ^ ((u >> 31) ? 0xffffffffu : 0x80000000u); }
DI int wave_excl_scan(int v, int lane) { (void)lane; return wave_incl_scan(v) - v; }
DI int wave_sum_i(int v) {
    v += DPPI(v, 0xB1, 0xF, true); v += DPPI(v, 0x4E, 0xF, true); v += DPPI(v, 0x124, 0xF, true); v += DPPI(v, 0x128, 0xF, true);
    const auto r = __builtin_amdgcn_permlane16_swap((unsigned)v, (unsigned)v, false, false); v = (int)(r[0] + r[1]);
    const auto q = __builtin_amdgcn_permlane32_swap((unsigned)v, (unsigned)v, false, false); return (int)(q[0] + q[1]);
}
template <int NR>
DI unsigned kth_regn(const unsigned (&k)[16], int K) {
    unsigned hi = 0u, lo = 0xffffffffu;
#pragma unroll
    for (int j = 0; j < NR; ++j) { hi = (k[j] > hi) ? k[j] : hi; const unsigned kk = k[j] ? k[j] : 0xffffffffu; lo = (kk < lo) ? kk : lo; }
    hi = max(hi, (unsigned)DPPI((int)hi, 0xB1, 0xF, true)); hi = max(hi, (unsigned)DPPI((int)hi, 0x4E, 0xF, true));
    lo = min(lo, (unsigned)__builtin_amdgcn_update_dpp((int)0xffffffff, (int)lo, 0xB1, 0xF, 0xF, false)); lo = min(lo, (unsigned)__builtin_amdgcn_update_dpp((int)0xffffffff, (int)lo, 0x4E, 0xF, 0xF, false));
    hi = max(hi, (unsigned)DPPI((int)hi, 0x124, 0xF, true)); hi = max(hi, (unsigned)DPPI((int)hi, 0x128, 0xF, true));
    lo = min(lo, (unsigned)__builtin_amdgcn_update_dpp((int)0xffffffff, (int)lo, 0x124, 0xF, 0xF, false)); lo = min(lo, (unsigned)__builtin_amdgcn_update_dpp((int)0xffffffff, (int)lo, 0x128, 0xF, 0xF, false));
    { const auto r = __builtin_amdgcn_permlane16_swap(hi, hi, false, false); hi = max(r[0], r[1]); const auto q = __builtin_amdgcn_permlane32_swap(hi, hi, false, false); hi = max(q[0], q[1]); }
    { const auto r = __builtin_amdgcn_permlane16_swap(lo, lo, false, false); lo = min(r[0], r[1]); const auto q = __builtin_amdgcn_permlane32_swap(lo, lo, false, false); lo = min(q[0], q[1]); }
    const unsigned diff = (unsigned)__builtin_amdgcn_readfirstlane((int)(hi ^ lo));
    if (diff == 0u) return (unsigned)__builtin_amdgcn_readfirstlane((int)hi);
    const int top = 31 - __builtin_clz(diff);
    unsigned prefix = (unsigned)__builtin_amdgcn_readfirstlane((int)hi) & ~((2u << top) - 1u);
#pragma unroll 1
    for (int bit = top; bit >= 0; --bit) {
        const unsigned cand = prefix | (1u << bit); int c = 0;
#pragma unroll
        for (int j = 0; j < NR; ++j) c += __builtin_popcountll(__ballot(k[j] >= cand));
        if (c >= K) prefix = cand;
    }
    return prefix;
}
DI unsigned kth_reg16(const unsigned (&k)[16], int K) { return kth_regn<16>(k, K); }
DI unsigned kth_disp(const unsigned (&k)[16], int K, int nr) { return nr <= 6 ? kth_regn<6>(k, K) : nr <= 8 ? kth_regn<8>(k, K) : nr <= 12 ? kth_regn<12>(k, K) : kth_regn<16>(k, K); }
DI void dsa_attend(const Args& a, const bf16* proj, int b, size_t tokq, const LAS unsigned short* list, int cnt, LAS unsigned char* stg, int lane) {
        const int col = lane & 15, quad = lane >> 4, hd = col & 3;
        const bf16* qp = proj + tokq * PW + C_DQ + hd * 64 + 8 * quad;
        const bf16x8 qb0 = *(const bf16x8*)qp, qb1 = *(const bf16x8*)(qp + 32);
        const bf16* krow0 = proj + (size_t)b * SEQ * PW + C_DK; const bf16* vrow0 = proj + (size_t)b * SEQ * PW + C_DV;
        const int grow_ = lane >> 3, piece_ = lane & 7;
        f32x4 o[4];
#pragma unroll
        for (int dt = 0; dt < 4; ++dt) o[dt] = (f32x4){0.f, 0.f, 0.f, 0.f};
        float mrun = -1.0e30f, ls = 0.f;
#pragma unroll 1
        for (int ch = 0; ch < 2; ++ch) {
            if (ch * 128 >= cnt) break;
            int grow = grow_, piece = piece_; asm volatile("" : "+v"(grow), "+v"(piece));
            u32x4 wk[16], wv[16];
#pragma unroll
            for (int it = 0; it < 16; ++it) { const int j = ch * 128 + it * 8 + grow; const unsigned kidx = (j < cnt) ? (unsigned)list[j] : 0u;
                wk[it] = *(const u32x4*)(krow0 + (size_t)kidx * PW + 8 * piece); wv[it] = *(const u32x4*)(vrow0 + (size_t)kidx * PW + 8 * piece); }
#pragma unroll
            for (int it = 0; it < 16; ++it) { const int row = it * 8 + grow; *(LAS u32x4*)(stg + row * 128 + ((piece ^ (row & 7)) * 16)) = wk[it]; }
            LDS_WAIT();
            float sr[8][4];
            {
                int colq = col, quadq = quad; asm volatile("" : "+v"(colq), "+v"(quadq));
#pragma unroll
                for (int kt = 0; kt < 8; ++kt) {
                    const int row = kt * 16 + colq;
                    const bf16x8 a0 = *(const LAS bf16x8*)(stg + row * 128 + ((quadq ^ (row & 7)) * 16)), a1 = *(const LAS bf16x8*)(stg + row * 128 + (((quadq + 4) ^ (row & 7)) * 16));
                    f32x4 d = (f32x4){0.f, 0.f, 0.f, 0.f};
                    d = mfma16(a0, qb0, d); d = mfma16(a1, qb1, d);
#pragma unroll
                    for (int i = 0; i < 4; ++i) sr[kt][i] = (ch * 128 + kt * 16 + 4 * quadq + i < cnt) ? d[i] : -1.0e30f;
                }
            }
            float mx = -1.0e30f;
#pragma unroll
            for (int kt = 0; kt < 8; ++kt)
#pragma unroll
                for (int i = 0; i < 4; ++i) mx = fmaxf(mx, sr[kt][i]);
            mx = red16_max(mx); mx = red32_max(mx);
            const float mn = fmaxf(mrun, mx), al = fexp2(mrun - mn); mrun = mn;
            float lc = 0.f;
#pragma unroll
            for (int kt = 0; kt < 8; ++kt)
#pragma unroll
                for (int i = 0; i < 4; ++i) { const float p = (sr[kt][i] > -1.0e29f) ? fexp2(sr[kt][i] - mn) : 0.f; sr[kt][i] = p; lc += p; }
            lc = red16_sum(lc); lc = red32_sum(lc);
            ls = ls * al + lc;
#pragma unroll
            for (int dt = 0; dt < 4; ++dt) o[dt] = o[dt] * al;
            LDS_WAIT();
#pragma unroll
            for (int it = 0; it < 16; ++it) { const int row = it * 8 + grow; *(LAS u32x4*)(stg + row * 128 + ((piece ^ (row & 7)) * 16)) = wv[it]; }
            LDS_WAIT();
            {
                int colp = col, quadp = quad; asm volatile("" : "+v"(colp), "+v"(quadp));
#pragma unroll
                for (int g = 0; g < 4; ++g) {
                    u32x4 pw; pw.x = cvtpk(sr[2 * g][0], sr[2 * g][1]); pw.y = cvtpk(sr[2 * g][2], sr[2 * g][3]); pw.z = cvtpk(sr[2 * g + 1][0], sr[2 * g + 1][1]); pw.w = cvtpk(sr[2 * g + 1][2], sr[2 * g + 1][3]);
                    const bf16x8 pb = __builtin_bit_cast(bf16x8, pw);
                    const int klo = 32 * g + 4 * quadp + (colp >> 2), khi = klo + 16;
#pragma unroll
                    for (int dt = 0; dt < 4; ++dt) { const int pc = 2 * dt + ((colp & 3) >> 1), bo = (colp & 1) * 8;
                        const v4i16_t lo = __builtin_amdgcn_ds_read_tr16_b64_v4i16((LAS v4i16_t*)(stg + klo * 128 + ((pc ^ (klo & 7)) * 16) + bo));
                        const v4i16_t hi = __builtin_amdgcn_ds_read_tr16_b64_v4i16((LAS v4i16_t*)(stg + khi * 128 + ((pc ^ (khi & 7)) * 16) + bo));
                        const bf16x8 av = (bf16x8){lo[0], lo[1], lo[2], lo[3], hi[0], hi[1], hi[2], hi[3]};
                        o[dt] = mfma16(av, pb, o[dt]); }
                }
            }
            LDS_WAIT();
        }
        if (col < 4) { const float inv = 1.f / ls; bf16* om = (bf16*)(a.ws + WS_B) + tokq * DM + 768 + hd * 64 + 4 * quad;
#pragma unroll
            for (int dt = 0; dt < 4; ++dt) { float v[4] = {o[dt][0] * inv, o[dt][1] * inv, o[dt][2] * inv, o[dt][3] * inv}; st4bf(om + 16 * dt, v); } }
    }

DI void dsa_attend2(const Args& a, const bf16* proj, int b, size_t tokA, const LAS unsigned short* listA, int cntA, size_t tokB, const LAS unsigned short* listB, int cntB, LAS unsigned char* stg, int lane) {
    const int col = lane & 15, quad = lane >> 4, hd = col & 3;
    const bf16* krow0 = proj + (size_t)b * SEQ * PW + C_DK; const bf16* vrow0 = proj + (size_t)b * SEQ * PW + C_DV;
    const int grow_ = lane >> 3, piece_ = lane & 7;
    const int ncA = (cntA + 63) >> 6, nc = ncA + ((cntB + 63) >> 6);
    bf16x8 qb0, qb1; f32x4 o[4]; float mrun = -1.0e30f, ls = 0.f;
    u32x4 wk0[8], wv0[8], wk1[8], wv1[8];
#define DSA_GATHER(WK, WV, CI) { const bool isb_ = (CI) >= ncA; const int ch_ = isb_ ? (CI) - ncA : (CI); const int cnt_ = isb_ ? cntB : cntA; const LAS unsigned short* li_ = isb_ ? listB : listA; \
        int grow = grow_, piece = piece_; asm volatile("" : "+v"(grow), "+v"(piece)); \
        _Pragma("unroll") for (int it = 0; it < 8; ++it) { const int j = ch_ * 64 + it * 8 + grow; const unsigned kidx = (j < cnt_) ? (unsigned)li_[j] : 0u; \
            WK[it] = *(const u32x4*)(krow0 + (size_t)kidx * PW + 8 * piece); WV[it] = *(const u32x4*)(vrow0 + (size_t)kidx * PW + 8 * piece); } }
#define DSA_CHUNK(WK, WV, CI) { const bool isb_ = (CI) >= ncA; const int ch_ = isb_ ? (CI) - ncA : (CI); const int cnt_ = isb_ ? cntB : cntA; \
        if (ch_ == 0) { const bf16* qp = proj + (isb_ ? tokB : tokA) * PW + C_DQ + hd * 64 + 8 * quad; qb0 = *(const bf16x8*)qp; qb1 = *(const bf16x8*)(qp + 32); mrun = -1.0e30f; ls = 0.f; \
            _Pragma("unroll") for (int dt = 0; dt < 4; ++dt) o[dt] = (f32x4){0.f, 0.f, 0.f, 0.f}; } \
        int grow = grow_, piece = piece_; asm volatile("" : "+v"(grow), "+v"(piece)); \
        _Pragma("unroll") for (int it = 0; it < 8; ++it) { const int row = it * 8 + grow; *(LAS u32x4*)(stg + row * 128 + ((piece ^ (row & 7)) * 16)) = WK[it]; } \
        LDS_WAIT(); \
        float sr[4][4]; \
        { int colq = col, quadq = quad; asm volatile("" : "+v"(colq), "+v"(quadq)); \
          _Pragma("unroll") for (int kt = 0; kt < 4; ++kt) { const int row = kt * 16 + colq; \
            const bf16x8 a0 = *(const LAS bf16x8*)(stg + row * 128 + ((quadq ^ (row & 7)) * 16)), a1 = *(const LAS bf16x8*)(stg + row * 128 + (((quadq + 4) ^ (row & 7)) * 16)); \
            f32x4 d = (f32x4){0.f, 0.f, 0.f, 0.f}; d = mfma16(a0, qb0, d); d = mfma16(a1, qb1, d); \
            _Pragma("unroll") for (int i = 0; i < 4; ++i) sr[kt][i] = (ch_ * 64 + kt * 16 + 4 * quadq + i < cnt_) ? d[i] : -3.0e38f; } } \
        float mx = -3.0e38f; \
        _Pragma("unroll") for (int kt = 0; kt < 4; ++kt) _Pragma("unroll") for (int i = 0; i < 4; ++i) mx = fmaxf(mx, sr[kt][i]); \
        mx = red16_max(mx); mx = red32_max(mx); \
        const float mn = fmaxf(mrun, mx), al = fexp2(mrun - mn); mrun = mn; \
        float lc = 0.f; \
        _Pragma("unroll") for (int kt = 0; kt < 4; ++kt) _Pragma("unroll") for (int i = 0; i < 4; ++i) { const float p = fexp2(sr[kt][i] - mn); sr[kt][i] = p; lc += p; } \
        lc = red16_sum(lc); lc = red32_sum(lc); ls = ls * al + lc; \
        _Pragma("unroll") for (int dt = 0; dt < 4; ++dt) o[dt] = o[dt] * al; \
        LDS_WAIT(); \
        _Pragma("unroll") for (int it = 0; it < 8; ++it) { const int row = it * 8 + grow; *(LAS u32x4*)(stg + row * 128 + ((piece ^ (row & 7)) * 16)) = WV[it]; } \
        LDS_WAIT(); \
        { int colp = col, quadp = quad; asm volatile("" : "+v"(colp), "+v"(quadp)); \
          _Pragma("unroll") for (int g = 0; g < 2; ++g) { \
            u32x4 pw; pw.x = cvtpk(sr[2 * g][0], sr[2 * g][1]); pw.y = cvtpk(sr[2 * g][2], sr[2 * g][3]); pw.z = cvtpk(sr[2 * g + 1][0], sr[2 * g + 1][1]); pw.w = cvtpk(sr[2 * g + 1][2], sr[2 * g + 1][3]); \
            const bf16x8 pb = __builtin_bit_cast(bf16x8, pw); \
            const int klo = 32 * g + 4 * quadp + (colp >> 2), khi = klo + 16; \
            _Pragma("unroll") for (int dt = 0; dt < 4; ++dt) { const int pc = 2 * dt + ((colp & 3) >> 1), bo = (colp & 1) * 8; \
                const v4i16_t lo = __builtin_amdgcn_ds_read_tr16_b64_v4i16((LAS v4i16_t*)(stg + klo * 128 + ((pc ^ (klo & 7)) * 16) + bo)); \
                const v4i16_t hi = __builtin_amdgcn_ds_read_tr16_b64_v4i16((LAS v4i16_t*)(stg + khi * 128 + ((pc ^ (khi & 7)) * 16) + bo)); \
                const bf16x8 av = (bf16x8){lo[0], lo[1], lo[2], lo[3], hi[0], hi[1], hi[2], hi[3]}; \
                o[dt] = mfma16(av, pb, o[dt]); } } } \
        LDS_WAIT(); \
        const int nch_ = isb_ ? nc - ncA : ncA; \
        if (ch_ == nch_ - 1 && col < 4) { const float inv = 1.f / ls; bf16* om = (bf16*)(a.ws + WS_B) + (isb_ ? tokB : tokA) * DM + 768 + hd * 64 + 4 * quad; \
            _Pragma("unroll") for (int dt = 0; dt < 4; ++dt) { float v[4] = {o[dt][0] * inv, o[dt][1] * inv, o[dt][2] * inv, o[dt][3] * inv}; st4bf(om + 16 * dt, v); } } }
    if (nc > 0) DSA_GATHER(wk0, wv0, 0)
    for (int ci = 0; ci < nc; ci += 2) {
        if (ci + 1 < nc) DSA_GATHER(wk1, wv1, ci + 1)
        DSA_CHUNK(wk0, wv0, ci)
        if (ci + 1 < nc) {
            if (ci + 2 < nc) DSA_GATHER(wk0, wv0, ci + 2)
            DSA_CHUNK(wk1, wv1, ci + 1)
        }
    }
#undef DSA_GATHER
#undef DSA_CHUNK
}

typedef unsigned short u16x2_t __attribute__((ext_vector_type(2)));
DI unsigned pkmax16(unsigned x, unsigned y) { return __builtin_bit_cast(unsigned, __builtin_elementwise_max(__builtin_bit_cast(u16x2_t, x), __builtin_bit_cast(u16x2_t, y))); }
DI unsigned f2key16s(float f) { const unsigned h = (unsigned)__builtin_bit_cast(unsigned short, (_Float16)f); return h ^ ((unsigned)((int)__float_as_uint(f) >> 31) | 0x8000u); }
DI unsigned f2key16(float f) { const unsigned h = (unsigned)__builtin_bit_cast(unsigned short, (_Float16)f); return (h & 0x8000u) ? (~h & 0xffffu) : (h | 0x8000u); }
template <int NR>
DI int dsa_pick(const LAS unsigned short* s16, const LAS unsigned short* cidx, LAS unsigned short* list, int c, int lane, unsigned long long ltm, unsigned& tau) {
    unsigned ck[16], ixs[16];
#pragma unroll
    for (int j = 0; j < 16; ++j) { ck[j] = 0u; ixs[j] = 0u; }
#pragma unroll
    for (int j = 0; j < NR; ++j) ixs[j] = (unsigned)cidx[j * 64 + lane];
#pragma unroll
    for (int j = 0; j < NR; ++j) ixs[j] = (j * 64 + lane < c) ? ixs[j] : 0u;
#pragma unroll
    for (int j = 0; j < NR; ++j) ck[j] = (unsigned)s16[ixs[j]];
#pragma unroll
    for (int j = 0; j < NR; ++j) ck[j] = (j * 64 + lane < c) ? ck[j] : 0u;
    tau = kth_regn<NR>(ck, 256);
    int cg = 0;
#pragma unroll
    for (int j = 0; j < NR; ++j) cg += (ck[j] > tau) ? 1 : 0;
    const int krem = 256 - wave_sum_i(cg);
    int total = 0, eqt = 0;
#pragma unroll
    for (int j = 0; j < NR; ++j) {
        if (j * 64 < c) {
            const bool gt = ck[j] > tau, eq = ck[j] == tau;
            const unsigned long long eqm = __ballot(eq); const int eqp = __popcll(eqm & ltm);
            const bool take = gt || (eq && (eqt + eqp < krem));
            const unsigned long long tm = __ballot(take); const int pos = total + __popcll(tm & ltm);
            if (take) list[pos] = (unsigned short)ixs[j];
            total += __popcll(tm); eqt += __popcll(eqm);
        }
    }
    return total;
}
DI void dsa_unit16(const Args& a, int pu, LAS unsigned char* lds, int wave, int lane) {
    const bf16* proj = (const bf16*)(a.ws + WS_A);
    const int b = pu >> 9, p = pu & 511;
    const int tA0 = 8 * p, tB0 = 8184 - 8 * p, nA = tA0 + 8, nB = tB0 + 8;
    const int na32 = (nA + 31) & ~31, nb32 = (nB + 31) & ~31;
    LAS unsigned short* sc = (LAS unsigned short*)lds;
    {
        const int c = lane & 31, hh = lane >> 5, qr = c >> 2, hr = c & 3;
        const size_t tokA = (size_t)b * SEQ + tA0, tokB = (size_t)b * SEQ + tB0;
        bf16x8 iqA[4], iqB[4];
#pragma unroll
        for (int s = 0; s < 4; ++s) { iqA[s] = *(const bf16x8*)(proj + (tokA + qr) * PW + C_DIQ + hr * 64 + 16 * s + 8 * hh); iqB[s] = *(const bf16x8*)(proj + (tokB + qr) * PW + C_DIQ + hr * 64 + 16 * s + 8 * hh); }
        f32x4 iwA[4], iwB[4];
#pragma unroll
        for (int g = 0; g < 4; ++g) { iwA[g] = *(const f32x4*)((const float*)(a.ws + WS_IW) + (tokA + 2 * g + hh) * 4); iwB[g] = *(const f32x4*)((const float*)(a.ws + WS_IW) + (tokB + 2 * g + hh) * 4); }
        const bf16* kb = (const bf16*)(a.ws + WS_IKT) + (size_t)b * (SEQ / 32) * 2048;
        const int ntA = na32 >> 5, ntB = nb32 >> 5;
        LAS unsigned short* dA = sc + hh * na32 + c; LAS unsigned short* dB = sc + 8 * na32 + hh * nb32 + c;
#define DSA_EPI(X, IW, T0, DST, PITCH, K0, MASK) { _Pragma("unroll") for (int g = 0; g < 4; ++g) { \
            const float r0 = __builtin_amdgcn_fmed3f(X[4 * g], 0.f, 3.0e38f), r1 = __builtin_amdgcn_fmed3f(X[4 * g + 1], 0.f, 3.0e38f); \
            const float r2 = __builtin_amdgcn_fmed3f(X[4 * g + 2], 0.f, 3.0e38f), r3 = __builtin_amdgcn_fmed3f(X[4 * g + 3], 0.f, 3.0e38f); \
            float a0 = __builtin_fmaf(IW[g].x, r0, 0.f), a1 = __builtin_fmaf(IW[g].y, r1, 0.f); a0 = __builtin_fmaf(IW[g].z, r2, a0); a1 = __builtin_fmaf(IW[g].w, r3, a1); \
            unsigned key = f2key16s(a0 + a1); if (MASK) key = ((K0) + c <= (T0) + 2 * g + hh) ? key : 0u; \
            (DST)[2 * g * (PITCH) + (K0)] = (unsigned short)key; } }
        bf16x8 kf[4], nkf[4];
        if (wave < ntB) ld_kt(kf, kb + (size_t)wave * 2048, c, hh);
        for (int kt = wave; kt < ntB; kt += NWAVES) {
            { const int kn = (kt + NWAVES < ntB) ? kt + NWAVES : kt; ld_kt(nkf, kb + (size_t)kn * 2048, c, hh); }
            const int k0 = kt * 32; const bool hasA = kt < ntA;
            f32x16 x = zero16(), y = zero16();
#pragma unroll
            for (int s = 0; s < 4; ++s) x = mfma32(iqB[s], kf[s], x);
            if (hasA) {
#pragma unroll
                for (int s = 0; s < 4; ++s) y = mfma32(iqA[s], kf[s], y);
            }
            if (k0 + 31 > tB0) DSA_EPI(x, iwB, tB0, dB, nb32, k0, true) else DSA_EPI(x, iwB, tB0, dB, nb32, k0, false)
            if (hasA) { if (k0 + 31 > tA0) DSA_EPI(y, iwA, tA0, dA, na32, k0, true) else DSA_EPI(y, iwA, tA0, dA, na32, k0, false) }
#pragma unroll
            for (int s = 0; s < 4; ++s) kf[s] = nkf[s];
        }
#undef DSA_EPI
    }
    __syncthreads();
    LAS unsigned short* cidx = (LAS unsigned short*)(lds + DSA_CIDX + wave * 2048);
    LAS unsigned short* dummy = (LAS unsigned short*)(lds + DSA_DUMMY + wave * 128) + lane;
    const unsigned long long ltm = (1ull << lane) - 1ull;
    int cntA = 0, cntB = 0;
#pragma unroll 1
    for (int blk = 0; blk < 2; ++blk) {
        const int tq = (blk ? tB0 : tA0) + wave, n = tq + 1, n32 = (blk ? nb32 : na32);
        const LAS unsigned short* s16 = sc + (blk ? 8 * na32 + wave * nb32 : wave * na32);
        LAS unsigned short* list = (LAS unsigned short*)(lds + DSA_LIST + (blk * 8 + wave) * 512);
        int cnt;
        if (n <= 256) { for (int i = lane; i < n; i += 64) list[i] = (unsigned short)i; cnt = n; }
        else {
            int c = 0;
            if (n <= 1024) { for (int i = lane; i < n; i += 64) cidx[i] = (unsigned short)i; c = n; }
            else {
                const bool cs4 = n <= 2048; unsigned M[16];
#pragma unroll
                for (int it = 0; it < 16; ++it) {
                    const int i8 = (cs4 ? (it >> 1) : it) * 512 + lane * 8; unsigned mx = 0u;
                    if (i8 < n32) { const u32x4 v = *(const LAS u32x4*)(s16 + i8);
                        if (cs4) { const unsigned m2 = (it & 1) ? pkmax16(v.z, v.w) : pkmax16(v.x, v.y); mx = max(m2 & 0xffffu, m2 >> 16); }
                        else { const unsigned m4 = pkmax16(pkmax16(v.x, v.y), pkmax16(v.z, v.w)); mx = max(m4 & 0xffffu, m4 >> 16); } }
                    if (cs4 && it >= 8) mx = 0u;
                    M[it] = mx;
                }
                const unsigned beta = kth_disp(M, 256, cs4 ? ((n32 + 255) >> 8) : ((n32 + 511) >> 9));
                for (int i0 = 0; i0 < n32; i0 += 512) {
                    const int i8 = i0 + lane * 8;
                    u32x4 v = (u32x4){0u, 0u, 0u, 0u}; if (i8 < n32) v = *(const LAS u32x4*)(s16 + i8);
                    const unsigned kk[8] = {v.x & 0xffffu, v.x >> 16, v.y & 0xffffu, v.y >> 16, v.z & 0xffffu, v.z >> 16, v.w & 0xffffu, v.w >> 16};
                    int fc = 0;
#pragma unroll
                    for (int k = 0; k < 8; ++k) fc += (kk[k] >= beta) ? 1 : 0;
                    const int inc = wave_incl_scan(fc); int pos = c + inc - fc;
#pragma unroll
                    for (int k = 0; k < 8; ++k) { const bool cd = kk[k] >= beta;
                        LAS unsigned short* d = (cd && pos < 1024) ? (cidx + pos) : dummy; *d = (unsigned short)(i8 + k); pos += cd ? 1 : 0; }
                    c += __builtin_amdgcn_readlane(inc, 63);
                }
                LDS_WAIT();
            }
            unsigned tau; bool fromc = (c <= 1024);
            if (fromc) {
                const int nr = (c + 63) >> 6;
                cnt = nr <= 6 ? dsa_pick<6>(s16, cidx, list, c, lane, ltm, tau) : nr <= 8 ? dsa_pick<8>(s16, cidx, list, c, lane, ltm, tau) : nr <= 12 ? dsa_pick<12>(s16, cidx, list, c, lane, ltm, tau) : dsa_pick<16>(s16, cidx, list, c, lane, ltm, tau);
            } else {
                tau = 0u;
                for (int bit = 15; bit >= 0; --bit) {
                    const unsigned cand = tau | (1u << bit); int cc = 0;
                    for (int i = lane; i < n; i += 64) cc += ((unsigned)s16[i] >= cand) ? 1 : 0;
                    if (wave_sum_i(cc) >= 256) tau = cand;
                }
                int cg = 0;
                for (int i = lane; i < n; i += 64) cg += ((unsigned)s16[i] > tau) ? 1 : 0;
                const int krem = 256 - wave_sum_i(cg);
                int total = 0, eqt = 0;
                for (int i0 = 0; i0 < n; i0 += 64) {
                    const int i = i0 + lane; const unsigned key = (i < n) ? (unsigned)s16[i] : 0u;
                    const bool gt = key > tau, eq = (i < n) && key == tau;
                    const unsigned long long eqm = __ballot(eq); const int eqp = __popcll(eqm & ltm);
                    const bool take = gt || (eq && (eqt + eqp < krem));
                    const unsigned long long tm = __ballot(take); const int pos = total + __popcll(tm & ltm);
                    if (take) list[pos] = (unsigned short)i;
                    total += __popcll(tm); eqt += __popcll(eqm);
                }
                cnt = total;
            }
        }
        if (blk) cntB = cnt; else cntA = cnt;
    }
    __syncthreads();
    dsa_attend2(a, proj, b, (size_t)b * SEQ + tA0 + wave, (const LAS unsigned short*)(lds + DSA_LIST + wave * 512), cntA, (size_t)b * SEQ + tB0 + wave, (const LAS unsigned short*)(lds + DSA_LIST + (8 + wave) * 512), cntB, lds + wave * 16384, lane);
    __syncthreads();
}

#ifndef HOSTDUP
#define HOSTDUP 0
#endif
#ifndef MK_SINGLE
#define MK_SINGLE 1
#endif
constexpr int PRM_OFF = MISC_OFF + 256;
DI void store_args(LAS unsigned char* lds, const Args& k) {
    LAS unsigned long long* q = (LAS unsigned long long*)(lds + PRM_OFF);
    q[0] = (unsigned long long)k.x; q[1] = (unsigned long long)k.pos; q[2] = (unsigned long long)k.w_in; q[3] = (unsigned long long)k.b_f; q[4] = (unsigned long long)k.pe_cmp;
    q[5] = (unsigned long long)k.w_cmp1; q[6] = (unsigned long long)k.w_cmp2; q[7] = (unsigned long long)k.w_gate; q[8] = (unsigned long long)k.w_br; q[9] = (unsigned long long)k.w_o;
    q[10] = (unsigned long long)k.ln1_g; q[11] = (unsigned long long)k.ln1_b; q[12] = (unsigned long long)k.w_router; q[13] = (unsigned long long)k.router_bias;
    q[14] = (unsigned long long)k.w_eg; q[15] = (unsigned long long)k.w_eu; q[16] = (unsigned long long)k.w_ed; q[17] = (unsigned long long)k.w_sg; q[18] = (unsigned long long)k.w_su; q[19] = (unsigned long long)k.w_sd;
    q[20] = (unsigned long long)k.ln2_g; q[21] = (unsigned long long)k.ln2_b; q[22] = (unsigned long long)k.out; q[23] = (unsigned long long)k.ws;
}
DI unsigned long long ldprm(LAS unsigned char* lds, int i) {
    const u32x2 v = *(const LAS u32x2*)(lds + PRM_OFF + 8 * i);
    return ((unsigned long long)(unsigned)__builtin_amdgcn_readfirstlane((int)v.y) << 32) | (unsigned long long)(unsigned)__builtin_amdgcn_readfirstlane((int)v.x);
}
DI Args lds_args(LAS unsigned char* lds) {
    Args a;
    a.x = (const float*)(const GAS float*)ldprm(lds, 0); a.pos = (const int*)(const GAS int*)ldprm(lds, 1); a.w_in = (const float*)(const GAS float*)ldprm(lds, 2); a.b_f = (const float*)(const GAS float*)ldprm(lds, 3); a.pe_cmp = (const float*)(const GAS float*)ldprm(lds, 4);
    a.w_cmp1 = (const float*)(const GAS float*)ldprm(lds, 5); a.w_cmp2 = (const float*)(const GAS float*)ldprm(lds, 6); a.w_gate = (const float*)(const GAS float*)ldprm(lds, 7); a.w_br = (const float*)(const GAS float*)ldprm(lds, 8); a.w_o = (const float*)(const GAS float*)ldprm(lds, 9);
    a.ln1_g = (const float*)(const GAS float*)ldprm(lds, 10); a.ln1_b = (const float*)(const GAS float*)ldprm(lds, 11); a.w_router = (const float*)(const GAS float*)ldprm(lds, 12); a.router_bias = (const float*)(const GAS float*)ldprm(lds, 13);
    a.w_eg = (const float*)(const GAS float*)ldprm(lds, 14); a.w_eu = (const float*)(const GAS float*)ldprm(lds, 15); a.w_ed = (const float*)(const GAS float*)ldprm(lds, 16); a.w_sg = (const float*)(const GAS float*)ldprm(lds, 17); a.w_su = (const float*)(const GAS float*)ldprm(lds, 18); a.w_sd = (const float*)(const GAS float*)ldprm(lds, 19);
    a.ln2_g = (const float*)(const GAS float*)ldprm(lds, 20); a.ln2_b = (const float*)(const GAS float*)ldprm(lds, 21); a.out = (float*)(GAS float*)ldprm(lds, 22); a.ws = (unsigned char*)(GAS unsigned char*)ldprm(lds, 23); a.ph_lo = 0; a.ph_hi = 0;
    return a;
}
#ifndef PHMASK
#define PHMASK 0xffffffffu
#endif
#define PHON(j) (((PHMASK) >> (j)) & 1u)
#define PH_BEGIN const Args a = lds_args(lds); unsigned char* ws = a.ws; (void)ws; \
    const int tid = ltid(), lane = tid & 63, wave = __builtin_amdgcn_readfirstlane(tid >> 6); \
    const int G = lgrid(), bid = lbid(), gw = bid * NWAVES + wave, NGW = G * NWAVES; (void)bid; (void)lane; (void)wave; (void)gw; (void)NGW; (void)G;
#ifndef PH_NOINLINE
#define PHFN DI void
#else
#define PHFN __attribute__((noinline)) __device__ void
#endif

PHFN f_prologue(LAS unsigned char* lds) { PH_BEGIN ph_prologue(a, gw, NGW, lane); }
PHFN f_cvt(LAS unsigned char* lds, int l) { PH_BEGIN ph_cvt(a, l, lds, gw, NGW, wave, lane); }
PHFN f_proj(LAS unsigned char* lds) { PH_BEGIN
    SchedProj S; S.so.init(NTOK, PW, G, bid); S.A = (unsigned)WS_XB; S.B = (unsigned)W_IN;
    EpiProj E; E.proj = (bf16*)(ws + WS_A); E.sm32 = (float*)(ws + WS_SM32);
    gs::gemm_stream<SchedProj, EpiProj, 2>(lds, (const char*)ws, S, E); }
PHFN f_post(LAS unsigned char* lds, int l) { PH_BEGIN ph_post(a, l, lds, wave, lane); }
PHFN f_cmp(LAS unsigned char* lds) { PH_BEGIN
    SchedCmp S; S.kcr = (unsigned)WS_KCR; S.vcr = (unsigned)WS_VCR; S.w = (unsigned)W_C1;
    EpiCmp E; E.hid = (float*)(ws + WS_HID); E.cbias = (const float*)(ws + WS_CBIAS);
    gs::gemm_stream<SchedCmp, EpiCmp, 2>(lds, (const char*)ws, S, E);
    if (bid >= 32 && bid < 64 && wave == 0) cumsum_seq(a, bid - 32, lane);
    if (G < 64 && bid == 0 && wave == 1) for (int q = (G > 32 ? G - 32 : 0); q < 32; ++q) cumsum_seq(a, q, lane); }
PHFN f_cmp2(LAS unsigned char* lds, int l) { PH_BEGIN ph_cmp2(a, l, gw, NGW, lane); }
PHFN f_dsa(LAS unsigned char* lds) { PH_BEGIN for (int pu = bid; pu < NTOK / 16; pu += G) dsa_unit16(a, pu, lds, wave, lane); }
PHFN f_nsa(LAS unsigned char* lds) { PH_BEGIN
    for (int u = gw, r = 0; u < NTOK / 8; u += NGW, ++r) {
        int unit = u;
        if (NGW == 2048) { const int bsel = u >> 10, pos = ((u & 1023) + 256 * r) & 1023; unit = bsel * 1024 + pos; }
        nsa_unit(a, unit, lds + wave * 5120, lane);
    } }
PHFN f_sbfg(LAS unsigned char* lds, int l) { PH_BEGIN
    for (int u = bid; u < 2048; u += G) {
        const int r = u >> 8, blk = u & 255, bh = blk & 31, f = blk >> 5, mixer = r >> 2, rr = r & 3;
        const int QB = (rr == 0) ? f : (rr == 1) ? 31 - f : (rr == 2) ? 8 + f : 23 - f;
        if (mixer == 0) sbfg_block<0>(a, l, bh >> 2, bh & 3, QB, lds, tid, wave, lane); else sbfg_block<1>(a, l, bh >> 2, bh & 3, QB, lds, tid, wave, lane);
        __syncthreads();
    } }
PHFN f_merge(LAS unsigned char* lds) { PH_BEGIN
    SchedMerge S; S.xb = (unsigned)WS_XB; S.om = (unsigned)WS_B; S.wg = (unsigned)W_G; S.wbr = (unsigned)W_BR; S.G = G;
    EpiMerge E; E.merged = (bf16*)(ws + WS_C); E.stash = (u32x4*)(ws + WS_A + (size_t)bid * 65536);
    gs::gemm_stream<SchedMerge, EpiMerge, 1>(lds, (const char*)ws, S, E); }
PHFN f_wo(LAS unsigned char* lds, int l) { PH_BEGIN
    SchedWo S; S.so.init(NTOK, DM, G, bid); S.A = (unsigned)WS_C; S.B = (unsigned)W_O;
    EpiWo E; E.xb = (bf16*)(ws + WS_XB); (void)l;
    gs::gemm_stream<SchedWo, EpiWo, 2>(lds, (const char*)ws, S, E); }
PHFN f_ln1(LAS unsigned char* lds, int l) { PH_BEGIN ph_ln1(a, l, gw, NGW, lane); }
PHFN f_router(LAS unsigned char* lds) { PH_BEGIN
    SchedRouter S; S.xh = (unsigned)WS_XB; S.xl = (unsigned)WS_XL; S.wh = (unsigned)W_RH; S.wl = (unsigned)W_RL; S.G = G;
    EpiRouter E; E.logit = (float*)(ws + WS_LOGIT);
    gs::gemm_stream<SchedRouter, EpiRouter, 1>(lds, (const char*)ws, S, E); }
PHFN f_route(LAS unsigned char* lds, int l) { PH_BEGIN ph_route(a, l, lds, wave, lane); }
PHFN f_e1(LAS unsigned char* lds, int l) { PH_BEGIN
    moe_tables(a, l, lds);
    SchedE1 S; S.ptile = (const LAS int*)(lds + TBL_OFF); S.cntv = S.ptile + 2 * TBLN; S.xb = (unsigned)WS_XB; S.lists = (const unsigned*)(ws + WS_LIST); S.w1 = (unsigned)W_1; S.G = G;
    EpiE1 E; E.hb = (bf16*)(ws + WS_HB);
    gs::gemm_stream<SchedE1, EpiE1, 2>(lds, (const char*)ws, S, E); }
PHFN f_e2(LAS unsigned char* lds, int l, int c) { PH_BEGIN
    moe_tables(a, l, lds);
    SchedE2 S; S.ptile = (const LAS int*)(lds + TBL_OFF); S.ypre = S.ptile + TBLN; S.cntv = S.ptile + 2 * TBLN; S.hb = (unsigned)WS_HB; S.w2 = (unsigned)W_2; S.c = c; S.G = G;
    EpiE2 E; E.y = (unsigned char*)(ws + WS_Y);
    gs::gemm_stream<SchedE2, EpiE2, 2>(lds, (const char*)ws, S, E); }
PHFN f_ln2(LAS unsigned char* lds, int l, int c) { PH_BEGIN moe_tables(a, l, lds); ph_ln2(a, l, c, lds, gw, NGW, lane); }
PHFN f_seam(LAS unsigned char* lds) {
    XcdBarrier bar; bar.bar = (unsigned*)((unsigned char*)(GAS unsigned char*)ldprm(lds, 23) + WS_CTL) + CW_BAR; bar.x = xb_xcc_id(); bar.st = (volatile LAS unsigned*)(lds + MISC_OFF) + 8; xcd_barrier(bar); }

#define IN(k) (lo <= (k) && (k) < hi)
#define SEAM(k) do { if ((k) + 1 < hi) f_seam(lds); } while (0)
DI void run_layer(LAS unsigned char* lds, const int l, const int lo, const int hi) {
        const int pb = 1 + l * NPL;
        if (PHON(0) && IN(pb + 0)) { f_cvt(lds, l); SEAM(pb + 0); }
        if (PHON(1) && IN(pb + 1)) { f_proj(lds); SEAM(pb + 1); }
        if (PHON(2) && IN(pb + 2)) { f_post(lds, l); SEAM(pb + 2); }
        if (PHON(3) && IN(pb + 3)) { f_cmp(lds); __syncthreads(); f_dsa(lds); SEAM(pb + 3); }
        if (PHON(4) && IN(pb + 4)) { f_cmp2(lds, l); __syncthreads(); f_sbfg(lds, l); SEAM(pb + 4); }
        if (PHON(21) && IN(pb + 5)) { f_nsa(lds); SEAM(pb + 5); }
        if (PHON(6) && IN(pb + 6)) { f_merge(lds); SEAM(pb + 6); }
        if (PHON(7) && IN(pb + 7)) { f_wo(lds, l); SEAM(pb + 7); }
        if (PHON(8) && IN(pb + 8)) { f_ln1(lds, l); SEAM(pb + 8); }
        if (PHON(9) && IN(pb + 9)) { f_router(lds); SEAM(pb + 9); }
        if (PHON(10) && IN(pb + 10)) { f_route(lds, l); SEAM(pb + 10); }
        if (PHON(11) && IN(pb + 11)) { f_e1(lds, l); SEAM(pb + 11); }
        for (int c = 0; c < NCH; ++c) {
            if (PHON(12) && IN(pb + 12 + 2 * c)) { f_e2(lds, l, c); SEAM(pb + 12 + 2 * c); }
            if (PHON(13) && IN(pb + 13 + 2 * c)) { f_ln2(lds, l, c); SEAM(pb + 13 + 2 * c); }
        }
}
#undef IN
#undef SEAM
#ifndef DUPMASK
#define DUPMASK 0
#endif
#define DUP(j) (((DUPMASK) >> (j)) & 1)
__global__ void __launch_bounds__(NWAVES * 64, 2) fwd(Args ka) {
    extern __shared__ __attribute__((aligned(16))) unsigned char lds_[];
    LAS unsigned char* lds = (LAS unsigned char*)lds_;
    const int tid = threadIdx.x;
    volatile LAS unsigned* MISC = (volatile LAS unsigned*)(lds + MISC_OFF);
    if (tid < 64) MISC[tid] = 0u;
    if (tid == 64) store_args(lds, ka);
    const int lo = ka.ph_lo, hi = ka.ph_hi;
    __syncthreads();
    if (hi - lo > 1 && tid == 0) (void)xb_add(&((unsigned*)(ka.ws + WS_CTL) + CW_BAR)[XB_XCNT(xb_xcc_id())], 1u);
#define IN(k) (lo <= (k) && (k) < hi)
#define SEAM(k) do { if ((k) + 1 < hi) f_seam(lds); } while (0)
    if (PHON(31) && IN(0)) { f_prologue(lds); SEAM(0); }
    run_layer(lds, 0, lo, hi); run_layer(lds, 1, lo, hi); run_layer(lds, 2, lo, hi); run_layer(lds, 3, lo, hi);
#undef IN
#undef SEAM
}

extern "C" void kernel_launch(void* const* d_in, const int* in_sizes, int n_in, void* d_out, int out_size, void* d_ws, size_t ws_size, hipStream_t stream) {
    static int grid = 0;
    if (grid == 0) {
        if (n_in != 22 || in_sizes[0] != NTOK * DM || out_size != NTOK * DM || ws_size < WS_END) {
            fprintf(stderr, "kernel_launch: unexpected shapes/workspace: n_in %d in0 %d out %d ws %zu (need %zu)\n", n_in, n_in > 0 ? in_sizes[0] : -1, out_size, ws_size, (size_t)WS_END); grid = -1; return; }
        int dev = 0, cus = 0, per_cu = 0;
        if (hipGetDevice(&dev) != hipSuccess || hipDeviceGetAttribute(&cus, hipDeviceAttributeMultiprocessorCount, dev) != hipSuccess) { grid = -1; return; }
        if (hipFuncSetAttribute((const void*)fwd, hipFuncAttributeMaxDynamicSharedMemorySize, LDS_BYTES) != hipSuccess) { fprintf(stderr, "kernel_launch: hipFuncSetAttribute failed\n"); grid = -1; return; }
        if (hipOccupancyMaxActiveBlocksPerMultiprocessor(&per_cu, (const void*)fwd, NWAVES * 64, LDS_BYTES) != hipSuccess || per_cu < 1)
            fprintf(stderr, "kernel_launch: occupancy query reports %d blocks per CU\n", per_cu);
        (void)hipGetLastError();
        grid = cus;
    }
    if (grid < 0) return;
    (void)hipMemsetAsync((char*)d_ws + WS_CTL, 0, CTL_ZERO_BYTES, stream);
    Args a{};
    a.x = (const float*)d_in[0]; a.pos = (const int*)d_in[1]; a.w_in = (const float*)d_in[2]; a.b_f = (const float*)d_in[3]; a.pe_cmp = (const float*)d_in[4];
    a.w_cmp1 = (const float*)d_in[5]; a.w_cmp2 = (const float*)d_in[6]; a.w_gate = (const float*)d_in[7]; a.w_br = (const float*)d_in[8]; a.w_o = (const float*)d_in[9];
    a.ln1_g = (const float*)d_in[10]; a.ln1_b = (const float*)d_in[11]; a.w_router = (const float*)d_in[12]; a.router_bias = (const float*)d_in[13];
    a.w_eg = (const float*)d_in[14]; a.w_eu = (const float*)d_in[15]; a.w_ed = (const float*)d_in[16]; a.w_sg = (const float*)d_in[17]; a.w_su = (const float*)d_in[18]; a.w_sd = (const float*)d_in[19];
    a.ln2_g = (const float*)d_in[20]; a.ln2_b = (const float*)d_in[21];
    a.out = (float*)d_out; a.ws = (unsigned char*)d_ws;
#if MK_SINGLE
    a.ph_lo = 0; a.ph_hi = NPHASE;
    hipLaunchKernelGGL(fwd, dim3(grid), dim3(NWAVES * 64), LDS_BYTES, stream, a);
#else
    for (int p = 0; p < NPHASE; ++p) { a.ph_lo = p; a.ph_hi = p + 1; hipLaunchKernelGGL(fwd, dim3(grid), dim3(NWAVES * 64), LDS_BYTES, stream, a);
        if (p > 0 && ((HOSTDUP >> ((p - 1) % NPL)) & 1)) hipLaunchKernelGGL(fwd, dim3(grid), dim3(NWAVES * 64), LDS_BYTES, stream, a); }
#endif
}
```

```cpp
#include <hip/hip_runtime.h>
#include <cstdio>
#include <cstdint>

#define GAS __attribute__((address_space(1)))
#define LAS __attribute__((address_space(3)))
typedef unsigned short bf16;
typedef short bf16x8 __attribute__((ext_vector_type(8)));
typedef float f32x4 __attribute__((ext_vector_type(4)));
typedef float f32x2 __attribute__((ext_vector_type(2)));
typedef float f32x16 __attribute__((ext_vector_type(16)));
typedef unsigned u32x4 __attribute__((ext_vector_type(4)));
typedef unsigned u32x2 __attribute__((ext_vector_type(2)));
typedef __bf16 bf16x2_t __attribute__((ext_vector_type(2)));
typedef GAS unsigned gu32;

#define DI __device__ __forceinline__
#define LDS_WAIT() asm volatile("s_waitcnt lgkmcnt(0)" ::: "memory")
#define VM_WAIT() asm volatile("s_waitcnt vmcnt(0)" ::: "memory")
#define RLX_AGENT __ATOMIC_RELAXED, __HIP_MEMORY_SCOPE_AGENT

constexpr int NBATCH = 8, SEQ = 8192, NTOK = NBATCH * SEQ, DM = 1024, DEPTH = 4;
constexpr int PW = 3136;
constexpr int C_AQ = 0, C_BQ = 256, C_BK = 512, C_BV = 768, C_CQ = 1024, C_CK = 1280, C_CV = 1536, C_DQ = 1792, C_DIQ = 2048,
              C_AKC = 2304, C_AVC = 2368, C_AKS = 2432, C_AVS = 2496, C_AKW = 2560, C_AVW = 2624, C_DK = 2688, C_DV = 2752, C_DIK = 2816, C_SM = 2880;
constexpr int IN_W = 2900;
constexpr float QS = 0.18033688011112042f;
constexpr float LOG2E = 1.4426950408889634f;
constexpr float ALPHA = 1.681792830507429f;
constexpr float LN_EPS = 1e-5f;
constexpr int NEXP = 64, NCH = 2, CHTOK = NTOK / NCH;
constexpr int NPL = 12 + 2 * NCH;
constexpr int NPHASE = 1 + DEPTH * NPL;
constexpr int NWAVES = 8;

constexpr size_t MiB = 1u << 20;
constexpr size_t WS_CTL = 0, CTL_ZERO_BYTES = 1 * MiB;
constexpr size_t WS_ROPE = 1 * MiB;
constexpr size_t WS_SM32 = 5 * MiB;
constexpr size_t WS_GATE = 13 * MiB;
constexpr size_t WS_LOGF = 16 * MiB;
constexpr size_t WS_CUM  = 17 * MiB;
constexpr size_t WS_IW   = 18 * MiB;
constexpr size_t WS_HID  = 19 * MiB;
constexpr size_t WS_KCMP = 21 * MiB;
constexpr size_t WS_VTCMP = 21 * MiB + 512 * 1024;
constexpr size_t WS_CBIAS = 22 * MiB;
constexpr size_t WS_KCR  = 23 * MiB;
constexpr size_t WS_VCR  = 32 * MiB;
constexpr size_t WS_VT   = 41 * MiB;
constexpr size_t WS_VTB = WS_VT, WS_VTC = WS_VT + 32 * MiB, WS_VTAS = WS_VT + 64 * MiB, WS_VTAW = WS_VT + 72 * MiB;
constexpr size_t WS_LOGIT = WS_VT;
constexpr size_t WS_TOKINFO = WS_VT + 16 * MiB;
constexpr size_t WS_LIST = WS_VT + 20 * MiB;
constexpr size_t WS_W    = 121 * MiB;
constexpr size_t W_IN = WS_W, W_G = WS_W + 6 * MiB, W_BR = WS_W + 14 * MiB, W_O = WS_W + 16 * MiB, W_C1 = WS_W + 18 * MiB,
                 W_RH = WS_W + 20 * MiB, W_RL = WS_W + 20 * MiB + 512 * 1024, W_1 = WS_W + 21 * MiB, W_2 = WS_W + 86 * MiB;
constexpr size_t WS_XB   = 243 * MiB;
constexpr size_t WS_A    = 371 * MiB;
constexpr size_t WS_B    = 763 * MiB;
constexpr size_t WS_C    = 891 * MiB;
constexpr size_t WS_END  = 1019 * MiB;
constexpr size_t WS_KTS = WS_C, WS_KTW = WS_C + 8 * MiB, WS_IKT = WS_C + 16 * MiB, WS_KTB = WS_C + 32 * MiB, WS_KTC = WS_C + 64 * MiB;
constexpr size_t WS_XL = WS_A, WS_HB = WS_A, WS_Y = WS_A + 320 * MiB;
static_assert(WS_Y + (size_t)(CHTOK * 8 / 256 + 64 + CHTOK / 256) * 256 * DM <= WS_END, "tile-padded fp8 y chunk fits");
constexpr int HB_TILES = NTOK * 8 / 256 + NCH * 64 + NTOK / 256;
static_assert((size_t)HB_TILES * 256 * 512 <= 320 * MiB, "hbuf fits");

constexpr int CW_BAR = 4096;
constexpr int CW_CNT = 16384;
constexpr int CW_KMAX = 32768;

constexpr int RING_BYTES = 131072;
constexpr int MISC_OFF = 162816;
constexpr int LDS_BYTES = 163840;

DI unsigned cvtpk(float lo, float hi) { f32x2 v = {lo, hi}; bf16x2_t b = __builtin_convertvector(v, bf16x2_t); return __builtin_bit_cast(unsigned, b); }
DI u32x4 pack8(const f32x4& v0, const f32x4& v1) { u32x4 w; w.x = cvtpk(v0[0], v0[1]); w.y = cvtpk(v0[2], v0[3]); w.z = cvtpk(v1[0], v1[1]); w.w = cvtpk(v1[2], v1[3]); return w; }
DI float bf2f(unsigned short h) { return __uint_as_float(((unsigned)h) << 16); }
DI float bflo(unsigned w) { return __uint_as_float(w << 16); }
DI float bfhi(unsigned w) { return __uint_as_float(w & 0xffff0000u); }
DI float fexp2(float x) { return __builtin_amdgcn_exp2f(x); }
DI float flog2(float x) { return __builtin_amdgcn_logf(x); }
DI float frcp(float x) { return __builtin_amdgcn_rcpf(x); }
DI float sigmoidf_(float x) { return frcp(1.f + fexp2(-x * LOG2E)); }
#define DPPF(v, ctrl, rm, bc) __int_as_float(__builtin_amdgcn_update_dpp(0, __float_as_int(v), (ctrl), (rm), 0xF, (bc)))
#define DPPI(v, ctrl, rm, bc) __builtin_amdgcn_update_dpp(0, (v), (ctrl), (rm), 0xF, (bc))
DI float dpp_xor1(float v) { return DPPF(v, 0xB1, 0xF, true); }
DI float dpp_xor2(float v) { return DPPF(v, 0x4E, 0xF, true); }
DI float red16_sum(float v) { const auto r = __builtin_amdgcn_permlane16_swap(__float_as_uint(v), __float_as_uint(v), false, false); return __uint_as_float(r[0]) + __uint_as_float(r[1]); }
DI float red16_max(float v) { const auto r = __builtin_amdgcn_permlane16_swap(__float_as_uint(v), __float_as_uint(v), false, false); return fmaxf(__uint_as_float(r[0]), __uint_as_float(r[1])); }
DI float red32_sum(float v) { const auto r = __builtin_amdgcn_permlane32_swap(__float_as_uint(v), __float_as_uint(v), false, false); return __uint_as_float(r[0]) + __uint_as_float(r[1]); }
DI float red32_max(float v) { const auto r = __builtin_amdgcn_permlane32_swap(__float_as_uint(v), __float_as_uint(v), false, false); return fmaxf(__uint_as_float(r[0]), __uint_as_float(r[1])); }
DI float wave_sum(float v) {
    v += dpp_xor1(v); v += dpp_xor2(v); v += DPPF(v, 0x124, 0xF, true); v += DPPF(v, 0x128, 0xF, true);
    v = red16_sum(v); return red32_sum(v);
}
DI float wave_max(float v) {
    v = fmaxf(v, dpp_xor1(v)); v = fmaxf(v, dpp_xor2(v)); v = fmaxf(v, DPPF(v, 0x124, 0xF, true)); v = fmaxf(v, DPPF(v, 0x128, 0xF, true));
    v = red16_max(v); return red32_max(v);
}
DI int wave_incl_scan(int v) {
    v += DPPI(v, 0x111, 0xF, true); v += DPPI(v, 0x112, 0xF, true); v += DPPI(v, 0x114, 0xF, true); v += DPPI(v, 0x118, 0xF, true);
    v += DPPI(v, 0x142, 0xA, false);
    v += DPPI(v, 0x143, 0xC, false);
    return v;
}
DI float wave_incl_scan_f(float v) {
    v += DPPF(v, 0x111, 0xF, true); v += DPPF(v, 0x112, 0xF, true); v += DPPF(v, 0x114, 0xF, true); v += DPPF(v, 0x118, 0xF, true);
    v += DPPF(v, 0x142, 0xA, false); v += DPPF(v, 0x143, 0xC, false);
    return v;
}
DI int ltid() { int t = threadIdx.x; asm volatile("" : "+v"(t)); return t; }
DI int lbid() { int b = blockIdx.x; asm volatile("" : "+s"(b)); return b; }
DI int lgrid() { int g = gridDim.x; asm volatile("" : "+s"(g)); return g; }
DI f32x16 mfma32(bf16x8 a, bf16x8 b, f32x16 c) { return __builtin_amdgcn_mfma_f32_32x32x16_bf16(a, b, c, 0, 0, 0); }
DI f32x4 mfma16(bf16x8 a, bf16x8 b, f32x4 c) { return __builtin_amdgcn_mfma_f32_16x16x32_bf16(a, b, c, 0, 0, 0); }

#define XB_TMO      128
#define XB_XCNT(j)  (256  + 64 * (j))
#define XB_XSUB(j)  (1280 + 64 * (j))
#define XB_XGEN(j)  (2304 + 64 * (j))
#define XB_TOP      3328
#define XB_TOPGEN   3392
#define XCD_BAR_WORDS 3456
#define XB_SPIN_CAP (1u << 22)
DI unsigned xb_ld(unsigned* p)              { return __hip_atomic_load(p, __ATOMIC_RELAXED, __HIP_MEMORY_SCOPE_AGENT); }
DI unsigned xb_add(unsigned* p, unsigned v) { return __hip_atomic_fetch_add(p, v, __ATOMIC_RELAXED, __HIP_MEMORY_SCOPE_AGENT); }
DI unsigned xb_xcc_id() { return (unsigned)__builtin_amdgcn_s_getreg((3 << 11) | 20) & 0xFu; }
#define XB_SPIN(cond, bar) do { unsigned _sp = 0; while (cond) { __builtin_amdgcn_s_sleep(1); \
    if ((++_sp & 255u) == 0u) { if (xb_ld(&(bar)[XB_TMO])) break; if (_sp > XB_SPIN_CAP) { atomicAdd(&(bar)[XB_TMO], 1u); break; } } } } while (0)
struct XcdBarrier { unsigned* bar; unsigned x; volatile LAS unsigned* st; };
DI XcdBarrier xcd_barrier_post(unsigned* bar, volatile LAS unsigned* st) {
    XcdBarrier b; b.bar = bar; b.x = xb_xcc_id(); b.st = st;
    if (threadIdx.x == 0) (void)xb_add(&bar[XB_XCNT(b.x)], 1u);
    return b;
}
DI void xcd_barrier_complete(unsigned* bar, unsigned x, unsigned& nloc, unsigned& nx) {
    const unsigned G = gridDim.x * gridDim.y * gridDim.z;
    unsigned sum, cnt, mine, sp = 0u;
    for (;;) {
        sum = 0u; cnt = 0u; mine = 0u;
#pragma unroll
        for (unsigned j = 0; j < 16; ++j) { const unsigned c = xb_ld(&bar[XB_XCNT(j)]); sum += c; cnt += (c > 0u) ? 1u : 0u; mine = (j == x) ? c : mine; }
        if (sum == G) break;
        __builtin_amdgcn_s_sleep(1);
        if ((++sp & 255u) == 0u) { if (xb_ld(&bar[XB_TMO])) break; if (sp > XB_SPIN_CAP) { atomicAdd(&bar[XB_TMO], 1u); break; } }
    }
    nloc = mine > 0u ? mine : 1u; nx = cnt > 0u ? cnt : 1u;
}
DI void xcd_barrier(const XcdBarrier& b) {
    asm volatile("s_waitcnt vmcnt(0)" ::: "memory");
    __syncthreads();
    if (threadIdx.x == 0) {
        unsigned* bar = b.bar;
        __builtin_amdgcn_s_waitcnt(0);
        unsigned nloc = b.st[0], nx = b.st[1];
        if (nloc == 0u) { xcd_barrier_complete(bar, b.x, nloc, nx); b.st[0] = nloc; b.st[1] = nx; }
        const unsigned old = xb_add(&bar[XB_XSUB(b.x)], 1u);
        const unsigned gen = old / nloc;
        if (old + 1u == (gen + 1u) * nloc) {
            __builtin_amdgcn_fence(__ATOMIC_RELEASE, "agent");
            asm volatile("s_waitcnt vmcnt(0)" ::: "memory");
            const unsigned og = xb_add(&bar[XB_TOP], 1u);
            const unsigned tg = og / nx;
            if (og + 1u == (tg + 1u) * nx) xb_add(&bar[XB_TOPGEN], 1u);
            else XB_SPIN(xb_ld(&bar[XB_TOPGEN]) == tg, bar);
            __builtin_amdgcn_fence(__ATOMIC_ACQUIRE, "agent");
            xb_add(&bar[XB_XGEN(b.x)], 1u);
            asm volatile("s_waitcnt vmcnt(0)" ::: "memory");
        } else {
            XB_SPIN(xb_ld(&bar[XB_XGEN(b.x)]) == gen, bar);
            __builtin_amdgcn_fence(__ATOMIC_ACQUIRE, "agent");
            asm volatile("s_waitcnt vmcnt(0)" ::: "memory");
        }
    }
    __syncthreads();
}

namespace gs {
constexpr int BM = 256, BK = 64, HALF = 128, HTB = HALF * BK * 2, NXCD = 8, WGM = 8;
__host__ __device__ __forceinline__ int lds_byte(int r, int c) { const int st = (r >> 4) * 2 + (c >> 5), rr = r & 15, cc = c & 31, ob = rr * 64 + cc * 2; return st * 1024 + (ob ^ (((ob >> 9) & 1) << 5)); }
__host__ __device__ __forceinline__ void stage_rc(int b, int& R, int& C) { const int st = b / 1024, sb = b % 1024, swz = sb ^ (((sb >> 9) & 1) << 5); R = (st >> 1) * 16 + swz / 64; C = (st & 1) * 32 + (swz % 64) / 2; }
__host__ __device__ __forceinline__ int perm32(int rho) { const int n = rho >> 4, i = rho & 15; return 8 * (i >> 2) + 4 * n + (i & 3); }
__host__ __device__ __forceinline__ int bh8row(int R) { return (R >> 5) * 64 + 16 * ((R & 15) >> 2) + 4 * ((R >> 4) & 1) + (R & 3); }

struct GU {
    unsigned A, B; const int* idx;
    unsigned lda, ldb;
    int nt;
    int flags;
    int nvalid;
    int a0, a1, a2, a3;
};
struct Unit { int pm, pn; };
struct StaticOrder {
    int nM, nN, nwg, G, c;
    DI void init(int M, int N, int G_, int c_) { nM = M / BM; nN = N / BM; nwg = nM * nN; G = G_; c = c_; }
    DI bool next(int i, Unit& u) const {
        const long L = (long)i * G + c; if (L >= nwg) return false;
        int wgid = (int)L; { const int q = nwg / NXCD, r = nwg % NXCD, xcd = wgid % NXCD, off = wgid / NXCD; wgid = (xcd < r ? xcd * (q + 1) : r * (q + 1) + (xcd - r) * q) + off; }
        const int nig = WGM * nN, gid = wgid / nig, fm = gid * WGM, gsz = (nM - fm) < WGM ? (nM - fm) : WGM;
        u.pm = fm + ((wgid % nig) % gsz); u.pn = (wgid % nig) / gsz; return true;
    }
};

template <class Sched, class Epi, int NBH>
DI void gemm_stream(LAS unsigned char* lds, const char* wsb, Sched& S, Epi& E) {
    constexpr bool GATH = Sched::GATHER, FIXED = Sched::FIXED;
    const int tid = ltid(), wid = __builtin_amdgcn_readfirstlane(tid >> 6), lane = tid & 63, wr = wid >> 2, wc = wid & 3, fr = lane & 15, fq = lane >> 4;
    int R0, C0, R1, C1; stage_rc(tid * 16, R0, C0); stage_rc(tid * 16 + 8192, R1, C1);
    const unsigned Rb0 = Epi::BH8 ? (unsigned)bh8row(R0) : Epi::PERM ? ((R0 & ~31) + perm32(R0 & 31)) : R0, Rb1 = Epi::BH8 ? (unsigned)bh8row(R1) : Epi::PERM ? ((R1 & ~31) + perm32(R1 & 31)) : R1;
    constexpr unsigned BHS = Epi::BH8 ? 8u : (unsigned)HALF;
    const unsigned C0b = (unsigned)C0 * 2u, C1b = (unsigned)C1 * 2u;
    const unsigned ldsw = (unsigned)wid * 1024u;
    const int aoff = lds_byte(wr * 64 + fr, fq * 8), boff = lds_byte(wc * 32 + fr, fq * 8);
#define GS_SA(b, h) (((b) * 2 + (h)) * HTB)
#define GS_SB(b, h) ((4 + (b) * 2 + (h)) * HTB)
#define GS_STG_O(bufoff, gbase, o0, o1) do { \
        unsigned _q0 = (gbase) + (o0), _q1 = (gbase) + (o1); asm volatile("" : "+v"(_q0), "+v"(_q1)); \
        __builtin_amdgcn_global_load_lds((const unsigned*)(wsb + (size_t)_q0), (LAS unsigned*)(lds + (bufoff) + ldsw), 16, 0, 0); \
        __builtin_amdgcn_global_load_lds((const unsigned*)(wsb + (size_t)_q1), (LAS unsigned*)(lds + (bufoff) + ldsw + 8192), 16, 0, 0); } while (0)
#define GS_STGA(bufoff, gbase, h, r0, r1, ld) do { if constexpr (FIXED) GS_STG_O(bufoff, (gbase) + (unsigned)(h) * HALF * (ld), fa0, fa1); \
        else GS_STG_O(bufoff, gbase, (unsigned)(r0) * (ld) + C0b, (unsigned)(r1) * (ld) + C1b); } while (0)
#define GS_STGB(bufoff, gbase, h, ld) do { if constexpr (FIXED) GS_STG_O(bufoff, (gbase) + (unsigned)(h) * BHS * (ld), fb0, fb1); \
        else GS_STG_O(bufoff, (gbase) + (unsigned)(h) * BHS * (ld), Rb0 * (ld) + C0b, Rb1 * (ld) + C1b); } while (0)
#define GS_LDA(dst, b, h) do { _Pragma("unroll") for (int m = 0; m < 4; ++m) _Pragma("unroll") for (int k = 0; k < 2; ++k) dst[m][k] = *(const LAS bf16x8*)(lds + GS_SA(b, h) + aoff + m * 2048 + k * 1024); } while (0)
#define GS_LDB(dst, b, h) do { _Pragma("unroll") for (int n = 0; n < 2; ++n) _Pragma("unroll") for (int k = 0; k < 2; ++k) dst[n][k] = *(const LAS bf16x8*)(lds + GS_SB(b, h) + boff + n * 2048 + k * 1024); } while (0)
#define GS_MMA(ai, bj, At, Bt) do { __builtin_amdgcn_s_setprio(1); _Pragma("unroll") for (int m = 0; m < 4; ++m) _Pragma("unroll") for (int n = 0; n < 2; ++n) _Pragma("unroll") for (int k = 0; k < 2; ++k) \
        acc[ai][bj][m][n] = __builtin_amdgcn_mfma_f32_16x16x32_bf16(Bt[n][k], At[m][k], acc[ai][bj][m][n], 0, 0, 0); __builtin_amdgcn_s_setprio(0); } while (0)
#define GS_WAIT_V(n) asm volatile("s_waitcnt vmcnt(" #n ")" ::: "memory")
#define GS_WAIT_L(n) asm volatile("s_waitcnt lgkmcnt(" #n ")" ::: "memory")
#define GS_BAR __builtin_amdgcn_s_barrier()
#define GS_SCHED __builtin_amdgcn_sched_barrier(0)
#define GS_ROWS(u, ia) do { if (GATH) { if ((u).idx) { \
            ia[0] = R0 < (u).nvalid ? (unsigned)(u).idx[R0] : 0u; ia[1] = R1 < (u).nvalid ? (unsigned)(u).idx[R1] : 0u; \
            ia[2] = HALF + R0 < (u).nvalid ? (unsigned)(u).idx[HALF + R0] : 0u; ia[3] = HALF + R1 < (u).nvalid ? (unsigned)(u).idx[HALF + R1] : 0u; } \
        else { ia[0] = R0; ia[1] = R1; ia[2] = HALF + R0; ia[3] = HALF + R1; } } } while (0)
    GU cur, nxt; int ui = 0;
    if (!S.next(0, cur)) return;
    f32x4 acc[2][NBH][4][2];
#pragma unroll
    for (int a = 0; a < 2; ++a)
#pragma unroll
        for (int b = 0; b < NBH; ++b)
#pragma unroll
            for (int m = 0; m < 4; ++m)
#pragma unroll
                for (int n = 0; n < 2; ++n) acc[a][b][m][n] = (f32x4){0.f, 0.f, 0.f, 0.f};
    bf16x8 At[4][2], B0[2][2], B1[2][2];
    unsigned ia[4] = {(unsigned)R0, (unsigned)R1, (unsigned)(HALF + R0), (unsigned)(HALF + R1)}, na[4] = {(unsigned)R0, (unsigned)R1, (unsigned)(HALF + R0), (unsigned)(HALF + R1)};
    GS_ROWS(cur, ia);
    unsigned cA = cur.A, cB = cur.B;
    unsigned lda = cur.lda, ldb = cur.ldb;
    const unsigned fa0 = (unsigned)R0 * lda + C0b, fa1 = (unsigned)R1 * lda + C1b, fb0 = Rb0 * ldb + C0b, fb1 = Rb1 * ldb + C1b;
    if constexpr (NBH == 2) {
        GS_STGB(GS_SB(0, 0), cB, 0, ldb); GS_STGB(GS_SB(0, 1), cB, 1, ldb); GS_STGA(GS_SA(0, 0), cA, 0, ia[0], ia[1], lda); GS_STGA(GS_SA(0, 1), cA, 1, ia[2], ia[3], lda);
        if (wr == 1) GS_BAR;
        GS_WAIT_V(2); GS_BAR;
        GS_STGB(GS_SB(1, 0), cB + 128, 0, ldb); GS_STGA(GS_SA(1, 0), cA + 128, 0, ia[0], ia[1], lda); GS_STGB(GS_SB(1, 1), cB + 128, 1, ldb);
        GS_WAIT_V(6); GS_BAR;
    } else {
        GS_STGB(GS_SB(0, 0), cB, 0, ldb); GS_STGA(GS_SA(0, 0), cA, 0, ia[0], ia[1], lda); GS_STGA(GS_SA(0, 1), cA, 1, ia[2], ia[3], lda);
        if (wr == 1) GS_BAR;
        GS_WAIT_V(2); GS_BAR;
        GS_STGB(GS_SB(1, 0), cB + 128, 0, ldb); GS_STGA(GS_SA(1, 0), cA + 128, 0, ia[0], ia[1], lda);
        GS_WAIT_V(4); GS_BAR;
    }
    for (;;) {
        const bool has_next = S.next(ui + 1, nxt);
        unsigned nA = cA, nB = cB, nlda = lda, nldb = ldb;
        if (has_next) { GS_ROWS(nxt, na); nA = nxt.A; nB = nxt.B; nlda = nxt.lda; nldb = nxt.ldb; }
        else if (GATH) { na[0] = ia[0]; na[1] = ia[1]; na[2] = ia[2]; na[3] = ia[3]; }
        const int nt = cur.nt;
        for (int t = 0; t < nt; t += 2) {
            const bool last = (t == nt - 2);
            const unsigned a1 = cA + (unsigned)(t + 1) * 128u;
            const unsigned a2 = last ? nA : cA + (unsigned)(t + 2) * 128u, b2 = last ? nB : cB + (unsigned)(t + 2) * 128u;
            const unsigned a3 = a2 + 128u, b3 = b2 + 128u;
            const unsigned xlda = last ? nlda : lda, xldb = last ? nldb : ldb;
            unsigned x0, x1, x2, x3;
            if (GATH) { x0 = last ? na[0] : ia[0]; x1 = last ? na[1] : ia[1]; x2 = last ? na[2] : ia[2]; x3 = last ? na[3] : ia[3]; }
            else { x0 = R0; x1 = R1; x2 = HALF + R0; x3 = HALF + R1; }
            if constexpr (NBH == 2) {
                GS_LDB(B0, 0, 0); GS_LDB(B1, 0, 1); GS_SCHED; GS_LDA(At, 0, 0); GS_STGA(GS_SA(1, 1), a1, 1, ia[2], ia[3], lda);
                GS_WAIT_V(8); GS_WAIT_L(0); GS_BAR; GS_MMA(0, 0, At, B0); GS_MMA(0, 1, At, B1); GS_BAR; GS_SCHED;
                GS_LDA(At, 0, 1); GS_STGB(GS_SB(0, 0), b2, 0, xldb); GS_STGB(GS_SB(0, 1), b2, 1, xldb); GS_STGA(GS_SA(0, 0), a2, 0, x0, x1, xlda);
                GS_WAIT_V(8); GS_WAIT_L(0); GS_BAR; GS_MMA(1, 0, At, B0); GS_MMA(1, 1, At, B1); GS_BAR; GS_SCHED;
                GS_LDB(B0, 1, 0); GS_LDB(B1, 1, 1); GS_SCHED; GS_LDA(At, 1, 0); GS_STGA(GS_SA(0, 1), a2, 1, x2, x3, xlda);
                GS_WAIT_V(8); GS_WAIT_L(0); GS_BAR; GS_MMA(0, 0, At, B0); GS_MMA(0, 1, At, B1); GS_BAR; GS_SCHED;
                GS_LDA(At, 1, 1); GS_STGB(GS_SB(1, 0), b3, 0, xldb); GS_STGB(GS_SB(1, 1), b3, 1, xldb); GS_STGA(GS_SA(1, 0), a3, 0, x0, x1, xlda);
                GS_WAIT_V(8); GS_WAIT_L(0); GS_BAR; GS_MMA(1, 0, At, B0); GS_MMA(1, 1, At, B1); GS_BAR; GS_SCHED;
            } else {
                GS_LDB(B0, 0, 0); GS_SCHED; GS_LDA(At, 0, 0); GS_STGA(GS_SA(1, 1), a1, 1, ia[2], ia[3], lda);
                GS_WAIT_V(6); GS_WAIT_L(0); GS_BAR; GS_MMA(0, 0, At, B0); GS_BAR; GS_SCHED;
                GS_LDA(At, 0, 1); GS_STGB(GS_SB(0, 0), b2, 0, xldb); GS_STGA(GS_SA(0, 0), a2, 0, x0, x1, xlda);
                GS_WAIT_V(6); GS_WAIT_L(0); GS_BAR; GS_MMA(1, 0, At, B0); GS_BAR; GS_SCHED;
                GS_LDB(B0, 1, 0); GS_SCHED; GS_LDA(At, 1, 0); GS_STGA(GS_SA(0, 1), a2, 1, x2, x3, xlda);
                GS_WAIT_V(6); GS_WAIT_L(0); GS_BAR; GS_MMA(0, 0, At, B0); GS_BAR; GS_SCHED;
                GS_LDA(At, 1, 1); GS_STGB(GS_SB(1, 0), b3, 0, xldb); GS_STGA(GS_SA(1, 0), a3, 0, x0, x1, xlda);
                GS_WAIT_V(6); GS_WAIT_L(0); GS_BAR; GS_MMA(1, 0, At, B0); GS_BAR; GS_SCHED;
            }
        }
        if (cur.flags & 2) {
            if (wr == 0) GS_BAR;
            E(acc, cur, wr, wc, fr, fq);
        }
        if (!has_next) break;
        if (nxt.flags & 1) {
#pragma unroll
            for (int a = 0; a < 2; ++a)
#pragma unroll
                for (int b = 0; b < NBH; ++b)
#pragma unroll
                    for (int m = 0; m < 4; ++m)
#pragma unroll
                        for (int n = 0; n < 2; ++n) acc[a][b][m][n] = (f32x4){0.f, 0.f, 0.f, 0.f};
        }
        const bool did_epi = (cur.flags & 2) != 0;
        cur = nxt; cA = nA; cB = nB; lda = nlda; ldb = nldb; ++ui;
        if (GATH) { ia[0] = na[0]; ia[1] = na[1]; ia[2] = na[2]; ia[3] = na[3]; }
        if (did_epi) { if (wr == 1) GS_BAR; }
    }
    GS_WAIT_V(0);
    if (!(cur.flags & 2)) { if (wr == 0) GS_BAR; }
    GS_BAR;
#undef GS_SA
#undef GS_SB
#undef GS_STG_O
#undef GS_STGA
#undef GS_STGB
#undef GS_LDA
#undef GS_LDB
#undef GS_MMA
#undef GS_WAIT_V
#undef GS_WAIT_L
#undef GS_BAR
#undef GS_SCHED
#undef GS_ROWS
}
}

struct Args {
    const float* x; const int* pos; const float* w_in; const float* b_f; const float* pe_cmp; const float* w_cmp1; const float* w_cmp2;
    const float* w_gate; const float* w_br; const float* w_o; const float* ln1_g; const float* ln1_b; const float* w_router; const float* router_bias;
    const float* w_eg; const float* w_eu; const float* w_ed; const float* w_sg; const float* w_su; const float* w_sd; const float* ln2_g; const float* ln2_b;
    float* out; unsigned char* ws; int ph_lo, ph_hi;
};

DI void ph_prologue(const Args& a, int gw, int NGW, int lane) {
    bf16* xb = (bf16*)(a.ws + WS_XB);
    for (int row = gw; row < NTOK; row += NGW) {
        const f32x4* xr = (const f32x4*)(a.x + (size_t)row * DM) + lane;
        u32x2* o = (u32x2*)(xb + (size_t)row * DM) + lane;
#pragma unroll
        for (int j = 0; j < 4; ++j) { const f32x4 v = xr[64 * j]; u32x2 w; w.x = cvtpk(v.x, v.y); w.y = cvtpk(v.z, v.w); o[64 * j] = w; }
    }
    float* rope = (float*)(a.ws + WS_ROPE);
    constexpr float INVF[8] = {1.0f, 0.1939227432012558f, 0.03760603070259094f, 0.007292664609849453f, 0.0014142135623842478f, 0.00027424818836152554f, 5.318296098266728e-05f, 1.0313386155758053e-05f};
    for (int i = gw * 64 + lane; i < NTOK; i += NGW * 64) {
        const float p = (float)a.pos[i];
#pragma unroll
        for (int j = 0; j < 8; ++j) {
            const float ang = p * INVF[j];
            const double rev = (double)ang * 0.15915494309189535;
            const float fr = (float)(rev - __builtin_rint(rev));
            rope[(size_t)i * 16 + j] = __builtin_amdgcn_cosf(fr);
            rope[(size_t)i * 16 + 8 + j] = __builtin_amdgcn_sinf(fr);
        }
    }
}

constexpr float Y_SCALE = 16.f;
struct CvtItem { const float* W; bf16* WT; int N, n0, nv, k0, dK, drow0, mode; float scale; };
__device__ const int SEG_SRC[21] = {0, 652, 908, 1164, 1420, 1676, 1932, 2192, 2576, 256, 320, 384, 448, 512, 576, 2448, 2512, 2832, 640, 2188, 2896};
__device__ const int SEG_DST[21] = {C_AQ, C_BQ, C_BK, C_BV, C_CQ, C_CK, C_CV, C_DQ, C_DIQ, C_AKC, C_AVC, C_AKS, C_AVS, C_AKW, C_AVW, C_DK, C_DV, C_DIK, 2880, 2892, 2896};
constexpr int CVT_I_IN = 93 * 16, CVT_I_G = 2048, CVT_I_BR = 512, CVT_I_O = 512, CVT_I_C1 = 128, CVT_I_R = 64, CVT_I_E = 65 * 384, CVT_I_CB = 2;
constexpr int CVT_NIT = CVT_I_IN + CVT_I_G + CVT_I_BR + CVT_I_O + CVT_I_C1 + CVT_I_R + CVT_I_E + CVT_I_CB;
DI CvtItem cvt_decode(const Args& a, int l, int it) {
    unsigned char* ws = a.ws; CvtItem c; c.mode = 0; c.nv = 32; c.scale = 1.f;
    int r = it;
    if (r < CVT_I_IN) {
        const int kb = r / 93, ci = r % 93; int seg, off;
        if (ci < 72) { seg = ci >> 3; off = (ci & 7) * 32; } else if (ci < 90) { seg = 9 + ((ci - 72) >> 1); off = ((ci - 72) & 1) * 32; }
        else { seg = 18 + (ci - 90); off = 0; c.nv = (seg == 18) ? 12 : 4; }
        if (seg == 0 || seg == 1 || seg == 4 || seg == 7) c.scale = QS;
        c.W = a.w_in + (size_t)l * DM * IN_W; c.N = IN_W; c.n0 = SEG_SRC[seg] + off; c.k0 = kb * 64; c.WT = (bf16*)(ws + W_IN); c.dK = DM; c.drow0 = SEG_DST[seg] + off; return c; }
    r -= CVT_I_IN;
    if (r < CVT_I_G) { const int m = r >> 9, q = r & 511, kb = q >> 5, nb = q & 31;
        c.W = a.w_gate + (size_t)(l * 4 + m) * DM * DM; c.N = DM; c.n0 = nb * 32; c.k0 = kb * 64; c.WT = (bf16*)(ws + W_G) + (size_t)m * DM * DM; c.dK = DM; c.drow0 = nb * 32; c.scale = -LOG2E; return c; }
    r -= CVT_I_G;
    if (r < CVT_I_BR) { const int m = r >> 7, q = r & 127, kb = q >> 5, nb = q & 31;
        c.W = a.w_br + (size_t)(l * 4 + m) * 256 * DM; c.N = DM; c.n0 = nb * 32; c.k0 = kb * 64; c.WT = (bf16*)(ws + W_BR) + (size_t)m * DM * 256; c.dK = 256; c.drow0 = nb * 32; return c; }
    r -= CVT_I_BR;
    if (r < CVT_I_O) { const int kb = r >> 5, nb = r & 31;
        c.W = a.w_o + (size_t)l * DM * DM; c.N = DM; c.n0 = nb * 32; c.k0 = kb * 64; c.WT = (bf16*)(ws + W_O); c.dK = DM; c.drow0 = nb * 32; return c; }
    r -= CVT_I_O;
    if (r < CVT_I_C1) { const int j = r >> 6, q = r & 63, kb = q >> 1, nb = q & 1;
        c.W = a.w_cmp1 + (size_t)(l * 2 + j) * 2048 * 64; c.N = 64; c.n0 = nb * 32; c.k0 = kb * 64; c.WT = (bf16*)(ws + W_C1) + (size_t)j * 256 * 2048; c.dK = 2048; c.drow0 = nb * 32; return c; }
    r -= CVT_I_C1;
    if (r < CVT_I_R) { const int mode = r >> 5, q = r & 31, kb = q >> 1, nb = q & 1;
        c.W = a.w_router + (size_t)l * DM * 64; c.N = 64; c.n0 = nb * 32; c.k0 = kb * 64; c.WT = (bf16*)(ws + (mode ? W_RL : W_RH)); c.dK = DM; c.drow0 = nb * 32; c.mode = mode; return c; }
    r -= CVT_I_R;
    if (r < CVT_I_E) {
        const int e = r / 384, q = r % 384, which = q >> 7, qq = q & 127;
        if (which < 2) { const int kb = qq >> 3, nb = qq & 7, n0 = nb * 32, pn = n0 >> 7, i0 = n0 & 127;
            c.W = (which == 0) ? (e < 64 ? a.w_eg + (size_t)(l * 64 + e) * DM * 256 : a.w_sg + (size_t)l * DM * 256) : (e < 64 ? a.w_eu + (size_t)(l * 64 + e) * DM * 256 : a.w_su + (size_t)l * DM * 256);
            c.N = 256; c.n0 = n0; c.k0 = kb * 64; c.WT = (bf16*)(ws + W_1) + (size_t)e * 512 * DM; c.dK = DM; c.drow0 = pn * 256 + which * 128 + i0;
        } else { const int kb = qq >> 5, nb = qq & 31;
            c.W = e < 64 ? a.w_ed + (size_t)(l * 64 + e) * 256 * DM : a.w_sd + (size_t)l * 256 * DM; c.N = DM; c.n0 = nb * 32; c.k0 = kb * 64; c.WT = (bf16*)(ws + W_2) + (size_t)e * DM * 256; c.dK = 256; c.drow0 = nb * 32; c.scale = Y_SCALE; }
        return c; }
    r -= CVT_I_E;
    c.mode = 2; c.n0 = r; c.W = nullptr; c.WT = nullptr; c.N = 0; c.k0 = 0; c.dK = 0; c.drow0 = 0; return c;
}
DI void cvt_load(const CvtItem& c, f32x4 (&v)[8], int lane) {
    if (c.mode == 2) return;
    if (c.nv == 32 && ((c.N | c.n0) & 3) == 0) {
#pragma unroll
        for (int i = 0; i < 8; ++i) v[i] = *(const f32x4*)(c.W + (size_t)(c.k0 + 8 * i + (lane >> 3)) * c.N + c.n0 + (lane & 7) * 4);
    } else {
#pragma unroll
        for (int i = 0; i < 8; ++i) { const float* p = c.W + (size_t)(c.k0 + 8 * i + (lane >> 3)) * c.N + c.n0 + (lane & 7) * 4; const int c4 = (lane & 7) * 4;
            v[i][0] = (c4 + 0 < c.nv) ? p[0] : 0.f; v[i][1] = (c4 + 1 < c.nv) ? p[1] : 0.f; v[i][2] = (c4 + 2 < c.nv) ? p[2] : 0.f; v[i][3] = (c4 + 3 < c.nv) ? p[3] : 0.f; }
    }
}
DI void cvt_finish(const Args& a, int l, const CvtItem& c, const f32x4 (&v)[8], LAS float* scr, int lane) {
    if (c.mode == 2) {
        const int j = c.n0; const float* pe = a.pe_cmp + (size_t)(l * 2 + j) * 2048; const float* w1 = a.w_cmp1 + (size_t)(l * 2 + j) * 2048 * 64;
        float s = 0.f;
        for (int k = 0; k < 2048; ++k) s += pe[k] * w1[(size_t)k * 64 + lane];
        ((float*)(a.ws + WS_CBIAS))[j * 64 + lane] = s; return; }
#pragma unroll
    for (int i = 0; i < 8; ++i) { const int kk = 8 * i + (lane >> 3), c4 = (lane & 7) * 4; scr[kk * 33 + c4] = v[i][0]; scr[kk * 33 + c4 + 1] = v[i][1]; scr[kk * 33 + c4 + 2] = v[i][2]; scr[kk * 33 + c4 + 3] = v[i][3]; }
    LDS_WAIT(); asm volatile("" ::: "memory");
    const int cc = lane & 7;
#pragma unroll
    for (int j = 0; j < 4; ++j) {
        const int n = (lane >> 3) + 8 * j; const LAS float* s = scr + (8 * cc) * 33 + n;
        float w[8];
#pragma unroll
        for (int q = 0; q < 8; ++q) { w[q] = s[q * 33] * c.scale; if (c.mode == 1) { const float h = __uint_as_float(cvtpk(w[q], 0.f) << 16); w[q] = w[q] - h; } }
        u32x4 o; o.x = cvtpk(w[0], w[1]); o.y = cvtpk(w[2], w[3]); o.z = cvtpk(w[4], w[5]); o.w = cvtpk(w[6], w[7]);
        if (n < c.nv) *(u32x4*)(c.WT + (size_t)(c.drow0 + n) * c.dK + c.k0 + 8 * cc) = o;
    }
    LDS_WAIT(); asm volatile("" ::: "memory");
}
DI void ph_cvt(const Args& a, int l, LAS unsigned char* lds, int gw, int NGW, int wave, int lane) {
    LAS float* scr = (LAS float*)(lds + wave * 8704);
    f32x4 va[8], vb[8];
    CvtItem ca, cb; ca.mode = 2; ca.n0 = 0;
    int it = gw;
    if (it < CVT_NIT) { ca = cvt_decode(a, l, it); cvt_load(ca, va, lane); }
    for (; it < CVT_NIT; it += 2 * NGW) {
        const bool hasb = it + NGW < CVT_NIT;
        if (hasb) { cb = cvt_decode(a, l, it + NGW); cvt_load(cb, vb, lane); }
        cvt_finish(a, l, ca, va, scr, lane);
        const bool hasa = it + 2 * NGW < CVT_NIT;
        if (hasa) { ca = cvt_decode(a, l, it + 2 * NGW); cvt_load(ca, va, lane); }
        if (hasb) cvt_finish(a, l, cb, vb, scr, lane);
    }
}

DI void rope4(float (&v)[4], int a, const float* rp, float scale) {
    float pv[4];
#pragma unroll
    for (int i = 0; i < 4; ++i) pv[i] = dpp_xor2(v[i]);
    const f32x4 c4 = *(const f32x4*)(rp + 4 * (a & 1)), s4 = *(const f32x4*)(rp + 8 + 4 * (a & 1));
    if (a < 4) {
#pragma unroll
        for (int i = 0; i < 4; ++i) v[i] = (a < 2) ? (v[i] * c4[i] - pv[i] * s4[i]) : (pv[i] * s4[i] + v[i] * c4[i]);
    }
#pragma unroll
    for (int i = 0; i < 4; ++i) v[i] *= scale;
}
DI void ld4bf(const bf16* p, float (&v)[4]) { const u32x2 w = *(const u32x2*)p; v[0] = bflo(w.x); v[1] = bfhi(w.x); v[2] = bflo(w.y); v[3] = bfhi(w.y); }
DI void st4bf(bf16* p, const float (&v)[4]) { u32x2 w; w.x = cvtpk(v[0], v[1]); w.y = cvtpk(v[2], v[3]); *(u32x2*)p = w; }

DI void ph_post(const Args& a, int l, LAS unsigned char* lds, int wave, int lane) {
    unsigned char* ws = a.ws;
    bf16* proj = (bf16*)(ws + WS_A);
    const float* rope = (const float*)(ws + WS_ROPE);
    const float* sm32 = (const float*)(ws + WS_SM32);
    LAS bf16* T = (LAS bf16*)(lds + wave * 9216);
    for (int tile = lbid(); tile < NTOK / 64; tile += lgrid()) {
        const int tok0 = tile * 64;
        float kmx = 0.f;
        for (int tt = wave; tt < 64; tt += NWAVES) {
            const int tok = tok0 + tt; bf16* row = proj + (size_t)tok * PW;
            const float* cs = rope + (size_t)tok * 16;
            const int ah = lane & 15;
            float v[4];
            ld4bf(row + C_AQ + 4 * lane, v); rope4(v, ah, cs, 1.0f); st4bf(row + C_AQ + 4 * lane, v);
            ld4bf(row + C_DQ + 4 * lane, v); rope4(v, ah, cs, 1.0f); st4bf(row + C_DQ + 4 * lane, v);
            ld4bf(row + C_DIQ + 4 * lane, v); rope4(v, ah, cs, 1.0f); st4bf(row + C_DIQ + 4 * lane, v);
            {
                const int tl = tok % SEQ, kin = tl & 31, slot = (kin & ~12) | ((kin & 4) << 1) | ((kin & 8) >> 1), hq = lane >> 4;
                const size_t toff = (((size_t)(tok / SEQ) * 4 + hq) * (SEQ / 32) + (tl >> 5)) * 2048 + ((ah >> 1) * 32 + slot) * 8 + (ah & 1) * 4;
                *(u32x2*)((bf16*)(ws + WS_KTB) + toff) = *(const u32x2*)(row + C_BK + 4 * lane);
                const u32x2 ckw = *(const u32x2*)(row + C_CK + 4 * lane);
                *(u32x2*)((bf16*)(ws + WS_KTC) + toff) = ckw;
                float sq = bflo(ckw.x) * bflo(ckw.x) + bfhi(ckw.x) * bfhi(ckw.x) + bflo(ckw.y) * bflo(ckw.y) + bfhi(ckw.y) * bfhi(ckw.y);
                sq += dpp_xor1(sq); sq += dpp_xor2(sq); sq += DPPF(sq, 0x124, 0xF, true); sq += DPPF(sq, 0x128, 0xF, true);
                kmx = fmaxf(kmx, sq);
            }
            { const int hk = lane >> 4; const int cb = (hk == 0) ? C_AKS : (hk == 1) ? C_AKW : (hk == 2) ? C_DK : C_DIK;
              ld4bf(row + cb + 4 * ah, v); rope4(v, ah, cs, 1.0f); st4bf(row + cb + 4 * ah, v);
              if (hk < 2) {
                  const int tl = tok % SEQ, kin = tl & 31, slot = (kin & ~12) | ((kin & 4) << 1) | ((kin & 8) >> 1);
                  bf16* kt = (bf16*)(ws + (hk == 0 ? WS_KTS : WS_KTW)) + ((size_t)(tok / SEQ) * (SEQ / 32) + (tl >> 5)) * 2048 + ((ah >> 1) * 32 + slot) * 8 + (ah & 1) * 4;
                  st4bf(kt, v); }
              if (hk == 3) {
                  const int tl = tok % SEQ;
                  bf16* it = (bf16*)(ws + WS_IKT) + ((size_t)(tok / SEQ) * (SEQ / 32) + (tl >> 5)) * 2048 + ((ah >> 1) * 32 + (tl & 31)) * 8 + (ah & 1) * 4;
                  st4bf(it, v); } }
            if (lane < 32) { const int j = lane >> 4; const u32x2 w = *(const u32x2*)(row + (j ? C_AVC : C_AKC) + 4 * ah);
                *(u32x2*)((bf16*)(ws + (j ? WS_VCR : WS_KCR)) + (size_t)tok * 64 + 4 * ah) = w; }
            if (lane < 20) {
                const float s = sm32[(size_t)tok * 32 + lane];
                if (lane < 12) ((float*)(ws + WS_GATE))[(size_t)tok * 12 + lane] = sigmoidf_(s);
                else if (lane < 16) { const float z = s + a.b_f[l * 4 + (lane - 12)];
                    ((float*)(ws + WS_LOGF))[(size_t)tok * 4 + (lane - 12)] = fminf(z, 0.f) * LOG2E - flog2(1.f + fexp2(-fabsf(z) * LOG2E)); }
                else ((float*)(ws + WS_IW))[(size_t)tok * 4 + (lane - 16)] = s;
            }
        }
        if ((lane & 15) == 0) atomicMax((unsigned*)(ws + WS_CTL) + CW_KMAX + l * 32 + (tok0 / SEQ) * 4 + (lane >> 4), __float_as_uint(kmx * 1.02f));
        const int bidx = tok0 / SEQ, tl0 = tok0 % SEQ;
        for (int hv = wave; hv < 10; hv += NWAVES) {
            int cb; bf16* dst;
            if (hv < 4) { cb = C_BV + 64 * hv; dst = (bf16*)(ws + WS_VTB) + (size_t)(bidx * 4 + hv) * 64 * SEQ; }
            else if (hv < 8) { cb = C_CV + 64 * (hv - 4); dst = (bf16*)(ws + WS_VTC) + (size_t)(bidx * 4 + hv - 4) * 64 * SEQ; }
            else if (hv == 8) { cb = C_AVS; dst = (bf16*)(ws + WS_VTAS) + (size_t)bidx * 64 * SEQ; }
            else { cb = C_AVW; dst = (bf16*)(ws + WS_VTAW) + (size_t)bidx * 64 * SEQ; }
            const bf16* src = proj + (size_t)(tok0 + lane) * PW + cb;
#pragma unroll
            for (int i = 0; i < 8; ++i) { const u32x4 w = *(const u32x4*)(src + 8 * i);
                T[(8 * i + 0) * 72 + lane] = (bf16)(w.x & 0xffff); T[(8 * i + 1) * 72 + lane] = (bf16)(w.x >> 16);
                T[(8 * i + 2) * 72 + lane] = (bf16)(w.y & 0xffff); T[(8 * i + 3) * 72 + lane] = (bf16)(w.y >> 16);
                T[(8 * i + 4) * 72 + lane] = (bf16)(w.z & 0xffff); T[(8 * i + 5) * 72 + lane] = (bf16)(w.z >> 16);
                T[(8 * i + 6) * 72 + lane] = (bf16)(w.w & 0xffff); T[(8 * i + 7) * 72 + lane] = (bf16)(w.w >> 16); }
            LDS_WAIT(); asm volatile("" ::: "memory");
            {
                const int dt = lane >> 5, cc = lane & 31;
#pragma unroll
                for (int i = 0; i < 8; ++i) { const int tile = i >> 2, sh = i & 3;
                    bf16* d = dst + ((size_t)(tl0 >> 5) + tile) * 2048 + ((dt * 2 + (sh >> 1)) * 64 + (sh & 1) * 32 + cc) * 8;
                    *(u32x4*)d = *(const LAS u32x4*)(T + lane * 72 + 8 * i); }
            }
            LDS_WAIT(); asm volatile("" ::: "memory");
        }
    }
}

DI void cumsum_seq(const Args& a, int bh, int lane) {
    const float* lf = (const float*)(a.ws + WS_LOGF); float* cum = (float*)(a.ws + WS_CUM);
    const int b = bh >> 2, h = bh & 3;
    const float* src = lf + ((size_t)b * SEQ + lane * 128) * 4 + h;
    float s = 0.f;
    for (int i = 0; i < 128; ++i) s += src[(size_t)i * 4];
    const float incl = wave_incl_scan_f(s);
    float run = incl - s;
    float* dst = cum + (size_t)bh * SEQ + lane * 128;
    for (int i = 0; i < 128; ++i) { run += src[(size_t)i * 4]; dst[i] = run; }
}

DI void ph_cmp2(const Args& a, int l, int gw, int NGW, int lane) {
    const float* hid = (const float*)(a.ws + WS_HID);
    bf16* kc = (bf16*)(a.ws + WS_KCMP); bf16* vtc = (bf16*)(a.ws + WS_VTCMP);
    for (int it = gw; it < 2 * 4096; it += NGW) {
        const int j = it >> 12, row = it & 4095, b = row >> 9, n = row & 511;
        const float* h = hid + ((size_t)j * 4096 + row) * 64; const float* w2 = a.w_cmp2 + (size_t)(l * 2 + j) * 64 * 64;
        float s = 0.f;
#pragma unroll 8
        for (int k = 0; k < 64; ++k) s += h[k] * w2[k * 64 + lane];
        if (n == 511) s = 0.f;
        const bf16 o = (bf16)(cvtpk(s, 0.f) & 0xffff);
        const int tile = n >> 5, kin = n & 31;
        if (j == 0) { const int slot = (kin & ~12) | ((kin & 4) << 1) | ((kin & 8) >> 1); kc[((size_t)b * 16 + tile) * 2048 + ((lane >> 3) * 32 + slot) * 8 + (lane & 7)] = o; }
        else { const int sI = kin >> 4, hI = (kin >> 3) & 1, e = kin & 7; vtc[((size_t)b * 16 + tile) * 2048 + (((lane >> 5) * 2 + sI) * 64 + hI * 32 + (lane & 31)) * 8 + e] = o; }
    }
}

DI void ph_ln1(const Args& a, int l, int gw, int NGW, int lane) {
    bf16* xb = (bf16*)(a.ws + WS_XB); bf16* xl = (bf16*)(a.ws + WS_XL);
    const float* g = a.ln1_g + l * DM; const float* be = a.ln1_b + l * DM;
    u32x4 nq0 = {0u,0u,0u,0u}, nq1 = {0u,0u,0u,0u};
    if (gw < NTOK) { const u32x4* x0 = (const u32x4*)(xb + (size_t)gw * DM) + lane; nq0 = x0[0]; nq1 = x0[64]; }
    for (int row = gw; row < NTOK; row += NGW) {
        u32x4* xr = (u32x4*)(xb + (size_t)row * DM) + lane; u32x4* lr = (u32x4*)(xl + (size_t)row * DM) + lane;
        const u32x4 qq[2] = {nq0, nq1};
        if (row + NGW < NTOK) { const u32x4* xn = (const u32x4*)(xb + (size_t)(row + NGW) * DM) + lane; nq0 = xn[0]; nq1 = xn[64]; }
        f32x4 v[4]; float s = 0.f;
#pragma unroll
        for (int j = 0; j < 2; ++j) { const u32x4 q = qq[j];
            v[2 * j] = (f32x4){bflo(q.x), bfhi(q.x), bflo(q.y), bfhi(q.y)}; v[2 * j + 1] = (f32x4){bflo(q.z), bfhi(q.z), bflo(q.w), bfhi(q.w)}; }
#pragma unroll
        for (int j = 0; j < 4; ++j) s += (v[j].x + v[j].y) + (v[j].z + v[j].w);
        const float mean = wave_sum(s) * (1.f / DM); float s2 = 0.f;
#pragma unroll
        for (int j = 0; j < 4; ++j) { v[j] = v[j] - mean; s2 += (v[j].x * v[j].x + v[j].y * v[j].y) + (v[j].z * v[j].z + v[j].w * v[j].w); }
        const float rstd = 1.f / sqrtf(wave_sum(s2) * (1.f / DM) + LN_EPS);
#pragma unroll
        for (int j = 0; j < 2; ++j) {
            const int cb = 8 * lane + 512 * j;
            const f32x4 g0 = *(const f32x4*)(g + cb), g1 = *(const f32x4*)(g + cb + 4), b0 = *(const f32x4*)(be + cb), b1 = *(const f32x4*)(be + cb + 4);
            const f32x4 y0 = v[2 * j] * rstd * g0 + b0, y1 = v[2 * j + 1] * rstd * g1 + b1;
            const u32x4 hi = pack8(y0, y1);
            const f32x4 r0 = {y0[0] - bflo(hi.x), y0[1] - bfhi(hi.x), y0[2] - bflo(hi.y), y0[3] - bfhi(hi.y)}, r1 = {y1[0] - bflo(hi.z), y1[1] - bfhi(hi.z), y1[2] - bflo(hi.w), y1[3] - bfhi(hi.w)};
            xr[64 * j] = hi; lr[64 * j] = pack8(r0, r1);
        }
    }
}

DI void ph_route(const Args& a, int l, LAS unsigned char* lds, int wave, int lane) {
    const float* logit = (const float*)(a.ws + WS_LOGIT);
    u32x2* tokinfo = (u32x2*)(a.ws + WS_TOKINFO);
    unsigned* lists = (unsigned*)(a.ws + WS_LIST);
    unsigned* gcnt = (unsigned*)(a.ws + WS_CTL) + CW_CNT + l * NCH * 64;
    LAS unsigned* lcnt = (LAS unsigned*)lds;
    LAS unsigned* lbase = lcnt + 64;
    LAS unsigned* stash = lbase + 64;
    const float rb = a.router_bias[l * 64 + lane];
    for (int blk = lbid(); blk < NTOK / 256; blk += lgrid()) {
        const int tok0 = blk * 256, c = tok0 / CHTOK;
        if (ltid() < 64) lcnt[ltid()] = 0u;
        __syncthreads();
        for (int tt = wave; tt < 256; tt += NWAVES) {
            const int tok = tok0 + tt;
            const float sc = sigmoidf_(logit[(size_t)tok * 64 + lane]);
            const float bi = sc + rb;
            float m1 = bi;
            m1 = fmaxf(m1, __shfl_xor(m1, 1)); m1 = fmaxf(m1, __shfl_xor(m1, 2)); m1 = fmaxf(m1, __shfl_xor(m1, 4));
            const unsigned long long eqm = __ballot(bi == m1);
            const int gsh = lane & ~7; const unsigned gm = (unsigned)((eqm >> gsh) & 0xffu);
            const int first = __builtin_ctz(gm);
            float v2 = ((lane & 7) == first) ? -3.0e38f : bi;
            v2 = fmaxf(v2, __shfl_xor(v2, 1)); v2 = fmaxf(v2, __shfl_xor(v2, 2)); v2 = fmaxf(v2, __shfl_xor(v2, 4));
            const float gs = m1 + v2;
            const int g = lane >> 3; int grank = 0;
#pragma unroll
            for (int gg = 0; gg < 8; ++gg) { const float o = __int_as_float(__builtin_amdgcn_readlane(__float_as_int(gs), gg * 8)); grank += (o > gs || (o == gs && gg < g)) ? 1 : 0; }
            const float mb = (grank < 4) ? bi : -1.0e30f;
            int rank = 0;
#pragma unroll 4
            for (int e = 0; e < 64; ++e) { const float o = __int_as_float(__builtin_amdgcn_readlane(__float_as_int(mb), e)); rank += (o > mb || (o == mb && e < lane)) ? 1 : 0; }
            const bool sel = rank < 8;
            const float wsum = wave_sum(sel ? sc : 0.f);
            const float w = sc / wsum * 2.5f;
            const unsigned long long sm = __ballot(sel);
            const int k = __popcll(sm & ((1ull << lane) - 1ull));
            if (sel) {
                const unsigned lp = atomicAdd((unsigned*)&lcnt[lane], 1u);
                stash[tt * 8 + k] = ((unsigned)lane << 16) | lp;
                ((float*)tokinfo)[((size_t)tok * 8 + k) * 2 + 1] = w;
            }
        }
        __syncthreads();
        if (ltid() < 64) lbase[ltid()] = atomicAdd(&gcnt[c * 64 + ltid()], lcnt[ltid()]);
        __syncthreads();
        for (int i = ltid(); i < 256 * 8; i += NWAVES * 64) {
            const unsigned s = stash[i]; const unsigned e = s >> 16, lp = s & 0xffffu; const int tok = tok0 + (i >> 3);
            const unsigned pos = lbase[e] + lp;
            lists[((size_t)c * 64 + e) * CHTOK + pos] = (unsigned)tok;
            ((unsigned*)tokinfo)[((size_t)tok * 8 + (i & 7)) * 2] = (e << 16) | pos;
        }
        __syncthreads();
    }
}

typedef f32x4 Acc2[2][2][4][2];
typedef f32x4 Acc1[2][1][4][2];

struct SchedProj {
    static constexpr bool GATHER = false, FIXED = true;
    gs::StaticOrder so; unsigned A, B;
    DI bool next(int i, gs::GU& u) const { gs::Unit t; if (!so.next(i, t)) return false;
        u.A = A + (unsigned)t.pm * 256u * 2048u; u.B = B + (unsigned)t.pn * 256u * 2048u; u.idx = nullptr; u.lda = 2048; u.ldb = 2048; u.nt = 16; u.flags = 3; u.nvalid = 256;
        u.a0 = t.pm; u.a1 = t.pn; u.a2 = 0; u.a3 = 0; return true; }
};
struct EpiProj {
    static constexpr bool PERM = true; static constexpr bool BH8 = false; bf16* proj; float* sm32;
    DI void operator()(const Acc2& acc, const gs::GU& u, int wr, int wc, int fr, int fq) const {
        const int row0 = u.a0 * 256 + wr * 64 + fr, col0 = u.a1 * 256 + wc * 32 + 8 * fq;
#pragma unroll
        for (int ai = 0; ai < 2; ++ai)
#pragma unroll
            for (int m = 0; m < 4; ++m) { const int row = row0 + ai * 128 + m * 16;
#pragma unroll
                for (int bj = 0; bj < 2; ++bj) *(u32x4*)(proj + (size_t)row * PW + col0 + bj * 128) = pack8(acc[ai][bj][m][0], acc[ai][bj][m][1]);
                if (u.a1 == 11 && wc == 2) { *(f32x4*)(sm32 + (size_t)row * 32 + 8 * fq) = acc[ai][0][m][0]; *(f32x4*)(sm32 + (size_t)row * 32 + 8 * fq + 4) = acc[ai][0][m][1]; } }
    }
};

struct SchedCmp {
    static constexpr bool GATHER = false, FIXED = true;
    unsigned kcr, vcr, w;
    DI bool next(int i, gs::GU& u) const { if (i > 0 || lbid() >= 32) return false; const int j = lbid() >> 4, pm = lbid() & 15;
        u.A = (j ? vcr : kcr) + (unsigned)pm * 256u * 2048u; u.B = w + (unsigned)j * 256u * 4096u; u.idx = nullptr; u.lda = 2048; u.ldb = 4096; u.nt = 32; u.flags = 3; u.nvalid = 256;
        u.a0 = pm; u.a1 = j; u.a2 = 0; u.a3 = 0; return true; }
};
struct EpiCmp {
    static constexpr bool PERM = true; static constexpr bool BH8 = false; float* hid; const float* cbias;
    DI void operator()(const Acc2& acc, const gs::GU& u, int wr, int wc, int fr, int fq) const {
        if (wc >= 2) return;
        const int row0 = u.a0 * 256 + wr * 64 + fr, col0 = wc * 32 + 8 * fq, j = u.a1;
        float cb[8];
#pragma unroll
        for (int q = 0; q < 8; ++q) cb[q] = cbias[j * 64 + col0 + q];
#pragma unroll
        for (int ai = 0; ai < 2; ++ai)
#pragma unroll
            for (int m = 0; m < 4; ++m) { const int row = row0 + ai * 128 + m * 16; float o[8];
#pragma unroll
                for (int q = 0; q < 8; ++q) { const float x = acc[ai][0][m][q >> 2][q & 3] + cb[q];
                    const float y2 = 1.5957691216f * (x + 0.044715f * x * x * x);
                    o[q] = x * frcp(1.f + fexp2(-y2 * LOG2E)); }
                float* d = hid + ((size_t)j * 4096 + row) * 64 + col0;
                *(f32x4*)d = (f32x4){o[0], o[1], o[2], o[3]}; *(f32x4*)(d + 4) = (f32x4){o[4], o[5], o[6], o[7]}; }
    }
};

struct SchedMerge {
    static constexpr bool GATHER = false, FIXED = false;
    unsigned xb, om, wg, wbr; int G;
    DI bool next(int i, gs::GU& u) const { const int ti = i >> 3, k = i & 7; const int bid_ = lbid(); const long L = (long)ti * G + bid_; if (L >= 2048) return false;
        int pm = (int)(L >> 3), pc = (int)(L & 7); const int m = k >> 1, kind = k & 1;
        if (G == 256) { const int x = bid_ & 7, idx = bid_ >> 3; pm = ti * 32 + x * 4 + (idx >> 3); pc = idx & 7; }
        if (kind == 0) { u.A = om + (unsigned)pm * 256u * 2048u + (unsigned)m * 512u; u.B = wbr + (unsigned)m * 1024u * 512u + (unsigned)pc * 128u * 512u; u.lda = 2048; u.ldb = 512; u.nt = 4; }
        else           { u.A = xb + (unsigned)pm * 256u * 2048u;           u.B = wg + (unsigned)m * 1024u * 2048u + (unsigned)pc * 128u * 2048u; u.lda = 2048; u.ldb = 2048; u.nt = 16; }
        u.idx = nullptr; u.flags = 3; u.nvalid = 256; u.a0 = pm; u.a1 = pc; u.a2 = kind; u.a3 = m; return true; }
};
struct EpiMerge {
    static constexpr bool PERM = true; static constexpr bool BH8 = false; bf16* merged; u32x4* stash;
    f32x4 M[2][4][2];
    DI void operator()(const Acc1& acc, const gs::GU& u, int wr, int wc, int fr, int fq) {
        const int tid = ltid();
        if (u.a2 == 0) {
#pragma unroll
            for (int ai = 0; ai < 2; ++ai)
#pragma unroll
                for (int m = 0; m < 4; ++m) stash[(ai * 4 + m) * 512 + tid] = pack8(acc[ai][0][m][0], acc[ai][0][m][1]);
        } else {
            const bool first = (u.a3 == 0), lastm = (u.a3 == 3);
            const int row0 = u.a0 * 256 + wr * 64 + fr, col0 = u.a1 * 128 + wc * 32 + 8 * fq;
            if (first) {
#pragma unroll
                for (int ai = 0; ai < 2; ++ai)
#pragma unroll
                    for (int m = 0; m < 4; ++m) { M[ai][m][0] = (f32x4){0.f, 0.f, 0.f, 0.f}; M[ai][m][1] = (f32x4){0.f, 0.f, 0.f, 0.f}; }
            }
#pragma unroll
            for (int ai = 0; ai < 2; ++ai)
#pragma unroll
                for (int m = 0; m < 4; ++m) {
                    const u32x4 p = stash[(ai * 4 + m) * 512 + tid];
                    const f32x4 g0 = acc[ai][0][m][0], g1 = acc[ai][0][m][1];
                    f32x4 m0 = M[ai][m][0], m1 = M[ai][m][1];
                    m0[0] = __builtin_fmaf(frcp(1.f + fexp2(g0[0])), bflo(p.x), m0[0]); m0[1] = __builtin_fmaf(frcp(1.f + fexp2(g0[1])), bfhi(p.x), m0[1]);
                    m0[2] = __builtin_fmaf(frcp(1.f + fexp2(g0[2])), bflo(p.y), m0[2]); m0[3] = __builtin_fmaf(frcp(1.f + fexp2(g0[3])), bfhi(p.y), m0[3]);
                    m1[0] = __builtin_fmaf(frcp(1.f + fexp2(g1[0])), bflo(p.z), m1[0]); m1[1] = __builtin_fmaf(frcp(1.f + fexp2(g1[1])), bfhi(p.z), m1[1]);
                    m1[2] = __builtin_fmaf(frcp(1.f + fexp2(g1[2])), bflo(p.w), m1[2]); m1[3] = __builtin_fmaf(frcp(1.f + fexp2(g1[3])), bfhi(p.w), m1[3]);
                    M[ai][m][0] = m0; M[ai][m][1] = m1;
                    asm volatile("" : "+v"(M[ai][m][0]), "+v"(M[ai][m][1]));
                    if (lastm) *(u32x4*)(merged + (size_t)(row0 + ai * 128 + m * 16) * DM + col0) = pack8(M[ai][m][0], M[ai][m][1]);
                    asm volatile("" ::: "memory");
                }
        }
    }
};

struct SchedWo {
    static constexpr bool GATHER = false, FIXED = true;
    gs::StaticOrder so; unsigned A, B;
    DI bool next(int i, gs::GU& u) const { gs::Unit t; if (!so.next(i, t)) return false;
        u.A = A + (unsigned)t.pm * 256u * 2048u; u.B = B + (unsigned)t.pn * 256u * 2048u; u.idx = nullptr; u.lda = 2048; u.ldb = 2048; u.nt = 16; u.flags = 3; u.nvalid = 256;
        u.a0 = t.pm; u.a1 = t.pn; u.a2 = 0; u.a3 = 0; return true; }
};
struct EpiWo {
    static constexpr bool PERM = true; static constexpr bool BH8 = false; bf16* xb;
    DI void operator()(const Acc2& acc, const gs::GU& u, int wr, int wc, int fr, int fq) const {
        const int row0 = u.a0 * 256 + wr * 64 + fr, col0 = u.a1 * 256 + wc * 32 + 8 * fq;
#pragma unroll
        for (int ai = 0; ai < 2; ++ai)
#pragma unroll
            for (int m = 0; m < 4; ++m) {
#pragma unroll
                for (int bj = 0; bj < 2; ++bj) { bf16* p = xb + (size_t)(row0 + ai * 128 + m * 16) * DM + col0 + bj * 128; const u32x4 xv = *(const u32x4*)p;
                    f32x4 v0 = acc[ai][bj][m][0], v1 = acc[ai][bj][m][1];
                    v0[0] += ALPHA * bflo(xv.x); v0[1] += ALPHA * bfhi(xv.x); v0[2] += ALPHA * bflo(xv.y); v0[3] += ALPHA * bfhi(xv.y);
                    v1[0] += ALPHA * bflo(xv.z); v1[1] += ALPHA * bfhi(xv.z); v1[2] += ALPHA * bflo(xv.w); v1[3] += ALPHA * bfhi(xv.w);
                    *(u32x4*)p = pack8(v0, v1); } }
    }
};

struct SchedRouter {
    static constexpr bool GATHER = false, FIXED = true;
    unsigned xh, xl, wh, wl; int G;
    DI bool next(int i, gs::GU& u) const { const int ti = i / 3, k = i % 3; const int pm = ti * G + lbid(); if (pm >= 256) return false;
        u.A = ((k == 1) ? xl : xh) + (unsigned)pm * 256u * 2048u; u.B = (k == 2) ? wl : wh; u.idx = nullptr; u.lda = 2048; u.ldb = 2048; u.nt = 16;
        u.flags = (k == 0 ? 1 : 0) | (k == 2 ? 2 : 0); u.nvalid = 256; u.a0 = pm; u.a1 = 0; u.a2 = 0; u.a3 = 0; return true; }
};
struct EpiRouter {
    static constexpr bool PERM = false; static constexpr bool BH8 = false; float* logit;
    DI void operator()(const Acc1& acc, const gs::GU& u, int wr, int wc, int fr, int fq) const {
        if (wc >= 2) return;
        const int row0 = u.a0 * 256 + wr * 64 + fr, col0 = wc * 32 + 4 * fq;
#pragma unroll
        for (int ai = 0; ai < 2; ++ai)
#pragma unroll
            for (int m = 0; m < 4; ++m)
#pragma unroll
                for (int n = 0; n < 2; ++n) *(f32x4*)(logit + (size_t)(row0 + ai * 128 + m * 16) * 64 + col0 + n * 16) = acc[ai][0][m][n];
    }
};

constexpr int TBL_OFF = 131072, NPAIR = NCH * 65, TBLN = 528;
static_assert(NPAIR + 1 <= TBLN && TBL_OFF + 3 * TBLN * 4 <= MISC_OFF, "MoE tables");
DI void moe_tables(const Args& a, int l, LAS unsigned char* lds) {
    LAS int* ptile = (LAS int*)(lds + TBL_OFF); LAS int* ypre = ptile + TBLN; LAS int* cntv = ypre + TBLN;
    __syncthreads();
    const int tid_ = ltid();
    if (tid_ < 64) {
        const unsigned* gcnt = (const unsigned*)(a.ws + WS_CTL) + CW_CNT + l * NCH * 64;
        int pt = 0;
        for (int c = 0; c < NCH; ++c) {
            const int n = (int)__hip_atomic_load(gcnt + c * 64 + tid_, __ATOMIC_RELAXED, __HIP_MEMORY_SCOPE_AGENT);
            const int tl = (n + 255) >> 8;
            const int tinc = wave_incl_scan(tl), yinc = wave_incl_scan(n);
            const int p = c * 65 + tid_;
            cntv[p] = n; ptile[p] = pt + tinc - tl; ypre[p] = yinc - n;
            const int ttot = __builtin_amdgcn_readlane(tinc, 63), ytot = __builtin_amdgcn_readlane(yinc, 63);
            if (tid_ == 0) { cntv[c * 65 + 64] = CHTOK; ptile[c * 65 + 64] = pt + ttot; ypre[c * 65 + 64] = ytot; }
            pt += ttot + CHTOK / 256;
        }
        if (tid_ == 0) ptile[NPAIR] = pt;
    }
    __syncthreads();
}
DI int find_pair(const LAS int* ptile, int tile) {
    int lo = 0, hi = NPAIR;
    while (hi - lo > 1) { const int mid = (lo + hi) >> 1; if (ptile[mid] <= tile) lo = mid; else hi = mid; }
    return lo;
}
struct SchedE1 {
    static constexpr bool GATHER = true, FIXED = false;
    const LAS int* ptile; const LAS int* cntv; unsigned xb; const unsigned* lists; unsigned w1; int G;
    DI bool next(int i, gs::GU& u) const { const int bid_ = lbid(); int un = i * G + bid_;
        if (G == 256) { const int x = bid_ & 7, idx = bid_ >> 3; un = (i * 128 + x * 16 + (idx >> 1)) * 2 + (idx & 1); }
        const int tile = un >> 1, pn = un & 1; if (tile >= ptile[NPAIR]) return false;
        const int p = find_pair(ptile, tile), c = p / 65, e = p % 65, t = tile - ptile[p];
        if (e < 64) { u.A = xb; u.idx = (const int*)(lists + ((size_t)c * 64 + e) * CHTOK + (size_t)t * 256); u.nvalid = cntv[p] - t * 256; }
        else { u.A = xb + ((unsigned)c * CHTOK + (unsigned)t * 256u) * 2048u; u.idx = nullptr; u.nvalid = 256; }
        u.B = w1 + (unsigned)e * 512u * 2048u + (unsigned)pn * 256u * 2048u; u.lda = 2048; u.ldb = 2048; u.nt = 16; u.flags = 3; u.a0 = tile; u.a1 = pn; u.a2 = 0; u.a3 = 0; return true; }
};
struct EpiE1 {
    static constexpr bool PERM = true; static constexpr bool BH8 = false; bf16* hb;
    DI void operator()(const Acc2& acc, const gs::GU& u, int wr, int wc, int fr, int fq) const {
        const int row0 = u.a0 * 256 + wr * 64 + fr, col0 = u.a1 * 128 + wc * 32 + 8 * fq;
#pragma unroll
        for (int ai = 0; ai < 2; ++ai)
#pragma unroll
            for (int m = 0; m < 4; ++m) { f32x4 h[2];
#pragma unroll
                for (int n = 0; n < 2; ++n)
#pragma unroll
                    for (int q = 0; q < 4; ++q) { const float g = acc[ai][0][m][n][q], up = acc[ai][1][m][n][q]; h[n][q] = g * sigmoidf_(g) * up; }
                *(u32x4*)(hb + (size_t)(row0 + ai * 128 + m * 16) * 256 + col0) = pack8(h[0], h[1]); }
    }
};
struct SchedE2 {
    static constexpr bool GATHER = false, FIXED = true;
    const LAS int* ptile; const LAS int* cntv; const LAS int* ypre; unsigned hb, w2; int c; int G;
    DI bool next(int i, gs::GU& u) const { const int bid_ = lbid(); int un = i * G + bid_;
        if (G == 256) { const int x = bid_ & 7, idx = bid_ >> 3; un = (i * 64 + x * 8 + (idx >> 2)) * 4 + (idx & 3); }
        const int tile = ptile[c * 65] + (un >> 2), pn = un & 3; if (tile >= ptile[(c + 1) * 65]) return false;
        const int p = find_pair(ptile, tile), e = p % 65, t = tile - ptile[p];
        u.A = hb + (unsigned)tile * 256u * 512u; u.B = w2 + (unsigned)e * 1024u * 512u + (unsigned)pn * 256u * 512u; u.idx = nullptr; u.lda = 512; u.ldb = 512; u.nt = 4; u.flags = 3;
        u.nvalid = 256; u.a0 = (tile - ptile[c * 65]) * 256; u.a1 = pn; u.a2 = 0; u.a3 = 0; return true; }
};
DI unsigned pk4_fp8(float a, float b, float c, float d) { int w = __builtin_amdgcn_cvt_pk_fp8_f32(a, b, 0, false); w = __builtin_amdgcn_cvt_pk_fp8_f32(c, d, w, true); return (unsigned)w; }
struct EpiE2 {
    static constexpr bool PERM = true; static constexpr bool BH8 = true; unsigned char* y;
    DI void operator()(const Acc2& acc, const gs::GU& u, int wr, int wc, int fr, int fq) const {
        const int row0 = u.a0 + wr * 64 + fr, col0 = u.a1 * 256 + wc * 64 + 16 * fq;
#pragma unroll
        for (int ai = 0; ai < 2; ++ai)
#pragma unroll
            for (int m = 0; m < 4; ++m) {
                u32x4 w;
                { const f32x4 v0 = acc[ai][0][m][0], v1 = acc[ai][0][m][1]; w.x = pk4_fp8(v0[0], v0[1], v0[2], v0[3]); w.y = pk4_fp8(v1[0], v1[1], v1[2], v1[3]); }
                { const f32x4 v0 = acc[ai][1][m][0], v1 = acc[ai][1][m][1]; w.z = pk4_fp8(v0[0], v0[1], v0[2], v0[3]); w.w = pk4_fp8(v1[0], v1[1], v1[2], v1[3]); }
                *(u32x4*)(y + (size_t)(row0 + ai * 128 + m * 16) * DM + col0) = w; }
    }
};

DI void ph_ln2(const Args& a, int l, int c, LAS unsigned char* lds, int gw, int NGW, int lane) {
    const LAS int* ptile = (const LAS int*)(lds + TBL_OFF);
    bf16* xb = (bf16*)(a.ws + WS_XB); const unsigned char* y = (const unsigned char*)(a.ws + WS_Y);
    const u32x2* tokinfo = (const u32x2*)(a.ws + WS_TOKINFO);
    const float* g = a.ln2_g + l * DM; const float* be = a.ln2_b + l * DM;
    u32x4 nx0 = {0u,0u,0u,0u}, nx1 = {0u,0u,0u,0u}; u32x2 nti = {0u, 0u};
    if (gw < CHTOK) { const int row0 = c * CHTOK + gw; const u32x4* xr0 = (const u32x4*)(xb + (size_t)row0 * DM) + lane; nx0 = xr0[0]; nx1 = xr0[64]; if (lane < 8) nti = tokinfo[(size_t)row0 * 8 + lane]; }
    for (int tt = gw; tt < CHTOK; tt += NGW) {
        const int row = c * CHTOK + tt;
        const u32x4 cx0 = nx0, cx1 = nx1; const u32x2 cti = nti;
        if (tt + NGW < CHTOK) { const int rown = row + NGW; const u32x4* xrn = (const u32x4*)(xb + (size_t)rown * DM) + lane; nx0 = xrn[0]; nx1 = xrn[64]; if (lane < 8) nti = tokinfo[(size_t)rown * 8 + lane]; }
        u32x4* xr = (u32x4*)(xb + (size_t)row * DM) + lane;
        f32x4 v[4];
        v[0] = (f32x4){bflo(cx0.x), bfhi(cx0.x), bflo(cx0.y), bfhi(cx0.y)} * ALPHA; v[1] = (f32x4){bflo(cx0.z), bfhi(cx0.z), bflo(cx0.w), bfhi(cx0.w)} * ALPHA;
        v[2] = (f32x4){bflo(cx1.x), bfhi(cx1.x), bflo(cx1.y), bfhi(cx1.y)} * ALPHA; v[3] = (f32x4){bflo(cx1.z), bfhi(cx1.z), bflo(cx1.w), bfhi(cx1.w)} * ALPHA;
        int yrv = 0; float wv = 1.f;
        if (lane < 8) { const u32x2 ti = cti; yrv = (ptile[c * 65 + (int)(ti.x >> 16)] - ptile[c * 65]) * 256 + (int)(ti.x & 0xffffu); wv = __uint_as_float(ti.y); }
        else if (lane == 8) yrv = (ptile[c * 65 + 64] - ptile[c * 65]) * 256 + tt;
        u32x2 q[9][2]; float wk[9];
#pragma unroll
        for (int k = 0; k < 9; ++k) { const int yrow = __builtin_amdgcn_readlane(yrv, k); wk[k] = __int_as_float(__builtin_amdgcn_readlane(__float_as_int(wv), k)) * (1.f / Y_SCALE);
            const u32x2* yr = (const u32x2*)(y + (size_t)yrow * DM) + lane; q[k][0] = yr[0]; q[k][1] = yr[64]; }
#pragma unroll
        for (int k = 0; k < 9; ++k) {
#pragma unroll
            for (int j = 0; j < 2; ++j) { const float ws_ = wk[k]; const u32x2 qq = q[k][j];
                v[2 * j][0] += ws_ * __builtin_amdgcn_cvt_f32_fp8((int)qq.x, 0); v[2 * j][1] += ws_ * __builtin_amdgcn_cvt_f32_fp8((int)qq.x, 1); v[2 * j][2] += ws_ * __builtin_amdgcn_cvt_f32_fp8((int)qq.x, 2); v[2 * j][3] += ws_ * __builtin_amdgcn_cvt_f32_fp8((int)qq.x, 3);
                v[2 * j + 1][0] += ws_ * __builtin_amdgcn_cvt_f32_fp8((int)qq.y, 0); v[2 * j + 1][1] += ws_ * __builtin_amdgcn_cvt_f32_fp8((int)qq.y, 1); v[2 * j + 1][2] += ws_ * __builtin_amdgcn_cvt_f32_fp8((int)qq.y, 2); v[2 * j + 1][3] += ws_ * __builtin_amdgcn_cvt_f32_fp8((int)qq.y, 3); }
        }
        float s = 0.f;
#pragma unroll
        for (int j = 0; j < 4; ++j) s += (v[j].x + v[j].y) + (v[j].z + v[j].w);
        const float mean = wave_sum(s) * (1.f / DM); float s2 = 0.f;
#pragma unroll
        for (int j = 0; j < 4; ++j) { v[j] = v[j] - mean; s2 += (v[j].x * v[j].x + v[j].y * v[j].y) + (v[j].z * v[j].z + v[j].w * v[j].w); }
        const float rstd = 1.f / sqrtf(wave_sum(s2) * (1.f / DM) + LN_EPS);
#pragma unroll
        for (int j = 0; j < 2; ++j) {
            const int cb = 8 * lane + 512 * j;
            const f32x4 g0 = *(const f32x4*)(g + cb), g1 = *(const f32x4*)(g + cb + 4), b0 = *(const f32x4*)(be + cb), b1 = *(const f32x4*)(be + cb + 4);
            const f32x4 y0 = v[2 * j] * rstd * g0 + b0, y1 = v[2 * j + 1] * rstd * g1 + b1;
            xr[64 * j] = pack8(y0, y1);
            if (l == DEPTH - 1) { float* o = a.out + (size_t)row * DM + cb; *(f32x4*)o = y0; *(f32x4*)(o + 4) = y1; }
        }
    }
}

DI int pi32(int r) { return (r & ~12) | ((r & 4) << 1) | ((r & 8) >> 1); }
DI int kofs(int i, int hh) { return 16 * (i >> 3) + 8 * hh + (i & 7); }
DI bf16x8 pack_p(const float (&p)[16], int s) {
    u32x4 w; w.x = cvtpk(p[8 * s], p[8 * s + 1]); w.y = cvtpk(p[8 * s + 2], p[8 * s + 3]); w.z = cvtpk(p[8 * s + 4], p[8 * s + 5]); w.w = cvtpk(p[8 * s + 6], p[8 * s + 7]);
    return __builtin_bit_cast(bf16x8, w);
}
DI f32x16 zero16() { f32x16 z;
#pragma unroll
    for (int i = 0; i < 16; ++i) z[i] = 0.f; return z; }
DI void store_ot(bf16* dst, const f32x16& o0, const f32x16& o1, float sc, int hh) {
#pragma unroll
    for (int g = 0; g < 4; ++g) {
        float v[4];
#pragma unroll
        for (int q = 0; q < 4; ++q) v[q] = o0[4 * g + q] * sc;
        st4bf(dst + 8 * g + 4 * hh, v);
#pragma unroll
        for (int q = 0; q < 4; ++q) v[q] = o1[4 * g + q] * sc;
        st4bf(dst + 32 + 8 * g + 4 * hh, v);
    }
}

DI void load_kv(bf16x8 (&kf)[4], bf16x8 (&vf)[2][2], const bf16* kp, const bf16* vp) {
#pragma unroll
    for (int s = 0; s < 4; ++s) kf[s] = *(const bf16x8*)(kp + 16 * s);
#pragma unroll
    for (int dt = 0; dt < 2; ++dt)
#pragma unroll
        for (int s = 0; s < 2; ++s) vf[dt][s] = *(const bf16x8*)(vp + (size_t)dt * 32 * SEQ + 16 * s);
}
DI void copy_kv(bf16x8 (&kf)[4], bf16x8 (&vf)[2][2], const bf16x8 (&nkf)[4], const bf16x8 (&nvf)[2][2]) {
#pragma unroll
    for (int s = 0; s < 4; ++s) kf[s] = nkf[s];
#pragma unroll
    for (int dt = 0; dt < 2; ++dt)
#pragma unroll
        for (int s = 0; s < 2; ++s) vf[dt][s] = nvf[dt][s];
}

DI void sb_unit(const Args& a, int b, int h, int qb, int lane) {
    const bf16* proj = (const bf16*)(a.ws + WS_A);
    const int c = lane & 31, hh = lane >> 5, pr = pi32(c);
    const size_t tokq = (size_t)b * SEQ + qb * 32 + c;
    const bf16* qp = proj + tokq * PW + C_BQ + h * 64 + 8 * hh;
    bf16x8 qf[4];
#pragma unroll
    for (int s = 0; s < 4; ++s) qf[s] = *(const bf16x8*)(qp + 16 * s);
    f32x16 o0 = zero16(), o1 = zero16(); float R = 1.f;
    const bool slot0lo = (__builtin_amdgcn_permlane32_swap((unsigned)hh, (unsigned)hh, false, false)[0] == 0u);
    const bf16* kbase = proj + (size_t)b * SEQ * PW + C_BK + h * 64 + 8 * hh;
    const bf16* vb0 = (const bf16*)(a.ws + WS_VTB) + ((size_t)(b * 4 + h) * 64 + c) * SEQ + 8 * hh;
    bf16x8 kf[4], vf[2][2];
    load_kv(kf, vf, kbase + (size_t)(qb * 32 + pr) * PW, vb0 + qb * 32);
    for (int kt = qb; kt >= 0; --kt) {
        bf16x8 nkf[4], nvf[2][2];
        { const int kn = (kt > 0) ? kt - 1 : 0; load_kv(nkf, nvf, kbase + (size_t)(kn * 32 + pr) * PW, vb0 + kn * 32); }
        f32x16 x = zero16();
#pragma unroll
        for (int s = 0; s < 4; ++s) x = mfma32(kf[s], qf[s], x);
        const bool diag = (kt == qb);
        float rr[16], ex[16], T[2];
#pragma unroll
        for (int i = 0; i < 16; ++i) { float rv = frcp(1.f + fexp2(x[i])); if (diag && kofs(i, hh) >= c) rv = 1.f; rr[i] = rv; }
#pragma unroll
        for (int s = 0; s < 2; ++s) { ex[8 * s + 7] = 1.f;
#pragma unroll
            for (int j = 6; j >= 0; --j) ex[8 * s + j] = ex[8 * s + j + 1] * rr[8 * s + j + 1];
            T[s] = ex[8 * s] * rr[8 * s]; }
        const auto r0_ = __builtin_amdgcn_permlane32_swap(__float_as_uint(T[0]), __float_as_uint(T[0]), false, false), r1_ = __builtin_amdgcn_permlane32_swap(__float_as_uint(T[1]), __float_as_uint(T[1]), false, false);
        const float PT0 = __uint_as_float((hh != 0) == slot0lo ? r0_[0] : r0_[1]), PT1 = __uint_as_float((hh != 0) == slot0lo ? r1_[0] : r1_[1]);
        float suf0, suf1;
        if (hh == 0) { suf1 = R * PT1; suf0 = suf1 * T[1] * PT0; } else { suf1 = R; suf0 = R * T[1] * PT1; }
        R = R * (T[0] * T[1]) * (PT0 * PT1);
        float p[16];
#pragma unroll
        for (int i = 0; i < 16; ++i) p[i] = (1.f - rr[i]) * ex[i] * (i < 8 ? suf0 : suf1);
        const bf16x8 pb0 = pack_p(p, 0), pb1 = pack_p(p, 1);
        o0 = mfma32(vf[0][0], pb0, o0); o0 = mfma32(vf[0][1], pb1, o0);
        o1 = mfma32(vf[1][0], pb0, o1); o1 = mfma32(vf[1][1], pb1, o1);
        copy_kv(kf, vf, nkf, nvf);
    }
    store_ot((bf16*)(a.ws + WS_B) + tokq * DM + 256 + h * 64, o0, o1, 1.f, hh);
}

DI void fg_unit(const Args& a, int b, int h, int qb, int lane) {
    const bf16* proj = (const bf16*)(a.ws + WS_A);
    const int c = lane & 31, hh = lane >> 5, pr = pi32(c);
    const size_t tokq = (size_t)b * SEQ + qb * 32 + c;
    const bf16* qp = proj + tokq * PW + C_CQ + h * 64 + 8 * hh;
    bf16x8 qf[4];
#pragma unroll
    for (int s = 0; s < 4; ++s) qf[s] = *(const bf16x8*)(qp + 16 * s);
    const float* cum = (const float*)(a.ws + WS_CUM) + (size_t)(b * 4 + h) * SEQ;
    const float cq = cum[qb * 32 + c];
    f32x16 o0 = zero16(), o1 = zero16(); float m = -1.0e30f, l = 0.f;
    const bf16* kbase = proj + (size_t)b * SEQ * PW + C_CK + h * 64 + 8 * hh;
    const bf16* vb0 = (const bf16*)(a.ws + WS_VTC) + ((size_t)(b * 4 + h) * 64 + c) * SEQ + 8 * hh;
    bf16x8 kf[4], vf[2][2];
    load_kv(kf, vf, kbase + (size_t)pr * PW, vb0);
    for (int kt = 0; kt <= qb; ++kt) {
        const int k0 = kt * 32;
        bf16x8 nkf[4], nvf[2][2];
        { const int kn = (kt < qb) ? kt + 1 : kt; load_kv(nkf, nvf, kbase + (size_t)(kn * 32 + pr) * PW, vb0 + kn * 32); }
        float ck[16];
#pragma unroll
        for (int s = 0; s < 2; ++s) { const f32x4 c0 = *(const f32x4*)(cum + k0 + 16 * s + 8 * hh), c1 = *(const f32x4*)(cum + k0 + 16 * s + 8 * hh + 4);
            ck[8 * s] = c0.x; ck[8 * s + 1] = c0.y; ck[8 * s + 2] = c0.z; ck[8 * s + 3] = c0.w; ck[8 * s + 4] = c1.x; ck[8 * s + 5] = c1.y; ck[8 * s + 6] = c1.z; ck[8 * s + 7] = c1.w; }
        f32x16 x = zero16();
#pragma unroll
        for (int s = 0; s < 4; ++s) x = mfma32(kf[s], qf[s], x);
        const bool diag = (kt == qb);
        float sv[16]; float tmax = -1.0e30f;
#pragma unroll
        for (int i = 0; i < 16; ++i) { const bool ok = !(diag && kofs(i, hh) > c); sv[i] = ok ? (x[i] + (cq - ck[i])) : -1.0e30f; tmax = fmaxf(tmax, sv[i]); }
        tmax = red32_max(tmax);
        const float mn = fmaxf(m, tmax), al = fexp2(m - mn);
        float p[16]; float ls = 0.f;
#pragma unroll
        for (int i = 0; i < 16; ++i) { p[i] = (sv[i] > -1.0e29f) ? fexp2(sv[i] - mn) : 0.f; ls += p[i]; }
        l = l * al + ls; m = mn;
#pragma unroll
        for (int i = 0; i < 16; ++i) { o0[i] *= al; o1[i] *= al; }
        const bf16x8 pb0 = pack_p(p, 0), pb1 = pack_p(p, 1);
        o0 = mfma32(vf[0][0], pb0, o0); o0 = mfma32(vf[0][1], pb1, o0);
        o1 = mfma32(vf[1][0], pb0, o1); o1 = mfma32(vf[1][1], pb1, o1);
        copy_kv(kf, vf, nkf, nvf);
    }
    const float lt = red32_sum(l);
    store_ot((bf16*)(a.ws + WS_B) + tokq * DM + 512 + h * 64, o0, o1, 1.f / lt, hh);
}


DI void atile_load(u32x4& reg, const bf16* kt0, const bf16* vt0, int kt, int tid) {
    reg = (tid < 256) ? *(const u32x4*)(kt0 + (size_t)kt * 2048 + tid * 8) : *(const u32x4*)(vt0 + (size_t)kt * 2048 + (tid - 256) * 8);
}
DI void atile_store(LAS unsigned char* buf, const u32x4& reg, int tid) { *(LAS u32x4*)(buf + tid * 16) = reg; }
DI void atile_frags(bf16x8 (&kf)[4], bf16x8 (&vf)[2][2], const LAS unsigned char* buf, int c, int hh, int prow) {
    (void)prow;
#pragma unroll
    for (int s = 0; s < 4; ++s) kf[s] = *(const LAS bf16x8*)(buf + ((2 * s + hh) * 32 + c) * 16);
#pragma unroll
    for (int dt = 0; dt < 2; ++dt)
#pragma unroll
        for (int s = 0; s < 2; ++s) vf[dt][s] = *(const LAS bf16x8*)(buf + 4096 + ((dt * 2 + s) * 64 + hh * 32 + c) * 16);
}
template <int MIXER>
DI void sbfg_block(const Args& a, int l, int b, int h, int QB, LAS unsigned char* lds, int tid, int wave, int lane) {
    const bf16* proj = (const bf16*)(a.ws + WS_A);
    const int c = lane & 31, hh = lane >> 5, pr = pi32(c);
    const int ntile = 8 * QB + 8, qb = 8 * QB + wave;
    const size_t tokq = (size_t)b * SEQ + qb * 32 + c;
    const bf16* qp = proj + tokq * PW + (MIXER == 0 ? C_BQ : C_CQ) + h * 64 + 8 * hh;
    bf16x8 qf[4];
#pragma unroll
    for (int s = 0; s < 4; ++s) qf[s] = *(const bf16x8*)(qp + 16 * s);
    const bf16* krow0 = (const bf16*)(a.ws + (MIXER == 0 ? WS_KTB : WS_KTC)) + (size_t)(b * 4 + h) * (SEQ / 32) * 2048;
    const bf16* vt0 = (const bf16*)(a.ws + (MIXER == 0 ? WS_VTB : WS_VTC)) + (size_t)(b * 4 + h) * (SEQ / 32) * 2048;
    const float* cum = (const float*)(a.ws + WS_CUM) + (size_t)(b * 4 + h) * SEQ;
    const float cq = (MIXER == 1) ? cum[qb * 32 + c] : 0.f;
    float Bq = 0.f;
    if (MIXER == 1) { float qs = 0.f;
#pragma unroll
        for (int s = 0; s < 4; ++s) { const u32x4 w = __builtin_bit_cast(u32x4, qf[s]);
            qs += bflo(w.x) * bflo(w.x) + bfhi(w.x) * bfhi(w.x) + bflo(w.y) * bflo(w.y) + bfhi(w.y) * bfhi(w.y) + bflo(w.z) * bflo(w.z) + bfhi(w.z) * bfhi(w.z) + bflo(w.w) * bflo(w.w) + bfhi(w.w) * bfhi(w.w); }
        qs = red32_sum(qs);
        const float k2 = __uint_as_float(((const unsigned*)(a.ws + WS_CTL))[CW_KMAX + l * 32 + b * 4 + h]);
        Bq = sqrtf(qs * k2) * 1.01f + 0.5f; }
    f32x16 o0 = zero16(), o1 = zero16(); float R = 1.f, m = -1.0e30f, l_ = 0.f;
    const bool slot0lo = (__builtin_amdgcn_permlane32_swap((unsigned)hh, (unsigned)hh, false, false)[0] == 0u);
    u32x4 reg;
    atile_load(reg, krow0, vt0, ntile - 1, tid); atile_store(lds, reg, tid);
    if (ntile > 1) { atile_load(reg, krow0, vt0, ntile - 2, tid); atile_store(lds + 8192, reg, tid); }
    __syncthreads();
    bf16x8 kfA[4], vfA[2][2], kfB[4], vfB[2][2];
    atile_frags(kfA, vfA, lds, c, hh, pr);
    int st = 0;
#define SBFG_STEP(JJ, KF, VF, NKF, NVF) { \
        const int kt = ntile - 1 - (JJ); \
        const int st1 = (st == 2) ? 0 : st + 1, st2 = (st1 == 2) ? 0 : st1 + 1; \
        if ((JJ) + 2 < ntile) atile_load(reg, krow0, vt0, kt - 2, tid); \
        if ((JJ) + 1 < ntile) atile_frags(NKF, NVF, lds + st1 * 8192, c, hh, pr); \
        if (kt <= qb) { \
            f32x16 x = zero16(); \
_Pragma("unroll") \
            for (int s = 0; s < 4; ++s) x = mfma32(KF[s], qf[s], x); \
            const bool diag = (kt == qb); \
            float p[16]; \
            if (MIXER == 0) { \
                float rr[16], ex[16], T[2]; \
_Pragma("unroll") \
                for (int i = 0; i < 16; ++i) rr[i] = frcp(1.f + fexp2(x[i])); \
                if (diag) { \
_Pragma("unroll") \
                    for (int i = 0; i < 16; ++i) if (kofs(i, hh) >= c) rr[i] = 1.f; \
                } \
_Pragma("unroll") \
                for (int s = 0; s < 2; ++s) { ex[8 * s + 7] = 1.f; \
_Pragma("unroll") \
                    for (int q = 6; q >= 0; --q) ex[8 * s + q] = ex[8 * s + q + 1] * rr[8 * s + q + 1]; \
                    T[s] = ex[8 * s] * rr[8 * s]; } \
                const auto r0_ = __builtin_amdgcn_permlane32_swap(__float_as_uint(T[0]), __float_as_uint(T[0]), false, false), r1_ = __builtin_amdgcn_permlane32_swap(__float_as_uint(T[1]), __float_as_uint(T[1]), false, false); \
                const float PT0 = __uint_as_float((hh != 0) == slot0lo ? r0_[0] : r0_[1]), PT1 = __uint_as_float((hh != 0) == slot0lo ? r1_[0] : r1_[1]); \
                float suf0, suf1; \
                if (hh == 0) { suf1 = R * PT1; suf0 = suf1 * T[1] * PT0; } else { suf1 = R; suf0 = R * T[1] * PT1; } \
                R = R * (T[0] * T[1]) * (PT0 * PT1); \
_Pragma("unroll") \
                for (int i = 0; i < 16; ++i) p[i] = (ex[i] - ex[i] * rr[i]) * (i < 8 ? suf0 : suf1); \
            } else { \
                const int k0 = kt * 32; \
                float ck[16]; \
_Pragma("unroll") \
                for (int s = 0; s < 2; ++s) { const f32x4 c0 = *(const f32x4*)(cum + k0 + 16 * s + 8 * hh), c1 = *(const f32x4*)(cum + k0 + 16 * s + 8 * hh + 4); \
                    ck[8 * s] = c0.x; ck[8 * s + 1] = c0.y; ck[8 * s + 2] = c0.z; ck[8 * s + 3] = c0.w; ck[8 * s + 4] = c1.x; ck[8 * s + 5] = c1.y; ck[8 * s + 6] = c1.z; ck[8 * s + 7] = c1.w; } \
                float sv[16]; float tmax = -1.0e30f; \
_Pragma("unroll") \
                for (int i = 0; i < 16; ++i) sv[i] = x[i] + (cq - ck[i]); \
                if (diag) { \
_Pragma("unroll") \
                    for (int i = 0; i < 16; ++i) if (kofs(i, hh) > c) sv[i] = -1.0e30f; \
                } \
_Pragma("unroll") \
                for (int i = 0; i < 16; ++i) tmax = fmaxf(tmax, sv[i]); \
                tmax = red32_max(tmax); \
                if (__any(tmax > m)) { \
                    const float mn = fmaxf(m, tmax), al = fexp2(m - mn); m = mn; l_ *= al; \
_Pragma("unroll") \
                    for (int i = 0; i < 16; ++i) { o0[i] *= al; o1[i] *= al; } \
                } \
                float ls = 0.f; \
_Pragma("unroll") \
                for (int i = 0; i < 16; ++i) { p[i] = fexp2(sv[i] - m); ls += p[i]; } \
                l_ += ls; \
            } \
            const bf16x8 pb0 = pack_p(p, 0), pb1 = pack_p(p, 1); \
            o0 = mfma32(VF[0][0], pb0, o0); o0 = mfma32(VF[0][1], pb1, o0); \
            o1 = mfma32(VF[1][0], pb0, o1); o1 = mfma32(VF[1][1], pb1, o1); \
        } \
        if ((JJ) + 2 < ntile) atile_store(lds + st2 * 8192, reg, tid); \
        __syncthreads(); \
        st = st1; \
    }
    LAS unsigned* dflag = (LAS unsigned*)(lds + 24576);
    for (int j = 0; j < ntile; j += 2) {
        SBFG_STEP(j, kfA, vfA, kfB, vfB)
        {
            const int ktj = ntile - 1 - j; const bool started = ktj <= qb;
            bool fin;
            if (MIXER == 0) fin = started && __all(R < 1.0e-12f);
            else { const float cn = (ktj >= 1) ? cum[32 * ktj - 1] : 0.f; fin = started && (ktj >= 1) && __all(Bq + (cq - cn) < m - 40.f); }
            if (lane == 0) dflag[((j >> 1) & 1) * 8 + wave] = fin ? 1u : 0u;
        }
        SBFG_STEP(j + 1, kfB, vfB, kfA, vfA)
        {
            const u32x4 f0 = *(const LAS u32x4*)(dflag + ((j >> 1) & 1) * 8), f1 = *(const LAS u32x4*)(dflag + ((j >> 1) & 1) * 8 + 4);
            if ((f0.x & f0.y & f0.z & f0.w & f1.x & f1.y & f1.z & f1.w) != 0u) break;
        }
    }
#undef SBFG_STEP
    if (MIXER == 0) store_ot((bf16*)(a.ws + WS_B) + tokq * DM + 256 + h * 64, o0, o1, 1.f, hh);
    else { const float lt = red32_sum(l_); store_ot((bf16*)(a.ws + WS_B) + tokq * DM + 512 + h * 64, o0, o1, 1.f / lt, hh); }
}

DI void osm_step(const f32x16& x, int lo, int hi, int hh, bool interior, bool sel, float& m, float& l, f32x16& o0, f32x16& o1, const bf16x8 (&vf)[2][2]) {
    float sv[16];
    if (interior) {
#pragma unroll
        for (int i = 0; i < 16; ++i) sv[i] = x[i];
    } else {
#pragma unroll
        for (int i = 0; i < 16; ++i) { const int ko = kofs(i, hh); sv[i] = (ko <= hi && ko >= lo) ? x[i] : -3.0e38f; }
    }
    float tmax = -3.0e38f;
#pragma unroll
    for (int i = 0; i < 16; ++i) tmax = fmaxf(tmax, sv[i]);
    tmax = red32_max(sel ? tmax : -3.0e38f);
    if (__any(tmax > m)) { const float mn = fmaxf(m, tmax), al = fexp2(m - mn); m = mn; l *= al;
#pragma unroll
        for (int i = 0; i < 16; ++i) { o0[i] *= al; o1[i] *= al; } }
    const float meff = sel ? m : 3.0e38f;
    float p[16]; float ls = 0.f;
#pragma unroll
    for (int i = 0; i < 16; ++i) { p[i] = fexp2(sv[i] - meff); ls += p[i]; }
    l += ls;
    const bf16x8 pb0 = pack_p(p, 0), pb1 = pack_p(p, 1);
    o0 = mfma32(vf[0][0], pb0, o0); o0 = mfma32(vf[0][1], pb1, o0);
    o1 = mfma32(vf[1][0], pb0, o1); o1 = mfma32(vf[1][1], pb1, o1);
}

DI void ld_k4(bf16x8 (&kf)[4], const bf16* kp) {
#pragma unroll
    for (int s = 0; s < 4; ++s) kf[s] = *(const bf16x8*)(kp + 16 * s);
}
DI void ld_v4(bf16x8 (&vf)[2][2], const bf16* vp, int vpitch) {
#pragma unroll
    for (int dt = 0; dt < 2; ++dt)
#pragma unroll
        for (int s = 0; s < 2; ++s) vf[dt][s] = *(const bf16x8*)(vp + (size_t)dt * 32 * vpitch + 16 * s);
}
DI void ld_kt(bf16x8 (&kf)[4], const bf16* tile, int c, int hh) {
#pragma unroll
    for (int s = 0; s < 4; ++s) kf[s] = *(const bf16x8*)(tile + ((2 * s + hh) * 32 + c) * 8);
}
DI void ld_vt(bf16x8 (&vf)[2][2], const bf16* tile, int c, int hh) {
#pragma unroll
    for (int dt = 0; dt < 2; ++dt)
#pragma unroll
        for (int s = 0; s < 2; ++s) vf[dt][s] = *(const bf16x8*)(tile + ((dt * 2 + s) * 64 + hh * 32 + c) * 8);
}
DI unsigned wave_max_u(unsigned v) {
    v = max(v, (unsigned)DPPI((int)v, 0xB1, 0xF, true)); v = max(v, (unsigned)DPPI((int)v, 0x4E, 0xF, true));
    v = max(v, (unsigned)DPPI((int)v, 0x124, 0xF, true)); v = max(v, (unsigned)DPPI((int)v, 0x128, 0xF, true));
    { const auto r = __builtin_amdgcn_permlane16_swap(v, v, false, false); v = max(r[0], r[1]); const auto q = __builtin_amdgcn_permlane32_swap(v, v, false, false); v = max(q[0], q[1]); }
    return v;
}
DI void nsa_unit(const Args& a, int unit, LAS unsigned char* wl, int lane) {
    const bf16* proj = (const bf16*)(a.ws + WS_A);
    const int tok0 = unit * 8, b = tok0 / SEQ, t0 = tok0 % SEQ;
    const int c = lane & 31, hh = lane >> 5, ql = c >> 2, hd = c & 3, pr = pi32(c);
    const int tq = t0 + ql; const size_t tokq = (size_t)tok0 + ql;
    const bf16* qp = proj + tokq * PW + C_AQ + hd * 64 + 8 * hh;
    bf16x8 qf[4];
#pragma unroll
    for (int s = 0; s < 4; ++s) qf[s] = *(const bf16x8*)(qp + 16 * s);
    LAS float* imp = (LAS float*)wl; LAS unsigned* selm = (LAS unsigned*)(wl + 4096); LAS unsigned char* blist = (LAS unsigned char*)(wl + 4096 + 128);
    for (int i = lane; i < 1024; i += 64) imp[i] = 0.f;
    const float* gate = (const float*)(a.ws + WS_GATE) + tokq * 12 + hd * 3;
    const float g0 = gate[0], g1 = gate[1], g2 = gate[2];
    f32x16 of0 = zero16(), of1 = zero16();
    {
        const bf16* kc = (const bf16*)(a.ws + WS_KCMP) + (size_t)b * 16 * 2048;
        const bf16* vt = (const bf16*)(a.ws + WS_VTCMP) + (size_t)b * 16 * 2048;
        const int nmaxq = (tq >= 31) ? ((tq - 31) >> 4) : -1;
        const int nmaxu = (t0 + 7 >= 31) ? ((t0 + 7 - 31) >> 4) : -1;
        const int ntile = (nmaxu >> 5) + 1;
        float m = -1.0e30f, l = 0.f;
        bf16x8 kf[4], nkf[4];
        if (ntile > 0) ld_kt(kf, kc, c, hh);
        for (int kt = 0; kt < ntile; ++kt) {
            ld_kt(nkf, kc + (size_t)(kt + 1 < ntile ? kt + 1 : kt) * 2048, c, hh);
            f32x16 x = zero16();
#pragma unroll
            for (int s = 0; s < 4; ++s) x = mfma32(kf[s], qf[s], x);
            const int lim = nmaxq - kt * 32; float sv[16]; float tmax = -3.0e38f;
#pragma unroll
            for (int i = 0; i < 16; ++i) { sv[i] = (kofs(i, hh) <= lim) ? x[i] : -3.0e38f; tmax = fmaxf(tmax, sv[i]); }
            tmax = red32_max(tmax);
            const float mn = fmaxf(m, tmax); float ls = 0.f;
#pragma unroll
            for (int i = 0; i < 16; ++i) ls += fexp2(sv[i] - mn);
            l = l * fexp2(m - mn) + ls; m = mn;
#pragma unroll
            for (int s = 0; s < 4; ++s) kf[s] = nkf[s];
        }
        const float lt = red32_sum(l);
        const float inv = 1.f / fmaxf(lt, 1.0e-30f);
        f32x16 o0 = zero16(), o1 = zero16();
        LDS_WAIT();
        bf16x8 vf[2][2], nvf[2][2];
        if (ntile > 0) { ld_kt(kf, kc, c, hh); ld_vt(vf, vt, c, hh); }
        for (int kt = 0; kt < ntile; ++kt) {
            { const int kn = (kt + 1 < ntile ? kt + 1 : kt); ld_kt(nkf, kc + (size_t)kn * 2048, c, hh); ld_vt(nvf, vt + (size_t)kn * 2048, c, hh); }
            f32x16 x = zero16();
#pragma unroll
            for (int s = 0; s < 4; ++s) x = mfma32(kf[s], qf[s], x);
            float p[16], ps[16];
#pragma unroll
            for (int i = 0; i < 16; ++i) { p[i] = (kofs(i, hh) <= nmaxq - kt * 32) ? fexp2(x[i] - m) * inv : 0.f;
                float t = p[i]; t += dpp_xor1(t); t += dpp_xor2(t); ps[i] = t; }
            if (hd == 0) {
#pragma unroll
                for (int s = 0; s < 2; ++s) { const int gb = (kt * 32 + 16 * s + 8 * hh) >> 2; LAS float* ip = imp + ql * 128 + gb;
                    __hip_atomic_fetch_add(ip, (ps[8 * s] + ps[8 * s + 1]) + (ps[8 * s + 2] + ps[8 * s + 3]), __ATOMIC_RELAXED, __HIP_MEMORY_SCOPE_WORKGROUP);
                    __hip_atomic_fetch_add(ip + 1, ps[8 * s + 3] + (ps[8 * s + 4] + ps[8 * s + 5]) + (ps[8 * s + 6] + ps[8 * s + 7]), __ATOMIC_RELAXED, __HIP_MEMORY_SCOPE_WORKGROUP);
                    if (gb + 2 < 128) __hip_atomic_fetch_add(ip + 2, ps[8 * s + 7], __ATOMIC_RELAXED, __HIP_MEMORY_SCOPE_WORKGROUP); }
            }
            const bf16x8 pb0 = pack_p(p, 0), pb1 = pack_p(p, 1);
            o0 = mfma32(vf[0][0], pb0, o0); o0 = mfma32(vf[0][1], pb1, o0);
            o1 = mfma32(vf[1][0], pb0, o1); o1 = mfma32(vf[1][1], pb1, o1);
            copy_kv(kf, vf, nkf, nvf);
        }
#pragma unroll
        for (int i = 0; i < 16; ++i) { of0[i] = g0 * o0[i]; of1[i] = g0 * o1[i]; }
    }
    LDS_WAIT();
    for (int qi = 0; qi < 8; ++qi) {
        const int qblk = (t0 + qi) >> 6;
        const LAS float* iq = imp + qi * 128;
        const int b0 = lane, b1 = lane + 64;
        const bool ad0 = b0 <= qblk, ad1 = b1 <= qblk;
        const bool f0 = (b0 == 0) || (b0 == qblk) || (b0 == qblk - 1), f1 = (b1 == qblk) || (b1 == qblk - 1);
        unsigned v0 = ad0 ? __float_as_uint(f0 ? iq[b0] + 1.0e6f : iq[b0]) + 1u : 0u, v1 = ad1 ? __float_as_uint(f1 ? iq[b1] + 1.0e6f : iq[b1]) + 1u : 0u;
        unsigned long long m0 = 0ull, m1 = 0ull;
        const int nsel = (qblk + 1 < 16) ? qblk + 1 : 16;
        for (int r = 0; r < nsel; ++r) {
            const unsigned mx = wave_max_u(max(v0, v1));
            const unsigned long long e0 = __ballot(v0 == mx);
            if (e0) { const int idx = __builtin_ctzll(e0); m0 |= 1ull << idx; if (lane == idx) v0 = 0u; }
            else { const unsigned long long e1 = __ballot(v1 == mx); const int idx = __builtin_ctzll(e1); m1 |= 1ull << idx; if (lane == idx) v1 = 0u; }
        }
        if (lane == 0) { selm[qi * 4] = (unsigned)m0; selm[qi * 4 + 1] = (unsigned)(m0 >> 32); selm[qi * 4 + 2] = (unsigned)m1; selm[qi * 4 + 3] = (unsigned)(m1 >> 32); }
    }
    LDS_WAIT();
    {
        unsigned mk[4], um[4]; int nb = 0;
#pragma unroll
        for (int w = 0; w < 4; ++w) { mk[w] = selm[ql * 4 + w]; unsigned u = 0;
#pragma unroll
            for (int q = 0; q < 8; ++q) u |= selm[q * 4 + w];
            um[w] = (unsigned)__builtin_amdgcn_readfirstlane((int)u); }
#pragma unroll
        for (int w = 0; w < 4; ++w) { const unsigned u = um[w]; const int l32 = lane & 31;
            if (lane < 32 && ((u >> l32) & 1u)) blist[nb + __builtin_popcount(u & ((1u << l32) - 1u))] = (unsigned char)(32 * w + l32);
            nb += __builtin_popcount(u); }
        LDS_WAIT();
        const bf16* kbase = (const bf16*)(a.ws + WS_KTS) + (size_t)b * (SEQ / 32) * 2048;
        const bf16* vb0 = (const bf16*)(a.ws + WS_VTAS) + (size_t)b * (SEQ / 32) * 2048;
        f32x16 o0 = zero16(), o1 = zero16(); float m = -1.0e30f, l = 0.f;
        const int nt = 2 * nb;
        bf16x8 kf[4], vf[2][2], nkf[4], nvf[2][2];
        int blk = blist[0];
        { const int t0i = blk * 2; ld_kt(kf, kbase + (size_t)t0i * 2048, c, hh); ld_vt(vf, vb0 + (size_t)t0i * 2048, c, hh); }
#define NSA_SEL_STEP(TT, KF, VF, NKF, NVF) { \
            const int k0 = blk * 64 + 32 * ((TT) & 1); \
            const int tn = ((TT) + 1 < nt) ? (TT) + 1 : (TT); const int blkn = blist[tn >> 1]; \
            { const int tni = blkn * 2 + (tn & 1); ld_kt(NKF, kbase + (size_t)tni * 2048, c, hh); ld_vt(NVF, vb0 + (size_t)tni * 2048, c, hh); } \
            const bool mysel = ((((blk >> 5) == 0 ? mk[0] : (blk >> 5) == 1 ? mk[1] : (blk >> 5) == 2 ? mk[2] : mk[3]) >> (blk & 31)) & 1u) != 0u; \
            f32x16 x = zero16(); \
            _Pragma("unroll") for (int s = 0; s < 4; ++s) x = mfma32(KF[s], qf[s], x); \
            osm_step(x, 0, tq - k0, hh, k0 + 31 <= t0, mysel, m, l, o0, o1, VF); \
            blk = blkn; }
        for (int t = 0; t < nt; t += 2) {
            NSA_SEL_STEP(t, kf, vf, nkf, nvf)
            NSA_SEL_STEP(t + 1, nkf, nvf, kf, vf)
        }
#undef NSA_SEL_STEP
        const float lt = red32_sum(l); const float sc = g1 / fmaxf(lt, 1.0e-30f);
#pragma unroll
        for (int i = 0; i < 16; ++i) { of0[i] += sc * o0[i]; of1[i] += sc * o1[i]; }
    }
    {
        const bf16* kbase = (const bf16*)(a.ws + WS_KTW) + (size_t)b * (SEQ / 32) * 2048;
        const bf16* vb0 = (const bf16*)(a.ws + WS_VTAW) + (size_t)b * (SEQ / 32) * 2048;
        f32x16 o0 = zero16(), o1 = zero16(); float m = -1.0e30f, l = 0.f;
        const int klo = (t0 >= 511) ? ((t0 - 511) >> 5) : 0, khi = (t0 + 7) >> 5;
        bf16x8 kf[4], vf[2][2], nkf[4], nvf[2][2];
        ld_kt(kf, kbase + (size_t)klo * 2048, c, hh); ld_vt(vf, vb0 + (size_t)klo * 2048, c, hh);
        for (int kt = klo; kt <= khi; ++kt) {
            const int k0 = kt * 32;
            { const int kn = (kt < khi ? kt + 1 : kt); ld_kt(nkf, kbase + (size_t)kn * 2048, c, hh); ld_vt(nvf, vb0 + (size_t)kn * 2048, c, hh); }
            f32x16 x = zero16();
#pragma unroll
            for (int s = 0; s < 4; ++s) x = mfma32(kf[s], qf[s], x);
            osm_step(x, tq - 511 - k0, tq - k0, hh, k0 >= t0 + 7 - 511 && k0 + 31 <= t0, true, m, l, o0, o1, vf);
            copy_kv(kf, vf, nkf, nvf);
        }
        const float lt = red32_sum(l); const float sc = g2 / fmaxf(lt, 1.0e-30f);
#pragma unroll
        for (int i = 0; i < 16; ++i) { of0[i] += sc * o0[i]; of1[i] += sc * o1[i]; }
    }
    store_ot((bf16*)(a.ws + WS_B) + tokq * DM + hd * 64, of0, of1, 1.f, hh);
}

#ifndef DSA_REP_S
#define DSA_REP_S 1
#define DSA_REP_L 1
#define DSA_REP_A 1
#endif
#ifndef DSA_REP_1
#define DSA_REP_1 1
#define DSA_REP_2 1
#define DSA_REP_3 1
#endif
constexpr int DSA_CIDX = 132096, DSA_LIST = DSA_CIDX + 16384, DSA_DUMMY = DSA_LIST + 8192;  static_assert(DSA_DUMMY + 8 * 128 <= MISC_OFF, "DSA LDS map");
static_assert(DSA_LIST + 8192 <= MISC_OFF, "DSA LDS map");
typedef short v4i16_t __attribute__((ext_vector_type(4)));
DI unsigned f2key(float f) { const unsigned u = __float_as_uint(f); return u ^ ((u >> 31) ? 0xffffffffu : 0x80000000u); }
DI int wave_excl_scan(int v, int lane) { (void)lane; return wave_incl_scan(v) - v; }
DI int wave_sum_i(int v) {
    v += DPPI(v, 0xB1, 0xF, true); v += DPPI(v, 0x4E, 0xF, true); v += DPPI(v, 0x124, 0xF, true); v += DPPI(v, 0x128, 0xF, true);
    const auto r = __builtin_amdgcn_permlane16_swap((unsigned)v, (unsigned)v, false, false); v = (int)(r[0] + r[1]);
    const auto q = __builtin_amdgcn_permlane32_swap((unsigned)v, (unsigned)v, false, false); return (int)(q[0] + q[1]);
}
template <int NR>
DI unsigned kth_regn(const unsigned (&k)[16], int K) {
    unsigned hi = 0u, lo = 0xffffffffu;
#pragma unroll
    for (int j = 0; j < NR; ++j) { hi = (k[j] > hi) ? k[j] : hi; const unsigned kk = k[j] ? k[j] : 0xffffffffu; lo = (kk < lo) ? kk : lo; }
    hi = max(hi, (unsigned)DPPI((int)hi, 0xB1, 0xF, true)); hi = max(hi, (unsigned)DPPI((int)hi, 0x4E, 0xF, true));
    lo = min(lo, (unsigned)__builtin_amdgcn_update_dpp((int)0xffffffff, (int)lo, 0xB1, 0xF, 0xF, false)); lo = min(lo, (unsigned)__builtin_amdgcn_update_dpp((int)0xffffffff, (int)lo, 0x4E, 0xF, 0xF, false));
    hi = max(hi, (unsigned)DPPI((int)hi, 0x124, 0xF, true)); hi = max(hi, (unsigned)DPPI((int)hi, 0x128, 0xF, true));
    lo = min(lo, (unsigned)__builtin_amdgcn_update_dpp((int)0xffffffff, (int)lo, 0x124, 0xF, 0xF, false)); lo = min(lo, (unsigned)__builtin_amdgcn_update_dpp((int)0xffffffff, (int)lo, 0x128, 0xF, 0xF, false));
    { const auto r = __builtin_amdgcn_permlane16_swap(hi, hi, false, false); hi = max(r[0], r[1]); const auto q = __builtin_amdgcn_permlane32_swap(hi, hi, false, false); hi = max(q[0], q[1]); }
    { const auto r = __builtin_amdgcn_permlane16_swap(lo, lo, false, false); lo = min(r[0], r[1]); const auto q = __builtin_amdgcn_permlane32_swap(lo, lo, false, false); lo = min(q[0], q[1]); }
    const unsigned diff = (unsigned)__builtin_amdgcn_readfirstlane((int)(hi ^ lo));
    if (diff == 0u) return (unsigned)__builtin_amdgcn_readfirstlane((int)hi);
    const int top = 31 - __builtin_clz(diff);
    unsigned prefix = (unsigned)__builtin_amdgcn_readfirstlane((int)hi) & ~((2u << top) - 1u);
#pragma unroll 1
    for (int bit = top; bit >= 0; --bit) {
        const unsigned cand = prefix | (1u << bit); int c = 0;
#pragma unroll
        for (int j = 0; j < NR; ++j) c += __builtin_popcountll(__ballot(k[j] >= cand));
        if (c >= K) prefix = cand;
    }
    return prefix;
}
DI unsigned kth_reg16(const unsigned (&k)[16], int K) { return kth_regn<16>(k, K); }
DI unsigned kth_disp(const unsigned (&k)[16], int K, int nr) { return nr <= 6 ? kth_regn<6>(k, K) : nr <= 8 ? kth_regn<8>(k, K) : nr <= 12 ? kth_regn<12>(k, K) : kth_regn<16>(k, K); }
DI void dsa_attend(const Args& a, const bf16* proj, int b, size_t tokq, const LAS unsigned short* list, int cnt, LAS unsigned char* stg, int lane) {
        const int col = lane & 15, quad = lane >> 4, hd = col & 3;
        const bf16* qp = proj + tokq * PW + C_DQ + hd * 64 + 8 * quad;
        const bf16x8 qb0 = *(const bf16x8*)qp, qb1 = *(const bf16x8*)(qp + 32);
        const bf16* krow0 = proj + (size_t)b * SEQ * PW + C_DK; const bf16* vrow0 = proj + (size_t)b * SEQ * PW + C_DV;
        const int grow_ = lane >> 3, piece_ = lane & 7;
        f32x4 o[4];
#pragma unroll
        for (int dt = 0; dt < 4; ++dt) o[dt] = (f32x4){0.f, 0.f, 0.f, 0.f};
        float mrun = -1.0e30f, ls = 0.f;
#pragma unroll 1
        for (int ch = 0; ch < 2; ++ch) {
            if (ch * 128 >= cnt) break;
            int grow = grow_, piece = piece_; asm volatile("" : "+v"(grow), "+v"(piece));
            u32x4 wk[16], wv[16];
#pragma unroll
            for (int it = 0; it < 16; ++it) { const int j = ch * 128 + it * 8 + grow; const unsigned kidx = (j < cnt) ? (unsigned)list[j] : 0u;
                wk[it] = *(const u32x4*)(krow0 + (size_t)kidx * PW + 8 * piece); wv[it] = *(const u32x4*)(vrow0 + (size_t)kidx * PW + 8 * piece); }
#pragma unroll
            for (int it = 0; it < 16; ++it) { const int row = it * 8 + grow; *(LAS u32x4*)(stg + row * 128 + ((piece ^ (row & 7)) * 16)) = wk[it]; }
            LDS_WAIT();
            float sr[8][4];
            {
                int colq = col, quadq = quad; asm volatile("" : "+v"(colq), "+v"(quadq));
#pragma unroll
                for (int kt = 0; kt < 8; ++kt) {
                    const int row = kt * 16 + colq;
                    const bf16x8 a0 = *(const LAS bf16x8*)(stg + row * 128 + ((quadq ^ (row & 7)) * 16)), a1 = *(const LAS bf16x8*)(stg + row * 128 + (((quadq + 4) ^ (row & 7)) * 16));
                    f32x4 d = (f32x4){0.f, 0.f, 0.f, 0.f};
                    d = mfma16(a0, qb0, d); d = mfma16(a1, qb1, d);
#pragma unroll
                    for (int i = 0; i < 4; ++i) sr[kt][i] = (ch * 128 + kt * 16 + 4 * quadq + i < cnt) ? d[i] : -1.0e30f;
                }
            }
            float mx = -1.0e30f;
#pragma unroll
            for (int kt = 0; kt < 8; ++kt)
#pragma unroll
                for (int i = 0; i < 4; ++i) mx = fmaxf(mx, sr[kt][i]);
            mx = red16_max(mx); mx = red32_max(mx);
            const float mn = fmaxf(mrun, mx), al = fexp2(mrun - mn); mrun = mn;
            float lc = 0.f;
#pragma unroll
            for (int kt = 0; kt < 8; ++kt)
#pragma unroll
                for (int i = 0; i < 4; ++i) { const float p = (sr[kt][i] > -1.0e29f) ? fexp2(sr[kt][i] - mn) : 0.f; sr[kt][i] = p; lc += p; }
            lc = red16_sum(lc); lc = red32_sum(lc);
            ls = ls * al + lc;
#pragma unroll
            for (int dt = 0; dt < 4; ++dt) o[dt] = o[dt] * al;
            LDS_WAIT();
#pragma unroll
            for (int it = 0; it < 16; ++it) { const int row = it * 8 + grow; *(LAS u32x4*)(stg + row * 128 + ((piece ^ (row & 7)) * 16)) = wv[it]; }
            LDS_WAIT();
            {
                int colp = col, quadp = quad; asm volatile("" : "+v"(colp), "+v"(quadp));
#pragma unroll
                for (int g = 0; g < 4; ++g) {
                    u32x4 pw; pw.x = cvtpk(sr[2 * g][0], sr[2 * g][1]); pw.y = cvtpk(sr[2 * g][2], sr[2 * g][3]); pw.z = cvtpk(sr[2 * g + 1][0], sr[2 * g + 1][1]); pw.w = cvtpk(sr[2 * g + 1][2], sr[2 * g + 1][3]);
                    const bf16x8 pb = __builtin_bit_cast(bf16x8, pw);
                    const int klo = 32 * g + 4 * quadp + (colp >> 2), khi = klo + 16;
#pragma unroll
                    for (int dt = 0; dt < 4; ++dt) { const int pc = 2 * dt + ((colp & 3) >> 1), bo = (colp & 1) * 8;
                        const v4i16_t lo = __builtin_amdgcn_ds_read_tr16_b64_v4i16((LAS v4i16_t*)(stg + klo * 128 + ((pc ^ (klo & 7)) * 16) + bo));
                        const v4i16_t hi = __builtin_amdgcn_ds_read_tr16_b64_v4i16((LAS v4i16_t*)(stg + khi * 128 + ((pc ^ (khi & 7)) * 16) + bo));
                        const bf16x8 av = (bf16x8){lo[0], lo[1], lo[2], lo[3], hi[0], hi[1], hi[2], hi[3]};
                        o[dt] = mfma16(av, pb, o[dt]); }
                }
            }
            LDS_WAIT();
        }
        if (col < 4) { const float inv = 1.f / ls; bf16* om = (bf16*)(a.ws + WS_B) + tokq * DM + 768 + hd * 64 + 4 * quad;
#pragma unroll
            for (int dt = 0; dt < 4; ++dt) { float v[4] = {o[dt][0] * inv, o[dt][1] * inv, o[dt][2] * inv, o[dt][3] * inv}; st4bf(om + 16 * dt, v); } }
    }

DI void dsa_attend2(const Args& a, const bf16* proj, int b, size_t tokA, const LAS unsigned short* listA, int cntA, size_t tokB, const LAS unsigned short* listB, int cntB, LAS unsigned char* stg, int lane) {
    const int col = lane & 15, quad = lane >> 4, hd = col & 3;
    const bf16* krow0 = proj + (size_t)b * SEQ * PW + C_DK; const bf16* vrow0 = proj + (size_t)b * SEQ * PW + C_DV;
    const int grow_ = lane >> 3, piece_ = lane & 7;
    const int ncA = (cntA + 63) >> 6, nc = ncA + ((cntB + 63) >> 6);
    bf16x8 qb0, qb1; f32x4 o[4]; float mrun = -1.0e30f, ls = 0.f;
    u32x4 wk0[8], wv0[8], wk1[8], wv1[8];
#define DSA_GATHER(WK, WV, CI) { const bool isb_ = (CI) >= ncA; const int ch_ = isb_ ? (CI) - ncA : (CI); const int cnt_ = isb_ ? cntB : cntA; const LAS unsigned short* li_ = isb_ ? listB : listA; \
        int grow = grow_, piece = piece_; asm volatile("" : "+v"(grow), "+v"(piece)); \
        _Pragma("unroll") for (int it = 0; it < 8; ++it) { const int j = ch_ * 64 + it * 8 + grow; const unsigned kidx = (j < cnt_) ? (unsigned)li_[j] : 0u; \
            WK[it] = *(const u32x4*)(krow0 + (size_t)kidx * PW + 8 * piece); WV[it] = *(const u32x4*)(vrow0 + (size_t)kidx * PW + 8 * piece); } }
#define DSA_CHUNK(WK, WV, CI) { const bool isb_ = (CI) >= ncA; const int ch_ = isb_ ? (CI) - ncA : (CI); const int cnt_ = isb_ ? cntB : cntA; \
        if (ch_ == 0) { const bf16* qp = proj + (isb_ ? tokB : tokA) * PW + C_DQ + hd * 64 + 8 * quad; qb0 = *(const bf16x8*)qp; qb1 = *(const bf16x8*)(qp + 32); mrun = -1.0e30f; ls = 0.f; \
            _Pragma("unroll") for (int dt = 0; dt < 4; ++dt) o[dt] = (f32x4){0.f, 0.f, 0.f, 0.f}; } \
        int grow = grow_, piece = piece_; asm volatile("" : "+v"(grow), "+v"(piece)); \
        _Pragma("unroll") for (int it = 0; it < 8; ++it) { const int row = it * 8 + grow; *(LAS u32x4*)(stg + row * 128 + ((piece ^ (row & 7)) * 16)) = WK[it]; } \
        LDS_WAIT(); \
        float sr[4][4]; \
        { int colq = col, quadq = quad; asm volatile("" : "+v"(colq), "+v"(quadq)); \
          _Pragma("unroll") for (int kt = 0; kt < 4; ++kt) { const int row = kt * 16 + colq; \
            const bf16x8 a0 = *(const LAS bf16x8*)(stg + row * 128 + ((quadq ^ (row & 7)) * 16)), a1 = *(const LAS bf16x8*)(stg + row * 128 + (((quadq + 4) ^ (row & 7)) * 16)); \
            f32x4 d = (f32x4){0.f, 0.f, 0.f, 0.f}; d = mfma16(a0, qb0, d); d = mfma16(a1, qb1, d); \
            _Pragma("unroll") for (int i = 0; i < 4; ++i) sr[kt][i] = (ch_ * 64 + kt * 16 + 4 * quadq + i < cnt_) ? d[i] : -3.0e38f; } } \
        float mx = -3.0e38f; \
        _Pragma("unroll") for (int kt = 0; kt < 4; ++kt) _Pragma("unroll") for (int i = 0; i < 4; ++i) mx = fmaxf(mx, sr[kt][i]); \
        mx = red16_max(mx); mx = red32_max(mx); \
        const float mn = fmaxf(mrun, mx), al = fexp2(mrun - mn); mrun = mn; \
        float lc = 0.f; \
        _Pragma("unroll") for (int kt = 0; kt < 4; ++kt) _Pragma("unroll") for (int i = 0; i < 4; ++i) { const float p = fexp2(sr[kt][i] - mn); sr[kt][i] = p; lc += p; } \
        lc = red16_sum(lc); lc = red32_sum(lc); ls = ls * al + lc; \
        _Pragma("unroll") for (int dt = 0; dt < 4; ++dt) o[dt] = o[dt] * al; \
        LDS_WAIT(); \
        _Pragma("unroll") for (int it = 0; it < 8; ++it) { const int row = it * 8 + grow; *(LAS u32x4*)(stg + row * 128 + ((piece ^ (row & 7)) * 16)) = WV[it]; } \
        LDS_WAIT(); \
        { int colp = col, quadp = quad; asm volatile("" : "+v"(colp), "+v"(quadp)); \
          _Pragma("unroll") for (int g = 0; g < 2; ++g) { \
            u32x4 pw; pw.x = cvtpk(sr[2 * g][0], sr[2 * g][1]); pw.y = cvtpk(sr[2 * g][2], sr[2 * g][3]); pw.z = cvtpk(sr[2 * g + 1][0], sr[2 * g + 1][1]); pw.w = cvtpk(sr[2 * g + 1][2], sr[2 * g + 1][3]); \
            const bf16x8 pb = __builtin_bit_cast(bf16x8, pw); \
            const int klo = 32 * g + 4 * quadp + (colp >> 2), khi = klo + 16; \
            _Pragma("unroll") for (int dt = 0; dt < 4; ++dt) { const int pc = 2 * dt + ((colp & 3) >> 1), bo = (colp & 1) * 8; \
                const v4i16_t lo = __builtin_amdgcn_ds_read_tr16_b64_v4i16((LAS v4i16_t*)(stg + klo * 128 + ((pc ^ (klo & 7)) * 16) + bo)); \
                const v4i16_t hi = __builtin_amdgcn_ds_read_tr16_b64_v4i16((LAS v4i16_t*)(stg + khi * 128 + ((pc ^ (khi & 7)) * 16) + bo)); \
                const bf16x8 av = (bf16x8){lo[0], lo[1], lo[2], lo[3], hi[0], hi[1], hi[2], hi[3]}; \
                o[dt] = mfma16(av, pb, o[dt]); } } } \
        LDS_WAIT(); \
        const int nch_ = isb_ ? nc - ncA : ncA; \
        if (ch_ == nch_ - 1 && col < 4) { const float inv = 1.f / ls; bf16* om = (bf16*)(a.ws + WS_B) + (isb_ ? tokB : tokA) * DM + 768 + hd * 64 + 4 * quad; \
            _Pragma("unroll") for (int dt = 0; dt < 4; ++dt) { float v[4] = {o[dt][0] * inv, o[dt][1] * inv, o[dt][2] * inv, o[dt][3] * inv}; st4bf(om + 16 * dt, v); } } }
    if (nc > 0) DSA_GATHER(wk0, wv0, 0)
    for (int ci = 0; ci < nc; ci += 2) {
        if (ci + 1 < nc) DSA_GATHER(wk1, wv1, ci + 1)
        DSA_CHUNK(wk0, wv0, ci)
        if (ci + 1 < nc) {
            if (ci + 2 < nc) DSA_GATHER(wk0, wv0, ci + 2)
            DSA_CHUNK(wk1, wv1, ci + 1)
        }
    }
#undef DSA_GATHER
#undef DSA_CHUNK
}

typedef unsigned short u16x2_t __attribute__((ext_vector_type(2)));
DI unsigned pkmax16(unsigned x, unsigned y) { return __builtin_bit_cast(unsigned, __builtin_elementwise_max(__builtin_bit_cast(u16x2_t, x), __builtin_bit_cast(u16x2_t, y))); }
DI unsigned f2key16s(float f) { const unsigned h = (unsigned)__builtin_bit_cast(unsigned short, (_Float16)f); return h ^ ((unsigned)((int)__float_as_uint(f) >> 31) | 0x8000u); }
DI unsigned f2key16(float f) { const unsigned h = (unsigned)__builtin_bit_cast(unsigned short, (_Float16)f); return (h & 0x8000u) ? (~h & 0xffffu) : (h | 0x8000u); }
template <int NR>
DI int dsa_pick(const LAS unsigned short* s16, const LAS unsigned short* cidx, LAS unsigned short* list, int c, int lane, unsigned long long ltm, unsigned& tau) {
    unsigned ck[16], ixs[16];
#pragma unroll
    for (int j = 0; j < 16; ++j) { ck[j] = 0u; ixs[j] = 0u; }
#pragma unroll
    for (int j = 0; j < NR; ++j) ixs[j] = (unsigned)cidx[j * 64 + lane];
#pragma unroll
    for (int j = 0; j < NR; ++j) ixs[j] = (j * 64 + lane < c) ? ixs[j] : 0u;
#pragma unroll
    for (int j = 0; j < NR; ++j) ck[j] = (unsigned)s16[ixs[j]];
#pragma unroll
    for (int j = 0; j < NR; ++j) ck[j] = (j * 64 + lane < c) ? ck[j] : 0u;
    tau = kth_regn<NR>(ck, 256);
    int cg = 0;
#pragma unroll
    for (int j = 0; j < NR; ++j) cg += (ck[j] > tau) ? 1 : 0;
    const int krem = 256 - wave_sum_i(cg);
    int total = 0, eqt = 0;
#pragma unroll
    for (int j = 0; j < NR; ++j) {
        if (j * 64 < c) {
            const bool gt = ck[j] > tau, eq = ck[j] == tau;
            const unsigned long long eqm = __ballot(eq); const int eqp = __popcll(eqm & ltm);
            const bool take = gt || (eq && (eqt + eqp < krem));
            const unsigned long long tm = __ballot(take); const int pos = total + __popcll(tm & ltm);
            if (take) list[pos] = (unsigned short)ixs[j];
            total += __popcll(tm); eqt += __popcll(eqm);
        }
    }
    return total;
}
DI void dsa_unit16(const Args& a, int pu, LAS unsigned char* lds, int wave, int lane) {
    const bf16* proj = (const bf16*)(a.ws + WS_A);
    const int b = pu >> 9, p = pu & 511;
    const int tA0 = 8 * p, tB0 = 8184 - 8 * p, nA = tA0 + 8, nB = tB0 + 8;
    const int na32 = (nA + 31) & ~31, nb32 = (nB + 31) & ~31;
    LAS unsigned short* sc = (LAS unsigned short*)lds;
    {
        const int c = lane & 31, hh = lane >> 5, qr = c >> 2, hr = c & 3;
        const size_t tokA = (size_t)b * SEQ + tA0, tokB = (size_t)b * SEQ + tB0;
        bf16x8 iqA[4], iqB[4];
#pragma unroll
        for (int s = 0; s < 4; ++s) { iqA[s] = *(const bf16x8*)(proj + (tokA + qr) * PW + C_DIQ + hr * 64 + 16 * s + 8 * hh); iqB[s] = *(const bf16x8*)(proj + (tokB + qr) * PW + C_DIQ + hr * 64 + 16 * s + 8 * hh); }
        f32x4 iwA[4], iwB[4];
#pragma unroll
        for (int g = 0; g < 4; ++g) { iwA[g] = *(const f32x4*)((const float*)(a.ws + WS_IW) + (tokA + 2 * g + hh) * 4); iwB[g] = *(const f32x4*)((const float*)(a.ws + WS_IW) + (tokB + 2 * g + hh) * 4); }
        const bf16* kb = (const bf16*)(a.ws + WS_IKT) + (size_t)b * (SEQ / 32) * 2048;
        const int ntA = na32 >> 5, ntB = nb32 >> 5;
        LAS unsigned short* dA = sc + hh * na32 + c; LAS unsigned short* dB = sc + 8 * na32 + hh * nb32 + c;
#define DSA_EPI(X, IW, T0, DST, PITCH, K0, MASK) { _Pragma("unroll") for (int g = 0; g < 4; ++g) { \
            const float r0 = __builtin_amdgcn_fmed3f(X[4 * g], 0.f, 3.0e38f), r1 = __builtin_amdgcn_fmed3f(X[4 * g + 1], 0.f, 3.0e38f); \
            const float r2 = __builtin_amdgcn_fmed3f(X[4 * g + 2], 0.f, 3.0e38f), r3 = __builtin_amdgcn_fmed3f(X[4 * g + 3], 0.f, 3.0e38f); \
            float a0 = __builtin_fmaf(IW[g].x, r0, 0.f), a1 = __builtin_fmaf(IW[g].y, r1, 0.f); a0 = __builtin_fmaf(IW[g].z, r2, a0); a1 = __builtin_fmaf(IW[g].w, r3, a1); \
            unsigned key = f2key16s(a0 + a1); if (MASK) key = ((K0) + c <= (T0) + 2 * g + hh) ? key : 0u; \
            (DST)[2 * g * (PITCH) + (K0)] = (unsigned short)key; } }
        bf16x8 kf[4], nkf[4];
        if (wave < ntB) ld_kt(kf, kb + (size_t)wave * 2048, c, hh);
        for (int kt = wave; kt < ntB; kt += NWAVES) {
            { const int kn = (kt + NWAVES < ntB) ? kt + NWAVES : kt; ld_kt(nkf, kb + (size_t)kn * 2048, c, hh); }
            const int k0 = kt * 32; const bool hasA = kt < ntA;
            f32x16 x = zero16(), y = zero16();
#pragma unroll
            for (int s = 0; s < 4; ++s) x = mfma32(iqB[s], kf[s], x);
            if (hasA) {
#pragma unroll
                for (int s = 0; s < 4; ++s) y = mfma32(iqA[s], kf[s], y);
            }
            if (k0 + 31 > tB0) DSA_EPI(x, iwB, tB0, dB, nb32, k0, true) else DSA_EPI(x, iwB, tB0, dB, nb32, k0, false)
            if (hasA) { if (k0 + 31 > tA0) DSA_EPI(y, iwA, tA0, dA, na32, k0, true) else DSA_EPI(y, iwA, tA0, dA, na32, k0, false) }
#pragma unroll
            for (int s = 0; s < 4; ++s) kf[s] = nkf[s];
        }
#undef DSA_EPI
    }
    __syncthreads();
    LAS unsigned short* cidx = (LAS unsigned short*)(lds + DSA_CIDX + wave * 2048);
    LAS unsigned short* dummy = (LAS unsigned short*)(lds + DSA_DUMMY + wave * 128) + lane;
    const unsigned long long ltm = (1ull << lane) - 1ull;
    int cntA = 0, cntB = 0;
#pragma unroll 1
    for (int blk = 0; blk < 2; ++blk) {
        const int tq = (blk ? tB0 : tA0) + wave, n = tq + 1, n32 = (blk ? nb32 : na32);
        const LAS unsigned short* s16 = sc + (blk ? 8 * na32 + wave * nb32 : wave * na32);
        LAS unsigned short* list = (LAS unsigned short*)(lds + DSA_LIST + (blk * 8 + wave) * 512);
        int cnt;
        if (n <= 256) { for (int i = lane; i < n; i += 64) list[i] = (unsigned short)i; cnt = n; }
        else {
            int c = 0;
            if (n <= 1024) { for (int i = lane; i < n; i += 64) cidx[i] = (unsigned short)i; c = n; }
            else {
                const bool cs4 = n <= 2048; unsigned M[16];
#pragma unroll
                for (int it = 0; it < 16; ++it) {
                    const int i8 = (cs4 ? (it >> 1) : it) * 512 + lane * 8; unsigned mx = 0u;
                    if (i8 < n32) { const u32x4 v = *(const LAS u32x4*)(s16 + i8);
                        if (cs4) { const unsigned m2 = (it & 1) ? pkmax16(v.z, v.w) : pkmax16(v.x, v.y); mx = max(m2 & 0xffffu, m2 >> 16); }
                        else { const unsigned m4 = pkmax16(pkmax16(v.x, v.y), pkmax16(v.z, v.w)); mx = max(m4 & 0xffffu, m4 >> 16); } }
                    if (cs4 && it >= 8) mx = 0u;
                    M[it] = mx;
                }
                const unsigned beta = kth_disp(M, 256, cs4 ? ((n32 + 255) >> 8) : ((n32 + 511) >> 9));
                for (int i0 = 0; i0 < n32; i0 += 512) {
                    const int i8 = i0 + lane * 8;
                    u32x4 v = (u32x4){0u, 0u, 0u, 0u}; if (i8 < n32) v = *(const LAS u32x4*)(s16 + i8);
                    const unsigned kk[8] = {v.x & 0xffffu, v.x >> 16, v.y & 0xffffu, v.y >> 16, v.z & 0xffffu, v.z >> 16, v.w & 0xffffu, v.w >> 16};
                    int fc = 0;
#pragma unroll
                    for (int k = 0; k < 8; ++k) fc += (kk[k] >= beta) ? 1 : 0;
                    const int inc = wave_incl_scan(fc); int pos = c + inc - fc;
#pragma unroll
                    for (int k = 0; k < 8; ++k) { const bool cd = kk[k] >= beta;
                        LAS unsigned short* d = (cd && pos < 1024) ? (cidx + pos) : dummy; *d = (unsigned short)(i8 + k); pos += cd ? 1 : 0; }
                    c += __builtin_amdgcn_readlane(inc, 63);
                }
                LDS_WAIT();
            }
            unsigned tau; bool fromc = (c <= 1024);
            if (fromc) {
                const int nr = (c + 63) >> 6;
                cnt = nr <= 6 ? dsa_pick<6>(s16, cidx, list, c, lane, ltm, tau) : nr <= 8 ? dsa_pick<8>(s16, cidx, list, c, lane, ltm, tau) : nr <= 12 ? dsa_pick<12>(s16, cidx, list, c, lane, ltm, tau) : dsa_pick<16>(s16, cidx, list, c, lane, ltm, tau);
            } else {
                tau = 0u;
                for (int bit = 15; bit >= 0; --bit) {
                    const unsigned cand = tau | (1u << bit); int cc = 0;
                    for (int i = lane; i < n; i += 64) cc += ((unsigned)s16[i] >= cand) ? 1 : 0;
                    if (wave_sum_i(cc) >= 256) tau = cand;
                }
                int cg = 0;
                for (int i = lane; i < n; i += 64) cg += ((unsigned)s16[i] > tau) ? 1 : 0;
                const int krem = 256 - wave_sum_i(cg);
                int total = 0, eqt = 0;
                for (int i0 = 0; i0 < n; i0 += 64) {
                    const int i = i0 + lane; const unsigned key = (i < n) ? (unsigned)s16[i] : 0u;
                    const bool gt = key > tau, eq = (i < n) && key == tau;
                    const unsigned long long eqm = __ballot(eq); const int eqp = __popcll(eqm & ltm);
                    const bool take = gt || (eq && (eqt + eqp < krem));
                    const unsigned long long tm = __ballot(take); const int pos = total + __popcll(tm & ltm);
                    if (take) list[pos] = (unsigned short)i;
                    total += __popcll(tm); eqt += __popcll(eqm);
                }
                cnt = total;
            }
        }
        if (blk) cntB = cnt; else cntA = cnt;
    }
    __syncthreads();
    dsa_attend2(a, proj, b, (size_t)b * SEQ + tA0 + wave, (const LAS unsigned short*)(lds + DSA_LIST + wave * 512), cntA, (size_t)b * SEQ + tB0 + wave, (const LAS unsigned short*)(lds + DSA_LIST + (8 + wave) * 512), cntB, lds + wave * 16384, lane);
    __syncthreads();
}

#ifndef HOSTDUP
#define HOSTDUP 0
#endif
#ifndef MK_SINGLE
#define MK_SINGLE 1
#endif
constexpr int PRM_OFF = MISC_OFF + 256;
DI void store_args(LAS unsigned char* lds, const Args& k) {
    LAS unsigned long long* q = (LAS unsigned long long*)(lds + PRM_OFF);
    q[0] = (unsigned long long)k.x; q[1] = (unsigned long long)k.pos; q[2] = (unsigned long long)k.w_in; q[3] = (unsigned long long)k.b_f; q[4] = (unsigned long long)k.pe_cmp;
    q[5] = (unsigned long long)k.w_cmp1; q[6] = (unsigned long long)k.w_cmp2; q[7] = (unsigned long long)k.w_gate; q[8] = (unsigned long long)k.w_br; q[9] = (unsigned long long)k.w_o;
    q[10] = (unsigned long long)k.ln1_g; q[11] = (unsigned long long)k.ln1_b; q[12] = (unsigned long long)k.w_router; q[13] = (unsigned long long)k.router_bias;
    q[14] = (unsigned long long)k.w_eg; q[15] = (unsigned long long)k.w_eu; q[16] = (unsigned long long)k.w_ed; q[17] = (unsigned long long)k.w_sg; q[18] = (unsigned long long)k.w_su; q[19] = (unsigned long long)k.w_sd;
    q[20] = (unsigned long long)k.ln2_g; q[21] = (unsigned long long)k.ln2_b; q[22] = (unsigned long long)k.out; q[23] = (unsigned long long)k.ws;
}
DI unsigned long long ldprm(LAS unsigned char* lds, int i) {
    const u32x2 v = *(const LAS u32x2*)(lds + PRM_OFF + 8 * i);
    return ((unsigned long long)(unsigned)__builtin_amdgcn_readfirstlane((int)v.y) << 32) | (unsigned long long)(unsigned)__builtin_amdgcn_readfirstlane((int)v.x);
}
DI Args lds_args(LAS unsigned char* lds) {
    Args a;
    a.x = (const float*)(const GAS float*)ldprm(lds, 0); a.pos = (const int*)(const GAS int*)ldprm(lds, 1); a.w_in = (const float*)(const GAS float*)ldprm(lds, 2); a.b_f = (const float*)(const GAS float*)ldprm(lds, 3); a.pe_cmp = (const float*)(const GAS float*)ldprm(lds, 4);
    a.w_cmp1 = (const float*)(const GAS float*)ldprm(lds, 5); a.w_cmp2 = (const float*)(const GAS float*)ldprm(lds, 6); a.w_gate = (const float*)(const GAS float*)ldprm(lds, 7); a.w_br = (const float*)(const GAS float*)ldprm(lds, 8); a.w_o = (const float*)(const GAS float*)ldprm(lds, 9);
    a.ln1_g = (const float*)(const GAS float*)ldprm(lds, 10); a.ln1_b = (const float*)(const GAS float*)ldprm(lds, 11); a.w_router = (const float*)(const GAS float*)ldprm(lds, 12); a.router_bias = (const float*)(const GAS float*)ldprm(lds, 13);
    a.w_eg = (const float*)(const GAS float*)ldprm(lds, 14); a.w_eu = (const float*)(const GAS float*)ldprm(lds, 15); a.w_ed = (const float*)(const GAS float*)ldprm(lds, 16); a.w_sg = (const float*)(const GAS float*)ldprm(lds, 17); a.w_su = (const float*)(const GAS float*)ldprm(lds, 18); a.w_sd = (const float*)(const GAS float*)ldprm(lds, 19);
    a.ln2_g = (const float*)(const GAS float*)ldprm(lds, 20); a.ln2_b = (const float*)(const GAS float*)ldprm(lds, 21); a.out = (float*)(GAS float*)ldprm(lds, 22); a.ws = (unsigned char*)(GAS unsigned char*)ldprm(lds, 23); a.ph_lo = 0; a.ph_hi = 0;
    return a;
}
#ifndef PHMASK
#define PHMASK 0xffffffffu
#endif
#define PHON(j) (((PHMASK) >> (j)) & 1u)
#define PH_BEGIN const Args a = lds_args(lds); unsigned char* ws = a.ws; (void)ws; \
    const int tid = ltid(), lane = tid & 63, wave = __builtin_amdgcn_readfirstlane(tid >> 6); \
    const int G = lgrid(), bid = lbid(), gw = bid * NWAVES + wave, NGW = G * NWAVES; (void)bid; (void)lane; (void)wave; (void)gw; (void)NGW; (void)G;
#ifndef PH_NOINLINE
#define PHFN DI void
#else
#define PHFN __attribute__((noinline)) __device__ void
#endif

PHFN f_prologue(LAS unsigned char* lds) { PH_BEGIN ph_prologue(a, gw, NGW, lane); }
PHFN f_cvt(LAS unsigned char* lds, int l) { PH_BEGIN ph_cvt(a, l, lds, gw, NGW, wave, lane); }
PHFN f_proj(LAS unsigned char* lds) { PH_BEGIN
    SchedProj S; S.so.init(NTOK, PW, G, bid); S.A = (unsigned)WS_XB; S.B = (unsigned)W_IN;
    EpiProj E; E.proj = (bf16*)(ws + WS_A); E.sm32 = (float*)(ws + WS_SM32);
    gs::gemm_stream<SchedProj, EpiProj, 2>(lds, (const char*)ws, S, E); }
PHFN f_post(LAS unsigned char* lds, int l) { PH_BEGIN ph_post(a, l, lds, wave, lane); }
PHFN f_cmp(LAS unsigned char* lds) { PH_BEGIN
    SchedCmp S; S.kcr = (unsigned)WS_KCR; S.vcr = (unsigned)WS_VCR; S.w = (unsigned)W_C1;
    EpiCmp E; E.hid = (float*)(ws + WS_HID); E.cbias = (const float*)(ws + WS_CBIAS);
    gs::gemm_stream<SchedCmp, EpiCmp, 2>(lds, (const char*)ws, S, E);
    if (bid >= 32 && bid < 64 && wave == 0) cumsum_seq(a, bid - 32, lane);
    if (G < 64 && bid == 0 && wave == 1) for (int q = (G > 32 ? G - 32 : 0); q < 32; ++q) cumsum_seq(a, q, lane); }
PHFN f_cmp2(LAS unsigned char* lds, int l) { PH_BEGIN ph_cmp2(a, l, gw, NGW, lane); }
PHFN f_dsa(LAS unsigned char* lds) { PH_BEGIN for (int pu = bid; pu < NTOK / 16; pu += G) dsa_unit16(a, pu, lds, wave, lane); }
PHFN f_nsa(LAS unsigned char* lds) { PH_BEGIN
    for (int u = gw, r = 0; u < NTOK / 8; u += NGW, ++r) {
        int unit = u;
        if (NGW == 2048) { const int bsel = u >> 10, pos = ((u & 1023) + 256 * r) & 1023; unit = bsel * 1024 + pos; }
        nsa_unit(a, unit, lds + wave * 5120, lane);
    } }
PHFN f_sbfg(LAS unsigned char* lds, int l) { PH_BEGIN
    for (int u = bid; u < 2048; u += G) {
        const int r = u >> 8, blk = u & 255, bh = blk & 31, f = blk >> 5, mixer = r >> 2, rr = r & 3;
        const int QB = (rr == 0) ? f : (rr == 1) ? 31 - f : (rr == 2) ? 8 + f : 23 - f;
        if (mixer == 0) sbfg_block<0>(a, l, bh >> 2, bh & 3, QB, lds, tid, wave, lane); else sbfg_block<1>(a, l, bh >> 2, bh & 3, QB, lds, tid, wave, lane);
        __syncthreads();
    } }
PHFN f_merge(LAS unsigned char* lds) { PH_BEGIN
    SchedMerge S; S.xb = (unsigned)WS_XB; S.om = (unsigned)WS_B; S.wg = (unsigned)W_G; S.wbr = (unsigned)W_BR; S.G = G;
    EpiMerge E; E.merged = (bf16*)(ws + WS_C); E.stash = (u32x4*)(ws + WS_A + (size_t)bid * 65536);
    gs::gemm_stream<SchedMerge, EpiMerge, 1>(lds, (const char*)ws, S, E); }
PHFN f_wo(LAS unsigned char* lds, int l) { PH_BEGIN
    SchedWo S; S.so.init(NTOK, DM, G, bid); S.A = (unsigned)WS_C; S.B = (unsigned)W_O;
    EpiWo E; E.xb = (bf16*)(ws + WS_XB); (void)l;
    gs::gemm_stream<SchedWo, EpiWo, 2>(lds, (const char*)ws, S, E); }
PHFN f_ln1(LAS unsigned char* lds, int l) { PH_BEGIN ph_ln1(a, l, gw, NGW, lane); }
PHFN f_router(LAS unsigned char* lds) { PH_BEGIN
    SchedRouter S; S.xh = (unsigned)WS_XB; S.xl = (unsigned)WS_XL; S.wh = (unsigned)W_RH; S.wl = (unsigned)W_RL; S.G = G;
    EpiRouter E; E.logit = (float*)(ws + WS_LOGIT);
    gs::gemm_stream<SchedRouter, EpiRouter, 1>(lds, (const char*)ws, S, E); }
PHFN f_route(LAS unsigned char* lds, int l) { PH_BEGIN ph_route(a, l, lds, wave, lane); }
PHFN f_e1(LAS unsigned char* lds, int l) { PH_BEGIN
    moe_tables(a, l, lds);
    SchedE1 S; S.ptile = (const LAS int*)(lds + TBL_OFF); S.cntv = S.ptile + 2 * TBLN; S.xb = (unsigned)WS_XB; S.lists = (const unsigned*)(ws + WS_LIST); S.w1 = (unsigned)W_1; S.G = G;
    EpiE1 E; E.hb = (bf16*)(ws + WS_HB);
    gs::gemm_stream<SchedE1, EpiE1, 2>(lds, (const char*)ws, S, E); }
PHFN f_e2(LAS unsigned char* lds, int l, int c) { PH_BEGIN
    moe_tables(a, l, lds);
    SchedE2 S; S.ptile = (const LAS int*)(lds + TBL_OFF); S.ypre = S.ptile + TBLN; S.cntv = S.ptile + 2 * TBLN; S.hb = (unsigned)WS_HB; S.w2 = (unsigned)W_2; S.c = c; S.G = G;
    EpiE2 E; E.y = (unsigned char*)(ws + WS_Y);
    gs::gemm_stream<SchedE2, EpiE2, 2>(lds, (const char*)ws, S, E); }
PHFN f_ln2(LAS unsigned char* lds, int l, int c) { PH_BEGIN moe_tables(a, l, lds); ph_ln2(a, l, c, lds, gw, NGW, lane); }
PHFN f_seam(LAS unsigned char* lds) {
    XcdBarrier bar; bar.bar = (unsigned*)((unsigned char*)(GAS unsigned char*)ldprm(lds, 23) + WS_CTL) + CW_BAR; bar.x = xb_xcc_id(); bar.st = (volatile LAS unsigned*)(lds + MISC_OFF) + 8; xcd_barrier(bar); }

#define IN(k) (lo <= (k) && (k) < hi)
#define SEAM(k) do { if ((k) + 1 < hi) f_seam(lds); } while (0)
DI void run_layer(LAS unsigned char* lds, const int l, const int lo, const int hi) {
        const int pb = 1 + l * NPL;
        if (PHON(0) && IN(pb + 0)) { f_cvt(lds, l); SEAM(pb + 0); }
        if (PHON(1) && IN(pb + 1)) { f_proj(lds); SEAM(pb + 1); }
        if (PHON(2) && IN(pb + 2)) { f_post(lds, l); SEAM(pb + 2); }
        if (PHON(3) && IN(pb + 3)) { f_cmp(lds); __syncthreads(); f_dsa(lds); SEAM(pb + 3); }
        if (PHON(4) && IN(pb + 4)) { f_cmp2(lds, l); __syncthreads(); f_sbfg(lds, l); SEAM(pb + 4); }
        if (PHON(21) && IN(pb + 5)) { f_nsa(lds); SEAM(pb + 5); }
        if (PHON(6) && IN(pb + 6)) { f_merge(lds); SEAM(pb + 6); }
        if (PHON(7) && IN(pb + 7)) { f_wo(lds, l); SEAM(pb + 7); }
        if (PHON(8) && IN(pb + 8)) { f_ln1(lds, l); SEAM(pb + 8); }
        if (PHON(9) && IN(pb + 9)) { f_router(lds); SEAM(pb + 9); }
        if (PHON(10) && IN(pb + 10)) { f_route(lds, l); SEAM(pb + 10); }
        if (PHON(11) && IN(pb + 11)) { f_e1(lds, l); SEAM(pb + 11); }
        for (int c = 0; c < NCH; ++c) {
            if (PHON(12) && IN(pb + 12 + 2 * c)) { f_e2(lds, l, c); SEAM(pb + 12 + 2 * c); }
            if (PHON(13) && IN(pb + 13 + 2 * c)) { f_ln2(lds, l, c); SEAM(pb + 13 + 2 * c); }
        }
}
#undef IN
#undef SEAM
#ifndef DUPMASK
#define DUPMASK 0
#endif
#define DUP(j) (((DUPMASK) >> (j)) & 1)
__global__ void __launch_bounds__(NWAVES * 64, 2) fwd(Args ka) {
    extern __shared__ __attribute__((aligned(16))) unsigned char lds_[];
    LAS unsigned char* lds = (LAS unsigned char*)lds_;
    const int tid = threadIdx.x;
    volatile LAS unsigned* MISC = (volatile LAS unsigned*)(lds + MISC_OFF);
    if (tid < 64) MISC[tid] = 0u;
    if (tid == 64) store_args(lds, ka);
    const int lo = ka.ph_lo, hi = ka.ph_hi;
    __syncthreads();
    if (hi - lo > 1 && tid == 0) (void)xb_add(&((unsigned*)(ka.ws + WS_CTL) + CW_BAR)[XB_XCNT(xb_xcc_id())], 1u);
#define IN(k) (lo <= (k) && (k) < hi)
#define SEAM(k) do { if ((k) + 1 < hi) f_seam(lds); } while (0)
    if (PHON(31) && IN(0)) { f_prologue(lds); SEAM(0); }
    run_layer(lds, 0, lo, hi); run_layer(lds, 1, lo, hi); run_layer(lds, 2, lo, hi); run_layer(lds, 3, lo, hi);
#undef IN
#undef SEAM
}

extern "C" void kernel_launch(void* const* d_in, const int* in_sizes, int n_in, void* d_out, int out_size, void* d_ws, size_t ws_size, hipStream_t stream) {
    static int grid = 0;
    if (grid == 0) {
        if (n_in != 22 || in_sizes[0] != NTOK * DM || out_size != NTOK * DM || ws_size < WS_END) {
            fprintf(stderr, "kernel_launch: unexpected shapes/workspace: n_in %d in0 %d out %d ws %zu (need %zu)\n", n_in, n_in > 0 ? in_sizes[0] : -1, out_size, ws_size, (size_t)WS_END); grid = -1; return; }
        int dev = 0, cus = 0, per_cu = 0;
        if (hipGetDevice(&dev) != hipSuccess || hipDeviceGetAttribute(&cus, hipDeviceAttributeMultiprocessorCount, dev) != hipSuccess) { grid = -1; return; }
        if (hipFuncSetAttribute((const void*)fwd, hipFuncAttributeMaxDynamicSharedMemorySize, LDS_BYTES) != hipSuccess) { fprintf(stderr, "kernel_launch: hipFuncSetAttribute failed\n"); grid = -1; return; }
        if (hipOccupancyMaxActiveBlocksPerMultiprocessor(&per_cu, (const void*)fwd, NWAVES * 64, LDS_BYTES) != hipSuccess || per_cu < 1)
            fprintf(stderr, "kernel_launch: occupancy query reports %d blocks per CU\n", per_cu);
        (void)hipGetLastError();
        grid = cus;
    }
    if (grid < 0) return;
    (void)hipMemsetAsync((char*)d_ws + WS_CTL, 0, CTL_ZERO_BYTES, stream);
    Args a{};
    a.x = (const float*)d_in[0]; a.pos = (const int*)d_in[1]; a.w_in = (const float*)d_in[2]; a.b_f = (const float*)d_in[3]; a.pe_cmp = (const float*)d_in[4];
    a.w_cmp1 = (const float*)d_in[5]; a.w_cmp2 = (const float*)d_in[6]; a.w_gate = (const float*)d_in[7]; a.w_br = (const float*)d_in[8]; a.w_o = (const float*)d_in[9];
    a.ln1_g = (const float*)d_in[10]; a.ln1_b = (const float*)d_in[11]; a.w_router = (const float*)d_in[12]; a.router_bias = (const float*)d_in[13];
    a.w_eg = (const float*)d_in[14]; a.w_eu = (const float*)d_in[15]; a.w_ed = (const float*)d_in[16]; a.w_sg = (const float*)d_in[17]; a.w_su = (const float*)d_in[18]; a.w_sd = (const float*)d_in[19];
    a.ln2_g = (const float*)d_in[20]; a.ln2_b = (const float*)d_in[21];
    a.out = (float*)d_out; a.ws = (unsigned char*)d_ws;
#if MK_SINGLE
    a.ph_lo = 0; a.ph_hi = NPHASE;
    hipLaunchKernelGGL(fwd, dim3(grid), dim3(NWAVES * 64), LDS_BYTES, stream, a);
#else
    for (int p = 0; p < NPHASE; ++p) { a.ph_lo = p; a.ph_hi = p + 1; hipLaunchKernelGGL(fwd, dim3(grid), dim3(NWAVES * 64), LDS_BYTES, stream, a);
        if (p > 0 && ((HOSTDUP >> ((p - 1) % NPL)) & 1)) hipLaunchKernelGGL(fwd, dim3(grid), dim3(NWAVES * 64), LDS_BYTES, stream, a); }
#endif
}
```

```cpp
#include <hip/hip_runtime.h>
#include <cstdio>
#include <cstdint>

#define GAS __attribute__((address_space(1)))
#define LAS __attribute__((address_space(3)))
typedef unsigned short bf16;
typedef short bf16x8 __attribute__((ext_vector_type(8)));
typedef float f32x4 __attribute__((ext_vector_type(4)));
typedef float f32x2 __attribute__((ext_vector_type(2)));
typedef float f32x16 __attribute__((ext_vector_type(16)));
typedef unsigned u32x4 __attribute__((ext_vector_type(4)));
typedef unsigned u32x2 __attribute__((ext_vector_type(2)));
typedef __bf16 bf16x2_t __attribute__((ext_vector_type(2)));
typedef GAS unsigned gu32;

#define DI __device__ __forceinline__
#define LDS_WAIT() asm volatile("s_waitcnt lgkmcnt(0)" ::: "memory")
#define VM_WAIT() asm volatile("s_waitcnt vmcnt(0)" ::: "memory")
#define RLX_AGENT __ATOMIC_RELAXED, __HIP_MEMORY_SCOPE_AGENT

constexpr int NBATCH = 8, SEQ = 8192, NTOK = NBATCH * SEQ, DM = 1024, DEPTH = 4;
constexpr int PW = 3136;
constexpr int C_AQ = 0, C_BQ = 256, C_BK = 512, C_BV = 768, C_CQ = 1024, C_CK = 1280, C_CV = 1536, C_DQ = 1792, C_DIQ = 2048,
              C_AKC = 2304, C_AVC = 2368, C_AKS = 2432, C_AVS = 2496, C_AKW = 2560, C_AVW = 2624, C_DK = 2688, C_DV = 2752, C_DIK = 2816, C_SM = 2880;
constexpr int IN_W = 2900;
constexpr float QS = 0.18033688011112042f;
constexpr float LOG2E = 1.4426950408889634f;
constexpr float ALPHA = 1.681792830507429f;
constexpr float LN_EPS = 1e-5f;
constexpr int NEXP = 64, NCH = 2, CHTOK = NTOK / NCH;
constexpr int NPL = 12 + 2 * NCH;
constexpr int NPHASE = 1 + DEPTH * NPL;
constexpr int NWAVES = 8;

constexpr size_t MiB = 1u << 20;
constexpr size_t WS_CTL = 0, CTL_ZERO_BYTES = 1 * MiB;
constexpr size_t WS_ROPE = 1 * MiB;
constexpr size_t WS_SM32 = 5 * MiB;
constexpr size_t WS_GATE = 13 * MiB;
constexpr size_t WS_LOGF = 16 * MiB;
constexpr size_t WS_CUM  = 17 * MiB;
constexpr size_t WS_IW   = 18 * MiB;
constexpr size_t WS_HID  = 19 * MiB;
constexpr size_t WS_KCMP = 21 * MiB;
constexpr size_t WS_VTCMP = 21 * MiB + 512 * 1024;
constexpr size_t WS_CBIAS = 22 * MiB;
constexpr size_t WS_KCR  = 23 * MiB;
constexpr size_t WS_VCR  = 32 * MiB;
constexpr size_t WS_VT   = 41 * MiB;
constexpr size_t WS_VTB = WS_VT, WS_VTC = WS_VT + 32 * MiB, WS_VTAS = WS_VT + 64 * MiB, WS_VTAW = WS_VT + 72 * MiB;
constexpr size_t WS_LOGIT = WS_VT;
constexpr size_t WS_TOKINFO = WS_VT + 16 * MiB;
constexpr size_t WS_LIST = WS_VT + 20 * MiB;
constexpr size_t WS_W    = 121 * MiB;
constexpr size_t W_IN = WS_W, W_G = WS_W + 6 * MiB, W_BR = WS_W + 14 * MiB, W_O = WS_W + 16 * MiB, W_C1 = WS_W + 18 * MiB,
                 W_RH = WS_W + 20 * MiB, W_RL = WS_W + 20 * MiB + 512 * 1024, W_1 = WS_W + 21 * MiB, W_2 = WS_W + 86 * MiB;
constexpr size_t WS_XB   = 243 * MiB;
constexpr size_t WS_A    = 371 * MiB;
constexpr size_t WS_B    = 763 * MiB;
constexpr size_t WS_C    = 891 * MiB;
constexpr size_t WS_END  = 1019 * MiB;
constexpr size_t WS_KTS = WS_C, WS_KTW = WS_C + 8 * MiB, WS_IKT = WS_C + 16 * MiB, WS_KTB = WS_C + 32 * MiB, WS_KTC = WS_C + 64 * MiB;
constexpr size_t WS_XL = WS_A, WS_HB = WS_A, WS_Y = WS_A + 320 * MiB;
static_assert(WS_Y + (size_t)(CHTOK * 8 / 256 + 64 + CHTOK / 256) * 256 * DM <= WS_END, "tile-padded fp8 y chunk fits");
constexpr int HB_TILES = NTOK * 8 / 256 + NCH * 64 + NTOK / 256;
static_assert((size_t)HB_TILES * 256 * 512 <= 320 * MiB, "hbuf fits");

constexpr int CW_BAR = 4096;
constexpr int CW_CNT = 16384;
constexpr int CW_KMAX = 32768;

constexpr int RING_BYTES = 131072;
constexpr int MISC_OFF = 162816;
constexpr int LDS_BYTES = 163840;

DI unsigned cvtpk(float lo, float hi) { f32x2 v = {lo, hi}; bf16x2_t b = __builtin_convertvector(v, bf16x2_t); return __builtin_bit_cast(unsigned, b); }
DI u32x4 pack8(const f32x4& v0, const f32x4& v1) { u32x4 w; w.x = cvtpk(v0[0], v0[1]); w.y = cvtpk(v0[2], v0[3]); w.z = cvtpk(v1[0], v1[1]); w.w = cvtpk(v1[2], v1[3]); return w; }
DI float bf2f(unsigned short h) { return __uint_as_float(((unsigned)h) << 16); }
DI float bflo(unsigned w) { return __uint_as_float(w << 16); }
DI float bfhi(unsigned w) { return __uint_as_float(w & 0xffff0000u); }
DI float fexp2(float x) { return __builtin_amdgcn_exp2f(x); }
DI float flog2(float x) { return __builtin_amdgcn_logf(x); }
DI float frcp(float x) { return __builtin_amdgcn_rcpf(x); }
DI float sigmoidf_(float x) { return frcp(1.f + fexp2(-x * LOG2E)); }
#define DPPF(v, ctrl, rm, bc) __int_as_float(__builtin_amdgcn_update_dpp(0, __float_as_int(v), (ctrl), (rm), 0xF, (bc)))
#define DPPI(v, ctrl, rm, bc) __builtin_amdgcn_update_dpp(0, (v), (ctrl), (rm), 0xF, (bc))
DI float dpp_xor1(float v) { return DPPF(v, 0xB1, 0xF, true); }
DI float dpp_xor2(float v) { return DPPF(v, 0x4E, 0xF, true); }
DI float red16_sum(float v) { const auto r = __builtin_amdgcn_permlane16_swap(__float_as_uint(v), __float_as_uint(v), false, false); return __uint_as_float(r[0]) + __uint_as_float(r[1]); }
DI float red16_max(float v) { const auto r = __builtin_amdgcn_permlane16_swap(__float_as_uint(v), __float_as_uint(v), false, false); return fmaxf(__uint_as_float(r[0]), __uint_as_float(r[1])); }
DI float red32_sum(float v) { const auto r = __builtin_amdgcn_permlane32_swap(__float_as_uint(v), __float_as_uint(v), false, false); return __uint_as_float(r[0]) + __uint_as_float(r[1]); }
DI float red32_max(float v) { const auto r = __builtin_amdgcn_permlane32_swap(__float_as_uint(v), __float_as_uint(v), false, false); return fmaxf(__uint_as_float(r[0]), __uint_as_float(r[1])); }
DI float wave_sum(float v) {
    v += dpp_xor1(v); v += dpp_xor2(v); v += DPPF(v, 0x124, 0xF, true); v += DPPF(v, 0x128, 0xF, true);
    v = red16_sum(v); return red32_sum(v);
}
DI float wave_max(float v) {
    v = fmaxf(v, dpp_xor1(v)); v = fmaxf(v, dpp_xor2(v)); v = fmaxf(v, DPPF(v, 0x124, 0xF, true)); v = fmaxf(v, DPPF(v, 0x128, 0xF, true));
    v = red16_max(v); return red32_max(v);
}
DI int wave_incl_scan(int v) {
    v += DPPI(v, 0x111, 0xF, true); v += DPPI(v, 0x112, 0xF, true); v += DPPI(v, 0x114, 0xF, true); v += DPPI(v, 0x118, 0xF, true);
    v += DPPI(v, 0x142, 0xA, false);
    v += DPPI(v, 0x143, 0xC, false);
    return v;
}
DI float wave_incl_scan_f(float v) {
    v += DPPF(v, 0x111, 0xF, true); v += DPPF(v, 0x112, 0xF, true); v += DPPF(v, 0x114, 0xF, true); v += DPPF(v, 0x118, 0xF, true);
    v += DPPF(v, 0x142, 0xA, false); v += DPPF(v, 0x143, 0xC, false);
    return v;
}
DI int ltid() { int t = threadIdx.x; asm volatile("" : "+v"(t)); return t; }
DI int lbid() { int b = blockIdx.x; asm volatile("" : "+s"(b)); return b; }
DI int lgrid() { int g = gridDim.x; asm volatile("" : "+s"(g)); return g; }
DI f32x16 mfma32(bf16x8 a, bf16x8 b, f32x16 c) { return __builtin_amdgcn_mfma_f32_32x32x16_bf16(a, b, c, 0, 0, 0); }
DI f32x4 mfma16(bf16x8 a, bf16x8 b, f32x4 c) { return __builtin_amdgcn_mfma_f32_16x16x32_bf16(a, b, c, 0, 0, 0); }

#define XB_TMO      128
#define XB_XCNT(j)  (256  + 64 * (j))
#define XB_XSUB(j)  (1280 + 64 * (j))
#define XB_XGEN(j)  (2304 + 64 * (j))
#define XB_TOP      3328
#define XB_TOPGEN   3392
#define XCD_BAR_WORDS 3456
#define XB_SPIN_CAP (1u << 22)
DI unsigned xb_ld(unsigned* p)              { return __hip_atomic_load(p, __ATOMIC_RELAXED, __HIP_MEMORY_SCOPE_AGENT); }
DI unsigned xb_add(unsigned* p, unsigned v) { return __hip_atomic_fetch_add(p, v, __ATOMIC_RELAXED, __HIP_MEMORY_SCOPE_AGENT); }
DI unsigned xb_xcc_id() { return (unsigned)__builtin_amdgcn_s_getreg((3 << 11) | 20) & 0xFu; }
#define XB_SPIN(cond, bar) do { unsigned _sp = 0; while (cond) { __builtin_amdgcn_s_sleep(1); \
    if ((++_sp & 255u) == 0u) { if (xb_ld(&(bar)[XB_TMO])) break; if (_sp > XB_SPIN_CAP) { atomicAdd(&(bar)[XB_TMO], 1u); break; } } } } while (0)
struct XcdBarrier { unsigned* bar; unsigned x; volatile LAS unsigned* st; };
DI XcdBarrier xcd_barrier_post(unsigned* bar, volatile LAS unsigned* st) {
    XcdBarrier b; b.bar = bar; b.x = xb_xcc_id(); b.st = st;
    if (threadIdx.x == 0) (void)xb_add(&bar[XB_XCNT(b.x)], 1u);
    return b;
}
DI void xcd_barrier_complete(unsigned* bar, unsigned x, unsigned& nloc, unsigned& nx) {
    const unsigned G = gridDim.x * gridDim.y * gridDim.z;
    unsigned sum, cnt, mine, sp = 0u;
    for (;;) {
        sum = 0u; cnt = 0u; mine = 0u;
#pragma unroll
        for (unsigned j = 0; j < 16; ++j) { const unsigned c = xb_ld(&bar[XB_XCNT(j)]); sum += c; cnt += (c > 0u) ? 1u : 0u; mine = (j == x) ? c : mine; }
        if (sum == G) break;
        __builtin_amdgcn_s_sleep(1);
        if ((++sp & 255u) == 0u) { if (xb_ld(&bar[XB_TMO])) break; if (sp > XB_SPIN_CAP) { atomicAdd(&bar[XB_TMO], 1u); break; } }
    }
    nloc = mine > 0u ? mine : 1u; nx = cnt > 0u ? cnt : 1u;
}
DI void xcd_barrier(const XcdBarrier& b) {
    asm volatile("s_waitcnt vmcnt(0)" ::: "memory");
    __syncthreads();
    if (threadIdx.x == 0) {
        unsigned* bar = b.bar;
        __builtin_amdgcn_s_waitcnt(0);
        unsigned nloc = b.st[0], nx = b.st[1];
        if (nloc == 0u) { xcd_barrier_complete(bar, b.x, nloc, nx); b.st[0] = nloc; b.st[1] = nx; }
        const unsigned old = xb_add(&bar[XB_XSUB(b.x)], 1u);
        const unsigned gen = old / nloc;
        if (old + 1u == (gen + 1u) * nloc) {
            __builtin_amdgcn_fence(__ATOMIC_RELEASE, "agent");
            asm volatile("s_waitcnt vmcnt(0)" ::: "memory");
            const unsigned og = xb_add(&bar[XB_TOP], 1u);
            const unsigned tg = og / nx;
            if (og + 1u == (tg + 1u) * nx) xb_add(&bar[XB_TOPGEN], 1u);
            else XB_SPIN(xb_ld(&bar[XB_TOPGEN]) == tg, bar);
            __builtin_amdgcn_fence(__ATOMIC_ACQUIRE, "agent");
            xb_add(&bar[XB_XGEN(b.x)], 1u);
            asm volatile("s_waitcnt vmcnt(0)" ::: "memory");
        } else {
            XB_SPIN(xb_ld(&bar[XB_XGEN(b.x)]) == gen, bar);
            __builtin_amdgcn_fence(__ATOMIC_ACQUIRE, "agent");
            asm volatile("s_waitcnt vmcnt(0)" ::: "memory");
        }
    }
    __syncthreads();
}

namespace gs {
constexpr int BM = 256, BK = 64, HALF = 128, HTB = HALF * BK * 2, NXCD = 8, WGM = 8;
__host__ __device__ __forceinline__ int lds_byte(int r, int c) { const int st = (r >> 4) * 2 + (c >> 5), rr = r & 15, cc = c & 31, ob = rr * 64 + cc * 2; return st * 1024 + (ob ^ (((ob >> 9) & 1) << 5)); }
__host__ __device__ __forceinline__ void stage_rc(int b, int& R, int& C) { const int st = b / 1024, sb = b % 1024, swz = sb ^ (((sb >> 9) & 1) << 5); R = (st >> 1) * 16 + swz / 64; C = (st & 1) * 32 + (swz % 64) / 2; }
__host__ __device__ __forceinline__ int perm32(int rho) { const int n = rho >> 4, i = rho & 15; return 8 * (i >> 2) + 4 * n + (i & 3); }
__host__ __device__ __forceinline__ int bh8row(int R) { return (R >> 5) * 64 + 16 * ((R & 15) >> 2) + 4 * ((R >> 4) & 1) + (R & 3); }

struct GU {
    unsigned A, B; const int* idx;
    unsigned lda, ldb;
    int nt;
    int flags;
    int nvalid;
    int a0, a1, a2, a3;
};
struct Unit { int pm, pn; };
struct StaticOrder {
    int nM, nN, nwg, G, c;
    DI void init(int M, int N, int G_, int c_) { nM = M / BM; nN = N / BM; nwg = nM * nN; G = G_; c = c_; }
    DI bool next(int i, Unit& u) const {
        const long L = (long)i * G + c; if (L >= nwg) return false;
        int wgid = (int)L; { const int q = nwg / NXCD, r = nwg % NXCD, xcd = wgid % NXCD, off = wgid / NXCD; wgid = (xcd < r ? xcd * (q + 1) : r * (q + 1) + (xcd - r) * q) + off; }
        const int nig = WGM * nN, gid = wgid / nig, fm = gid * WGM, gsz = (nM - fm) < WGM ? (nM - fm) : WGM;
        u.pm = fm + ((wgid % nig) % gsz); u.pn = (wgid % nig) / gsz; return true;
    }
};

template <class Sched, class Epi, int NBH>
DI void gemm_stream(LAS unsigned char* lds, const char* wsb, Sched& S, Epi& E) {
    constexpr bool GATH = Sched::GATHER, FIXED = Sched::FIXED;
    const int tid = ltid(), wid = __builtin_amdgcn_readfirstlane(tid >> 6), lane = tid & 63, wr = wid >> 2, wc = wid & 3, fr = lane & 15, fq = lane >> 4;
    int R0, C0, R1, C1; stage_rc(tid * 16, R0, C0); stage_rc(tid * 16 + 8192, R1, C1);
    const unsigned Rb0 = Epi::BH8 ? (unsigned)bh8row(R0) : Epi::PERM ? ((R0 & ~31) + perm32(R0 & 31)) : R0, Rb1 = Epi::BH8 ? (unsigned)bh8row(R1) : Epi::PERM ? ((R1 & ~31) + perm32(R1 & 31)) : R1;
    constexpr unsigned BHS = Epi::BH8 ? 8u : (unsigned)HALF;
    const unsigned C0b = (unsigned)C0 * 2u, C1b = (unsigned)C1 * 2u;
    const unsigned ldsw = (unsigned)wid * 1024u;
    const int aoff = lds_byte(wr * 64 + fr, fq * 8), boff = lds_byte(wc * 32 + fr, fq * 8);
#define GS_SA(b, h) (((b) * 2 + (h)) * HTB)
#define GS_SB(b, h) ((4 + (b) * 2 + (h)) * HTB)
#define GS_STG_O(bufoff, gbase, o0, o1) do { \
        unsigned _q0 = (gbase) + (o0), _q1 = (gbase) + (o1); asm volatile("" : "+v"(_q0), "+v"(_q1)); \
        __builtin_amdgcn_global_load_lds((const unsigned*)(wsb + (size_t)_q0), (LAS unsigned*)(lds + (bufoff) + ldsw), 16, 0, 0); \
        __builtin_amdgcn_global_load_lds((const unsigned*)(wsb + (size_t)_q1), (LAS unsigned*)(lds + (bufoff) + ldsw + 8192), 16, 0, 0); } while (0)
#define GS_STGA(bufoff, gbase, h, r0, r1, ld) do { if constexpr (FIXED) GS_STG_O(bufoff, (gbase) + (unsigned)(h) * HALF * (ld), fa0, fa1); \
        else GS_STG_O(bufoff, gbase, (unsigned)(r0) * (ld) + C0b, (unsigned)(r1) * (ld) + C1b); } while (0)
#define GS_STGB(bufoff, gbase, h, ld) do { if constexpr (FIXED) GS_STG_O(bufoff, (gbase) + (unsigned)(h) * BHS * (ld), fb0, fb1); \
        else GS_STG_O(bufoff, (gbase) + (unsigned)(h) * BHS * (ld), Rb0 * (ld) + C0b, Rb1 * (ld) + C1b); } while (0)
#define GS_LDA(dst, b, h) do { _Pragma("unroll") for (int m = 0; m < 4; ++m) _Pragma("unroll") for (int k = 0; k < 2; ++k) dst[m][k] = *(const LAS bf16x8*)(lds + GS_SA(b, h) + aoff + m * 2048 + k * 1024); } while (0)
#define GS_LDB(dst, b, h) do { _Pragma("unroll") for (int n = 0; n < 2; ++n) _Pragma("unroll") for (int k = 0; k < 2; ++k) dst[n][k] = *(const LAS bf16x8*)(lds + GS_SB(b, h) + boff + n * 2048 + k * 1024); } while (0)
#define GS_MMA(ai, bj, At, Bt) do { __builtin_amdgcn_s_setprio(1); _Pragma("unroll") for (int m = 0; m < 4; ++m) _Pragma("unroll") for (int n = 0; n < 2; ++n) _Pragma("unroll") for (int k = 0; k < 2; ++k) \
        acc[ai][bj][m][n] = __builtin_amdgcn_mfma_f32_16x16x32_bf16(Bt[n][k], At[m][k], acc[ai][bj][m][n], 0, 0, 0); __builtin_amdgcn_s_setprio(0); } while (0)
#define GS_WAIT_V(n) asm volatile("s_waitcnt vmcnt(" #n ")" ::: "memory")
#define GS_WAIT_L(n) asm volatile("s_waitcnt lgkmcnt(" #n ")" ::: "memory")
#define GS_BAR __builtin_amdgcn_s_barrier()
#define GS_SCHED __builtin_amdgcn_sched_barrier(0)
#define GS_ROWS(u, ia) do { if (GATH) { if ((u).idx) { \
            ia[0] = R0 < (u).nvalid ? (unsigned)(u).idx[R0] : 0u; ia[1] = R1 < (u).nvalid ? (unsigned)(u).idx[R1] : 0u; \
            ia[2] = HALF + R0 < (u).nvalid ? (unsigned)(u).idx[HALF + R0] : 0u; ia[3] = HALF + R1 < (u).nvalid ? (unsigned)(u).idx[HALF + R1] : 0u; } \
        else { ia[0] = R0; ia[1] = R1; ia[2] = HALF + R0; ia[3] = HALF + R1; } } } while (0)
    GU cur, nxt; int ui = 0;
    if (!S.next(0, cur)) return;
    f32x4 acc[2][NBH][4][2];
#pragma unroll
    for (int a = 0; a < 2; ++a)
#pragma unroll
        for (int b = 0; b < NBH; ++b)
#pragma unroll
            for (int m = 0; m < 4; ++m)
#pragma unroll
                for (int n = 0; n < 2; ++n) acc[a][b][m][n] = (f32x4){0.f, 0.f, 0.f, 0.f};
    bf16x8 At[4][2], B0[2][2], B1[2][2];
    unsigned ia[4] = {(unsigned)R0, (unsigned)R1, (unsigned)(HALF + R0), (unsigned)(HALF + R1)}, na[4] = {(unsigned)R0, (unsigned)R1, (unsigned)(HALF + R0), (unsigned)(HALF + R1)};
    GS_ROWS(cur, ia);
    unsigned cA = cur.A, cB = cur.B;
    unsigned lda = cur.lda, ldb = cur.ldb;
    const unsigned fa0 = (unsigned)R0 * lda + C0b, fa1 = (unsigned)R1 * lda + C1b, fb0 = Rb0 * ldb + C0b, fb1 = Rb1 * ldb + C1b;
    if constexpr (NBH == 2) {
        GS_STGB(GS_SB(0, 0), cB, 0, ldb); GS_STGB(GS_SB(0, 1), cB, 1, ldb); GS_STGA(GS_SA(0, 0), cA, 0, ia[0], ia[1], lda); GS_STGA(GS_SA(0, 1), cA, 1, ia[2], ia[3], lda);
        if (wr == 1) GS_BAR;
        GS_WAIT_V(2); GS_BAR;
        GS_STGB(GS_SB(1, 0), cB + 128, 0, ldb); GS_STGA(GS_SA(1, 0), cA + 128, 0, ia[0], ia[1], lda); GS_STGB(GS_SB(1, 1), cB + 128, 1, ldb);
        GS_WAIT_V(6); GS_BAR;
    } else {
        GS_STGB(GS_SB(0, 0), cB, 0, ldb); GS_STGA(GS_SA(0, 0), cA, 0, ia[0], ia[1], lda); GS_STGA(GS_SA(0, 1), cA, 1, ia[2], ia[3], lda);
        if (wr == 1) GS_BAR;
        GS_WAIT_V(2); GS_BAR;
        GS_STGB(GS_SB(1, 0), cB + 128, 0, ldb); GS_STGA(GS_SA(1, 0), cA + 128, 0, ia[0], ia[1], lda);
        GS_WAIT_V(4); GS_BAR;
    }
    for (;;) {
        const bool has_next = S.next(ui + 1, nxt);
        unsigned nA = cA, nB = cB, nlda = lda, nldb = ldb;
        if (has_next) { GS_ROWS(nxt, na); nA = nxt.A; nB = nxt.B; nlda = nxt.lda; nldb = nxt.ldb; }
        else if (GATH) { na[0] = ia[0]; na[1] = ia[1]; na[2] = ia[2]; na[3] = ia[3]; }
        const int nt = cur.nt;
        for (int t = 0; t < nt; t += 2) {
            const bool last = (t == nt - 2);
            const unsigned a1 = cA + (unsigned)(t + 1) * 128u;
            const unsigned a2 = last ? nA : cA + (unsigned)(t + 2) * 128u, b2 = last ? nB : cB + (unsigned)(t + 2) * 128u;
            const unsigned a3 = a2 + 128u, b3 = b2 + 128u;
            const unsigned xlda = last ? nlda : lda, xldb = last ? nldb : ldb;
            unsigned x0, x1, x2, x3;
            if (GATH) { x0 = last ? na[0] : ia[0]; x1 = last ? na[1] : ia[1]; x2 = last ? na[2] : ia[2]; x3 = last ? na[3] : ia[3]; }
            else { x0 = R0; x1 = R1; x2 = HALF + R0; x3 = HALF + R1; }
            if constexpr (NBH == 2) {
                GS_LDB(B0, 0, 0); GS_LDB(B1, 0, 1); GS_SCHED; GS_LDA(At, 0, 0); GS_STGA(GS_SA(1, 1), a1, 1, ia[2], ia[3], lda);
                GS_WAIT_V(8); GS_WAIT_L(0); GS_BAR; GS_MMA(0, 0, At, B0); GS_MMA(0, 1, At, B1); GS_BAR; GS_SCHED;
                GS_LDA(At, 0, 1); GS_STGB(GS_SB(0, 0), b2, 0, xldb); GS_STGB(GS_SB(0, 1), b2, 1, xldb); GS_STGA(GS_SA(0, 0), a2, 0, x0, x1, xlda);
                GS_WAIT_V(8); GS_WAIT_L(0); GS_BAR; GS_MMA(1, 0, At, B0); GS_MMA(1, 1, At, B1); GS_BAR; GS_SCHED;
                GS_LDB(B0, 1, 0); GS_LDB(B1, 1, 1); GS_SCHED; GS_LDA(At, 1, 0); GS_STGA(GS_SA(0, 1), a2, 1, x2, x3, xlda);
                GS_WAIT_V(8); GS_WAIT_L(0); GS_BAR; GS_MMA(0, 0, At, B0); GS_MMA(0, 1, At, B1); GS_BAR; GS_SCHED;
                GS_LDA(At, 1, 1); GS_STGB(GS_SB(1, 0), b3, 0, xldb); GS_STGB(GS_SB(1, 1), b3, 1, xldb); GS_STGA(GS_SA(1, 0), a3, 0, x0, x1, xlda);
                GS_WAIT_V(8); GS_WAIT_L(0); GS_BAR; GS_MMA(1, 0, At, B0); GS_MMA(1, 1, At, B1); GS_BAR; GS_SCHED;
            } else {
                GS_LDB(B0, 0, 0); GS_SCHED; GS_LDA(At, 0, 0); GS_STGA(GS_SA(1, 1), a1, 1, ia[2], ia[3], lda);
                GS_WAIT_V(6); GS_WAIT_L(0); GS_BAR; GS_MMA(0, 0, At, B0); GS_BAR; GS_SCHED;
                GS_LDA(At, 0, 1); GS_STGB(GS_SB(0, 0), b2, 0, xldb); GS_STGA(GS_SA(0, 0), a2, 0, x0, x1, xlda);
                GS_WAIT_V(6); GS_WAIT_L(0); GS_BAR; GS_MMA(1, 0, At, B0); GS_BAR; GS_SCHED;
                GS_LDB(B0, 1, 0); GS_SCHED; GS_LDA(At, 1, 0); GS_STGA(GS_SA(0, 1), a2, 1, x2, x3, xlda);
                GS_WAIT_V(6); GS_WAIT_L(0); GS_BAR; GS_MMA(0, 0, At, B0); GS_BAR; GS_SCHED;
                GS_LDA(At, 1, 1); GS_STGB(GS_SB(1, 0), b3, 0, xldb); GS_STGA(GS_SA(1, 0), a3, 0, x0, x1, xlda);
                GS_WAIT_V(6); GS_WAIT_L(0); GS_BAR; GS_MMA(1, 0, At, B0); GS_BAR; GS_SCHED;
            }
        }
        if (cur.flags & 2) {
            if (wr == 0) GS_BAR;
            E(acc, cur, wr, wc, fr, fq);
        }
        if (!has_next) break;
        if (nxt.flags & 1) {
#pragma unroll
            for (int a = 0; a < 2; ++a)
#pragma unroll
                for (int b = 0; b < NBH; ++b)
#pragma unroll
                    for (int m = 0; m < 4; ++m)
#pragma unroll
                        for (int n = 0; n < 2; ++n) acc[a][b][m][n] = (f32x4){0.f, 0.f, 0.f, 0.f};
        }
        const bool did_epi = (cur.flags & 2) != 0;
        cur = nxt; cA = nA; cB = nB; lda = nlda; ldb = nldb; ++ui;
        if (GATH) { ia[0] = na[0]; ia[1] = na[1]; ia[2] = na[2]; ia[3] = na[3]; }
        if (did_epi) { if (wr == 1) GS_BAR; }
    }
    GS_WAIT_V(0);
    if (!(cur.flags & 2)) { if (wr == 0) GS_BAR; }
    GS_BAR;
#undef GS_SA
#undef GS_SB
#undef GS_STG_O
#undef GS_STGA
#undef GS_STGB
#undef GS_LDA
#undef GS_LDB
#undef GS_MMA
#undef GS_WAIT_V
#undef GS_WAIT_L
#undef GS_BAR
#undef GS_SCHED
#undef GS_ROWS
}
}

struct Args {
    const float* x; const int* pos; const float* w_in; const float* b_f; const float* pe_cmp; const float* w_cmp1; const float* w_cmp2;
    const float* w_gate; const float* w_br; const float* w_o; const float* ln1_g; const float* ln1_b; const float* w_router; const float* router_bias;
    const float* w_eg; const float* w_eu; const float* w_ed; const float* w_sg; const float* w_su; const float* w_sd; const float* ln2_g; const float* ln2_b;
    float* out; unsigned char* ws; int ph_lo, ph_hi;
};

DI void ph_prologue(const Args& a, int gw, int NGW, int lane) {
    bf16* xb = (bf16*)(a.ws + WS_XB);
    for (int row = gw; row < NTOK; row += NGW) {
        const f32x4* xr = (const f32x4*)(a.x + (size_t)row * DM) + lane;
        u32x2* o = (u32x2*)(xb + (size_t)row * DM) + lane;
#pragma unroll
        for (int j = 0; j < 4; ++j) { const f32x4 v = xr[64 * j]; u32x2 w; w.x = cvtpk(v.x, v.y); w.y = cvtpk(v.z, v.w); o[64 * j] = w; }
    }
    float* rope = (float*)(a.ws + WS_ROPE);
    constexpr float INVF[8] = {1.0f, 0.1939227432012558f, 0.03760603070259094f, 0.007292664609849453f, 0.0014142135623842478f, 0.00027424818836152554f, 5.318296098266728e-05f, 1.0313386155758053e-05f};
    for (int i = gw * 64 + lane; i < NTOK; i += NGW * 64) {
        const float p = (float)a.pos[i];
#pragma unroll
        for (int j = 0; j < 8; ++j) {
            const float ang = p * INVF[j];
            const double rev = (double)ang * 0.15915494309189535;
            const float fr = (float)(rev - __builtin_rint(rev));
            rope[(size_t)i * 16 + j] = __builtin_amdgcn_cosf(fr);
            rope[(size_t)i * 16 + 8 + j] = __builtin_amdgcn_sinf(fr);
        }
    }
}

constexpr float Y_SCALE = 16.f;
struct CvtItem { const float* W; bf16* WT; int N, n0, nv, k0, dK, drow0, mode; float scale; };
__device__ const int SEG_SRC[21] = {0, 652, 908, 1164, 1420, 1676, 1932, 2192, 2576, 256, 320, 384, 448, 512, 576, 2448, 2512, 2832, 640, 2188, 2896};
__device__ const int SEG_DST[21] = {C_AQ, C_BQ, C_BK, C_BV, C_CQ, C_CK, C_CV, C_DQ, C_DIQ, C_AKC, C_AVC, C_AKS, C_AVS, C_AKW, C_AVW, C_DK, C_DV, C_DIK, 2880, 2892, 2896};
constexpr int CVT_I_IN = 93 * 16, CVT_I_G = 2048, CVT_I_BR = 512, CVT_I_O = 512, CVT_I_C1 = 128, CVT_I_R = 64, CVT_I_E = 65 * 384, CVT_I_CB = 2;
constexpr int CVT_NIT = CVT_I_IN + CVT_I_G + CVT_I_BR + CVT_I_O + CVT_I_C1 + CVT_I_R + CVT_I_E + CVT_I_CB;
DI CvtItem cvt_decode(const Args& a, int l, int it) {
    unsigned char* ws = a.ws; CvtItem c; c.mode = 0; c.nv = 32; c.scale = 1.f;
    int r = it;
    if (r < CVT_I_IN) {
        const int kb = r / 93, ci = r % 93; int seg, off;
        if (ci < 72) { seg = ci >> 3; off = (ci & 7) * 32; } else if (ci < 90) { seg = 9 + ((ci - 72) >> 1); off = ((ci - 72) & 1) * 32; }
        else { seg = 18 + (ci - 90); off = 0; c.nv = (seg == 18) ? 12 : 4; }
        if (seg == 0 || seg == 1 || seg == 4 || seg == 7) c.scale = QS;
        c.W = a.w_in + (size_t)l * DM * IN_W; c.N = IN_W; c.n0 = SEG_SRC[seg] + off; c.k0 = kb * 64; c.WT = (bf16*)(ws + W_IN); c.dK = DM; c.drow0 = SEG_DST[seg] + off; return c; }
    r -= CVT_I_IN;
    if (r < CVT_I_G) { const int m = r >> 9, q = r & 511, kb = q >> 5, nb = q & 31;
        c.W = a.w_gate + (size_t)(l * 4 + m) * DM * DM; c.N = DM; c.n0 = nb * 32; c.k0 = kb * 64; c.WT = (bf16*)(ws + W_G) + (size_t)m * DM * DM; c.dK = DM; c.drow0 = nb * 32; c.scale = -LOG2E; return c; }
    r -= CVT_I_G;
    if (r < CVT_I_BR) { const int m = r >> 7, q = r & 127, kb = q >> 5, nb = q & 31;
        c.W = a.w_br + (size_t)(l * 4 + m) * 256 * DM; c.N = DM; c.n0 = nb * 32; c.k0 = kb * 64; c.WT = (bf16*)(ws + W_BR) + (size_t)m * DM * 256; c.dK = 256; c.drow0 = nb * 32; return c; }
    r -= CVT_I_BR;
    if (r < CVT_I_O) { const int kb = r >> 5, nb = r & 31;
        c.W = a.w_o + (size_t)l * DM * DM; c.N = DM; c.n0 = nb * 32; c.k0 = kb * 64; c.WT = (bf16*)(ws + W_O); c.dK = DM; c.drow0 = nb * 32; return c; }
    r -= CVT_I_O;
    if (r < CVT_I_C1) { const int j = r >> 6, q = r & 63, kb = q >> 1, nb = q & 1;
        c.W = a.w_cmp1 + (size_t)(l * 2 + j) * 2048 * 64; c.N = 64; c.n0 = nb * 32; c.k0 = kb * 64; c.WT = (bf16*)(ws + W_C1) + (size_t)j * 256 * 2048; c.dK = 2048; c.drow0 = nb * 32; return c; }
    r -= CVT_I_C1;
    if (r < CVT_I_R) { const int mode = r >> 5, q = r & 31, kb = q >> 1, nb = q & 1;
        c.W = a.w_router + (size_t)l * DM * 64; c.N = 64; c.n0 = nb * 32; c.k0 = kb * 64; c.WT = (bf16*)(ws + (mode ? W_RL : W_RH)); c.dK = DM; c.drow0 = nb * 32; c.mode = mode; return c; }
    r -= CVT_I_R;
    if (r < CVT_I_E) {
        const int e = r / 384, q = r % 384, which = q >> 7, qq = q & 127;
        if (which < 2) { const int kb = qq >> 3, nb = qq & 7, n0 = nb * 32, pn = n0 >> 7, i0 = n0 & 127;
            c.W = (which == 0) ? (e < 64 ? a.w_eg + (size_t)(l * 64 + e) * DM * 256 : a.w_sg + (size_t)l * DM * 256) : (e < 64 ? a.w_eu + (size_t)(l * 64 + e) * DM * 256 : a.w_su + (size_t)l * DM * 256);
            c.N = 256; c.n0 = n0; c.k0 = kb * 64; c.WT = (bf16*)(ws + W_1) + (size_t)e * 512 * DM; c.dK = DM; c.drow0 = pn * 256 + which * 128 + i0;
        } else { const int kb = qq >> 5, nb = qq & 31;
            c.W = e < 64 ? a.w_ed + (size_t)(l * 64 + e) * 256 * DM : a.w_sd + (size_t)l * 256 * DM; c.N = DM; c.n0 = nb * 32; c.k0 = kb * 64; c.WT = (bf16*)(ws + W_2) + (size_t)e * DM * 256; c.dK = 256; c.drow0 = nb * 32; c.scale = Y_SCALE; }
        return c; }
    r -= CVT_I_E;
    c.mode = 2; c.n0 = r; c.W = nullptr; c.WT = nullptr; c.N = 0; c.k0 = 0; c.dK = 0; c.drow0 = 0; return c;
}
DI void cvt_load(const CvtItem& c, f32x4 (&v)[8], int lane) {
    if (c.mode == 2) return;
    if (c.nv == 32 && ((c.N | c.n0) & 3) == 0) {
#pragma unroll
        for (int i = 0; i < 8; ++i) v[i] = *(const f32x4*)(c.W + (size_t)(c.k0 + 8 * i + (lane >> 3)) * c.N + c.n0 + (lane & 7) * 4);
    } else {
#pragma unroll
        for (int i = 0; i < 8; ++i) { const float* p = c.W + (size_t)(c.k0 + 8 * i + (lane >> 3)) * c.N + c.n0 + (lane & 7) * 4; const int c4 = (lane & 7) * 4;
            v[i][0] = (c4 + 0 < c.nv) ? p[0] : 0.f; v[i][1] = (c4 + 1 < c.nv) ? p[1] : 0.f; v[i][2] = (c4 + 2 < c.nv) ? p[2] : 0.f; v[i][3] = (c4 + 3 < c.nv) ? p[3] : 0.f; }
    }
}
DI void cvt_finish(const Args& a, int l, const CvtItem& c, const f32x4 (&v)[8], LAS float* scr, int lane) {
    if (c.mode == 2) {
        const int j = c.n0; const float* pe = a.pe_cmp + (size_t)(l * 2 + j) * 2048; const float* w1 = a.w_cmp1 + (size_t)(l * 2 + j) * 2048 * 64;
        float s = 0.f;
        for (int k = 0; k < 2048; ++k) s += pe[k] * w1[(size_t)k * 64 + lane];
        ((float*)(a.ws + WS_CBIAS))[j * 64 + lane] = s; return; }
#pragma unroll
    for (int i = 0; i < 8; ++i) { const int kk = 8 * i + (lane >> 3), c4 = (lane & 7) * 4; scr[kk * 33 + c4] = v[i][0]; scr[kk * 33 + c4 + 1] = v[i][1]; scr[kk * 33 + c4 + 2] = v[i][2]; scr[kk * 33 + c4 + 3] = v[i][3]; }
    LDS_WAIT(); asm volatile("" ::: "memory");
    const int cc = lane & 7;
#pragma unroll
    for (int j = 0; j < 4; ++j) {
        const int n = (lane >> 3) + 8 * j; const LAS float* s = scr + (8 * cc) * 33 + n;
        float w[8];
#pragma unroll
        for (int q = 0; q < 8; ++q) { w[q] = s[q * 33] * c.scale; if (c.mode == 1) { const float h = __uint_as_float(cvtpk(w[q], 0.f) << 16); w[q] = w[q] - h; } }
        u32x4 o; o.x = cvtpk(w[0], w[1]); o.y = cvtpk(w[2], w[3]); o.z = cvtpk(w[4], w[5]); o.w = cvtpk(w[6], w[7]);
        if (n < c.nv) *(u32x4*)(c.WT + (size_t)(c.drow0 + n) * c.dK + c.k0 + 8 * cc) = o;
    }
    LDS_WAIT(); asm volatile("" ::: "memory");
}
DI void ph_cvt(const Args& a, int l, LAS unsigned char* lds, int gw, int NGW, int wave, int lane) {
    LAS float* scr = (LAS float*)(lds + wave * 8704);
    f32x4 va[8], vb[8];
    CvtItem ca, cb; ca.mode = 2; ca.n0 = 0;
    int it = gw;
    if (it < CVT_NIT) { ca = cvt_decode(a, l, it); cvt_load(ca, va, lane); }
    for (; it < CVT_NIT; it += 2 * NGW) {
        const bool hasb = it + NGW < CVT_NIT;
        if (hasb) { cb = cvt_decode(a, l, it + NGW); cvt_load(cb, vb, lane); }
        cvt_finish(a, l, ca, va, scr, lane);
        const bool hasa = it + 2 * NGW < CVT_NIT;
        if (hasa) { ca = cvt_decode(a, l, it + 2 * NGW); cvt_load(ca, va, lane); }
        if (hasb) cvt_finish(a, l, cb, vb, scr, lane);
    }
}

DI void rope4(float (&v)[4], int a, const float* rp, float scale) {
    float pv[4];
#pragma unroll
    for (int i = 0; i < 4; ++i) pv[i] = dpp_xor2(v[i]);
    const f32x4 c4 = *(const f32x4*)(rp + 4 * (a & 1)), s4 = *(const f32x4*)(rp + 8 + 4 * (a & 1));
    if (a < 4) {
#pragma unroll
        for (int i = 0; i < 4; ++i) v[i] = (a < 2) ? (v[i] * c4[i] - pv[i] * s4[i]) : (pv[i] * s4[i] + v[i] * c4[i]);
    }
#pragma unroll
    for (int i = 0; i < 4; ++i) v[i] *= scale;
}
DI void ld4bf(const bf16* p, float (&v)[4]) { const u32x2 w = *(const u32x2*)p; v[0] = bflo(w.x); v[1] = bfhi(w.x); v[2] = bflo(w.y); v[3] = bfhi(w.y); }
DI void st4bf(bf16* p, const float (&v)[4]) { u32x2 w; w.x = cvtpk(v[0], v[1]); w.y = cvtpk(v[2], v[3]); *(u32x2*)p = w; }

DI void ph_post(const Args& a, int l, LAS unsigned char* lds, int wave, int lane) {
    unsigned char* ws = a.ws;
    bf16* proj = (bf16*)(ws + WS_A);
    const float* rope = (const float*)(ws + WS_ROPE);
    const float* sm32 = (const float*)(ws + WS_SM32);
    LAS bf16* T = (LAS bf16*)(lds + wave * 9216);
    for (int tile = lbid(); tile < NTOK / 64; tile += lgrid()) {
        const int tok0 = tile * 64;
        float kmx = 0.f;
        for (int tt = wave; tt < 64; tt += NWAVES) {
            const int tok = tok0 + tt; bf16* row = proj + (size_t)tok * PW;
            const float* cs = rope + (size_t)tok * 16;
            const int ah = lane & 15;
            float v[4];
            ld4bf(row + C_AQ + 4 * lane, v); rope4(v, ah, cs, 1.0f); st4bf(row + C_AQ + 4 * lane, v);
            ld4bf(row + C_DQ + 4 * lane, v); rope4(v, ah, cs, 1.0f); st4bf(row + C_DQ + 4 * lane, v);
            ld4bf(row + C_DIQ + 4 * lane, v); rope4(v, ah, cs, 1.0f); st4bf(row + C_DIQ + 4 * lane, v);
            {
                const int tl = tok % SEQ, kin = tl & 31, slot = (kin & ~12) | ((kin & 4) << 1) | ((kin & 8) >> 1), hq = lane >> 4;
                const size_t toff = (((size_t)(tok / SEQ) * 4 + hq) * (SEQ / 32) + (tl >> 5)) * 2048 + ((ah >> 1) * 32 + slot) * 8 + (ah & 1) * 4;
                *(u32x2*)((bf16*)(ws + WS_KTB) + toff) = *(const u32x2*)(row + C_BK + 4 * lane);
                const u32x2 ckw = *(const u32x2*)(row + C_CK + 4 * lane);
                *(u32x2*)((bf16*)(ws + WS_KTC) + toff) = ckw;
                float sq = bflo(ckw.x) * bflo(ckw.x) + bfhi(ckw.x) * bfhi(ckw.x) + bflo(ckw.y) * bflo(ckw.y) + bfhi(ckw.y) * bfhi(ckw.y);
                sq += dpp_xor1(sq); sq += dpp_xor2(sq); sq += DPPF(sq, 0x124, 0xF, true); sq += DPPF(sq, 0x128, 0xF, true);
                kmx = fmaxf(kmx, sq);
            }
            { const int hk = lane >> 4; const int cb = (hk == 0) ? C_AKS : (hk == 1) ? C_AKW : (hk == 2) ? C_DK : C_DIK;
              ld4bf(row + cb + 4 * ah, v); rope4(v, ah, cs, 1.0f); st4bf(row + cb + 4 * ah, v);
              if (hk < 2) {
                  const int tl = tok % SEQ, kin = tl & 31, slot = (kin & ~12) | ((kin & 4) << 1) | ((kin & 8) >> 1);
                  bf16* kt = (bf16*)(ws + (hk == 0 ? WS_KTS : WS_KTW)) + ((size_t)(tok / SEQ) * (SEQ / 32) + (tl >> 5)) * 2048 + ((ah >> 1) * 32 + slot) * 8 + (ah & 1) * 4;
                  st4bf(kt, v); }
              if (hk == 3) {
                  const int tl = tok % SEQ;
                  bf16* it = (bf16*)(ws + WS_IKT) + ((size_t)(tok / SEQ) * (SEQ / 32) + (tl >> 5)) * 2048 + ((ah >> 1) * 32 + (tl & 31)) * 8 + (ah & 1) * 4;
                  st4bf(it, v); } }
            if (lane < 32) { const int j = lane >> 4; const u32x2 w = *(const u32x2*)(row + (j ? C_AVC : C_AKC) + 4 * ah);
                *(u32x2*)((bf16*)(ws + (j ? WS_VCR : WS_KCR)) + (size_t)tok * 64 + 4 * ah) = w; }
            if (lane < 20) {
                const float s = sm32[(size_t)tok * 32 + lane];
                if (lane < 12) ((float*)(ws + WS_GATE))[(size_t)tok * 12 + lane] = sigmoidf_(s);
                else if (lane < 16) { const float z = s + a.b_f[l * 4 + (lane - 12)];
                    ((float*)(ws + WS_LOGF))[(size_t)tok * 4 + (lane - 12)] = fminf(z, 0.f) * LOG2E - flog2(1.f + fexp2(-fabsf(z) * LOG2E)); }
                else ((float*)(ws + WS_IW))[(size_t)tok * 4 + (lane - 16)] = s;
            }
        }
        if ((lane & 15) == 0) atomicMax((unsigned*)(ws + WS_CTL) + CW_KMAX + l * 32 + (tok0 / SEQ) * 4 + (lane >> 4), __float_as_uint(kmx * 1.02f));
        const int bidx = tok0 / SEQ, tl0 = tok0 % SEQ;
        for (int hv = wave; hv < 10; hv += NWAVES) {
            int cb; bf16* dst;
            if (hv < 4) { cb = C_BV + 64 * hv; dst = (bf16*)(ws + WS_VTB) + (size_t)(bidx * 4 + hv) * 64 * SEQ; }
            else if (hv < 8) { cb = C_CV + 64 * (hv - 4); dst = (bf16*)(ws + WS_VTC) + (size_t)(bidx * 4 + hv - 4) * 64 * SEQ; }
            else if (hv == 8) { cb = C_AVS; dst = (bf16*)(ws + WS_VTAS) + (size_t)bidx * 64 * SEQ; }
            else { cb = C_AVW; dst = (bf16*)(ws + WS_VTAW) + (size_t)bidx * 64 * SEQ; }
            const bf16* src = proj + (size_t)(tok0 + lane) * PW + cb;
#pragma unroll
            for (int i = 0; i < 8; ++i) { const u32x4 w = *(const u32x4*)(src + 8 * i);
                T[(8 * i + 0) * 72 + lane] = (bf16)(w.x & 0xffff); T[(8 * i + 1) * 72 + lane] = (bf16)(w.x >> 16);
                T[(8 * i + 2) * 72 + lane] = (bf16)(w.y & 0xffff); T[(8 * i + 3) * 72 + lane] = (bf16)(w.y >> 16);
                T[(8 * i + 4) * 72 + lane] = (bf16)(w.z & 0xffff); T[(8 * i + 5) * 72 + lane] = (bf16)(w.z >> 16);
                T[(8 * i + 6) * 72 + lane] = (bf16)(w.w & 0xffff); T[(8 * i + 7) * 72 + lane] = (bf16)(w.w >> 16); }
            LDS_WAIT(); asm volatile("" ::: "memory");
            {
                const int dt = lane >> 5, cc = lane & 31;
#pragma unroll
                for (int i = 0; i < 8; ++i) { const int tile = i >> 2, sh = i & 3;
                    bf16* d = dst + ((size_t)(tl0 >> 5) + tile) * 2048 + ((dt * 2 + (sh >> 1)) * 64 + (sh & 1) * 32 + cc) * 8;
                    *(u32x4*)d = *(const LAS u32x4*)(T + lane * 72 + 8 * i); }
            }
            LDS_WAIT(); asm volatile("" ::: "memory");
        }
    }
}

DI void cumsum_seq(const Args& a, int bh, int lane) {
    const float* lf = (const float*)(a.ws + WS_LOGF); float* cum = (float*)(a.ws + WS_CUM);
    const int b = bh >> 2, h = bh & 3;
    const float* src = lf + ((size_t)b * SEQ + lane * 128) * 4 + h;
    float s = 0.f;
    for (int i = 0; i < 128; ++i) s += src[(size_t)i * 4];
    const float incl = wave_incl_scan_f(s);
    float run = incl - s;
    float* dst = cum + (size_t)bh * SEQ + lane * 128;
    for (int i = 0; i < 128; ++i) { run += src[(size_t)i * 4]; dst[i] = run; }
}

DI void ph_cmp2(const Args& a, int l, int gw, int NGW, int lane) {
    const float* hid = (const float*)(a.ws + WS_HID);
    bf16* kc = (bf16*)(a.ws + WS_KCMP); bf16* vtc = (bf16*)(a.ws + WS_VTCMP);
    for (int it = gw; it < 2 * 4096; it += NGW) {
        const int j = it >> 12, row = it & 4095, b = row >> 9, n = row & 511;
        const float* h = hid + ((size_t)j * 4096 + row) * 64; const float* w2 = a.w_cmp2 + (size_t)(l * 2 + j) * 64 * 64;
        float s = 0.f;
#pragma unroll 8
        for (int k = 0; k < 64; ++k) s += h[k] * w2[k * 64 + lane];
        if (n == 511) s = 0.f;
        const bf16 o = (bf16)(cvtpk(s, 0.f) & 0xffff);
        const int tile = n >> 5, kin = n & 31;
        if (j == 0) { const int slot = (kin & ~12) | ((kin & 4) << 1) | ((kin & 8) >> 1); kc[((size_t)b * 16 + tile) * 2048 + ((lane >> 3) * 32 + slot) * 8 + (lane & 7)] = o; }
        else { const int sI = kin >> 4, hI = (kin >> 3) & 1, e = kin & 7; vtc[((size_t)b * 16 + tile) * 2048 + (((lane >> 5) * 2 + sI) * 64 + hI * 32 + (lane & 31)) * 8 + e] = o; }
    }
}

DI void ph_ln1(const Args& a, int l, int gw, int NGW, int lane) {
    bf16* xb = (bf16*)(a.ws + WS_XB); bf16* xl = (bf16*)(a.ws + WS_XL);
    const float* g = a.ln1_g + l * DM; const float* be = a.ln1_b + l * DM;
    u32x4 nq0 = {0u,0u,0u,0u}, nq1 = {0u,0u,0u,0u};
    if (gw < NTOK) { const u32x4* x0 = (const u32x4*)(xb + (size_t)gw * DM) + lane; nq0 = x0[0]; nq1 = x0[64]; }
    for (int row = gw; row < NTOK; row += NGW) {
        u32x4* xr = (u32x4*)(xb + (size_t)row * DM) + lane; u32x4* lr = (u32x4*)(xl + (size_t)row * DM) + lane;
        const u32x4 qq[2] = {nq0, nq1};
        if (row + NGW < NTOK) { const u32x4* xn = (const u32x4*)(xb + (size_t)(row + NGW) * DM) + lane; nq0 = xn[0]; nq1 = xn[64]; }
        f32x4 v[4]; float s = 0.f;
#pragma unroll
        for (int j = 0; j < 2; ++j) { const u32x4 q = qq[j];
            v[2 * j] = (f32x4){bflo(q.x), bfhi(q.x), bflo(q.y), bfhi(q.y)}; v[2 * j + 1] = (f32x4){bflo(q.z), bfhi(q.z), bflo(q.w), bfhi(q.w)}; }
#pragma unroll
        for (int j = 0; j < 4; ++j) s += (v[j].x + v[j].y) + (v[j].z + v[j].w);
        const float mean = wave_sum(s) * (1.f / DM); float s2 = 0.f;
#pragma unroll
        for (int j = 0; j < 4; ++j) { v[j] = v[j] - mean; s2 += (v[j].x * v[j].x + v[j].y * v[j].y) + (v[j].z * v[j].z + v[j].w * v[j].w); }
        const float rstd = 1.f / sqrtf(wave_sum(s2) * (1.f / DM) + LN_EPS);
#pragma unroll
        for (int j = 0; j < 2; ++j) {
            const int cb = 8 * lane + 512 * j;
            const f32x4 g0 = *(const f32x4*)(g + cb), g1 = *(const f32x4*)(g + cb + 4), b0 = *(const f32x4*)(be + cb), b1 = *(const f32x4*)(be + cb + 4);
            const f32x4 y0 = v[2 * j] * rstd * g0 + b0, y1 = v[2 * j + 1] * rstd * g1 + b1;
            const u32x4 hi = pack8(y0, y1);
            const f32x4 r0 = {y0[0] - bflo(hi.x), y0[1] - bfhi(hi.x), y0[2] - bflo(hi.y), y0[3] - bfhi(hi.y)}, r1 = {y1[0] - bflo(hi.z), y1[1] - bfhi(hi.z), y1[2] - bflo(hi.w), y1[3] - bfhi(hi.w)};
            xr[64 * j] = hi; lr[64 * j] = pack8(r0, r1);
        }
    }
}

DI void ph_route(const Args& a, int l, LAS unsigned char* lds, int wave, int lane) {
    const float* logit = (const float*)(a.ws + WS_LOGIT);
    u32x2* tokinfo = (u32x2*)(a.ws + WS_TOKINFO);
    unsigned* lists = (unsigned*)(a.ws + WS_LIST);
    unsigned* gcnt = (unsigned*)(a.ws + WS_CTL) + CW_CNT + l * NCH * 64;
    LAS unsigned* lcnt = (LAS unsigned*)lds;
    LAS unsigned* lbase = lcnt + 64;
    LAS unsigned* stash = lbase + 64;
    const float rb = a.router_bias[l * 64 + lane];
    for (int blk = lbid(); blk < NTOK / 256; blk += lgrid()) {
        const int tok0 = blk * 256, c = tok0 / CHTOK;
        if (ltid() < 64) lcnt[ltid()] = 0u;
        __syncthreads();
        for (int tt = wave; tt < 256; tt += NWAVES) {
            const int tok = tok0 + tt;
            const float sc = sigmoidf_(logit[(size_t)tok * 64 + lane]);
            const float bi = sc + rb;
            float m1 = bi;
            m1 = fmaxf(m1, __shfl_xor(m1, 1)); m1 = fmaxf(m1, __shfl_xor(m1, 2)); m1 = fmaxf(m1, __shfl_xor(m1, 4));
            const unsigned long long eqm = __ballot(bi == m1);
            const int gsh = lane & ~7; const unsigned gm = (unsigned)((eqm >> gsh) & 0xffu);
            const int first = __builtin_ctz(gm);
            float v2 = ((lane & 7) == first) ? -3.0e38f : bi;
            v2 = fmaxf(v2, __shfl_xor(v2, 1)); v2 = fmaxf(v2, __shfl_xor(v2, 2)); v2 = fmaxf(v2, __shfl_xor(v2, 4));
            const float gs = m1 + v2;
            const int g = lane >> 3; int grank = 0;
#pragma unroll
            for (int gg = 0; gg < 8; ++gg) { const float o = __int_as_float(__builtin_amdgcn_readlane(__float_as_int(gs), gg * 8)); grank += (o > gs || (o == gs && gg < g)) ? 1 : 0; }
            const float mb = (grank < 4) ? bi : -1.0e30f;
            int rank = 0;
#pragma unroll 4
            for (int e = 0; e < 64; ++e) { const float o = __int_as_float(__builtin_amdgcn_readlane(__float_as_int(mb), e)); rank += (o > mb || (o == mb && e < lane)) ? 1 : 0; }
            const bool sel = rank < 8;
            const float wsum = wave_sum(sel ? sc : 0.f);
            const float w = sc / wsum * 2.5f;
            const unsigned long long sm = __ballot(sel);
            const int k = __popcll(sm & ((1ull << lane) - 1ull));
            if (sel) {
                const unsigned lp = atomicAdd((unsigned*)&lcnt[lane], 1u);
                stash[tt * 8 + k] = ((unsigned)lane << 16) | lp;
                ((float*)tokinfo)[((size_t)tok * 8 + k) * 2 + 1] = w;
            }
        }
        __syncthreads();
        if (ltid() < 64) lbase[ltid()] = atomicAdd(&gcnt[c * 64 + ltid()], lcnt[ltid()]);
        __syncthreads();
        for (int i = ltid(); i < 256 * 8; i += NWAVES * 64) {
            const unsigned s = stash[i]; const unsigned e = s >> 16, lp = s & 0xffffu; const int tok = tok0 + (i >> 3);
            const unsigned pos = lbase[e] + lp;
            lists[((size_t)c * 64 + e) * CHTOK + pos] = (unsigned)tok;
            ((unsigned*)tokinfo)[((size_t)tok * 8 + (i & 7)) * 2] = (e << 16) | pos;
        }
        __syncthreads();
    }
}

typedef f32x4 Acc2[2][2][4][2];
typedef f32x4 Acc1[2][1][4][2];

struct SchedProj {
    static constexpr bool GATHER = false, FIXED = true;
    gs::StaticOrder so; unsigned A, B;
    DI bool next(int i, gs::GU& u) const { gs::Unit t; if (!so.next(i, t)) return false;
        u.A = A + (unsigned)t.pm * 256u * 2048u; u.B = B + (unsigned)t.pn * 256u * 2048u; u.idx = nullptr; u.lda = 2048; u.ldb = 2048; u.nt = 16; u.flags = 3; u.nvalid = 256;
        u.a0 = t.pm; u.a1 = t.pn; u.a2 = 0; u.a3 = 0; return true; }
};
struct EpiProj {
    static constexpr bool PERM = true; static constexpr bool BH8 = false; bf16* proj; float* sm32;
    DI void operator()(const Acc2& acc, const gs::GU& u, int wr, int wc, int fr, int fq) const {
        const int row0 = u.a0 * 256 + wr * 64 + fr, col0 = u.a1 * 256 + wc * 32 + 8 * fq;
#pragma unroll
        for (int ai = 0; ai < 2; ++ai)
#pragma unroll
            for (int m = 0; m < 4; ++m) { const int row = row0 + ai * 128 + m * 16;
#pragma unroll
                for (int bj = 0; bj < 2; ++bj) *(u32x4*)(proj + (size_t)row * PW + col0 + bj * 128) = pack8(acc[ai][bj][m][0], acc[ai][bj][m][1]);
                if (u.a1 == 11 && wc == 2) { *(f32x4*)(sm32 + (size_t)row * 32 + 8 * fq) = acc[ai][0][m][0]; *(f32x4*)(sm32 + (size_t)row * 32 + 8 * fq + 4) = acc[ai][0][m][1]; } }
    }
};

struct SchedCmp {
    static constexpr bool GATHER = false, FIXED = true;
    unsigned kcr, vcr, w;
    DI bool next(int i, gs::GU& u) const { if (i > 0 || lbid() >= 32) return false; const int j = lbid() >> 4, pm = lbid() & 15;
        u.A = (j ? vcr : kcr) + (unsigned)pm * 256u * 2048u; u.B = w + (unsigned)j * 256u * 4096u; u.idx = nullptr; u.lda = 2048; u.ldb = 4096; u.nt = 32; u.flags = 3; u.nvalid = 256;
        u.a0 = pm; u.a1 = j; u.a2 = 0; u.a3 = 0; return true; }
};
struct EpiCmp {
    static constexpr bool PERM = true; static constexpr bool BH8 = false; float* hid; const float* cbias;
    DI void operator()(const Acc2& acc, const gs::GU& u, int wr, int wc, int fr, int fq) const {
        if (wc >= 2) return;
        const int row0 = u.a0 * 256 + wr * 64 + fr, col0 = wc * 32 + 8 * fq, j = u.a1;
        float cb[8];
#pragma unroll
        for (int q = 0; q < 8; ++q) cb[q] = cbias[j * 64 + col0 + q];
#pragma unroll
        for (int ai = 0; ai < 2; ++ai)
#pragma unroll
            for (int m = 0; m < 4; ++m) { const int row = row0 + ai * 128 + m * 16; float o[8];
#pragma unroll
                for (int q = 0; q < 8; ++q) { const float x = acc[ai][0][m][q >> 2][q & 3] + cb[q];
                    const float y2 = 1.5957691216f * (x + 0.044715f * x * x * x);
                    o[q] = x * frcp(1.f + fexp2(-y2 * LOG2E)); }
                float* d = hid + ((size_t)j * 4096 + row) * 64 + col0;
                *(f32x4*)d = (f32x4){o[0], o[1], o[2], o[3]}; *(f32x4*)(d + 4) = (f32x4){o[4], o[5], o[6], o[7]}; }
    }
};

struct SchedMerge {
    static constexpr bool GATHER = false, FIXED = false;
    unsigned xb, om, wg, wbr; int G;
    DI bool next(int i, gs::GU& u) const { const int ti = i >> 3, k = i & 7; const int bid_ = lbid(); const long L = (long)ti * G + bid_; if (L >= 2048) return false;
        int pm = (int)(L >> 3), pc = (int)(L & 7); const int m = k >> 1, kind = k & 1;
        if (G == 256) { const int x = bid_ & 7, idx = bid_ >> 3; pm = ti * 32 + x * 4 + (idx >> 3); pc = idx & 7; }
        if (kind == 0) { u.A = om + (unsigned)pm * 256u * 2048u + (unsigned)m * 512u; u.B = wbr + (unsigned)m * 1024u * 512u + (unsigned)pc * 128u * 512u; u.lda = 2048; u.ldb = 512; u.nt = 4; }
        else           { u.A = xb + (unsigned)pm * 256u * 2048u;           u.B = wg + (unsigned)m * 1024u * 2048u + (unsigned)pc * 128u * 2048u; u.lda = 2048; u.ldb = 2048; u.nt = 16; }
        u.idx = nullptr; u.flags = 3; u.nvalid = 256; u.a0 = pm; u.a1 = pc; u.a2 = kind; u.a3 = m; return true; }
};
struct EpiMerge {
    static constexpr bool PERM = true; static constexpr bool BH8 = false; bf16* merged; u32x4* stash;
    f32x4 M[2][4][2];
    DI void operator()(const Acc1& acc, const gs::GU& u, int wr, int wc, int fr, int fq) {
        const int tid = ltid();
        if (u.a2 == 0) {
#pragma unroll
            for (int ai = 0; ai < 2; ++ai)
#pragma unroll
                for (int m = 0; m < 4; ++m) stash[(ai * 4 + m) * 512 + tid] = pack8(acc[ai][0][m][0], acc[ai][0][m][1]);
        } else {
            const bool first = (u.a3 == 0), lastm = (u.a3 == 3);
            const int row0 = u.a0 * 256 + wr * 64 + fr, col0 = u.a1 * 128 + wc * 32 + 8 * fq;
            if (first) {
#pragma unroll
                for (int ai = 0; ai < 2; ++ai)
#pragma unroll
                    for (int m = 0; m < 4; ++m) { M[ai][m][0] = (f32x4){0.f, 0.f, 0.f, 0.f}; M[ai][m][1] = (f32x4){0.f, 0.f, 0.f, 0.f}; }
            }
#pragma unroll
            for (int ai = 0; ai < 2; ++ai)
#pragma unroll
                for (int m = 0; m < 4; ++m) {
                    const u32x4 p = stash[(ai * 4 + m) * 512 + tid];
                    const f32x4 g0 = acc[ai][0][m][0], g1 = acc[ai][0][m][1];
                    f32x4 m0 = M[ai][m][0], m1 = M[ai][m][1];
                    m0[0] = __builtin_fmaf(frcp(1.f + fexp2(g0[0])), bflo(p.x), m0[0]); m0[1] = __builtin_fmaf(frcp(1.f + fexp2(g0[1])), bfhi(p.x), m0[1]);
                    m0[2] = __builtin_fmaf(frcp(1.f + fexp2(g0[2])), bflo(p.y), m0[2]); m0[3] = __builtin_fmaf(frcp(1.f + fexp2(g0[3])), bfhi(p.y), m0[3]);
                    m1[0] = __builtin_fmaf(frcp(1.f + fexp2(g1[0])), bflo(p.z), m1[0]); m1[1] = __builtin_fmaf(frcp(1.f + fexp2(g1[1])), bfhi(p.z), m1[1]);
                    m1[2] = __builtin_fmaf(frcp(1.f + fexp2(g1[2])), bflo(p.w), m1[2]); m1[3] = __builtin_fmaf(frcp(1.f + fexp2(g1[3])), bfhi(p.w), m1[3]);
                    M[ai][m][0] = m0; M[ai][m][1] = m1;
                    asm volatile("" : "+v"(M[ai][m][0]), "+v"(M[ai][m][1]));
                    if (lastm) *(u32x4*)(merged + (size_t)(row0 + ai * 128 + m * 16) * DM + col0) = pack8(M[ai][m][0], M[ai][m][1]);
                    asm volatile("" ::: "memory");
                }
        }
    }
};

struct SchedWo {
    static constexpr bool GATHER = false, FIXED = true;
    gs::StaticOrder so; unsigned A, B;
    DI bool next(int i, gs::GU& u) const { gs::Unit t; if (!so.next(i, t)) return false;
        u.A = A + (unsigned)t.pm * 256u * 2048u; u.B = B + (unsigned)t.pn * 256u * 2048u; u.idx = nullptr; u.lda = 2048; u.ldb = 2048; u.nt = 16; u.flags = 3; u.nvalid = 256;
        u.a0 = t.pm; u.a1 = t.pn; u.a2 = 0; u.a3 = 0; return true; }
};
struct EpiWo {
    static constexpr bool PERM = true; static constexpr bool BH8 = false; bf16* xb;
    DI void operator()(const Acc2& acc, const gs::GU& u, int wr, int wc, int fr, int fq) const {
        const int row0 = u.a0 * 256 + wr * 64 + fr, col0 = u.a1 * 256 + wc * 32 + 8 * fq;
#pragma unroll
        for (int ai = 0; ai < 2; ++ai)
#pragma unroll
            for (int m = 0; m < 4; ++m) {
#pragma unroll
                for (int bj = 0; bj < 2; ++bj) { bf16* p = xb + (size_t)(row0 + ai * 128 + m * 16) * DM + col0 + bj * 128; const u32x4 xv = *(const u32x4*)p;
                    f32x4 v0 = acc[ai][bj][m][0], v1 = acc[ai][bj][m][1];
                    v0[0] += ALPHA * bflo(xv.x); v0[1] += ALPHA * bfhi(xv.x); v0[2] += ALPHA * bflo(xv.y); v0[3] += ALPHA * bfhi(xv.y);
                    v1[0] += ALPHA * bflo(xv.z); v1[1] += ALPHA * bfhi(xv.z); v1[2] += ALPHA * bflo(xv.w); v1[3] += ALPHA * bfhi(xv.w);
                    *(u32x4*)p = pack8(v0, v1); } }
    }
};

struct SchedRouter {
    static constexpr bool GATHER = false, FIXED = true;
    unsigned xh, xl, wh, wl; int G;
    DI bool next(int i, gs::GU& u) const { const int ti = i / 3, k = i % 3; const int pm = ti * G + lbid(); if (pm >= 256) return false;
        u.A = ((k == 1) ? xl : xh) + (unsigned)pm * 256u * 2048u; u.B = (k == 2) ? wl : wh; u.idx = nullptr; u.lda = 2048; u.ldb = 2048; u.nt = 16;
        u.flags = (k == 0 ? 1 : 0) | (k == 2 ? 2 : 0); u.nvalid = 256; u.a0 = pm; u.a1 = 0; u.a2 = 0; u.a3 = 0; return true; }
};
struct EpiRouter {
    static constexpr bool PERM = false; static constexpr bool BH8 = false; float* logit;
    DI void operator()(const Acc1& acc, const gs::GU& u, int wr, int wc, int fr, int fq) const {
        if (wc >= 2) return;
        const int row0 = u.a0 * 256 + wr * 64 + fr, col0 = wc * 32 + 4 * fq;
#pragma unroll
        for (int ai = 0; ai < 2; ++ai)
#pragma unroll
            for (int m = 0; m < 4; ++m)
#pragma unroll
                for (int n = 0; n < 2; ++n) *(f32x4*)(logit + (size_t)(row0 + ai * 128 + m * 16) * 64 + col0 + n * 16) = acc[ai][0][m][n];
    }
};

constexpr int TBL_OFF = 131072, NPAIR = NCH * 65, TBLN = 528;
static_assert(NPAIR + 1 <= TBLN && TBL_OFF + 3 * TBLN * 4 <= MISC_OFF, "MoE tables");
DI void moe_tables(const Args& a, int l, LAS unsigned char* lds) {
    LAS int* ptile = (LAS int*)(lds + TBL_OFF); LAS int* ypre = ptile + TBLN; LAS int* cntv = ypre + TBLN;
    __syncthreads();
    const int tid_ = ltid();
    if (tid_ < 64) {
        const unsigned* gcnt = (const unsigned*)(a.ws + WS_CTL) + CW_CNT + l * NCH * 64;
        int pt = 0;
        for (int c = 0; c < NCH; ++c) {
            const int n = (int)__hip_atomic_load(gcnt + c * 64 + tid_, __ATOMIC_RELAXED, __HIP_MEMORY_SCOPE_AGENT);
            const int tl = (n + 255) >> 8;
            const int tinc = wave_incl_scan(tl), yinc = wave_incl_scan(n);
            const int p = c * 65 + tid_;
            cntv[p] = n; ptile[p] = pt + tinc - tl; ypre[p] = yinc - n;
            const int ttot = __builtin_amdgcn_readlane(tinc, 63), ytot = __builtin_amdgcn_readlane(yinc, 63);
            if (tid_ == 0) { cntv[c * 65 + 64] = CHTOK; ptile[c * 65 + 64] = pt + ttot; ypre[c * 65 + 64] = ytot; }
            pt += ttot + CHTOK / 256;
        }
        if (tid_ == 0) ptile[NPAIR] = pt;
    }
    __syncthreads();
}
DI int find_pair(const LAS int* ptile, int tile) {
    int lo = 0, hi = NPAIR;
    while (hi - lo > 1) { const int mid = (lo + hi) >> 1; if (ptile[mid] <= tile) lo = mid; else hi = mid; }
    return lo;
}
struct SchedE1 {
    static constexpr bool GATHER = true, FIXED = false;
    const LAS int* ptile; const LAS int* cntv; unsigned xb; const unsigned* lists; unsigned w1; int G;
    DI bool next(int i, gs::GU& u) const { const int bid_ = lbid(); int un = i * G + bid_;
        if (G == 256) { const int x = bid_ & 7, idx = bid_ >> 3; un = (i * 128 + x * 16 + (idx >> 1)) * 2 + (idx & 1); }
        const int tile = un >> 1, pn = un & 1; if (tile >= ptile[NPAIR]) return false;
        const int p = find_pair(ptile, tile), c = p / 65, e = p % 65, t = tile - ptile[p];
        if (e < 64) { u.A = xb; u.idx = (const int*)(lists + ((size_t)c * 64 + e) * CHTOK + (size_t)t * 256); u.nvalid = cntv[p] - t * 256; }
        else { u.A = xb + ((unsigned)c * CHTOK + (unsigned)t * 256u) * 2048u; u.idx = nullptr; u.nvalid = 256; }
        u.B = w1 + (unsigned)e * 512u * 2048u + (unsigned)pn * 256u * 2048u; u.lda = 2048; u.ldb = 2048; u.nt = 16; u.flags = 3; u.a0 = tile; u.a1 = pn; u.a2 = 0; u.a3 = 0; return true; }
};
struct EpiE1 {
    static constexpr bool PERM = true; static constexpr bool BH8 = false; bf16* hb;
    DI void operator()(const Acc2& acc, const gs::GU& u, int wr, int wc, int fr, int fq) const {
        const int row0 = u.a0 * 256 + wr * 64 + fr, col0 = u.a1 * 128 + wc * 32 + 8 * fq;
#pragma unroll
        for (int ai = 0; ai < 2; ++ai)
#pragma unroll
            for (int m = 0; m < 4; ++m) { f32x4 h[2];
#pragma unroll
                for (int n = 0; n < 2; ++n)
#pragma unroll
                    for (int q = 0; q < 4; ++q) { const float g = acc[ai][0][m][n][q], up = acc[ai][1][m][n][q]; h[n][q] = g * sigmoidf_(g) * up; }
                *(u32x4*)(hb + (size_t)(row0 + ai * 128 + m * 16) * 256 + col0) = pack8(h[0], h[1]); }
    }
};
struct SchedE2 {
    static constexpr bool GATHER = false, FIXED = true;
    const LAS int* ptile; const LAS int* cntv; const LAS int* ypre; unsigned hb, w2; int c; int G;
    DI bool next(int i, gs::GU& u) const { const int bid_ = lbid(); int un = i * G + bid_;
        if (G == 256) { const int x = bid_ & 7, idx = bid_ >> 3; un = (i * 64 + x * 8 + (idx >> 2)) * 4 + (idx & 3); }
        const int tile = ptile[c * 65] + (un >> 2), pn = un & 3; if (tile >= ptile[(c + 1) * 65]) return false;
        const int p = find_pair(ptile, tile), e = p % 65, t = tile - ptile[p];
        u.A = hb + (unsigned)tile * 256u * 512u; u.B = w2 + (unsigned)e * 1024u * 512u + (unsigned)pn * 256u * 512u; u.idx = nullptr; u.lda = 512; u.ldb = 512; u.nt = 4; u.flags = 3;
        u.nvalid = 256; u.a0 = (tile - ptile[c * 65]) * 256; u.a1 = pn; u.a2 = 0; u.a3 = 0; return true; }
};
DI unsigned pk4_fp8(float a, float b, float c, float d) { int w = __builtin_amdgcn_cvt_pk_fp8_f32(a, b, 0, false); w = __builtin_amdgcn_cvt_pk_fp8_f32(c, d, w, true); return (unsigned)w; }
struct EpiE2 {
    static constexpr bool PERM = true; static constexpr bool BH8 = true; unsigned char* y;
    DI void operator()(const Acc2& acc, const gs::GU& u, int wr, int wc, int fr, int fq) const {
        const int row0 = u.a0 + wr * 64 + fr, col0 = u.a1 * 256 + wc * 64 + 16 * fq;
#pragma unroll
        for (int ai = 0; ai < 2; ++ai)
#pragma unroll
            for (int m = 0; m < 4; ++m) {
                u32x4 w;
                { const f32x4 v0 = acc[ai][0][m][0], v1 = acc[ai][0][m][1]; w.x = pk4_fp8(v0[0], v0[1], v0[2], v0[3]); w.y = pk4_fp8(v1[0], v1[1], v1[2], v1[3]); }
                { const f32x4 v0 = acc[ai][1][m][0], v1 = acc[ai][1][m][1]; w.z = pk4_fp8(v0[0], v0[1], v0[2], v0[3]); w.w = pk4_fp8(v1[0], v1[1], v1[2], v1[3]); }
                *(u32x4*)(y + (size_t)(row0 + ai * 128 + m * 16) * DM + col0) = w; }
    }
};

DI void ph_ln2(const Args& a, int l, int c, LAS unsigned char* lds, int gw, int NGW, int lane) {
    const LAS int* ptile = (const LAS int*)(lds + TBL_OFF);
    bf16* xb = (bf16*)(a.ws + WS_XB); const unsigned char* y = (const unsigned char*)(a.ws + WS_Y);
    const u32x2* tokinfo = (const u32x2*)(a.ws + WS_TOKINFO);
    const float* g = a.ln2_g + l * DM; const float* be = a.ln2_b + l * DM;
    u32x4 nx0 = {0u,0u,0u,0u}, nx1 = {0u,0u,0u,0u}; u32x2 nti = {0u, 0u};
    if (gw < CHTOK) { const int row0 = c * CHTOK + gw; const u32x4* xr0 = (const u32x4*)(xb + (size_t)row0 * DM) + lane; nx0 = xr0[0]; nx1 = xr0[64]; if (lane < 8) nti = tokinfo[(size_t)row0 * 8 + lane]; }
    for (int tt = gw; tt < CHTOK; tt += NGW) {
        const int row = c * CHTOK + tt;
        const u32x4 cx0 = nx0, cx1 = nx1; const u32x2 cti = nti;
        if (tt + NGW < CHTOK) { const int rown = row + NGW; const u32x4* xrn = (const u32x4*)(xb + (size_t)rown * DM) + lane; nx0 = xrn[0]; nx1 = xrn[64]; if (lane < 8) nti = tokinfo[(size_t)rown * 8 + lane]; }
        u32x4* xr = (u32x4*)(xb + (size_t)row * DM) + lane;
        f32x4 v[4];
        v[0] = (f32x4){bflo(cx0.x), bfhi(cx0.x), bflo(cx0.y), bfhi(cx0.y)} * ALPHA; v[1] = (f32x4){bflo(cx0.z), bfhi(cx0.z), bflo(cx0.w), bfhi(cx0.w)} * ALPHA;
        v[2] = (f32x4){bflo(cx1.x), bfhi(cx1.x), bflo(cx1.y), bfhi(cx1.y)} * ALPHA; v[3] = (f32x4){bflo(cx1.z), bfhi(cx1.z), bflo(cx1.w), bfhi(cx1.w)} * ALPHA;
        int yrv = 0; float wv = 1.f;
        if (lane < 8) { const u32x2 ti = cti; yrv = (ptile[c * 65 + (int)(ti.x >> 16)] - ptile[c * 65]) * 256 + (int)(ti.x & 0xffffu); wv = __uint_as_float(ti.y); }
        else if (lane == 8) yrv = (ptile[c * 65 + 64] - ptile[c * 65]) * 256 + tt;
        u32x2 q[9][2]; float wk[9];
#pragma unroll
        for (int k = 0; k < 9; ++k) { const int yrow = __builtin_amdgcn_readlane(yrv, k); wk[k] = __int_as_float(__builtin_amdgcn_readlane(__float_as_int(wv), k)) * (1.f / Y_SCALE);
            const u32x2* yr = (const u32x2*)(y + (size_t)yrow * DM) + lane; q[k][0] = yr[0]; q[k][1] = yr[64]; }
#pragma unroll
        for (int k = 0; k < 9; ++k) {
#pragma unroll
            for (int j = 0; j < 2; ++j) { const float ws_ = wk[k]; const u32x2 qq = q[k][j];
                v[2 * j][0] += ws_ * __builtin_amdgcn_cvt_f32_fp8((int)qq.x, 0); v[2 * j][1] += ws_ * __builtin_amdgcn_cvt_f32_fp8((int)qq.x, 1); v[2 * j][2] += ws_ * __builtin_amdgcn_cvt_f32_fp8((int)qq.x, 2); v[2 * j][3] += ws_ * __builtin_amdgcn_cvt_f32_fp8((int)qq.x, 3);
                v[2 * j + 1][0] += ws_ * __builtin_amdgcn_cvt_f32_fp8((int)qq.y, 0); v[2 * j + 1][1] += ws_ * __builtin_amdgcn_cvt_f32_fp8((int)qq.y, 1); v[2 * j + 1][2] += ws_ * __builtin_amdgcn_cvt_f32_fp8((int)qq.y, 2); v[2 * j + 1][3] += ws_ * __builtin_amdgcn_cvt_f32_fp8((int)qq.y, 3); }
        }
        float s = 0.f;
#pragma unroll
        for (int j = 0; j < 4; ++j) s += (v[j].x + v[j].y) + (v[j].z + v[j].w);
        const float mean = wave_sum(s) * (1.f / DM); float s2 = 0.f;
#pragma unroll
        for (int j = 0; j < 4; ++j) { v[j] = v[j] - mean; s2 += (v[j].x * v[j].x + v[j].y * v[j].y) + (v[j].z * v[j].z + v[j].w * v[j].w); }
        const float rstd = 1.f / sqrtf(wave_sum(s2) * (1.f / DM) + LN_EPS);
#pragma unroll
        for (int j = 0; j < 2; ++j) {
            const int cb = 8 * lane + 512 * j;
            const f32x4 g0 = *(const f32x4*)(g + cb), g1 = *(const f32x4*)(g + cb + 4), b0 = *(const f32x4*)(be + cb), b1 = *(const f32x4*)(be + cb + 4);
            const f32x4 y0 = v[2 * j] * rstd * g0 + b0, y1 = v[2 * j + 1] * rstd * g1 + b1;
            xr[64 * j] = pack8(y0, y1);
            if (l == DEPTH - 1) { float* o = a.out + (size_t)row * DM + cb; *(f32x4*)o = y0; *(f32x4*)(o + 4) = y1; }
        }
    }
}

DI int pi32(int r) { return (r & ~12) | ((r & 4) << 1) | ((r & 8) >> 1); }
DI int kofs(int i, int hh) { return 16 * (i >> 3) + 8 * hh + (i & 7); }
DI bf16x8 pack_p(const float (&p)[16], int s) {
    u32x4 w; w.x = cvtpk(p[8 * s], p[8 * s + 1]); w.y = cvtpk(p[8 * s + 2], p[8 * s + 3]); w.z = cvtpk(p[8 * s + 4], p[8 * s + 5]); w.w = cvtpk(p[8 * s + 6], p[8 * s + 7]);
    return __builtin_bit_cast(bf16x8, w);
}
DI f32x16 zero16() { f32x16 z;
#pragma unroll
    for (int i = 0; i < 16; ++i) z[i] = 0.f; return z; }
DI void store_ot(bf16* dst, const f32x16& o0, const f32x16& o1, float sc, int hh) {
#pragma unroll
    for (int g = 0; g < 4; ++g) {
        float v[4];
#pragma unroll
        for (int q = 0; q < 4; ++q) v[q] = o0[4 * g + q] * sc;
        st4bf(dst + 8 * g + 4 * hh, v);
#pragma unroll
        for (int q = 0; q < 4; ++q) v[q] = o1[4 * g + q] * sc;
        st4bf(dst + 32 + 8 * g + 4 * hh, v);
    }
}

DI void load_kv(bf16x8 (&kf)[4], bf16x8 (&vf)[2][2], const bf16* kp, const bf16* vp) {
#pragma unroll
    for (int s = 0; s < 4; ++s) kf[s] = *(const bf16x8*)(kp + 16 * s);
#pragma unroll
    for (int dt = 0; dt < 2; ++dt)
#pragma unroll
        for (int s = 0; s < 2; ++s) vf[dt][s] = *(const bf16x8*)(vp + (size_t)dt * 32 * SEQ + 16 * s);
}
DI void copy_kv(bf16x8 (&kf)[4], bf16x8 (&vf)[2][2], const bf16x8 (&nkf)[4], const bf16x8 (&nvf)[2][2]) {
#pragma unroll
    for (int s = 0; s < 4; ++s) kf[s] = nkf[s];
#pragma unroll
    for (int dt = 0; dt < 2; ++dt)
#pragma unroll
        for (int s = 0; s < 2; ++s) vf[dt][s] = nvf[dt][s];
}

DI void sb_unit(const Args& a, int b, int h, int qb, int lane) {
    const bf16* proj = (const bf16*)(a.ws + WS_A);
    const int c = lane & 31, hh = lane >> 5, pr = pi32(c);
    const size_t tokq = (size_t)b * SEQ + qb * 32 + c;
    const bf16* qp = proj + tokq * PW + C_BQ + h * 64 + 8 * hh;
    bf16x8 qf[4];
#pragma unroll
    for (int s = 0; s < 4; ++s) qf[s] = *(const bf16x8*)(qp + 16 * s);
    f32x16 o0 = zero16(), o1 = zero16(); float R = 1.f;
    const bool slot0lo = (__builtin_amdgcn_permlane32_swap((unsigned)hh, (unsigned)hh, false, false)[0] == 0u);
    const bf16* kbase = proj + (size_t)b * SEQ * PW + C_BK + h * 64 + 8 * hh;
    const bf16* vb0 = (const bf16*)(a.ws + WS_VTB) + ((size_t)(b * 4 + h) * 64 + c) * SEQ + 8 * hh;
    bf16x8 kf[4], vf[2][2];
    load_kv(kf, vf, kbase + (size_t)(qb * 32 + pr) * PW, vb0 + qb * 32);
    for (int kt = qb; kt >= 0; --kt) {
        bf16x8 nkf[4], nvf[2][2];
        { const int kn = (kt > 0) ? kt - 1 : 0; load_kv(nkf, nvf, kbase + (size_t)(kn * 32 + pr) * PW, vb0 + kn * 32); }
        f32x16 x = zero16();
#pragma unroll
        for (int s = 0; s < 4; ++s) x = mfma32(kf[s], qf[s], x);
        const bool diag = (kt == qb);
        float rr[16], ex[16], T[2];
#pragma unroll
        for (int i = 0; i < 16; ++i) { float rv = frcp(1.f + fexp2(x[i])); if (diag && kofs(i, hh) >= c) rv = 1.f; rr[i] = rv; }
#pragma unroll
        for (int s = 0; s < 2; ++s) { ex[8 * s + 7] = 1.f;
#pragma unroll
            for (int j = 6; j >= 0; --j) ex[8 * s + j] = ex[8 * s + j + 1] * rr[8 * s + j + 1];
            T[s] = ex[8 * s] * rr[8 * s]; }
        const auto r0_ = __builtin_amdgcn_permlane32_swap(__float_as_uint(T[0]), __float_as_uint(T[0]), false, false), r1_ = __builtin_amdgcn_permlane32_swap(__float_as_uint(T[1]), __float_as_uint(T[1]), false, false);
        const float PT0 = __uint_as_float((hh != 0) == slot0lo ? r0_[0] : r0_[1]), PT1 = __uint_as_float((hh != 0) == slot0lo ? r1_[0] : r1_[1]);
        float suf0, suf1;
        if (hh == 0) { suf1 = R * PT1; suf0 = suf1 * T[1] * PT0; } else { suf1 = R; suf0 = R * T[1] * PT1; }
        R = R * (T[0] * T[1]) * (PT0 * PT1);
        float p[16];
#pragma unroll
        for (int i = 0; i < 16; ++i) p[i] = (1.f - rr[i]) * ex[i] * (i < 8 ? suf0 : suf1);
        const bf16x8 pb0 = pack_p(p, 0), pb1 = pack_p(p, 1);
        o0 = mfma32(vf[0][0], pb0, o0); o0 = mfma32(vf[0][1], pb1, o0);
        o1 = mfma32(vf[1][0], pb0, o1); o1 = mfma32(vf[1][1], pb1, o1);
        copy_kv(kf, vf, nkf, nvf);
    }
    store_ot((bf16*)(a.ws + WS_B) + tokq * DM + 256 + h * 64, o0, o1, 1.f, hh);
}

DI void fg_unit(const Args& a, int b, int h, int qb, int lane) {
    const bf16* proj = (const bf16*)(a.ws + WS_A);
    const int c = lane & 31, hh = lane >> 5, pr = pi32(c);
    const size_t tokq = (size_t)b * SEQ + qb * 32 + c;
    const bf16* qp = proj + tokq * PW + C_CQ + h * 64 + 8 * hh;
    bf16x8 qf[4];
#pragma unroll
    for (int s = 0; s < 4; ++s) qf[s] = *(const bf16x8*)(qp + 16 * s);
    const float* cum = (const float*)(a.ws + WS_CUM) + (size_t)(b * 4 + h) * SEQ;
    const float cq = cum[qb * 32 + c];
    f32x16 o0 = zero16(), o1 = zero16(); float m = -1.0e30f, l = 0.f;
    const bf16* kbase = proj + (size_t)b * SEQ * PW + C_CK + h * 64 + 8 * hh;
    const bf16* vb0 = (const bf16*)(a.ws + WS_VTC) + ((size_t)(b * 4 + h) * 64 + c) * SEQ + 8 * hh;
    bf16x8 kf[4], vf[2][2];
    load_kv(kf, vf, kbase + (size_t)pr * PW, vb0);
    for (int kt = 0; kt <= qb; ++kt) {
        const int k0 = kt * 32;
        bf16x8 nkf[4], nvf[2][2];
        { const int kn = (kt < qb) ? kt + 1 : kt; load_kv(nkf, nvf, kbase + (size_t)(kn * 32 + pr) * PW, vb0 + kn * 32); }
        float ck[16];
#pragma unroll
        for (int s = 0; s < 2; ++s) { const f32x4 c0 = *(const f32x4*)(cum + k0 + 16 * s + 8 * hh), c1 = *(const f32x4*)(cum + k0 + 16 * s + 8 * hh + 4);
            ck[8 * s] = c0.x; ck[8 * s + 1] = c0.y; ck[8 * s + 2] = c0.z; ck[8 * s + 3] = c0.w; ck[8 * s + 4] = c1.x; ck[8 * s + 5] = c1.y; ck[8 * s + 6] = c1.z; ck[8 * s + 7] = c1.w; }
        f32x16 x = zero16();
#pragma unroll
        for (int s = 0; s < 4; ++s) x = mfma32(kf[s], qf[s], x);
        const bool diag = (kt == qb);
        float sv[16]; float tmax = -1.0e30f;
#pragma unroll
        for (int i = 0; i < 16; ++i) { const bool ok = !(diag && kofs(i, hh) > c); sv[i] = ok ? (x[i] + (cq - ck[i])) : -1.0e30f; tmax = fmaxf(tmax, sv[i]); }
        tmax = red32_max(tmax);
        const float mn = fmaxf(m, tmax), al = fexp2(m - mn);
        float p[16]; float ls = 0.f;
#pragma unroll
        for (int i = 0; i < 16; ++i) { p[i] = (sv[i] > -1.0e29f) ? fexp2(sv[i] - mn) : 0.f; ls += p[i]; }
        l = l * al + ls; m = mn;
#pragma unroll
        for (int i = 0; i < 16; ++i) { o0[i] *= al; o1[i] *= al; }
        const bf16x8 pb0 = pack_p(p, 0), pb1 = pack_p(p, 1);
        o0 = mfma32(vf[0][0], pb0, o0); o0 = mfma32(vf[0][1], pb1, o0);
        o1 = mfma32(vf[1][0], pb0, o1); o1 = mfma32(vf[1][1], pb1, o1);
        copy_kv(kf, vf, nkf, nvf);
    }
    const float lt = red32_sum(l);
    store_ot((bf16*)(a.ws + WS_B) + tokq * DM + 512 + h * 64, o0, o1, 1.f / lt, hh);
}


DI void atile_load(u32x4& reg, const bf16* kt0, const bf16* vt0, int kt, int tid) {
    reg = (tid < 256) ? *(const u32x4*)(kt0 + (size_t)kt * 2048 + tid * 8) : *(const u32x4*)(vt0 + (size_t)kt * 2048 + (tid - 256) * 8);
}
DI void atile_store(LAS unsigned char* buf, const u32x4& reg, int tid) { *(LAS u32x4*)(buf + tid * 16) = reg; }
DI void atile_frags(bf16x8 (&kf)[4], bf16x8 (&vf)[2][2], const LAS unsigned char* buf, int c, int hh, int prow) {
    (void)prow;
#pragma unroll
    for (int s = 0; s < 4; ++s) kf[s] = *(const LAS bf16x8*)(buf + ((2 * s + hh) * 32 + c) * 16);
#pragma unroll
    for (int dt = 0; dt < 2; ++dt)
#pragma unroll
        for (int s = 0; s < 2; ++s) vf[dt][s] = *(const LAS bf16x8*)(buf + 4096 + ((dt * 2 + s) * 64 + hh * 32 + c) * 16);
}
template <int MIXER>
DI void sbfg_block(const Args& a, int l, int b, int h, int QB, LAS unsigned char* lds, int tid, int wave, int lane) {
    const bf16* proj = (const bf16*)(a.ws + WS_A);
    const int c = lane & 31, hh = lane >> 5, pr = pi32(c);
    const int ntile = 8 * QB + 8, qb = 8 * QB + wave;
    const size_t tokq = (size_t)b * SEQ + qb * 32 + c;
    const bf16* qp = proj + tokq * PW + (MIXER == 0 ? C_BQ : C_CQ) + h * 64 + 8 * hh;
    bf16x8 qf[4];
#pragma unroll
    for (int s = 0; s < 4; ++s) qf[s] = *(const bf16x8*)(qp + 16 * s);
    const bf16* krow0 = (const bf16*)(a.ws + (MIXER == 0 ? WS_KTB : WS_KTC)) + (size_t)(b * 4 + h) * (SEQ / 32) * 2048;
    const bf16* vt0 = (const bf16*)(a.ws + (MIXER == 0 ? WS_VTB : WS_VTC)) + (size_t)(b * 4 + h) * (SEQ / 32) * 2048;
    const float* cum = (const float*)(a.ws + WS_CUM) + (size_t)(b * 4 + h) * SEQ;
    const float cq = (MIXER == 1) ? cum[qb * 32 + c] : 0.f;
    float Bq = 0.f;
    if (MIXER == 1) { float qs = 0.f;
#pragma unroll
        for (int s = 0; s < 4; ++s) { const u32x4 w = __builtin_bit_cast(u32x4, qf[s]);
            qs += bflo(w.x) * bflo(w.x) + bfhi(w.x) * bfhi(w.x) + bflo(w.y) * bflo(w.y) + bfhi(w.y) * bfhi(w.y) + bflo(w.z) * bflo(w.z) + bfhi(w.z) * bfhi(w.z) + bflo(w.w) * bflo(w.w) + bfhi(w.w) * bfhi(w.w); }
        qs = red32_sum(qs);
        const float k2 = __uint_as_float(((const unsigned*)(a.ws + WS_CTL))[CW_KMAX + l * 32 + b * 4 + h]);
        Bq = sqrtf(qs * k2) * 1.01f + 0.5f; }
    f32x16 o0 = zero16(), o1 = zero16(); float R = 1.f, m = -1.0e30f, l_ = 0.f;
    const bool slot0lo = (__builtin_amdgcn_permlane32_swap((unsigned)hh, (unsigned)hh, false, false)[0] == 0u);
    u32x4 reg;
    atile_load(reg, krow0, vt0, ntile - 1, tid); atile_store(lds, reg, tid);
    if (ntile > 1) { atile_load(reg, krow0, vt0, ntile - 2, tid); atile_store(lds + 8192, reg, tid); }
    __syncthreads();
    bf16x8 kfA[4], vfA[2][2], kfB[4], vfB[2][2];
    atile_frags(kfA, vfA, lds, c, hh, pr);
    int st = 0;
#define SBFG_STEP(JJ, KF, VF, NKF, NVF) { \
        const int kt = ntile - 1 - (JJ); \
        const int st1 = (st == 2) ? 0 : st + 1, st2 = (st1 == 2) ? 0 : st1 + 1; \
        if ((JJ) + 2 < ntile) atile_load(reg, krow0, vt0, kt - 2, tid); \
        if ((JJ) + 1 < ntile) atile_frags(NKF, NVF, lds + st1 * 8192, c, hh, pr); \
        if (kt <= qb) { \
            f32x16 x = zero16(); \
_Pragma("unroll") \
            for (int s = 0; s < 4; ++s) x = mfma32(KF[s], qf[s], x); \
            const bool diag = (kt == qb); \
            float p[16]; \
            if (MIXER == 0) { \
                float rr[16], ex[16], T[2]; \
_Pragma("unroll") \
                for (int i = 0; i < 16; ++i) rr[i] = frcp(1.f + fexp2(x[i])); \
                if (diag) { \
_Pragma("unroll") \
                    for (int i = 0; i < 16; ++i) if (kofs(i, hh) >= c) rr[i] = 1.f; \
                } \
_Pragma("unroll") \
                for (int s = 0; s < 2; ++s) { ex[8 * s + 7] = 1.f; \
_Pragma("unroll") \
                    for (int q = 6; q >= 0; --q) ex[8 * s + q] = ex[8 * s + q + 1] * rr[8 * s + q + 1]; \
                    T[s] = ex[8 * s] * rr[8 * s]; } \
                const auto r0_ = __builtin_amdgcn_permlane32_swap(__float_as_uint(T[0]), __float_as_uint(T[0]), false, false), r1_ = __builtin_amdgcn_permlane32_swap(__float_as_uint(T[1]), __float_as_uint(T[1]), false, false); \
                const float PT0 = __uint_as_float((hh != 0) == slot0lo ? r0_[0] : r0_[1]), PT1 = __uint_as_float((hh != 0) == slot0lo ? r1_[0] : r1_[1]); \
                float suf0, suf1; \
                if (hh == 0) { suf1 = R * PT1; suf0 = suf1 * T[1] * PT0; } else { suf1 = R; suf0 = R * T[1] * PT1; } \
                R = R * (T[0] * T[1]) * (PT0 * PT1); \
_Pragma("unroll") \
                for (int i = 0; i < 16; ++i) p[i] = (ex[i] - ex[i] * rr[i]) * (i < 8 ? suf0 : suf1); \
            } else { \
                const int k0 = kt * 32; \
                float ck[16]; \
_Pragma("unroll") \
                for (int s = 0; s < 2; ++s) { const f32x4 c0 = *(const f32x4*)(cum + k0 + 16 * s + 8 * hh), c1 = *(const f32x4*)(cum + k0 + 16 * s + 8 * hh + 4); \
                    ck[8 * s] = c0.x; ck[8 * s + 1] = c0.y; ck[8 * s + 2] = c0.z; ck[8 * s + 3] = c0.w; ck[8 * s + 4] = c1.x; ck[8 * s + 5] = c1.y; ck[8 * s + 6] = c1.z; ck[8 * s + 7] = c1.w; } \
                float sv[16]; float tmax = -1.0e30f; \
_Pragma("unroll") \
                for (int i = 0; i < 16; ++i) sv[i] = x[i] + (cq - ck[i]); \
                if (diag) { \
_Pragma("unroll") \
                    for (int i = 0; i < 16; ++i) if (kofs(i, hh) > c) sv[i] = -1.0e30f; \
                } \
_Pragma("unroll") \
                for (int i = 0; i < 16; ++i) tmax = fmaxf(tmax, sv[i]); \
                tmax = red32_max(tmax); \
                if (__any(tmax > m)) { \
                    const float mn = fmaxf(m, tmax), al = fexp2(m - mn); m = mn; l_ *= al; \
_Pragma("unroll") \
                    for (int i = 0; i < 16; ++i) { o0[i] *= al; o1[i] *= al; } \
                } \
                float ls = 0.f; \
_Pragma("unroll") \
                for (int i = 0; i < 16; ++i) { p[i] = fexp2(sv[i] - m); ls += p[i]; } \
                l_ += ls; \
            } \
            const bf16x8 pb0 = pack_p(p, 0), pb1 = pack_p(p, 1); \
            o0 = mfma32(VF[0][0], pb0, o0); o0 = mfma32(VF[0][1], pb1, o0); \
            o1 = mfma32(VF[1][0], pb0, o1); o1 = mfma32(VF[1][1], pb1, o1); \
        } \
        if ((JJ) + 2 < ntile) atile_store(lds + st2 * 8192, reg, tid); \
        __syncthreads(); \
        st = st1; \
    }
    LAS unsigned* dflag = (LAS unsigned*)(lds + 24576);
    for (int j = 0; j < ntile; j += 2) {
        SBFG_STEP(j, kfA, vfA, kfB, vfB)
        {
            const int ktj = ntile - 1 - j; const bool started = ktj <= qb;
            bool fin;
            if (MIXER == 0) fin = started && __all(R < 1.0e-12f);
            else { const float cn = (ktj >= 1) ? cum[32 * ktj - 1] : 0.f; fin = started && (ktj >= 1) && __all(Bq + (cq - cn) < m - 40.f); }
            if (lane == 0) dflag[((j >> 1) & 1) * 8 + wave] = fin ? 1u : 0u;
        }
        SBFG_STEP(j + 1, kfB, vfB, kfA, vfA)
        {
            const u32x4 f0 = *(const LAS u32x4*)(dflag + ((j >> 1) & 1) * 8), f1 = *(const LAS u32x4*)(dflag + ((j >> 1) & 1) * 8 + 4);
            if ((f0.x & f0.y & f0.z & f0.w & f1.x & f1.y & f1.z & f1.w) != 0u) break;
        }
    }
#undef SBFG_STEP
    if (MIXER == 0) store_ot((bf16*)(a.ws + WS_B) + tokq * DM + 256 + h * 64, o0, o1, 1.f, hh);
    else { const float lt = red32_sum(l_); store_ot((bf16*)(a.ws + WS_B) + tokq * DM + 512 + h * 64, o0, o1, 1.f / lt, hh); }
}

DI void osm_step(const f32x16& x, int lo, int hi, int hh, bool interior, bool sel, float& m, float& l, f32x16& o0, f32x16& o1, const bf16x8 (&vf)[2][2]) {
    float sv[16];
    if (interior) {
#pragma unroll
        for (int i = 0; i < 16; ++i) sv[i] = x[i];
    } else {
#pragma unroll
        for (int i = 0; i < 16; ++i) { const int ko = kofs(i, hh); sv[i] = (ko <= hi && ko >= lo) ? x[i] : -3.0e38f; }
    }
    float tmax = -3.0e38f;
#pragma unroll
    for (int i = 0; i < 16; ++i) tmax = fmaxf(tmax, sv[i]);
    tmax = red32_max(sel ? tmax : -3.0e38f);
    if (__any(tmax > m)) { const float mn = fmaxf(m, tmax), al = fexp2(m - mn); m = mn; l *= al;
#pragma unroll
        for (int i = 0; i < 16; ++i) { o0[i] *= al; o1[i] *= al; } }
    const float meff = sel ? m : 3.0e38f;
    float p[16]; float ls = 0.f;
#pragma unroll
    for (int i = 0; i < 16; ++i) { p[i] = fexp2(sv[i] - meff); ls += p[i]; }
    l += ls;
    const bf16x8 pb0 = pack_p(p, 0), pb1 = pack_p(p, 1);
    o0 = mfma32(vf[0][0], pb0, o0); o0 = mfma32(vf[0][1], pb1, o0);
    o1 = mfma32(vf[1][0], pb0, o1); o1 = mfma32(vf[1][1], pb1, o1);
}

DI void ld_k4(bf16x8 (&kf)[4], const bf16* kp) {
#pragma unroll
    for (int s = 0; s < 4; ++s) kf[s] = *(const bf16x8*)(kp + 16 * s);
}
DI void ld_v4(bf16x8 (&vf)[2][2], const bf16* vp, int vpitch) {
#pragma unroll
    for (int dt = 0; dt < 2; ++dt)
#pragma unroll
        for (int s = 0; s < 2; ++s) vf[dt][s] = *(const bf16x8*)(vp + (size_t)dt * 32 * vpitch + 16 * s);
}
DI void ld_kt(bf16x8 (&kf)[4], const bf16* tile, int c, int hh) {
#pragma unroll
    for (int s = 0; s < 4; ++s) kf[s] = *(const bf16x8*)(tile + ((2 * s + hh) * 32 + c) * 8);
}
DI void ld_vt(bf16x8 (&vf)[2][2], const bf16* tile, int c, int hh) {
#pragma unroll
    for (int dt = 0; dt < 2; ++dt)
#pragma unroll
        for (int s = 0; s < 2; ++s) vf[dt][s] = *(const bf16x8*)(tile + ((dt * 2 + s) * 64 + hh * 32 + c) * 8);
}
DI unsigned wave_max_u(unsigned v) {
    v = max(v, (unsigned)DPPI((int)v, 0xB1, 0xF, true)); v = max(v, (unsigned)DPPI((int)v, 0x4E, 0xF, true));
    v = max(v, (unsigned)DPPI((int)v, 0x124, 0xF, true)); v = max(v, (unsigned)DPPI((int)v, 0x128, 0xF, true));
    { const auto r = __builtin_amdgcn_permlane16_swap(v, v, false, false); v = max(r[0], r[1]); const auto q = __builtin_amdgcn_permlane32_swap(v, v, false, false); v = max(q[0], q[1]); }
    return v;
}
DI void nsa_unit(const Args& a, int unit, LAS unsigned char* wl, int lane) {
    const bf16* proj = (const bf16*)(a.ws + WS_A);
    const int tok0 = unit * 8, b = tok0 / SEQ, t0 = tok0 % SEQ;
    const int c = lane & 31, hh = lane >> 5, ql = c >> 2, hd = c & 3, pr = pi32(c);
    const int tq = t0 + ql; const size_t tokq = (size_t)tok0 + ql;
    const bf16* qp = proj + tokq * PW + C_AQ + hd * 64 + 8 * hh;
    bf16x8 qf[4];
#pragma unroll
    for (int s = 0; s < 4; ++s) qf[s] = *(const bf16x8*)(qp + 16 * s);
    LAS float* imp = (LAS float*)wl; LAS unsigned* selm = (LAS unsigned*)(wl + 4096); LAS unsigned char* blist = (LAS unsigned char*)(wl + 4096 + 128);
    for (int i = lane; i < 1024; i += 64) imp[i] = 0.f;
    const float* gate = (const float*)(a.ws + WS_GATE) + tokq * 12 + hd * 3;
    const float g0 = gate[0], g1 = gate[1], g2 = gate[2];
    f32x16 of0 = zero16(), of1 = zero16();
    {
        const bf16* kc = (const bf16*)(a.ws + WS_KCMP) + (size_t)b * 16 * 2048;
        const bf16* vt = (const bf16*)(a.ws + WS_VTCMP) + (size_t)b * 16 * 2048;
        const int nmaxq = (tq >= 31) ? ((tq - 31) >> 4) : -1;
        const int nmaxu = (t0 + 7 >= 31) ? ((t0 + 7 - 31) >> 4) : -1;
        const int nmax0 = (t0 >= 31) ? ((t0 - 31) >> 4) : -1;
        const int ntile = (nmaxu >> 5) + 1;
        float m = -1.0e30f, l = 0.f;
        bf16x8 kf[4], nkf[4];
        if (ntile > 0) ld_kt(kf, kc, c, hh);
        for (int kt = 0; kt < ntile; ++kt) {
            ld_kt(nkf, kc + (size_t)(kt + 1 < ntile ? kt + 1 : kt) * 2048, c, hh);
            f32x16 x = zero16();
#pragma unroll
            for (int s = 0; s < 4; ++s) x = mfma32(kf[s], qf[s], x);
            const int lim = nmaxq - kt * 32; float sv[16]; float tmax = -3.0e38f;
            if (kt * 32 + 31 <= nmax0) {
#pragma unroll
                for (int i = 0; i < 16; ++i) sv[i] = x[i];
            } else {
#pragma unroll
                for (int i = 0; i < 16; ++i) sv[i] = (kofs(i, hh) <= lim) ? x[i] : -3.0e38f;
            }
#pragma unroll
            for (int i = 0; i < 16; ++i) tmax = fmaxf(tmax, sv[i]);
            tmax = red32_max(tmax);
            const float mn = fmaxf(m, tmax); float ls = 0.f;
#pragma unroll
            for (int i = 0; i < 16; ++i) ls += fexp2(sv[i] - mn);
            l = l * fexp2(m - mn) + ls; m = mn;
#pragma unroll
            for (int s = 0; s < 4; ++s) kf[s] = nkf[s];
        }
        const float lt = red32_sum(l);
        const float inv = 1.f / fmaxf(lt, 1.0e-30f);
        f32x16 o0 = zero16(), o1 = zero16();
        LDS_WAIT();
        bf16x8 vf[2][2], nvf[2][2];
        if (ntile > 0) { ld_kt(kf, kc, c, hh); ld_vt(vf, vt, c, hh); }
        for (int kt = 0; kt < ntile; ++kt) {
            { const int kn = (kt + 1 < ntile ? kt + 1 : kt); ld_kt(nkf, kc + (size_t)kn * 2048, c, hh); ld_vt(nvf, vt + (size_t)kn * 2048, c, hh); }
            f32x16 x = zero16();
#pragma unroll
            for (int s = 0; s < 4; ++s) x = mfma32(kf[s], qf[s], x);
            float p[16], ps[16], sv[16];
            if (kt * 32 + 31 <= nmax0) {
#pragma unroll
                for (int i = 0; i < 16; ++i) sv[i] = x[i];
            } else {
#pragma unroll
                for (int i = 0; i < 16; ++i) sv[i] = (kofs(i, hh) <= nmaxq - kt * 32) ? x[i] : -3.0e38f;
            }
#pragma unroll
            for (int i = 0; i < 16; ++i) { p[i] = fexp2(sv[i] - m) * inv;
                float t = p[i]; t += dpp_xor1(t); t += dpp_xor2(t); ps[i] = t; }
            if (hd == 0) {
#pragma unroll
                for (int s = 0; s < 2; ++s) { const int gb = (kt * 32 + 16 * s + 8 * hh) >> 2; LAS float* ip = imp + ql * 128 + gb;
                    __hip_atomic_fetch_add(ip, (ps[8 * s] + ps[8 * s + 1]) + (ps[8 * s + 2] + ps[8 * s + 3]), __ATOMIC_RELAXED, __HIP_MEMORY_SCOPE_WORKGROUP);
                    __hip_atomic_fetch_add(ip + 1, ps[8 * s + 3] + (ps[8 * s + 4] + ps[8 * s + 5]) + (ps[8 * s + 6] + ps[8 * s + 7]), __ATOMIC_RELAXED, __HIP_MEMORY_SCOPE_WORKGROUP);
                    if (gb + 2 < 128) __hip_atomic_fetch_add(ip + 2, ps[8 * s + 7], __ATOMIC_RELAXED, __HIP_MEMORY_SCOPE_WORKGROUP); }
            }
            const bf16x8 pb0 = pack_p(p, 0), pb1 = pack_p(p, 1);
            o0 = mfma32(vf[0][0], pb0, o0); o0 = mfma32(vf[0][1], pb1, o0);
            o1 = mfma32(vf[1][0], pb0, o1); o1 = mfma32(vf[1][1], pb1, o1);
            copy_kv(kf, vf, nkf, nvf);
        }
#pragma unroll
        for (int i = 0; i < 16; ++i) { of0[i] = g0 * o0[i]; of1[i] = g0 * o1[i]; }
    }
    LDS_WAIT();
    for (int qi = 0; qi < 8; ++qi) {
        const int qblk = (t0 + qi) >> 6;
        const LAS float* iq = imp + qi * 128;
        const int b0 = lane, b1 = lane + 64;
        const bool ad0 = b0 <= qblk, ad1 = b1 <= qblk;
        const bool f0 = (b0 == 0) || (b0 == qblk) || (b0 == qblk - 1), f1 = (b1 == qblk) || (b1 == qblk - 1);
        unsigned v0 = ad0 ? __float_as_uint(f0 ? iq[b0] + 1.0e6f : iq[b0]) + 1u : 0u, v1 = ad1 ? __float_as_uint(f1 ? iq[b1] + 1.0e6f : iq[b1]) + 1u : 0u;
        unsigned long long m0 = 0ull, m1 = 0ull;
        const int nsel = (qblk + 1 < 16) ? qblk + 1 : 16;
        for (int r = 0; r < nsel; ++r) {
            const unsigned mx = wave_max_u(max(v0, v1));
            const unsigned long long e0 = __ballot(v0 == mx);
            if (e0) { const int idx = __builtin_ctzll(e0); m0 |= 1ull << idx; if (lane == idx) v0 = 0u; }
            else { const unsigned long long e1 = __ballot(v1 == mx); const int idx = __builtin_ctzll(e1); m1 |= 1ull << idx; if (lane == idx) v1 = 0u; }
        }
        if (lane == 0) { selm[qi * 4] = (unsigned)m0; selm[qi * 4 + 1] = (unsigned)(m0 >> 32); selm[qi * 4 + 2] = (unsigned)m1; selm[qi * 4 + 3] = (unsigned)(m1 >> 32); }
    }
    LDS_WAIT();
    {
        unsigned mk[4], um[4]; int nb = 0;
#pragma unroll
        for (int w = 0; w < 4; ++w) { mk[w] = selm[ql * 4 + w]; unsigned u = 0;
#pragma unroll
            for (int q = 0; q < 8; ++q) u |= selm[q * 4 + w];
            um[w] = (unsigned)__builtin_amdgcn_readfirstlane((int)u); }
#pragma unroll
        for (int w = 0; w < 4; ++w) { const unsigned u = um[w]; const int l32 = lane & 31;
            if (lane < 32 && ((u >> l32) & 1u)) blist[nb + __builtin_popcount(u & ((1u << l32) - 1u))] = (unsigned char)(32 * w + l32);
            nb += __builtin_popcount(u); }
        LDS_WAIT();
        const bf16* kbase = (const bf16*)(a.ws + WS_KTS) + (size_t)b * (SEQ / 32) * 2048;
        const bf16* vb0 = (const bf16*)(a.ws + WS_VTAS) + (size_t)b * (SEQ / 32) * 2048;
        f32x16 o0 = zero16(), o1 = zero16(); float m = -1.0e30f, l = 0.f;
        const int nt = 2 * nb;
        bf16x8 kf[4], vf[2][2], nkf[4], nvf[2][2];
        int blk = blist[0];
        { const int t0i = blk * 2; ld_kt(kf, kbase + (size_t)t0i * 2048, c, hh); ld_vt(vf, vb0 + (size_t)t0i * 2048, c, hh); }
#define NSA_SEL_STEP(TT, KF, VF, NKF, NVF) { \
            const int k0 = blk * 64 + 32 * ((TT) & 1); \
            const int tn = ((TT) + 1 < nt) ? (TT) + 1 : (TT); const int blkn = blist[tn >> 1]; \
            { const int tni = blkn * 2 + (tn & 1); ld_kt(NKF, kbase + (size_t)tni * 2048, c, hh); ld_vt(NVF, vb0 + (size_t)tni * 2048, c, hh); } \
            const bool mysel = ((((blk >> 5) == 0 ? mk[0] : (blk >> 5) == 1 ? mk[1] : (blk >> 5) == 2 ? mk[2] : mk[3]) >> (blk & 31)) & 1u) != 0u; \
            f32x16 x = zero16(); \
            _Pragma("unroll") for (int s = 0; s < 4; ++s) x = mfma32(KF[s], qf[s], x); \
            osm_step(x, 0, tq - k0, hh, k0 + 31 <= t0, mysel, m, l, o0, o1, VF); \
            blk = blkn; }
        for (int t = 0; t < nt; t += 2) {
            NSA_SEL_STEP(t, kf, vf, nkf, nvf)
            NSA_SEL_STEP(t + 1, nkf, nvf, kf, vf)
        }
#undef NSA_SEL_STEP
        const float lt = red32_sum(l); const float sc = g1 / fmaxf(lt, 1.0e-30f);
#pragma unroll
        for (int i = 0; i < 16; ++i) { of0[i] += sc * o0[i]; of1[i] += sc * o1[i]; }
    }
    {
        const bf16* kbase = (const bf16*)(a.ws + WS_KTW) + (size_t)b * (SEQ / 32) * 2048;
        const bf16* vb0 = (const bf16*)(a.ws + WS_VTAW) + (size_t)b * (SEQ / 32) * 2048;
        f32x16 o0 = zero16(), o1 = zero16(); float m = -1.0e30f, l = 0.f;
        const int klo = (t0 >= 511) ? ((t0 - 511) >> 5) : 0, khi = (t0 + 7) >> 5;
        bf16x8 kf[4], vf[2][2], nkf[4], nvf[2][2];
        ld_kt(kf, kbase + (size_t)klo * 2048, c, hh); ld_vt(vf, vb0 + (size_t)klo * 2048, c, hh);
        for (int kt = klo; kt <= khi; ++kt) {
            const int k0 = kt * 32;
            { const int kn = (kt < khi ? kt + 1 : kt); ld_kt(nkf, kbase + (size_t)kn * 2048, c, hh); ld_vt(nvf, vb0 + (size_t)kn * 2048, c, hh); }
            f32x16 x = zero16();
#pragma unroll
            for (int s = 0; s < 4; ++s) x = mfma32(kf[s], qf[s], x);
            osm_step(x, tq - 511 - k0, tq - k0, hh, k0 >= t0 + 7 - 511 && k0 + 31 <= t0, true, m, l, o0, o1, vf);
            copy_kv(kf, vf, nkf, nvf);
        }
        const float lt = red32_sum(l); const float sc = g2 / fmaxf(lt, 1.0e-30f);
#pragma unroll
        for (int i = 0; i < 16; ++i) { of0[i] += sc * o0[i]; of1[i] += sc * o1[i]; }
    }
    store_ot((bf16*)(a.ws + WS_B) + tokq * DM + hd * 64, of0, of1, 1.f, hh);
}

#ifndef DSA_REP_S
#define DSA_REP_S 1
#define DSA_REP_L 1
#define DSA_REP_A 1
#endif
#ifndef DSA_REP_1
#define DSA_REP_1 1
#define DSA_REP_2 1
#define DSA_REP_3 1
#endif
constexpr int DSA_CIDX = 132096, DSA_LIST = DSA_CIDX + 16384, DSA_DUMMY = DSA_LIST + 8192;  static_assert(DSA_DUMMY + 8 * 128 <= MISC_OFF, "DSA LDS map");
static_assert(DSA_LIST + 8192 <= MISC_OFF, "DSA LDS map");
typedef short v4i16_t __attribute__((ext_vector_type(4)));
DI unsigned f2key(float f) { const unsigned u = __float_as_uint(f); return u ^ ((u >> 31) ? 0xffffffffu : 0x80000000u); }
DI int wave_excl_scan(int v, int lane) { (void)lane; return wave_incl_scan(v) - v; }
DI int wave_sum_i(int v) {
    v += DPPI(v, 0xB1, 0xF, true); v += DPPI(v, 0x4E, 0xF, true); v += DPPI(v, 0x124, 0xF, true); v += DPPI(v, 0x128, 0xF, true);
    const auto r = __builtin_amdgcn_permlane16_swap((unsigned)v, (unsigned)v, false, false); v = (int)(r[0] + r[1]);
    const auto q = __builtin_amdgcn_permlane32_swap((unsigned)v, (unsigned)v, false, false); return (int)(q[0] + q[1]);
}
template <int NR>
DI unsigned kth_regn(const unsigned (&k)[16], int K) {
    unsigned hi = 0u, lo = 0xffffffffu;
#pragma unroll
    for (int j = 0; j < NR; ++j) { hi = (k[j] > hi) ? k[j] : hi; const unsigned kk = k[j] ? k[j] : 0xffffffffu; lo = (kk < lo) ? kk : lo; }
    hi = max(hi, (unsigned)DPPI((int)hi, 0xB1, 0xF, true)); hi = max(hi, (unsigned)DPPI((int)hi, 0x4E, 0xF, true));
    lo = min(lo, (unsigned)__builtin_amdgcn_update_dpp((int)0xffffffff, (int)lo, 0xB1, 0xF, 0xF, false)); lo = min(lo, (unsigned)__builtin_amdgcn_update_dpp((int)0xffffffff, (int)lo, 0x4E, 0xF, 0xF, false));
    hi = max(hi, (unsigned)DPPI((int)hi, 0x124, 0xF, true)); hi = max(hi, (unsigned)DPPI((int)hi, 0x128, 0xF, true));
    lo = min(lo, (unsigned)__builtin_amdgcn_update_dpp((int)0xffffffff, (int)lo, 0x124, 0xF, 0xF, false)); lo = min(lo, (unsigned)__builtin_amdgcn_update_dpp((int)0xffffffff, (int)lo, 0x128, 0xF, 0xF, false));
    { const auto r = __builtin_amdgcn_permlane16_swap(hi, hi, false, false); hi = max(r[0], r[1]); const auto q = __builtin_amdgcn_permlane32_swap(hi, hi, false, false); hi = max(q[0], q[1]); }
    { const auto r = __builtin_amdgcn_permlane16_swap(lo, lo, false, false); lo = min(r[0], r[1]); const auto q = __builtin_amdgcn_permlane32_swap(lo, lo, false, false); lo = min(q[0], q[1]); }
    const unsigned diff = (unsigned)__builtin_amdgcn_readfirstlane((int)(hi ^ lo));
    if (diff == 0u) return (unsigned)__builtin_amdgcn_readfirstlane((int)hi);
    const int top = 31 - __builtin_clz(diff);
    unsigned prefix = (unsigned)__builtin_amdgcn_readfirstlane((int)hi) & ~((2u << top) - 1u);
#pragma unroll 1
    for (int bit = top; bit >= 0; --bit) {
        const unsigned cand = prefix | (1u << bit); int c = 0;
#pragma unroll
        for (int j = 0; j < NR; ++j) c += __builtin_popcountll(__ballot(k[j] >= cand));
        if (c >= K) prefix = cand;
    }
    return prefix;
}
DI unsigned kth_reg16(const unsigned (&k)[16], int K) { return kth_regn<16>(k, K); }
DI unsigned kth_disp(const unsigned (&k)[16], int K, int nr) { return nr <= 6 ? kth_regn<6>(k, K) : nr <= 8 ? kth_regn<8>(k, K) : nr <= 12 ? kth_regn<12>(k, K) : kth_regn<16>(k, K); }
DI void dsa_attend(const Args& a, const bf16* proj, int b, size_t tokq, const LAS unsigned short* list, int cnt, LAS unsigned char* stg, int lane) {
        const int col = lane & 15, quad = lane >> 4, hd = col & 3;
        const bf16* qp = proj + tokq * PW + C_DQ + hd * 64 + 8 * quad;
        const bf16x8 qb0 = *(const bf16x8*)qp, qb1 = *(const bf16x8*)(qp + 32);
        const bf16* krow0 = proj + (size_t)b * SEQ * PW + C_DK; const bf16* vrow0 = proj + (size_t)b * SEQ * PW + C_DV;
        const int grow_ = lane >> 3, piece_ = lane & 7;
        f32x4 o[4];
#pragma unroll
        for (int dt = 0; dt < 4; ++dt) o[dt] = (f32x4){0.f, 0.f, 0.f, 0.f};
        float mrun = -1.0e30f, ls = 0.f;
#pragma unroll 1
        for (int ch = 0; ch < 2; ++ch) {
            if (ch * 128 >= cnt) break;
            int grow = grow_, piece = piece_; asm volatile("" : "+v"(grow), "+v"(piece));
            u32x4 wk[16], wv[16];
#pragma unroll
            for (int it = 0; it < 16; ++it) { const int j = ch * 128 + it * 8 + grow; const unsigned kidx = (j < cnt) ? (unsigned)list[j] : 0u;
                wk[it] = *(const u32x4*)(krow0 + (size_t)kidx * PW + 8 * piece); wv[it] = *(const u32x4*)(vrow0 + (size_t)kidx * PW + 8 * piece); }
#pragma unroll
            for (int it = 0; it < 16; ++it) { const int row = it * 8 + grow; *(LAS u32x4*)(stg + row * 128 + ((piece ^ (row & 7)) * 16)) = wk[it]; }
            LDS_WAIT();
            float sr[8][4];
            {
                int colq = col, quadq = quad; asm volatile("" : "+v"(colq), "+v"(quadq));
#pragma unroll
                for (int kt = 0; kt < 8; ++kt) {
                    const int row = kt * 16 + colq;
                    const bf16x8 a0 = *(const LAS bf16x8*)(stg + row * 128 + ((quadq ^ (row & 7)) * 16)), a1 = *(const LAS bf16x8*)(stg + row * 128 + (((quadq + 4) ^ (row & 7)) * 16));
                    f32x4 d = (f32x4){0.f, 0.f, 0.f, 0.f};
                    d = mfma16(a0, qb0, d); d = mfma16(a1, qb1, d);
#pragma unroll
                    for (int i = 0; i < 4; ++i) sr[kt][i] = (ch * 128 + kt * 16 + 4 * quadq + i < cnt) ? d[i] : -1.0e30f;
                }
            }
            float mx = -1.0e30f;
#pragma unroll
            for (int kt = 0; kt < 8; ++kt)
#pragma unroll
                for (int i = 0; i < 4; ++i) mx = fmaxf(mx, sr[kt][i]);
            mx = red16_max(mx); mx = red32_max(mx);
            const float mn = fmaxf(mrun, mx), al = fexp2(mrun - mn); mrun = mn;
            float lc = 0.f;
#pragma unroll
            for (int kt = 0; kt < 8; ++kt)
#pragma unroll
                for (int i = 0; i < 4; ++i) { const float p = (sr[kt][i] > -1.0e29f) ? fexp2(sr[kt][i] - mn) : 0.f; sr[kt][i] = p; lc += p; }
            lc = red16_sum(lc); lc = red32_sum(lc);
            ls = ls * al + lc;
#pragma unroll
            for (int dt = 0; dt < 4; ++dt) o[dt] = o[dt] * al;
            LDS_WAIT();
#pragma unroll
            for (int it = 0; it < 16; ++it) { const int row = it * 8 + grow; *(LAS u32x4*)(stg + row * 128 + ((piece ^ (row & 7)) * 16)) = wv[it]; }
            LDS_WAIT();
            {
                int colp = col, quadp = quad; asm volatile("" : "+v"(colp), "+v"(quadp));
#pragma unroll
                for (int g = 0; g < 4; ++g) {
                    u32x4 pw; pw.x = cvtpk(sr[2 * g][0], sr[2 * g][1]); pw.y = cvtpk(sr[2 * g][2], sr[2 * g][3]); pw.z = cvtpk(sr[2 * g + 1][0], sr[2 * g + 1][1]); pw.w = cvtpk(sr[2 * g + 1][2], sr[2 * g + 1][3]);
                    const bf16x8 pb = __builtin_bit_cast(bf16x8, pw);
                    const int klo = 32 * g + 4 * quadp + (colp >> 2), khi = klo + 16;
#pragma unroll
                    for (int dt = 0; dt < 4; ++dt) { const int pc = 2 * dt + ((colp & 3) >> 1), bo = (colp & 1) * 8;
                        const v4i16_t lo = __builtin_amdgcn_ds_read_tr16_b64_v4i16((LAS v4i16_t*)(stg + klo * 128 + ((pc ^ (klo & 7)) * 16) + bo));
                        const v4i16_t hi = __builtin_amdgcn_ds_read_tr16_b64_v4i16((LAS v4i16_t*)(stg + khi * 128 + ((pc ^ (khi & 7)) * 16) + bo));
                        const bf16x8 av = (bf16x8){lo[0], lo[1], lo[2], lo[3], hi[0], hi[1], hi[2], hi[3]};
                        o[dt] = mfma16(av, pb, o[dt]); }
                }
            }
            LDS_WAIT();
        }
        if (col < 4) { const float inv = 1.f / ls; bf16* om = (bf16*)(a.ws + WS_B) + tokq * DM + 768 + hd * 64 + 4 * quad;
#pragma unroll
            for (int dt = 0; dt < 4; ++dt) { float v[4] = {o[dt][0] * inv, o[dt][1] * inv, o[dt][2] * inv, o[dt][3] * inv}; st4bf(om + 16 * dt, v); } }
    }

DI void dsa_attend2(const Args& a, const bf16* proj, int b, size_t tokA, const LAS unsigned short* listA, int cntA, size_t tokB, const LAS unsigned short* listB, int cntB, LAS unsigned char* stg, int lane) {
    const int col = lane & 15, quad = lane >> 4, hd = col & 3;
    const bf16* krow0 = proj + (size_t)b * SEQ * PW + C_DK; const bf16* vrow0 = proj + (size_t)b * SEQ * PW + C_DV;
    const int grow_ = lane >> 3, piece_ = lane & 7;
    const int ncA = (cntA + 63) >> 6, nc = ncA + ((cntB + 63) >> 6);
    bf16x8 qb0, qb1; f32x4 o[4]; float mrun = -1.0e30f, ls = 0.f;
    u32x4 wk0[8], wv0[8], wk1[8], wv1[8];
#define DSA_GATHER(WK, WV, CI) { const bool isb_ = (CI) >= ncA; const int ch_ = isb_ ? (CI) - ncA : (CI); const int cnt_ = isb_ ? cntB : cntA; const LAS unsigned short* li_ = isb_ ? listB : listA; \
        int grow = grow_, piece = piece_; asm volatile("" : "+v"(grow), "+v"(piece)); \
        _Pragma("unroll") for (int it = 0; it < 8; ++it) { const int j = ch_ * 64 + it * 8 + grow; const unsigned kidx = (j < cnt_) ? (unsigned)li_[j] : 0u; \
            WK[it] = *(const u32x4*)(krow0 + (size_t)kidx * PW + 8 * piece); WV[it] = *(const u32x4*)(vrow0 + (size_t)kidx * PW + 8 * piece); } }
#define DSA_CHUNK(WK, WV, CI) { const bool isb_ = (CI) >= ncA; const int ch_ = isb_ ? (CI) - ncA : (CI); const int cnt_ = isb_ ? cntB : cntA; \
        if (ch_ == 0) { const bf16* qp = proj + (isb_ ? tokB : tokA) * PW + C_DQ + hd * 64 + 8 * quad; qb0 = *(const bf16x8*)qp; qb1 = *(const bf16x8*)(qp + 32); mrun = -1.0e30f; ls = 0.f; \
            _Pragma("unroll") for (int dt = 0; dt < 4; ++dt) o[dt] = (f32x4){0.f, 0.f, 0.f, 0.f}; } \
        int grow = grow_, piece = piece_; asm volatile("" : "+v"(grow), "+v"(piece)); \
        _Pragma("unroll") for (int it = 0; it < 8; ++it) { const int row = it * 8 + grow; *(LAS u32x4*)(stg + row * 128 + ((piece ^ (row & 7)) * 16)) = WK[it]; } \
        LDS_WAIT(); \
        float sr[4][4]; \
        { int colq = col, quadq = quad; asm volatile("" : "+v"(colq), "+v"(quadq)); \
          _Pragma("unroll") for (int kt = 0; kt < 4; ++kt) { const int row = kt * 16 + colq; \
            const bf16x8 a0 = *(const LAS bf16x8*)(stg + row * 128 + ((quadq ^ (row & 7)) * 16)), a1 = *(const LAS bf16x8*)(stg + row * 128 + (((quadq + 4) ^ (row & 7)) * 16)); \
            f32x4 d = (f32x4){0.f, 0.f, 0.f, 0.f}; d = mfma16(a0, qb0, d); d = mfma16(a1, qb1, d); \
            _Pragma("unroll") for (int i = 0; i < 4; ++i) sr[kt][i] = (ch_ * 64 + kt * 16 + 4 * quadq + i < cnt_) ? d[i] : -3.0e38f; } } \
        float mx = -3.0e38f; \
        _Pragma("unroll") for (int kt = 0; kt < 4; ++kt) _Pragma("unroll") for (int i = 0; i < 4; ++i) mx = fmaxf(mx, sr[kt][i]); \
        mx = red16_max(mx); mx = red32_max(mx); \
        const float mn = fmaxf(mrun, mx), al = fexp2(mrun - mn); mrun = mn; \
        float lc = 0.f; \
        _Pragma("unroll") for (int kt = 0; kt < 4; ++kt) _Pragma("unroll") for (int i = 0; i < 4; ++i) { const float p = fexp2(sr[kt][i] - mn); sr[kt][i] = p; lc += p; } \
        lc = red16_sum(lc); lc = red32_sum(lc); ls = ls * al + lc; \
        _Pragma("unroll") for (int dt = 0; dt < 4; ++dt) o[dt] = o[dt] * al; \
        LDS_WAIT(); \
        _Pragma("unroll") for (int it = 0; it < 8; ++it) { const int row = it * 8 + grow; *(LAS u32x4*)(stg + row * 128 + ((piece ^ (row & 7)) * 16)) = WV[it]; } \
        LDS_WAIT(); \
        { int colp = col, quadp = quad; asm volatile("" : "+v"(colp), "+v"(quadp)); \
          _Pragma("unroll") for (int g = 0; g < 2; ++g) { \
            u32x4 pw; pw.x = cvtpk(sr[2 * g][0], sr[2 * g][1]); pw.y = cvtpk(sr[2 * g][2], sr[2 * g][3]); pw.z = cvtpk(sr[2 * g + 1][0], sr[2 * g + 1][1]); pw.w = cvtpk(sr[2 * g + 1][2], sr[2 * g + 1][3]); \
            const bf16x8 pb = __builtin_bit_cast(bf16x8, pw); \
            const int klo = 32 * g + 4 * quadp + (colp >> 2), khi = klo + 16; \
            _Pragma("unroll") for (int dt = 0; dt < 4; ++dt) { const int pc = 2 * dt + ((colp & 3) >> 1), bo = (colp & 1) * 8; \
                const v4i16_t lo = __builtin_amdgcn_ds_read_tr16_b64_v4i16((LAS v4i16_t*)(stg + klo * 128 + ((pc ^ (klo & 7)) * 16) + bo)); \
                const v4i16_t hi = __builtin_amdgcn_ds_read_tr16_b64_v4i16((LAS v4i16_t*)(stg + khi * 128 + ((pc ^ (khi & 7)) * 16) + bo)); \
                const bf16x8 av = (bf16x8){lo[0], lo[1], lo[2], lo[3], hi[0], hi[1], hi[2], hi[3]}; \
                o[dt] = mfma16(av, pb, o[dt]); } } } \
        LDS_WAIT(); \
        const int nch_ = isb_ ? nc - ncA : ncA; \
        if (ch_ == nch_ - 1 && col < 4) { const float inv = 1.f / ls; bf16* om = (bf16*)(a.ws + WS_B) + (isb_ ? tokB : tokA) * DM + 768 + hd * 64 + 4 * quad; \
            _Pragma("unroll") for (int dt = 0; dt < 4; ++dt) { float v[4] = {o[dt][0] * inv, o[dt][1] * inv, o[dt][2] * inv, o[dt][3] * inv}; st4bf(om + 16 * dt, v); } } }
    if (nc > 0) DSA_GATHER(wk0, wv0, 0)
    for (int ci = 0; ci < nc; ci += 2) {
        if (ci + 1 < nc) DSA_GATHER(wk1, wv1, ci + 1)
        DSA_CHUNK(wk0, wv0, ci)
        if (ci + 1 < nc) {
            if (ci + 2 < nc) DSA_GATHER(wk0, wv0, ci + 2)
            DSA_CHUNK(wk1, wv1, ci + 1)
        }
    }
#undef DSA_GATHER
#undef DSA_CHUNK
}

typedef unsigned short u16x2_t __attribute__((ext_vector_type(2)));
DI unsigned pkmax16(unsigned x, unsigned y) { return __builtin_bit_cast(unsigned, __builtin_elementwise_max(__builtin_bit_cast(u16x2_t, x), __builtin_bit_cast(u16x2_t, y))); }
DI unsigned f2key16s(float f) { const unsigned h = (unsigned)__builtin_bit_cast(unsigned short, (_Float16)f); return h ^ ((unsigned)((int)__float_as_uint(f) >> 31) | 0x8000u); }
DI unsigned f2key16(float f) { const unsigned h = (unsigned)__builtin_bit_cast(unsigned short, (_Float16)f); return (h & 0x8000u) ? (~h & 0xffffu) : (h | 0x8000u); }
template <int NR>
DI int dsa_pick(const LAS unsigned short* s16, const LAS unsigned short* cidx, LAS unsigned short* list, int c, int lane, unsigned long long ltm, unsigned& tau) {
    unsigned ck[16], ixs[16];
#pragma unroll
    for (int j = 0; j < 16; ++j) { ck[j] = 0u; ixs[j] = 0u; }
#pragma unroll
    for (int j = 0; j < NR; ++j) ixs[j] = (unsigned)cidx[j * 64 + lane];
#pragma unroll
    for (int j = 0; j < NR; ++j) ixs[j] = (j * 64 + lane < c) ? ixs[j] : 0u;
#pragma unroll
    for (int j = 0; j < NR; ++j) ck[j] = (unsigned)s16[ixs[j]];
#pragma unroll
    for (int j = 0; j < NR; ++j) ck[j] = (j * 64 + lane < c) ? ck[j] : 0u;
    tau = kth_regn<NR>(ck, 256);
    int cg = 0;
#pragma unroll
    for (int j = 0; j < NR; ++j) cg += (ck[j] > tau) ? 1 : 0;
    const int krem = 256 - wave_sum_i(cg);
    int total = 0, eqt = 0;
#pragma unroll
    for (int j = 0; j < NR; ++j) {
        if (j * 64 < c) {
            const bool gt = ck[j] > tau, eq = ck[j] == tau;
            const unsigned long long eqm = __ballot(eq); const int eqp = __popcll(eqm & ltm);
            const bool take = gt || (eq && (eqt + eqp < krem));
            const unsigned long long tm = __ballot(take); const int pos = total + __popcll(tm & ltm);
            if (take) list[pos] = (unsigned short)ixs[j];
            total += __popcll(tm); eqt += __popcll(eqm);
        }
    }
    return total;
}
DI void dsa_unit16(const Args& a, int pu, LAS unsigned char* lds, int wave, int lane) {
    const bf16* proj = (const bf16*)(a.ws + WS_A);
    const int b = pu >> 9, p = pu & 511;
    const int tA0 = 8 * p, tB0 = 8184 - 8 * p, nA = tA0 + 8, nB = tB0 + 8;
    const int na32 = (nA + 31) & ~31, nb32 = (nB + 31) & ~31;
    LAS unsigned short* sc = (LAS unsigned short*)lds;
    {
        const int c = lane & 31, hh = lane >> 5, qr = c >> 2, hr = c & 3;
        const size_t tokA = (size_t)b * SEQ + tA0, tokB = (size_t)b * SEQ + tB0;
        bf16x8 iqA[4], iqB[4];
#pragma unroll
        for (int s = 0; s < 4; ++s) { iqA[s] = *(const bf16x8*)(proj + (tokA + qr) * PW + C_DIQ + hr * 64 + 16 * s + 8 * hh); iqB[s] = *(const bf16x8*)(proj + (tokB + qr) * PW + C_DIQ + hr * 64 + 16 * s + 8 * hh); }
        f32x4 iwA[4], iwB[4];
#pragma unroll
        for (int g = 0; g < 4; ++g) { iwA[g] = *(const f32x4*)((const float*)(a.ws + WS_IW) + (tokA + 2 * g + hh) * 4); iwB[g] = *(const f32x4*)((const float*)(a.ws + WS_IW) + (tokB + 2 * g + hh) * 4); }
        const bf16* kb = (const bf16*)(a.ws + WS_IKT) + (size_t)b * (SEQ / 32) * 2048;
        const int ntA = na32 >> 5, ntB = nb32 >> 5;
        LAS unsigned short* dA = sc + hh * na32 + c; LAS unsigned short* dB = sc + 8 * na32 + hh * nb32 + c;
#define DSA_EPI(X, IW, T0, DST, PITCH, K0, MASK) { _Pragma("unroll") for (int g = 0; g < 4; ++g) { \
            const float r0 = __builtin_amdgcn_fmed3f(X[4 * g], 0.f, 3.0e38f), r1 = __builtin_amdgcn_fmed3f(X[4 * g + 1], 0.f, 3.0e38f); \
            const float r2 = __builtin_amdgcn_fmed3f(X[4 * g + 2], 0.f, 3.0e38f), r3 = __builtin_amdgcn_fmed3f(X[4 * g + 3], 0.f, 3.0e38f); \
            float a0 = __builtin_fmaf(IW[g].x, r0, 0.f), a1 = __builtin_fmaf(IW[g].y, r1, 0.f); a0 = __builtin_fmaf(IW[g].z, r2, a0); a1 = __builtin_fmaf(IW[g].w, r3, a1); \
            unsigned key = f2key16s(a0 + a1); if (MASK) key = ((K0) + c <= (T0) + 2 * g + hh) ? key : 0u; \
            (DST)[2 * g * (PITCH) + (K0)] = (unsigned short)key; } }
        bf16x8 kf[4], nkf[4];
        if (wave < ntB) ld_kt(kf, kb + (size_t)wave * 2048, c, hh);
        for (int kt = wave; kt < ntB; kt += NWAVES) {
            { const int kn = (kt + NWAVES < ntB) ? kt + NWAVES : kt; ld_kt(nkf, kb + (size_t)kn * 2048, c, hh); }
            const int k0 = kt * 32; const bool hasA = kt < ntA;
            f32x16 x = zero16(), y = zero16();
#pragma unroll
            for (int s = 0; s < 4; ++s) x = mfma32(iqB[s], kf[s], x);
            if (hasA) {
#pragma unroll
                for (int s = 0; s < 4; ++s) y = mfma32(iqA[s], kf[s], y);
            }
            if (k0 + 31 > tB0) DSA_EPI(x, iwB, tB0, dB, nb32, k0, true) else DSA_EPI(x, iwB, tB0, dB, nb32, k0, false)
            if (hasA) { if (k0 + 31 > tA0) DSA_EPI(y, iwA, tA0, dA, na32, k0, true) else DSA_EPI(y, iwA, tA0, dA, na32, k0, false) }
#pragma unroll
            for (int s = 0; s < 4; ++s) kf[s] = nkf[s];
        }
#undef DSA_EPI
    }
    __syncthreads();
    LAS unsigned short* cidx = (LAS unsigned short*)(lds + DSA_CIDX + wave * 2048);
    LAS unsigned short* dummy = (LAS unsigned short*)(lds + DSA_DUMMY + wave * 128) + lane;
    const unsigned long long ltm = (1ull << lane) - 1ull;
    int cntA = 0, cntB = 0;
#pragma unroll 1
    for (int blk = 0; blk < 2; ++blk) {
        const int tq = (blk ? tB0 : tA0) + wave, n = tq + 1, n32 = (blk ? nb32 : na32);
        const LAS unsigned short* s16 = sc + (blk ? 8 * na32 + wave * nb32 : wave * na32);
        LAS unsigned short* list = (LAS unsigned short*)(lds + DSA_LIST + (blk * 8 + wave) * 512);
        int cnt;
        if (n <= 256) { for (int i = lane; i < n; i += 64) list[i] = (unsigned short)i; cnt = n; }
        else {
            int c = 0;
            if (n <= 1024) { for (int i = lane; i < n; i += 64) cidx[i] = (unsigned short)i; c = n; }
            else {
                const bool cs4 = n <= 2048; unsigned M[16];
#pragma unroll
                for (int it = 0; it < 16; ++it) {
                    const int i8 = (cs4 ? (it >> 1) : it) * 512 + lane * 8; unsigned mx = 0u;
                    if (i8 < n32) { const u32x4 v = *(const LAS u32x4*)(s16 + i8);
                        if (cs4) { const unsigned m2 = (it & 1) ? pkmax16(v.z, v.w) : pkmax16(v.x, v.y); mx = max(m2 & 0xffffu, m2 >> 16); }
                        else { const unsigned m4 = pkmax16(pkmax16(v.x, v.y), pkmax16(v.z, v.w)); mx = max(m4 & 0xffffu, m4 >> 16); } }
                    if (cs4 && it >= 8) mx = 0u;
                    M[it] = mx;
                }
                const unsigned beta = kth_disp(M, 256, cs4 ? ((n32 + 255) >> 8) : ((n32 + 511) >> 9));
                for (int i0 = 0; i0 < n32; i0 += 512) {
                    const int i8 = i0 + lane * 8;
                    u32x4 v = (u32x4){0u, 0u, 0u, 0u}; if (i8 < n32) v = *(const LAS u32x4*)(s16 + i8);
                    const unsigned kk[8] = {v.x & 0xffffu, v.x >> 16, v.y & 0xffffu, v.y >> 16, v.z & 0xffffu, v.z >> 16, v.w & 0xffffu, v.w >> 16};
                    int fc = 0;
#pragma unroll
                    for (int k = 0; k < 8; ++k) fc += (kk[k] >= beta) ? 1 : 0;
                    const int inc = wave_incl_scan(fc); int pos = c + inc - fc;
#pragma unroll
                    for (int k = 0; k < 8; ++k) { const bool cd = kk[k] >= beta;
                        LAS unsigned short* d = (cd && pos < 1024) ? (cidx + pos) : dummy; *d = (unsigned short)(i8 + k); pos += cd ? 1 : 0; }
                    c += __builtin_amdgcn_readlane(inc, 63);
                }
                LDS_WAIT();
            }
            unsigned tau; bool fromc = (c <= 1024);
            if (fromc) {
                const int nr = (c + 63) >> 6;
                cnt = nr <= 6 ? dsa_pick<6>(s16, cidx, list, c, lane, ltm, tau) : nr <= 8 ? dsa_pick<8>(s16, cidx, list, c, lane, ltm, tau) : nr <= 12 ? dsa_pick<12>(s16, cidx, list, c, lane, ltm, tau) : dsa_pick<16>(s16, cidx, list, c, lane, ltm, tau);
            } else {
                tau = 0u;
                for (int bit = 15; bit >= 0; --bit) {
                    const unsigned cand = tau | (1u << bit); int cc = 0;
                    for (int i = lane; i < n; i += 64) cc += ((unsigned)s16[i] >= cand) ? 1 : 0;
                    if (wave_sum_i(cc) >= 256) tau = cand;
                }
                int cg = 0;
                for (int i = lane; i < n; i += 64) cg += ((unsigned)s16[i] > tau) ? 1 : 0;
                const int krem = 256 - wave_sum_i(cg);
                int total = 0, eqt = 0;
                for (int i0 = 0; i0 < n; i0 += 64) {
                    const int i = i0 + lane; const unsigned key = (i < n) ? (unsigned)s16[i] : 0u;
                    const bool gt = key > tau, eq = (i < n) && key == tau;
                    const unsigned long long eqm = __ballot(eq); const int eqp = __popcll(eqm & ltm);
                    const bool take = gt || (eq && (eqt + eqp < krem));
                    const unsigned long long tm = __ballot(take); const int pos = total + __popcll(tm & ltm);
                    if (take) list[pos] = (unsigned short)i;
                    total += __popcll(tm); eqt += __popcll(eqm);
                }
                cnt = total;
            }
        }
        if (blk) cntB = cnt; else cntA = cnt;
    }
    __syncthreads();
    dsa_attend2(a, proj, b, (size_t)b * SEQ + tA0 + wave, (const LAS unsigned short*)(lds + DSA_LIST + wave * 512), cntA, (size_t)b * SEQ + tB0 + wave, (const LAS unsigned short*)(lds + DSA_LIST + (8 + wave) * 512), cntB, lds + wave * 16384, lane);
    __syncthreads();
}

#ifndef HOSTDUP
#define HOSTDUP 0
#endif
#ifndef MK_SINGLE
#define MK_SINGLE 1
#endif
constexpr int PRM_OFF = MISC_OFF + 256;
DI void store_args(LAS unsigned char* lds, const Args& k) {
    LAS unsigned long long* q = (LAS unsigned long long*)(lds + PRM_OFF);
    q[0] = (unsigned long long)k.x; q[1] = (unsigned long long)k.pos; q[2] = (unsigned long long)k.w_in; q[3] = (unsigned long long)k.b_f; q[4] = (unsigned long long)k.pe_cmp;
    q[5] = (unsigned long long)k.w_cmp1; q[6] = (unsigned long long)k.w_cmp2; q[7] = (unsigned long long)k.w_gate; q[8] = (unsigned long long)k.w_br; q[9] = (unsigned long long)k.w_o;
    q[10] = (unsigned long long)k.ln1_g; q[11] = (unsigned long long)k.ln1_b; q[12] = (unsigned long long)k.w_router; q[13] = (unsigned long long)k.router_bias;
    q[14] = (unsigned long long)k.w_eg; q[15] = (unsigned long long)k.w_eu; q[16] = (unsigned long long)k.w_ed; q[17] = (unsigned long long)k.w_sg; q[18] = (unsigned long long)k.w_su; q[19] = (unsigned long long)k.w_sd;
    q[20] = (unsigned long long)k.ln2_g; q[21] = (unsigned long long)k.ln2_b; q[22] = (unsigned long long)k.out; q[23] = (unsigned long long)k.ws;
}
DI unsigned long long ldprm(LAS unsigned char* lds, int i) {
    const u32x2 v = *(const LAS u32x2*)(lds + PRM_OFF + 8 * i);
    return ((unsigned long long)(unsigned)__builtin_amdgcn_readfirstlane((int)v.y) << 32) | (unsigned long long)(unsigned)__builtin_amdgcn_readfirstlane((int)v.x);
}
DI Args lds_args(LAS unsigned char* lds) {
    Args a;
    a.x = (const float*)(const GAS float*)ldprm(lds, 0); a.pos = (const int*)(const GAS int*)ldprm(lds, 1); a.w_in = (const float*)(const GAS float*)ldprm(lds, 2); a.b_f = (const float*)(const GAS float*)ldprm(lds, 3); a.pe_cmp = (const float*)(const GAS float*)ldprm(lds, 4);
    a.w_cmp1 = (const float*)(const GAS float*)ldprm(lds, 5); a.w_cmp2 = (const float*)(const GAS float*)ldprm(lds, 6); a.w_gate = (const float*)(const GAS float*)ldprm(lds, 7); a.w_br = (const float*)(const GAS float*)ldprm(lds, 8); a.w_o = (const float*)(const GAS float*)ldprm(lds, 9);
    a.ln1_g = (const float*)(const GAS float*)ldprm(lds, 10); a.ln1_b = (const float*)(const GAS float*)ldprm(lds, 11); a.w_router = (const float*)(const GAS float*)ldprm(lds, 12); a.router_bias = (const float*)(const GAS float*)ldprm(lds, 13);
    a.w_eg = (const float*)(const GAS float*)ldprm(lds, 14); a.w_eu = (const float*)(const GAS float*)ldprm(lds, 15); a.w_ed = (const float*)(const GAS float*)ldprm(lds, 16); a.w_sg = (const float*)(const GAS float*)ldprm(lds, 17); a.w_su = (const float*)(const GAS float*)ldprm(lds, 18); a.w_sd = (const float*)(const GAS float*)ldprm(lds, 19);
    a.ln2_g = (const float*)(const GAS float*)ldprm(lds, 20); a.ln2_b = (const float*)(const GAS float*)ldprm(lds, 21); a.out = (float*)(GAS float*)ldprm(lds, 22); a.ws = (unsigned char*)(GAS unsigned char*)ldprm(lds, 23); a.ph_lo = 0; a.ph_hi = 0;
    return a;
}
#ifndef PHMASK
#define PHMASK 0xffffffffu
#endif
#define PHON(j) (((PHMASK) >> (j)) & 1u)
#define PH_BEGIN const Args a = lds_args(lds); unsigned char* ws = a.ws; (void)ws; \
    const int tid = ltid(), lane = tid & 63, wave = __builtin_amdgcn_readfirstlane(tid >> 6); \
    const int G = lgrid(), bid = lbid(), gw = bid * NWAVES + wave, NGW = G * NWAVES; (void)bid; (void)lane; (void)wave; (void)gw; (void)NGW; (void)G;
#ifndef PH_NOINLINE
#define PHFN DI void
#else
#define PHFN __attribute__((noinline)) __device__ void
#endif

PHFN f_prologue(LAS unsigned char* lds) { PH_BEGIN ph_prologue(a, gw, NGW, lane); }
PHFN f_cvt(LAS unsigned char* lds, int l) { PH_BEGIN ph_cvt(a, l, lds, gw, NGW, wave, lane); }
PHFN f_proj(LAS unsigned char* lds) { PH_BEGIN
    SchedProj S; S.so.init(NTOK, PW, G, bid); S.A = (unsigned)WS_XB; S.B = (unsigned)W_IN;
    EpiProj E; E.proj = (bf16*)(ws + WS_A); E.sm32 = (float*)(ws + WS_SM32);
    gs::gemm_stream<SchedProj, EpiProj, 2>(lds, (const char*)ws, S, E); }
PHFN f_post(LAS unsigned char* lds, int l) { PH_BEGIN ph_post(a, l, lds, wave, lane); }
PHFN f_cmp(LAS unsigned char* lds) { PH_BEGIN
    SchedCmp S; S.kcr = (unsigned)WS_KCR; S.vcr = (unsigned)WS_VCR; S.w = (unsigned)W_C1;
    EpiCmp E; E.hid = (float*)(ws + WS_HID); E.cbias = (const float*)(ws + WS_CBIAS);
    gs::gemm_stream<SchedCmp, EpiCmp, 2>(lds, (const char*)ws, S, E);
    if (bid >= 32 && bid < 64 && wave == 0) cumsum_seq(a, bid - 32, lane);
    if (G < 64 && bid == 0 && wave == 1) for (int q = (G > 32 ? G - 32 : 0); q < 32; ++q) cumsum_seq(a, q, lane); }
PHFN f_cmp2(LAS unsigned char* lds, int l) { PH_BEGIN ph_cmp2(a, l, gw, NGW, lane); }
PHFN f_dsa(LAS unsigned char* lds) { PH_BEGIN for (int pu = bid; pu < NTOK / 16; pu += G) dsa_unit16(a, pu, lds, wave, lane); }
PHFN f_nsa(LAS unsigned char* lds) { PH_BEGIN
    for (int u = gw, r = 0; u < NTOK / 8; u += NGW, ++r) {
        int unit = u;
        if (NGW == 2048) { const int bsel = u >> 10, pos = ((u & 1023) + 256 * r) & 1023; unit = bsel * 1024 + pos; }
        nsa_unit(a, unit, lds + wave * 5120, lane);
    } }
PHFN f_sbfg(LAS unsigned char* lds, int l) { PH_BEGIN
    for (int u = bid; u < 2048; u += G) {
        const int r = u >> 8, blk = u & 255, bh = blk & 31, f = blk >> 5, mixer = r >> 2, rr = r & 3;
        const int QB = (rr == 0) ? f : (rr == 1) ? 31 - f : (rr == 2) ? 8 + f : 23 - f;
        if (mixer == 0) sbfg_block<0>(a, l, bh >> 2, bh & 3, QB, lds, tid, wave, lane); else sbfg_block<1>(a, l, bh >> 2, bh & 3, QB, lds, tid, wave, lane);
        __syncthreads();
    } }
PHFN f_merge(LAS unsigned char* lds) { PH_BEGIN
    SchedMerge S; S.xb = (unsigned)WS_XB; S.om = (unsigned)WS_B; S.wg = (unsigned)W_G; S.wbr = (unsigned)W_BR; S.G = G;
    EpiMerge E; E.merged = (bf16*)(ws + WS_C); E.stash = (u32x4*)(ws + WS_A + (size_t)bid * 65536);
    gs::gemm_stream<SchedMerge, EpiMerge, 1>(lds, (const char*)ws, S, E); }
PHFN f_wo(LAS unsigned char* lds, int l) { PH_BEGIN
    SchedWo S; S.so.init(NTOK, DM, G, bid); S.A = (unsigned)WS_C; S.B = (unsigned)W_O;
    EpiWo E; E.xb = (bf16*)(ws + WS_XB); (void)l;
    gs::gemm_stream<SchedWo, EpiWo, 2>(lds, (const char*)ws, S, E); }
PHFN f_ln1(LAS unsigned char* lds, int l) { PH_BEGIN ph_ln1(a, l, gw, NGW, lane); }
PHFN f_router(LAS unsigned char* lds) { PH_BEGIN
    SchedRouter S; S.xh = (unsigned)WS_XB; S.xl = (unsigned)WS_XL; S.wh = (unsigned)W_RH; S.wl = (unsigned)W_RL; S.G = G;
    EpiRouter E; E.logit = (float*)(ws + WS_LOGIT);
    gs::gemm_stream<SchedRouter, EpiRouter, 1>(lds, (const char*)ws, S, E); }
PHFN f_route(LAS unsigned char* lds, int l) { PH_BEGIN ph_route(a, l, lds, wave, lane); }
PHFN f_e1(LAS unsigned char* lds, int l) { PH_BEGIN
    moe_tables(a, l, lds);
    SchedE1 S; S.ptile = (const LAS int*)(lds + TBL_OFF); S.cntv = S.ptile + 2 * TBLN; S.xb = (unsigned)WS_XB; S.lists = (const unsigned*)(ws + WS_LIST); S.w1 = (unsigned)W_1; S.G = G;
    EpiE1 E; E.hb = (bf16*)(ws + WS_HB);
    gs::gemm_stream<SchedE1, EpiE1, 2>(lds, (const char*)ws, S, E); }
PHFN f_e2(LAS unsigned char* lds, int l, int c) { PH_BEGIN
    moe_tables(a, l, lds);
    SchedE2 S; S.ptile = (const LAS int*)(lds + TBL_OFF); S.ypre = S.ptile + TBLN; S.cntv = S.ptile + 2 * TBLN; S.hb = (unsigned)WS_HB; S.w2 = (unsigned)W_2; S.c = c; S.G = G;
    EpiE2 E; E.y = (unsigned char*)(ws + WS_Y);
    gs::gemm_stream<SchedE2, EpiE2, 2>(lds, (const char*)ws, S, E); }
PHFN f_ln2(LAS unsigned char* lds, int l, int c) { PH_BEGIN moe_tables(a, l, lds); ph_ln2(a, l, c, lds, gw, NGW, lane); }
PHFN f_seam(LAS unsigned char* lds) {
    XcdBarrier bar; bar.bar = (unsigned*)((unsigned char*)(GAS unsigned char*)ldprm(lds, 23) + WS_CTL) + CW_BAR; bar.x = xb_xcc_id(); bar.st = (volatile LAS unsigned*)(lds + MISC_OFF) + 8; xcd_barrier(bar); }

#define IN(k) (lo <= (k) && (k) < hi)
#define SEAM(k) do { if ((k) + 1 < hi) f_seam(lds); } while (0)
DI void run_layer(LAS unsigned char* lds, const int l, const int lo, const int hi) {
        const int pb = 1 + l * NPL;
        if (PHON(0) && IN(pb + 0)) { f_cvt(lds, l); SEAM(pb + 0); }
        if (PHON(1) && IN(pb + 1)) { f_proj(lds); SEAM(pb + 1); }
        if (PHON(2) && IN(pb + 2)) { f_post(lds, l); SEAM(pb + 2); }
        if (PHON(3) && IN(pb + 3)) { f_cmp(lds); __syncthreads(); f_dsa(lds); SEAM(pb + 3); }
        if (PHON(4) && IN(pb + 4)) { f_cmp2(lds, l); __syncthreads(); f_sbfg(lds, l); SEAM(pb + 4); }
        if (PHON(21) && IN(pb + 5)) { f_nsa(lds); SEAM(pb + 5); }
        if (PHON(6) && IN(pb + 6)) { f_merge(lds); SEAM(pb + 6); }
        if (PHON(7) && IN(pb + 7)) { f_wo(lds, l); SEAM(pb + 7); }
        if (PHON(8) && IN(pb + 8)) { f_ln1(lds, l); SEAM(pb + 8); }
        if (PHON(9) && IN(pb + 9)) { f_router(lds); SEAM(pb + 9); }
        if (PHON(10) && IN(pb + 10)) { f_route(lds, l); SEAM(pb + 10); }
        if (PHON(11) && IN(pb + 11)) { f_e1(lds, l); SEAM(pb + 11); }
        for (int c = 0; c < NCH; ++c) {
            if (PHON(12) && IN(pb + 12 + 2 * c)) { f_e2(lds, l, c); SEAM(pb + 12 + 2 * c); }
            if (PHON(13) && IN(pb + 13 + 2 * c)) { f_ln2(lds, l, c); SEAM(pb + 13 + 2 * c); }
        }
}
#undef IN
#undef SEAM
#ifndef DUPMASK
#define DUPMASK 0
#endif
#define DUP(j) (((DUPMASK) >> (j)) & 1)
__global__ void __launch_bounds__(NWAVES * 64, 2) fwd(Args ka) {
    extern __shared__ __attribute__((aligned(16))) unsigned char lds_[];
    LAS unsigned char* lds = (LAS unsigned char*)lds_;
    const int tid = threadIdx.x;
    volatile LAS unsigned* MISC = (volatile LAS unsigned*)(lds + MISC_OFF);
    if (tid < 64) MISC[tid] = 0u;
    if (tid == 64) store_args(lds, ka);
    const int lo = ka.ph_lo, hi = ka.ph_hi;
    __syncthreads();
    if (hi - lo > 1 && tid == 0) (void)xb_add(&((unsigned*)(ka.ws + WS_CTL) + CW_BAR)[XB_XCNT(xb_xcc_id())], 1u);
#define IN(k) (lo <= (k) && (k) < hi)
#define SEAM(k) do { if ((k) + 1 < hi) f_seam(lds); } while (0)
    if (PHON(31) && IN(0)) { f_prologue(lds); SEAM(0); }
    run_layer(lds, 0, lo, hi); run_layer(lds, 1, lo, hi); run_layer(lds, 2, lo, hi); run_layer(lds, 3, lo, hi);
#undef IN
#undef SEAM
}

extern "C" void kernel_launch(void* const* d_in, const int* in_sizes, int n_in, void* d_out, int out_size, void* d_ws, size_t ws_size, hipStream_t stream) {
    static int grid = 0;
    if (grid == 0) {
        if (n_in != 22 || in_sizes[0] != NTOK * DM || out_size != NTOK * DM || ws_size < WS_END) {
            fprintf(stderr, "kernel_launch: unexpected shapes/workspace: n_in %d in0 %d out %d ws %zu (need %zu)\n", n_in, n_in > 0 ? in_sizes[0] : -1, out_size, ws_size, (size_t)WS_END); grid = -1; return; }
        int dev = 0, cus = 0, per_cu = 0;
        if (hipGetDevice(&dev) != hipSuccess || hipDeviceGetAttribute(&cus, hipDeviceAttributeMultiprocessorCount, dev) != hipSuccess) { grid = -1; return; }
        if (hipFuncSetAttribute((const void*)fwd, hipFuncAttributeMaxDynamicSharedMemorySize, LDS_BYTES) != hipSuccess) { fprintf(stderr, "kernel_launch: hipFuncSetAttribute failed\n"); grid = -1; return; }
        if (hipOccupancyMaxActiveBlocksPerMultiprocessor(&per_cu, (const void*)fwd, NWAVES * 64, LDS_BYTES) != hipSuccess || per_cu < 1)
            fprintf(stderr, "kernel_launch: occupancy query reports %d blocks per CU\n", per_cu);
        (void)hipGetLastError();
        grid = cus;
    }
    if (grid < 0) return;
    (void)hipMemsetAsync((char*)d_ws + WS_CTL, 0, CTL_ZERO_BYTES, stream);
    Args a{};
    a.x = (const float*)d_in[0]; a.pos = (const int*)d_in[1]; a.w_in = (const float*)d_in[2]; a.b_f = (const float*)d_in[3]; a.pe_cmp = (const float*)d_in[4];
    a.w_cmp1 = (const float*)d_in[5]; a.w_cmp2 = (const float*)d_in[6]; a.w_gate = (const float*)d_in[7]; a.w_br = (const float*)d_in[8]; a.w_o = (const float*)d_in[9];
    a.ln1_g = (const float*)d_in[10]; a.ln1_b = (const float*)d_in[11]; a.w_router = (const float*)d_in[12]; a.router_bias = (const float*)d_in[13];
    a.w_eg = (const float*)d_in[14]; a.w_eu = (const float*)d_in[15]; a.w_ed = (const float*)d_in[16]; a.w_sg = (const float*)d_in[17]; a.w_su = (const float*)d_in[18]; a.w_sd = (const float*)d_in[19];
    a.ln2_g = (const float*)d_in[20]; a.ln2_b = (const float*)d_in[21];
    a.out = (float*)d_out; a.ws = (unsigned char*)d_ws;
#if MK_SINGLE
    a.ph_lo = 0; a.ph_hi = NPHASE;
    hipLaunchKernelGGL(fwd, dim3(grid), dim3(NWAVES * 64), LDS_BYTES, stream, a);
#else
    for (int p = 0; p < NPHASE; ++p) { a.ph_lo = p; a.ph_hi = p + 1; hipLaunchKernelGGL(fwd, dim3(grid), dim3(NWAVES * 64), LDS_BYTES, stream, a);
        if (p > 0 && ((HOSTDUP >> ((p - 1) % NPL)) & 1)) hipLaunchKernelGGL(fwd, dim3(grid), dim3(NWAVES * 64), LDS_BYTES, stream, a); }
#endif
}
```

```cpp
#include <hip/hip_runtime.h>
#include <cstdio>
#include <cstdint>

#define GAS __attribute__((address_space(1)))
#define LAS __attribute__((address_space(3)))
typedef unsigned short bf16;
typedef short bf16x8 __attribute__((ext_vector_type(8)));
typedef float f32x4 __attribute__((ext_vector_type(4)));
typedef float f32x2 __attribute__((ext_vector_type(2)));
typedef float f32x16 __attribute__((ext_vector_type(16)));
typedef unsigned u32x4 __attribute__((ext_vector_type(4)));
typedef unsigned u32x2 __attribute__((ext_vector_type(2)));
typedef __bf16 bf16x2_t __attribute__((ext_vector_type(2)));
typedef GAS unsigned gu32;

#define DI __device__ __forceinline__
#define LDS_WAIT() asm volatile("s_waitcnt lgkmcnt(0)" ::: "memory")
#define VM_WAIT() asm volatile("s_waitcnt vmcnt(0)" ::: "memory")
#define RLX_AGENT __ATOMIC_RELAXED, __HIP_MEMORY_SCOPE_AGENT

constexpr int NBATCH = 8, SEQ = 8192, NTOK = NBATCH * SEQ, DM = 1024, DEPTH = 4;
constexpr int PW = 3136;
constexpr int C_AQ = 0, C_BQ = 256, C_BK = 512, C_BV = 768, C_CQ = 1024, C_CK = 1280, C_CV = 1536, C_DQ = 1792, C_DIQ = 2048,
              C_AKC = 2304, C_AVC = 2368, C_AKS = 2432, C_AVS = 2496, C_AKW = 2560, C_AVW = 2624, C_DK = 2688, C_DV = 2752, C_DIK = 2816, C_SM = 2880;
constexpr int IN_W = 2900;
constexpr float QS = 0.18033688011112042f;
constexpr float LOG2E = 1.4426950408889634f;
constexpr float ALPHA = 1.681792830507429f;
constexpr float LN_EPS = 1e-5f;
constexpr int NEXP = 64, NCH = 2, CHTOK = NTOK / NCH;
constexpr int NPL = 12 + 2 * NCH;
constexpr int NPHASE = 1 + DEPTH * NPL;
constexpr int NWAVES = 8;

constexpr size_t MiB = 1u << 20;
constexpr size_t WS_CTL = 0, CTL_ZERO_BYTES = 1 * MiB;
constexpr size_t WS_ROPE = 1 * MiB;
constexpr size_t WS_SM32 = 5 * MiB;
constexpr size_t WS_GATE = 13 * MiB;
constexpr size_t WS_LOGF = 16 * MiB;
constexpr size_t WS_CUM  = 17 * MiB;
constexpr size_t WS_IW   = 18 * MiB;
constexpr size_t WS_HID  = 19 * MiB;
constexpr size_t WS_KCMP = 21 * MiB;
constexpr size_t WS_VTCMP = 21 * MiB + 512 * 1024;
constexpr size_t WS_CBIAS = 22 * MiB;
constexpr size_t WS_KCR  = 23 * MiB;
constexpr size_t WS_VCR  = 32 * MiB;
constexpr size_t WS_VT   = 41 * MiB;
constexpr size_t WS_VTB = WS_VT, WS_VTC = WS_VT + 32 * MiB, WS_VTAS = WS_VT + 64 * MiB, WS_VTAW = WS_VT + 72 * MiB;
constexpr size_t WS_LOGIT = WS_VT;
constexpr size_t WS_TOKINFO = WS_VT + 16 * MiB;
constexpr size_t WS_LIST = WS_VT + 20 * MiB;
constexpr size_t WS_W    = 121 * MiB;
constexpr size_t W_IN = WS_W, W_G = WS_W + 6 * MiB, W_BR = WS_W + 14 * MiB, W_O = WS_W + 16 * MiB, W_C1 = WS_W + 18 * MiB,
                 W_RH = WS_W + 20 * MiB, W_RL = WS_W + 20 * MiB + 512 * 1024, W_1 = WS_W + 21 * MiB, W_2 = WS_W + 86 * MiB;
constexpr size_t WS_XB   = 243 * MiB;
constexpr size_t WS_A    = 371 * MiB;
constexpr size_t WS_B    = 763 * MiB;
constexpr size_t WS_C    = 891 * MiB;
constexpr size_t WS_END  = 1019 * MiB;
constexpr size_t WS_KTS = WS_C, WS_KTW = WS_C + 8 * MiB, WS_IKT = WS_C + 16 * MiB, WS_KTB = WS_C + 32 * MiB, WS_KTC = WS_C + 64 * MiB;
constexpr size_t WS_XL = WS_A, WS_HB = WS_A, WS_Y = WS_A + 320 * MiB;
static_assert(WS_Y + (size_t)(CHTOK * 8 / 256 + 64 + CHTOK / 256) * 256 * DM <= WS_END, "tile-padded fp8 y chunk fits");
constexpr int HB_TILES = NTOK * 8 / 256 + NCH * 64 + NTOK / 256;
static_assert((size_t)HB_TILES * 256 * 512 <= 320 * MiB, "hbuf fits");

constexpr int CW_BAR = 4096;
constexpr int CW_CNT = 16384;
constexpr int CW_KMAX = 32768;

constexpr int RING_BYTES = 131072;
constexpr int MISC_OFF = 162816;
constexpr int LDS_BYTES = 163840;

DI unsigned cvtpk(float lo, float hi) { f32x2 v = {lo, hi}; bf16x2_t b = __builtin_convertvector(v, bf16x2_t); return __builtin_bit_cast(unsigned, b); }
DI u32x4 pack8(const f32x4& v0, const f32x4& v1) { u32x4 w; w.x = cvtpk(v0[0], v0[1]); w.y = cvtpk(v0[2], v0[3]); w.z = cvtpk(v1[0], v1[1]); w.w = cvtpk(v1[2], v1[3]); return w; }
DI float bf2f(unsigned short h) { return __uint_as_float(((unsigned)h) << 16); }
DI float bflo(unsigned w) { return __uint_as_float(w << 16); }
DI float bfhi(unsigned w) { return __uint_as_float(w & 0xffff0000u); }
DI float fexp2(float x) { return __builtin_amdgcn_exp2f(x); }
DI float flog2(float x) { return __builtin_amdgcn_logf(x); }
DI float frcp(float x) { return __builtin_amdgcn_rcpf(x); }
DI float sigmoidf_(float x) { return frcp(1.f + fexp2(-x * LOG2E)); }
#define DPPF(v, ctrl, rm, bc) __int_as_float(__builtin_amdgcn_update_dpp(0, __float_as_int(v), (ctrl), (rm), 0xF, (bc)))
#define DPPI(v, ctrl, rm, bc) __builtin_amdgcn_update_dpp(0, (v), (ctrl), (rm), 0xF, (bc))
DI float dpp_xor1(float v) { return DPPF(v, 0xB1, 0xF, true); }
DI float dpp_xor2(float v) { return DPPF(v, 0x4E, 0xF, true); }
DI float red16_sum(float v) { const auto r = __builtin_amdgcn_permlane16_swap(__float_as_uint(v), __float_as_uint(v), false, false); return __uint_as_float(r[0]) + __uint_as_float(r[1]); }
DI float red16_max(float v) { const auto r = __builtin_amdgcn_permlane16_swap(__float_as_uint(v), __float_as_uint(v), false, false); return fmaxf(__uint_as_float(r[0]), __uint_as_float(r[1])); }
DI float red32_sum(float v) { const auto r = __builtin_amdgcn_permlane32_swap(__float_as_uint(v), __float_as_uint(v), false, false); return __uint_as_float(r[0]) + __uint_as_float(r[1]); }
DI float red32_max(float v) { const auto r = __builtin_amdgcn_permlane32_swap(__float_as_uint(v), __float_as_uint(v), false, false); return fmaxf(__uint_as_float(r[0]), __uint_as_float(r[1])); }
DI float wave_sum(float v) {
    v += dpp_xor1(v); v += dpp_xor2(v); v += DPPF(v, 0x124, 0xF, true); v += DPPF(v, 0x128, 0xF, true);
    v = red16_sum(v); return red32_sum(v);
}
DI float wave_max(float v) {
    v = fmaxf(v, dpp_xor1(v)); v = fmaxf(v, dpp_xor2(v)); v = fmaxf(v, DPPF(v, 0x124, 0xF, true)); v = fmaxf(v, DPPF(v, 0x128, 0xF, true));
    v = red16_max(v); return red32_max(v);
}
DI int wave_incl_scan(int v) {
    v += DPPI(v, 0x111, 0xF, true); v += DPPI(v, 0x112, 0xF, true); v += DPPI(v, 0x114, 0xF, true); v += DPPI(v, 0x118, 0xF, true);
    v += DPPI(v, 0x142, 0xA, false);
    v += DPPI(v, 0x143, 0xC, false);
    return v;
}
DI float wave_incl_scan_f(float v) {
    v += DPPF(v, 0x111, 0xF, true); v += DPPF(v, 0x112, 0xF, true); v += DPPF(v, 0x114, 0xF, true); v += DPPF(v, 0x118, 0xF, true);
    v += DPPF(v, 0x142, 0xA, false); v += DPPF(v, 0x143, 0xC, false);
    return v;
}
DI int ltid() { int t = threadIdx.x; asm volatile("" : "+v"(t)); return t; }
DI int lbid() { int b = blockIdx.x; asm volatile("" : "+s"(b)); return b; }
DI int lgrid() { int g = gridDim.x; asm volatile("" : "+s"(g)); return g; }
DI f32x16 mfma32(bf16x8 a, bf16x8 b, f32x16 c) { return __builtin_amdgcn_mfma_f32_32x32x16_bf16(a, b, c, 0, 0, 0); }
DI f32x4 mfma16(bf16x8 a, bf16x8 b, f32x4 c) { return __builtin_amdgcn_mfma_f32_16x16x32_bf16(a, b, c, 0, 0, 0); }

#define XB_TMO      128
#define XB_XCNT(j)  (256  + 64 * (j))
#define XB_XSUB(j)  (1280 + 64 * (j))
#define XB_XGEN(j)  (2304 + 64 * (j))
#define XB_TOP      3328
#define XB_TOPGEN   3392
#define XCD_BAR_WORDS 3456
#define XB_SPIN_CAP (1u << 22)
DI unsigned xb_ld(unsigned* p)              { return __hip_atomic_load(p, __ATOMIC_RELAXED, __HIP_MEMORY_SCOPE_AGENT); }
DI unsigned xb_add(unsigned* p, unsigned v) { return __hip_atomic_fetch_add(p, v, __ATOMIC_RELAXED, __HIP_MEMORY_SCOPE_AGENT); }
DI unsigned xb_xcc_id() { return (unsigned)__builtin_amdgcn_s_getreg((3 << 11) | 20) & 0xFu; }
#define XB_SPIN(cond, bar) do { unsigned _sp = 0; while (cond) { __builtin_amdgcn_s_sleep(1); \
    if ((++_sp & 255u) == 0u) { if (xb_ld(&(bar)[XB_TMO])) break; if (_sp > XB_SPIN_CAP) { atomicAdd(&(bar)[XB_TMO], 1u); break; } } } } while (0)
struct XcdBarrier { unsigned* bar; unsigned x; volatile LAS unsigned* st; };
DI XcdBarrier xcd_barrier_post(unsigned* bar, volatile LAS unsigned* st) {
    XcdBarrier b; b.bar = bar; b.x = xb_xcc_id(); b.st = st;
    if (threadIdx.x == 0) (void)xb_add(&bar[XB_XCNT(b.x)], 1u);
    return b;
}
DI void xcd_barrier_complete(unsigned* bar, unsigned x, unsigned& nloc, unsigned& nx) {
    const unsigned G = gridDim.x * gridDim.y * gridDim.z;
    unsigned sum, cnt, mine, sp = 0u;
    for (;;) {
        sum = 0u; cnt = 0u; mine = 0u;
#pragma unroll
        for (unsigned j = 0; j < 16; ++j) { const unsigned c = xb_ld(&bar[XB_XCNT(j)]); sum += c; cnt += (c > 0u) ? 1u : 0u; mine = (j == x) ? c : mine; }
        if (sum == G) break;
        __builtin_amdgcn_s_sleep(1);
        if ((++sp & 255u) == 0u) { if (xb_ld(&bar[XB_TMO])) break; if (sp > XB_SPIN_CAP) { atomicAdd(&bar[XB_TMO], 1u); break; } }
    }
    nloc = mine > 0u ? mine : 1u; nx = cnt > 0u ? cnt : 1u;
}
DI void xcd_barrier(const XcdBarrier& b) {
    asm volatile("s_waitcnt vmcnt(0)" ::: "memory");
    __syncthreads();
    if (threadIdx.x == 0) {
        unsigned* bar = b.bar;
        __builtin_amdgcn_s_waitcnt(0);
        unsigned nloc = b.st[0], nx = b.st[1];
        if (nloc == 0u) { xcd_barrier_complete(bar, b.x, nloc, nx); b.st[0] = nloc; b.st[1] = nx; }
        const unsigned old = xb_add(&bar[XB_XSUB(b.x)], 1u);
        const unsigned gen = old / nloc;
        if (old + 1u == (gen + 1u) * nloc) {
            __builtin_amdgcn_fence(__ATOMIC_RELEASE, "agent");
            asm volatile("s_waitcnt vmcnt(0)" ::: "memory");
            const unsigned og = xb_add(&bar[XB_TOP], 1u);
            const unsigned tg = og / nx;
            if (og + 1u == (tg + 1u) * nx) xb_add(&bar[XB_TOPGEN], 1u);
            else XB_SPIN(xb_ld(&bar[XB_TOPGEN]) == tg, bar);
            __builtin_amdgcn_fence(__ATOMIC_ACQUIRE, "agent");
            xb_add(&bar[XB_XGEN(b.x)], 1u);
            asm volatile("s_waitcnt vmcnt(0)" ::: "memory");
        } else {
            XB_SPIN(xb_ld(&bar[XB_XGEN(b.x)]) == gen, bar);
            __builtin_amdgcn_fence(__ATOMIC_ACQUIRE, "agent");
            asm volatile("s_waitcnt vmcnt(0)" ::: "memory");
        }
    }
    __syncthreads();
}

namespace gs {
constexpr int BM = 256, BK = 64, HALF = 128, HTB = HALF * BK * 2, NXCD = 8, WGM = 8;
__host__ __device__ __forceinline__ int lds_byte(int r, int c) { const int st = (r >> 4) * 2 + (c >> 5), rr = r & 15, cc = c & 31, ob = rr * 64 + cc * 2; return st * 1024 + (ob ^ (((ob >> 9) & 1) << 5)); }
__host__ __device__ __forceinline__ void stage_rc(int b, int& R, int& C) { const int st = b / 1024, sb = b % 1024, swz = sb ^ (((sb >> 9) & 1) << 5); R = (st >> 1) * 16 + swz / 64; C = (st & 1) * 32 + (swz % 64) / 2; }
__host__ __device__ __forceinline__ int perm32(int rho) { const int n = rho >> 4, i = rho & 15; return 8 * (i >> 2) + 4 * n + (i & 3); }
__host__ __device__ __forceinline__ int bh8row(int R) { return (R >> 5) * 64 + 16 * ((R & 15) >> 2) + 4 * ((R >> 4) & 1) + (R & 3); }

struct GU {
    unsigned A, B; const int* idx;
    unsigned lda, ldb;
    int nt;
    int flags;
    int nvalid;
    int a0, a1, a2, a3;
};
struct Unit { int pm, pn; };
struct StaticOrder {
    int nM, nN, nwg, G, c;
    DI void init(int M, int N, int G_, int c_) { nM = M / BM; nN = N / BM; nwg = nM * nN; G = G_; c = c_; }
    DI bool next(int i, Unit& u) const {
        const long L = (long)i * G + c; if (L >= nwg) return false;
        int wgid = (int)L; { const int q = nwg / NXCD, r = nwg % NXCD, xcd = wgid % NXCD, off = wgid / NXCD; wgid = (xcd < r ? xcd * (q + 1) : r * (q + 1) + (xcd - r) * q) + off; }
        const int nig = WGM * nN, gid = wgid / nig, fm = gid * WGM, gsz = (nM - fm) < WGM ? (nM - fm) : WGM;
        u.pm = fm + ((wgid % nig) % gsz); u.pn = (wgid % nig) / gsz; return true;
    }
};

template <class Sched, class Epi, int NBH>
DI void gemm_stream(LAS unsigned char* lds, const char* wsb, Sched& S, Epi& E) {
    constexpr bool GATH = Sched::GATHER, FIXED = Sched::FIXED;
    const int tid = ltid(), wid = __builtin_amdgcn_readfirstlane(tid >> 6), lane = tid & 63, wr = wid >> 2, wc = wid & 3, fr = lane & 15, fq = lane >> 4;
    int R0, C0, R1, C1; stage_rc(tid * 16, R0, C0); stage_rc(tid * 16 + 8192, R1, C1);
    const unsigned Rb0 = Epi::BH8 ? (unsigned)bh8row(R0) : Epi::PERM ? ((R0 & ~31) + perm32(R0 & 31)) : R0, Rb1 = Epi::BH8 ? (unsigned)bh8row(R1) : Epi::PERM ? ((R1 & ~31) + perm32(R1 & 31)) : R1;
    constexpr unsigned BHS = Epi::BH8 ? 8u : (unsigned)HALF;
    const unsigned C0b = (unsigned)C0 * 2u, C1b = (unsigned)C1 * 2u;
    const unsigned ldsw = (unsigned)wid * 1024u;
    const int aoff = lds_byte(wr * 64 + fr, fq * 8), boff = lds_byte(wc * 32 + fr, fq * 8);
#define GS_SA(b, h) (((b) * 2 + (h)) * HTB)
#define GS_SB(b, h) ((4 + (b) * 2 + (h)) * HTB)
#define GS_STG_O(bufoff, gbase, o0, o1) do { \
        unsigned _q0 = (gbase) + (o0), _q1 = (gbase) + (o1); asm volatile("" : "+v"(_q0), "+v"(_q1)); \
        __builtin_amdgcn_global_load_lds((const unsigned*)(wsb + (size_t)_q0), (LAS unsigned*)(lds + (bufoff) + ldsw), 16, 0, 0); \
        __builtin_amdgcn_global_load_lds((const unsigned*)(wsb + (size_t)_q1), (LAS unsigned*)(lds + (bufoff) + ldsw + 8192), 16, 0, 0); } while (0)
#define GS_STGA(bufoff, gbase, h, r0, r1, ld) do { if constexpr (FIXED) GS_STG_O(bufoff, (gbase) + (unsigned)(h) * HALF * (ld), fa0, fa1); \
        else GS_STG_O(bufoff, gbase, (unsigned)(r0) * (ld) + C0b, (unsigned)(r1) * (ld) + C1b); } while (0)
#define GS_STGB(bufoff, gbase, h, ld) do { if constexpr (FIXED) GS_STG_O(bufoff, (gbase) + (unsigned)(h) * BHS * (ld), fb0, fb1); \
        else GS_STG_O(bufoff, (gbase) + (unsigned)(h) * BHS * (ld), Rb0 * (ld) + C0b, Rb1 * (ld) + C1b); } while (0)
#define GS_LDA(dst, b, h) do { _Pragma("unroll") for (int m = 0; m < 4; ++m) _Pragma("unroll") for (int k = 0; k < 2; ++k) dst[m][k] = *(const LAS bf16x8*)(lds + GS_SA(b, h) + aoff + m * 2048 + k * 1024); } while (0)
#define GS_LDB(dst, b, h) do { _Pragma("unroll") for (int n = 0; n < 2; ++n) _Pragma("unroll") for (int k = 0; k < 2; ++k) dst[n][k] = *(const LAS bf16x8*)(lds + GS_SB(b, h) + boff + n * 2048 + k * 1024); } while (0)
#define GS_MMA(ai, bj, At, Bt) do { __builtin_amdgcn_s_setprio(1); _Pragma("unroll") for (int m = 0; m < 4; ++m) _Pragma("unroll") for (int n = 0; n < 2; ++n) _Pragma("unroll") for (int k = 0; k < 2; ++k) \
        acc[ai][bj][m][n] = __builtin_amdgcn_mfma_f32_16x16x32_bf16(Bt[n][k], At[m][k], acc[ai][bj][m][n], 0, 0, 0); __builtin_amdgcn_s_setprio(0); } while (0)
#define GS_WAIT_V(n) asm volatile("s_waitcnt vmcnt(" #n ")" ::: "memory")
#define GS_WAIT_L(n) asm volatile("s_waitcnt lgkmcnt(" #n ")" ::: "memory")
#define GS_BAR __builtin_amdgcn_s_barrier()
#define GS_SCHED __builtin_amdgcn_sched_barrier(0)
#define GS_ROWS(u, ia) do { if (GATH) { if ((u).idx) { \
            ia[0] = R0 < (u).nvalid ? (unsigned)(u).idx[R0] : 0u; ia[1] = R1 < (u).nvalid ? (unsigned)(u).idx[R1] : 0u; \
            ia[2] = HALF + R0 < (u).nvalid ? (unsigned)(u).idx[HALF + R0] : 0u; ia[3] = HALF + R1 < (u).nvalid ? (unsigned)(u).idx[HALF + R1] : 0u; } \
        else { ia[0] = R0; ia[1] = R1; ia[2] = HALF + R0; ia[3] = HALF + R1; } } } while (0)
    GU cur, nxt; int ui = 0;
    if (!S.next(0, cur)) return;
    f32x4 acc[2][NBH][4][2];
#pragma unroll
    for (int a = 0; a < 2; ++a)
#pragma unroll
        for (int b = 0; b < NBH; ++b)
#pragma unroll
            for (int m = 0; m < 4; ++m)
#pragma unroll
                for (int n = 0; n < 2; ++n) acc[a][b][m][n] = (f32x4){0.f, 0.f, 0.f, 0.f};
    bf16x8 At[4][2], B0[2][2], B1[2][2];
    unsigned ia[4] = {(unsigned)R0, (unsigned)R1, (unsigned)(HALF + R0), (unsigned)(HALF + R1)}, na[4] = {(unsigned)R0, (unsigned)R1, (unsigned)(HALF + R0), (unsigned)(HALF + R1)};
    GS_ROWS(cur, ia);
    unsigned cA = cur.A, cB = cur.B;
    unsigned lda = cur.lda, ldb = cur.ldb;
    const unsigned fa0 = (unsigned)R0 * lda + C0b, fa1 = (unsigned)R1 * lda + C1b, fb0 = Rb0 * ldb + C0b, fb1 = Rb1 * ldb + C1b;
    if constexpr (NBH == 2) {
        GS_STGB(GS_SB(0, 0), cB, 0, ldb); GS_STGB(GS_SB(0, 1), cB, 1, ldb); GS_STGA(GS_SA(0, 0), cA, 0, ia[0], ia[1], lda); GS_STGA(GS_SA(0, 1), cA, 1, ia[2], ia[3], lda);
        if (wr == 1) GS_BAR;
        GS_WAIT_V(2); GS_BAR;
        GS_STGB(GS_SB(1, 0), cB + 128, 0, ldb); GS_STGA(GS_SA(1, 0), cA + 128, 0, ia[0], ia[1], lda); GS_STGB(GS_SB(1, 1), cB + 128, 1, ldb);
        GS_WAIT_V(6); GS_BAR;
    } else {
        GS_STGB(GS_SB(0, 0), cB, 0, ldb); GS_STGA(GS_SA(0, 0), cA, 0, ia[0], ia[1], lda); GS_STGA(GS_SA(0, 1), cA, 1, ia[2], ia[3], lda);
        if (wr == 1) GS_BAR;
        GS_WAIT_V(2); GS_BAR;
        GS_STGB(GS_SB(1, 0), cB + 128, 0, ldb); GS_STGA(GS_SA(1, 0), cA + 128, 0, ia[0], ia[1], lda);
        GS_WAIT_V(4); GS_BAR;
    }
    for (;;) {
        const bool has_next = S.next(ui + 1, nxt);
        unsigned nA = cA, nB = cB, nlda = lda, nldb = ldb;
        if (has_next) { GS_ROWS(nxt, na); nA = nxt.A; nB = nxt.B; nlda = nxt.lda; nldb = nxt.ldb; }
        else if (GATH) { na[0] = ia[0]; na[1] = ia[1]; na[2] = ia[2]; na[3] = ia[3]; }
        const int nt = cur.nt;
        for (int t = 0; t < nt; t += 2) {
            const bool last = (t == nt - 2);
            const unsigned a1 = cA + (unsigned)(t + 1) * 128u;
            const unsigned a2 = last ? nA : cA + (unsigned)(t + 2) * 128u, b2 = last ? nB : cB + (unsigned)(t + 2) * 128u;
            const unsigned a3 = a2 + 128u, b3 = b2 + 128u;
            const unsigned xlda = last ? nlda : lda, xldb = last ? nldb : ldb;
            unsigned x0, x1, x2, x3;
            if (GATH) { x0 = last ? na[0] : ia[0]; x1 = last ? na[1] : ia[1]; x2 = last ? na[2] : ia[2]; x3 = last ? na[3] : ia[3]; }
            else { x0 = R0; x1 = R1; x2 = HALF + R0; x3 = HALF + R1; }
            if constexpr (NBH == 2) {
                GS_LDB(B0, 0, 0); GS_LDB(B1, 0, 1); GS_SCHED; GS_LDA(At, 0, 0); GS_STGA(GS_SA(1, 1), a1, 1, ia[2], ia[3], lda);
                GS_WAIT_V(8); GS_WAIT_L(0); GS_BAR; GS_MMA(0, 0, At, B0); GS_MMA(0, 1, At, B1); GS_BAR; GS_SCHED;
                GS_LDA(At, 0, 1); GS_STGB(GS_SB(0, 0), b2, 0, xldb); GS_STGB(GS_SB(0, 1), b2, 1, xldb); GS_STGA(GS_SA(0, 0), a2, 0, x0, x1, xlda);
                GS_WAIT_V(8); GS_WAIT_L(0); GS_BAR; GS_MMA(1, 0, At, B0); GS_MMA(1, 1, At, B1); GS_BAR; GS_SCHED;
                GS_LDB(B0, 1, 0); GS_LDB(B1, 1, 1); GS_SCHED; GS_LDA(At, 1, 0); GS_STGA(GS_SA(0, 1), a2, 1, x2, x3, xlda);
                GS_WAIT_V(8); GS_WAIT_L(0); GS_BAR; GS_MMA(0, 0, At, B0); GS_MMA(0, 1, At, B1); GS_BAR; GS_SCHED;
                GS_LDA(At, 1, 1); GS_STGB(GS_SB(1, 0), b3, 0, xldb); GS_STGB(GS_SB(1, 1), b3, 1, xldb); GS_STGA(GS_SA(1, 0), a3, 0, x0, x1, xlda);
                GS_WAIT_V(8); GS_WAIT_L(0); GS_BAR; GS_MMA(1, 0, At, B0); GS_MMA(1, 1, At, B1); GS_BAR; GS_SCHED;
            } else {
                GS_LDB(B0, 0, 0); GS_SCHED; GS_LDA(At, 0, 0); GS_STGA(GS_SA(1, 1), a1, 1, ia[2], ia[3], lda);
                GS_WAIT_V(6); GS_WAIT_L(0); GS_BAR; GS_MMA(0, 0, At, B0); GS_BAR; GS_SCHED;
                GS_LDA(At, 0, 1); GS_STGB(GS_SB(0, 0), b2, 0, xldb); GS_STGA(GS_SA(0, 0), a2, 0, x0, x1, xlda);
                GS_WAIT_V(6); GS_WAIT_L(0); GS_BAR; GS_MMA(1, 0, At, B0); GS_BAR; GS_SCHED;
                GS_LDB(B0, 1, 0); GS_SCHED; GS_LDA(At, 1, 0); GS_STGA(GS_SA(0, 1), a2, 1, x2, x3, xlda);
                GS_WAIT_V(6); GS_WAIT_L(0); GS_BAR; GS_MMA(0, 0, At, B0); GS_BAR; GS_SCHED;
                GS_LDA(At, 1, 1); GS_STGB(GS_SB(1, 0), b3, 0, xldb); GS_STGA(GS_SA(1, 0), a3, 0, x0, x1, xlda);
                GS_WAIT_V(6); GS_WAIT_L(0); GS_BAR; GS_MMA(1, 0, At, B0); GS_BAR; GS_SCHED;
            }
        }
        if (cur.flags & 2) {
            if (wr == 0) GS_BAR;
            E(acc, cur, wr, wc, fr, fq);
        }
        if (!has_next) break;
        if (nxt.flags & 1) {
#pragma unroll
            for (int a = 0; a < 2; ++a)
#pragma unroll
                for (int b = 0; b < NBH; ++b)
#pragma unroll
                    for (int m = 0; m < 4; ++m)
#pragma unroll
                        for (int n = 0; n < 2; ++n) acc[a][b][m][n] = (f32x4){0.f, 0.f, 0.f, 0.f};
        }
        const bool did_epi = (cur.flags & 2) != 0;
        cur = nxt; cA = nA; cB = nB; lda = nlda; ldb = nldb; ++ui;
        if (GATH) { ia[0] = na[0]; ia[1] = na[1]; ia[2] = na[2]; ia[3] = na[3]; }
        if (did_epi) { if (wr == 1) GS_BAR; }
    }
    GS_WAIT_V(0);
    if (!(cur.flags & 2)) { if (wr == 0) GS_BAR; }
    GS_BAR;
#undef GS_SA
#undef GS_SB
#undef GS_STG_O
#undef GS_STGA
#undef GS_STGB
#undef GS_LDA
#undef GS_LDB
#undef GS_MMA
#undef GS_WAIT_V
#undef GS_WAIT_L
#undef GS_BAR
#undef GS_SCHED
#undef GS_ROWS
}
}

struct Args {
    const float* x; const int* pos; const float* w_in; const float* b_f; const float* pe_cmp; const float* w_cmp1; const float* w_cmp2;
    const float* w_gate; const float* w_br; const float* w_o; const float* ln1_g; const float* ln1_b; const float* w_router; const float* router_bias;
    const float* w_eg; const float* w_eu; const float* w_ed; const float* w_sg; const float* w_su; const float* w_sd; const float* ln2_g; const float* ln2_b;
    float* out; unsigned char* ws; int ph_lo, ph_hi;
};

DI void ph_prologue(const Args& a, int gw, int NGW, int lane) {
    bf16* xb = (bf16*)(a.ws + WS_XB);
    for (int row = gw; row < NTOK; row += NGW) {
        const f32x4* xr = (const f32x4*)(a.x + (size_t)row * DM) + lane;
        u32x2* o = (u32x2*)(xb + (size_t)row * DM) + lane;
#pragma unroll
        for (int j = 0; j < 4; ++j) { const f32x4 v = xr[64 * j]; u32x2 w; w.x = cvtpk(v.x, v.y); w.y = cvtpk(v.z, v.w); o[64 * j] = w; }
    }
    float* rope = (float*)(a.ws + WS_ROPE);
    constexpr float INVF[8] = {1.0f, 0.1939227432012558f, 0.03760603070259094f, 0.007292664609849453f, 0.0014142135623842478f, 0.00027424818836152554f, 5.318296098266728e-05f, 1.0313386155758053e-05f};
    for (int i = gw * 64 + lane; i < NTOK; i += NGW * 64) {
        const float p = (float)a.pos[i];
#pragma unroll
        for (int j = 0; j < 8; ++j) {
            const float ang = p * INVF[j];
            const double rev = (double)ang * 0.15915494309189535;
            const float fr = (float)(rev - __builtin_rint(rev));
            rope[(size_t)i * 16 + j] = __builtin_amdgcn_cosf(fr);
            rope[(size_t)i * 16 + 8 + j] = __builtin_amdgcn_sinf(fr);
        }
    }
}

constexpr float Y_SCALE = 16.f;
struct CvtItem { const float* W; bf16* WT; int N, n0, nv, k0, dK, drow0, mode; float scale; };
__device__ const int SEG_SRC[21] = {0, 652, 908, 1164, 1420, 1676, 1932, 2192, 2576, 256, 320, 384, 448, 512, 576, 2448, 2512, 2832, 640, 2188, 2896};
__device__ const int SEG_DST[21] = {C_AQ, C_BQ, C_BK, C_BV, C_CQ, C_CK, C_CV, C_DQ, C_DIQ, C_AKC, C_AVC, C_AKS, C_AVS, C_AKW, C_AVW, C_DK, C_DV, C_DIK, 2880, 2892, 2896};
constexpr int CVT_I_IN = 93 * 16, CVT_I_G = 2048, CVT_I_BR = 512, CVT_I_O = 512, CVT_I_C1 = 128, CVT_I_R = 64, CVT_I_E = 65 * 384, CVT_I_CB = 2;
constexpr int CVT_NIT = CVT_I_IN + CVT_I_G + CVT_I_BR + CVT_I_O + CVT_I_C1 + CVT_I_R + CVT_I_E + CVT_I_CB;
DI CvtItem cvt_decode(const Args& a, int l, int it) {
    unsigned char* ws = a.ws; CvtItem c; c.mode = 0; c.nv = 32; c.scale = 1.f;
    int r = it;
    if (r < CVT_I_IN) {
        const int kb = r / 93, ci = r % 93; int seg, off;
        if (ci < 72) { seg = ci >> 3; off = (ci & 7) * 32; } else if (ci < 90) { seg = 9 + ((ci - 72) >> 1); off = ((ci - 72) & 1) * 32; }
        else { seg = 18 + (ci - 90); off = 0; c.nv = (seg == 18) ? 12 : 4; }
        if (seg == 0 || seg == 1 || seg == 4 || seg == 7) c.scale = QS;
        c.W = a.w_in + (size_t)l * DM * IN_W; c.N = IN_W; c.n0 = SEG_SRC[seg] + off; c.k0 = kb * 64; c.WT = (bf16*)(ws + W_IN); c.dK = DM; c.drow0 = SEG_DST[seg] + off; return c; }
    r -= CVT_I_IN;
    if (r < CVT_I_G) { const int m = r >> 9, q = r & 511, kb = q >> 5, nb = q & 31;
        c.W = a.w_gate + (size_t)(l * 4 + m) * DM * DM; c.N = DM; c.n0 = nb * 32; c.k0 = kb * 64; c.WT = (bf16*)(ws + W_G) + (size_t)m * DM * DM; c.dK = DM; c.drow0 = nb * 32; c.scale = -LOG2E; return c; }
    r -= CVT_I_G;
    if (r < CVT_I_BR) { const int m = r >> 7, q = r & 127, kb = q >> 5, nb = q & 31;
        c.W = a.w_br + (size_t)(l * 4 + m) * 256 * DM; c.N = DM; c.n0 = nb * 32; c.k0 = kb * 64; c.WT = (bf16*)(ws + W_BR) + (size_t)m * DM * 256; c.dK = 256; c.drow0 = nb * 32; return c; }
    r -= CVT_I_BR;
    if (r < CVT_I_O) { const int kb = r >> 5, nb = r & 31;
        c.W = a.w_o + (size_t)l * DM * DM; c.N = DM; c.n0 = nb * 32; c.k0 = kb * 64; c.WT = (bf16*)(ws + W_O); c.dK = DM; c.drow0 = nb * 32; return c; }
    r -= CVT_I_O;
    if (r < CVT_I_C1) { const int j = r >> 6, q = r & 63, kb = q >> 1, nb = q & 1;
        c.W = a.w_cmp1 + (size_t)(l * 2 + j) * 2048 * 64; c.N = 64; c.n0 = nb * 32; c.k0 = kb * 64; c.WT = (bf16*)(ws + W_C1) + (size_t)j * 256 * 2048; c.dK = 2048; c.drow0 = nb * 32; return c; }
    r -= CVT_I_C1;
    if (r < CVT_I_R) { const int mode = r >> 5, q = r & 31, kb = q >> 1, nb = q & 1;
        c.W = a.w_router + (size_t)l * DM * 64; c.N = 64; c.n0 = nb * 32; c.k0 = kb * 64; c.WT = (bf16*)(ws + (mode ? W_RL : W_RH)); c.dK = DM; c.drow0 = nb * 32; c.mode = mode; return c; }
    r -= CVT_I_R;
    if (r < CVT_I_E) {
        const int e = r / 384, q = r % 384, which = q >> 7, qq = q & 127;
        if (which < 2) { const int kb = qq >> 3, nb = qq & 7, n0 = nb * 32, pn = n0 >> 7, i0 = n0 & 127;
            c.W = (which == 0) ? (e < 64 ? a.w_eg + (size_t)(l * 64 + e) * DM * 256 : a.w_sg + (size_t)l * DM * 256) : (e < 64 ? a.w_eu + (size_t)(l * 64 + e) * DM * 256 : a.w_su + (size_t)l * DM * 256);
            c.N = 256; c.n0 = n0; c.k0 = kb * 64; c.WT = (bf16*)(ws + W_1) + (size_t)e * 512 * DM; c.dK = DM; c.drow0 = pn * 256 + which * 128 + i0;
        } else { const int kb = qq >> 5, nb = qq & 31;
            c.W = e < 64 ? a.w_ed + (size_t)(l * 64 + e) * 256 * DM : a.w_sd + (size_t)l * 256 * DM; c.N = DM; c.n0 = nb * 32; c.k0 = kb * 64; c.WT = (bf16*)(ws + W_2) + (size_t)e * DM * 256; c.dK = 256; c.drow0 = nb * 32; c.scale = Y_SCALE; }
        return c; }
    r -= CVT_I_E;
    c.mode = 2; c.n0 = r; c.W = nullptr; c.WT = nullptr; c.N = 0; c.k0 = 0; c.dK = 0; c.drow0 = 0; return c;
}
DI void cvt_load(const CvtItem& c, f32x4 (&v)[8], int lane) {
    if (c.mode == 2) return;
    if (c.nv == 32 && ((c.N | c.n0) & 3) == 0) {
#pragma unroll
        for (int i = 0; i < 8; ++i) v[i] = *(const f32x4*)(c.W + (size_t)(c.k0 + 8 * i + (lane >> 3)) * c.N + c.n0 + (lane & 7) * 4);
    } else {
#pragma unroll
        for (int i = 0; i < 8; ++i) { const float* p = c.W + (size_t)(c.k0 + 8 * i + (lane >> 3)) * c.N + c.n0 + (lane & 7) * 4; const int c4 = (lane & 7) * 4;
            v[i][0] = (c4 + 0 < c.nv) ? p[0] : 0.f; v[i][1] = (c4 + 1 < c.nv) ? p[1] : 0.f; v[i][2] = (c4 + 2 < c.nv) ? p[2] : 0.f; v[i][3] = (c4 + 3 < c.nv) ? p[3] : 0.f; }
    }
}
DI void cvt_finish(const Args& a, int l, const CvtItem& c, const f32x4 (&v)[8], LAS float* scr, int lane) {
    if (c.mode == 2) {
        const int j = c.n0; const float* pe = a.pe_cmp + (size_t)(l * 2 + j) * 2048; const float* w1 = a.w_cmp1 + (size_t)(l * 2 + j) * 2048 * 64;
        float s = 0.f;
        for (int k = 0; k < 2048; ++k) s += pe[k] * w1[(size_t)k * 64 + lane];
        ((float*)(a.ws + WS_CBIAS))[j * 64 + lane] = s; return; }
#pragma unroll
    for (int i = 0; i < 8; ++i) { const int kk = 8 * i + (lane >> 3), c4 = (lane & 7) * 4; scr[kk * 33 + c4] = v[i][0]; scr[kk * 33 + c4 + 1] = v[i][1]; scr[kk * 33 + c4 + 2] = v[i][2]; scr[kk * 33 + c4 + 3] = v[i][3]; }
    LDS_WAIT(); asm volatile("" ::: "memory");
    const int cc = lane & 7;
#pragma unroll
    for (int j = 0; j < 4; ++j) {
        const int n = (lane >> 3) + 8 * j; const LAS float* s = scr + (8 * cc) * 33 + n;
        float w[8];
#pragma unroll
        for (int q = 0; q < 8; ++q) { w[q] = s[q * 33] * c.scale; if (c.mode == 1) { const float h = __uint_as_float(cvtpk(w[q], 0.f) << 16); w[q] = w[q] - h; } }
        u32x4 o; o.x = cvtpk(w[0], w[1]); o.y = cvtpk(w[2], w[3]); o.z = cvtpk(w[4], w[5]); o.w = cvtpk(w[6], w[7]);
        if (n < c.nv) *(u32x4*)(c.WT + (size_t)(c.drow0 + n) * c.dK + c.k0 + 8 * cc) = o;
    }
    LDS_WAIT(); asm volatile("" ::: "memory");
}
DI void ph_cvt(const Args& a, int l, LAS unsigned char* lds, int gw, int NGW, int wave, int lane) {
    LAS float* scr = (LAS float*)(lds + wave * 8704);
    f32x4 va[8], vb[8];
    CvtItem ca, cb; ca.mode = 2; ca.n0 = 0;
    int it = gw;
    if (it < CVT_NIT) { ca = cvt_decode(a, l, it); cvt_load(ca, va, lane); }
    for (; it < CVT_NIT; it += 2 * NGW) {
        const bool hasb = it + NGW < CVT_NIT;
        if (hasb) { cb = cvt_decode(a, l, it + NGW); cvt_load(cb, vb, lane); }
        cvt_finish(a, l, ca, va, scr, lane);
        const bool hasa = it + 2 * NGW < CVT_NIT;
        if (hasa) { ca = cvt_decode(a, l, it + 2 * NGW); cvt_load(ca, va, lane); }
        if (hasb) cvt_finish(a, l, cb, vb, scr, lane);
    }
}

DI void rope4(float (&v)[4], int a, const float* rp, float scale) {
    float pv[4];
#pragma unroll
    for (int i = 0; i < 4; ++i) pv[i] = dpp_xor2(v[i]);
    const f32x4 c4 = *(const f32x4*)(rp + 4 * (a & 1)), s4 = *(const f32x4*)(rp + 8 + 4 * (a & 1));
    if (a < 4) {
#pragma unroll
        for (int i = 0; i < 4; ++i) v[i] = (a < 2) ? (v[i] * c4[i] - pv[i] * s4[i]) : (pv[i] * s4[i] + v[i] * c4[i]);
    }
#pragma unroll
    for (int i = 0; i < 4; ++i) v[i] *= scale;
}
DI void ld4bf(const bf16* p, float (&v)[4]) { const u32x2 w = *(const u32x2*)p; v[0] = bflo(w.x); v[1] = bfhi(w.x); v[2] = bflo(w.y); v[3] = bfhi(w.y); }
DI void st4bf(bf16* p, const float (&v)[4]) { u32x2 w; w.x = cvtpk(v[0], v[1]); w.y = cvtpk(v[2], v[3]); *(u32x2*)p = w; }

DI void ph_post(const Args& a, int l, LAS unsigned char* lds, int wave, int lane) {
    unsigned char* ws = a.ws;
    bf16* proj = (bf16*)(ws + WS_A);
    const float* rope = (const float*)(ws + WS_ROPE);
    const float* sm32 = (const float*)(ws + WS_SM32);
    LAS bf16* T = (LAS bf16*)(lds + wave * 9216);
    for (int tile = lbid(); tile < NTOK / 64; tile += lgrid()) {
        const int tok0 = tile * 64;
        float kmx = 0.f;
        for (int tt = wave; tt < 64; tt += NWAVES) {
            const int tok = tok0 + tt; bf16* row = proj + (size_t)tok * PW;
            const float* cs = rope + (size_t)tok * 16;
            const int ah = lane & 15;
            float v[4];
            ld4bf(row + C_AQ + 4 * lane, v); rope4(v, ah, cs, 1.0f); st4bf(row + C_AQ + 4 * lane, v);
            ld4bf(row + C_DQ + 4 * lane, v); rope4(v, ah, cs, 1.0f); st4bf(row + C_DQ + 4 * lane, v);
            ld4bf(row + C_DIQ + 4 * lane, v); rope4(v, ah, cs, 1.0f); st4bf(row + C_DIQ + 4 * lane, v);
            {
                const int tl = tok % SEQ, kin = tl & 31, slot = (kin & ~12) | ((kin & 4) << 1) | ((kin & 8) >> 1), hq = lane >> 4;
                const size_t toff = (((size_t)(tok / SEQ) * 4 + hq) * (SEQ / 32) + (tl >> 5)) * 2048 + ((ah >> 1) * 32 + slot) * 8 + (ah & 1) * 4;
                *(u32x2*)((bf16*)(ws + WS_KTB) + toff) = *(const u32x2*)(row + C_BK + 4 * lane);
                const u32x2 ckw = *(const u32x2*)(row + C_CK + 4 * lane);
                *(u32x2*)((bf16*)(ws + WS_KTC) + toff) = ckw;
                float sq = bflo(ckw.x) * bflo(ckw.x) + bfhi(ckw.x) * bfhi(ckw.x) + bflo(ckw.y) * bflo(ckw.y) + bfhi(ckw.y) * bfhi(ckw.y);
                sq += dpp_xor1(sq); sq += dpp_xor2(sq); sq += DPPF(sq, 0x124, 0xF, true); sq += DPPF(sq, 0x128, 0xF, true);
                kmx = fmaxf(kmx, sq);
            }
            { const int hk = lane >> 4; const int cb = (hk == 0) ? C_AKS : (hk == 1) ? C_AKW : (hk == 2) ? C_DK : C_DIK;
              ld4bf(row + cb + 4 * ah, v); rope4(v, ah, cs, 1.0f); st4bf(row + cb + 4 * ah, v);
              if (hk < 2) {
                  const int tl = tok % SEQ, kin = tl & 31, slot = (kin & ~12) | ((kin & 4) << 1) | ((kin & 8) >> 1);
                  bf16* kt = (bf16*)(ws + (hk == 0 ? WS_KTS : WS_KTW)) + ((size_t)(tok / SEQ) * (SEQ / 32) + (tl >> 5)) * 2048 + ((ah >> 1) * 32 + slot) * 8 + (ah & 1) * 4;
                  st4bf(kt, v); }
              if (hk == 3) {
                  const int tl = tok % SEQ;
                  bf16* it = (bf16*)(ws + WS_IKT) + ((size_t)(tok / SEQ) * (SEQ / 32) + (tl >> 5)) * 2048 + ((ah >> 1) * 32 + (tl & 31)) * 8 + (ah & 1) * 4;
                  st4bf(it, v); } }
            if (lane < 32) { const int j = lane >> 4; const u32x2 w = *(const u32x2*)(row + (j ? C_AVC : C_AKC) + 4 * ah);
                *(u32x2*)((bf16*)(ws + (j ? WS_VCR : WS_KCR)) + (size_t)tok * 64 + 4 * ah) = w; }
            if (lane < 20) {
                const float s = sm32[(size_t)tok * 32 + lane];
                if (lane < 12) ((float*)(ws + WS_GATE))[(size_t)tok * 12 + lane] = sigmoidf_(s);
                else if (lane < 16) { const float z = s + a.b_f[l * 4 + (lane - 12)];
                    ((float*)(ws + WS_LOGF))[(size_t)tok * 4 + (lane - 12)] = fminf(z, 0.f) * LOG2E - flog2(1.f + fexp2(-fabsf(z) * LOG2E)); }
                else ((float*)(ws + WS_IW))[(size_t)tok * 4 + (lane - 16)] = s;
            }
        }
        if ((lane & 15) == 0) atomicMax((unsigned*)(ws + WS_CTL) + CW_KMAX + l * 32 + (tok0 / SEQ) * 4 + (lane >> 4), __float_as_uint(kmx * 1.02f));
        const int bidx = tok0 / SEQ, tl0 = tok0 % SEQ;
        for (int hv = wave; hv < 10; hv += NWAVES) {
            int cb; bf16* dst;
            if (hv < 4) { cb = C_BV + 64 * hv; dst = (bf16*)(ws + WS_VTB) + (size_t)(bidx * 4 + hv) * 64 * SEQ; }
            else if (hv < 8) { cb = C_CV + 64 * (hv - 4); dst = (bf16*)(ws + WS_VTC) + (size_t)(bidx * 4 + hv - 4) * 64 * SEQ; }
            else if (hv == 8) { cb = C_AVS; dst = (bf16*)(ws + WS_VTAS) + (size_t)bidx * 64 * SEQ; }
            else { cb = C_AVW; dst = (bf16*)(ws + WS_VTAW) + (size_t)bidx * 64 * SEQ; }
            const bf16* src = proj + (size_t)(tok0 + lane) * PW + cb;
#pragma unroll
            for (int i = 0; i < 8; ++i) { const u32x4 w = *(const u32x4*)(src + 8 * i);
                T[(8 * i + 0) * 72 + lane] = (bf16)(w.x & 0xffff); T[(8 * i + 1) * 72 + lane] = (bf16)(w.x >> 16);
                T[(8 * i + 2) * 72 + lane] = (bf16)(w.y & 0xffff); T[(8 * i + 3) * 72 + lane] = (bf16)(w.y >> 16);
                T[(8 * i + 4) * 72 + lane] = (bf16)(w.z & 0xffff); T[(8 * i + 5) * 72 + lane] = (bf16)(w.z >> 16);
                T[(8 * i + 6) * 72 + lane] = (bf16)(w.w & 0xffff); T[(8 * i + 7) * 72 + lane] = (bf16)(w.w >> 16); }
            LDS_WAIT(); asm volatile("" ::: "memory");
            {
                const int dt = lane >> 5, cc = lane & 31;
#pragma unroll
                for (int i = 0; i < 8; ++i) { const int tile = i >> 2, sh = i & 3;
                    bf16* d = dst + ((size_t)(tl0 >> 5) + tile) * 2048 + ((dt * 2 + (sh >> 1)) * 64 + (sh & 1) * 32 + cc) * 8;
                    *(u32x4*)d = *(const LAS u32x4*)(T + lane * 72 + 8 * i); }
            }
            LDS_WAIT(); asm volatile("" ::: "memory");
        }
    }
}

DI void cumsum_seq(const Args& a, int bh, int lane) {
    const float* lf = (const float*)(a.ws + WS_LOGF); float* cum = (float*)(a.ws + WS_CUM);
    const int b = bh >> 2, h = bh & 3;
    const float* src = lf + ((size_t)b * SEQ + lane * 128) * 4 + h;
    float s = 0.f;
    for (int i = 0; i < 128; ++i) s += src[(size_t)i * 4];
    const float incl = wave_incl_scan_f(s);
    float run = incl - s;
    float* dst = cum + (size_t)bh * SEQ + lane * 128;
    for (int i = 0; i < 128; ++i) { run += src[(size_t)i * 4]; dst[i] = run; }
}

DI void ph_cmp2(const Args& a, int l, int gw, int NGW, int lane) {
    const float* hid = (const float*)(a.ws + WS_HID);
    bf16* kc = (bf16*)(a.ws + WS_KCMP); bf16* vtc = (bf16*)(a.ws + WS_VTCMP);
    for (int it = gw; it < 2 * 4096; it += NGW) {
        const int j = it >> 12, row = it & 4095, b = row >> 9, n = row & 511;
        const float* h = hid + ((size_t)j * 4096 + row) * 64; const float* w2 = a.w_cmp2 + (size_t)(l * 2 + j) * 64 * 64;
        float s = 0.f;
#pragma unroll 8
        for (int k = 0; k < 64; ++k) s += h[k] * w2[k * 64 + lane];
        if (n == 511) s = 0.f;
        const bf16 o = (bf16)(cvtpk(s, 0.f) & 0xffff);
        const int tile = n >> 5, kin = n & 31;
        if (j == 0) { const int slot = (kin & ~12) | ((kin & 4) << 1) | ((kin & 8) >> 1); kc[((size_t)b * 16 + tile) * 2048 + ((lane >> 3) * 32 + slot) * 8 + (lane & 7)] = o; }
        else { const int sI = kin >> 4, hI = (kin >> 3) & 1, e = kin & 7; vtc[((size_t)b * 16 + tile) * 2048 + (((lane >> 5) * 2 + sI) * 64 + hI * 32 + (lane & 31)) * 8 + e] = o; }
    }
}

DI void ph_ln1(const Args& a, int l, int gw, int NGW, int lane) {
    bf16* xb = (bf16*)(a.ws + WS_XB); bf16* xl = (bf16*)(a.ws + WS_XL);
    const float* g = a.ln1_g + l * DM; const float* be = a.ln1_b + l * DM;
    u32x4 nq0 = {0u,0u,0u,0u}, nq1 = {0u,0u,0u,0u};
    if (gw < NTOK) { const u32x4* x0 = (const u32x4*)(xb + (size_t)gw * DM) + lane; nq0 = x0[0]; nq1 = x0[64]; }
    for (int row = gw; row < NTOK; row += NGW) {
        u32x4* xr = (u32x4*)(xb + (size_t)row * DM) + lane; u32x4* lr = (u32x4*)(xl + (size_t)row * DM) + lane;
        const u32x4 qq[2] = {nq0, nq1};
        if (row + NGW < NTOK) { const u32x4* xn = (const u32x4*)(xb + (size_t)(row + NGW) * DM) + lane; nq0 = xn[0]; nq1 = xn[64]; }
        f32x4 v[4]; float s = 0.f;
#pragma unroll
        for (int j = 0; j < 2; ++j) { const u32x4 q = qq[j];
            v[2 * j] = (f32x4){bflo(q.x), bfhi(q.x), bflo(q.y), bfhi(q.y)}; v[2 * j + 1] = (f32x4){bflo(q.z), bfhi(q.z), bflo(q.w), bfhi(q.w)}; }
#pragma unroll
        for (int j = 0; j < 4; ++j) s += (v[j].x + v[j].y) + (v[j].z + v[j].w);
        const float mean = wave_sum(s) * (1.f / DM); float s2 = 0.f;
#pragma unroll
        for (int j = 0; j < 4; ++j) { v[j] = v[j] - mean; s2 += (v[j].x * v[j].x + v[j].y * v[j].y) + (v[j].z * v[j].z + v[j].w * v[j].w); }
        const float rstd = 1.f / sqrtf(wave_sum(s2) * (1.f / DM) + LN_EPS);
#pragma unroll
        for (int j = 0; j < 2; ++j) {
            const int cb = 8 * lane + 512 * j;
            const f32x4 g0 = *(const f32x4*)(g + cb), g1 = *(const f32x4*)(g + cb + 4), b0 = *(const f32x4*)(be + cb), b1 = *(const f32x4*)(be + cb + 4);
            const f32x4 y0 = v[2 * j] * rstd * g0 + b0, y1 = v[2 * j + 1] * rstd * g1 + b1;
            const u32x4 hi = pack8(y0, y1);
            const f32x4 r0 = {y0[0] - bflo(hi.x), y0[1] - bfhi(hi.x), y0[2] - bflo(hi.y), y0[3] - bfhi(hi.y)}, r1 = {y1[0] - bflo(hi.z), y1[1] - bfhi(hi.z), y1[2] - bflo(hi.w), y1[3] - bfhi(hi.w)};
            xr[64 * j] = hi; lr[64 * j] = pack8(r0, r1);
        }
    }
}

DI void ph_route(const Args& a, int l, LAS unsigned char* lds, int wave, int lane) {
    const float* logit = (const float*)(a.ws + WS_LOGIT);
    u32x2* tokinfo = (u32x2*)(a.ws + WS_TOKINFO);
    unsigned* lists = (unsigned*)(a.ws + WS_LIST);
    unsigned* gcnt = (unsigned*)(a.ws + WS_CTL) + CW_CNT + l * NCH * 64;
    LAS unsigned* lcnt = (LAS unsigned*)lds;
    LAS unsigned* lbase = lcnt + 64;
    LAS unsigned* stash = lbase + 64;
    const float rb = a.router_bias[l * 64 + lane];
    for (int blk = lbid(); blk < NTOK / 256; blk += lgrid()) {
        const int tok0 = blk * 256, c = tok0 / CHTOK;
        if (ltid() < 64) lcnt[ltid()] = 0u;
        __syncthreads();
        for (int tt = wave; tt < 256; tt += NWAVES) {
            const int tok = tok0 + tt;
            const float sc = sigmoidf_(logit[(size_t)tok * 64 + lane]);
            const float bi = sc + rb;
            float m1 = bi;
            m1 = fmaxf(m1, __shfl_xor(m1, 1)); m1 = fmaxf(m1, __shfl_xor(m1, 2)); m1 = fmaxf(m1, __shfl_xor(m1, 4));
            const unsigned long long eqm = __ballot(bi == m1);
            const int gsh = lane & ~7; const unsigned gm = (unsigned)((eqm >> gsh) & 0xffu);
            const int first = __builtin_ctz(gm);
            float v2 = ((lane & 7) == first) ? -3.0e38f : bi;
            v2 = fmaxf(v2, __shfl_xor(v2, 1)); v2 = fmaxf(v2, __shfl_xor(v2, 2)); v2 = fmaxf(v2, __shfl_xor(v2, 4));
            const float gs = m1 + v2;
            const int g = lane >> 3; int grank = 0;
#pragma unroll
            for (int gg = 0; gg < 8; ++gg) { const float o = __int_as_float(__builtin_amdgcn_readlane(__float_as_int(gs), gg * 8)); grank += (o > gs || (o == gs && gg < g)) ? 1 : 0; }
            const float mb = (grank < 4) ? bi : -1.0e30f;
            int rank = 0;
#pragma unroll 4
            for (int e = 0; e < 64; ++e) { const float o = __int_as_float(__builtin_amdgcn_readlane(__float_as_int(mb), e)); rank += (o > mb || (o == mb && e < lane)) ? 1 : 0; }
            const bool sel = rank < 8;
            const float wsum = wave_sum(sel ? sc : 0.f);
            const float w = sc / wsum * 2.5f;
            const unsigned long long sm = __ballot(sel);
            const int k = __popcll(sm & ((1ull << lane) - 1ull));
            if (sel) {
                const unsigned lp = atomicAdd((unsigned*)&lcnt[lane], 1u);
                stash[tt * 8 + k] = ((unsigned)lane << 16) | lp;
                ((float*)tokinfo)[((size_t)tok * 8 + k) * 2 + 1] = w;
            }
        }
        __syncthreads();
        if (ltid() < 64) lbase[ltid()] = atomicAdd(&gcnt[c * 64 + ltid()], lcnt[ltid()]);
        __syncthreads();
        for (int i = ltid(); i < 256 * 8; i += NWAVES * 64) {
            const unsigned s = stash[i]; const unsigned e = s >> 16, lp = s & 0xffffu; const int tok = tok0 + (i >> 3);
            const unsigned pos = lbase[e] + lp;
            lists[((size_t)c * 64 + e) * CHTOK + pos] = (unsigned)tok;
            ((unsigned*)tokinfo)[((size_t)tok * 8 + (i & 7)) * 2] = (e << 16) | pos;
        }
        __syncthreads();
    }
}

typedef f32x4 Acc2[2][2][4][2];
typedef f32x4 Acc1[2][1][4][2];

struct SchedProj {
    static constexpr bool GATHER = false, FIXED = true;
    gs::StaticOrder so; unsigned A, B;
    DI bool next(int i, gs::GU& u) const { gs::Unit t; if (!so.next(i, t)) return false;
        u.A = A + (unsigned)t.pm * 256u * 2048u; u.B = B + (unsigned)t.pn * 256u * 2048u; u.idx = nullptr; u.lda = 2048; u.ldb = 2048; u.nt = 16; u.flags = 3; u.nvalid = 256;
        u.a0 = t.pm; u.a1 = t.pn; u.a2 = 0; u.a3 = 0; return true; }
};
struct EpiProj {
    static constexpr bool PERM = true; static constexpr bool BH8 = false; bf16* proj; float* sm32;
    DI void operator()(const Acc2& acc, const gs::GU& u, int wr, int wc, int fr, int fq) const {
        const int row0 = u.a0 * 256 + wr * 64 + fr, col0 = u.a1 * 256 + wc * 32 + 8 * fq;
#pragma unroll
        for (int ai = 0; ai < 2; ++ai)
#pragma unroll
            for (int m = 0; m < 4; ++m) { const int row = row0 + ai * 128 + m * 16;
#pragma unroll
                for (int bj = 0; bj < 2; ++bj) *(u32x4*)(proj + (size_t)row * PW + col0 + bj * 128) = pack8(acc[ai][bj][m][0], acc[ai][bj][m][1]);
                if (u.a1 == 11 && wc == 2) { *(f32x4*)(sm32 + (size_t)row * 32 + 8 * fq) = acc[ai][0][m][0]; *(f32x4*)(sm32 + (size_t)row * 32 + 8 * fq + 4) = acc[ai][0][m][1]; } }
    }
};

struct SchedCmp {
    static constexpr bool GATHER = false, FIXED = true;
    unsigned kcr, vcr, w;
    DI bool next(int i, gs::GU& u) const { if (i > 0 || lbid() >= 32) return false; const int j = lbid() >> 4, pm = lbid() & 15;
        u.A = (j ? vcr : kcr) + (unsigned)pm * 256u * 2048u; u.B = w + (unsigned)j * 256u * 4096u; u.idx = nullptr; u.lda = 2048; u.ldb = 4096; u.nt = 32; u.flags = 3; u.nvalid = 256;
        u.a0 = pm; u.a1 = j; u.a2 = 0; u.a3 = 0; return true; }
};
struct EpiCmp {
    static constexpr bool PERM = true; static constexpr bool BH8 = false; float* hid; const float* cbias;
    DI void operator()(const Acc2& acc, const gs::GU& u, int wr, int wc, int fr, int fq) const {
        if (wc >= 2) return;
        const int row0 = u.a0 * 256 + wr * 64 + fr, col0 = wc * 32 + 8 * fq, j = u.a1;
        float cb[8];
#pragma unroll
        for (int q = 0; q < 8; ++q) cb[q] = cbias[j * 64 + col0 + q];
#pragma unroll
        for (int ai = 0; ai < 2; ++ai)
#pragma unroll
            for (int m = 0; m < 4; ++m) { const int row = row0 + ai * 128 + m * 16; float o[8];
#pragma unroll
                for (int q = 0; q < 8; ++q) { const float x = acc[ai][0][m][q >> 2][q & 3] + cb[q];
                    const float y2 = 1.5957691216f * (x + 0.044715f * x * x * x);
                    o[q] = x * frcp(1.f + fexp2(-y2 * LOG2E)); }
                float* d = hid + ((size_t)j * 4096 + row) * 64 + col0;
                *(f32x4*)d = (f32x4){o[0], o[1], o[2], o[3]}; *(f32x4*)(d + 4) = (f32x4){o[4], o[5], o[6], o[7]}; }
    }
};

struct SchedMerge {
    static constexpr bool GATHER = false, FIXED = false;
    unsigned xb, om, wg, wbr; int G;
    DI bool next(int i, gs::GU& u) const { const int ti = i >> 3, k = i & 7; const int bid_ = lbid(); const long L = (long)ti * G + bid_; if (L >= 2048) return false;
        int pm = (int)(L >> 3), pc = (int)(L & 7); const int m = k >> 1, kind = k & 1;
        if (G == 256) { const int x = bid_ & 7, idx = bid_ >> 3; pm = ti * 32 + x * 4 + (idx >> 3); pc = idx & 7; }
        if (kind == 0) { u.A = om + (unsigned)pm * 256u * 2048u + (unsigned)m * 512u; u.B = wbr + (unsigned)m * 1024u * 512u + (unsigned)pc * 128u * 512u; u.lda = 2048; u.ldb = 512; u.nt = 4; }
        else           { u.A = xb + (unsigned)pm * 256u * 2048u;           u.B = wg + (unsigned)m * 1024u * 2048u + (unsigned)pc * 128u * 2048u; u.lda = 2048; u.ldb = 2048; u.nt = 16; }
        u.idx = nullptr; u.flags = 3; u.nvalid = 256; u.a0 = pm; u.a1 = pc; u.a2 = kind; u.a3 = m; return true; }
};
struct EpiMerge {
    static constexpr bool PERM = true; static constexpr bool BH8 = false; bf16* merged; LAS unsigned char* lds;
    f32x4 M[2][4][2]; u32x4 p7;
    DI LAS u32x4* slot(int k, int tid) const { const int off = (k < 2) ? 5 * gs::HTB + k * 8192 : (k < 4) ? 7 * gs::HTB + (k - 2) * 8192 : 8 * gs::HTB + (k - 4) * 8192; return (LAS u32x4*)(lds + off) + tid; }
    DI void operator()(const Acc1& acc, const gs::GU& u, int wr, int wc, int fr, int fq) {
        const int tid = ltid();
        if (u.a2 == 0) {
#pragma unroll
            for (int ai = 0; ai < 2; ++ai)
#pragma unroll
                for (int m = 0; m < 4; ++m) { const u32x4 w = pack8(acc[ai][0][m][0], acc[ai][0][m][1]); if (ai * 4 + m < 7) *slot(ai * 4 + m, tid) = w; else p7 = w; }
        } else {
            const bool first = (u.a3 == 0), lastm = (u.a3 == 3);
            const int row0 = u.a0 * 256 + wr * 64 + fr, col0 = u.a1 * 128 + wc * 32 + 8 * fq;
            if (first) {
#pragma unroll
                for (int ai = 0; ai < 2; ++ai)
#pragma unroll
                    for (int m = 0; m < 4; ++m) { M[ai][m][0] = (f32x4){0.f, 0.f, 0.f, 0.f}; M[ai][m][1] = (f32x4){0.f, 0.f, 0.f, 0.f}; }
            }
#pragma unroll
            for (int ai = 0; ai < 2; ++ai)
#pragma unroll
                for (int m = 0; m < 4; ++m) {
                    const u32x4 p = (ai * 4 + m < 7) ? *slot(ai * 4 + m, tid) : p7;
                    const f32x4 g0 = acc[ai][0][m][0], g1 = acc[ai][0][m][1];
                    f32x4 m0 = M[ai][m][0], m1 = M[ai][m][1];
                    m0[0] = __builtin_fmaf(frcp(1.f + fexp2(g0[0])), bflo(p.x), m0[0]); m0[1] = __builtin_fmaf(frcp(1.f + fexp2(g0[1])), bfhi(p.x), m0[1]);
                    m0[2] = __builtin_fmaf(frcp(1.f + fexp2(g0[2])), bflo(p.y), m0[2]); m0[3] = __builtin_fmaf(frcp(1.f + fexp2(g0[3])), bfhi(p.y), m0[3]);
                    m1[0] = __builtin_fmaf(frcp(1.f + fexp2(g1[0])), bflo(p.z), m1[0]); m1[1] = __builtin_fmaf(frcp(1.f + fexp2(g1[1])), bfhi(p.z), m1[1]);
                    m1[2] = __builtin_fmaf(frcp(1.f + fexp2(g1[2])), bflo(p.w), m1[2]); m1[3] = __builtin_fmaf(frcp(1.f + fexp2(g1[3])), bfhi(p.w), m1[3]);
                    M[ai][m][0] = m0; M[ai][m][1] = m1;
                    asm volatile("" : "+v"(M[ai][m][0]), "+v"(M[ai][m][1]));
                    if (lastm) *(u32x4*)(merged + (size_t)(row0 + ai * 128 + m * 16) * DM + col0) = pack8(M[ai][m][0], M[ai][m][1]);
                    asm volatile("" ::: "memory");
                }
        }
    }
};

struct SchedWo {
    static constexpr bool GATHER = false, FIXED = true;
    gs::StaticOrder so; unsigned A, B;
    DI bool next(int i, gs::GU& u) const { gs::Unit t; if (!so.next(i, t)) return false;
        u.A = A + (unsigned)t.pm * 256u * 2048u; u.B = B + (unsigned)t.pn * 256u * 2048u; u.idx = nullptr; u.lda = 2048; u.ldb = 2048; u.nt = 16; u.flags = 3; u.nvalid = 256;
        u.a0 = t.pm; u.a1 = t.pn; u.a2 = 0; u.a3 = 0; return true; }
};
struct EpiWo {
    static constexpr bool PERM = true; static constexpr bool BH8 = false; bf16* xb;
    DI void operator()(const Acc2& acc, const gs::GU& u, int wr, int wc, int fr, int fq) const {
        const int row0 = u.a0 * 256 + wr * 64 + fr, col0 = u.a1 * 256 + wc * 32 + 8 * fq;
#pragma unroll
        for (int ai = 0; ai < 2; ++ai)
#pragma unroll
            for (int m = 0; m < 4; ++m) {
#pragma unroll
                for (int bj = 0; bj < 2; ++bj) { bf16* p = xb + (size_t)(row0 + ai * 128 + m * 16) * DM + col0 + bj * 128; const u32x4 xv = *(const u32x4*)p;
                    f32x4 v0 = acc[ai][bj][m][0], v1 = acc[ai][bj][m][1];
                    v0[0] += ALPHA * bflo(xv.x); v0[1] += ALPHA * bfhi(xv.x); v0[2] += ALPHA * bflo(xv.y); v0[3] += ALPHA * bfhi(xv.y);
                    v1[0] += ALPHA * bflo(xv.z); v1[1] += ALPHA * bfhi(xv.z); v1[2] += ALPHA * bflo(xv.w); v1[3] += ALPHA * bfhi(xv.w);
                    *(u32x4*)p = pack8(v0, v1); } }
    }
};

struct SchedRouter {
    static constexpr bool GATHER = false, FIXED = true;
    unsigned xh, xl, wh, wl; int G;
    DI bool next(int i, gs::GU& u) const { const int ti = i / 3, k = i % 3; const int pm = ti * G + lbid(); if (pm >= 256) return false;
        u.A = ((k == 1) ? xl : xh) + (unsigned)pm * 256u * 2048u; u.B = (k == 2) ? wl : wh; u.idx = nullptr; u.lda = 2048; u.ldb = 2048; u.nt = 16;
        u.flags = (k == 0 ? 1 : 0) | (k == 2 ? 2 : 0); u.nvalid = 256; u.a0 = pm; u.a1 = 0; u.a2 = 0; u.a3 = 0; return true; }
};
struct EpiRouter {
    static constexpr bool PERM = false; static constexpr bool BH8 = false; float* logit;
    DI void operator()(const Acc1& acc, const gs::GU& u, int wr, int wc, int fr, int fq) const {
        if (wc >= 2) return;
        const int row0 = u.a0 * 256 + wr * 64 + fr, col0 = wc * 32 + 4 * fq;
#pragma unroll
        for (int ai = 0; ai < 2; ++ai)
#pragma unroll
            for (int m = 0; m < 4; ++m)
#pragma unroll
                for (int n = 0; n < 2; ++n) *(f32x4*)(logit + (size_t)(row0 + ai * 128 + m * 16) * 64 + col0 + n * 16) = acc[ai][0][m][n];
    }
};

constexpr int TBL_OFF = 131072, NPAIR = NCH * 65, TBLN = 528;
static_assert(NPAIR + 1 <= TBLN && TBL_OFF + 3 * TBLN * 4 <= MISC_OFF, "MoE tables");
DI void moe_tables(const Args& a, int l, LAS unsigned char* lds) {
    LAS int* ptile = (LAS int*)(lds + TBL_OFF); LAS int* ypre = ptile + TBLN; LAS int* cntv = ypre + TBLN;
    __syncthreads();
    const int tid_ = ltid();
    if (tid_ < 64) {
        const unsigned* gcnt = (const unsigned*)(a.ws + WS_CTL) + CW_CNT + l * NCH * 64;
        int pt = 0;
        for (int c = 0; c < NCH; ++c) {
            const int n = (int)__hip_atomic_load(gcnt + c * 64 + tid_, __ATOMIC_RELAXED, __HIP_MEMORY_SCOPE_AGENT);
            const int tl = (n + 255) >> 8;
            const int tinc = wave_incl_scan(tl), yinc = wave_incl_scan(n);
            const int p = c * 65 + tid_;
            cntv[p] = n; ptile[p] = pt + tinc - tl; ypre[p] = yinc - n;
            const int ttot = __builtin_amdgcn_readlane(tinc, 63), ytot = __builtin_amdgcn_readlane(yinc, 63);
            if (tid_ == 0) { cntv[c * 65 + 64] = CHTOK; ptile[c * 65 + 64] = pt + ttot; ypre[c * 65 + 64] = ytot; }
            pt += ttot + CHTOK / 256;
        }
        if (tid_ == 0) ptile[NPAIR] = pt;
    }
    __syncthreads();
}
DI int find_pair(const LAS int* ptile, int tile) {
    int lo = 0, hi = NPAIR;
    while (hi - lo > 1) { const int mid = (lo + hi) >> 1; if (ptile[mid] <= tile) lo = mid; else hi = mid; }
    return lo;
}
struct SchedE1 {
    static constexpr bool GATHER = true, FIXED = false;
    const LAS int* ptile; const LAS int* cntv; unsigned xb; const unsigned* lists; unsigned w1; int G;
    DI bool next(int i, gs::GU& u) const { const int bid_ = lbid(); int un = i * G + bid_;
        if (G == 256) { const int x = bid_ & 7, idx = bid_ >> 3; un = (i * 128 + x * 16 + (idx >> 1)) * 2 + (idx & 1); }
        const int tile = un >> 1, pn = un & 1; if (tile >= ptile[NPAIR]) return false;
        const int p = find_pair(ptile, tile), c = p / 65, e = p % 65, t = tile - ptile[p];
        if (e < 64) { u.A = xb; u.idx = (const int*)(lists + ((size_t)c * 64 + e) * CHTOK + (size_t)t * 256); u.nvalid = cntv[p] - t * 256; }
        else { u.A = xb + ((unsigned)c * CHTOK + (unsigned)t * 256u) * 2048u; u.idx = nullptr; u.nvalid = 256; }
        u.B = w1 + (unsigned)e * 512u * 2048u + (unsigned)pn * 256u * 2048u; u.lda = 2048; u.ldb = 2048; u.nt = 16; u.flags = 3; u.a0 = tile; u.a1 = pn; u.a2 = 0; u.a3 = 0; return true; }
};
struct EpiE1 {
    static constexpr bool PERM = true; static constexpr bool BH8 = false; bf16* hb;
    DI void operator()(const Acc2& acc, const gs::GU& u, int wr, int wc, int fr, int fq) const {
        const int row0 = u.a0 * 256 + wr * 64 + fr, col0 = u.a1 * 128 + wc * 32 + 8 * fq;
#pragma unroll
        for (int ai = 0; ai < 2; ++ai)
#pragma unroll
            for (int m = 0; m < 4; ++m) { f32x4 h[2];
#pragma unroll
                for (int n = 0; n < 2; ++n)
#pragma unroll
                    for (int q = 0; q < 4; ++q) { const float g = acc[ai][0][m][n][q], up = acc[ai][1][m][n][q]; h[n][q] = g * sigmoidf_(g) * up; }
                *(u32x4*)(hb + (size_t)(row0 + ai * 128 + m * 16) * 256 + col0) = pack8(h[0], h[1]); }
    }
};
struct SchedE2 {
    static constexpr bool GATHER = false, FIXED = true;
    const LAS int* ptile; const LAS int* cntv; const LAS int* ypre; unsigned hb, w2; int c; int G;
    DI bool next(int i, gs::GU& u) const { const int bid_ = lbid(); int un = i * G + bid_;
        if (G == 256) { const int x = bid_ & 7, idx = bid_ >> 3; un = (i * 64 + x * 8 + (idx >> 2)) * 4 + (idx & 3); }
        const int tile = ptile[c * 65] + (un >> 2), pn = un & 3; if (tile >= ptile[(c + 1) * 65]) return false;
        const int p = find_pair(ptile, tile), e = p % 65, t = tile - ptile[p];
        u.A = hb + (unsigned)tile * 256u * 512u; u.B = w2 + (unsigned)e * 1024u * 512u + (unsigned)pn * 256u * 512u; u.idx = nullptr; u.lda = 512; u.ldb = 512; u.nt = 4; u.flags = 3;
        u.nvalid = 256; u.a0 = (tile - ptile[c * 65]) * 256; u.a1 = pn; u.a2 = 0; u.a3 = 0; return true; }
};
DI unsigned pk4_fp8(float a, float b, float c, float d) { int w = __builtin_amdgcn_cvt_pk_fp8_f32(a, b, 0, false); w = __builtin_amdgcn_cvt_pk_fp8_f32(c, d, w, true); return (unsigned)w; }
struct EpiE2 {
    static constexpr bool PERM = true; static constexpr bool BH8 = true; unsigned char* y;
    DI void operator()(const Acc2& acc, const gs::GU& u, int wr, int wc, int fr, int fq) const {
        const int row0 = u.a0 + wr * 64 + fr, col0 = u.a1 * 256 + wc * 64 + 16 * fq;
#pragma unroll
        for (int ai = 0; ai < 2; ++ai)
#pragma unroll
            for (int m = 0; m < 4; ++m) {
                u32x4 w;
                { const f32x4 v0 = acc[ai][0][m][0], v1 = acc[ai][0][m][1]; w.x = pk4_fp8(v0[0], v0[1], v0[2], v0[3]); w.y = pk4_fp8(v1[0], v1[1], v1[2], v1[3]); }
                { const f32x4 v0 = acc[ai][1][m][0], v1 = acc[ai][1][m][1]; w.z = pk4_fp8(v0[0], v0[1], v0[2], v0[3]); w.w = pk4_fp8(v1[0], v1[1], v1[2], v1[3]); }
                *(u32x4*)(y + (size_t)(row0 + ai * 128 + m * 16) * DM + col0) = w; }
    }
};

DI void ph_ln2(const Args& a, int l, int c, LAS unsigned char* lds, int gw, int NGW, int lane) {
    const LAS int* ptile = (const LAS int*)(lds + TBL_OFF);
    bf16* xb = (bf16*)(a.ws + WS_XB); const unsigned char* y = (const unsigned char*)(a.ws + WS_Y);
    const u32x2* tokinfo = (const u32x2*)(a.ws + WS_TOKINFO);
    const float* g = a.ln2_g + l * DM; const float* be = a.ln2_b + l * DM;
    u32x4 nx0 = {0u,0u,0u,0u}, nx1 = {0u,0u,0u,0u}; u32x2 nti = {0u, 0u};
    if (gw < CHTOK) { const int row0 = c * CHTOK + gw; const u32x4* xr0 = (const u32x4*)(xb + (size_t)row0 * DM) + lane; nx0 = xr0[0]; nx1 = xr0[64]; if (lane < 8) nti = tokinfo[(size_t)row0 * 8 + lane]; }
    for (int tt = gw; tt < CHTOK; tt += NGW) {
        const int row = c * CHTOK + tt;
        const u32x4 cx0 = nx0, cx1 = nx1; const u32x2 cti = nti;
        if (tt + NGW < CHTOK) { const int rown = row + NGW; const u32x4* xrn = (const u32x4*)(xb + (size_t)rown * DM) + lane; nx0 = xrn[0]; nx1 = xrn[64]; if (lane < 8) nti = tokinfo[(size_t)rown * 8 + lane]; }
        u32x4* xr = (u32x4*)(xb + (size_t)row * DM) + lane;
        f32x4 v[4];
        v[0] = (f32x4){bflo(cx0.x), bfhi(cx0.x), bflo(cx0.y), bfhi(cx0.y)} * ALPHA; v[1] = (f32x4){bflo(cx0.z), bfhi(cx0.z), bflo(cx0.w), bfhi(cx0.w)} * ALPHA;
        v[2] = (f32x4){bflo(cx1.x), bfhi(cx1.x), bflo(cx1.y), bfhi(cx1.y)} * ALPHA; v[3] = (f32x4){bflo(cx1.z), bfhi(cx1.z), bflo(cx1.w), bfhi(cx1.w)} * ALPHA;
        int yrv = 0; float wv = 1.f;
        if (lane < 8) { const u32x2 ti = cti; yrv = (ptile[c * 65 + (int)(ti.x >> 16)] - ptile[c * 65]) * 256 + (int)(ti.x & 0xffffu); wv = __uint_as_float(ti.y); }
        else if (lane == 8) yrv = (ptile[c * 65 + 64] - ptile[c * 65]) * 256 + tt;
        u32x2 q[9][2]; float wk[9];
#pragma unroll
        for (int k = 0; k < 9; ++k) { const int yrow = __builtin_amdgcn_readlane(yrv, k); wk[k] = __int_as_float(__builtin_amdgcn_readlane(__float_as_int(wv), k)) * (1.f / Y_SCALE);
            const u32x2* yr = (const u32x2*)(y + (size_t)yrow * DM) + lane; q[k][0] = yr[0]; q[k][1] = yr[64]; }
#pragma unroll
        for (int k = 0; k < 9; ++k) {
#pragma unroll
            for (int j = 0; j < 2; ++j) { const float ws_ = wk[k]; const u32x2 qq = q[k][j];
                v[2 * j][0] += ws_ * __builtin_amdgcn_cvt_f32_fp8((int)qq.x, 0); v[2 * j][1] += ws_ * __builtin_amdgcn_cvt_f32_fp8((int)qq.x, 1); v[2 * j][2] += ws_ * __builtin_amdgcn_cvt_f32_fp8((int)qq.x, 2); v[2 * j][3] += ws_ * __builtin_amdgcn_cvt_f32_fp8((int)qq.x, 3);
                v[2 * j + 1][0] += ws_ * __builtin_amdgcn_cvt_f32_fp8((int)qq.y, 0); v[2 * j + 1][1] += ws_ * __builtin_amdgcn_cvt_f32_fp8((int)qq.y, 1); v[2 * j + 1][2] += ws_ * __builtin_amdgcn_cvt_f32_fp8((int)qq.y, 2); v[2 * j + 1][3] += ws_ * __builtin_amdgcn_cvt_f32_fp8((int)qq.y, 3); }
        }
        float s = 0.f;
#pragma unroll
        for (int j = 0; j < 4; ++j) s += (v[j].x + v[j].y) + (v[j].z + v[j].w);
        const float mean = wave_sum(s) * (1.f / DM); float s2 = 0.f;
#pragma unroll
        for (int j = 0; j < 4; ++j) { v[j] = v[j] - mean; s2 += (v[j].x * v[j].x + v[j].y * v[j].y) + (v[j].z * v[j].z + v[j].w * v[j].w); }
        const float rstd = 1.f / sqrtf(wave_sum(s2) * (1.f / DM) + LN_EPS);
#pragma unroll
        for (int j = 0; j < 2; ++j) {
            const int cb = 8 * lane + 512 * j;
            const f32x4 g0 = *(const f32x4*)(g + cb), g1 = *(const f32x4*)(g + cb + 4), b0 = *(const f32x4*)(be + cb), b1 = *(const f32x4*)(be + cb + 4);
            const f32x4 y0 = v[2 * j] * rstd * g0 + b0, y1 = v[2 * j + 1] * rstd * g1 + b1;
            xr[64 * j] = pack8(y0, y1);
            if (l == DEPTH - 1) { float* o = a.out + (size_t)row * DM + cb; *(f32x4*)o = y0; *(f32x4*)(o + 4) = y1; }
        }
    }
}

DI int pi32(int r) { return (r & ~12) | ((r & 4) << 1) | ((r & 8) >> 1); }
DI int kofs(int i, int hh) { return 16 * (i >> 3) + 8 * hh + (i & 7); }
DI bf16x8 pack_p(const float (&p)[16], int s) {
    u32x4 w; w.x = cvtpk(p[8 * s], p[8 * s + 1]); w.y = cvtpk(p[8 * s + 2], p[8 * s + 3]); w.z = cvtpk(p[8 * s + 4], p[8 * s + 5]); w.w = cvtpk(p[8 * s + 6], p[8 * s + 7]);
    return __builtin_bit_cast(bf16x8, w);
}
DI f32x16 zero16() { f32x16 z;
#pragma unroll
    for (int i = 0; i < 16; ++i) z[i] = 0.f; return z; }
DI void store_ot(bf16* dst, const f32x16& o0, const f32x16& o1, float sc, int hh) {
#pragma unroll
    for (int g = 0; g < 4; ++g) {
        float v[4];
#pragma unroll
        for (int q = 0; q < 4; ++q) v[q] = o0[4 * g + q] * sc;
        st4bf(dst + 8 * g + 4 * hh, v);
#pragma unroll
        for (int q = 0; q < 4; ++q) v[q] = o1[4 * g + q] * sc;
        st4bf(dst + 32 + 8 * g + 4 * hh, v);
    }
}

DI void load_kv(bf16x8 (&kf)[4], bf16x8 (&vf)[2][2], const bf16* kp, const bf16* vp) {
#pragma unroll
    for (int s = 0; s < 4; ++s) kf[s] = *(const bf16x8*)(kp + 16 * s);
#pragma unroll
    for (int dt = 0; dt < 2; ++dt)
#pragma unroll
        for (int s = 0; s < 2; ++s) vf[dt][s] = *(const bf16x8*)(vp + (size_t)dt * 32 * SEQ + 16 * s);
}
DI void copy_kv(bf16x8 (&kf)[4], bf16x8 (&vf)[2][2], const bf16x8 (&nkf)[4], const bf16x8 (&nvf)[2][2]) {
#pragma unroll
    for (int s = 0; s < 4; ++s) kf[s] = nkf[s];
#pragma unroll
    for (int dt = 0; dt < 2; ++dt)
#pragma unroll
        for (int s = 0; s < 2; ++s) vf[dt][s] = nvf[dt][s];
}

DI void sb_unit(const Args& a, int b, int h, int qb, int lane) {
    const bf16* proj = (const bf16*)(a.ws + WS_A);
    const int c = lane & 31, hh = lane >> 5, pr = pi32(c);
    const size_t tokq = (size_t)b * SEQ + qb * 32 + c;
    const bf16* qp = proj + tokq * PW + C_BQ + h * 64 + 8 * hh;
    bf16x8 qf[4];
#pragma unroll
    for (int s = 0; s < 4; ++s) qf[s] = *(const bf16x8*)(qp + 16 * s);
    f32x16 o0 = zero16(), o1 = zero16(); float R = 1.f;
    const bool slot0lo = (__builtin_amdgcn_permlane32_swap((unsigned)hh, (unsigned)hh, false, false)[0] == 0u);
    const bf16* kbase = proj + (size_t)b * SEQ * PW + C_BK + h * 64 + 8 * hh;
    const bf16* vb0 = (const bf16*)(a.ws + WS_VTB) + ((size_t)(b * 4 + h) * 64 + c) * SEQ + 8 * hh;
    bf16x8 kf[4], vf[2][2];
    load_kv(kf, vf, kbase + (size_t)(qb * 32 + pr) * PW, vb0 + qb * 32);
    for (int kt = qb; kt >= 0; --kt) {
        bf16x8 nkf[4], nvf[2][2];
        { const int kn = (kt > 0) ? kt - 1 : 0; load_kv(nkf, nvf, kbase + (size_t)(kn * 32 + pr) * PW, vb0 + kn * 32); }
        f32x16 x = zero16();
#pragma unroll
        for (int s = 0; s < 4; ++s) x = mfma32(kf[s], qf[s], x);
        const bool diag = (kt == qb);
        float rr[16], ex[16], T[2];
#pragma unroll
        for (int i = 0; i < 16; ++i) { float rv = frcp(1.f + fexp2(x[i])); if (diag && kofs(i, hh) >= c) rv = 1.f; rr[i] = rv; }
#pragma unroll
        for (int s = 0; s < 2; ++s) { ex[8 * s + 7] = 1.f;
#pragma unroll
            for (int j = 6; j >= 0; --j) ex[8 * s + j] = ex[8 * s + j + 1] * rr[8 * s + j + 1];
            T[s] = ex[8 * s] * rr[8 * s]; }
        const auto r0_ = __builtin_amdgcn_permlane32_swap(__float_as_uint(T[0]), __float_as_uint(T[0]), false, false), r1_ = __builtin_amdgcn_permlane32_swap(__float_as_uint(T[1]), __float_as_uint(T[1]), false, false);
        const float PT0 = __uint_as_float((hh != 0) == slot0lo ? r0_[0] : r0_[1]), PT1 = __uint_as_float((hh != 0) == slot0lo ? r1_[0] : r1_[1]);
        float suf0, suf1;
        if (hh == 0) { suf1 = R * PT1; suf0 = suf1 * T[1] * PT0; } else { suf1 = R; suf0 = R * T[1] * PT1; }
        R = R * (T[0] * T[1]) * (PT0 * PT1);
        float p[16];
#pragma unroll
        for (int i = 0; i < 16; ++i) p[i] = (1.f - rr[i]) * ex[i] * (i < 8 ? suf0 : suf1);
        const bf16x8 pb0 = pack_p(p, 0), pb1 = pack_p(p, 1);
        o0 = mfma32(vf[0][0], pb0, o0); o0 = mfma32(vf[0][1], pb1, o0);
        o1 = mfma32(vf[1][0], pb0, o1); o1 = mfma32(vf[1][1], pb1, o1);
        copy_kv(kf, vf, nkf, nvf);
    }
    store_ot((bf16*)(a.ws + WS_B) + tokq * DM + 256 + h * 64, o0, o1, 1.f, hh);
}

DI void fg_unit(const Args& a, int b, int h, int qb, int lane) {
    const bf16* proj = (const bf16*)(a.ws + WS_A);
    const int c = lane & 31, hh = lane >> 5, pr = pi32(c);
    const size_t tokq = (size_t)b * SEQ + qb * 32 + c;
    const bf16* qp = proj + tokq * PW + C_CQ + h * 64 + 8 * hh;
    bf16x8 qf[4];
#pragma unroll
    for (int s = 0; s < 4; ++s) qf[s] = *(const bf16x8*)(qp + 16 * s);
    const float* cum = (const float*)(a.ws + WS_CUM) + (size_t)(b * 4 + h) * SEQ;
    const float cq = cum[qb * 32 + c];
    f32x16 o0 = zero16(), o1 = zero16(); float m = -1.0e30f, l = 0.f;
    const bf16* kbase = proj + (size_t)b * SEQ * PW + C_CK + h * 64 + 8 * hh;
    const bf16* vb0 = (const bf16*)(a.ws + WS_VTC) + ((size_t)(b * 4 + h) * 64 + c) * SEQ + 8 * hh;
    bf16x8 kf[4], vf[2][2];
    load_kv(kf, vf, kbase + (size_t)pr * PW, vb0);
    for (int kt = 0; kt <= qb; ++kt) {
        const int k0 = kt * 32;
        bf16x8 nkf[4], nvf[2][2];
        { const int kn = (kt < qb) ? kt + 1 : kt; load_kv(nkf, nvf, kbase + (size_t)(kn * 32 + pr) * PW, vb0 + kn * 32); }
        float ck[16];
#pragma unroll
        for (int s = 0; s < 2; ++s) { const f32x4 c0 = *(const f32x4*)(cum + k0 + 16 * s + 8 * hh), c1 = *(const f32x4*)(cum + k0 + 16 * s + 8 * hh + 4);
            ck[8 * s] = c0.x; ck[8 * s + 1] = c0.y; ck[8 * s + 2] = c0.z; ck[8 * s + 3] = c0.w; ck[8 * s + 4] = c1.x; ck[8 * s + 5] = c1.y; ck[8 * s + 6] = c1.z; ck[8 * s + 7] = c1.w; }
        f32x16 x = zero16();
#pragma unroll
        for (int s = 0; s < 4; ++s) x = mfma32(kf[s], qf[s], x);
        const bool diag = (kt == qb);
        float sv[16]; float tmax = -1.0e30f;
#pragma unroll
        for (int i = 0; i < 16; ++i) { const bool ok = !(diag && kofs(i, hh) > c); sv[i] = ok ? (x[i] + (cq - ck[i])) : -1.0e30f; tmax = fmaxf(tmax, sv[i]); }
        tmax = red32_max(tmax);
        const float mn = fmaxf(m, tmax), al = fexp2(m - mn);
        float p[16]; float ls = 0.f;
#pragma unroll
        for (int i = 0; i < 16; ++i) { p[i] = (sv[i] > -1.0e29f) ? fexp2(sv[i] - mn) : 0.f; ls += p[i]; }
        l = l * al + ls; m = mn;
#pragma unroll
        for (int i = 0; i < 16; ++i) { o0[i] *= al; o1[i] *= al; }
        const bf16x8 pb0 = pack_p(p, 0), pb1 = pack_p(p, 1);
        o0 = mfma32(vf[0][0], pb0, o0); o0 = mfma32(vf[0][1], pb1, o0);
        o1 = mfma32(vf[1][0], pb0, o1); o1 = mfma32(vf[1][1], pb1, o1);
        copy_kv(kf, vf, nkf, nvf);
    }
    const float lt = red32_sum(l);
    store_ot((bf16*)(a.ws + WS_B) + tokq * DM + 512 + h * 64, o0, o1, 1.f / lt, hh);
}


DI void atile_load(u32x4& reg, const bf16* kt0, const bf16* vt0, int kt, int tid) {
    reg = (tid < 256) ? *(const u32x4*)(kt0 + (size_t)kt * 2048 + tid * 8) : *(const u32x4*)(vt0 + (size_t)kt * 2048 + (tid - 256) * 8);
}
DI void atile_store(LAS unsigned char* buf, const u32x4& reg, int tid) { *(LAS u32x4*)(buf + tid * 16) = reg; }
DI void atile_frags(bf16x8 (&kf)[4], bf16x8 (&vf)[2][2], const LAS unsigned char* buf, int c, int hh, int prow) {
    (void)prow;
#pragma unroll
    for (int s = 0; s < 4; ++s) kf[s] = *(const LAS bf16x8*)(buf + ((2 * s + hh) * 32 + c) * 16);
#pragma unroll
    for (int dt = 0; dt < 2; ++dt)
#pragma unroll
        for (int s = 0; s < 2; ++s) vf[dt][s] = *(const LAS bf16x8*)(buf + 4096 + ((dt * 2 + s) * 64 + hh * 32 + c) * 16);
}
template <int MIXER>
DI void sbfg_block(const Args& a, int l, int b, int h, int QB, LAS unsigned char* lds, int tid, int wave, int lane) {
    const bf16* proj = (const bf16*)(a.ws + WS_A);
    const int c = lane & 31, hh = lane >> 5, pr = pi32(c);
    const int ntile = 8 * QB + 8, qb = 8 * QB + wave;
    const size_t tokq = (size_t)b * SEQ + qb * 32 + c;
    const bf16* qp = proj + tokq * PW + (MIXER == 0 ? C_BQ : C_CQ) + h * 64 + 8 * hh;
    bf16x8 qf[4];
#pragma unroll
    for (int s = 0; s < 4; ++s) qf[s] = *(const bf16x8*)(qp + 16 * s);
    const bf16* krow0 = (const bf16*)(a.ws + (MIXER == 0 ? WS_KTB : WS_KTC)) + (size_t)(b * 4 + h) * (SEQ / 32) * 2048;
    const bf16* vt0 = (const bf16*)(a.ws + (MIXER == 0 ? WS_VTB : WS_VTC)) + (size_t)(b * 4 + h) * (SEQ / 32) * 2048;
    const float* cum = (const float*)(a.ws + WS_CUM) + (size_t)(b * 4 + h) * SEQ;
    const float cq = (MIXER == 1) ? cum[qb * 32 + c] : 0.f;
    float Bq = 0.f;
    if (MIXER == 1) { float qs = 0.f;
#pragma unroll
        for (int s = 0; s < 4; ++s) { const u32x4 w = __builtin_bit_cast(u32x4, qf[s]);
            qs += bflo(w.x) * bflo(w.x) + bfhi(w.x) * bfhi(w.x) + bflo(w.y) * bflo(w.y) + bfhi(w.y) * bfhi(w.y) + bflo(w.z) * bflo(w.z) + bfhi(w.z) * bfhi(w.z) + bflo(w.w) * bflo(w.w) + bfhi(w.w) * bfhi(w.w); }
        qs = red32_sum(qs);
        const float k2 = __uint_as_float(((const unsigned*)(a.ws + WS_CTL))[CW_KMAX + l * 32 + b * 4 + h]);
        Bq = sqrtf(qs * k2) * 1.01f + 0.5f; }
    f32x16 o0 = zero16(), o1 = zero16(); float R = 1.f, m = -1.0e30f, l_ = 0.f;
    const bool slot0lo = (__builtin_amdgcn_permlane32_swap((unsigned)hh, (unsigned)hh, false, false)[0] == 0u);
    u32x4 reg;
    atile_load(reg, krow0, vt0, ntile - 1, tid); atile_store(lds, reg, tid);
    if (ntile > 1) { atile_load(reg, krow0, vt0, ntile - 2, tid); atile_store(lds + 8192, reg, tid); }
    __syncthreads();
    bf16x8 kfA[4], vfA[2][2], kfB[4], vfB[2][2];
    atile_frags(kfA, vfA, lds, c, hh, pr);
    int st = 0;
#define SBFG_STEP(JJ, KF, VF, NKF, NVF) { \
        const int kt = ntile - 1 - (JJ); \
        const int st1 = (st == 2) ? 0 : st + 1, st2 = (st1 == 2) ? 0 : st1 + 1; \
        if ((JJ) + 2 < ntile) atile_load(reg, krow0, vt0, kt - 2, tid); \
        if ((JJ) + 1 < ntile) atile_frags(NKF, NVF, lds + st1 * 8192, c, hh, pr); \
        if (kt <= qb) { \
            f32x16 x = zero16(); \
_Pragma("unroll") \
            for (int s = 0; s < 4; ++s) x = mfma32(KF[s], qf[s], x); \
            const bool diag = (kt == qb); \
            float p[16]; \
            if (MIXER == 0) { \
                float rr[16], ex[16], T[2]; \
_Pragma("unroll") \
                for (int i = 0; i < 16; ++i) rr[i] = frcp(1.f + fexp2(x[i])); \
                if (diag) { \
_Pragma("unroll") \
                    for (int i = 0; i < 16; ++i) if (kofs(i, hh) >= c) rr[i] = 1.f; \
                } \
_Pragma("unroll") \
                for (int s = 0; s < 2; ++s) { ex[8 * s + 7] = 1.f; \
_Pragma("unroll") \
                    for (int q = 6; q >= 0; --q) ex[8 * s + q] = ex[8 * s + q + 1] * rr[8 * s + q + 1]; \
                    T[s] = ex[8 * s] * rr[8 * s]; } \
                const auto r0_ = __builtin_amdgcn_permlane32_swap(__float_as_uint(T[0]), __float_as_uint(T[0]), false, false), r1_ = __builtin_amdgcn_permlane32_swap(__float_as_uint(T[1]), __float_as_uint(T[1]), false, false); \
                const float PT0 = __uint_as_float((hh != 0) == slot0lo ? r0_[0] : r0_[1]), PT1 = __uint_as_float((hh != 0) == slot0lo ? r1_[0] : r1_[1]); \
                float suf0, suf1; \
                if (hh == 0) { suf1 = R * PT1; suf0 = suf1 * T[1] * PT0; } else { suf1 = R; suf0 = R * T[1] * PT1; } \
                R = R * (T[0] * T[1]) * (PT0 * PT1); \
_Pragma("unroll") \
                for (int i = 0; i < 16; ++i) p[i] = (ex[i] - ex[i] * rr[i]) * (i < 8 ? suf0 : suf1); \
            } else { \
                const int k0 = kt * 32; \
                float ck[16]; \
_Pragma("unroll") \
                for (int s = 0; s < 2; ++s) { const f32x4 c0 = *(const f32x4*)(cum + k0 + 16 * s + 8 * hh), c1 = *(const f32x4*)(cum + k0 + 16 * s + 8 * hh + 4); \
                    ck[8 * s] = c0.x; ck[8 * s + 1] = c0.y; ck[8 * s + 2] = c0.z; ck[8 * s + 3] = c0.w; ck[8 * s + 4] = c1.x; ck[8 * s + 5] = c1.y; ck[8 * s + 6] = c1.z; ck[8 * s + 7] = c1.w; } \
                float sv[16]; float tmax = -1.0e30f; \
_Pragma("unroll") \
                for (int i = 0; i < 16; ++i) sv[i] = x[i] + (cq - ck[i]); \
                if (diag) { \
_Pragma("unroll") \
                    for (int i = 0; i < 16; ++i) if (kofs(i, hh) > c) sv[i] = -1.0e30f; \
                } \
_Pragma("unroll") \
                for (int i = 0; i < 16; ++i) tmax = fmaxf(tmax, sv[i]); \
                tmax = red32_max(tmax); \
                if (__any(tmax > m)) { \
                    const float mn = fmaxf(m, tmax), al = fexp2(m - mn); m = mn; l_ *= al; \
_Pragma("unroll") \
                    for (int i = 0; i < 16; ++i) { o0[i] *= al; o1[i] *= al; } \
                } \
                float ls = 0.f; \
_Pragma("unroll") \
                for (int i = 0; i < 16; ++i) { p[i] = fexp2(sv[i] - m); ls += p[i]; } \
                l_ += ls; \
            } \
            const bf16x8 pb0 = pack_p(p, 0), pb1 = pack_p(p, 1); \
            o0 = mfma32(VF[0][0], pb0, o0); o0 = mfma32(VF[0][1], pb1, o0); \
            o1 = mfma32(VF[1][0], pb0, o1); o1 = mfma32(VF[1][1], pb1, o1); \
        } \
        if ((JJ) + 2 < ntile) atile_store(lds + st2 * 8192, reg, tid); \
        __syncthreads(); \
        st = st1; \
    }
    LAS unsigned* dflag = (LAS unsigned*)(lds + 24576);
    for (int j = 0; j < ntile; j += 2) {
        SBFG_STEP(j, kfA, vfA, kfB, vfB)
        {
            const int ktj = ntile - 1 - j; const bool started = ktj <= qb;
            bool fin;
            if (MIXER == 0) fin = started && __all(R < 1.0e-12f);
            else { const float cn = (ktj >= 1) ? cum[32 * ktj - 1] : 0.f; fin = started && (ktj >= 1) && __all(Bq + (cq - cn) < m - 40.f); }
            if (lane == 0) dflag[((j >> 1) & 1) * 8 + wave] = fin ? 1u : 0u;
        }
        SBFG_STEP(j + 1, kfB, vfB, kfA, vfA)
        {
            const u32x4 f0 = *(const LAS u32x4*)(dflag + ((j >> 1) & 1) * 8), f1 = *(const LAS u32x4*)(dflag + ((j >> 1) & 1) * 8 + 4);
            if ((f0.x & f0.y & f0.z & f0.w & f1.x & f1.y & f1.z & f1.w) != 0u) break;
        }
    }
#undef SBFG_STEP
    if (MIXER == 0) store_ot((bf16*)(a.ws + WS_B) + tokq * DM + 256 + h * 64, o0, o1, 1.f, hh);
    else { const float lt = red32_sum(l_); store_ot((bf16*)(a.ws + WS_B) + tokq * DM + 512 + h * 64, o0, o1, 1.f / lt, hh); }
}

DI void osm_step(const f32x16& x, int lo, int hi, int hh, bool interior, bool sel, float& m, float& l, f32x16& o0, f32x16& o1, const bf16x8 (&vf)[2][2]) {
    float sv[16];
    if (interior) {
#pragma unroll
        for (int i = 0; i < 16; ++i) sv[i] = x[i];
    } else {
#pragma unroll
        for (int i = 0; i < 16; ++i) { const int ko = kofs(i, hh); sv[i] = (ko <= hi && ko >= lo) ? x[i] : -3.0e38f; }
    }
    float tmax = -3.0e38f;
#pragma unroll
    for (int i = 0; i < 16; ++i) tmax = fmaxf(tmax, sv[i]);
    tmax = red32_max(sel ? tmax : -3.0e38f);
    if (__any(tmax > m)) { const float mn = fmaxf(m, tmax), al = fexp2(m - mn); m = mn; l *= al;
#pragma unroll
        for (int i = 0; i < 16; ++i) { o0[i] *= al; o1[i] *= al; } }
    const float meff = sel ? m : 3.0e38f;
    float p[16]; float ls = 0.f;
#pragma unroll
    for (int i = 0; i < 16; ++i) { p[i] = fexp2(sv[i] - meff); ls += p[i]; }
    l += ls;
    const bf16x8 pb0 = pack_p(p, 0), pb1 = pack_p(p, 1);
    o0 = mfma32(vf[0][0], pb0, o0); o0 = mfma32(vf[0][1], pb1, o0);
    o1 = mfma32(vf[1][0], pb0, o1); o1 = mfma32(vf[1][1], pb1, o1);
}

DI void ld_k4(bf16x8 (&kf)[4], const bf16* kp) {
#pragma unroll
    for (int s = 0; s < 4; ++s) kf[s] = *(const bf16x8*)(kp + 16 * s);
}
DI void ld_v4(bf16x8 (&vf)[2][2], const bf16* vp, int vpitch) {
#pragma unroll
    for (int dt = 0; dt < 2; ++dt)
#pragma unroll
        for (int s = 0; s < 2; ++s) vf[dt][s] = *(const bf16x8*)(vp + (size_t)dt * 32 * vpitch + 16 * s);
}
DI void ld_kt(bf16x8 (&kf)[4], const bf16* tile, int c, int hh) {
#pragma unroll
    for (int s = 0; s < 4; ++s) kf[s] = *(const bf16x8*)(tile + ((2 * s + hh) * 32 + c) * 8);
}
DI void ld_vt(bf16x8 (&vf)[2][2], const bf16* tile, int c, int hh) {
#pragma unroll
    for (int dt = 0; dt < 2; ++dt)
#pragma unroll
        for (int s = 0; s < 2; ++s) vf[dt][s] = *(const bf16x8*)(tile + ((dt * 2 + s) * 64 + hh * 32 + c) * 8);
}
DI unsigned wave_max_u(unsigned v) {
    v = max(v, (unsigned)DPPI((int)v, 0xB1, 0xF, true)); v = max(v, (unsigned)DPPI((int)v, 0x4E, 0xF, true));
    v = max(v, (unsigned)DPPI((int)v, 0x124, 0xF, true)); v = max(v, (unsigned)DPPI((int)v, 0x128, 0xF, true));
    { const auto r = __builtin_amdgcn_permlane16_swap(v, v, false, false); v = max(r[0], r[1]); const auto q = __builtin_amdgcn_permlane32_swap(v, v, false, false); v = max(q[0], q[1]); }
    return v;
}
DI void nsa_unit(const Args& a, int unit, LAS unsigned char* wl, int lane) {
    const bf16* proj = (const bf16*)(a.ws + WS_A);
    const int tok0 = unit * 8, b = tok0 / SEQ, t0 = tok0 % SEQ;
    const int c = lane & 31, hh = lane >> 5, ql = c >> 2, hd = c & 3, pr = pi32(c);
    const int tq = t0 + ql; const size_t tokq = (size_t)tok0 + ql;
    const bf16* qp = proj + tokq * PW + C_AQ + hd * 64 + 8 * hh;
    bf16x8 qf[4];
#pragma unroll
    for (int s = 0; s < 4; ++s) qf[s] = *(const bf16x8*)(qp + 16 * s);
    LAS float* imp = (LAS float*)wl; LAS unsigned* selm = (LAS unsigned*)(wl + 4096); LAS unsigned char* blist = (LAS unsigned char*)(wl + 4096 + 128);
    for (int i = lane; i < 1024; i += 64) imp[i] = 0.f;
    const float* gate = (const float*)(a.ws + WS_GATE) + tokq * 12 + hd * 3;
    const float g0 = gate[0], g1 = gate[1], g2 = gate[2];
    f32x16 of0 = zero16(), of1 = zero16();
    {
        const bf16* kc = (const bf16*)(a.ws + WS_KCMP) + (size_t)b * 16 * 2048;
        const bf16* vt = (const bf16*)(a.ws + WS_VTCMP) + (size_t)b * 16 * 2048;
        const int nmaxq = (tq >= 31) ? ((tq - 31) >> 4) : -1;
        const int nmaxu = (t0 + 7 >= 31) ? ((t0 + 7 - 31) >> 4) : -1;
        const int nmax0 = (t0 >= 31) ? ((t0 - 31) >> 4) : -1;
        const int ntile = (nmaxu >> 5) + 1;
        float m = -1.0e30f, l = 0.f;
        bf16x8 kf[4], nkf[4];
        if (ntile > 0) ld_kt(kf, kc, c, hh);
        for (int kt = 0; kt < ntile; ++kt) {
            ld_kt(nkf, kc + (size_t)(kt + 1 < ntile ? kt + 1 : kt) * 2048, c, hh);
            f32x16 x = zero16();
#pragma unroll
            for (int s = 0; s < 4; ++s) x = mfma32(kf[s], qf[s], x);
            const int lim = nmaxq - kt * 32; float sv[16]; float tmax = -3.0e38f;
            if (kt * 32 + 31 <= nmax0) {
#pragma unroll
                for (int i = 0; i < 16; ++i) sv[i] = x[i];
            } else {
#pragma unroll
                for (int i = 0; i < 16; ++i) sv[i] = (kofs(i, hh) <= lim) ? x[i] : -3.0e38f;
            }
#pragma unroll
            for (int i = 0; i < 16; ++i) tmax = fmaxf(tmax, sv[i]);
            tmax = red32_max(tmax);
            const float mn = fmaxf(m, tmax); float ls = 0.f;
#pragma unroll
            for (int i = 0; i < 16; ++i) ls += fexp2(sv[i] - mn);
            l = l * fexp2(m - mn) + ls; m = mn;
#pragma unroll
            for (int s = 0; s < 4; ++s) kf[s] = nkf[s];
        }
        const float lt = red32_sum(l);
        const float inv = 1.f / fmaxf(lt, 1.0e-30f);
        f32x16 o0 = zero16(), o1 = zero16();
        LDS_WAIT();
        bf16x8 vf[2][2], nvf[2][2];
        if (ntile > 0) { ld_kt(kf, kc, c, hh); ld_vt(vf, vt, c, hh); }
        for (int kt = 0; kt < ntile; ++kt) {
            { const int kn = (kt + 1 < ntile ? kt + 1 : kt); ld_kt(nkf, kc + (size_t)kn * 2048, c, hh); ld_vt(nvf, vt + (size_t)kn * 2048, c, hh); }
            f32x16 x = zero16();
#pragma unroll
            for (int s = 0; s < 4; ++s) x = mfma32(kf[s], qf[s], x);
            float p[16], ps[16], sv[16];
            if (kt * 32 + 31 <= nmax0) {
#pragma unroll
                for (int i = 0; i < 16; ++i) sv[i] = x[i];
            } else {
#pragma unroll
                for (int i = 0; i < 16; ++i) sv[i] = (kofs(i, hh) <= nmaxq - kt * 32) ? x[i] : -3.0e38f;
            }
#pragma unroll
            for (int i = 0; i < 16; ++i) { p[i] = fexp2(sv[i] - m) * inv;
                float t = p[i]; t += dpp_xor1(t); t += dpp_xor2(t); ps[i] = t; }
            if (hd == 0) {
#pragma unroll
                for (int s = 0; s < 2; ++s) { const int gb = (kt * 32 + 16 * s + 8 * hh) >> 2; LAS float* ip = imp + ql * 128 + gb;
                    __hip_atomic_fetch_add(ip, (ps[8 * s] + ps[8 * s + 1]) + (ps[8 * s + 2] + ps[8 * s + 3]), __ATOMIC_RELAXED, __HIP_MEMORY_SCOPE_WORKGROUP);
                    __hip_atomic_fetch_add(ip + 1, ps[8 * s + 3] + (ps[8 * s + 4] + ps[8 * s + 5]) + (ps[8 * s + 6] + ps[8 * s + 7]), __ATOMIC_RELAXED, __HIP_MEMORY_SCOPE_WORKGROUP);
                    if (gb + 2 < 128) __hip_atomic_fetch_add(ip + 2, ps[8 * s + 7], __ATOMIC_RELAXED, __HIP_MEMORY_SCOPE_WORKGROUP); }
            }
            const bf16x8 pb0 = pack_p(p, 0), pb1 = pack_p(p, 1);
            o0 = mfma32(vf[0][0], pb0, o0); o0 = mfma32(vf[0][1], pb1, o0);
            o1 = mfma32(vf[1][0], pb0, o1); o1 = mfma32(vf[1][1], pb1, o1);
            copy_kv(kf, vf, nkf, nvf);
        }
#pragma unroll
        for (int i = 0; i < 16; ++i) { of0[i] = g0 * o0[i]; of1[i] = g0 * o1[i]; }
    }
    LDS_WAIT();
    for (int qi = 0; qi < 8; ++qi) {
        const int qblk = (t0 + qi) >> 6;
        const LAS float* iq = imp + qi * 128;
        const int b0 = lane, b1 = lane + 64;
        const bool ad0 = b0 <= qblk, ad1 = b1 <= qblk;
        const bool f0 = (b0 == 0) || (b0 == qblk) || (b0 == qblk - 1), f1 = (b1 == qblk) || (b1 == qblk - 1);
        unsigned v0 = ad0 ? __float_as_uint(f0 ? iq[b0] + 1.0e6f : iq[b0]) + 1u : 0u, v1 = ad1 ? __float_as_uint(f1 ? iq[b1] + 1.0e6f : iq[b1]) + 1u : 0u;
        unsigned long long m0 = 0ull, m1 = 0ull;
        const int nsel = (qblk + 1 < 16) ? qblk + 1 : 16;
        for (int r = 0; r < nsel; ++r) {
            const unsigned mx = wave_max_u(max(v0, v1));
            const unsigned long long e0 = __ballot(v0 == mx);
            if (e0) { const int idx = __builtin_ctzll(e0); m0 |= 1ull << idx; if (lane == idx) v0 = 0u; }
            else { const unsigned long long e1 = __ballot(v1 == mx); const int idx = __builtin_ctzll(e1); m1 |= 1ull << idx; if (lane == idx) v1 = 0u; }
        }
        if (lane == 0) { selm[qi * 4] = (unsigned)m0; selm[qi * 4 + 1] = (unsigned)(m0 >> 32); selm[qi * 4 + 2] = (unsigned)m1; selm[qi * 4 + 3] = (unsigned)(m1 >> 32); }
    }
    LDS_WAIT();
    {
        unsigned mk[4], um[4]; int nb = 0;
#pragma unroll
        for (int w = 0; w < 4; ++w) { mk[w] = selm[ql * 4 + w]; unsigned u = 0;
#pragma unroll
            for (int q = 0; q < 8; ++q) u |= selm[q * 4 + w];
            um[w] = (unsigned)__builtin_amdgcn_readfirstlane((int)u); }
#pragma unroll
        for (int w = 0; w < 4; ++w) { const unsigned u = um[w]; const int l32 = lane & 31;
            if (lane < 32 && ((u >> l32) & 1u)) blist[nb + __builtin_popcount(u & ((1u << l32) - 1u))] = (unsigned char)(32 * w + l32);
            nb += __builtin_popcount(u); }
        LDS_WAIT();
        const bf16* kbase = (const bf16*)(a.ws + WS_KTS) + (size_t)b * (SEQ / 32) * 2048;
        const bf16* vb0 = (const bf16*)(a.ws + WS_VTAS) + (size_t)b * (SEQ / 32) * 2048;
        f32x16 o0 = zero16(), o1 = zero16(); float m = -1.0e30f, l = 0.f;
        const int nt = 2 * nb;
        bf16x8 kf[4], vf[2][2], nkf[4], nvf[2][2];
        int blk = blist[0];
        { const int t0i = blk * 2; ld_kt(kf, kbase + (size_t)t0i * 2048, c, hh); ld_vt(vf, vb0 + (size_t)t0i * 2048, c, hh); }
#define NSA_SEL_STEP(TT, KF, VF, NKF, NVF) { \
            const int k0 = blk * 64 + 32 * ((TT) & 1); \
            const int tn = ((TT) + 1 < nt) ? (TT) + 1 : (TT); const int blkn = blist[tn >> 1]; \
            { const int tni = blkn * 2 + (tn & 1); ld_kt(NKF, kbase + (size_t)tni * 2048, c, hh); ld_vt(NVF, vb0 + (size_t)tni * 2048, c, hh); } \
            const bool mysel = ((((blk >> 5) == 0 ? mk[0] : (blk >> 5) == 1 ? mk[1] : (blk >> 5) == 2 ? mk[2] : mk[3]) >> (blk & 31)) & 1u) != 0u; \
            f32x16 x = zero16(); \
            _Pragma("unroll") for (int s = 0; s < 4; ++s) x = mfma32(KF[s], qf[s], x); \
            osm_step(x, 0, tq - k0, hh, k0 + 31 <= t0, mysel, m, l, o0, o1, VF); \
            blk = blkn; }
        for (int t = 0; t < nt; t += 2) {
            NSA_SEL_STEP(t, kf, vf, nkf, nvf)
            NSA_SEL_STEP(t + 1, nkf, nvf, kf, vf)
        }
#undef NSA_SEL_STEP
        const float lt = red32_sum(l); const float sc = g1 / fmaxf(lt, 1.0e-30f);
#pragma unroll
        for (int i = 0; i < 16; ++i) { of0[i] += sc * o0[i]; of1[i] += sc * o1[i]; }
    }
    {
        const bf16* kbase = (const bf16*)(a.ws + WS_KTW) + (size_t)b * (SEQ / 32) * 2048;
        const bf16* vb0 = (const bf16*)(a.ws + WS_VTAW) + (size_t)b * (SEQ / 32) * 2048;
        f32x16 o0 = zero16(), o1 = zero16(); float m = -1.0e30f, l = 0.f;
        const int klo = (t0 >= 511) ? ((t0 - 511) >> 5) : 0, khi = (t0 + 7) >> 5;
        bf16x8 kf[4], vf[2][2], nkf[4], nvf[2][2];
        ld_kt(kf, kbase + (size_t)klo * 2048, c, hh); ld_vt(vf, vb0 + (size_t)klo * 2048, c, hh);
        for (int kt = klo; kt <= khi; ++kt) {
            const int k0 = kt * 32;
            { const int kn = (kt < khi ? kt + 1 : kt); ld_kt(nkf, kbase + (size_t)kn * 2048, c, hh); ld_vt(nvf, vb0 + (size_t)kn * 2048, c, hh); }
            f32x16 x = zero16();
#pragma unroll
            for (int s = 0; s < 4; ++s) x = mfma32(kf[s], qf[s], x);
            osm_step(x, tq - 511 - k0, tq - k0, hh, k0 >= t0 + 7 - 511 && k0 + 31 <= t0, true, m, l, o0, o1, vf);
            copy_kv(kf, vf, nkf, nvf);
        }
        const float lt = red32_sum(l); const float sc = g2 / fmaxf(lt, 1.0e-30f);
#pragma unroll
        for (int i = 0; i < 16; ++i) { of0[i] += sc * o0[i]; of1[i] += sc * o1[i]; }
    }
    store_ot((bf16*)(a.ws + WS_B) + tokq * DM + hd * 64, of0, of1, 1.f, hh);
}

#ifndef DSA_REP_S
#define DSA_REP_S 1
#define DSA_REP_L 1
#define DSA_REP_A 1
#endif
#ifndef DSA_REP_1
#define DSA_REP_1 1
#define DSA_REP_2 1
#define DSA_REP_3 1
#endif
constexpr int DSA_CIDX = 132096, DSA_LIST = DSA_CIDX + 16384, DSA_DUMMY = DSA_LIST + 8192;  static_assert(DSA_DUMMY + 8 * 128 <= MISC_OFF, "DSA LDS map");
static_assert(DSA_LIST + 8192 <= MISC_OFF, "DSA LDS map");
typedef short v4i16_t __attribute__((ext_vector_type(4)));
DI unsigned f2key(float f) { const unsigned u = __float_as_uint(f); return u ^ ((u >> 31) ? 0xffffffffu : 0x80000000u); }
DI int wave_excl_scan(int v, int lane) { (void)lane; return wave_incl_scan(v) - v; }
DI int wave_sum_i(int v) {
    v += DPPI(v, 0xB1, 0xF, true); v += DPPI(v, 0x4E, 0xF, true); v += DPPI(v, 0x124, 0xF, true); v += DPPI(v, 0x128, 0xF, true);
    const auto r = __builtin_amdgcn_permlane16_swap((unsigned)v, (unsigned)v, false, false); v = (int)(r[0] + r[1]);
    const auto q = __builtin_amdgcn_permlane32_swap((unsigned)v, (unsigned)v, false, false); return (int)(q[0] + q[1]);
}
template <int NR>
DI unsigned kth_regn(const unsigned (&k)[16], int K) {
    unsigned hi = 0u, lo = 0xffffffffu;
#pragma unroll
    for (int j = 0; j < NR; ++j) { hi = (k[j] > hi) ? k[j] : hi; const unsigned kk = k[j] ? k[j] : 0xffffffffu; lo = (kk < lo) ? kk : lo; }
    hi = max(hi, (unsigned)DPPI((int)hi, 0xB1, 0xF, true)); hi = max(hi, (unsigned)DPPI((int)hi, 0x4E, 0xF, true));
    lo = min(lo, (unsigned)__builtin_amdgcn_update_dpp((int)0xffffffff, (int)lo, 0xB1, 0xF, 0xF, false)); lo = min(lo, (unsigned)__builtin_amdgcn_update_dpp((int)0xffffffff, (int)lo, 0x4E, 0xF, 0xF, false));
    hi = max(hi, (unsigned)DPPI((int)hi, 0x124, 0xF, true)); hi = max(hi, (unsigned)DPPI((int)hi, 0x128, 0xF, true));
    lo = min(lo, (unsigned)__builtin_amdgcn_update_dpp((int)0xffffffff, (int)lo, 0x124, 0xF, 0xF, false)); lo = min(lo, (unsigned)__builtin_amdgcn_update_dpp((int)0xffffffff, (int)lo, 0x128, 0xF, 0xF, false));
    { const auto r = __builtin_amdgcn_permlane16_swap(hi, hi, false, false); hi = max(r[0], r[1]); const auto q = __builtin_amdgcn_permlane32_swap(hi, hi, false, false); hi = max(q[0], q[1]); }
    { const auto r = __builtin_amdgcn_permlane16_swap(lo, lo, false, false); lo = min(r[0], r[1]); const auto q = __builtin_amdgcn_permlane32_swap(lo, lo, false, false); lo = min(q[0], q[1]); }
    const unsigned diff = (unsigned)__builtin_amdgcn_readfirstlane((int)(hi ^ lo));
    if (diff == 0u) return (unsigned)__builtin_amdgcn_readfirstlane((int)hi);
    const int top = 31 - __builtin_clz(diff);
    unsigned prefix = (unsigned)__builtin_amdgcn_readfirstlane((int)hi) & ~((2u << top) - 1u);
#pragma unroll 1
    for (int bit = top; bit >= 0; --bit) {
        const unsigned cand = prefix | (1u << bit); int c = 0;
#pragma unroll
        for (int j = 0; j < NR; ++j) c += __builtin_popcountll(__ballot(k[j] >= cand));
        if (c >= K) prefix = cand;
    }
    return prefix;
}
DI unsigned kth_reg16(const unsigned (&k)[16], int K) { return kth_regn<16>(k, K); }
DI unsigned kth_disp(const unsigned (&k)[16], int K, int nr) { return nr <= 6 ? kth_regn<6>(k, K) : nr <= 8 ? kth_regn<8>(k, K) : nr <= 12 ? kth_regn<12>(k, K) : kth_regn<16>(k, K); }
DI void dsa_attend(const Args& a, const bf16* proj, int b, size_t tokq, const LAS unsigned short* list, int cnt, LAS unsigned char* stg, int lane) {
        const int col = lane & 15, quad = lane >> 4, hd = col & 3;
        const bf16* qp = proj + tokq * PW + C_DQ + hd * 64 + 8 * quad;
        const bf16x8 qb0 = *(const bf16x8*)qp, qb1 = *(const bf16x8*)(qp + 32);
        const bf16* krow0 = proj + (size_t)b * SEQ * PW + C_DK; const bf16* vrow0 = proj + (size_t)b * SEQ * PW + C_DV;
        const int grow_ = lane >> 3, piece_ = lane & 7;
        f32x4 o[4];
#pragma unroll
        for (int dt = 0; dt < 4; ++dt) o[dt] = (f32x4){0.f, 0.f, 0.f, 0.f};
        float mrun = -1.0e30f, ls = 0.f;
#pragma unroll 1
        for (int ch = 0; ch < 2; ++ch) {
            if (ch * 128 >= cnt) break;
            int grow = grow_, piece = piece_; asm volatile("" : "+v"(grow), "+v"(piece));
            u32x4 wk[16], wv[16];
#pragma unroll
            for (int it = 0; it < 16; ++it) { const int j = ch * 128 + it * 8 + grow; const unsigned kidx = (j < cnt) ? (unsigned)list[j] : 0u;
                wk[it] = *(const u32x4*)(krow0 + (size_t)kidx * PW + 8 * piece); wv[it] = *(const u32x4*)(vrow0 + (size_t)kidx * PW + 8 * piece); }
#pragma unroll
            for (int it = 0; it < 16; ++it) { const int row = it * 8 + grow; *(LAS u32x4*)(stg + row * 128 + ((piece ^ (row & 7)) * 16)) = wk[it]; }
            LDS_WAIT();
            float sr[8][4];
            {
                int colq = col, quadq = quad; asm volatile("" : "+v"(colq), "+v"(quadq));
#pragma unroll
                for (int kt = 0; kt < 8; ++kt) {
                    const int row = kt * 16 + colq;
                    const bf16x8 a0 = *(const LAS bf16x8*)(stg + row * 128 + ((quadq ^ (row & 7)) * 16)), a1 = *(const LAS bf16x8*)(stg + row * 128 + (((quadq + 4) ^ (row & 7)) * 16));
                    f32x4 d = (f32x4){0.f, 0.f, 0.f, 0.f};
                    d = mfma16(a0, qb0, d); d = mfma16(a1, qb1, d);
#pragma unroll
                    for (int i = 0; i < 4; ++i) sr[kt][i] = (ch * 128 + kt * 16 + 4 * quadq + i < cnt) ? d[i] : -1.0e30f;
                }
            }
            float mx = -1.0e30f;
#pragma unroll
            for (int kt = 0; kt < 8; ++kt)
#pragma unroll
                for (int i = 0; i < 4; ++i) mx = fmaxf(mx, sr[kt][i]);
            mx = red16_max(mx); mx = red32_max(mx);
            const float mn = fmaxf(mrun, mx), al = fexp2(mrun - mn); mrun = mn;
            float lc = 0.f;
#pragma unroll
            for (int kt = 0; kt < 8; ++kt)
#pragma unroll
                for (int i = 0; i < 4; ++i) { const float p = (sr[kt][i] > -1.0e29f) ? fexp2(sr[kt][i] - mn) : 0.f; sr[kt][i] = p; lc += p; }
            lc = red16_sum(lc); lc = red32_sum(lc);
            ls = ls * al + lc;
#pragma unroll
            for (int dt = 0; dt < 4; ++dt) o[dt] = o[dt] * al;
            LDS_WAIT();
#pragma unroll
            for (int it = 0; it < 16; ++it) { const int row = it * 8 + grow; *(LAS u32x4*)(stg + row * 128 + ((piece ^ (row & 7)) * 16)) = wv[it]; }
            LDS_WAIT();
            {
                int colp = col, quadp = quad; asm volatile("" : "+v"(colp), "+v"(quadp));
#pragma unroll
                for (int g = 0; g < 4; ++g) {
                    u32x4 pw; pw.x = cvtpk(sr[2 * g][0], sr[2 * g][1]); pw.y = cvtpk(sr[2 * g][2], sr[2 * g][3]); pw.z = cvtpk(sr[2 * g + 1][0], sr[2 * g + 1][1]); pw.w = cvtpk(sr[2 * g + 1][2], sr[2 * g + 1][3]);
                    const bf16x8 pb = __builtin_bit_cast(bf16x8, pw);
                    const int klo = 32 * g + 4 * quadp + (colp >> 2), khi = klo + 16;
#pragma unroll
                    for (int dt = 0; dt < 4; ++dt) { const int pc = 2 * dt + ((colp & 3) >> 1), bo = (colp & 1) * 8;
                        const v4i16_t lo = __builtin_amdgcn_ds_read_tr16_b64_v4i16((LAS v4i16_t*)(stg + klo * 128 + ((pc ^ (klo & 7)) * 16) + bo));
                        const v4i16_t hi = __builtin_amdgcn_ds_read_tr16_b64_v4i16((LAS v4i16_t*)(stg + khi * 128 + ((pc ^ (khi & 7)) * 16) + bo));
                        const bf16x8 av = (bf16x8){lo[0], lo[1], lo[2], lo[3], hi[0], hi[1], hi[2], hi[3]};
                        o[dt] = mfma16(av, pb, o[dt]); }
                }
            }
            LDS_WAIT();
        }
        if (col < 4) { const float inv = 1.f / ls; bf16* om = (bf16*)(a.ws + WS_B) + tokq * DM + 768 + hd * 64 + 4 * quad;
#pragma unroll
            for (int dt = 0; dt < 4; ++dt) { float v[4] = {o[dt][0] * inv, o[dt][1] * inv, o[dt][2] * inv, o[dt][3] * inv}; st4bf(om + 16 * dt, v); } }
    }

DI void dsa_attend2(const Args& a, const bf16* proj, int b, size_t tokA, const LAS unsigned short* listA, int cntA, size_t tokB, const LAS unsigned short* listB, int cntB, LAS unsigned char* stg, int lane) {
    const int col = lane & 15, quad = lane >> 4, hd = col & 3;
    const bf16* krow0 = proj + (size_t)b * SEQ * PW + C_DK; const bf16* vrow0 = proj + (size_t)b * SEQ * PW + C_DV;
    const int grow_ = lane >> 3, piece_ = lane & 7;
    const int ncA = (cntA + 63) >> 6, nc = ncA + ((cntB + 63) >> 6);
    bf16x8 qb0, qb1; f32x4 o[4]; float mrun = -1.0e30f, ls = 0.f;
    u32x4 wk0[8], wv0[8], wk1[8], wv1[8];
#define DSA_GATHER(WK, WV, CI) { const bool isb_ = (CI) >= ncA; const int ch_ = isb_ ? (CI) - ncA : (CI); const int cnt_ = isb_ ? cntB : cntA; const LAS unsigned short* li_ = isb_ ? listB : listA; \
        int grow = grow_, piece = piece_; asm volatile("" : "+v"(grow), "+v"(piece)); \
        _Pragma("unroll") for (int it = 0; it < 8; ++it) { const int j = ch_ * 64 + it * 8 + grow; const unsigned kidx = (j < cnt_) ? (unsigned)li_[j] : 0u; \
            WK[it] = *(const u32x4*)(krow0 + (size_t)kidx * PW + 8 * piece); WV[it] = *(const u32x4*)(vrow0 + (size_t)kidx * PW + 8 * piece); } }
#define DSA_CHUNK(WK, WV, CI) { const bool isb_ = (CI) >= ncA; const int ch_ = isb_ ? (CI) - ncA : (CI); const int cnt_ = isb_ ? cntB : cntA; \
        if (ch_ == 0) { const bf16* qp = proj + (isb_ ? tokB : tokA) * PW + C_DQ + hd * 64 + 8 * quad; qb0 = *(const bf16x8*)qp; qb1 = *(const bf16x8*)(qp + 32); mrun = -1.0e30f; ls = 0.f; \
            _Pragma("unroll") for (int dt = 0; dt < 4; ++dt) o[dt] = (f32x4){0.f, 0.f, 0.f, 0.f}; } \
        int grow = grow_, piece = piece_; asm volatile("" : "+v"(grow), "+v"(piece)); \
        _Pragma("unroll") for (int it = 0; it < 8; ++it) { const int row = it * 8 + grow; *(LAS u32x4*)(stg + row * 128 + ((piece ^ (row & 7)) * 16)) = WK[it]; } \
        LDS_WAIT(); \
        float sr[4][4]; \
        { int colq = col, quadq = quad; asm volatile("" : "+v"(colq), "+v"(quadq)); \
          _Pragma("unroll") for (int kt = 0; kt < 4; ++kt) { const int row = kt * 16 + colq; \
            const bf16x8 a0 = *(const LAS bf16x8*)(stg + row * 128 + ((quadq ^ (row & 7)) * 16)), a1 = *(const LAS bf16x8*)(stg + row * 128 + (((quadq + 4) ^ (row & 7)) * 16)); \
            f32x4 d = (f32x4){0.f, 0.f, 0.f, 0.f}; d = mfma16(a0, qb0, d); d = mfma16(a1, qb1, d); \
            _Pragma("unroll") for (int i = 0; i < 4; ++i) sr[kt][i] = (ch_ * 64 + kt * 16 + 4 * quadq + i < cnt_) ? d[i] : -3.0e38f; } } \
        float mx = -3.0e38f; \
        _Pragma("unroll") for (int kt = 0; kt < 4; ++kt) _Pragma("unroll") for (int i = 0; i < 4; ++i) mx = fmaxf(mx, sr[kt][i]); \
        mx = red16_max(mx); mx = red32_max(mx); \
        const float mn = fmaxf(mrun, mx), al = fexp2(mrun - mn); mrun = mn; \
        float lc = 0.f; \
        _Pragma("unroll") for (int kt = 0; kt < 4; ++kt) _Pragma("unroll") for (int i = 0; i < 4; ++i) { const float p = fexp2(sr[kt][i] - mn); sr[kt][i] = p; lc += p; } \
        lc = red16_sum(lc); lc = red32_sum(lc); ls = ls * al + lc; \
        _Pragma("unroll") for (int dt = 0; dt < 4; ++dt) o[dt] = o[dt] * al; \
        LDS_WAIT(); \
        _Pragma("unroll") for (int it = 0; it < 8; ++it) { const int row = it * 8 + grow; *(LAS u32x4*)(stg + row * 128 + ((piece ^ (row & 7)) * 16)) = WV[it]; } \
        LDS_WAIT(); \
        { int colp = col, quadp = quad; asm volatile("" : "+v"(colp), "+v"(quadp)); \
          _Pragma("unroll") for (int g = 0; g < 2; ++g) { \
            u32x4 pw; pw.x = cvtpk(sr[2 * g][0], sr[2 * g][1]); pw.y = cvtpk(sr[2 * g][2], sr[2 * g][3]); pw.z = cvtpk(sr[2 * g + 1][0], sr[2 * g + 1][1]); pw.w = cvtpk(sr[2 * g + 1][2], sr[2 * g + 1][3]); \
            const bf16x8 pb = __builtin_bit_cast(bf16x8, pw); \
            const int klo = 32 * g + 4 * quadp + (colp >> 2), khi = klo + 16; \
            _Pragma("unroll") for (int dt = 0; dt < 4; ++dt) { const int pc = 2 * dt + ((colp & 3) >> 1), bo = (colp & 1) * 8; \
                const v4i16_t lo = __builtin_amdgcn_ds_read_tr16_b64_v4i16((LAS v4i16_t*)(stg + klo * 128 + ((pc ^ (klo & 7)) * 16) + bo)); \
                const v4i16_t hi = __builtin_amdgcn_ds_read_tr16_b64_v4i16((LAS v4i16_t*)(stg + khi * 128 + ((pc ^ (khi & 7)) * 16) + bo)); \
                const bf16x8 av = (bf16x8){lo[0], lo[1], lo[2], lo[3], hi[0], hi[1], hi[2], hi[3]}; \
                o[dt] = mfma16(av, pb, o[dt]); } } } \
        LDS_WAIT(); \
        const int nch_ = isb_ ? nc - ncA : ncA; \
        if (ch_ == nch_ - 1 && col < 4) { const float inv = 1.f / ls; bf16* om = (bf16*)(a.ws + WS_B) + (isb_ ? tokB : tokA) * DM + 768 + hd * 64 + 4 * quad; \
            _Pragma("unroll") for (int dt = 0; dt < 4; ++dt) { float v[4] = {o[dt][0] * inv, o[dt][1] * inv, o[dt][2] * inv, o[dt][3] * inv}; st4bf(om + 16 * dt, v); } } }
    if (nc > 0) DSA_GATHER(wk0, wv0, 0)
    for (int ci = 0; ci < nc; ci += 2) {
        if (ci + 1 < nc) DSA_GATHER(wk1, wv1, ci + 1)
        DSA_CHUNK(wk0, wv0, ci)
        if (ci + 1 < nc) {
            if (ci + 2 < nc) DSA_GATHER(wk0, wv0, ci + 2)
            DSA_CHUNK(wk1, wv1, ci + 1)
        }
    }
#undef DSA_GATHER
#undef DSA_CHUNK
}

typedef unsigned short u16x2_t __attribute__((ext_vector_type(2)));
DI unsigned pkmax16(unsigned x, unsigned y) { return __builtin_bit_cast(unsigned, __builtin_elementwise_max(__builtin_bit_cast(u16x2_t, x), __builtin_bit_cast(u16x2_t, y))); }
DI unsigned f2key16s(float f) { const unsigned h = (unsigned)__builtin_bit_cast(unsigned short, (_Float16)f); return h ^ ((unsigned)((int)__float_as_uint(f) >> 31) | 0x8000u); }
DI unsigned f2key16(float f) { const unsigned h = (unsigned)__builtin_bit_cast(unsigned short, (_Float16)f); return (h & 0x8000u) ? (~h & 0xffffu) : (h | 0x8000u); }
template <int NR>
DI int dsa_pick(const LAS unsigned short* s16, const LAS unsigned short* cidx, LAS unsigned short* list, int c, int lane, unsigned long long ltm, unsigned& tau) {
    unsigned ck[16], ixs[16];
#pragma unroll
    for (int j = 0; j < 16; ++j) { ck[j] = 0u; ixs[j] = 0u; }
#pragma unroll
    for (int j = 0; j < NR; ++j) ixs[j] = (unsigned)cidx[j * 64 + lane];
#pragma unroll
    for (int j = 0; j < NR; ++j) ixs[j] = (j * 64 + lane < c) ? ixs[j] : 0u;
#pragma unroll
    for (int j = 0; j < NR; ++j) ck[j] = (unsigned)s16[ixs[j]];
#pragma unroll
    for (int j = 0; j < NR; ++j) ck[j] = (j * 64 + lane < c) ? ck[j] : 0u;
    tau = kth_regn<NR>(ck, 256);
    int cg = 0;
#pragma unroll
    for (int j = 0; j < NR; ++j) cg += (ck[j] > tau) ? 1 : 0;
    const int krem = 256 - wave_sum_i(cg);
    int total = 0, eqt = 0;
#pragma unroll
    for (int j = 0; j < NR; ++j) {
        if (j * 64 < c) {
            const bool gt = ck[j] > tau, eq = ck[j] == tau;
            const unsigned long long eqm = __ballot(eq); const int eqp = __popcll(eqm & ltm);
            const bool take = gt || (eq && (eqt + eqp < krem));
            const unsigned long long tm = __ballot(take); const int pos = total + __popcll(tm & ltm);
            if (take) list[pos] = (unsigned short)ixs[j];
            total += __popcll(tm); eqt += __popcll(eqm);
        }
    }
    return total;
}
DI void dsa_unit16(const Args& a, int pu, LAS unsigned char* lds, int wave, int lane) {
    const bf16* proj = (const bf16*)(a.ws + WS_A);
    const int b = pu >> 9, p = pu & 511;
    const int tA0 = 8 * p, tB0 = 8184 - 8 * p, nA = tA0 + 8, nB = tB0 + 8;
    const int na32 = (nA + 31) & ~31, nb32 = (nB + 31) & ~31;
    LAS unsigned short* sc = (LAS unsigned short*)lds;
    {
        const int c = lane & 31, hh = lane >> 5, qr = c >> 2, hr = c & 3;
        const size_t tokA = (size_t)b * SEQ + tA0, tokB = (size_t)b * SEQ + tB0;
        bf16x8 iqA[4], iqB[4];
#pragma unroll
        for (int s = 0; s < 4; ++s) { iqA[s] = *(const bf16x8*)(proj + (tokA + qr) * PW + C_DIQ + hr * 64 + 16 * s + 8 * hh); iqB[s] = *(const bf16x8*)(proj + (tokB + qr) * PW + C_DIQ + hr * 64 + 16 * s + 8 * hh); }
        f32x4 iwA[4], iwB[4];
#pragma unroll
        for (int g = 0; g < 4; ++g) { iwA[g] = *(const f32x4*)((const float*)(a.ws + WS_IW) + (tokA + 2 * g + hh) * 4); iwB[g] = *(const f32x4*)((const float*)(a.ws + WS_IW) + (tokB + 2 * g + hh) * 4); }
        const bf16* kb = (const bf16*)(a.ws + WS_IKT) + (size_t)b * (SEQ / 32) * 2048;
        const int ntA = na32 >> 5, ntB = nb32 >> 5;
        LAS unsigned short* dA = sc + hh * na32 + c; LAS unsigned short* dB = sc + 8 * na32 + hh * nb32 + c;
#define DSA_EPI(X, IW, T0, DST, PITCH, K0, MASK) { _Pragma("unroll") for (int g = 0; g < 4; ++g) { \
            const float r0 = __builtin_amdgcn_fmed3f(X[4 * g], 0.f, 3.0e38f), r1 = __builtin_amdgcn_fmed3f(X[4 * g + 1], 0.f, 3.0e38f); \
            const float r2 = __builtin_amdgcn_fmed3f(X[4 * g + 2], 0.f, 3.0e38f), r3 = __builtin_amdgcn_fmed3f(X[4 * g + 3], 0.f, 3.0e38f); \
            float a0 = __builtin_fmaf(IW[g].x, r0, 0.f), a1 = __builtin_fmaf(IW[g].y, r1, 0.f); a0 = __builtin_fmaf(IW[g].z, r2, a0); a1 = __builtin_fmaf(IW[g].w, r3, a1); \
            unsigned key = f2key16s(a0 + a1); if (MASK) key = ((K0) + c <= (T0) + 2 * g + hh) ? key : 0u; \
            (DST)[2 * g * (PITCH) + (K0)] = (unsigned short)key; } }
        bf16x8 kf[4], nkf[4];
        if (wave < ntB) ld_kt(kf, kb + (size_t)wave * 2048, c, hh);
        for (int kt = wave; kt < ntB; kt += NWAVES) {
            { const int kn = (kt + NWAVES < ntB) ? kt + NWAVES : kt; ld_kt(nkf, kb + (size_t)kn * 2048, c, hh); }
            const int k0 = kt * 32; const bool hasA = kt < ntA;
            f32x16 x = zero16(), y = zero16();
#pragma unroll
            for (int s = 0; s < 4; ++s) x = mfma32(iqB[s], kf[s], x);
            if (hasA) {
#pragma unroll
                for (int s = 0; s < 4; ++s) y = mfma32(iqA[s], kf[s], y);
            }
            if (k0 + 31 > tB0) DSA_EPI(x, iwB, tB0, dB, nb32, k0, true) else DSA_EPI(x, iwB, tB0, dB, nb32, k0, false)
            if (hasA) { if (k0 + 31 > tA0) DSA_EPI(y, iwA, tA0, dA, na32, k0, true) else DSA_EPI(y, iwA, tA0, dA, na32, k0, false) }
#pragma unroll
            for (int s = 0; s < 4; ++s) kf[s] = nkf[s];
        }
#undef DSA_EPI
    }
    __syncthreads();
    LAS unsigned short* cidx = (LAS unsigned short*)(lds + DSA_CIDX + wave * 2048);
    LAS unsigned short* dummy = (LAS unsigned short*)(lds + DSA_DUMMY + wave * 128) + lane;
    const unsigned long long ltm = (1ull << lane) - 1ull;
    int cntA = 0, cntB = 0;
#pragma unroll 1
    for (int blk = 0; blk < 2; ++blk) {
        const int tq = (blk ? tB0 : tA0) + wave, n = tq + 1, n32 = (blk ? nb32 : na32);
        const LAS unsigned short* s16 = sc + (blk ? 8 * na32 + wave * nb32 : wave * na32);
        LAS unsigned short* list = (LAS unsigned short*)(lds + DSA_LIST + (blk * 8 + wave) * 512);
        int cnt;
        if (n <= 256) { for (int i = lane; i < n; i += 64) list[i] = (unsigned short)i; cnt = n; }
        else {
            int c = 0;
            if (n <= 1024) { for (int i = lane; i < n; i += 64) cidx[i] = (unsigned short)i; c = n; }
            else {
                const bool cs4 = n <= 2048; unsigned M[16];
#pragma unroll
                for (int it = 0; it < 16; ++it) {
                    const int i8 = (cs4 ? (it >> 1) : it) * 512 + lane * 8; unsigned mx = 0u;
                    if (i8 < n32) { const u32x4 v = *(const LAS u32x4*)(s16 + i8);
                        if (cs4) { const unsigned m2 = (it & 1) ? pkmax16(v.z, v.w) : pkmax16(v.x, v.y); mx = max(m2 & 0xffffu, m2 >> 16); }
                        else { const unsigned m4 = pkmax16(pkmax16(v.x, v.y), pkmax16(v.z, v.w)); mx = max(m4 & 0xffffu, m4 >> 16); } }
                    if (cs4 && it >= 8) mx = 0u;
                    M[it] = mx;
                }
                const unsigned beta = kth_disp(M, 256, cs4 ? ((n32 + 255) >> 8) : ((n32 + 511) >> 9));
                for (int i0 = 0; i0 < n32; i0 += 512) {
                    const int i8 = i0 + lane * 8;
                    u32x4 v = (u32x4){0u, 0u, 0u, 0u}; if (i8 < n32) v = *(const LAS u32x4*)(s16 + i8);
                    const unsigned kk[8] = {v.x & 0xffffu, v.x >> 16, v.y & 0xffffu, v.y >> 16, v.z & 0xffffu, v.z >> 16, v.w & 0xffffu, v.w >> 16};
                    int fc = 0;
#pragma unroll
                    for (int k = 0; k < 8; ++k) fc += (kk[k] >= beta) ? 1 : 0;
                    const int inc = wave_incl_scan(fc); int pos = c + inc - fc;
#pragma unroll
                    for (int k = 0; k < 8; ++k) { const bool cd = kk[k] >= beta;
                        LAS unsigned short* d = (cd && pos < 1024) ? (cidx + pos) : dummy; *d = (unsigned short)(i8 + k); pos += cd ? 1 : 0; }
                    c += __builtin_amdgcn_readlane(inc, 63);
                }
                LDS_WAIT();
            }
            unsigned tau; bool fromc = (c <= 1024);
            if (fromc) {
                const int nr = (c + 63) >> 6;
                cnt = nr <= 6 ? dsa_pick<6>(s16, cidx, list, c, lane, ltm, tau) : nr <= 8 ? dsa_pick<8>(s16, cidx, list, c, lane, ltm, tau) : nr <= 12 ? dsa_pick<12>(s16, cidx, list, c, lane, ltm, tau) : dsa_pick<16>(s16, cidx, list, c, lane, ltm, tau);
            } else {
                tau = 0u;
                for (int bit = 15; bit >= 0; --bit) {
                    const unsigned cand = tau | (1u << bit); int cc = 0;
                    for (int i = lane; i < n; i += 64) cc += ((unsigned)s16[i] >= cand) ? 1 : 0;
                    if (wave_sum_i(cc) >= 256) tau = cand;
                }
                int cg = 0;
                for (int i = lane; i < n; i += 64) cg += ((unsigned)s16[i] > tau) ? 1 : 0;
                const int krem = 256 - wave_sum_i(cg);
                int total = 0, eqt = 0;
                for (int i0 = 0; i0 < n; i0 += 64) {
                    const int i = i0 + lane; const unsigned key = (i < n) ? (unsigned)s16[i] : 0u;
                    const bool gt = key > tau, eq = (i < n) && key == tau;
                    const unsigned long long eqm = __ballot(eq); const int eqp = __popcll(eqm & ltm);
                    const bool take = gt || (eq && (eqt + eqp < krem));
                    const unsigned long long tm = __ballot(take); const int pos = total + __popcll(tm & ltm);
                    if (take) list[pos] = (unsigned short)i;
                    total += __popcll(tm); eqt += __popcll(eqm);
                }
                cnt = total;
            }
        }
        if (blk) cntB = cnt; else cntA = cnt;
    }
    __syncthreads();
    dsa_attend2(a, proj, b, (size_t)b * SEQ + tA0 + wave, (const LAS unsigned short*)(lds + DSA_LIST + wave * 512), cntA, (size_t)b * SEQ + tB0 + wave, (const LAS unsigned short*)(lds + DSA_LIST + (8 + wave) * 512), cntB, lds + wave * 16384, lane);
    __syncthreads();
}

#ifndef HOSTDUP
#define HOSTDUP 0
#endif
#ifndef MK_SINGLE
#define MK_SINGLE 1
#endif
constexpr int PRM_OFF = MISC_OFF + 256;
DI void store_args(LAS unsigned char* lds, const Args& k) {
    LAS unsigned long long* q = (LAS unsigned long long*)(lds + PRM_OFF);
    q[0] = (unsigned long long)k.x; q[1] = (unsigned long long)k.pos; q[2] = (unsigned long long)k.w_in; q[3] = (unsigned long long)k.b_f; q[4] = (unsigned long long)k.pe_cmp;
    q[5] = (unsigned long long)k.w_cmp1; q[6] = (unsigned long long)k.w_cmp2; q[7] = (unsigned long long)k.w_gate; q[8] = (unsigned long long)k.w_br; q[9] = (unsigned long long)k.w_o;
    q[10] = (unsigned long long)k.ln1_g; q[11] = (unsigned long long)k.ln1_b; q[12] = (unsigned long long)k.w_router; q[13] = (unsigned long long)k.router_bias;
    q[14] = (unsigned long long)k.w_eg; q[15] = (unsigned long long)k.w_eu; q[16] = (unsigned long long)k.w_ed; q[17] = (unsigned long long)k.w_sg; q[18] = (unsigned long long)k.w_su; q[19] = (unsigned long long)k.w_sd;
    q[20] = (unsigned long long)k.ln2_g; q[21] = (unsigned long long)k.ln2_b; q[22] = (unsigned long long)k.out; q[23] = (unsigned long long)k.ws;
}
DI unsigned long long ldprm(LAS unsigned char* lds, int i) {
    const u32x2 v = *(const LAS u32x2*)(lds + PRM_OFF + 8 * i);
    return ((unsigned long long)(unsigned)__builtin_amdgcn_readfirstlane((int)v.y) << 32) | (unsigned long long)(unsigned)__builtin_amdgcn_readfirstlane((int)v.x);
}
DI Args lds_args(LAS unsigned char* lds) {
    Args a;
    a.x = (const float*)(const GAS float*)ldprm(lds, 0); a.pos = (const int*)(const GAS int*)ldprm(lds, 1); a.w_in = (const float*)(const GAS float*)ldprm(lds, 2); a.b_f = (const float*)(const GAS float*)ldprm(lds, 3); a.pe_cmp = (const float*)(const GAS float*)ldprm(lds, 4);
    a.w_cmp1 = (const float*)(const GAS float*)ldprm(lds, 5); a.w_cmp2 = (const float*)(const GAS float*)ldprm(lds, 6); a.w_gate = (const float*)(const GAS float*)ldprm(lds, 7); a.w_br = (const float*)(const GAS float*)ldprm(lds, 8); a.w_o = (const float*)(const GAS float*)ldprm(lds, 9);
    a.ln1_g = (const float*)(const GAS float*)ldprm(lds, 10); a.ln1_b = (const float*)(const GAS float*)ldprm(lds, 11); a.w_router = (const float*)(const GAS float*)ldprm(lds, 12); a.router_bias = (const float*)(const GAS float*)ldprm(lds, 13);
    a.w_eg = (const float*)(const GAS float*)ldprm(lds, 14); a.w_eu = (const float*)(const GAS float*)ldprm(lds, 15); a.w_ed = (const float*)(const GAS float*)ldprm(lds, 16); a.w_sg = (const float*)(const GAS float*)ldprm(lds, 17); a.w_su = (const float*)(const GAS float*)ldprm(lds, 18); a.w_sd = (const float*)(const GAS float*)ldprm(lds, 19);
    a.ln2_g = (const float*)(const GAS float*)ldprm(lds, 20); a.ln2_b = (const float*)(const GAS float*)ldprm(lds, 21); a.out = (float*)(GAS float*)ldprm(lds, 22); a.ws = (unsigned char*)(GAS unsigned char*)ldprm(lds, 23); a.ph_lo = 0; a.ph_hi = 0;
    return a;
}
#ifndef PHMASK
#define PHMASK 0xffffffffu
#endif
#define PHON(j) (((PHMASK) >> (j)) & 1u)
#define PH_BEGIN const Args a = lds_args(lds); unsigned char* ws = a.ws; (void)ws; \
    const int tid = ltid(), lane = tid & 63, wave = __builtin_amdgcn_readfirstlane(tid >> 6); \
    const int G = lgrid(), bid = lbid(), gw = bid * NWAVES + wave, NGW = G * NWAVES; (void)bid; (void)lane; (void)wave; (void)gw; (void)NGW; (void)G;
#ifndef PH_NOINLINE
#define PHFN DI void
#else
#define PHFN __attribute__((noinline)) __device__ void
#endif

PHFN f_prologue(LAS unsigned char* lds) { PH_BEGIN ph_prologue(a, gw, NGW, lane); }
PHFN f_cvt(LAS unsigned char* lds, int l) { PH_BEGIN ph_cvt(a, l, lds, gw, NGW, wave, lane); }
PHFN f_proj(LAS unsigned char* lds) { PH_BEGIN
    SchedProj S; S.so.init(NTOK, PW, G, bid); S.A = (unsigned)WS_XB; S.B = (unsigned)W_IN;
    EpiProj E; E.proj = (bf16*)(ws + WS_A); E.sm32 = (float*)(ws + WS_SM32);
    gs::gemm_stream<SchedProj, EpiProj, 2>(lds, (const char*)ws, S, E); }
PHFN f_post(LAS unsigned char* lds, int l) { PH_BEGIN ph_post(a, l, lds, wave, lane); }
PHFN f_cmp(LAS unsigned char* lds) { PH_BEGIN
    SchedCmp S; S.kcr = (unsigned)WS_KCR; S.vcr = (unsigned)WS_VCR; S.w = (unsigned)W_C1;
    EpiCmp E; E.hid = (float*)(ws + WS_HID); E.cbias = (const float*)(ws + WS_CBIAS);
    gs::gemm_stream<SchedCmp, EpiCmp, 2>(lds, (const char*)ws, S, E);
    if (bid >= 32 && bid < 64 && wave == 0) cumsum_seq(a, bid - 32, lane);
    if (G < 64 && bid == 0 && wave == 1) for (int q = (G > 32 ? G - 32 : 0); q < 32; ++q) cumsum_seq(a, q, lane); }
PHFN f_cmp2(LAS unsigned char* lds, int l) { PH_BEGIN ph_cmp2(a, l, gw, NGW, lane); }
PHFN f_dsa(LAS unsigned char* lds) { PH_BEGIN for (int pu = bid; pu < NTOK / 16; pu += G) dsa_unit16(a, pu, lds, wave, lane); }
PHFN f_nsa(LAS unsigned char* lds) { PH_BEGIN
    for (int u = gw, r = 0; u < NTOK / 8; u += NGW, ++r) {
        int unit = u;
        if (NGW == 2048) { const int bsel = u >> 10, pos = ((u & 1023) + 256 * r) & 1023; unit = bsel * 1024 + pos; }
        nsa_unit(a, unit, lds + wave * 5120, lane);
    } }
PHFN f_sbfg(LAS unsigned char* lds, int l) { PH_BEGIN
    for (int u = bid; u < 2048; u += G) {
        const int r = u >> 8, blk = u & 255, bh = blk & 31, f = blk >> 5, mixer = r >> 2, rr = r & 3;
        const int QB = (rr == 0) ? f : (rr == 1) ? 31 - f : (rr == 2) ? 8 + f : 23 - f;
        if (mixer == 0) sbfg_block<0>(a, l, bh >> 2, bh & 3, QB, lds, tid, wave, lane); else sbfg_block<1>(a, l, bh >> 2, bh & 3, QB, lds, tid, wave, lane);
        __syncthreads();
    } }
PHFN f_merge(LAS unsigned char* lds) { PH_BEGIN
    SchedMerge S; S.xb = (unsigned)WS_XB; S.om = (unsigned)WS_B; S.wg = (unsigned)W_G; S.wbr = (unsigned)W_BR; S.G = G;
    EpiMerge E; E.merged = (bf16*)(ws + WS_C); E.lds = lds;
    gs::gemm_stream<SchedMerge, EpiMerge, 1>(lds, (const char*)ws, S, E); }
PHFN f_wo(LAS unsigned char* lds, int l) { PH_BEGIN
    SchedWo S; S.so.init(NTOK, DM, G, bid); S.A = (unsigned)WS_C; S.B = (unsigned)W_O;
    EpiWo E; E.xb = (bf16*)(ws + WS_XB); (void)l;
    gs::gemm_stream<SchedWo, EpiWo, 2>(lds, (const char*)ws, S, E); }
PHFN f_ln1(LAS unsigned char* lds, int l) { PH_BEGIN ph_ln1(a, l, gw, NGW, lane); }
PHFN f_router(LAS unsigned char* lds) { PH_BEGIN
    SchedRouter S; S.xh = (unsigned)WS_XB; S.xl = (unsigned)WS_XL; S.wh = (unsigned)W_RH; S.wl = (unsigned)W_RL; S.G = G;
    EpiRouter E; E.logit = (float*)(ws + WS_LOGIT);
    gs::gemm_stream<SchedRouter, EpiRouter, 1>(lds, (const char*)ws, S, E); }
PHFN f_route(LAS unsigned char* lds, int l) { PH_BEGIN ph_route(a, l, lds, wave, lane); }
PHFN f_e1(LAS unsigned char* lds, int l) { PH_BEGIN
    moe_tables(a, l, lds);
    SchedE1 S; S.ptile = (const LAS int*)(lds + TBL_OFF); S.cntv = S.ptile + 2 * TBLN; S.xb = (unsigned)WS_XB; S.lists = (const unsigned*)(ws + WS_LIST); S.w1 = (unsigned)W_1; S.G = G;
    EpiE1 E; E.hb = (bf16*)(ws + WS_HB);
    gs::gemm_stream<SchedE1, EpiE1, 2>(lds, (const char*)ws, S, E); }
PHFN f_e2(LAS unsigned char* lds, int l, int c) { PH_BEGIN
    moe_tables(a, l, lds);
    SchedE2 S; S.ptile = (const LAS int*)(lds + TBL_OFF); S.ypre = S.ptile + TBLN; S.cntv = S.ptile + 2 * TBLN; S.hb = (unsigned)WS_HB; S.w2 = (unsigned)W_2; S.c = c; S.G = G;
    EpiE2 E; E.y = (unsigned char*)(ws + WS_Y);
    gs::gemm_stream<SchedE2, EpiE2, 2>(lds, (const char*)ws, S, E); }
PHFN f_ln2(LAS unsigned char* lds, int l, int c) { PH_BEGIN moe_tables(a, l, lds); ph_ln2(a, l, c, lds, gw, NGW, lane); }
PHFN f_seam(LAS unsigned char* lds) {
    XcdBarrier bar; bar.bar = (unsigned*)((unsigned char*)(GAS unsigned char*)ldprm(lds, 23) + WS_CTL) + CW_BAR; bar.x = xb_xcc_id(); bar.st = (volatile LAS unsigned*)(lds + MISC_OFF) + 8; xcd_barrier(bar); }

#define IN(k) (lo <= (k) && (k) < hi)
#define SEAM(k) do { if ((k) + 1 < hi) f_seam(lds); } while (0)
DI void run_layer(LAS unsigned char* lds, const int l, const int lo, const int hi) {
        const int pb = 1 + l * NPL;
        if (PHON(0) && IN(pb + 0)) { f_cvt(lds, l); SEAM(pb + 0); }
        if (PHON(1) && IN(pb + 1)) { f_proj(lds); SEAM(pb + 1); }
        if (PHON(2) && IN(pb + 2)) { f_post(lds, l); SEAM(pb + 2); }
        if (PHON(3) && IN(pb + 3)) { f_cmp(lds); __syncthreads(); f_dsa(lds); SEAM(pb + 3); }
        if (PHON(4) && IN(pb + 4)) { f_cmp2(lds, l); __syncthreads(); f_sbfg(lds, l); SEAM(pb + 4); }
        if (PHON(21) && IN(pb + 5)) { f_nsa(lds); SEAM(pb + 5); }
        if (PHON(6) && IN(pb + 6)) { f_merge(lds); SEAM(pb + 6); }
        if (PHON(7) && IN(pb + 7)) { f_wo(lds, l); SEAM(pb + 7); }
        if (PHON(8) && IN(pb + 8)) { f_ln1(lds, l); SEAM(pb + 8); }
        if (PHON(9) && IN(pb + 9)) { f_router(lds); SEAM(pb + 9); }
        if (PHON(10) && IN(pb + 10)) { f_route(lds, l); SEAM(pb + 10); }
        if (PHON(11) && IN(pb + 11)) { f_e1(lds, l); SEAM(pb + 11); }
        for (int c = 0; c < NCH; ++c) {
            if (PHON(12) && IN(pb + 12 + 2 * c)) { f_e2(lds, l, c); SEAM(pb + 12 + 2 * c); }
            if (PHON(13) && IN(pb + 13 + 2 * c)) { f_ln2(lds, l, c); SEAM(pb + 13 + 2 * c); }
        }
}
#undef IN
#undef SEAM
#ifndef DUPMASK
#define DUPMASK 0
#endif
#define DUP(j) (((DUPMASK) >> (j)) & 1)
__global__ void __launch_bounds__(NWAVES * 64, 2) fwd(Args ka) {
    extern __shared__ __attribute__((aligned(16))) unsigned char lds_[];
    LAS unsigned char* lds = (LAS unsigned char*)lds_;
    const int tid = threadIdx.x;
    volatile LAS unsigned* MISC = (volatile LAS unsigned*)(lds + MISC_OFF);
    if (tid < 64) MISC[tid] = 0u;
    if (tid == 64) store_args(lds, ka);
    const int lo = ka.ph_lo, hi = ka.ph_hi;
    __syncthreads();
    if (hi - lo > 1 && tid == 0) (void)xb_add(&((unsigned*)(ka.ws + WS_CTL) + CW_BAR)[XB_XCNT(xb_xcc_id())], 1u);
#define IN(k) (lo <= (k) && (k) < hi)
#define SEAM(k) do { if ((k) + 1 < hi) f_seam(lds); } while (0)
    if (PHON(31) && IN(0)) { f_prologue(lds); SEAM(0); }
    run_layer(lds, 0, lo, hi); run_layer(lds, 1, lo, hi); run_layer(lds, 2, lo, hi); run_layer(lds, 3, lo, hi);
#undef IN
#undef SEAM
}

extern "C" void kernel_launch(void* const* d_in, const int* in_sizes, int n_in, void* d_out, int out_size, void* d_ws, size_t ws_size, hipStream_t stream) {
    static int grid = 0;
    if (grid == 0) {
        if (n_in != 22 || in_sizes[0] != NTOK * DM || out_size != NTOK * DM || ws_size < WS_END) {
            fprintf(stderr, "kernel_launch: unexpected shapes/workspace: n_in %d in0 %d out %d ws %zu (need %zu)\n", n_in, n_in > 0 ? in_sizes[0] : -1, out_size, ws_size, (size_t)WS_END); grid = -1; return; }
        int dev = 0, cus = 0, per_cu = 0;
        if (hipGetDevice(&dev) != hipSuccess || hipDeviceGetAttribute(&cus, hipDeviceAttributeMultiprocessorCount, dev) != hipSuccess) { grid = -1; return; }
        if (hipFuncSetAttribute((const void*)fwd, hipFuncAttributeMaxDynamicSharedMemorySize, LDS_BYTES) != hipSuccess) { fprintf(stderr, "kernel_launch: hipFuncSetAttribute failed\n"); grid = -1; return; }
        if (hipOccupancyMaxActiveBlocksPerMultiprocessor(&per_cu, (const void*)fwd, NWAVES * 64, LDS_BYTES) != hipSuccess || per_cu < 1)
            fprintf(stderr, "kernel_launch: occupancy query reports %d blocks per CU\n", per_cu);
        (void)hipGetLastError();
        grid = cus;
    }
    if (grid < 0) return;
    (void)hipMemsetAsync((char*)d_ws + WS_CTL, 0, CTL_ZERO_BYTES, stream);
    Args a{};
    a.x = (const float*)d_in[0]; a.pos = (const int*)d_in[1]; a.w_in = (const float*)d_in[2]; a.b_f = (const float*)d_in[3]; a.pe_cmp = (const float*)d_in[4];
    a.w_cmp1 = (const float*)d_in[5]; a.w_cmp2 = (const float*)d_in[6]; a.w_gate = (const float*)d_in[7]; a.w_br = (const float*)d_in[8]; a.w_o = (const float*)d_in[9];
    a.ln1_g = (const float*)d_in[10]; a.ln1_b = (const float*)d_in[11]; a.w_router = (const float*)d_in[12]; a.router_bias = (const float*)d_in[13];
    a.w_eg = (const float*)d_in[14]; a.w_eu = (const float*)d_in[15]; a.w_ed = (const float*)d_in[16]; a.w_sg = (const float*)d_in[17]; a.w_su = (const float*)d_in[18]; a.w_sd = (const float*)d_in[19];
    a.ln2_g = (const float*)d_in[20]; a.ln2_b = (const float*)d_in[21];
    a.out = (float*)d_out; a.ws = (unsigned char*)d_ws;
#if MK_SINGLE
    a.ph_lo = 0; a.ph_hi = NPHASE;
    hipLaunchKernelGGL(fwd, dim3(grid), dim3(NWAVES * 64), LDS_BYTES, stream, a);
#else
    for (int p = 0; p < NPHASE; ++p) { a.ph_lo = p; a.ph_hi = p + 1; hipLaunchKernelGGL(fwd, dim3(grid), dim3(NWAVES * 64), LDS_BYTES, stream, a);
        if (p > 0 && ((HOSTDUP >> ((p - 1) % NPL)) & 1)) hipLaunchKernelGGL(fwd, dim3(grid), dim3(NWAVES * 64), LDS_BYTES, stream, a); }
#endif
}
```

```cpp
#include <hip/hip_runtime.h>
#include <cstdio>
#include <cstdint>

#define GAS __attribute__((address_space(1)))
#define LAS __attribute__((address_space(3)))
typedef unsigned short bf16;
typedef short bf16x8 __attribute__((ext_vector_type(8)));
typedef float f32x4 __attribute__((ext_vector_type(4)));
typedef float f32x2 __attribute__((ext_vector_type(2)));
typedef float f32x16 __attribute__((ext_vector_type(16)));
typedef unsigned u32x4 __attribute__((ext_vector_type(4)));
typedef unsigned u32x2 __attribute__((ext_vector_type(2)));
typedef __bf16 bf16x2_t __attribute__((ext_vector_type(2)));
typedef GAS unsigned gu32;

#define DI __device__ __forceinline__
#define LDS_WAIT() asm volatile("s_waitcnt lgkmcnt(0)" ::: "memory")
#define VM_WAIT() asm volatile("s_waitcnt vmcnt(0)" ::: "memory")
#define RLX_AGENT __ATOMIC_RELAXED, __HIP_MEMORY_SCOPE_AGENT

constexpr int NBATCH = 8, SEQ = 8192, NTOK = NBATCH * SEQ, DM = 1024, DEPTH = 4;
constexpr int PW = 3136;
constexpr int C_AQ = 0, C_BQ = 256, C_BK = 512, C_BV = 768, C_CQ = 1024, C_CK = 1280, C_CV = 1536, C_DQ = 1792, C_DIQ = 2048,
              C_AKC = 2304, C_AVC = 2368, C_AKS = 2432, C_AVS = 2496, C_AKW = 2560, C_AVW = 2624, C_DK = 2688, C_DV = 2752, C_DIK = 2816, C_SM = 2880;
constexpr int IN_W = 2900;
constexpr float QS = 0.18033688011112042f;
constexpr float LOG2E = 1.4426950408889634f;
constexpr float ALPHA = 1.681792830507429f;
constexpr float LN_EPS = 1e-5f;
constexpr int NEXP = 64, NCH = 2, CHTOK = NTOK / NCH;
constexpr int NPL = 12 + 2 * NCH;
constexpr int NPHASE = 1 + DEPTH * NPL;
constexpr int NWAVES = 8;

constexpr size_t MiB = 1u << 20;
constexpr size_t WS_CTL = 0, CTL_ZERO_BYTES = 1 * MiB;
constexpr size_t WS_ROPE = 1 * MiB;
constexpr size_t WS_SM32 = 5 * MiB;
constexpr size_t WS_GATE = 13 * MiB;
constexpr size_t WS_LOGF = 16 * MiB;
constexpr size_t WS_CUM  = 17 * MiB;
constexpr size_t WS_IW   = 18 * MiB;
constexpr size_t WS_HID  = 19 * MiB;
constexpr size_t WS_KCMP = 21 * MiB;
constexpr size_t WS_VTCMP = 21 * MiB + 512 * 1024;
constexpr size_t WS_CBIAS = 22 * MiB;
constexpr size_t WS_KCR  = 23 * MiB;
constexpr size_t WS_VCR  = 32 * MiB;
constexpr size_t WS_VT   = 41 * MiB;
constexpr size_t WS_VTB = WS_VT, WS_VTC = WS_VT + 32 * MiB, WS_VTAS = WS_VT + 64 * MiB, WS_VTAW = WS_VT + 72 * MiB;
constexpr size_t WS_LOGIT = WS_VT;
constexpr size_t WS_TOKINFO = WS_VT + 16 * MiB;
constexpr size_t WS_LIST = WS_VT + 20 * MiB;
constexpr size_t WS_W    = 121 * MiB;
constexpr size_t W_IN = WS_W, W_G = WS_W + 6 * MiB, W_BR = WS_W + 14 * MiB, W_O = WS_W + 16 * MiB, W_C1 = WS_W + 18 * MiB,
                 W_RH = WS_W + 20 * MiB, W_RL = WS_W + 20 * MiB + 512 * 1024, W_1 = WS_W + 21 * MiB, W_2 = WS_W + 86 * MiB;
constexpr size_t WS_XB   = 243 * MiB;
constexpr size_t WS_A    = 371 * MiB;
constexpr size_t WS_B    = 763 * MiB;
constexpr size_t WS_C    = 891 * MiB;
constexpr size_t WS_END  = 1019 * MiB;
constexpr size_t WS_KTS = WS_C, WS_KTW = WS_C + 8 * MiB, WS_IKT = WS_C + 16 * MiB, WS_KTB = WS_C + 32 * MiB, WS_KTC = WS_C + 64 * MiB;
constexpr size_t WS_XL = WS_A, WS_HB = WS_A, WS_Y = WS_A + 320 * MiB;
static_assert(WS_Y + (size_t)(CHTOK * 8 / 256 + 64 + CHTOK / 256) * 256 * DM <= WS_END, "tile-padded fp8 y chunk fits");
constexpr int HB_TILES = NTOK * 8 / 256 + NCH * 64 + NTOK / 256;
static_assert((size_t)HB_TILES * 256 * 512 <= 320 * MiB, "hbuf fits");

constexpr int CW_BAR = 4096;
constexpr int CW_CNT = 16384;
constexpr int CW_KMAX = 32768;

constexpr int RING_BYTES = 131072;
constexpr int MISC_OFF = 162816;
constexpr int LDS_BYTES = 163840;

DI unsigned cvtpk(float lo, float hi) { f32x2 v = {lo, hi}; bf16x2_t b = __builtin_convertvector(v, bf16x2_t); return __builtin_bit_cast(unsigned, b); }
DI u32x4 pack8(const f32x4& v0, const f32x4& v1) { u32x4 w; w.x = cvtpk(v0[0], v0[1]); w.y = cvtpk(v0[2], v0[3]); w.z = cvtpk(v1[0], v1[1]); w.w = cvtpk(v1[2], v1[3]); return w; }
DI float bf2f(unsigned short h) { return __uint_as_float(((unsigned)h) << 16); }
DI float bflo(unsigned w) { return __uint_as_float(w << 16); }
DI float bfhi(unsigned w) { return __uint_as_float(w & 0xffff0000u); }
DI float fexp2(float x) { return __builtin_amdgcn_exp2f(x); }
DI float flog2(float x) { return __builtin_amdgcn_logf(x); }
DI float frcp(float x) { return __builtin_amdgcn_rcpf(x); }
DI float sigmoidf_(float x) { return frcp(1.f + fexp2(-x * LOG2E)); }
#define DPPF(v, ctrl, rm, bc) __int_as_float(__builtin_amdgcn_update_dpp(0, __float_as_int(v), (ctrl), (rm), 0xF, (bc)))
#define DPPI(v, ctrl, rm, bc) __builtin_amdgcn_update_dpp(0, (v), (ctrl), (rm), 0xF, (bc))
DI float dpp_xor1(float v) { return DPPF(v, 0xB1, 0xF, true); }
DI float dpp_xor2(float v) { return DPPF(v, 0x4E, 0xF, true); }
DI float red16_sum(float v) { const auto r = __builtin_amdgcn_permlane16_swap(__float_as_uint(v), __float_as_uint(v), false, false); return __uint_as_float(r[0]) + __uint_as_float(r[1]); }
DI float red16_max(float v) { const auto r = __builtin_amdgcn_permlane16_swap(__float_as_uint(v), __float_as_uint(v), false, false); return fmaxf(__uint_as_float(r[0]), __uint_as_float(r[1])); }
DI float red32_sum(float v) { const auto r = __builtin_amdgcn_permlane32_swap(__float_as_uint(v), __float_as_uint(v), false, false); return __uint_as_float(r[0]) + __uint_as_float(r[1]); }
DI float red32_max(float v) { const auto r = __builtin_amdgcn_permlane32_swap(__float_as_uint(v), __float_as_uint(v), false, false); return fmaxf(__uint_as_float(r[0]), __uint_as_float(r[1])); }
DI float wave_sum(float v) {
    v += dpp_xor1(v); v += dpp_xor2(v); v += DPPF(v, 0x124, 0xF, true); v += DPPF(v, 0x128, 0xF, true);
    v = red16_sum(v); return red32_sum(v);
}
DI float wave_max(float v) {
    v = fmaxf(v, dpp_xor1(v)); v = fmaxf(v, dpp_xor2(v)); v = fmaxf(v, DPPF(v, 0x124, 0xF, true)); v = fmaxf(v, DPPF(v, 0x128, 0xF, true));
    v = red16_max(v); return red32_max(v);
}
DI int wave_incl_scan(int v) {
    v += DPPI(v, 0x111, 0xF, true); v += DPPI(v, 0x112, 0xF, true); v += DPPI(v, 0x114, 0xF, true); v += DPPI(v, 0x118, 0xF, true);
    v += DPPI(v, 0x142, 0xA, false);
    v += DPPI(v, 0x143, 0xC, false);
    return v;
}
DI float wave_incl_scan_f(float v) {
    v += DPPF(v, 0x111, 0xF, true); v += DPPF(v, 0x112, 0xF, true); v += DPPF(v, 0x114, 0xF, true); v += DPPF(v, 0x118, 0xF, true);
    v += DPPF(v, 0x142, 0xA, false); v += DPPF(v, 0x143, 0xC, false);
    return v;
}
DI int ltid() { int t = threadIdx.x; asm volatile("" : "+v"(t)); return t; }
DI int lbid() { int b = blockIdx.x; asm volatile("" : "+s"(b)); return b; }
DI int lgrid() { int g = gridDim.x; asm volatile("" : "+s"(g)); return g; }
DI f32x16 mfma32(bf16x8 a, bf16x8 b, f32x16 c) { return __builtin_amdgcn_mfma_f32_32x32x16_bf16(a, b, c, 0, 0, 0); }
DI f32x4 mfma16(bf16x8 a, bf16x8 b, f32x4 c) { return __builtin_amdgcn_mfma_f32_16x16x32_bf16(a, b, c, 0, 0, 0); }

#define XB_TMO      128
#define XB_XCNT(j)  (256  + 64 * (j))
#define XB_XSUB(j)  (1280 + 64 * (j))
#define XB_XGEN(j)  (2304 + 64 * (j))
#define XB_TOP      3328
#define XB_TOPGEN   3392
#define XCD_BAR_WORDS 3456
#define XB_SPIN_CAP (1u << 22)
DI unsigned xb_ld(unsigned* p)              { return __hip_atomic_load(p, __ATOMIC_RELAXED, __HIP_MEMORY_SCOPE_AGENT); }
DI unsigned xb_add(unsigned* p, unsigned v) { return __hip_atomic_fetch_add(p, v, __ATOMIC_RELAXED, __HIP_MEMORY_SCOPE_AGENT); }
DI unsigned xb_xcc_id() { return (unsigned)__builtin_amdgcn_s_getreg((3 << 11) | 20) & 0xFu; }
#define XB_SPIN(cond, bar) do { unsigned _sp = 0; while (cond) { __builtin_amdgcn_s_sleep(1); \
    if ((++_sp & 255u) == 0u) { if (xb_ld(&(bar)[XB_TMO])) break; if (_sp > XB_SPIN_CAP) { atomicAdd(&(bar)[XB_TMO], 1u); break; } } } } while (0)
struct XcdBarrier { unsigned* bar; unsigned x; volatile LAS unsigned* st; };
DI XcdBarrier xcd_barrier_post(unsigned* bar, volatile LAS unsigned* st) {
    XcdBarrier b; b.bar = bar; b.x = xb_xcc_id(); b.st = st;
    if (threadIdx.x == 0) (void)xb_add(&bar[XB_XCNT(b.x)], 1u);
    return b;
}
DI void xcd_barrier_complete(unsigned* bar, unsigned x, unsigned& nloc, unsigned& nx) {
    const unsigned G = gridDim.x * gridDim.y * gridDim.z;
    unsigned sum, cnt, mine, sp = 0u;
    for (;;) {
        sum = 0u; cnt = 0u; mine = 0u;
#pragma unroll
        for (unsigned j = 0; j < 16; ++j) { const unsigned c = xb_ld(&bar[XB_XCNT(j)]); sum += c; cnt += (c > 0u) ? 1u : 0u; mine = (j == x) ? c : mine; }
        if (sum == G) break;
        __builtin_amdgcn_s_sleep(1);
        if ((++sp & 255u) == 0u) { if (xb_ld(&bar[XB_TMO])) break; if (sp > XB_SPIN_CAP) { atomicAdd(&bar[XB_TMO], 1u); break; } }
    }
    nloc = mine > 0u ? mine : 1u; nx = cnt > 0u ? cnt : 1u;
}
DI void xcd_barrier(const XcdBarrier& b) {
    asm volatile("s_waitcnt vmcnt(0)" ::: "memory");
    __syncthreads();
    if (threadIdx.x == 0) {
        unsigned* bar = b.bar;
        __builtin_amdgcn_s_waitcnt(0);
        unsigned nloc = b.st[0], nx = b.st[1];
        if (nloc == 0u) { xcd_barrier_complete(bar, b.x, nloc, nx); b.st[0] = nloc; b.st[1] = nx; }
        const unsigned old = xb_add(&bar[XB_XSUB(b.x)], 1u);
        const unsigned gen = old / nloc;
        if (old + 1u == (gen + 1u) * nloc) {
            __builtin_amdgcn_fence(__ATOMIC_RELEASE, "agent");
            asm volatile("s_waitcnt vmcnt(0)" ::: "memory");
            const unsigned og = xb_add(&bar[XB_TOP], 1u);
            const unsigned tg = og / nx;
            if (og + 1u == (tg + 1u) * nx) xb_add(&bar[XB_TOPGEN], 1u);
            else XB_SPIN(xb_ld(&bar[XB_TOPGEN]) == tg, bar);
            __builtin_amdgcn_fence(__ATOMIC_ACQUIRE, "agent");
            xb_add(&bar[XB_XGEN(b.x)], 1u);
            asm volatile("s_waitcnt vmcnt(0)" ::: "memory");
        } else {
            XB_SPIN(xb_ld(&bar[XB_XGEN(b.x)]) == gen, bar);
            __builtin_amdgcn_fence(__ATOMIC_ACQUIRE, "agent");
            asm volatile("s_waitcnt vmcnt(0)" ::: "memory");
        }
    }
    __syncthreads();
}

namespace gs {
constexpr int BM = 256, BK = 64, HALF = 128, HTB = HALF * BK * 2, NXCD = 8, WGM = 8;
__host__ __device__ __forceinline__ int lds_byte(int r, int c) { const int st = (r >> 4) * 2 + (c >> 5), rr = r & 15, cc = c & 31, ob = rr * 64 + cc * 2; return st * 1024 + (ob ^ (((ob >> 9) & 1) << 5)); }
__host__ __device__ __forceinline__ void stage_rc(int b, int& R, int& C) { const int st = b / 1024, sb = b % 1024, swz = sb ^ (((sb >> 9) & 1) << 5); R = (st >> 1) * 16 + swz / 64; C = (st & 1) * 32 + (swz % 64) / 2; }
__host__ __device__ __forceinline__ int perm32(int rho) { const int n = rho >> 4, i = rho & 15; return 8 * (i >> 2) + 4 * n + (i & 3); }
__host__ __device__ __forceinline__ int bh8row(int R) { return (R >> 5) * 64 + 16 * ((R & 15) >> 2) + 4 * ((R >> 4) & 1) + (R & 3); }

struct GU {
    unsigned A, B; const int* idx;
    unsigned lda, ldb;
    int nt;
    int flags;
    int nvalid;
    int a0, a1, a2, a3;
};
struct Unit { int pm, pn; };
struct StaticOrder {
    int nM, nN, nwg, G, c;
    DI void init(int M, int N, int G_, int c_) { nM = M / BM; nN = N / BM; nwg = nM * nN; G = G_; c = c_; }
    DI bool next(int i, Unit& u) const {
        const long L = (long)i * G + c; if (L >= nwg) return false;
        int wgid = (int)L; { const int q = nwg / NXCD, r = nwg % NXCD, xcd = wgid % NXCD, off = wgid / NXCD; wgid = (xcd < r ? xcd * (q + 1) : r * (q + 1) + (xcd - r) * q) + off; }
        const int nig = WGM * nN, gid = wgid / nig, fm = gid * WGM, gsz = (nM - fm) < WGM ? (nM - fm) : WGM;
        u.pm = fm + ((wgid % nig) % gsz); u.pn = (wgid % nig) / gsz; return true;
    }
};

template <class Sched, class Epi, int NBH>
DI void gemm_stream(LAS unsigned char* lds, const char* wsb, Sched& S, Epi& E) {
    constexpr bool GATH = Sched::GATHER, FIXED = Sched::FIXED;
    const int tid = ltid(), wid = __builtin_amdgcn_readfirstlane(tid >> 6), lane = tid & 63, wr = wid >> 2, wc = wid & 3, fr = lane & 15, fq = lane >> 4;
    int R0, C0, R1, C1; stage_rc(tid * 16, R0, C0); stage_rc(tid * 16 + 8192, R1, C1);
    const unsigned Rb0 = Epi::BH8 ? (unsigned)bh8row(R0) : Epi::PERM ? ((R0 & ~31) + perm32(R0 & 31)) : R0, Rb1 = Epi::BH8 ? (unsigned)bh8row(R1) : Epi::PERM ? ((R1 & ~31) + perm32(R1 & 31)) : R1;
    constexpr unsigned BHS = Epi::BH8 ? 8u : (unsigned)HALF;
    const unsigned C0b = (unsigned)C0 * 2u, C1b = (unsigned)C1 * 2u;
    const unsigned ldsw = (unsigned)wid * 1024u;
    const int aoff = lds_byte(wr * 64 + fr, fq * 8), boff = lds_byte(wc * 32 + fr, fq * 8);
#define GS_SA(b, h) (((b) * 2 + (h)) * HTB)
#define GS_SB(b, h) ((4 + (b) * 2 + (h)) * HTB)
#define GS_STG_O(bufoff, gbase, o0, o1) do { \
        unsigned _q0 = (gbase) + (o0), _q1 = (gbase) + (o1); asm volatile("" : "+v"(_q0), "+v"(_q1)); \
        __builtin_amdgcn_global_load_lds((const unsigned*)(wsb + (size_t)_q0), (LAS unsigned*)(lds + (bufoff) + ldsw), 16, 0, 0); \
        __builtin_amdgcn_global_load_lds((const unsigned*)(wsb + (size_t)_q1), (LAS unsigned*)(lds + (bufoff) + ldsw + 8192), 16, 0, 0); } while (0)
#define GS_STGA(bufoff, gbase, h, r0, r1, ld) do { if constexpr (FIXED) GS_STG_O(bufoff, (gbase) + (unsigned)(h) * HALF * (ld), fa0, fa1); \
        else GS_STG_O(bufoff, gbase, (unsigned)(r0) * (ld) + C0b, (unsigned)(r1) * (ld) + C1b); } while (0)
#define GS_STGB(bufoff, gbase, h, ld) do { if constexpr (FIXED) GS_STG_O(bufoff, (gbase) + (unsigned)(h) * BHS * (ld), fb0, fb1); \
        else GS_STG_O(bufoff, (gbase) + (unsigned)(h) * BHS * (ld), Rb0 * (ld) + C0b, Rb1 * (ld) + C1b); } while (0)
#define GS_LDA(dst, b, h) do { _Pragma("unroll") for (int m = 0; m < 4; ++m) _Pragma("unroll") for (int k = 0; k < 2; ++k) dst[m][k] = *(const LAS bf16x8*)(lds + GS_SA(b, h) + aoff + m * 2048 + k * 1024); } while (0)
#define GS_LDB(dst, b, h) do { _Pragma("unroll") for (int n = 0; n < 2; ++n) _Pragma("unroll") for (int k = 0; k < 2; ++k) dst[n][k] = *(const LAS bf16x8*)(lds + GS_SB(b, h) + boff + n * 2048 + k * 1024); } while (0)
#define GS_MMA(ai, bj, At, Bt) do { __builtin_amdgcn_s_setprio(1); _Pragma("unroll") for (int m = 0; m < 4; ++m) _Pragma("unroll") for (int n = 0; n < 2; ++n) _Pragma("unroll") for (int k = 0; k < 2; ++k) \
        acc[ai][bj][m][n] = __builtin_amdgcn_mfma_f32_16x16x32_bf16(Bt[n][k], At[m][k], acc[ai][bj][m][n], 0, 0, 0); __builtin_amdgcn_s_setprio(0); } while (0)
#define GS_WAIT_V(n) asm volatile("s_waitcnt vmcnt(" #n ")" ::: "memory")
#define GS_WAIT_L(n) asm volatile("s_waitcnt lgkmcnt(" #n ")" ::: "memory")
#define GS_BAR __builtin_amdgcn_s_barrier()
#define GS_SCHED __builtin_amdgcn_sched_barrier(0)
#define GS_ROWS(u, ia) do { if (GATH) { if ((u).idx) { \
            ia[0] = R0 < (u).nvalid ? (unsigned)(u).idx[R0] : 0u; ia[1] = R1 < (u).nvalid ? (unsigned)(u).idx[R1] : 0u; \
            ia[2] = HALF + R0 < (u).nvalid ? (unsigned)(u).idx[HALF + R0] : 0u; ia[3] = HALF + R1 < (u).nvalid ? (unsigned)(u).idx[HALF + R1] : 0u; } \
        else { ia[0] = R0; ia[1] = R1; ia[2] = HALF + R0; ia[3] = HALF + R1; } } } while (0)
    GU cur, nxt; int ui = 0;
    if (!S.next(0, cur)) return;
    f32x4 acc[2][NBH][4][2];
#pragma unroll
    for (int a = 0; a < 2; ++a)
#pragma unroll
        for (int b = 0; b < NBH; ++b)
#pragma unroll
            for (int m = 0; m < 4; ++m)
#pragma unroll
                for (int n = 0; n < 2; ++n) acc[a][b][m][n] = (f32x4){0.f, 0.f, 0.f, 0.f};
    bf16x8 At[4][2], B0[2][2], B1[2][2];
    unsigned ia[4] = {(unsigned)R0, (unsigned)R1, (unsigned)(HALF + R0), (unsigned)(HALF + R1)}, na[4] = {(unsigned)R0, (unsigned)R1, (unsigned)(HALF + R0), (unsigned)(HALF + R1)};
    GS_ROWS(cur, ia);
    unsigned cA = cur.A, cB = cur.B;
    unsigned lda = cur.lda, ldb = cur.ldb;
    const unsigned fa0 = (unsigned)R0 * lda + C0b, fa1 = (unsigned)R1 * lda + C1b, fb0 = Rb0 * ldb + C0b, fb1 = Rb1 * ldb + C1b;
    if constexpr (NBH == 2) {
        GS_STGB(GS_SB(0, 0), cB, 0, ldb); GS_STGB(GS_SB(0, 1), cB, 1, ldb); GS_STGA(GS_SA(0, 0), cA, 0, ia[0], ia[1], lda); GS_STGA(GS_SA(0, 1), cA, 1, ia[2], ia[3], lda);
        if (wr == 1) GS_BAR;
        GS_WAIT_V(2); GS_BAR;
        GS_STGB(GS_SB(1, 0), cB + 128, 0, ldb); GS_STGA(GS_SA(1, 0), cA + 128, 0, ia[0], ia[1], lda); GS_STGB(GS_SB(1, 1), cB + 128, 1, ldb);
        GS_WAIT_V(6); GS_BAR;
    } else {
        GS_STGB(GS_SB(0, 0), cB, 0, ldb); GS_STGA(GS_SA(0, 0), cA, 0, ia[0], ia[1], lda); GS_STGA(GS_SA(0, 1), cA, 1, ia[2], ia[3], lda);
        if (wr == 1) GS_BAR;
        GS_WAIT_V(2); GS_BAR;
        GS_STGB(GS_SB(1, 0), cB + 128, 0, ldb); GS_STGA(GS_SA(1, 0), cA + 128, 0, ia[0], ia[1], lda);
        GS_WAIT_V(4); GS_BAR;
    }
    for (;;) {
        const bool has_next = S.next(ui + 1, nxt);
        unsigned nA = cA, nB = cB, nlda = lda, nldb = ldb;
        if (has_next) { GS_ROWS(nxt, na); nA = nxt.A; nB = nxt.B; nlda = nxt.lda; nldb = nxt.ldb; }
        else if (GATH) { na[0] = ia[0]; na[1] = ia[1]; na[2] = ia[2]; na[3] = ia[3]; }
        const int nt = cur.nt;
        for (int t = 0; t < nt; t += 2) {
            const bool last = (t == nt - 2);
            const unsigned a1 = cA + (unsigned)(t + 1) * 128u;
            const unsigned a2 = last ? nA : cA + (unsigned)(t + 2) * 128u, b2 = last ? nB : cB + (unsigned)(t + 2) * 128u;
            const unsigned a3 = a2 + 128u, b3 = b2 + 128u;
            const unsigned xlda = last ? nlda : lda, xldb = last ? nldb : ldb;
            unsigned x0, x1, x2, x3;
            if (GATH) { x0 = last ? na[0] : ia[0]; x1 = last ? na[1] : ia[1]; x2 = last ? na[2] : ia[2]; x3 = last ? na[3] : ia[3]; }
            else { x0 = R0; x1 = R1; x2 = HALF + R0; x3 = HALF + R1; }
            if constexpr (NBH == 2) {
                GS_LDB(B0, 0, 0); GS_LDB(B1, 0, 1); GS_SCHED; GS_LDA(At, 0, 0); GS_STGA(GS_SA(1, 1), a1, 1, ia[2], ia[3], lda);
                GS_WAIT_V(8); GS_WAIT_L(0); GS_BAR; GS_MMA(0, 0, At, B0); GS_MMA(0, 1, At, B1); GS_BAR; GS_SCHED;
                GS_LDA(At, 0, 1); GS_STGB(GS_SB(0, 0), b2, 0, xldb); GS_STGB(GS_SB(0, 1), b2, 1, xldb); GS_STGA(GS_SA(0, 0), a2, 0, x0, x1, xlda);
                GS_WAIT_V(8); GS_WAIT_L(0); GS_BAR; GS_MMA(1, 0, At, B0); GS_MMA(1, 1, At, B1); GS_BAR; GS_SCHED;
                GS_LDB(B0, 1, 0); GS_LDB(B1, 1, 1); GS_SCHED; GS_LDA(At, 1, 0); GS_STGA(GS_SA(0, 1), a2, 1, x2, x3, xlda);
                GS_WAIT_V(8); GS_WAIT_L(0); GS_BAR; GS_MMA(0, 0, At, B0); GS_MMA(0, 1, At, B1); GS_BAR; GS_SCHED;
                GS_LDA(At, 1, 1); GS_STGB(GS_SB(1, 0), b3, 0, xldb); GS_STGB(GS_SB(1, 1), b3, 1, xldb); GS_STGA(GS_SA(1, 0), a3, 0, x0, x1, xlda);
                GS_WAIT_V(8); GS_WAIT_L(0); GS_BAR; GS_MMA(1, 0, At, B0); GS_MMA(1, 1, At, B1); GS_BAR; GS_SCHED;
            } else {
                GS_LDB(B0, 0, 0); GS_SCHED; GS_LDA(At, 0, 0); GS_STGA(GS_SA(1, 1), a1, 1, ia[2], ia[3], lda);
                GS_WAIT_V(6); GS_WAIT_L(0); GS_BAR; GS_MMA(0, 0, At, B0); GS_BAR; GS_SCHED;
                GS_LDA(At, 0, 1); GS_STGB(GS_SB(0, 0), b2, 0, xldb); GS_STGA(GS_SA(0, 0), a2, 0, x0, x1, xlda);
                GS_WAIT_V(6); GS_WAIT_L(0); GS_BAR; GS_MMA(1, 0, At, B0); GS_BAR; GS_SCHED;
                GS_LDB(B0, 1, 0); GS_SCHED; GS_LDA(At, 1, 0); GS_STGA(GS_SA(0, 1), a2, 1, x2, x3, xlda);
                GS_WAIT_V(6); GS_WAIT_L(0); GS_BAR; GS_MMA(0, 0, At, B0); GS_BAR; GS_SCHED;
                GS_LDA(At, 1, 1); GS_STGB(GS_SB(1, 0), b3, 0, xldb); GS_STGA(GS_SA(1, 0), a3, 0, x0, x1, xlda);
                GS_WAIT_V(6); GS_WAIT_L(0); GS_BAR; GS_MMA(1, 0, At, B0); GS_BAR; GS_SCHED;
            }
        }
        if (cur.flags & 2) {
            if (wr == 0) GS_BAR;
            E(acc, cur, wr, wc, fr, fq);
        }
        if (!has_next) break;
        if (nxt.flags & 1) {
#pragma unroll
            for (int a = 0; a < 2; ++a)
#pragma unroll
                for (int b = 0; b < NBH; ++b)
#pragma unroll
                    for (int m = 0; m < 4; ++m)
#pragma unroll
                        for (int n = 0; n < 2; ++n) acc[a][b][m][n] = (f32x4){0.f, 0.f, 0.f, 0.f};
        }
        const bool did_epi = (cur.flags & 2) != 0;
        cur = nxt; cA = nA; cB = nB; lda = nlda; ldb = nldb; ++ui;
        if (GATH) { ia[0] = na[0]; ia[1] = na[1]; ia[2] = na[2]; ia[3] = na[3]; }
        if (did_epi) { if (wr == 1) GS_BAR; }
    }
    GS_WAIT_V(0);
    if (!(cur.flags & 2)) { if (wr == 0) GS_BAR; }
    GS_BAR;
#undef GS_SA
#undef GS_SB
#undef GS_STG_O
#undef GS_STGA
#undef GS_STGB
#undef GS_LDA
#undef GS_LDB
#undef GS_MMA
#undef GS_WAIT_V
#undef GS_WAIT_L
#undef GS_BAR
#undef GS_SCHED
#undef GS_ROWS
}
}

struct Args {
    const float* x; const int* pos; const float* w_in; const float* b_f; const float* pe_cmp; const float* w_cmp1; const float* w_cmp2;
    const float* w_gate; const float* w_br; const float* w_o; const float* ln1_g; const float* ln1_b; const float* w_router; const float* router_bias;
    const float* w_eg; const float* w_eu; const float* w_ed; const float* w_sg; const float* w_su; const float* w_sd; const float* ln2_g; const float* ln2_b;
    float* out; unsigned char* ws; int ph_lo, ph_hi;
};

DI void ph_prologue(const Args& a, int gw, int NGW, int lane) {
    bf16* xb = (bf16*)(a.ws + WS_XB);
    for (int row = gw; row < NTOK; row += NGW) {
        const f32x4* xr = (const f32x4*)(a.x + (size_t)row * DM) + lane;
        u32x2* o = (u32x2*)(xb + (size_t)row * DM) + lane;
#pragma unroll
        for (int j = 0; j < 4; ++j) { const f32x4 v = xr[64 * j]; u32x2 w; w.x = cvtpk(v.x, v.y); w.y = cvtpk(v.z, v.w); o[64 * j] = w; }
    }
    float* rope = (float*)(a.ws + WS_ROPE);
    constexpr float INVF[8] = {1.0f, 0.1939227432012558f, 0.03760603070259094f, 0.007292664609849453f, 0.0014142135623842478f, 0.00027424818836152554f, 5.318296098266728e-05f, 1.0313386155758053e-05f};
    for (int i = gw * 64 + lane; i < NTOK; i += NGW * 64) {
        const float p = (float)a.pos[i];
#pragma unroll
        for (int j = 0; j < 8; ++j) {
            const float ang = p * INVF[j];
            const double rev = (double)ang * 0.15915494309189535;
            const float fr = (float)(rev - __builtin_rint(rev));
            rope[(size_t)i * 16 + j] = __builtin_amdgcn_cosf(fr);
            rope[(size_t)i * 16 + 8 + j] = __builtin_amdgcn_sinf(fr);
        }
    }
}

constexpr float Y_SCALE = 16.f;
struct CvtItem { const float* W; bf16* WT; int N, n0, nv, k0, dK, drow0, mode; float scale; };
__device__ const int SEG_SRC[21] = {0, 652, 908, 1164, 1420, 1676, 1932, 2192, 2576, 256, 320, 384, 448, 512, 576, 2448, 2512, 2832, 640, 2188, 2896};
__device__ const int SEG_DST[21] = {C_AQ, C_BQ, C_BK, C_BV, C_CQ, C_CK, C_CV, C_DQ, C_DIQ, C_AKC, C_AVC, C_AKS, C_AVS, C_AKW, C_AVW, C_DK, C_DV, C_DIK, 2880, 2892, 2896};
constexpr int CVT_I_IN = 93 * 16, CVT_I_G = 2048, CVT_I_BR = 512, CVT_I_O = 512, CVT_I_C1 = 128, CVT_I_R = 64, CVT_I_E = 65 * 384, CVT_I_CB = 2;
constexpr int CVT_NIT = CVT_I_IN + CVT_I_G + CVT_I_BR + CVT_I_O + CVT_I_C1 + CVT_I_R + CVT_I_E + CVT_I_CB;
DI CvtItem cvt_decode(const Args& a, int l, int it) {
    unsigned char* ws = a.ws; CvtItem c; c.mode = 0; c.nv = 32; c.scale = 1.f;
    int r = it;
    if (r < CVT_I_IN) {
        const int kb = r / 93, ci = r % 93; int seg, off;
        if (ci < 72) { seg = ci >> 3; off = (ci & 7) * 32; } else if (ci < 90) { seg = 9 + ((ci - 72) >> 1); off = ((ci - 72) & 1) * 32; }
        else { seg = 18 + (ci - 90); off = 0; c.nv = (seg == 18) ? 12 : 4; }
        if (seg == 0 || seg == 1 || seg == 4 || seg == 7) c.scale = QS;
        c.W = a.w_in + (size_t)l * DM * IN_W; c.N = IN_W; c.n0 = SEG_SRC[seg] + off; c.k0 = kb * 64; c.WT = (bf16*)(ws + W_IN); c.dK = DM; c.drow0 = SEG_DST[seg] + off; return c; }
    r -= CVT_I_IN;
    if (r < CVT_I_G) { const int m = r >> 9, q = r & 511, kb = q >> 5, nb = q & 31;
        c.W = a.w_gate + (size_t)(l * 4 + m) * DM * DM; c.N = DM; c.n0 = nb * 32; c.k0 = kb * 64; c.WT = (bf16*)(ws + W_G) + (size_t)m * DM * DM; c.dK = DM; c.drow0 = nb * 32; c.scale = -LOG2E; return c; }
    r -= CVT_I_G;
    if (r < CVT_I_BR) { const int m = r >> 7, q = r & 127, kb = q >> 5, nb = q & 31;
        c.W = a.w_br + (size_t)(l * 4 + m) * 256 * DM; c.N = DM; c.n0 = nb * 32; c.k0 = kb * 64; c.WT = (bf16*)(ws + W_BR) + (size_t)m * DM * 256; c.dK = 256; c.drow0 = nb * 32; return c; }
    r -= CVT_I_BR;
    if (r < CVT_I_O) { const int kb = r >> 5, nb = r & 31;
        c.W = a.w_o + (size_t)l * DM * DM; c.N = DM; c.n0 = nb * 32; c.k0 = kb * 64; c.WT = (bf16*)(ws + W_O); c.dK = DM; c.drow0 = nb * 32; return c; }
    r -= CVT_I_O;
    if (r < CVT_I_C1) { const int j = r >> 6, q = r & 63, kb = q >> 1, nb = q & 1;
        c.W = a.w_cmp1 + (size_t)(l * 2 + j) * 2048 * 64; c.N = 64; c.n0 = nb * 32; c.k0 = kb * 64; c.WT = (bf16*)(ws + W_C1) + (size_t)j * 256 * 2048; c.dK = 2048; c.drow0 = nb * 32; return c; }
    r -= CVT_I_C1;
    if (r < CVT_I_R) { const int mode = r >> 5, q = r & 31, kb = q >> 1, nb = q & 1;
        c.W = a.w_router + (size_t)l * DM * 64; c.N = 64; c.n0 = nb * 32; c.k0 = kb * 64; c.WT = (bf16*)(ws + (mode ? W_RL : W_RH)); c.dK = DM; c.drow0 = nb * 32; c.mode = mode; return c; }
    r -= CVT_I_R;
    if (r < CVT_I_E) {
        const int e = r / 384, q = r % 384, which = q >> 7, qq = q & 127;
        if (which < 2) { const int kb = qq >> 3, nb = qq & 7, n0 = nb * 32, pn = n0 >> 7, i0 = n0 & 127;
            c.W = (which == 0) ? (e < 64 ? a.w_eg + (size_t)(l * 64 + e) * DM * 256 : a.w_sg + (size_t)l * DM * 256) : (e < 64 ? a.w_eu + (size_t)(l * 64 + e) * DM * 256 : a.w_su + (size_t)l * DM * 256);
            c.N = 256; c.n0 = n0; c.k0 = kb * 64; c.WT = (bf16*)(ws + W_1) + (size_t)e * 512 * DM; c.dK = DM; c.drow0 = pn * 256 + which * 128 + i0;
        } else { const int kb = qq >> 5, nb = qq & 31;
            c.W = e < 64 ? a.w_ed + (size_t)(l * 64 + e) * 256 * DM : a.w_sd + (size_t)l * 256 * DM; c.N = DM; c.n0 = nb * 32; c.k0 = kb * 64; c.WT = (bf16*)(ws + W_2) + (size_t)e * DM * 256; c.dK = 256; c.drow0 = nb * 32; c.scale = Y_SCALE; }
        return c; }
    r -= CVT_I_E;
    c.mode = 2; c.n0 = r; c.W = nullptr; c.WT = nullptr; c.N = 0; c.k0 = 0; c.dK = 0; c.drow0 = 0; return c;
}
DI void cvt_load(const CvtItem& c, f32x4 (&v)[8], int lane) {
    if (c.mode == 2) return;
    if (c.nv == 32 && ((c.N | c.n0) & 3) == 0) {
#pragma unroll
        for (int i = 0; i < 8; ++i) v[i] = *(const f32x4*)(c.W + (size_t)(c.k0 + 8 * i + (lane >> 3)) * c.N + c.n0 + (lane & 7) * 4);
    } else {
#pragma unroll
        for (int i = 0; i < 8; ++i) { const float* p = c.W + (size_t)(c.k0 + 8 * i + (lane >> 3)) * c.N + c.n0 + (lane & 7) * 4; const int c4 = (lane & 7) * 4;
            v[i][0] = (c4 + 0 < c.nv) ? p[0] : 0.f; v[i][1] = (c4 + 1 < c.nv) ? p[1] : 0.f; v[i][2] = (c4 + 2 < c.nv) ? p[2] : 0.f; v[i][3] = (c4 + 3 < c.nv) ? p[3] : 0.f; }
    }
}
DI void cvt_finish(const Args& a, int l, const CvtItem& c, const f32x4 (&v)[8], LAS float* scr, int lane) {
    if (c.mode == 2) {
        const int j = c.n0; const float* pe = a.pe_cmp + (size_t)(l * 2 + j) * 2048; const float* w1 = a.w_cmp1 + (size_t)(l * 2 + j) * 2048 * 64;
        float s = 0.f;
        for (int k = 0; k < 2048; ++k) s += pe[k] * w1[(size_t)k * 64 + lane];
        ((float*)(a.ws + WS_CBIAS))[j * 64 + lane] = s; return; }
#pragma unroll
    for (int i = 0; i < 8; ++i) { const int kk = 8 * i + (lane >> 3), c4 = (lane & 7) * 4; scr[kk * 33 + c4] = v[i][0]; scr[kk * 33 + c4 + 1] = v[i][1]; scr[kk * 33 + c4 + 2] = v[i][2]; scr[kk * 33 + c4 + 3] = v[i][3]; }
    LDS_WAIT(); asm volatile("" ::: "memory");
    const int cc = lane & 7;
#pragma unroll
    for (int j = 0; j < 4; ++j) {
        const int n = (lane >> 3) + 8 * j; const LAS float* s = scr + (8 * cc) * 33 + n;
        float w[8];
#pragma unroll
        for (int q = 0; q < 8; ++q) { w[q] = s[q * 33] * c.scale; if (c.mode == 1) { const float h = __uint_as_float(cvtpk(w[q], 0.f) << 16); w[q] = w[q] - h; } }
        u32x4 o; o.x = cvtpk(w[0], w[1]); o.y = cvtpk(w[2], w[3]); o.z = cvtpk(w[4], w[5]); o.w = cvtpk(w[6], w[7]);
        if (n < c.nv) *(u32x4*)(c.WT + (size_t)(c.drow0 + n) * c.dK + c.k0 + 8 * cc) = o;
    }
    LDS_WAIT(); asm volatile("" ::: "memory");
}
DI void ph_cvt(const Args& a, int l, LAS unsigned char* lds, int gw, int NGW, int wave, int lane) {
    LAS float* scr = (LAS float*)(lds + wave * 8704);
    f32x4 va[8], vb[8];
    CvtItem ca, cb; ca.mode = 2; ca.n0 = 0;
    int it = gw;
    if (it < CVT_NIT) { ca = cvt_decode(a, l, it); cvt_load(ca, va, lane); }
    for (; it < CVT_NIT; it += 2 * NGW) {
        const bool hasb = it + NGW < CVT_NIT;
        if (hasb) { cb = cvt_decode(a, l, it + NGW); cvt_load(cb, vb, lane); }
        cvt_finish(a, l, ca, va, scr, lane);
        const bool hasa = it + 2 * NGW < CVT_NIT;
        if (hasa) { ca = cvt_decode(a, l, it + 2 * NGW); cvt_load(ca, va, lane); }
        if (hasb) cvt_finish(a, l, cb, vb, scr, lane);
    }
}

DI void rope4(float (&v)[4], int a, const float* rp, float scale) {
    float pv[4];
#pragma unroll
    for (int i = 0; i < 4; ++i) pv[i] = dpp_xor2(v[i]);
    const f32x4 c4 = *(const f32x4*)(rp + 4 * (a & 1)), s4 = *(const f32x4*)(rp + 8 + 4 * (a & 1));
    if (a < 4) {
#pragma unroll
        for (int i = 0; i < 4; ++i) v[i] = (a < 2) ? (v[i] * c4[i] - pv[i] * s4[i]) : (pv[i] * s4[i] + v[i] * c4[i]);
    }
#pragma unroll
    for (int i = 0; i < 4; ++i) v[i] *= scale;
}
DI void ld4bf(const bf16* p, float (&v)[4]) { const u32x2 w = *(const u32x2*)p; v[0] = bflo(w.x); v[1] = bfhi(w.x); v[2] = bflo(w.y); v[3] = bfhi(w.y); }
DI void st4bf(bf16* p, const float (&v)[4]) { u32x2 w; w.x = cvtpk(v[0], v[1]); w.y = cvtpk(v[2], v[3]); *(u32x2*)p = w; }

DI void ph_post(const Args& a, int l, LAS unsigned char* lds, int wave, int lane) {
    unsigned char* ws = a.ws;
    bf16* proj = (bf16*)(ws + WS_A);
    const float* rope = (const float*)(ws + WS_ROPE);
    const float* sm32 = (const float*)(ws + WS_SM32);
    LAS bf16* T = (LAS bf16*)(lds + wave * 9216);
    for (int tile = lbid(); tile < NTOK / 64; tile += lgrid()) {
        const int tok0 = tile * 64;
        float kmx = 0.f;
        for (int tt = wave; tt < 64; tt += NWAVES) {
            const int tok = tok0 + tt; bf16* row = proj + (size_t)tok * PW;
            const float* cs = rope + (size_t)tok * 16;
            const int ah = lane & 15;
            float v[4];
            ld4bf(row + C_AQ + 4 * lane, v); rope4(v, ah, cs, 1.0f); st4bf(row + C_AQ + 4 * lane, v);
            ld4bf(row + C_DQ + 4 * lane, v); rope4(v, ah, cs, 1.0f); st4bf(row + C_DQ + 4 * lane, v);
            ld4bf(row + C_DIQ + 4 * lane, v); rope4(v, ah, cs, 1.0f); st4bf(row + C_DIQ + 4 * lane, v);
            {
                const int tl = tok % SEQ, kin = tl & 31, slot = (kin & ~12) | ((kin & 4) << 1) | ((kin & 8) >> 1), hq = lane >> 4;
                const size_t toff = (((size_t)(tok / SEQ) * 4 + hq) * (SEQ / 32) + (tl >> 5)) * 2048 + ((ah >> 1) * 32 + slot) * 8 + (ah & 1) * 4;
                *(u32x2*)((bf16*)(ws + WS_KTB) + toff) = *(const u32x2*)(row + C_BK + 4 * lane);
                const u32x2 ckw = *(const u32x2*)(row + C_CK + 4 * lane);
                *(u32x2*)((bf16*)(ws + WS_KTC) + toff) = ckw;
                float sq = bflo(ckw.x) * bflo(ckw.x) + bfhi(ckw.x) * bfhi(ckw.x) + bflo(ckw.y) * bflo(ckw.y) + bfhi(ckw.y) * bfhi(ckw.y);
                sq += dpp_xor1(sq); sq += dpp_xor2(sq); sq += DPPF(sq, 0x124, 0xF, true); sq += DPPF(sq, 0x128, 0xF, true);
                kmx = fmaxf(kmx, sq);
            }
            { const int hk = lane >> 4; const int cb = (hk == 0) ? C_AKS : (hk == 1) ? C_AKW : (hk == 2) ? C_DK : C_DIK;
              ld4bf(row + cb + 4 * ah, v); rope4(v, ah, cs, 1.0f); st4bf(row + cb + 4 * ah, v);
              if (hk < 2) {
                  const int tl = tok % SEQ, kin = tl & 31, slot = (kin & ~12) | ((kin & 4) << 1) | ((kin & 8) >> 1);
                  bf16* kt = (bf16*)(ws + (hk == 0 ? WS_KTS : WS_KTW)) + ((size_t)(tok / SEQ) * (SEQ / 32) + (tl >> 5)) * 2048 + ((ah >> 1) * 32 + slot) * 8 + (ah & 1) * 4;
                  st4bf(kt, v); }
              if (hk == 3) {
                  const int tl = tok % SEQ;
                  bf16* it = (bf16*)(ws + WS_IKT) + ((size_t)(tok / SEQ) * (SEQ / 32) + (tl >> 5)) * 2048 + ((ah >> 1) * 32 + (tl & 31)) * 8 + (ah & 1) * 4;
                  st4bf(it, v); } }
            if (lane < 32) { const int j = lane >> 4; const u32x2 w = *(const u32x2*)(row + (j ? C_AVC : C_AKC) + 4 * ah);
                *(u32x2*)((bf16*)(ws + (j ? WS_VCR : WS_KCR)) + (size_t)tok * 64 + 4 * ah) = w; }
            if (lane < 20) {
                const float s = sm32[(size_t)tok * 32 + lane];
                if (lane < 12) ((float*)(ws + WS_GATE))[(size_t)tok * 12 + lane] = sigmoidf_(s);
                else if (lane < 16) { const float z = s + a.b_f[l * 4 + (lane - 12)];
                    ((float*)(ws + WS_LOGF))[(size_t)tok * 4 + (lane - 12)] = fminf(z, 0.f) * LOG2E - flog2(1.f + fexp2(-fabsf(z) * LOG2E)); }
                else ((float*)(ws + WS_IW))[(size_t)tok * 4 + (lane - 16)] = s;
            }
        }
        if ((lane & 15) == 0) atomicMax((unsigned*)(ws + WS_CTL) + CW_KMAX + l * 32 + (tok0 / SEQ) * 4 + (lane >> 4), __float_as_uint(kmx * 1.02f));
        const int bidx = tok0 / SEQ, tl0 = tok0 % SEQ;
        for (int hv = wave; hv < 10; hv += NWAVES) {
            int cb; bf16* dst;
            if (hv < 4) { cb = C_BV + 64 * hv; dst = (bf16*)(ws + WS_VTB) + (size_t)(bidx * 4 + hv) * 64 * SEQ; }
            else if (hv < 8) { cb = C_CV + 64 * (hv - 4); dst = (bf16*)(ws + WS_VTC) + (size_t)(bidx * 4 + hv - 4) * 64 * SEQ; }
            else if (hv == 8) { cb = C_AVS; dst = (bf16*)(ws + WS_VTAS) + (size_t)bidx * 64 * SEQ; }
            else { cb = C_AVW; dst = (bf16*)(ws + WS_VTAW) + (size_t)bidx * 64 * SEQ; }
            const bf16* src = proj + (size_t)(tok0 + lane) * PW + cb;
#pragma unroll
            for (int i = 0; i < 8; ++i) { const u32x4 w = *(const u32x4*)(src + 8 * i);
                T[(8 * i + 0) * 72 + lane] = (bf16)(w.x & 0xffff); T[(8 * i + 1) * 72 + lane] = (bf16)(w.x >> 16);
                T[(8 * i + 2) * 72 + lane] = (bf16)(w.y & 0xffff); T[(8 * i + 3) * 72 + lane] = (bf16)(w.y >> 16);
                T[(8 * i + 4) * 72 + lane] = (bf16)(w.z & 0xffff); T[(8 * i + 5) * 72 + lane] = (bf16)(w.z >> 16);
                T[(8 * i + 6) * 72 + lane] = (bf16)(w.w & 0xffff); T[(8 * i + 7) * 72 + lane] = (bf16)(w.w >> 16); }
            LDS_WAIT(); asm volatile("" ::: "memory");
            {
                const int dt = lane >> 5, cc = lane & 31;
#pragma unroll
                for (int i = 0; i < 8; ++i) { const int tile = i >> 2, sh = i & 3;
                    bf16* d = dst + ((size_t)(tl0 >> 5) + tile) * 2048 + ((dt * 2 + (sh >> 1)) * 64 + (sh & 1) * 32 + cc) * 8;
                    *(u32x4*)d = *(const LAS u32x4*)(T + lane * 72 + 8 * i); }
            }
            LDS_WAIT(); asm volatile("" ::: "memory");
        }
    }
}

DI void cumsum_seq(const Args& a, int bh, int lane) {
    const float* lf = (const float*)(a.ws + WS_LOGF); float* cum = (float*)(a.ws + WS_CUM);
    const int b = bh >> 2, h = bh & 3;
    const float* src = lf + ((size_t)b * SEQ + lane * 128) * 4 + h;
    float s = 0.f;
    for (int i = 0; i < 128; ++i) s += src[(size_t)i * 4];
    const float incl = wave_incl_scan_f(s);
    float run = incl - s;
    float* dst = cum + (size_t)bh * SEQ + lane * 128;
    for (int i = 0; i < 128; ++i) { run += src[(size_t)i * 4]; dst[i] = run; }
}

DI void ph_cmp2(const Args& a, int l, int gw, int NGW, int lane) {
    const float* hid = (const float*)(a.ws + WS_HID);
    bf16* kc = (bf16*)(a.ws + WS_KCMP); bf16* vtc = (bf16*)(a.ws + WS_VTCMP);
    for (int it = gw; it < 2 * 4096; it += NGW) {
        const int j = it >> 12, row = it & 4095, b = row >> 9, n = row & 511;
        const float* h = hid + ((size_t)j * 4096 + row) * 64; const float* w2 = a.w_cmp2 + (size_t)(l * 2 + j) * 64 * 64;
        float s = 0.f;
#pragma unroll 8
        for (int k = 0; k < 64; ++k) s += h[k] * w2[k * 64 + lane];
        if (n == 511) s = 0.f;
        const bf16 o = (bf16)(cvtpk(s, 0.f) & 0xffff);
        const int tile = n >> 5, kin = n & 31;
        if (j == 0) { const int slot = (kin & ~12) | ((kin & 4) << 1) | ((kin & 8) >> 1); kc[((size_t)b * 16 + tile) * 2048 + ((lane >> 3) * 32 + slot) * 8 + (lane & 7)] = o; }
        else { const int sI = kin >> 4, hI = (kin >> 3) & 1, e = kin & 7; vtc[((size_t)b * 16 + tile) * 2048 + (((lane >> 5) * 2 + sI) * 64 + hI * 32 + (lane & 31)) * 8 + e] = o; }
    }
}

DI void ph_ln1(const Args& a, int l, int gw, int NGW, int lane) {
    bf16* xb = (bf16*)(a.ws + WS_XB); bf16* xl = (bf16*)(a.ws + WS_XL);
    const float* g = a.ln1_g + l * DM; const float* be = a.ln1_b + l * DM;
    u32x4 nq0 = {0u,0u,0u,0u}, nq1 = {0u,0u,0u,0u};
    if (gw < NTOK) { const u32x4* x0 = (const u32x4*)(xb + (size_t)gw * DM) + lane; nq0 = x0[0]; nq1 = x0[64]; }
    for (int row = gw; row < NTOK; row += NGW) {
        u32x4* xr = (u32x4*)(xb + (size_t)row * DM) + lane; u32x4* lr = (u32x4*)(xl + (size_t)row * DM) + lane;
        const u32x4 qq[2] = {nq0, nq1};
        if (row + NGW < NTOK) { const u32x4* xn = (const u32x4*)(xb + (size_t)(row + NGW) * DM) + lane; nq0 = xn[0]; nq1 = xn[64]; }
        f32x4 v[4]; float s = 0.f;
#pragma unroll
        for (int j = 0; j < 2; ++j) { const u32x4 q = qq[j];
            v[2 * j] = (f32x4){bflo(q.x), bfhi(q.x), bflo(q.y), bfhi(q.y)}; v[2 * j + 1] = (f32x4){bflo(q.z), bfhi(q.z), bflo(q.w), bfhi(q.w)}; }
#pragma unroll
        for (int j = 0; j < 4; ++j) s += (v[j].x + v[j].y) + (v[j].z + v[j].w);
        const float mean = wave_sum(s) * (1.f / DM); float s2 = 0.f;
#pragma unroll
        for (int j = 0; j < 4; ++j) { v[j] = v[j] - mean; s2 += (v[j].x * v[j].x + v[j].y * v[j].y) + (v[j].z * v[j].z + v[j].w * v[j].w); }
        const float rstd = 1.f / sqrtf(wave_sum(s2) * (1.f / DM) + LN_EPS);
#pragma unroll
        for (int j = 0; j < 2; ++j) {
            const int cb = 8 * lane + 512 * j;
            const f32x4 g0 = *(const f32x4*)(g + cb), g1 = *(const f32x4*)(g + cb + 4), b0 = *(const f32x4*)(be + cb), b1 = *(const f32x4*)(be + cb + 4);
            const f32x4 y0 = v[2 * j] * rstd * g0 + b0, y1 = v[2 * j + 1] * rstd * g1 + b1;
            const u32x4 hi = pack8(y0, y1);
            const f32x4 r0 = {y0[0] - bflo(hi.x), y0[1] - bfhi(hi.x), y0[2] - bflo(hi.y), y0[3] - bfhi(hi.y)}, r1 = {y1[0] - bflo(hi.z), y1[1] - bfhi(hi.z), y1[2] - bflo(hi.w), y1[3] - bfhi(hi.w)};
            xr[64 * j] = hi; lr[64 * j] = pack8(r0, r1);
        }
    }
}

DI void ph_route(const Args& a, int l, LAS unsigned char* lds, int wave, int lane) {
    const float* logit = (const float*)(a.ws + WS_LOGIT);
    u32x2* tokinfo = (u32x2*)(a.ws + WS_TOKINFO);
    unsigned* lists = (unsigned*)(a.ws + WS_LIST);
    unsigned* gcnt = (unsigned*)(a.ws + WS_CTL) + CW_CNT + l * NCH * 64;
    LAS unsigned* lcnt = (LAS unsigned*)lds;
    LAS unsigned* lbase = lcnt + 64;
    LAS unsigned* stash = lbase + 64;
    const float rb = a.router_bias[l * 64 + lane];
    for (int blk = lbid(); blk < NTOK / 256; blk += lgrid()) {
        const int tok0 = blk * 256, c = tok0 / CHTOK;
        if (ltid() < 64) lcnt[ltid()] = 0u;
        __syncthreads();
        for (int tt = wave; tt < 256; tt += NWAVES) {
            const int tok = tok0 + tt;
            const float sc = sigmoidf_(logit[(size_t)tok * 64 + lane]);
            const float bi = sc + rb;
            float m1 = bi;
            m1 = fmaxf(m1, __shfl_xor(m1, 1)); m1 = fmaxf(m1, __shfl_xor(m1, 2)); m1 = fmaxf(m1, __shfl_xor(m1, 4));
            const unsigned long long eqm = __ballot(bi == m1);
            const int gsh = lane & ~7; const unsigned gm = (unsigned)((eqm >> gsh) & 0xffu);
            const int first = __builtin_ctz(gm);
            float v2 = ((lane & 7) == first) ? -3.0e38f : bi;
            v2 = fmaxf(v2, __shfl_xor(v2, 1)); v2 = fmaxf(v2, __shfl_xor(v2, 2)); v2 = fmaxf(v2, __shfl_xor(v2, 4));
            const float gs = m1 + v2;
            const int g = lane >> 3; int grank = 0;
#pragma unroll
            for (int gg = 0; gg < 8; ++gg) { const float o = __int_as_float(__builtin_amdgcn_readlane(__float_as_int(gs), gg * 8)); grank += (o > gs || (o == gs && gg < g)) ? 1 : 0; }
            const float mb = (grank < 4) ? bi : -1.0e30f;
            int rank = 0;
#pragma unroll 4
            for (int e = 0; e < 64; ++e) { const float o = __int_as_float(__builtin_amdgcn_readlane(__float_as_int(mb), e)); rank += (o > mb || (o == mb && e < lane)) ? 1 : 0; }
            const bool sel = rank < 8;
            const float wsum = wave_sum(sel ? sc : 0.f);
            const float w = sc / wsum * 2.5f;
            const unsigned long long sm = __ballot(sel);
            const int k = __popcll(sm & ((1ull << lane) - 1ull));
            if (sel) {
                const unsigned lp = atomicAdd((unsigned*)&lcnt[lane], 1u);
                stash[tt * 8 + k] = ((unsigned)lane << 16) | lp;
                ((float*)tokinfo)[((size_t)tok * 8 + k) * 2 + 1] = w;
            }
        }
        __syncthreads();
        if (ltid() < 64) lbase[ltid()] = atomicAdd(&gcnt[c * 64 + ltid()], lcnt[ltid()]);
        __syncthreads();
        for (int i = ltid(); i < 256 * 8; i += NWAVES * 64) {
            const unsigned s = stash[i]; const unsigned e = s >> 16, lp = s & 0xffffu; const int tok = tok0 + (i >> 3);
            const unsigned pos = lbase[e] + lp;
            lists[((size_t)c * 64 + e) * CHTOK + pos] = (unsigned)tok;
            ((unsigned*)tokinfo)[((size_t)tok * 8 + (i & 7)) * 2] = (e << 16) | pos;
        }
        __syncthreads();
    }
}

typedef f32x4 Acc2[2][2][4][2];
typedef f32x4 Acc1[2][1][4][2];

struct SchedProj {
    static constexpr bool GATHER = false, FIXED = true;
    gs::StaticOrder so; unsigned A, B;
    DI bool next(int i, gs::GU& u) const { gs::Unit t; if (!so.next(i, t)) return false;
        u.A = A + (unsigned)t.pm * 256u * 2048u; u.B = B + (unsigned)t.pn * 256u * 2048u; u.idx = nullptr; u.lda = 2048; u.ldb = 2048; u.nt = 16; u.flags = 3; u.nvalid = 256;
        u.a0 = t.pm; u.a1 = t.pn; u.a2 = 0; u.a3 = 0; return true; }
};
struct EpiProj {
    static constexpr bool PERM = true; static constexpr bool BH8 = false; bf16* proj; float* sm32;
    DI void operator()(const Acc2& acc, const gs::GU& u, int wr, int wc, int fr, int fq) const {
        const int row0 = u.a0 * 256 + wr * 64 + fr, col0 = u.a1 * 256 + wc * 32 + 8 * fq;
#pragma unroll
        for (int ai = 0; ai < 2; ++ai)
#pragma unroll
            for (int m = 0; m < 4; ++m) { const int row = row0 + ai * 128 + m * 16;
#pragma unroll
                for (int bj = 0; bj < 2; ++bj) *(u32x4*)(proj + (size_t)row * PW + col0 + bj * 128) = pack8(acc[ai][bj][m][0], acc[ai][bj][m][1]);
                if (u.a1 == 11 && wc == 2) { *(f32x4*)(sm32 + (size_t)row * 32 + 8 * fq) = acc[ai][0][m][0]; *(f32x4*)(sm32 + (size_t)row * 32 + 8 * fq + 4) = acc[ai][0][m][1]; } }
    }
};

struct SchedCmp {
    static constexpr bool GATHER = false, FIXED = true;
    unsigned kcr, vcr, w;
    DI bool next(int i, gs::GU& u) const { if (i > 0 || lbid() >= 32) return false; const int j = lbid() >> 4, pm = lbid() & 15;
        u.A = (j ? vcr : kcr) + (unsigned)pm * 256u * 2048u; u.B = w + (unsigned)j * 256u * 4096u; u.idx = nullptr; u.lda = 2048; u.ldb = 4096; u.nt = 32; u.flags = 3; u.nvalid = 256;
        u.a0 = pm; u.a1 = j; u.a2 = 0; u.a3 = 0; return true; }
};
struct EpiCmp {
    static constexpr bool PERM = true; static constexpr bool BH8 = false; float* hid; const float* cbias;
    DI void operator()(const Acc2& acc, const gs::GU& u, int wr, int wc, int fr, int fq) const {
        if (wc >= 2) return;
        const int row0 = u.a0 * 256 + wr * 64 + fr, col0 = wc * 32 + 8 * fq, j = u.a1;
        float cb[8];
#pragma unroll
        for (int q = 0; q < 8; ++q) cb[q] = cbias[j * 64 + col0 + q];
#pragma unroll
        for (int ai = 0; ai < 2; ++ai)
#pragma unroll
            for (int m = 0; m < 4; ++m) { const int row = row0 + ai * 128 + m * 16; float o[8];
#pragma unroll
                for (int q = 0; q < 8; ++q) { const float x = acc[ai][0][m][q >> 2][q & 3] + cb[q];
                    const float y2 = 1.5957691216f * (x + 0.044715f * x * x * x);
                    o[q] = x * frcp(1.f + fexp2(-y2 * LOG2E)); }
                float* d = hid + ((size_t)j * 4096 + row) * 64 + col0;
                *(f32x4*)d = (f32x4){o[0], o[1], o[2], o[3]}; *(f32x4*)(d + 4) = (f32x4){o[4], o[5], o[6], o[7]}; }
    }
};

struct SchedMerge {
    static constexpr bool GATHER = false, FIXED = false;
    unsigned xb, om, wg, wbr; int G;
    DI bool next(int i, gs::GU& u) const { const int ti = i >> 3, k = i & 7; const int bid_ = lbid(); const long L = (long)ti * G + bid_; if (L >= 2048) return false;
        int pm = (int)(L >> 3), pc = (int)(L & 7); const int m = k >> 1, kind = k & 1;
        if (G == 256) { const int x = bid_ & 7, idx = bid_ >> 3; pm = ti * 32 + x * 4 + (idx >> 3); pc = idx & 7; }
        if (kind == 0) { u.A = om + (unsigned)pm * 256u * 2048u + (unsigned)m * 512u; u.B = wbr + (unsigned)m * 1024u * 512u + (unsigned)pc * 128u * 512u; u.lda = 2048; u.ldb = 512; u.nt = 4; }
        else           { u.A = xb + (unsigned)pm * 256u * 2048u;           u.B = wg + (unsigned)m * 1024u * 2048u + (unsigned)pc * 128u * 2048u; u.lda = 2048; u.ldb = 2048; u.nt = 16; }
        u.idx = nullptr; u.flags = 3; u.nvalid = 256; u.a0 = pm; u.a1 = pc; u.a2 = kind; u.a3 = m; return true; }
};
struct EpiMerge {
    static constexpr bool PERM = true; static constexpr bool BH8 = false; bf16* merged; LAS unsigned char* lds;
    f32x4 M[2][4][2]; u32x4 p7;
    DI LAS u32x4* slot(int k, int tid) const { const int off = (k < 2) ? 5 * gs::HTB + k * 8192 : (k < 4) ? 7 * gs::HTB + (k - 2) * 8192 : 8 * gs::HTB + (k - 4) * 8192; return (LAS u32x4*)(lds + off) + tid; }
    DI void operator()(const Acc1& acc, const gs::GU& u, int wr, int wc, int fr, int fq) {
        const int tid = ltid();
        if (u.a2 == 0) {
#pragma unroll
            for (int ai = 0; ai < 2; ++ai)
#pragma unroll
                for (int m = 0; m < 4; ++m) { const u32x4 w = pack8(acc[ai][0][m][0], acc[ai][0][m][1]); if (ai * 4 + m < 7) *slot(ai * 4 + m, tid) = w; else p7 = w; }
        } else {
            const bool first = (u.a3 == 0), lastm = (u.a3 == 3);
            const int row0 = u.a0 * 256 + wr * 64 + fr, col0 = u.a1 * 128 + wc * 32 + 8 * fq;
            if (first) {
#pragma unroll
                for (int ai = 0; ai < 2; ++ai)
#pragma unroll
                    for (int m = 0; m < 4; ++m) { M[ai][m][0] = (f32x4){0.f, 0.f, 0.f, 0.f}; M[ai][m][1] = (f32x4){0.f, 0.f, 0.f, 0.f}; }
            }
#pragma unroll
            for (int ai = 0; ai < 2; ++ai)
#pragma unroll
                for (int m = 0; m < 4; ++m) {
                    const u32x4 p = (ai * 4 + m < 7) ? *slot(ai * 4 + m, tid) : p7;
                    const f32x4 g0 = acc[ai][0][m][0], g1 = acc[ai][0][m][1];
                    f32x4 m0 = M[ai][m][0], m1 = M[ai][m][1];
                    m0[0] = __builtin_fmaf(frcp(1.f + fexp2(g0[0])), bflo(p.x), m0[0]); m0[1] = __builtin_fmaf(frcp(1.f + fexp2(g0[1])), bfhi(p.x), m0[1]);
                    m0[2] = __builtin_fmaf(frcp(1.f + fexp2(g0[2])), bflo(p.y), m0[2]); m0[3] = __builtin_fmaf(frcp(1.f + fexp2(g0[3])), bfhi(p.y), m0[3]);
                    m1[0] = __builtin_fmaf(frcp(1.f + fexp2(g1[0])), bflo(p.z), m1[0]); m1[1] = __builtin_fmaf(frcp(1.f + fexp2(g1[1])), bfhi(p.z), m1[1]);
                    m1[2] = __builtin_fmaf(frcp(1.f + fexp2(g1[2])), bflo(p.w), m1[2]); m1[3] = __builtin_fmaf(frcp(1.f + fexp2(g1[3])), bfhi(p.w), m1[3]);
                    M[ai][m][0] = m0; M[ai][m][1] = m1;
                    asm volatile("" : "+v"(M[ai][m][0]), "+v"(M[ai][m][1]));
                    if (lastm) *(u32x4*)(merged + (size_t)(row0 + ai * 128 + m * 16) * DM + col0) = pack8(M[ai][m][0], M[ai][m][1]);
                    asm volatile("" ::: "memory");
                }
        }
    }
};

struct SchedWo {
    static constexpr bool GATHER = false, FIXED = true;
    gs::StaticOrder so; unsigned A, B;
    DI bool next(int i, gs::GU& u) const { gs::Unit t; if (!so.next(i, t)) return false;
        u.A = A + (unsigned)t.pm * 256u * 2048u; u.B = B + (unsigned)t.pn * 256u * 2048u; u.idx = nullptr; u.lda = 2048; u.ldb = 2048; u.nt = 16; u.flags = 3; u.nvalid = 256;
        u.a0 = t.pm; u.a1 = t.pn; u.a2 = 0; u.a3 = 0; return true; }
};
struct EpiWo {
    static constexpr bool PERM = true; static constexpr bool BH8 = false; bf16* xb;
    DI void operator()(const Acc2& acc, const gs::GU& u, int wr, int wc, int fr, int fq) const {
        const int row0 = u.a0 * 256 + wr * 64 + fr, col0 = u.a1 * 256 + wc * 32 + 8 * fq;
#pragma unroll
        for (int ai = 0; ai < 2; ++ai)
#pragma unroll
            for (int m = 0; m < 4; ++m) {
#pragma unroll
                for (int bj = 0; bj < 2; ++bj) { bf16* p = xb + (size_t)(row0 + ai * 128 + m * 16) * DM + col0 + bj * 128; const u32x4 xv = *(const u32x4*)p;
                    f32x4 v0 = acc[ai][bj][m][0], v1 = acc[ai][bj][m][1];
                    v0[0] += ALPHA * bflo(xv.x); v0[1] += ALPHA * bfhi(xv.x); v0[2] += ALPHA * bflo(xv.y); v0[3] += ALPHA * bfhi(xv.y);
                    v1[0] += ALPHA * bflo(xv.z); v1[1] += ALPHA * bfhi(xv.z); v1[2] += ALPHA * bflo(xv.w); v1[3] += ALPHA * bfhi(xv.w);
                    *(u32x4*)p = pack8(v0, v1); } }
    }
};

struct SchedRouter {
    static constexpr bool GATHER = false, FIXED = true;
    unsigned xh, xl, wh, wl; int G;
    DI bool next(int i, gs::GU& u) const { const int ti = i / 3, k = i % 3; const int pm = ti * G + lbid(); if (pm >= 256) return false;
        u.A = ((k == 1) ? xl : xh) + (unsigned)pm * 256u * 2048u; u.B = (k == 2) ? wl : wh; u.idx = nullptr; u.lda = 2048; u.ldb = 2048; u.nt = 16;
        u.flags = (k == 0 ? 1 : 0) | (k == 2 ? 2 : 0); u.nvalid = 256; u.a0 = pm; u.a1 = 0; u.a2 = 0; u.a3 = 0; return true; }
};
struct EpiRouter {
    static constexpr bool PERM = false; static constexpr bool BH8 = false; float* logit;
    DI void operator()(const Acc1& acc, const gs::GU& u, int wr, int wc, int fr, int fq) const {
        if (wc >= 2) return;
        const int row0 = u.a0 * 256 + wr * 64 + fr, col0 = wc * 32 + 4 * fq;
#pragma unroll
        for (int ai = 0; ai < 2; ++ai)
#pragma unroll
            for (int m = 0; m < 4; ++m)
#pragma unroll
                for (int n = 0; n < 2; ++n) *(f32x4*)(logit + (size_t)(row0 + ai * 128 + m * 16) * 64 + col0 + n * 16) = acc[ai][0][m][n];
    }
};

constexpr int TBL_OFF = 131072, NPAIR = NCH * 65, TBLN = 528;
static_assert(NPAIR + 1 <= TBLN && TBL_OFF + 3 * TBLN * 4 <= MISC_OFF, "MoE tables");
DI void moe_tables(const Args& a, int l, LAS unsigned char* lds) {
    LAS int* ptile = (LAS int*)(lds + TBL_OFF); LAS int* ypre = ptile + TBLN; LAS int* cntv = ypre + TBLN;
    __syncthreads();
    const int tid_ = ltid();
    if (tid_ < 64) {
        const unsigned* gcnt = (const unsigned*)(a.ws + WS_CTL) + CW_CNT + l * NCH * 64;
        int pt = 0;
        for (int c = 0; c < NCH; ++c) {
            const int n = (int)__hip_atomic_load(gcnt + c * 64 + tid_, __ATOMIC_RELAXED, __HIP_MEMORY_SCOPE_AGENT);
            const int tl = (n + 255) >> 8;
            const int tinc = wave_incl_scan(tl), yinc = wave_incl_scan(n);
            const int p = c * 65 + tid_;
            cntv[p] = n; ptile[p] = pt + tinc - tl; ypre[p] = yinc - n;
            const int ttot = __builtin_amdgcn_readlane(tinc, 63), ytot = __builtin_amdgcn_readlane(yinc, 63);
            if (tid_ == 0) { cntv[c * 65 + 64] = CHTOK; ptile[c * 65 + 64] = pt + ttot; ypre[c * 65 + 64] = ytot; }
            pt += ttot + CHTOK / 256;
        }
        if (tid_ == 0) ptile[NPAIR] = pt;
    }
    __syncthreads();
}
DI int find_pair(const LAS int* ptile, int tile) {
    int lo = 0, hi = NPAIR;
    while (hi - lo > 1) { const int mid = (lo + hi) >> 1; if (ptile[mid] <= tile) lo = mid; else hi = mid; }
    return lo;
}
struct SchedE1 {
    static constexpr bool GATHER = true, FIXED = false;
    const LAS int* ptile; const LAS int* cntv; unsigned xb; const unsigned* lists; unsigned w1; int G;
    DI bool next(int i, gs::GU& u) const { const int bid_ = lbid(); int un = i * G + bid_;
        if (G == 256) { const int x = bid_ & 7, idx = bid_ >> 3; un = (i * 128 + x * 16 + (idx >> 1)) * 2 + (idx & 1); }
        const int tile = un >> 1, pn = un & 1; if (tile >= ptile[NPAIR]) return false;
        const int p = find_pair(ptile, tile), c = p / 65, e = p % 65, t = tile - ptile[p];
        if (e < 64) { u.A = xb; u.idx = (const int*)(lists + ((size_t)c * 64 + e) * CHTOK + (size_t)t * 256); u.nvalid = cntv[p] - t * 256; }
        else { u.A = xb + ((unsigned)c * CHTOK + (unsigned)t * 256u) * 2048u; u.idx = nullptr; u.nvalid = 256; }
        u.B = w1 + (unsigned)e * 512u * 2048u + (unsigned)pn * 256u * 2048u; u.lda = 2048; u.ldb = 2048; u.nt = 16; u.flags = 3; u.a0 = tile; u.a1 = pn; u.a2 = 0; u.a3 = 0; return true; }
};
struct EpiE1 {
    static constexpr bool PERM = true; static constexpr bool BH8 = false; bf16* hb;
    DI void operator()(const Acc2& acc, const gs::GU& u, int wr, int wc, int fr, int fq) const {
        const int row0 = u.a0 * 256 + wr * 64 + fr, col0 = u.a1 * 128 + wc * 32 + 8 * fq;
#pragma unroll
        for (int ai = 0; ai < 2; ++ai)
#pragma unroll
            for (int m = 0; m < 4; ++m) { f32x4 h[2];
#pragma unroll
                for (int n = 0; n < 2; ++n)
#pragma unroll
                    for (int q = 0; q < 4; ++q) { const float g = acc[ai][0][m][n][q], up = acc[ai][1][m][n][q]; h[n][q] = g * sigmoidf_(g) * up; }
                *(u32x4*)(hb + (size_t)(row0 + ai * 128 + m * 16) * 256 + col0) = pack8(h[0], h[1]); }
    }
};
struct SchedE2 {
    static constexpr bool GATHER = false, FIXED = true;
    const LAS int* ptile; const LAS int* cntv; const LAS int* ypre; unsigned hb, w2; int c; int G;
    DI bool next(int i, gs::GU& u) const { const int bid_ = lbid(); int un = i * G + bid_;
        if (G == 256) { const int x = bid_ & 7, idx = bid_ >> 3; un = (i * 64 + x * 8 + (idx >> 2)) * 4 + (idx & 3); }
        const int tile = ptile[c * 65] + (un >> 2), pn = un & 3; if (tile >= ptile[(c + 1) * 65]) return false;
        const int p = find_pair(ptile, tile), e = p % 65, t = tile - ptile[p];
        u.A = hb + (unsigned)tile * 256u * 512u; u.B = w2 + (unsigned)e * 1024u * 512u + (unsigned)pn * 256u * 512u; u.idx = nullptr; u.lda = 512; u.ldb = 512; u.nt = 4; u.flags = 3;
        u.nvalid = 256; u.a0 = (tile - ptile[c * 65]) * 256; u.a1 = pn; u.a2 = 0; u.a3 = 0; return true; }
};
DI unsigned pk4_fp8(float a, float b, float c, float d) { int w = __builtin_amdgcn_cvt_pk_fp8_f32(a, b, 0, false); w = __builtin_amdgcn_cvt_pk_fp8_f32(c, d, w, true); return (unsigned)w; }
struct EpiE2 {
    static constexpr bool PERM = true; static constexpr bool BH8 = true; unsigned char* y;
    DI void operator()(const Acc2& acc, const gs::GU& u, int wr, int wc, int fr, int fq) const {
        const int row0 = u.a0 + wr * 64 + fr, col0 = u.a1 * 256 + wc * 64 + 16 * fq;
#pragma unroll
        for (int ai = 0; ai < 2; ++ai)
#pragma unroll
            for (int m = 0; m < 4; ++m) {
                u32x4 w;
                { const f32x4 v0 = acc[ai][0][m][0], v1 = acc[ai][0][m][1]; w.x = pk4_fp8(v0[0], v0[1], v0[2], v0[3]); w.y = pk4_fp8(v1[0], v1[1], v1[2], v1[3]); }
                { const f32x4 v0 = acc[ai][1][m][0], v1 = acc[ai][1][m][1]; w.z = pk4_fp8(v0[0], v0[1], v0[2], v0[3]); w.w = pk4_fp8(v1[0], v1[1], v1[2], v1[3]); }
                *(u32x4*)(y + (size_t)(row0 + ai * 128 + m * 16) * DM + col0) = w; }
    }
};

DI void ph_ln2(const Args& a, int l, int c, LAS unsigned char* lds, int gw, int NGW, int lane) {
    const LAS int* ptile = (const LAS int*)(lds + TBL_OFF);
    bf16* xb = (bf16*)(a.ws + WS_XB); const unsigned char* y = (const unsigned char*)(a.ws + WS_Y);
    const u32x2* tokinfo = (const u32x2*)(a.ws + WS_TOKINFO);
    const float* g = a.ln2_g + l * DM; const float* be = a.ln2_b + l * DM;
    u32x4 nx0 = {0u,0u,0u,0u}, nx1 = {0u,0u,0u,0u}; u32x2 nti = {0u, 0u};
    if (gw < CHTOK) { const int row0 = c * CHTOK + gw; const u32x4* xr0 = (const u32x4*)(xb + (size_t)row0 * DM) + lane; nx0 = xr0[0]; nx1 = xr0[64]; if (lane < 8) nti = tokinfo[(size_t)row0 * 8 + lane]; }
    for (int tt = gw; tt < CHTOK; tt += NGW) {
        const int row = c * CHTOK + tt;
        const u32x4 cx0 = nx0, cx1 = nx1; const u32x2 cti = nti;
        if (tt + NGW < CHTOK) { const int rown = row + NGW; const u32x4* xrn = (const u32x4*)(xb + (size_t)rown * DM) + lane; nx0 = xrn[0]; nx1 = xrn[64]; if (lane < 8) nti = tokinfo[(size_t)rown * 8 + lane]; }
        u32x4* xr = (u32x4*)(xb + (size_t)row * DM) + lane;
        f32x4 v[4];
        v[0] = (f32x4){bflo(cx0.x), bfhi(cx0.x), bflo(cx0.y), bfhi(cx0.y)} * ALPHA; v[1] = (f32x4){bflo(cx0.z), bfhi(cx0.z), bflo(cx0.w), bfhi(cx0.w)} * ALPHA;
        v[2] = (f32x4){bflo(cx1.x), bfhi(cx1.x), bflo(cx1.y), bfhi(cx1.y)} * ALPHA; v[3] = (f32x4){bflo(cx1.z), bfhi(cx1.z), bflo(cx1.w), bfhi(cx1.w)} * ALPHA;
        int yrv = 0; float wv = 1.f;
        if (lane < 8) { const u32x2 ti = cti; yrv = (ptile[c * 65 + (int)(ti.x >> 16)] - ptile[c * 65]) * 256 + (int)(ti.x & 0xffffu); wv = __uint_as_float(ti.y); }
        else if (lane == 8) yrv = (ptile[c * 65 + 64] - ptile[c * 65]) * 256 + tt;
        u32x2 q[9][2]; float wk[9];
#pragma unroll
        for (int k = 0; k < 9; ++k) { const int yrow = __builtin_amdgcn_readlane(yrv, k); wk[k] = __int_as_float(__builtin_amdgcn_readlane(__float_as_int(wv), k)) * (1.f / Y_SCALE);
            const u32x2* yr = (const u32x2*)(y + (size_t)yrow * DM) + lane; q[k][0] = yr[0]; q[k][1] = yr[64]; }
#pragma unroll
        for (int k = 0; k < 9; ++k) {
#pragma unroll
            for (int j = 0; j < 2; ++j) { const float ws_ = wk[k]; const u32x2 qq = q[k][j];
                v[2 * j][0] += ws_ * __builtin_amdgcn_cvt_f32_fp8((int)qq.x, 0); v[2 * j][1] += ws_ * __builtin_amdgcn_cvt_f32_fp8((int)qq.x, 1); v[2 * j][2] += ws_ * __builtin_amdgcn_cvt_f32_fp8((int)qq.x, 2); v[2 * j][3] += ws_ * __builtin_amdgcn_cvt_f32_fp8((int)qq.x, 3);
                v[2 * j + 1][0] += ws_ * __builtin_amdgcn_cvt_f32_fp8((int)qq.y, 0); v[2 * j + 1][1] += ws_ * __builtin_amdgcn_cvt_f32_fp8((int)qq.y, 1); v[2 * j + 1][2] += ws_ * __builtin_amdgcn_cvt_f32_fp8((int)qq.y, 2); v[2 * j + 1][3] += ws_ * __builtin_amdgcn_cvt_f32_fp8((int)qq.y, 3); }
        }
        float s = 0.f;
#pragma unroll
        for (int j = 0; j < 4; ++j) s += (v[j].x + v[j].y) + (v[j].z + v[j].w);
        const float mean = wave_sum(s) * (1.f / DM); float s2 = 0.f;
#pragma unroll
        for (int j = 0; j < 4; ++j) { v[j] = v[j] - mean; s2 += (v[j].x * v[j].x + v[j].y * v[j].y) + (v[j].z * v[j].z + v[j].w * v[j].w); }
        const float rstd = 1.f / sqrtf(wave_sum(s2) * (1.f / DM) + LN_EPS);
#pragma unroll
        for (int j = 0; j < 2; ++j) {
            const int cb = 8 * lane + 512 * j;
            const f32x4 g0 = *(const f32x4*)(g + cb), g1 = *(const f32x4*)(g + cb + 4), b0 = *(const f32x4*)(be + cb), b1 = *(const f32x4*)(be + cb + 4);
            const f32x4 y0 = v[2 * j] * rstd * g0 + b0, y1 = v[2 * j + 1] * rstd * g1 + b1;
            xr[64 * j] = pack8(y0, y1);
            if (l == DEPTH - 1) { float* o = a.out + (size_t)row * DM + cb; *(f32x4*)o = y0; *(f32x4*)(o + 4) = y1; }
        }
    }
}

DI int pi32(int r) { return (r & ~12) | ((r & 4) << 1) | ((r & 8) >> 1); }
DI int kofs(int i, int hh) { return 16 * (i >> 3) + 8 * hh + (i & 7); }
DI bf16x8 pack_p(const float (&p)[16], int s) {
    u32x4 w; w.x = cvtpk(p[8 * s], p[8 * s + 1]); w.y = cvtpk(p[8 * s + 2], p[8 * s + 3]); w.z = cvtpk(p[8 * s + 4], p[8 * s + 5]); w.w = cvtpk(p[8 * s + 6], p[8 * s + 7]);
    return __builtin_bit_cast(bf16x8, w);
}
DI f32x16 zero16() { f32x16 z;
#pragma unroll
    for (int i = 0; i < 16; ++i) z[i] = 0.f; return z; }
DI void store_ot(bf16* dst, const f32x16& o0, const f32x16& o1, float sc, int hh) {
#pragma unroll
    for (int g = 0; g < 4; ++g) {
        float v[4];
#pragma unroll
        for (int q = 0; q < 4; ++q) v[q] = o0[4 * g + q] * sc;
        st4bf(dst + 8 * g + 4 * hh, v);
#pragma unroll
        for (int q = 0; q < 4; ++q) v[q] = o1[4 * g + q] * sc;
        st4bf(dst + 32 + 8 * g + 4 * hh, v);
    }
}

DI void load_kv(bf16x8 (&kf)[4], bf16x8 (&vf)[2][2], const bf16* kp, const bf16* vp) {
#pragma unroll
    for (int s = 0; s < 4; ++s) kf[s] = *(const bf16x8*)(kp + 16 * s);
#pragma unroll
    for (int dt = 0; dt < 2; ++dt)
#pragma unroll
        for (int s = 0; s < 2; ++s) vf[dt][s] = *(const bf16x8*)(vp + (size_t)dt * 32 * SEQ + 16 * s);
}
DI void copy_kv(bf16x8 (&kf)[4], bf16x8 (&vf)[2][2], const bf16x8 (&nkf)[4], const bf16x8 (&nvf)[2][2]) {
#pragma unroll
    for (int s = 0; s < 4; ++s) kf[s] = nkf[s];
#pragma unroll
    for (int dt = 0; dt < 2; ++dt)
#pragma unroll
        for (int s = 0; s < 2; ++s) vf[dt][s] = nvf[dt][s];
}

DI void sb_unit(const Args& a, int b, int h, int qb, int lane) {
    const bf16* proj = (const bf16*)(a.ws + WS_A);
    const int c = lane & 31, hh = lane >> 5, pr = pi32(c);
    const size_t tokq = (size_t)b * SEQ + qb * 32 + c;
    const bf16* qp = proj + tokq * PW + C_BQ + h * 64 + 8 * hh;
    bf16x8 qf[4];
#pragma unroll
    for (int s = 0; s < 4; ++s) qf[s] = *(const bf16x8*)(qp + 16 * s);
    f32x16 o0 = zero16(), o1 = zero16(); float R = 1.f;
    const bool slot0lo = (__builtin_amdgcn_permlane32_swap((unsigned)hh, (unsigned)hh, false, false)[0] == 0u);
    const bf16* kbase = proj + (size_t)b * SEQ * PW + C_BK + h * 64 + 8 * hh;
    const bf16* vb0 = (const bf16*)(a.ws + WS_VTB) + ((size_t)(b * 4 + h) * 64 + c) * SEQ + 8 * hh;
    bf16x8 kf[4], vf[2][2];
    load_kv(kf, vf, kbase + (size_t)(qb * 32 + pr) * PW, vb0 + qb * 32);
    for (int kt = qb; kt >= 0; --kt) {
        bf16x8 nkf[4], nvf[2][2];
        { const int kn = (kt > 0) ? kt - 1 : 0; load_kv(nkf, nvf, kbase + (size_t)(kn * 32 + pr) * PW, vb0 + kn * 32); }
        f32x16 x = zero16();
#pragma unroll
        for (int s = 0; s < 4; ++s) x = mfma32(kf[s], qf[s], x);
        const bool diag = (kt == qb);
        float rr[16], ex[16], T[2];
#pragma unroll
        for (int i = 0; i < 16; ++i) { float rv = frcp(1.f + fexp2(x[i])); if (diag && kofs(i, hh) >= c) rv = 1.f; rr[i] = rv; }
#pragma unroll
        for (int s = 0; s < 2; ++s) { ex[8 * s + 7] = 1.f;
#pragma unroll
            for (int j = 6; j >= 0; --j) ex[8 * s + j] = ex[8 * s + j + 1] * rr[8 * s + j + 1];
            T[s] = ex[8 * s] * rr[8 * s]; }
        const auto r0_ = __builtin_amdgcn_permlane32_swap(__float_as_uint(T[0]), __float_as_uint(T[0]), false, false), r1_ = __builtin_amdgcn_permlane32_swap(__float_as_uint(T[1]), __float_as_uint(T[1]), false, false);
        const float PT0 = __uint_as_float((hh != 0) == slot0lo ? r0_[0] : r0_[1]), PT1 = __uint_as_float((hh != 0) == slot0lo ? r1_[0] : r1_[1]);
        float suf0, suf1;
        if (hh == 0) { suf1 = R * PT1; suf0 = suf1 * T[1] * PT0; } else { suf1 = R; suf0 = R * T[1] * PT1; }
        R = R * (T[0] * T[1]) * (PT0 * PT1);
        float p[16];
#pragma unroll
        for (int i = 0; i < 16; ++i) p[i] = (1.f - rr[i]) * ex[i] * (i < 8 ? suf0 : suf1);
        const bf16x8 pb0 = pack_p(p, 0), pb1 = pack_p(p, 1);
        o0 = mfma32(vf[0][0], pb0, o0); o0 = mfma32(vf[0][1], pb1, o0);
        o1 = mfma32(vf[1][0], pb0, o1); o1 = mfma32(vf[1][1], pb1, o1);
        copy_kv(kf, vf, nkf, nvf);
    }
    store_ot((bf16*)(a.ws + WS_B) + tokq * DM + 256 + h * 64, o0, o1, 1.f, hh);
}

DI void fg_unit(const Args& a, int b, int h, int qb, int lane) {
    const bf16* proj = (const bf16*)(a.ws + WS_A);
    const int c = lane & 31, hh = lane >> 5, pr = pi32(c);
    const size_t tokq = (size_t)b * SEQ + qb * 32 + c;
    const bf16* qp = proj + tokq * PW + C_CQ + h * 64 + 8 * hh;
    bf16x8 qf[4];
#pragma unroll
    for (int s = 0; s < 4; ++s) qf[s] = *(const bf16x8*)(qp + 16 * s);
    const float* cum = (const float*)(a.ws + WS_CUM) + (size_t)(b * 4 + h) * SEQ;
    const float cq = cum[qb * 32 + c];
    f32x16 o0 = zero16(), o1 = zero16(); float m = -1.0e30f, l = 0.f;
    const bf16* kbase = proj + (size_t)b * SEQ * PW + C_CK + h * 64 + 8 * hh;
    const bf16* vb0 = (const bf16*)(a.ws + WS_VTC) + ((size_t)(b * 4 + h) * 64 + c) * SEQ + 8 * hh;
    bf16x8 kf[4], vf[2][2];
    load_kv(kf, vf, kbase + (size_t)pr * PW, vb0);
    for (int kt = 0; kt <= qb; ++kt) {
        const int k0 = kt * 32;
        bf16x8 nkf[4], nvf[2][2];
        { const int kn = (kt < qb) ? kt + 1 : kt; load_kv(nkf, nvf, kbase + (size_t)(kn * 32 + pr) * PW, vb0 + kn * 32); }
        float ck[16];
#pragma unroll
        for (int s = 0; s < 2; ++s) { const f32x4 c0 = *(const f32x4*)(cum + k0 + 16 * s + 8 * hh), c1 = *(const f32x4*)(cum + k0 + 16 * s + 8 * hh + 4);
            ck[8 * s] = c0.x; ck[8 * s + 1] = c0.y; ck[8 * s + 2] = c0.z; ck[8 * s + 3] = c0.w; ck[8 * s + 4] = c1.x; ck[8 * s + 5] = c1.y; ck[8 * s + 6] = c1.z; ck[8 * s + 7] = c1.w; }
        f32x16 x = zero16();
#pragma unroll
        for (int s = 0; s < 4; ++s) x = mfma32(kf[s], qf[s], x);
        const bool diag = (kt == qb);
        float sv[16]; float tmax = -1.0e30f;
#pragma unroll
        for (int i = 0; i < 16; ++i) { const bool ok = !(diag && kofs(i, hh) > c); sv[i] = ok ? (x[i] + (cq - ck[i])) : -1.0e30f; tmax = fmaxf(tmax, sv[i]); }
        tmax = red32_max(tmax);
        const float mn = fmaxf(m, tmax), al = fexp2(m - mn);
        float p[16]; float ls = 0.f;
#pragma unroll
        for (int i = 0; i < 16; ++i) { p[i] = (sv[i] > -1.0e29f) ? fexp2(sv[i] - mn) : 0.f; ls += p[i]; }
        l = l * al + ls; m = mn;
#pragma unroll
        for (int i = 0; i < 16; ++i) { o0[i] *= al; o1[i] *= al; }
        const bf16x8 pb0 = pack_p(p, 0), pb1 = pack_p(p, 1);
        o0 = mfma32(vf[0][0], pb0, o0); o0 = mfma32(vf[0][1], pb1, o0);
        o1 = mfma32(vf[1][0], pb0, o1); o1 = mfma32(vf[1][1], pb1, o1);
        copy_kv(kf, vf, nkf, nvf);
    }
    const float lt = red32_sum(l);
    store_ot((bf16*)(a.ws + WS_B) + tokq * DM + 512 + h * 64, o0, o1, 1.f / lt, hh);
}


DI void atile_load(u32x4& reg, const bf16* kt0, const bf16* vt0, int kt, int tid) {
    reg = (tid < 256) ? *(const u32x4*)(kt0 + (size_t)kt * 2048 + tid * 8) : *(const u32x4*)(vt0 + (size_t)kt * 2048 + (tid - 256) * 8);
}
DI void atile_store(LAS unsigned char* buf, const u32x4& reg, int tid) { *(LAS u32x4*)(buf + tid * 16) = reg; }
DI void atile_frags(bf16x8 (&kf)[4], bf16x8 (&vf)[2][2], const LAS unsigned char* buf, int c, int hh, int prow) {
    (void)prow;
#pragma unroll
    for (int s = 0; s < 4; ++s) kf[s] = *(const LAS bf16x8*)(buf + ((2 * s + hh) * 32 + c) * 16);
#pragma unroll
    for (int dt = 0; dt < 2; ++dt)
#pragma unroll
        for (int s = 0; s < 2; ++s) vf[dt][s] = *(const LAS bf16x8*)(buf + 4096 + ((dt * 2 + s) * 64 + hh * 32 + c) * 16);
}
template <int MIXER>
DI void sbfg_block(const Args& a, int l, int b, int h, int QB, LAS unsigned char* lds, int tid, int wave, int lane) {
    const bf16* proj = (const bf16*)(a.ws + WS_A);
    const int c = lane & 31, hh = lane >> 5, pr = pi32(c);
    const int ntile = 8 * QB + 8, qb = 8 * QB + wave;
    const size_t tokq = (size_t)b * SEQ + qb * 32 + c;
    const bf16* qp = proj + tokq * PW + (MIXER == 0 ? C_BQ : C_CQ) + h * 64 + 8 * hh;
    bf16x8 qf[4];
#pragma unroll
    for (int s = 0; s < 4; ++s) qf[s] = *(const bf16x8*)(qp + 16 * s);
    const bf16* krow0 = (const bf16*)(a.ws + (MIXER == 0 ? WS_KTB : WS_KTC)) + (size_t)(b * 4 + h) * (SEQ / 32) * 2048;
    const bf16* vt0 = (const bf16*)(a.ws + (MIXER == 0 ? WS_VTB : WS_VTC)) + (size_t)(b * 4 + h) * (SEQ / 32) * 2048;
    const float* cum = (const float*)(a.ws + WS_CUM) + (size_t)(b * 4 + h) * SEQ;
    const float cq = (MIXER == 1) ? cum[qb * 32 + c] : 0.f;
    float Bq = 0.f;
    if (MIXER == 1) { float qs = 0.f;
#pragma unroll
        for (int s = 0; s < 4; ++s) { const u32x4 w = __builtin_bit_cast(u32x4, qf[s]);
            qs += bflo(w.x) * bflo(w.x) + bfhi(w.x) * bfhi(w.x) + bflo(w.y) * bflo(w.y) + bfhi(w.y) * bfhi(w.y) + bflo(w.z) * bflo(w.z) + bfhi(w.z) * bfhi(w.z) + bflo(w.w) * bflo(w.w) + bfhi(w.w) * bfhi(w.w); }
        qs = red32_sum(qs);
        const float k2 = __uint_as_float(((const unsigned*)(a.ws + WS_CTL))[CW_KMAX + l * 32 + b * 4 + h]);
        Bq = sqrtf(qs * k2) * 1.01f + 0.5f; }
    f32x16 o0 = zero16(), o1 = zero16(); float R = 1.f, m = -1.0e30f, l_ = 0.f;
    const bool slot0lo = (__builtin_amdgcn_permlane32_swap((unsigned)hh, (unsigned)hh, false, false)[0] == 0u);
    u32x4 reg;
    atile_load(reg, krow0, vt0, ntile - 1, tid); atile_store(lds, reg, tid);
    if (ntile > 1) { atile_load(reg, krow0, vt0, ntile - 2, tid); atile_store(lds + 8192, reg, tid); }
    __syncthreads();
    bf16x8 kfA[4], vfA[2][2], kfB[4], vfB[2][2];
    atile_frags(kfA, vfA, lds, c, hh, pr);
    int st = 0;
#define SBFG_STEP(JJ, KF, VF, NKF, NVF) { \
        const int kt = ntile - 1 - (JJ); \
        const int st1 = (st == 2) ? 0 : st + 1, st2 = (st1 == 2) ? 0 : st1 + 1; \
        if ((JJ) + 2 < ntile) atile_load(reg, krow0, vt0, kt - 2, tid); \
        if ((JJ) + 1 < ntile) atile_frags(NKF, NVF, lds + st1 * 8192, c, hh, pr); \
        if (kt <= qb) { \
            f32x16 x = zero16(); \
_Pragma("unroll") \
            for (int s = 0; s < 4; ++s) x = mfma32(KF[s], qf[s], x); \
            const bool diag = (kt == qb); \
            float p[16]; \
            if (MIXER == 0) { \
                float rr[16], ex[16], T[2]; \
_Pragma("unroll") \
                for (int i = 0; i < 16; ++i) rr[i] = frcp(1.f + fexp2(x[i])); \
                if (diag) { \
_Pragma("unroll") \
                    for (int i = 0; i < 16; ++i) if (kofs(i, hh) >= c) rr[i] = 1.f; \
                } \
_Pragma("unroll") \
                for (int s = 0; s < 2; ++s) { ex[8 * s + 7] = 1.f; \
_Pragma("unroll") \
                    for (int q = 6; q >= 0; --q) ex[8 * s + q] = ex[8 * s + q + 1] * rr[8 * s + q + 1]; \
                    T[s] = ex[8 * s] * rr[8 * s]; } \
                const auto r0_ = __builtin_amdgcn_permlane32_swap(__float_as_uint(T[0]), __float_as_uint(T[0]), false, false), r1_ = __builtin_amdgcn_permlane32_swap(__float_as_uint(T[1]), __float_as_uint(T[1]), false, false); \
                const float PT0 = __uint_as_float((hh != 0) == slot0lo ? r0_[0] : r0_[1]), PT1 = __uint_as_float((hh != 0) == slot0lo ? r1_[0] : r1_[1]); \
                float suf0, suf1; \
                if (hh == 0) { suf1 = R * PT1; suf0 = suf1 * T[1] * PT0; } else { suf1 = R; suf0 = R * T[1] * PT1; } \
                R = R * (T[0] * T[1]) * (PT0 * PT1); \
_Pragma("unroll") \
                for (int i = 0; i < 16; ++i) p[i] = (ex[i] - ex[i] * rr[i]) * (i < 8 ? suf0 : suf1); \
            } else { \
                const int k0 = kt * 32; \
                float ck[16]; \
_Pragma("unroll") \
                for (int s = 0; s < 2; ++s) { const f32x4 c0 = *(const f32x4*)(cum + k0 + 16 * s + 8 * hh), c1 = *(const f32x4*)(cum + k0 + 16 * s + 8 * hh + 4); \
                    ck[8 * s] = c0.x; ck[8 * s + 1] = c0.y; ck[8 * s + 2] = c0.z; ck[8 * s + 3] = c0.w; ck[8 * s + 4] = c1.x; ck[8 * s + 5] = c1.y; ck[8 * s + 6] = c1.z; ck[8 * s + 7] = c1.w; } \
                float sv[16]; float tmax = -1.0e30f; \
_Pragma("unroll") \
                for (int i = 0; i < 16; ++i) sv[i] = x[i] + (cq - ck[i]); \
                if (diag) { \
_Pragma("unroll") \
                    for (int i = 0; i < 16; ++i) if (kofs(i, hh) > c) sv[i] = -1.0e30f; \
                } \
_Pragma("unroll") \
                for (int i = 0; i < 16; ++i) tmax = fmaxf(tmax, sv[i]); \
                tmax = red32_max(tmax); \
                if (__any(tmax > m)) { \
                    const float mn = fmaxf(m, tmax), al = fexp2(m - mn); m = mn; l_ *= al; \
_Pragma("unroll") \
                    for (int i = 0; i < 16; ++i) { o0[i] *= al; o1[i] *= al; } \
                } \
                float ls = 0.f; \
_Pragma("unroll") \
                for (int i = 0; i < 16; ++i) { p[i] = fexp2(sv[i] - m); ls += p[i]; } \
                l_ += ls; \
            } \
            const bf16x8 pb0 = pack_p(p, 0), pb1 = pack_p(p, 1); \
            o0 = mfma32(VF[0][0], pb0, o0); o0 = mfma32(VF[0][1], pb1, o0); \
            o1 = mfma32(VF[1][0], pb0, o1); o1 = mfma32(VF[1][1], pb1, o1); \
        } \
        if ((JJ) + 2 < ntile) atile_store(lds + st2 * 8192, reg, tid); \
        __syncthreads(); \
        st = st1; \
    }
    LAS unsigned* dflag = (LAS unsigned*)(lds + 24576);
    for (int j = 0; j < ntile; j += 2) {
        SBFG_STEP(j, kfA, vfA, kfB, vfB)
        {
            const int ktj = ntile - 1 - j; const bool started = ktj <= qb;
            bool fin;
            if (MIXER == 0) fin = started && __all(R < 1.0e-12f);
            else { const float cn = (ktj >= 1) ? cum[32 * ktj - 1] : 0.f; fin = started && (ktj >= 1) && __all(Bq + (cq - cn) < m - 40.f); }
            if (lane == 0) dflag[((j >> 1) & 1) * 8 + wave] = fin ? 1u : 0u;
        }
        SBFG_STEP(j + 1, kfB, vfB, kfA, vfA)
        {
            const u32x4 f0 = *(const LAS u32x4*)(dflag + ((j >> 1) & 1) * 8), f1 = *(const LAS u32x4*)(dflag + ((j >> 1) & 1) * 8 + 4);
            if ((f0.x & f0.y & f0.z & f0.w & f1.x & f1.y & f1.z & f1.w) != 0u) break;
        }
    }
#undef SBFG_STEP
    if (MIXER == 0) store_ot((bf16*)(a.ws + WS_B) + tokq * DM + 256 + h * 64, o0, o1, 1.f, hh);
    else { const float lt = red32_sum(l_); store_ot((bf16*)(a.ws + WS_B) + tokq * DM + 512 + h * 64, o0, o1, 1.f / lt, hh); }
}

constexpr float OSM_THR = 4.f;
DI void osm_step(const f32x16& x, int lo, int hi, int hh, bool interior, bool sel, float& m, float& l, f32x16& o0, f32x16& o1, const bf16x8 (&vf)[2][2]) {
    float sv[16];
    if (interior) {
#pragma unroll
        for (int i = 0; i < 16; ++i) sv[i] = x[i];
    } else {
#pragma unroll
        for (int i = 0; i < 16; ++i) { const int ko = kofs(i, hh); sv[i] = (ko <= hi && ko >= lo) ? x[i] : -3.0e38f; }
    }
    float tmax = -3.0e38f;
#pragma unroll
    for (int i = 0; i < 16; ++i) tmax = fmaxf(tmax, sv[i]);
    tmax = red32_max(sel ? tmax : -3.0e38f);
    if (__any(tmax > m + OSM_THR)) { const float mn = fmaxf(m, tmax), al = fexp2(m - mn); m = mn; l *= al;
#pragma unroll
        for (int i = 0; i < 16; ++i) { o0[i] *= al; o1[i] *= al; } }
    const float meff = sel ? m : 3.0e38f;
    float p[16]; float ls = 0.f;
#pragma unroll
    for (int i = 0; i < 16; ++i) { p[i] = fexp2(sv[i] - meff); ls += p[i]; }
    l += ls;
    const bf16x8 pb0 = pack_p(p, 0), pb1 = pack_p(p, 1);
    o0 = mfma32(vf[0][0], pb0, o0); o0 = mfma32(vf[0][1], pb1, o0);
    o1 = mfma32(vf[1][0], pb0, o1); o1 = mfma32(vf[1][1], pb1, o1);
}

DI void ld_k4(bf16x8 (&kf)[4], const bf16* kp) {
#pragma unroll
    for (int s = 0; s < 4; ++s) kf[s] = *(const bf16x8*)(kp + 16 * s);
}
DI void ld_v4(bf16x8 (&vf)[2][2], const bf16* vp, int vpitch) {
#pragma unroll
    for (int dt = 0; dt < 2; ++dt)
#pragma unroll
        for (int s = 0; s < 2; ++s) vf[dt][s] = *(const bf16x8*)(vp + (size_t)dt * 32 * vpitch + 16 * s);
}
DI void ld_kt(bf16x8 (&kf)[4], const bf16* tile, int c, int hh) {
#pragma unroll
    for (int s = 0; s < 4; ++s) kf[s] = *(const bf16x8*)(tile + ((2 * s + hh) * 32 + c) * 8);
}
DI void ld_vt(bf16x8 (&vf)[2][2], const bf16* tile, int c, int hh) {
#pragma unroll
    for (int dt = 0; dt < 2; ++dt)
#pragma unroll
        for (int s = 0; s < 2; ++s) vf[dt][s] = *(const bf16x8*)(tile + ((dt * 2 + s) * 64 + hh * 32 + c) * 8);
}
DI unsigned wave_max_u(unsigned v) {
    v = max(v, (unsigned)DPPI((int)v, 0xB1, 0xF, true)); v = max(v, (unsigned)DPPI((int)v, 0x4E, 0xF, true));
    v = max(v, (unsigned)DPPI((int)v, 0x124, 0xF, true)); v = max(v, (unsigned)DPPI((int)v, 0x128, 0xF, true));
    { const auto r = __builtin_amdgcn_permlane16_swap(v, v, false, false); v = max(r[0], r[1]); const auto q = __builtin_amdgcn_permlane32_swap(v, v, false, false); v = max(q[0], q[1]); }
    return v;
}
DI void nsa_unit(const Args& a, int unit, LAS unsigned char* wl, int lane) {
    const bf16* proj = (const bf16*)(a.ws + WS_A);
    const int tok0 = unit * 8, b = tok0 / SEQ, t0 = tok0 % SEQ;
    const int c = lane & 31, hh = lane >> 5, ql = c >> 2, hd = c & 3, pr = pi32(c);
    const int tq = t0 + ql; const size_t tokq = (size_t)tok0 + ql;
    const bf16* qp = proj + tokq * PW + C_AQ + hd * 64 + 8 * hh;
    bf16x8 qf[4];
#pragma unroll
    for (int s = 0; s < 4; ++s) qf[s] = *(const bf16x8*)(qp + 16 * s);
    LAS float* imp = (LAS float*)wl; LAS unsigned* selm = (LAS unsigned*)(wl + 4096); LAS unsigned char* blist = (LAS unsigned char*)(wl + 4096 + 128);
    for (int i = lane; i < 1024; i += 64) imp[i] = 0.f;
    const float* gate = (const float*)(a.ws + WS_GATE) + tokq * 12 + hd * 3;
    const float g0 = gate[0], g1 = gate[1], g2 = gate[2];
    f32x16 of0 = zero16(), of1 = zero16();
    {
        const bf16* kc = (const bf16*)(a.ws + WS_KCMP) + (size_t)b * 16 * 2048;
        const bf16* vt = (const bf16*)(a.ws + WS_VTCMP) + (size_t)b * 16 * 2048;
        const int nmaxq = (tq >= 31) ? ((tq - 31) >> 4) : -1;
        const int nmaxu = (t0 + 7 >= 31) ? ((t0 + 7 - 31) >> 4) : -1;
        const int nmax0 = (t0 >= 31) ? ((t0 - 31) >> 4) : -1;
        const int ntile = (nmaxu >> 5) + 1;
        float m = -1.0e30f, l = 0.f;
        bf16x8 kf[4], nkf[4];
        if (ntile > 0) ld_kt(kf, kc, c, hh);
        for (int kt = 0; kt < ntile; ++kt) {
            ld_kt(nkf, kc + (size_t)(kt + 1 < ntile ? kt + 1 : kt) * 2048, c, hh);
            f32x16 x = zero16();
#pragma unroll
            for (int s = 0; s < 4; ++s) x = mfma32(kf[s], qf[s], x);
            const int lim = nmaxq - kt * 32; float sv[16]; float tmax = -3.0e38f;
            if (kt * 32 + 31 <= nmax0) {
#pragma unroll
                for (int i = 0; i < 16; ++i) sv[i] = x[i];
            } else {
#pragma unroll
                for (int i = 0; i < 16; ++i) sv[i] = (kofs(i, hh) <= lim) ? x[i] : -3.0e38f;
            }
#pragma unroll
            for (int i = 0; i < 16; ++i) tmax = fmaxf(tmax, sv[i]);
            tmax = red32_max(tmax);
            const float mn = fmaxf(m, tmax); float ls = 0.f;
#pragma unroll
            for (int i = 0; i < 16; ++i) ls += fexp2(sv[i] - mn);
            l = l * fexp2(m - mn) + ls; m = mn;
#pragma unroll
            for (int s = 0; s < 4; ++s) kf[s] = nkf[s];
        }
        const float lt = red32_sum(l);
        const float inv = 1.f / fmaxf(lt, 1.0e-30f);
        f32x16 o0 = zero16(), o1 = zero16();
        LDS_WAIT();
        bf16x8 vf[2][2], nvf[2][2];
        if (ntile > 0) { ld_kt(kf, kc, c, hh); ld_vt(vf, vt, c, hh); }
        for (int kt = 0; kt < ntile; ++kt) {
            { const int kn = (kt + 1 < ntile ? kt + 1 : kt); ld_kt(nkf, kc + (size_t)kn * 2048, c, hh); ld_vt(nvf, vt + (size_t)kn * 2048, c, hh); }
            f32x16 x = zero16();
#pragma unroll
            for (int s = 0; s < 4; ++s) x = mfma32(kf[s], qf[s], x);
            float p[16], ps[16], sv[16];
            if (kt * 32 + 31 <= nmax0) {
#pragma unroll
                for (int i = 0; i < 16; ++i) sv[i] = x[i];
            } else {
#pragma unroll
                for (int i = 0; i < 16; ++i) sv[i] = (kofs(i, hh) <= nmaxq - kt * 32) ? x[i] : -3.0e38f;
            }
#pragma unroll
            for (int i = 0; i < 16; ++i) { p[i] = fexp2(sv[i] - m) * inv;
                float t = p[i]; t += dpp_xor1(t); t += dpp_xor2(t); ps[i] = t; }
            if (hd == 0) {
#pragma unroll
                for (int s = 0; s < 2; ++s) { const int gb = (kt * 32 + 16 * s + 8 * hh) >> 2; LAS float* ip = imp + ql * 128 + gb;
                    __hip_atomic_fetch_add(ip, (ps[8 * s] + ps[8 * s + 1]) + (ps[8 * s + 2] + ps[8 * s + 3]), __ATOMIC_RELAXED, __HIP_MEMORY_SCOPE_WORKGROUP);
                    __hip_atomic_fetch_add(ip + 1, ps[8 * s + 3] + (ps[8 * s + 4] + ps[8 * s + 5]) + (ps[8 * s + 6] + ps[8 * s + 7]), __ATOMIC_RELAXED, __HIP_MEMORY_SCOPE_WORKGROUP);
                    if (gb + 2 < 128) __hip_atomic_fetch_add(ip + 2, ps[8 * s + 7], __ATOMIC_RELAXED, __HIP_MEMORY_SCOPE_WORKGROUP); }
            }
            const bf16x8 pb0 = pack_p(p, 0), pb1 = pack_p(p, 1);
            o0 = mfma32(vf[0][0], pb0, o0); o0 = mfma32(vf[0][1], pb1, o0);
            o1 = mfma32(vf[1][0], pb0, o1); o1 = mfma32(vf[1][1], pb1, o1);
            copy_kv(kf, vf, nkf, nvf);
        }
#pragma unroll
        for (int i = 0; i < 16; ++i) { of0[i] = g0 * o0[i]; of1[i] = g0 * o1[i]; }
    }
    LDS_WAIT();
    for (int qi = 0; qi < 8; ++qi) {
        const int qblk = (t0 + qi) >> 6;
        const LAS float* iq = imp + qi * 128;
        const int b0 = lane, b1 = lane + 64;
        const bool ad0 = b0 <= qblk, ad1 = b1 <= qblk;
        const bool f0 = (b0 == 0) || (b0 == qblk) || (b0 == qblk - 1), f1 = (b1 == qblk) || (b1 == qblk - 1);
        unsigned v0 = ad0 ? __float_as_uint(f0 ? iq[b0] + 1.0e6f : iq[b0]) + 1u : 0u, v1 = ad1 ? __float_as_uint(f1 ? iq[b1] + 1.0e6f : iq[b1]) + 1u : 0u;
        unsigned long long m0 = 0ull, m1 = 0ull;
        const int nsel = (qblk + 1 < 16) ? qblk + 1 : 16;
        for (int r = 0; r < nsel; ++r) {
            const unsigned mx = wave_max_u(max(v0, v1));
            const unsigned long long e0 = __ballot(v0 == mx);
            if (e0) { const int idx = __builtin_ctzll(e0); m0 |= 1ull << idx; if (lane == idx) v0 = 0u; }
            else { const unsigned long long e1 = __ballot(v1 == mx); const int idx = __builtin_ctzll(e1); m1 |= 1ull << idx; if (lane == idx) v1 = 0u; }
        }
        if (lane == 0) { selm[qi * 4] = (unsigned)m0; selm[qi * 4 + 1] = (unsigned)(m0 >> 32); selm[qi * 4 + 2] = (unsigned)m1; selm[qi * 4 + 3] = (unsigned)(m1 >> 32); }
    }
    LDS_WAIT();
    {
        unsigned mk[4], um[4]; int nb = 0;
#pragma unroll
        for (int w = 0; w < 4; ++w) { mk[w] = selm[ql * 4 + w]; unsigned u = 0;
#pragma unroll
            for (int q = 0; q < 8; ++q) u |= selm[q * 4 + w];
            um[w] = (unsigned)__builtin_amdgcn_readfirstlane((int)u); }
#pragma unroll
        for (int w = 0; w < 4; ++w) { const unsigned u = um[w]; const int l32 = lane & 31;
            if (lane < 32 && ((u >> l32) & 1u)) blist[nb + __builtin_popcount(u & ((1u << l32) - 1u))] = (unsigned char)(32 * w + l32);
            nb += __builtin_popcount(u); }
        LDS_WAIT();
        const bf16* kbase = (const bf16*)(a.ws + WS_KTS) + (size_t)b * (SEQ / 32) * 2048;
        const bf16* vb0 = (const bf16*)(a.ws + WS_VTAS) + (size_t)b * (SEQ / 32) * 2048;
        f32x16 o0 = zero16(), o1 = zero16(); float m = -1.0e30f, l = 0.f;
        const int nt = 2 * nb;
        bf16x8 kf[4], vf[2][2], nkf[4], nvf[2][2];
        int blk = blist[0];
        { const int t0i = blk * 2; ld_kt(kf, kbase + (size_t)t0i * 2048, c, hh); ld_vt(vf, vb0 + (size_t)t0i * 2048, c, hh); }
#define NSA_SEL_STEP(TT, KF, VF, NKF, NVF) { \
            const int k0 = blk * 64 + 32 * ((TT) & 1); \
            const int tn = ((TT) + 1 < nt) ? (TT) + 1 : (TT); const int blkn = blist[tn >> 1]; \
            { const int tni = blkn * 2 + (tn & 1); ld_kt(NKF, kbase + (size_t)tni * 2048, c, hh); ld_vt(NVF, vb0 + (size_t)tni * 2048, c, hh); } \
            const bool mysel = ((((blk >> 5) == 0 ? mk[0] : (blk >> 5) == 1 ? mk[1] : (blk >> 5) == 2 ? mk[2] : mk[3]) >> (blk & 31)) & 1u) != 0u; \
            f32x16 x = zero16(); \
            _Pragma("unroll") for (int s = 0; s < 4; ++s) x = mfma32(KF[s], qf[s], x); \
            osm_step(x, 0, tq - k0, hh, k0 + 31 <= t0, mysel, m, l, o0, o1, VF); \
            blk = blkn; }
        for (int t = 0; t < nt; t += 2) {
            NSA_SEL_STEP(t, kf, vf, nkf, nvf)
            NSA_SEL_STEP(t + 1, nkf, nvf, kf, vf)
        }
#undef NSA_SEL_STEP
        const float lt = red32_sum(l); const float sc = g1 / fmaxf(lt, 1.0e-30f);
#pragma unroll
        for (int i = 0; i < 16; ++i) { of0[i] += sc * o0[i]; of1[i] += sc * o1[i]; }
    }
    {
        const bf16* kbase = (const bf16*)(a.ws + WS_KTW) + (size_t)b * (SEQ / 32) * 2048;
        const bf16* vb0 = (const bf16*)(a.ws + WS_VTAW) + (size_t)b * (SEQ / 32) * 2048;
        f32x16 o0 = zero16(), o1 = zero16(); float m = -1.0e30f, l = 0.f;
        const int klo = (t0 >= 511) ? ((t0 - 511) >> 5) : 0, khi = (t0 + 7) >> 5;
        bf16x8 kf[4], vf[2][2], nkf[4], nvf[2][2];
        ld_kt(kf, kbase + (size_t)klo * 2048, c, hh); ld_vt(vf, vb0 + (size_t)klo * 2048, c, hh);
        for (int kt = klo; kt <= khi; ++kt) {
            const int k0 = kt * 32;
            { const int kn = (kt < khi ? kt + 1 : kt); ld_kt(nkf, kbase + (size_t)kn * 2048, c, hh); ld_vt(nvf, vb0 + (size_t)kn * 2048, c, hh); }
            f32x16 x = zero16();
#pragma unroll
            for (int s = 0; s < 4; ++s) x = mfma32(kf[s], qf[s], x);
            osm_step(x, tq - 511 - k0, tq - k0, hh, k0 >= t0 + 7 - 511 && k0 + 31 <= t0, true, m, l, o0, o1, vf);
            copy_kv(kf, vf, nkf, nvf);
        }
        const float lt = red32_sum(l); const float sc = g2 / fmaxf(lt, 1.0e-30f);
#pragma unroll
        for (int i = 0; i < 16; ++i) { of0[i] += sc * o0[i]; of1[i] += sc * o1[i]; }
    }
    store_ot((bf16*)(a.ws + WS_B) + tokq * DM + hd * 64, of0, of1, 1.f, hh);
}

#ifndef DSA_REP_S
#define DSA_REP_S 1
#define DSA_REP_L 1
#define DSA_REP_A 1
#endif
#ifndef DSA_REP_1
#define DSA_REP_1 1
#define DSA_REP_2 1
#define DSA_REP_3 1
#endif
constexpr int DSA_CIDX = 132096, DSA_LIST = DSA_CIDX + 16384, DSA_DUMMY = DSA_LIST + 8192;  static_assert(DSA_DUMMY + 8 * 128 <= MISC_OFF, "DSA LDS map");
static_assert(DSA_LIST + 8192 <= MISC_OFF, "DSA LDS map");
typedef short v4i16_t __attribute__((ext_vector_type(4)));
DI unsigned f2key(float f) { const unsigned u = __float_as_uint(f); return u ^ ((u >> 31) ? 0xffffffffu : 0x80000000u); }
DI int wave_excl_scan(int v, int lane) { (void)lane; return wave_incl_scan(v) - v; }
DI int wave_sum_i(int v) {
    v += DPPI(v, 0xB1, 0xF, true); v += DPPI(v, 0x4E, 0xF, true); v += DPPI(v, 0x124, 0xF, true); v += DPPI(v, 0x128, 0xF, true);
    const auto r = __builtin_amdgcn_permlane16_swap((unsigned)v, (unsigned)v, false, false); v = (int)(r[0] + r[1]);
    const auto q = __builtin_amdgcn_permlane32_swap((unsigned)v, (unsigned)v, false, false); return (int)(q[0] + q[1]);
}
template <int NR>
DI unsigned kth_regn(const unsigned (&k)[16], int K) {
    unsigned hi = 0u, lo = 0xffffffffu;
#pragma unroll
    for (int j = 0; j < NR; ++j) { hi = (k[j] > hi) ? k[j] : hi; const unsigned kk = k[j] ? k[j] : 0xffffffffu; lo = (kk < lo) ? kk : lo; }
    hi = max(hi, (unsigned)DPPI((int)hi, 0xB1, 0xF, true)); hi = max(hi, (unsigned)DPPI((int)hi, 0x4E, 0xF, true));
    lo = min(lo, (unsigned)__builtin_amdgcn_update_dpp((int)0xffffffff, (int)lo, 0xB1, 0xF, 0xF, false)); lo = min(lo, (unsigned)__builtin_amdgcn_update_dpp((int)0xffffffff, (int)lo, 0x4E, 0xF, 0xF, false));
    hi = max(hi, (unsigned)DPPI((int)hi, 0x124, 0xF, true)); hi = max(hi, (unsigned)DPPI((int)hi, 0x128, 0xF, true));
    lo = min(lo, (unsigned)__builtin_amdgcn_update_dpp((int)0xffffffff, (int)lo, 0x124, 0xF, 0xF, false)); lo = min(lo, (unsigned)__builtin_amdgcn_update_dpp((int)0xffffffff, (int)lo, 0x128, 0xF, 0xF, false));
    { const auto r = __builtin_amdgcn_permlane16_swap(hi, hi, false, false); hi = max(r[0], r[1]); const auto q = __builtin_amdgcn_permlane32_swap(hi, hi, false, false); hi = max(q[0], q[1]); }
    { const auto r = __builtin_amdgcn_permlane16_swap(lo, lo, false, false); lo = min(r[0], r[1]); const auto q = __builtin_amdgcn_permlane32_swap(lo, lo, false, false); lo = min(q[0], q[1]); }
    const unsigned diff = (unsigned)__builtin_amdgcn_readfirstlane((int)(hi ^ lo));
    if (diff == 0u) return (unsigned)__builtin_amdgcn_readfirstlane((int)hi);
    const int top = 31 - __builtin_clz(diff);
    unsigned prefix = (unsigned)__builtin_amdgcn_readfirstlane((int)hi) & ~((2u << top) - 1u);
#pragma unroll 1
    for (int bit = top; bit >= 0; --bit) {
        const unsigned cand = prefix | (1u << bit); int c = 0;
#pragma unroll
        for (int j = 0; j < NR; ++j) c += __builtin_popcountll(__ballot(k[j] >= cand));
        if (c >= K) prefix = cand;
    }
    return prefix;
}
DI unsigned kth_reg16(const unsigned (&k)[16], int K) { return kth_regn<16>(k, K); }
DI unsigned kth_disp(const unsigned (&k)[16], int K, int nr) { return nr <= 6 ? kth_regn<6>(k, K) : nr <= 8 ? kth_regn<8>(k, K) : nr <= 12 ? kth_regn<12>(k, K) : kth_regn<16>(k, K); }
DI void dsa_attend(const Args& a, const bf16* proj, int b, size_t tokq, const LAS unsigned short* list, int cnt, LAS unsigned char* stg, int lane) {
        const int col = lane & 15, quad = lane >> 4, hd = col & 3;
        const bf16* qp = proj + tokq * PW + C_DQ + hd * 64 + 8 * quad;
        const bf16x8 qb0 = *(const bf16x8*)qp, qb1 = *(const bf16x8*)(qp + 32);
        const bf16* krow0 = proj + (size_t)b * SEQ * PW + C_DK; const bf16* vrow0 = proj + (size_t)b * SEQ * PW + C_DV;
        const int grow_ = lane >> 3, piece_ = lane & 7;
        f32x4 o[4];
#pragma unroll
        for (int dt = 0; dt < 4; ++dt) o[dt] = (f32x4){0.f, 0.f, 0.f, 0.f};
        float mrun = -1.0e30f, ls = 0.f;
#pragma unroll 1
        for (int ch = 0; ch < 2; ++ch) {
            if (ch * 128 >= cnt) break;
            int grow = grow_, piece = piece_; asm volatile("" : "+v"(grow), "+v"(piece));
            u32x4 wk[16], wv[16];
#pragma unroll
            for (int it = 0; it < 16; ++it) { const int j = ch * 128 + it * 8 + grow; const unsigned kidx = (j < cnt) ? (unsigned)list[j] : 0u;
                wk[it] = *(const u32x4*)(krow0 + (size_t)kidx * PW + 8 * piece); wv[it] = *(const u32x4*)(vrow0 + (size_t)kidx * PW + 8 * piece); }
#pragma unroll
            for (int it = 0; it < 16; ++it) { const int row = it * 8 + grow; *(LAS u32x4*)(stg + row * 128 + ((piece ^ (row & 7)) * 16)) = wk[it]; }
            LDS_WAIT();
            float sr[8][4];
            {
                int colq = col, quadq = quad; asm volatile("" : "+v"(colq), "+v"(quadq));
#pragma unroll
                for (int kt = 0; kt < 8; ++kt) {
                    const int row = kt * 16 + colq;
                    const bf16x8 a0 = *(const LAS bf16x8*)(stg + row * 128 + ((quadq ^ (row & 7)) * 16)), a1 = *(const LAS bf16x8*)(stg + row * 128 + (((quadq + 4) ^ (row & 7)) * 16));
                    f32x4 d = (f32x4){0.f, 0.f, 0.f, 0.f};
                    d = mfma16(a0, qb0, d); d = mfma16(a1, qb1, d);
#pragma unroll
                    for (int i = 0; i < 4; ++i) sr[kt][i] = (ch * 128 + kt * 16 + 4 * quadq + i < cnt) ? d[i] : -1.0e30f;
                }
            }
            float mx = -1.0e30f;
#pragma unroll
            for (int kt = 0; kt < 8; ++kt)
#pragma unroll
                for (int i = 0; i < 4; ++i) mx = fmaxf(mx, sr[kt][i]);
            mx = red16_max(mx); mx = red32_max(mx);
            const float mn = fmaxf(mrun, mx), al = fexp2(mrun - mn); mrun = mn;
            float lc = 0.f;
#pragma unroll
            for (int kt = 0; kt < 8; ++kt)
#pragma unroll
                for (int i = 0; i < 4; ++i) { const float p = (sr[kt][i] > -1.0e29f) ? fexp2(sr[kt][i] - mn) : 0.f; sr[kt][i] = p; lc += p; }
            lc = red16_sum(lc); lc = red32_sum(lc);
            ls = ls * al + lc;
#pragma unroll
            for (int dt = 0; dt < 4; ++dt) o[dt] = o[dt] * al;
            LDS_WAIT();
#pragma unroll
            for (int it = 0; it < 16; ++it) { const int row = it * 8 + grow; *(LAS u32x4*)(stg + row * 128 + ((piece ^ (row & 7)) * 16)) = wv[it]; }
            LDS_WAIT();
            {
                int colp = col, quadp = quad; asm volatile("" : "+v"(colp), "+v"(quadp));
#pragma unroll
                for (int g = 0; g < 4; ++g) {
                    u32x4 pw; pw.x = cvtpk(sr[2 * g][0], sr[2 * g][1]); pw.y = cvtpk(sr[2 * g][2], sr[2 * g][3]); pw.z = cvtpk(sr[2 * g + 1][0], sr[2 * g + 1][1]); pw.w = cvtpk(sr[2 * g + 1][2], sr[2 * g + 1][3]);
                    const bf16x8 pb = __builtin_bit_cast(bf16x8, pw);
                    const int klo = 32 * g + 4 * quadp + (colp >> 2), khi = klo + 16;
#pragma unroll
                    for (int dt = 0; dt < 4; ++dt) { const int pc = 2 * dt + ((colp & 3) >> 1), bo = (colp & 1) * 8;
                        const v4i16_t lo = __builtin_amdgcn_ds_read_tr16_b64_v4i16((LAS v4i16_t*)(stg + klo * 128 + ((pc ^ (klo & 7)) * 16) + bo));
                        const v4i16_t hi = __builtin_amdgcn_ds_read_tr16_b64_v4i16((LAS v4i16_t*)(stg + khi * 128 + ((pc ^ (khi & 7)) * 16) + bo));
                        const bf16x8 av = (bf16x8){lo[0], lo[1], lo[2], lo[3], hi[0], hi[1], hi[2], hi[3]};
                        o[dt] = mfma16(av, pb, o[dt]); }
                }
            }
            LDS_WAIT();
        }
        if (col < 4) { const float inv = 1.f / ls; bf16* om = (bf16*)(a.ws + WS_B) + tokq * DM + 768 + hd * 64 + 4 * quad;
#pragma unroll
            for (int dt = 0; dt < 4; ++dt) { float v[4] = {o[dt][0] * inv, o[dt][1] * inv, o[dt][2] * inv, o[dt][3] * inv}; st4bf(om + 16 * dt, v); } }
    }

DI void dsa_attend2(const Args& a, const bf16* proj, int b, size_t tokA, const LAS unsigned short* listA, int cntA, size_t tokB, const LAS unsigned short* listB, int cntB, LAS unsigned char* stg, int lane) {
    const int col = lane & 15, quad = lane >> 4, hd = col & 3;
    const bf16* krow0 = proj + (size_t)b * SEQ * PW + C_DK; const bf16* vrow0 = proj + (size_t)b * SEQ * PW + C_DV;
    const int grow_ = lane >> 3, piece_ = lane & 7;
    const int ncA = (cntA + 63) >> 6, nc = ncA + ((cntB + 63) >> 6);
    bf16x8 qb0, qb1; f32x4 o[4]; float mrun = -1.0e30f, ls = 0.f;
    u32x4 wk0[8], wv0[8], wk1[8], wv1[8];
#define DSA_GATHER(WK, WV, CI) { const bool isb_ = (CI) >= ncA; const int ch_ = isb_ ? (CI) - ncA : (CI); const int cnt_ = isb_ ? cntB : cntA; const LAS unsigned short* li_ = isb_ ? listB : listA; \
        int grow = grow_, piece = piece_; asm volatile("" : "+v"(grow), "+v"(piece)); \
        _Pragma("unroll") for (int it = 0; it < 8; ++it) { const int j = ch_ * 64 + it * 8 + grow; const unsigned kidx = (j < cnt_) ? (unsigned)li_[j] : 0u; \
            WK[it] = *(const u32x4*)(krow0 + (size_t)kidx * PW + 8 * piece); WV[it] = *(const u32x4*)(vrow0 + (size_t)kidx * PW + 8 * piece); } }
#define DSA_CHUNK(WK, WV, CI) { const bool isb_ = (CI) >= ncA; const int ch_ = isb_ ? (CI) - ncA : (CI); const int cnt_ = isb_ ? cntB : cntA; \
        if (ch_ == 0) { const bf16* qp = proj + (isb_ ? tokB : tokA) * PW + C_DQ + hd * 64 + 8 * quad; qb0 = *(const bf16x8*)qp; qb1 = *(const bf16x8*)(qp + 32); mrun = -1.0e30f; ls = 0.f; \
            _Pragma("unroll") for (int dt = 0; dt < 4; ++dt) o[dt] = (f32x4){0.f, 0.f, 0.f, 0.f}; } \
        int grow = grow_, piece = piece_; asm volatile("" : "+v"(grow), "+v"(piece)); \
        _Pragma("unroll") for (int it = 0; it < 8; ++it) { const int row = it * 8 + grow; *(LAS u32x4*)(stg + row * 128 + ((piece ^ (row & 7)) * 16)) = WK[it]; } \
        LDS_WAIT(); \
        float sr[4][4]; \
        { int colq = col, quadq = quad; asm volatile("" : "+v"(colq), "+v"(quadq)); \
          _Pragma("unroll") for (int kt = 0; kt < 4; ++kt) { const int row = kt * 16 + colq; \
            const bf16x8 a0 = *(const LAS bf16x8*)(stg + row * 128 + ((quadq ^ (row & 7)) * 16)), a1 = *(const LAS bf16x8*)(stg + row * 128 + (((quadq + 4) ^ (row & 7)) * 16)); \
            f32x4 d = (f32x4){0.f, 0.f, 0.f, 0.f}; d = mfma16(a0, qb0, d); d = mfma16(a1, qb1, d); \
            _Pragma("unroll") for (int i = 0; i < 4; ++i) sr[kt][i] = (ch_ * 64 + kt * 16 + 4 * quadq + i < cnt_) ? d[i] : -3.0e38f; } } \
        float mx = -3.0e38f; \
        _Pragma("unroll") for (int kt = 0; kt < 4; ++kt) _Pragma("unroll") for (int i = 0; i < 4; ++i) mx = fmaxf(mx, sr[kt][i]); \
        mx = red16_max(mx); mx = red32_max(mx); \
        const float mn = fmaxf(mrun, mx), al = fexp2(mrun - mn); mrun = mn; \
        float lc = 0.f; \
        _Pragma("unroll") for (int kt = 0; kt < 4; ++kt) _Pragma("unroll") for (int i = 0; i < 4; ++i) { const float p = fexp2(sr[kt][i] - mn); sr[kt][i] = p; lc += p; } \
        lc = red16_sum(lc); lc = red32_sum(lc); ls = ls * al + lc; \
        _Pragma("unroll") for (int dt = 0; dt < 4; ++dt) o[dt] = o[dt] * al; \
        LDS_WAIT(); \
        _Pragma("unroll") for (int it = 0; it < 8; ++it) { const int row = it * 8 + grow; *(LAS u32x4*)(stg + row * 128 + ((piece ^ (row & 7)) * 16)) = WV[it]; } \
        LDS_WAIT(); \
        { int colp = col, quadp = quad; asm volatile("" : "+v"(colp), "+v"(quadp)); \
          _Pragma("unroll") for (int g = 0; g < 2; ++g) { \
            u32x4 pw; pw.x = cvtpk(sr[2 * g][0], sr[2 * g][1]); pw.y = cvtpk(sr[2 * g][2], sr[2 * g][3]); pw.z = cvtpk(sr[2 * g + 1][0], sr[2 * g + 1][1]); pw.w = cvtpk(sr[2 * g + 1][2], sr[2 * g + 1][3]); \
            const bf16x8 pb = __builtin_bit_cast(bf16x8, pw); \
            const int klo = 32 * g + 4 * quadp + (colp >> 2), khi = klo + 16; \
            _Pragma("unroll") for (int dt = 0; dt < 4; ++dt) { const int pc = 2 * dt + ((colp & 3) >> 1), bo = (colp & 1) * 8; \
                const v4i16_t lo = __builtin_amdgcn_ds_read_tr16_b64_v4i16((LAS v4i16_t*)(stg + klo * 128 + ((pc ^ (klo & 7)) * 16) + bo)); \
                const v4i16_t hi = __builtin_amdgcn_ds_read_tr16_b64_v4i16((LAS v4i16_t*)(stg + khi * 128 + ((pc ^ (khi & 7)) * 16) + bo)); \
                const bf16x8 av = (bf16x8){lo[0], lo[1], lo[2], lo[3], hi[0], hi[1], hi[2], hi[3]}; \
                o[dt] = mfma16(av, pb, o[dt]); } } } \
        LDS_WAIT(); \
        const int nch_ = isb_ ? nc - ncA : ncA; \
        if (ch_ == nch_ - 1 && col < 4) { const float inv = 1.f / ls; bf16* om = (bf16*)(a.ws + WS_B) + (isb_ ? tokB : tokA) * DM + 768 + hd * 64 + 4 * quad; \
            _Pragma("unroll") for (int dt = 0; dt < 4; ++dt) { float v[4] = {o[dt][0] * inv, o[dt][1] * inv, o[dt][2] * inv, o[dt][3] * inv}; st4bf(om + 16 * dt, v); } } }
    if (nc > 0) DSA_GATHER(wk0, wv0, 0)
    for (int ci = 0; ci < nc; ci += 2) {
        if (ci + 1 < nc) DSA_GATHER(wk1, wv1, ci + 1)
        DSA_CHUNK(wk0, wv0, ci)
        if (ci + 1 < nc) {
            if (ci + 2 < nc) DSA_GATHER(wk0, wv0, ci + 2)
            DSA_CHUNK(wk1, wv1, ci + 1)
        }
    }
#undef DSA_GATHER
#undef DSA_CHUNK
}

typedef unsigned short u16x2_t __attribute__((ext_vector_type(2)));
DI unsigned pkmax16(unsigned x, unsigned y) { return __builtin_bit_cast(unsigned, __builtin_elementwise_max(__builtin_bit_cast(u16x2_t, x), __builtin_bit_cast(u16x2_t, y))); }
DI unsigned f2key16s(float f) { const unsigned h = (unsigned)__builtin_bit_cast(unsigned short, (_Float16)f); return h ^ ((unsigned)((int)__float_as_uint(f) >> 31) | 0x8000u); }
DI unsigned f2key16(float f) { const unsigned h = (unsigned)__builtin_bit_cast(unsigned short, (_Float16)f); return (h & 0x8000u) ? (~h & 0xffffu) : (h | 0x8000u); }
template <int NR>
DI int dsa_pick(const LAS unsigned short* s16, const LAS unsigned short* cidx, LAS unsigned short* list, int c, int lane, unsigned long long ltm, unsigned& tau) {
    unsigned ck[16], ixs[16];
#pragma unroll
    for (int j = 0; j < 16; ++j) { ck[j] = 0u; ixs[j] = 0u; }
#pragma unroll
    for (int j = 0; j < NR; ++j) ixs[j] = (unsigned)cidx[j * 64 + lane];
#pragma unroll
    for (int j = 0; j < NR; ++j) ixs[j] = (j * 64 + lane < c) ? ixs[j] : 0u;
#pragma unroll
    for (int j = 0; j < NR; ++j) ck[j] = (unsigned)s16[ixs[j]];
#pragma unroll
    for (int j = 0; j < NR; ++j) ck[j] = (j * 64 + lane < c) ? ck[j] : 0u;
    tau = kth_regn<NR>(ck, 256);
    int cg = 0;
#pragma unroll
    for (int j = 0; j < NR; ++j) cg += (ck[j] > tau) ? 1 : 0;
    const int krem = 256 - wave_sum_i(cg);
    int total = 0, eqt = 0;
#pragma unroll
    for (int j = 0; j < NR; ++j) {
        if (j * 64 < c) {
            const bool gt = ck[j] > tau, eq = ck[j] == tau;
            const unsigned long long eqm = __ballot(eq); const int eqp = __popcll(eqm & ltm);
            const bool take = gt || (eq && (eqt + eqp < krem));
            const unsigned long long tm = __ballot(take); const int pos = total + __popcll(tm & ltm);
            if (take) list[pos] = (unsigned short)ixs[j];
            total += __popcll(tm); eqt += __popcll(eqm);
        }
    }
    return total;
}
DI void dsa_unit16(const Args& a, int pu, LAS unsigned char* lds, int wave, int lane) {
    const bf16* proj = (const bf16*)(a.ws + WS_A);
    const int b = pu >> 9, p = pu & 511;
    const int tA0 = 8 * p, tB0 = 8184 - 8 * p, nA = tA0 + 8, nB = tB0 + 8;
    const int na32 = (nA + 31) & ~31, nb32 = (nB + 31) & ~31;
    LAS unsigned short* sc = (LAS unsigned short*)lds;
    {
        const int c = lane & 31, hh = lane >> 5, qr = c >> 2, hr = c & 3;
        const size_t tokA = (size_t)b * SEQ + tA0, tokB = (size_t)b * SEQ + tB0;
        bf16x8 iqA[4], iqB[4];
#pragma unroll
        for (int s = 0; s < 4; ++s) { iqA[s] = *(const bf16x8*)(proj + (tokA + qr) * PW + C_DIQ + hr * 64 + 16 * s + 8 * hh); iqB[s] = *(const bf16x8*)(proj + (tokB + qr) * PW + C_DIQ + hr * 64 + 16 * s + 8 * hh); }
        f32x4 iwA[4], iwB[4];
#pragma unroll
        for (int g = 0; g < 4; ++g) { iwA[g] = *(const f32x4*)((const float*)(a.ws + WS_IW) + (tokA + 2 * g + hh) * 4); iwB[g] = *(const f32x4*)((const float*)(a.ws + WS_IW) + (tokB + 2 * g + hh) * 4); }
        const bf16* kb = (const bf16*)(a.ws + WS_IKT) + (size_t)b * (SEQ / 32) * 2048;
        const int ntA = na32 >> 5, ntB = nb32 >> 5;
        LAS unsigned short* dA = sc + hh * na32 + c; LAS unsigned short* dB = sc + 8 * na32 + hh * nb32 + c;
#define DSA_EPI(X, IW, T0, DST, PITCH, K0, MASK) { _Pragma("unroll") for (int g = 0; g < 4; ++g) { \
            const float r0 = __builtin_amdgcn_fmed3f(X[4 * g], 0.f, 3.0e38f), r1 = __builtin_amdgcn_fmed3f(X[4 * g + 1], 0.f, 3.0e38f); \
            const float r2 = __builtin_amdgcn_fmed3f(X[4 * g + 2], 0.f, 3.0e38f), r3 = __builtin_amdgcn_fmed3f(X[4 * g + 3], 0.f, 3.0e38f); \
            float a0 = __builtin_fmaf(IW[g].x, r0, 0.f), a1 = __builtin_fmaf(IW[g].y, r1, 0.f); a0 = __builtin_fmaf(IW[g].z, r2, a0); a1 = __builtin_fmaf(IW[g].w, r3, a1); \
            unsigned key = f2key16s(a0 + a1); if (MASK) key = ((K0) + c <= (T0) + 2 * g + hh) ? key : 0u; \
            (DST)[2 * g * (PITCH) + (K0)] = (unsigned short)key; } }
        bf16x8 kf[4], nkf[4];
        if (wave < ntB) ld_kt(kf, kb + (size_t)wave * 2048, c, hh);
        for (int kt = wave; kt < ntB; kt += NWAVES) {
            { const int kn = (kt + NWAVES < ntB) ? kt + NWAVES : kt; ld_kt(nkf, kb + (size_t)kn * 2048, c, hh); }
            const int k0 = kt * 32; const bool hasA = kt < ntA;
            f32x16 x = zero16(), y = zero16();
#pragma unroll
            for (int s = 0; s < 4; ++s) x = mfma32(iqB[s], kf[s], x);
            if (hasA) {
#pragma unroll
                for (int s = 0; s < 4; ++s) y = mfma32(iqA[s], kf[s], y);
            }
            if (k0 + 31 > tB0) DSA_EPI(x, iwB, tB0, dB, nb32, k0, true) else DSA_EPI(x, iwB, tB0, dB, nb32, k0, false)
            if (hasA) { if (k0 + 31 > tA0) DSA_EPI(y, iwA, tA0, dA, na32, k0, true) else DSA_EPI(y, iwA, tA0, dA, na32, k0, false) }
#pragma unroll
            for (int s = 0; s < 4; ++s) kf[s] = nkf[s];
        }
#undef DSA_EPI
    }
    __syncthreads();
    LAS unsigned short* cidx = (LAS unsigned short*)(lds + DSA_CIDX + wave * 2048);
    LAS unsigned short* dummy = (LAS unsigned short*)(lds + DSA_DUMMY + wave * 128) + lane;
    const unsigned long long ltm = (1ull << lane) - 1ull;
    int cntA = 0, cntB = 0;
#pragma unroll 1
    for (int blk = 0; blk < 2; ++blk) {
        const int tq = (blk ? tB0 : tA0) + wave, n = tq + 1, n32 = (blk ? nb32 : na32);
        const LAS unsigned short* s16 = sc + (blk ? 8 * na32 + wave * nb32 : wave * na32);
        LAS unsigned short* list = (LAS unsigned short*)(lds + DSA_LIST + (blk * 8 + wave) * 512);
        int cnt;
        if (n <= 256) { for (int i = lane; i < n; i += 64) list[i] = (unsigned short)i; cnt = n; }
        else {
            int c = 0;
            if (n <= 1024) { for (int i = lane; i < n; i += 64) cidx[i] = (unsigned short)i; c = n; }
            else {
                const bool cs4 = n <= 2048; unsigned M[16];
#pragma unroll
                for (int it = 0; it < 16; ++it) {
                    const int i8 = (cs4 ? (it >> 1) : it) * 512 + lane * 8; unsigned mx = 0u;
                    if (i8 < n32) { const u32x4 v = *(const LAS u32x4*)(s16 + i8);
                        if (cs4) { const unsigned m2 = (it & 1) ? pkmax16(v.z, v.w) : pkmax16(v.x, v.y); mx = max(m2 & 0xffffu, m2 >> 16); }
                        else { const unsigned m4 = pkmax16(pkmax16(v.x, v.y), pkmax16(v.z, v.w)); mx = max(m4 & 0xffffu, m4 >> 16); } }
                    if (cs4 && it >= 8) mx = 0u;
                    M[it] = mx;
                }
                const unsigned beta = kth_disp(M, 256, cs4 ? ((n32 + 255) >> 8) : ((n32 + 511) >> 9));
                for (int i0 = 0; i0 < n32; i0 += 512) {
                    const int i8 = i0 + lane * 8;
                    u32x4 v = (u32x4){0u, 0u, 0u, 0u}; if (i8 < n32) v = *(const LAS u32x4*)(s16 + i8);
                    const unsigned kk[8] = {v.x & 0xffffu, v.x >> 16, v.y & 0xffffu, v.y >> 16, v.z & 0xffffu, v.z >> 16, v.w & 0xffffu, v.w >> 16};
                    int fc = 0;
#pragma unroll
                    for (int k = 0; k < 8; ++k) fc += (kk[k] >= beta) ? 1 : 0;
                    const int inc = wave_incl_scan(fc); int pos = c + inc - fc;
#pragma unroll
                    for (int k = 0; k < 8; ++k) { const bool cd = kk[k] >= beta;
                        LAS unsigned short* d = (cd && pos < 1024) ? (cidx + pos) : dummy; *d = (unsigned short)(i8 + k); pos += cd ? 1 : 0; }
                    c += __builtin_amdgcn_readlane(inc, 63);
                }
                LDS_WAIT();
            }
            unsigned tau; bool fromc = (c <= 1024);
            if (fromc) {
                const int nr = (c + 63) >> 6;
                cnt = nr <= 6 ? dsa_pick<6>(s16, cidx, list, c, lane, ltm, tau) : nr <= 8 ? dsa_pick<8>(s16, cidx, list, c, lane, ltm, tau) : nr <= 12 ? dsa_pick<12>(s16, cidx, list, c, lane, ltm, tau) : dsa_pick<16>(s16, cidx, list, c, lane, ltm, tau);
            } else {
                tau = 0u;
                for (int bit = 15; bit >= 0; --bit) {
                    const unsigned cand = tau | (1u << bit); int cc = 0;
                    for (int i = lane; i < n; i += 64) cc += ((unsigned)s16[i] >= cand) ? 1 : 0;
                    if (wave_sum_i(cc) >= 256) tau = cand;
                }
                int cg = 0;
                for (int i = lane; i < n; i += 64) cg += ((unsigned)s16[i] > tau) ? 1 : 0;
                const int krem = 256 - wave_sum_i(cg);
                int total = 0, eqt = 0;
                for (int i0 = 0; i0 < n; i0 += 64) {
                    const int i = i0 + lane; const unsigned key = (i < n) ? (unsigned)s16[i] : 0u;
                    const bool gt = key > tau, eq = (i < n) && key == tau;
                    const unsigned long long eqm = __ballot(eq); const int eqp = __popcll(eqm & ltm);
                    const bool take = gt || (eq && (eqt + eqp < krem));
                    const unsigned long long tm = __ballot(take); const int pos = total + __popcll(tm & ltm);
                    if (take) list[pos] = (unsigned short)i;
                    total += __popcll(tm); eqt += __popcll(eqm);
                }
                cnt = total;
            }
        }
        if (blk) cntB = cnt; else cntA = cnt;
    }
    __syncthreads();
    dsa_attend2(a, proj, b, (size_t)b * SEQ + tA0 + wave, (const LAS unsigned short*)(lds + DSA_LIST + wave * 512), cntA, (size_t)b * SEQ + tB0 + wave, (const LAS unsigned short*)(lds + DSA_LIST + (8 + wave) * 512), cntB, lds + wave * 16384, lane);
    __syncthreads();
}

#ifndef HOSTDUP
#define HOSTDUP 0
#endif
#ifndef MK_SINGLE
#define MK_SINGLE 1
#endif
constexpr int PRM_OFF = MISC_OFF + 256;
DI void store_args(LAS unsigned char* lds, const Args& k) {
    LAS unsigned long long* q = (LAS unsigned long long*)(lds + PRM_OFF);
    q[0] = (unsigned long long)k.x; q[1] = (unsigned long long)k.pos; q[2] = (unsigned long long)k.w_in; q[3] = (unsigned long long)k.b_f; q[4] = (unsigned long long)k.pe_cmp;
    q[5] = (unsigned long long)k.w_cmp1; q[6] = (unsigned long long)k.w_cmp2; q[7] = (unsigned long long)k.w_gate; q[8] = (unsigned long long)k.w_br; q[9] = (unsigned long long)k.w_o;
    q[10] = (unsigned long long)k.ln1_g; q[11] = (unsigned long long)k.ln1_b; q[12] = (unsigned long long)k.w_router; q[13] = (unsigned long long)k.router_bias;
    q[14] = (unsigned long long)k.w_eg; q[15] = (unsigned long long)k.w_eu; q[16] = (unsigned long long)k.w_ed; q[17] = (unsigned long long)k.w_sg; q[18] = (unsigned long long)k.w_su; q[19] = (unsigned long long)k.w_sd;
    q[20] = (unsigned long long)k.ln2_g; q[21] = (unsigned long long)k.ln2_b; q[22] = (unsigned long long)k.out; q[23] = (unsigned long long)k.ws;
}
DI unsigned long long ldprm(LAS unsigned char* lds, int i) {
    const u32x2 v = *(const LAS u32x2*)(lds + PRM_OFF + 8 * i);
    return ((unsigned long long)(unsigned)__builtin_amdgcn_readfirstlane((int)v.y) << 32) | (unsigned long long)(unsigned)__builtin_amdgcn_readfirstlane((int)v.x);
}
DI Args lds_args(LAS unsigned char* lds) {
    Args a;
    a.x = (const float*)(const GAS float*)ldprm(lds, 0); a.pos = (const int*)(const GAS int*)ldprm(lds, 1); a.w_in = (const float*)(const GAS float*)ldprm(lds, 2); a.b_f = (const float*)(const GAS float*)ldprm(lds, 3); a.pe_cmp = (const float*)(const GAS float*)ldprm(lds, 4);
    a.w_cmp1 = (const float*)(const GAS float*)ldprm(lds, 5); a.w_cmp2 = (const float*)(const GAS float*)ldprm(lds, 6); a.w_gate = (const float*)(const GAS float*)ldprm(lds, 7); a.w_br = (const float*)(const GAS float*)ldprm(lds, 8); a.w_o = (const float*)(const GAS float*)ldprm(lds, 9);
    a.ln1_g = (const float*)(const GAS float*)ldprm(lds, 10); a.ln1_b = (const float*)(const GAS float*)ldprm(lds, 11); a.w_router = (const float*)(const GAS float*)ldprm(lds, 12); a.router_bias = (const float*)(const GAS float*)ldprm(lds, 13);
    a.w_eg = (const float*)(const GAS float*)ldprm(lds, 14); a.w_eu = (const float*)(const GAS float*)ldprm(lds, 15); a.w_ed = (const float*)(const GAS float*)ldprm(lds, 16); a.w_sg = (const float*)(const GAS float*)ldprm(lds, 17); a.w_su = (const float*)(const GAS float*)ldprm(lds, 18); a.w_sd = (const float*)(const GAS float*)ldprm(lds, 19);
    a.ln2_g = (const float*)(const GAS float*)ldprm(lds, 20); a.ln2_b = (const float*)(const GAS float*)ldprm(lds, 21); a.out = (float*)(GAS float*)ldprm(lds, 22); a.ws = (unsigned char*)(GAS unsigned char*)ldprm(lds, 23); a.ph_lo = 0; a.ph_hi = 0;
    return a;
}
#ifndef PHMASK
#define PHMASK 0xffffffffu
#endif
#define PHON(j) (((PHMASK) >> (j)) & 1u)
#define PH_BEGIN const Args a = lds_args(lds); unsigned char* ws = a.ws; (void)ws; \
    const int tid = ltid(), lane = tid & 63, wave = __builtin_amdgcn_readfirstlane(tid >> 6); \
    const int G = lgrid(), bid = lbid(), gw = bid * NWAVES + wave, NGW = G * NWAVES; (void)bid; (void)lane; (void)wave; (void)gw; (void)NGW; (void)G;
#ifndef PH_NOINLINE
#define PHFN DI void
#else
#define PHFN __attribute__((noinline)) __device__ void
#endif

PHFN f_prologue(LAS unsigned char* lds) { PH_BEGIN ph_prologue(a, gw, NGW, lane); }
PHFN f_cvt(LAS unsigned char* lds, int l) { PH_BEGIN ph_cvt(a, l, lds, gw, NGW, wave, lane); }
PHFN f_proj(LAS unsigned char* lds) { PH_BEGIN
    SchedProj S; S.so.init(NTOK, PW, G, bid); S.A = (unsigned)WS_XB; S.B = (unsigned)W_IN;
    EpiProj E; E.proj = (bf16*)(ws + WS_A); E.sm32 = (float*)(ws + WS_SM32);
    gs::gemm_stream<SchedProj, EpiProj, 2>(lds, (const char*)ws, S, E); }
PHFN f_post(LAS unsigned char* lds, int l) { PH_BEGIN ph_post(a, l, lds, wave, lane); }
PHFN f_cmp(LAS unsigned char* lds) { PH_BEGIN
    SchedCmp S; S.kcr = (unsigned)WS_KCR; S.vcr = (unsigned)WS_VCR; S.w = (unsigned)W_C1;
    EpiCmp E; E.hid = (float*)(ws + WS_HID); E.cbias = (const float*)(ws + WS_CBIAS);
    gs::gemm_stream<SchedCmp, EpiCmp, 2>(lds, (const char*)ws, S, E);
    if (bid >= 32 && bid < 64 && wave == 0) cumsum_seq(a, bid - 32, lane);
    if (G < 64 && bid == 0 && wave == 1) for (int q = (G > 32 ? G - 32 : 0); q < 32; ++q) cumsum_seq(a, q, lane); }
PHFN f_cmp2(LAS unsigned char* lds, int l) { PH_BEGIN ph_cmp2(a, l, gw, NGW, lane); }
PHFN f_dsa(LAS unsigned char* lds) { PH_BEGIN for (int pu = bid; pu < NTOK / 16; pu += G) dsa_unit16(a, pu, lds, wave, lane); }
PHFN f_nsa(LAS unsigned char* lds) { PH_BEGIN
    for (int u = gw, r = 0; u < NTOK / 8; u += NGW, ++r) {
        int unit = u;
        if (NGW == 2048) { const int bsel = u >> 10, pos = ((u & 1023) + 256 * r) & 1023; unit = bsel * 1024 + pos; }
        nsa_unit(a, unit, lds + wave * 5120, lane);
    } }
PHFN f_sbfg(LAS unsigned char* lds, int l) { PH_BEGIN
    for (int u = bid; u < 2048; u += G) {
        const int r = u >> 8, blk = u & 255, bh = blk & 31, f = blk >> 5, mixer = r >> 2, rr = r & 3;
        const int QB = (rr == 0) ? f : (rr == 1) ? 31 - f : (rr == 2) ? 8 + f : 23 - f;
        if (mixer == 0) sbfg_block<0>(a, l, bh >> 2, bh & 3, QB, lds, tid, wave, lane); else sbfg_block<1>(a, l, bh >> 2, bh & 3, QB, lds, tid, wave, lane);
        __syncthreads();
    } }
PHFN f_merge(LAS unsigned char* lds) { PH_BEGIN
    SchedMerge S; S.xb = (unsigned)WS_XB; S.om = (unsigned)WS_B; S.wg = (unsigned)W_G; S.wbr = (unsigned)W_BR; S.G = G;
    EpiMerge E; E.merged = (bf16*)(ws + WS_C); E.lds = lds;
    gs::gemm_stream<SchedMerge, EpiMerge, 1>(lds, (const char*)ws, S, E); }
PHFN f_wo(LAS unsigned char* lds, int l) { PH_BEGIN
    SchedWo S; S.so.init(NTOK, DM, G, bid); S.A = (unsigned)WS_C; S.B = (unsigned)W_O;
    EpiWo E; E.xb = (bf16*)(ws + WS_XB); (void)l;
    gs::gemm_stream<SchedWo, EpiWo, 2>(lds, (const char*)ws, S, E); }
PHFN f_ln1(LAS unsigned char* lds, int l) { PH_BEGIN ph_ln1(a, l, gw, NGW, lane); }
PHFN f_router(LAS unsigned char* lds) { PH_BEGIN
    SchedRouter S; S.xh = (unsigned)WS_XB; S.xl = (unsigned)WS_XL; S.wh = (unsigned)W_RH; S.wl = (unsigned)W_RL; S.G = G;
    EpiRouter E; E.logit = (float*)(ws + WS_LOGIT);
    gs::gemm_stream<SchedRouter, EpiRouter, 1>(lds, (const char*)ws, S, E); }
PHFN f_route(LAS unsigned char* lds, int l) { PH_BEGIN ph_route(a, l, lds, wave, lane); }
PHFN f_e1(LAS unsigned char* lds, int l) { PH_BEGIN
    moe_tables(a, l, lds);
    SchedE1 S; S.ptile = (const LAS int*)(lds + TBL_OFF); S.cntv = S.ptile + 2 * TBLN; S.xb = (unsigned)WS_XB; S.lists = (const unsigned*)(ws + WS_LIST); S.w1 = (unsigned)W_1; S.G = G;
    EpiE1 E; E.hb = (bf16*)(ws + WS_HB);
    gs::gemm_stream<SchedE1, EpiE1, 2>(lds, (const char*)ws, S, E); }
PHFN f_e2(LAS unsigned char* lds, int l, int c) { PH_BEGIN
    moe_tables(a, l, lds);
    SchedE2 S; S.ptile = (const LAS int*)(lds + TBL_OFF); S.ypre = S.ptile + TBLN; S.cntv = S.ptile + 2 * TBLN; S.hb = (unsigned)WS_HB; S.w2 = (unsigned)W_2; S.c = c; S.G = G;
    EpiE2 E; E.y = (unsigned char*)(ws + WS_Y);
    gs::gemm_stream<SchedE2, EpiE2, 2>(lds, (const char*)ws, S, E); }
PHFN f_ln2(LAS unsigned char* lds, int l, int c) { PH_BEGIN moe_tables(a, l, lds); ph_ln2(a, l, c, lds, gw, NGW, lane); }
PHFN f_seam(LAS unsigned char* lds) {
    XcdBarrier bar; bar.bar = (unsigned*)((unsigned char*)(GAS unsigned char*)ldprm(lds, 23) + WS_CTL) + CW_BAR; bar.x = xb_xcc_id(); bar.st = (volatile LAS unsigned*)(lds + MISC_OFF) + 8; xcd_barrier(bar); }

#define IN(k) (lo <= (k) && (k) < hi)
#define SEAM(k) do { if ((k) + 1 < hi) f_seam(lds); } while (0)
DI void run_layer(LAS unsigned char* lds, const int l, const int lo, const int hi) {
        const int pb = 1 + l * NPL;
        if (PHON(0) && IN(pb + 0)) { f_cvt(lds, l); SEAM(pb + 0); }
        if (PHON(1) && IN(pb + 1)) { f_proj(lds); SEAM(pb + 1); }
        if (PHON(2) && IN(pb + 2)) { f_post(lds, l); SEAM(pb + 2); }
        if (PHON(3) && IN(pb + 3)) { f_cmp(lds); __syncthreads(); f_dsa(lds); SEAM(pb + 3); }
        if (PHON(4) && IN(pb + 4)) { f_cmp2(lds, l); __syncthreads(); f_sbfg(lds, l); SEAM(pb + 4); }
        if (PHON(21) && IN(pb + 5)) { f_nsa(lds); SEAM(pb + 5); }
        if (PHON(6) && IN(pb + 6)) { f_merge(lds); SEAM(pb + 6); }
        if (PHON(7) && IN(pb + 7)) { f_wo(lds, l); SEAM(pb + 7); }
        if (PHON(8) && IN(pb + 8)) { f_ln1(lds, l); SEAM(pb + 8); }
        if (PHON(9) && IN(pb + 9)) { f_router(lds); SEAM(pb + 9); }
        if (PHON(10) && IN(pb + 10)) { f_route(lds, l); SEAM(pb + 10); }
        if (PHON(11) && IN(pb + 11)) { f_e1(lds, l); SEAM(pb + 11); }
        for (int c = 0; c < NCH; ++c) {
            if (PHON(12) && IN(pb + 12 + 2 * c)) { f_e2(lds, l, c); SEAM(pb + 12 + 2 * c); }
            if (PHON(13) && IN(pb + 13 + 2 * c)) { f_ln2(lds, l, c); SEAM(pb + 13 + 2 * c); }
        }
}
#undef IN
#undef SEAM
#ifndef DUPMASK
#define DUPMASK 0
#endif
#define DUP(j) (((DUPMASK) >> (j)) & 1)
__global__ void __launch_bounds__(NWAVES * 64, 2) fwd(Args ka) {
    extern __shared__ __attribute__((aligned(16))) unsigned char lds_[];
    LAS unsigned char* lds = (LAS unsigned char*)lds_;
    const int tid = threadIdx.x;
    volatile LAS unsigned* MISC = (volatile LAS unsigned*)(lds + MISC_OFF);
    if (tid < 64) MISC[tid] = 0u;
    if (tid == 64) store_args(lds, ka);
    const int lo = ka.ph_lo, hi = ka.ph_hi;
    __syncthreads();
    if (hi - lo > 1 && tid == 0) (void)xb_add(&((unsigned*)(ka.ws + WS_CTL) + CW_BAR)[XB_XCNT(xb_xcc_id())], 1u);
#define IN(k) (lo <= (k) && (k) < hi)
#define SEAM(k) do { if ((k) + 1 < hi) f_seam(lds); } while (0)
    if (PHON(31) && IN(0)) { f_prologue(lds); SEAM(0); }
    run_layer(lds, 0, lo, hi); run_layer(lds, 1, lo, hi); run_layer(lds, 2, lo, hi); run_layer(lds, 3, lo, hi);
#undef IN
#undef SEAM
}

extern "C" void kernel_launch(void* const* d_in, const int* in_sizes, int n_in, void* d_out, int out_size, void* d_ws, size_t ws_size, hipStream_t stream) {
    static int grid = 0;
    if (grid == 0) {
        if (n_in != 22 || in_sizes[0] != NTOK * DM || out_size != NTOK * DM || ws_size < WS_END) {
            fprintf(stderr, "kernel_launch: unexpected shapes/workspace: n_in %d in0 %d out %d ws %zu (need %zu)\n", n_in, n_in > 0 ? in_sizes[0] : -1, out_size, ws_size, (size_t)WS_END); grid = -1; return; }
        int dev = 0, cus = 0, per_cu = 0;
        if (hipGetDevice(&dev) != hipSuccess || hipDeviceGetAttribute(&cus, hipDeviceAttributeMultiprocessorCount, dev) != hipSuccess) { grid = -1; return; }
        if (hipFuncSetAttribute((const void*)fwd, hipFuncAttributeMaxDynamicSharedMemorySize, LDS_BYTES) != hipSuccess) { fprintf(stderr, "kernel_launch: hipFuncSetAttribute failed\n"); grid = -1; return; }
        if (hipOccupancyMaxActiveBlocksPerMultiprocessor(&per_cu, (const void*)fwd, NWAVES * 64, LDS_BYTES) != hipSuccess || per_cu < 1)
            fprintf(stderr, "kernel_launch: occupancy query reports %d blocks per CU\n", per_cu);
        (void)hipGetLastError();
        grid = cus;
    }
    if (grid < 0) return;
    (void)hipMemsetAsync((char*)d_ws + WS_CTL, 0, CTL_ZERO_BYTES, stream);
    Args a{};
    a.x = (const float*)d_in[0]; a.pos = (const int*)d_in[1]; a.w_in = (const float*)d_in[2]; a.b_f = (const float*)d_in[3]; a.pe_cmp = (const float*)d_in[4];
    a.w_cmp1 = (const float*)d_in[5]; a.w_cmp2 = (const float*)d_in[6]; a.w_gate = (const float*)d_in[7]; a.w_br = (const float*)d_in[8]; a.w_o = (const float*)d_in[9];
    a.ln1_g = (const float*)d_in[10]; a.ln1_b = (const float*)d_in[11]; a.w_router = (const float*)d_in[12]; a.router_bias = (const float*)d_in[13];
    a.w_eg = (const float*)d_in[14]; a.w_eu = (const float*)d_in[15]; a.w_ed = (const float*)d_in[16]; a.w_sg = (const float*)d_in[17]; a.w_su = (const float*)d_in[18]; a.w_sd = (const float*)d_in[19];
    a.ln2_g = (const float*)d_in[20]; a.ln2_b = (const float*)d_in[21];
    a.out = (float*)d_out; a.ws = (unsigned char*)d_ws;
#if MK_SINGLE
    a.ph_lo = 0; a.ph_hi = NPHASE;
    hipLaunchKernelGGL(fwd, dim3(grid), dim3(NWAVES * 64), LDS_BYTES, stream, a);
#else
    for (int p = 0; p < NPHASE; ++p) { a.ph_lo = p; a.ph_hi = p + 1; hipLaunchKernelGGL(fwd, dim3(grid), dim3(NWAVES * 64), LDS_BYTES, stream, a);
        if (p > 0 && ((HOSTDUP >> ((p - 1) % NPL)) & 1)) hipLaunchKernelGGL(fwd, dim3(grid), dim3(NWAVES * 64), LDS_BYTES, stream, a); }
#endif
}
```
